# Optimizing an MI355X kernel written in HIP

```python
import jax, jax.numpy as jnp
from jax import lax
import numpy as np

D_MODEL = 1024
BATCH = 8
SEQ = 4096
DEPTH = 1

MIX_WIDTH = D_MODEL
ATTN_HEADS = 8
HEAD_DIM = 64
ATTN_WIDTH = ATTN_HEADS * HEAD_DIM
CONV_WIDTH = MIX_WIDTH - ATTN_WIDTH
CONV_KERNEL = 31
IN_COLS = 3 * ATTN_WIDTH + 2 * CONV_WIDTH
Q_BLOCK = 128

PEER_HEADS = 8
PEER_KEY_DIM = 128
PEER_HALF = PEER_KEY_DIM // 2
N_KEYS = 128
N_EXPERTS = N_KEYS * N_KEYS
PEER_TOPK = 16
PEER_CHUNK = 128

EPS = 1e-6

kernel_name = "hymba_sbattn_conformer_peer"


def rms_norm(x, g):
    xf = x.astype(jnp.float32)
    y = xf * lax.rsqrt(jnp.mean(xf * xf, axis=-1, keepdims=True) + EPS)
    return (y * g.astype(jnp.float32)).astype(x.dtype)


def layer_norm(x, g, b):
    xf = x.astype(jnp.float32)
    mu = jnp.mean(xf, axis=-1, keepdims=True)
    xc = xf - mu
    var = jnp.mean(xc * xc, axis=-1, keepdims=True)
    y = xc * lax.rsqrt(var + EPS) * g.astype(jnp.float32) + b.astype(jnp.float32)
    return y.astype(x.dtype)


def stick_breaking_attention(q, k, v):
    B, H, S, hd = q.shape
    qf, kf, vf = q.astype(jnp.float32), k.astype(jnp.float32), v.astype(jnp.float32)
    scale = hd ** -0.5
    key_pos = jnp.arange(S)
    n_blocks = S // Q_BLOCK

    def block(i):
        start = i * Q_BLOCK
        qb = lax.dynamic_slice_in_dim(qf, start, Q_BLOCK, axis=2)
        z = jnp.einsum('bhqd,bhkd->bhqk', qb, kf) * scale
        q_pos = start + jnp.arange(Q_BLOCK)
        mask = key_pos[None, :] < q_pos[:, None]
        log_keep = jnp.where(mask, jax.nn.log_sigmoid(-z), 0.0)
        later = lax.cumsum(log_keep, axis=3, reverse=True) - log_keep
        att = jnp.where(mask, jnp.exp(jax.nn.log_sigmoid(z) + later), 0.0)
        return jnp.einsum('bhqk,bhkd->bhqd', att, vf)

    out = lax.map(block, jnp.arange(n_blocks))
    out = out.transpose(1, 2, 0, 3, 4).reshape(B, H, S, hd)
    return out.astype(q.dtype)


def conformer_conv(u, conv_w, conv_b, ln_g, ln_b):
    a, gate = jnp.split(u, 2, axis=-1)
    h = a * jax.nn.sigmoid(gate)
    h = lax.conv_general_dilated(
        h, conv_w[:, None, :], window_strides=(1,),
        padding=[(CONV_KERNEL - 1, 0)],
        dimension_numbers=('NWC', 'WIO', 'NWC'),
        feature_group_count=CONV_WIDTH) + conv_b
    h = layer_norm(h, ln_g, ln_b)
    return jax.nn.silu(h)


def hybrid_mixer(x, norm_g, w_in, q_norm_g, k_norm_g, attn_out_g, conv_w, conv_b,
                 conv_ln_g, conv_ln_b, w_out):
    B, S, _ = x.shape
    xn = rms_norm(x, norm_g)
    proj = jnp.einsum('bsd,de->bse', xn, w_in)
    q, k, v, c = jnp.split(proj, [ATTN_WIDTH, 2 * ATTN_WIDTH, 3 * ATTN_WIDTH], axis=-1)
    q = rms_norm(q.reshape(B, S, ATTN_HEADS, HEAD_DIM), q_norm_g).transpose(0, 2, 1, 3)
    k = rms_norm(k.reshape(B, S, ATTN_HEADS, HEAD_DIM), k_norm_g).transpose(0, 2, 1, 3)
    v = v.reshape(B, S, ATTN_HEADS, HEAD_DIM).transpose(0, 2, 1, 3)
    o_attn = stick_breaking_attention(q, k, v).transpose(0, 2, 1, 3).reshape(B, S, ATTN_WIDTH)
    o_attn = rms_norm(o_attn, attn_out_g)
    o_conv = conformer_conv(c, conv_w, conv_b, conv_ln_g, conv_ln_b)
    mixed = jnp.concatenate([o_attn, o_conv], axis=-1)
    return x + jnp.einsum('bse,ed->bsd', mixed, w_out)


def peer_ffn(xn, wq, sub_k1, sub_k2, u_tab, v_tab):
    B, S, D = xn.shape
    xt = xn.reshape(-1, PEER_CHUNK, D)
    k1 = sub_k1.astype(jnp.float32)
    k2 = sub_k2.astype(jnp.float32)

    def chunk(xc):
        qh = jnp.einsum('cd,de->ce', xc, wq).reshape(-1, PEER_HEADS, PEER_KEY_DIM).astype(jnp.float32)
        s1 = jnp.einsum('chd,hnd->chn', qh[..., :PEER_HALF], k1)
        s2 = jnp.einsum('chd,hnd->chn', qh[..., PEER_HALF:], k2)
        v1, i1 = lax.top_k(s1, PEER_TOPK)
        v2, i2 = lax.top_k(s2, PEER_TOPK)
        cand = (v1[..., :, None] + v2[..., None, :]).reshape(-1, PEER_HEADS, PEER_TOPK * PEER_TOPK)
        cidx = (i1[..., :, None] * N_KEYS + i2[..., None, :]).reshape(-1, PEER_HEADS, PEER_TOPK * PEER_TOPK)
        top_s, pos = lax.top_k(cand, PEER_TOPK)
        experts = jnp.take_along_axis(cidx, pos, axis=-1)
        gates = jax.nn.softmax(top_s, axis=-1)
        u_sel = u_tab[experts]
        act = jax.nn.gelu(jnp.einsum('chkd,cd->chk', u_sel, xc).astype(jnp.float32), approximate=False)
        w = (gates * act).astype(xc.dtype)
        v_sel = v_tab[experts]
        return jnp.einsum('chk,chkd->cd', w, v_sel)

    y = lax.map(chunk, xt)
    return y.reshape(B, S, D)


def setup_inputs(seed: int = 0) -> dict:
    key = jax.random.key(seed)
    ks = jax.random.split(key, 16)
    f32 = jnp.float32
    n = lambda k, shape, s: (jax.random.normal(k, shape, f32) * s)
    gain = lambda k, shape: 1.0 + 0.01 * jax.random.normal(k, shape, f32)
    return {
        "x": jax.random.normal(ks[0], (BATCH, SEQ, D_MODEL), f32),
        "norm_mix_g": gain(ks[1], (DEPTH, D_MODEL)),
        "w_in": n(ks[2], (DEPTH, D_MODEL, IN_COLS), D_MODEL ** -0.5),
        "q_norm_g": gain(ks[3], (DEPTH, HEAD_DIM)),
        "k_norm_g": gain(ks[4], (DEPTH, HEAD_DIM)),
        "attn_out_g": gain(ks[5], (DEPTH, ATTN_WIDTH)),
        "conv_w": n(ks[6], (DEPTH, CONV_KERNEL, CONV_WIDTH), CONV_KERNEL ** -0.5),
        "conv_b": n(ks[7], (DEPTH, CONV_WIDTH), 0.01),
        "conv_ln_g": gain(ks[8], (DEPTH, CONV_WIDTH)),
        "conv_ln_b": n(ks[9], (DEPTH, CONV_WIDTH), 0.01),
        "w_out": n(ks[10], (DEPTH, MIX_WIDTH, D_MODEL), MIX_WIDTH ** -0.5),
        "norm_ffn_g": gain(ks[11], (DEPTH, D_MODEL)),
        "peer_wq": n(ks[12], (DEPTH, D_MODEL, PEER_HEADS * PEER_KEY_DIM), D_MODEL ** -0.5),
        "peer_k1": n(ks[13], (DEPTH, PEER_HEADS, N_KEYS, PEER_HALF), PEER_HALF ** -0.5),
        "peer_k2": n(ks[14], (DEPTH, PEER_HEADS, N_KEYS, PEER_HALF), PEER_HALF ** -0.5),
        "peer_u": n(jax.random.fold_in(ks[15], 0), (DEPTH, N_EXPERTS, D_MODEL), D_MODEL ** -0.5),
        "peer_v": n(jax.random.fold_in(ks[15], 1), (DEPTH, N_EXPERTS, D_MODEL), PEER_HEADS ** -0.5),
    }


def reference(x, norm_mix_g, w_in, q_norm_g, k_norm_g, attn_out_g, conv_w, conv_b,
              conv_ln_g, conv_ln_b, w_out, norm_ffn_g, peer_wq, peer_k1, peer_k2,
              peer_u, peer_v):
    h = x
    for l in range(DEPTH):
        h = hybrid_mixer(h, norm_mix_g[l], w_in[l], q_norm_g[l], k_norm_g[l], attn_out_g[l],
                         conv_w[l], conv_b[l], conv_ln_g[l], conv_ln_b[l], w_out[l])
        h = h + peer_ffn(rms_norm(h, norm_ffn_g[l]), peer_wq[l], peer_k1[l], peer_k2[l],
                         peer_u[l], peer_v[l])
    return h
```

```cpp
#include <hip/hip_runtime.h>
#include <hip/hip_cooperative_groups.h>
#include <cstdio>
namespace cg = cooperative_groups;

#ifndef FUSED
#define FUSED 0
#endif

typedef unsigned short bf16_t;
typedef __bf16 bf16x8 __attribute__((ext_vector_type(8)));
typedef __bf16 bf16x2 __attribute__((ext_vector_type(2)));
typedef float f32x4 __attribute__((ext_vector_type(4)));
typedef float f32x16 __attribute__((ext_vector_type(16)));
typedef unsigned u32x4 __attribute__((ext_vector_type(4)));
typedef unsigned u32x2 __attribute__((ext_vector_type(2)));

constexpr int SEQ = 4096, T = 8 * SEQ, D = 1024, NIN = 2560;
constexpr float EPS = 1e-6f;
constexpr float LOG2E = 1.4426950408889634f;

constexpr size_t MiB = 1u << 20;
constexpr size_t WS_WIN = 0, WS_WOUT = 5 * MiB, WS_WQ = 7 * MiB, WS_K1 = 9 * MiB, WS_K2 = 9 * MiB + 131072, WS_SSQ = 10 * MiB;
constexpr size_t WS_U16 = 12 * MiB, WS_V16 = 44 * MiB;
constexpr size_t WS_Q = 76 * MiB, WS_K = 108 * MiB, WS_VT = 140 * MiB, WS_HG = 172 * MiB, WS_MIX = 204 * MiB;
constexpr size_t WS_XN2 = 76 * MiB, WS_PIDX = 140 * MiB, WS_PG = 156 * MiB;
constexpr size_t WS_END = 268 * MiB;

struct Params {
  const float *x, *norm_mix_g, *w_in, *q_norm_g, *k_norm_g, *attn_out_g, *conv_w, *conv_b, *conv_ln_g, *conv_ln_b,
      *w_out, *norm_ffn_g, *peer_wq, *peer_k1, *peer_k2, *peer_u, *peer_v;
  float* out;
  unsigned char* ws;
};

constexpr int NTHREADS = 256;
constexpr int CPITCH = 132;
constexpr int LDS_RS = 67584, LDS_RS2 = LDS_RS + 512, LDS_BYTES = LDS_RS2 + 512;

__device__ __forceinline__ unsigned pk2(float lo, float hi) {
  bf16x2 v = {(__bf16)lo, (__bf16)hi};
  return __builtin_bit_cast(unsigned, v);
}
__device__ __forceinline__ float bflo(unsigned u) { return __uint_as_float(u << 16); }
__device__ __forceinline__ float bfhi(unsigned u) { return __uint_as_float(u & 0xffff0000u); }
__device__ __forceinline__ float dot2(unsigned a, unsigned b, float c) {
  return __builtin_amdgcn_fdot2_f32_bf16(__builtin_bit_cast(bf16x2, a), __builtin_bit_cast(bf16x2, b), c, false);
}
__device__ __forceinline__ int vblock() {
  const int G = gridDim.x, b = blockIdx.x;
  return (G % 8 == 0) ? (b % 8) * (G / 8) + b / 8 : b;
}
__device__ __forceinline__ f32x16 mfma32(bf16x8 a, bf16x8 b, f32x16 c) { return __builtin_amdgcn_mfma_f32_32x32x16_bf16(a, b, c, 0, 0, 0); }
__device__ __forceinline__ f32x4 mfma16(bf16x8 a, bf16x8 b, f32x4 c) { return __builtin_amdgcn_mfma_f32_16x16x32_bf16(a, b, c, 0, 0, 0); }

__device__ __forceinline__ void transpose_items(const float* __restrict__ W, int N, bf16_t* __restrict__ Wt, const float* __restrict__ g, int glimit,
                                                int mode, long gtid, long nthr) {
  const long nitems = (long)N * 128;
  for (long it = gtid; it < nitems; it += nthr) {
    const int n = (int)(it % N), kc = (int)(it / N);
    int src = n;
    if (mode == 1 && n >= 1536) {
      const int r = n - 1536, j = r >> 7, rr = r & 127;
      src = rr < 64 ? 1536 + 64 * j + rr : 2048 + 64 * j + (rr - 64);
    }
    float v[8];
#pragma unroll
    for (int i = 0; i < 8; ++i) {
      const int k = kc * 8 + i;
      float w = W[(size_t)k * N + src];
      if (k < glimit) w *= g[k];
      v[i] = w;
    }
    u32x4 o = {pk2(v[0], v[1]), pk2(v[2], v[3]), pk2(v[4], v[5]), pk2(v[6], v[7])};
    *(u32x4*)(Wt + (size_t)n * 1024 + kc * 8) = o;
  }
}
__device__ __forceinline__ void convert_items(const float* __restrict__ src, bf16_t* __restrict__ dst, long n8, long gtid, long nthr) {
  for (long it = gtid; it < n8; it += nthr) {
    const f32x4 a = *(const f32x4*)(src + it * 8), b = *(const f32x4*)(src + it * 8 + 4);
    u32x4 o = {pk2(a.x, a.y), pk2(a.z, a.w), pk2(b.x, b.y), pk2(b.z, b.w)};
    *(u32x4*)(dst + it * 8) = o;
  }
}
__device__ void phase_prep(const Params& p) {
  const long gtid = (long)vblock() * NTHREADS + threadIdx.x, nthr = (long)gridDim.x * NTHREADS;
  unsigned char* ws = p.ws;
  transpose_items(p.w_in, NIN, (bf16_t*)(ws + WS_WIN), p.norm_mix_g, 1024, 1, gtid, nthr);
  transpose_items(p.w_out, D, (bf16_t*)(ws + WS_WOUT), p.attn_out_g, 512, 0, gtid, nthr);
  transpose_items(p.peer_wq, D, (bf16_t*)(ws + WS_WQ), p.norm_ffn_g, 1024, 0, gtid, nthr);
  convert_items(p.peer_k1, (bf16_t*)(ws + WS_K1), 65536 / 8, gtid, nthr);
  convert_items(p.peer_k2, (bf16_t*)(ws + WS_K2), 65536 / 8, gtid, nthr);
  convert_items(p.peer_u, (bf16_t*)(ws + WS_U16), (long)16384 * 1024 / 8, gtid, nthr);
  convert_items(p.peer_v, (bf16_t*)(ws + WS_V16), (long)16384 * 1024 / 8, gtid, nthr);
}

template <bool AF32, bool MID>
__device__ __forceinline__ void gemm_mainloop(const float* __restrict__ Af, const bf16_t* __restrict__ Ab, const bf16_t* __restrict__ Bt,
                                              int m0, int n0, char* smem, f32x4 (&acc)[4][4]) {
  const int tid = threadIdx.x, lane = tid & 63, wave = tid >> 6, wm = wave >> 1, wn = wave & 1;
  const int lrow = tid >> 3, lchunk = tid & 7;
  const int woff = lrow * 128 + ((lchunk ^ ((lrow >> 1) & 7)) << 4);
  float ss[4] = {0.f, 0.f, 0.f, 0.f};
  f32x4 ra[4][2];
  u32x4 rab[4], rb[4];
#pragma unroll
  for (int i = 0; i < 4; ++i)
#pragma unroll
    for (int j = 0; j < 4; ++j) acc[i][j] = (f32x4){0.f, 0.f, 0.f, 0.f};

  const float* ap = Af + (size_t)(m0 + lrow) * 1024 + lchunk * 8;
  const bf16_t* abp = Ab + (size_t)(m0 + lrow) * 1024 + lchunk * 8;
  const bf16_t* bp = Bt + (size_t)(n0 + lrow) * 1024 + lchunk * 8;

#define G_LOAD(kt)                                                                    \
  {                                                                                   \
    _Pragma("unroll") for (int j = 0; j < 4; ++j) {                                   \
      if (AF32) {                                                                     \
        ra[j][0] = *(const f32x4*)(ap + (size_t)j * 32 * 1024 + (kt) * 64);           \
        ra[j][1] = *(const f32x4*)(ap + (size_t)j * 32 * 1024 + (kt) * 64 + 4);       \
      } else {                                                                        \
        rab[j] = *(const u32x4*)(abp + (size_t)j * 32 * 1024 + (kt) * 64);            \
      }                                                                               \
      rb[j] = *(const u32x4*)(bp + (size_t)j * 32 * 1024 + (kt) * 64);                \
    }                                                                                 \
  }
#define G_WRITE(stage)                                                                                   \
  {                                                                                                      \
    char* sa = smem + (stage) * 32768 + woff;                                                            \
    _Pragma("unroll") for (int j = 0; j < 4; ++j) {                                                      \
      u32x4 av;                                                                                          \
      if (AF32) {                                                                                        \
        const f32x4 a0 = ra[j][0], a1 = ra[j][1];                                                        \
        ss[j] += a0.x * a0.x + a0.y * a0.y + a0.z * a0.z + a0.w * a0.w + a1.x * a1.x + a1.y * a1.y +     \
                 a1.z * a1.z + a1.w * a1.w;                                                              \
        av = (u32x4){pk2(a0.x, a0.y), pk2(a0.z, a0.w), pk2(a1.x, a1.y), pk2(a1.z, a1.w)};                \
      } else {                                                                                           \
        av = rab[j];                                                                                     \
      }                                                                                                  \
      *(u32x4*)(sa + j * 4096) = av;                                                                     \
      *(u32x4*)(sa + 16384 + j * 4096) = rb[j];                                                          \
    }                                                                                                    \
  }

  G_LOAD(0);
  G_WRITE(0);
  __syncthreads();
  const int sw = (lane & 15) >> 1;
  const int arow = (wm * 64 + (lane & 15)) * 128, brow = (wn * 64 + (lane & 15)) * 128;
  const int kq = lane >> 4;
  for (int kt = 0; kt < 16; ++kt) {
    if (kt + 1 < 16) G_LOAD(kt + 1);
    if (MID && kt == 8) {
      const float* rs2 = (const float*)(smem + LDS_RS2);
#pragma unroll
      for (int i = 0; i < 4; ++i) {
        const f32x4 r = *(const f32x4*)(rs2 + wm * 64 + i * 16 + (lane >> 4) * 4);
#pragma unroll
        for (int j = 0; j < 4; ++j) acc[i][j] *= r;
      }
    }
    const char* sb = smem + (kt & 1) * 32768;
#pragma unroll
    for (int kk = 0; kk < 2; ++kk) {
      bf16x8 af[4], bfr[4];
      const int co = ((kk * 4 + kq) ^ sw) << 4;
#pragma unroll
      for (int i = 0; i < 4; ++i) af[i] = *(const bf16x8*)(sb + arow + i * 2048 + co);
#pragma unroll
      for (int j = 0; j < 4; ++j) bfr[j] = *(const bf16x8*)(sb + 16384 + brow + j * 2048 + co);
#pragma unroll
      for (int i = 0; i < 4; ++i)
#pragma unroll
        for (int j = 0; j < 4; ++j) acc[i][j] = mfma16(af[i], bfr[j], acc[i][j]);
    }
    if (kt + 1 < 16) G_WRITE((kt + 1) & 1);
    __syncthreads();
  }
#undef G_LOAD
#undef G_WRITE
  if (AF32) {
    float* rs = (float*)(smem + LDS_RS);
#pragma unroll
    for (int j = 0; j < 4; ++j) {
      float s = ss[j];
      s += __shfl_xor(s, 1);
      s += __shfl_xor(s, 2);
      s += __shfl_xor(s, 4);
      if (lchunk == 0) rs[lrow + 32 * j] = rsqrtf(s * (1.f / 1024.f) + EPS);
    }
  }
  float* Cs = (float*)smem;
#pragma unroll
  for (int i = 0; i < 4; ++i)
#pragma unroll
    for (int j = 0; j < 4; ++j)
#pragma unroll
      for (int r = 0; r < 4; ++r)
        Cs[(wm * 64 + i * 16 + (lane >> 4) * 4 + r) * CPITCH + wn * 64 + j * 16 + (lane & 15)] = acc[i][j][r];
  __syncthreads();
}

__device__ void phase_inproj(const Params& p, char* smem) {
  unsigned char* ws = p.ws;
  const bf16_t* Wt = (const bf16_t*)(ws + WS_WIN);
  bf16_t* Qo = (bf16_t*)(ws + WS_Q);
  bf16_t* Ko = (bf16_t*)(ws + WS_K);
  bf16_t* Vt = (bf16_t*)(ws + WS_VT);
  bf16_t* HG = (bf16_t*)(ws + WS_HG);
  const int tid = threadIdx.x;
  const int ntiles = 256 * 20, per = (ntiles + gridDim.x - 1) / gridDim.x;
  const int vb = vblock();
  const float* Cs = (const float*)smem;
  const float* rs = (const float*)(smem + LDS_RS);
  for (int tile = vb * per; tile < min((vb + 1) * per, ntiles); ++tile) {
    const int mt = tile / 20, nt = tile % 20, m0 = mt * 128;
    f32x4 acc[4][4];
    gemm_mainloop<true, false>(p.x, nullptr, Wt, m0, nt * 128, smem, acc);
    if (nt < 8) {
      const int tok = tid & 127, hh = tid >> 7, t = m0 + tok, b = t >> 12, s = t & 4095;
      const int head = (nt & 3) * 2 + hh;
      const float* row = Cs + tok * CPITCH + hh * 64;
      f32x4 v[16];
      float ssq = 0.f;
#pragma unroll
      for (int i = 0; i < 16; ++i) {
        v[i] = *(const f32x4*)(row + i * 4);
        ssq += v[i].x * v[i].x + v[i].y * v[i].y + v[i].z * v[i].z + v[i].w * v[i].w;
      }
      const float r = rs[tok];
      float sc = r * rsqrtf(r * r * ssq * (1.f / 64.f) + EPS);
      const float* g = (nt < 4) ? p.q_norm_g : p.k_norm_g;
      if (nt < 4) sc *= 0.125f * LOG2E;
      bf16_t* dst = ((nt < 4) ? Qo : Ko) + ((size_t)(b * 8 + head) * 4096 + s) * 64;
#pragma unroll
      for (int i = 0; i < 8; ++i) {
        const f32x4 g0 = *(const f32x4*)(g + i * 8), g1 = *(const f32x4*)(g + i * 8 + 4);
        const f32x4 a = v[2 * i], c = v[2 * i + 1];
        u32x4 o = {pk2(a.x * sc * g0.x, a.y * sc * g0.y), pk2(a.z * sc * g0.z, a.w * sc * g0.w),
                   pk2(c.x * sc * g1.x, c.y * sc * g1.y), pk2(c.z * sc * g1.z, c.w * sc * g1.w)};
        *(u32x4*)(dst + i * 8) = o;
      }
    } else if (nt < 12) {
#pragma unroll
      for (int it = 0; it < 2; ++it) {
        const int item = tid + 256 * it, d = item & 63, kb = (item >> 6) & 3, hh = item >> 8;
        const int head = (nt - 8) * 2 + hh, t0 = m0 + kb * 32, b = t0 >> 12, kblk = (t0 & 4095) >> 5;
        unsigned o[16];
#pragma unroll
        for (int pp = 0; pp < 16; ++pp) {
          float val[2];
#pragma unroll
          for (int e = 0; e < 2; ++e) {
            const int pos = pp * 2 + e, sI = pos >> 4, h = (pos >> 3) & 1, j = pos & 7;
            const int key = 16 * sI + 8 * (j >> 2) + 4 * h + (j & 3);
            val[e] = Cs[(kb * 32 + key) * CPITCH + hh * 64 + d] * rs[kb * 32 + key];
          }
          o[pp] = pk2(val[0], val[1]);
        }
        bf16_t* dst = Vt + ((((size_t)(b * 8 + head) * 128 + kblk) * 64 + d) * 32);
#pragma unroll
        for (int q = 0; q < 4; ++q) *(u32x4*)(dst + q * 8) = (u32x4){o[4 * q], o[4 * q + 1], o[4 * q + 2], o[4 * q + 3]};
      }
    } else {
      const int jc = nt - 12;
#pragma unroll
      for (int it = 0; it < 4; ++it) {
        const int item = tid + 256 * it, c8 = item & 7, tok = item >> 3;
        const float* row = Cs + tok * CPITCH + c8 * 8;
        const float r = rs[tok];
        const f32x4 a0 = *(const f32x4*)(row), a1 = *(const f32x4*)(row + 4), g0 = *(const f32x4*)(row + 64), g1 = *(const f32x4*)(row + 68);
        float h[8];
#define GLU(a, g) ((a) * r / (1.f + __expf(-(g) * r)))
        h[0] = GLU(a0.x, g0.x); h[1] = GLU(a0.y, g0.y); h[2] = GLU(a0.z, g0.z); h[3] = GLU(a0.w, g0.w);
        h[4] = GLU(a1.x, g1.x); h[5] = GLU(a1.y, g1.y); h[6] = GLU(a1.z, g1.z); h[7] = GLU(a1.w, g1.w);
#undef GLU
        *(u32x4*)(HG + (size_t)(m0 + tok) * 512 + jc * 64 + c8 * 8) = (u32x4){pk2(h[0], h[1]), pk2(h[2], h[3]), pk2(h[4], h[5]), pk2(h[6], h[7])};
      }
    }
    __syncthreads();
  }
}

__device__ void conv_item(const Params& p, int item, char* smem) {
  unsigned char* ws = p.ws;
  const bf16_t* HG = (const bf16_t*)(ws + WS_HG);
  bf16_t* MIX = (bf16_t*)(ws + WS_MIX);
  const int tid = threadIdx.x, lane = tid & 63, wave = tid >> 6;
  const int t0 = item * 32, s0 = t0 & 4095;
  for (int idx = tid; idx < 62 * 64; idx += 256) {
    const int r = idx >> 6, c16 = idx & 63;
    u32x4 v = {0u, 0u, 0u, 0u};
    if (s0 - 30 + r >= 0) v = *(const u32x4*)(HG + (size_t)(t0 - 30 + r) * 512 + c16 * 8);
    *(u32x4*)(smem + r * 1024 + c16 * 16) = v;
  }
  float w0[31], w1[31];
#pragma unroll
  for (int j = 0; j < 31; ++j) {
    const float2 w = *(const float2*)(p.conv_w + j * 512 + 2 * tid);
    w0[j] = w.x;
    w1[j] = w.y;
  }
  const float2 cb = *(const float2*)(p.conv_b + 2 * tid);
  const float2 lg = *(const float2*)(p.conv_ln_g + 2 * tid);
  const float2 lb = *(const float2*)(p.conv_ln_b + 2 * tid);
  float* red = (float*)(smem + 62 * 1024);
  __syncthreads();
  for (int tt = 0; tt < 32; ++tt) {
    float a0 = cb.x, a1 = cb.y;
#pragma unroll
    for (int j = 0; j < 31; ++j) {
      const unsigned v = *(const unsigned*)(smem + (tt + j) * 1024 + tid * 4);
      a0 += w0[j] * bflo(v);
      a1 += w1[j] * bfhi(v);
    }
    float s1 = a0 + a1, s2 = a0 * a0 + a1 * a1;
#pragma unroll
    for (int o = 1; o < 64; o <<= 1) {
      s1 += __shfl_xor(s1, o);
      s2 += __shfl_xor(s2, o);
    }
    float* rr = red + (tt & 1) * 8;
    if (lane == 0) {
      rr[wave * 2] = s1;
      rr[wave * 2 + 1] = s2;
    }
    __syncthreads();
    const float S1 = rr[0] + rr[2] + rr[4] + rr[6], S2 = rr[1] + rr[3] + rr[5] + rr[7];
    const float mu = S1 * (1.f / 512.f);
    const float var = fmaxf(S2 * (1.f / 512.f) - mu * mu, 0.f);
    const float rstd = rsqrtf(var + EPS);
    const float y0 = (a0 - mu) * rstd * lg.x + lb.x, y1 = (a1 - mu) * rstd * lg.y + lb.y;
    const float z0 = y0 / (1.f + __expf(-y0)), z1 = y1 / (1.f + __expf(-y1));
    *(unsigned*)(MIX + (size_t)(t0 + tt) * 1024 + 512 + 2 * tid) = pk2(z0, z1);
  }
  __syncthreads();
}

__device__ void attn_item(const Params& p, int item, int lane) {
  unsigned char* ws = p.ws;
  const bf16_t* Qm = (const bf16_t*)(ws + WS_Q);
  const bf16_t* Km = (const bf16_t*)(ws + WS_K);
  const bf16_t* Vt = (const bf16_t*)(ws + WS_VT);
  bf16_t* MIX = (bf16_t*)(ws + WS_MIX);
  float* SSQ = (float*)(ws + WS_SSQ);
  const int qt = item & 127, bh = item >> 7;
  const int tok = lane & 31, hf = lane >> 5;
  bf16x8 qf[4];
  {
    const bf16_t* qp = Qm + ((size_t)bh * 4096 + qt * 32 + tok) * 64 + 8 * hf;
#pragma unroll
    for (int ks = 0; ks < 4; ++ks) qf[ks] = *(const bf16x8*)(qp + ks * 16);
  }
  f32x16 o0, o1;
#pragma unroll
  for (int i = 0; i < 16; ++i) { o0[i] = 0.f; o1[i] = 0.f; }
  float c = 0.f;
  for (int kb = qt; kb >= 0; --kb) {
    const bf16_t* kp = Km + ((size_t)bh * 4096 + kb * 32 + tok) * 64 + 8 * hf;
    bf16x8 kf[4];
#pragma unroll
    for (int ks = 0; ks < 4; ++ks) kf[ks] = *(const bf16x8*)(kp + ks * 16);
    const bf16_t* vp = Vt + (((size_t)bh * 128 + kb) * 64 + tok) * 32 + hf * 8;
    bf16x8 vf[2][2];
#pragma unroll
    for (int m = 0; m < 2; ++m)
#pragma unroll
      for (int s = 0; s < 2; ++s) vf[m][s] = *(const bf16x8*)(vp + m * 1024 + s * 16);
    f32x16 sc;
#pragma unroll
    for (int i = 0; i < 16; ++i) sc[i] = 0.f;
#pragma unroll
    for (int ks = 0; ks < 4; ++ks) sc = mfma32(kf[ks], qf[ks], sc);
    const bool diag = (kb == qt);
    float lk[16], zs[16];
#pragma unroll
    for (int i = 0; i < 16; ++i) {
      const float zl = sc[i];
      const float e = __builtin_amdgcn_exp2f(zl);
      const float sp = __builtin_amdgcn_logf(1.f + e);
      const bool valid = !diag || ((i & 3) + 8 * (i >> 2) + 4 * hf < tok);
      lk[i] = valid ? -sp : 0.f;
      zs[i] = valid ? zl - sp : -1e30f;
    }
    float Tg[4], Pg[4];
#pragma unroll
    for (int g = 0; g < 4; ++g) {
      Tg[g] = (lk[4 * g] + lk[4 * g + 1]) + (lk[4 * g + 2] + lk[4 * g + 3]);
      Pg[g] = __shfl_xor(Tg[g], 32);
    }
    float base[4];
    float run = 0.f;
#pragma unroll
    for (int g = 3; g >= 0; --g) {
      base[g] = c + run + (hf == 0 ? Pg[g] : 0.f);
      run += Tg[g] + Pg[g];
    }
    float pr[16];
#pragma unroll
    for (int g = 0; g < 4; ++g) {
      float l = base[g];
#pragma unroll
      for (int r = 3; r >= 0; --r) {
        pr[4 * g + r] = __builtin_amdgcn_exp2f(zs[4 * g + r] + l);
        l += lk[4 * g + r];
      }
    }
    c += run;
    bf16x8 pf[2];
#pragma unroll
    for (int s = 0; s < 2; ++s)
#pragma unroll
      for (int j = 0; j < 8; ++j) pf[s][j] = (__bf16)pr[8 * s + j];
#pragma unroll
    for (int s = 0; s < 2; ++s) {
      o0 = mfma32(vf[0][s], pf[s], o0);
      o1 = mfma32(vf[1][s], pf[s], o1);
    }
    if (__all(c < -150.f)) break;
  }
  const int t = (bh >> 3) * 4096 + qt * 32 + tok, hh = bh & 7;
  float ssq = 0.f;
#pragma unroll
  for (int i = 0; i < 16; ++i) ssq += o0[i] * o0[i] + o1[i] * o1[i];
  ssq += __shfl_xor(ssq, 32);
  if (hf == 0) SSQ[t * 8 + hh] = ssq;
  bf16_t* dst = MIX + (size_t)t * 1024 + hh * 64 + 4 * hf;
#pragma unroll
  for (int g = 0; g < 4; ++g) {
    *(u32x2*)(dst + 8 * g) = (u32x2){pk2(o0[4 * g], o0[4 * g + 1]), pk2(o0[4 * g + 2], o0[4 * g + 3])};
    *(u32x2*)(dst + 32 + 8 * g) = (u32x2){pk2(o1[4 * g], o1[4 * g + 1]), pk2(o1[4 * g + 2], o1[4 * g + 3])};
  }
}

__device__ void phase_mix(const Params& p, char* smem) {
  const int vb = vblock(), G = gridDim.x;
  for (int item = vb; item < 1024; item += G) conv_item(p, item, smem);
  const int lane = threadIdx.x & 63, gw = vb * 4 + (threadIdx.x >> 6), nw = G * 4;
  for (int item = gw; item < 8192; item += nw) attn_item(p, item, lane);
}

__device__ void phase_outproj(const Params& p, char* smem) {
  unsigned char* ws = p.ws;
  const bf16_t* MIX = (const bf16_t*)(ws + WS_MIX);
  const bf16_t* Wt = (const bf16_t*)(ws + WS_WOUT);
  const float* SSQ = (const float*)(ws + WS_SSQ);
  const int tid = threadIdx.x;
  const int ntiles = 256 * 8, per = (ntiles + gridDim.x - 1) / gridDim.x;
  const int vb = vblock();
  const float* Cs = (const float*)smem;
  for (int tile = vb * per; tile < min((vb + 1) * per, ntiles); ++tile) {
    const int mt = tile >> 3, nt = tile & 7, m0 = mt * 128, n0 = nt * 128;
    if (tid < 128) {
      const f32x4 a = *(const f32x4*)(SSQ + (size_t)(m0 + tid) * 8), b = *(const f32x4*)(SSQ + (size_t)(m0 + tid) * 8 + 4);
      const float s = (a.x + a.y) + (a.z + a.w) + (b.x + b.y) + (b.z + b.w);
      ((float*)(smem + LDS_RS2))[tid] = rsqrtf(s * (1.f / 512.f) + EPS);
    }
    f32x4 acc[4][4];
    gemm_mainloop<false, true>(nullptr, MIX, Wt, m0, n0, smem, acc);
#pragma unroll
    for (int it = 0; it < 16; ++it) {
      const int item = tid + 256 * it, c4 = item & 31, tok = item >> 5;
      const f32x4 v = *(const f32x4*)(Cs + tok * CPITCH + c4 * 4);
      const size_t o = (size_t)(m0 + tok) * 1024 + n0 + c4 * 4;
      const f32x4 xr = *(const f32x4*)(p.x + o);
      *(f32x4*)(p.out + o) = xr + v;
    }
    __syncthreads();
  }
}

__device__ __forceinline__ unsigned f2key(float f, unsigned n) {
  const unsigned u = (__float_as_uint(f) & ~0x7Fu) | n;
  return u ^ ((unsigned)((int)u >> 31) | 0x80000000u);
}
__device__ __forceinline__ unsigned f2key_raw(float f) {
  const unsigned u = __float_as_uint(f);
  return u ^ ((unsigned)((int)u >> 31) | 0x80000000u);
}
__device__ __forceinline__ unsigned key2u(unsigned k) { return k ^ ((k >> 31) ? 0x80000000u : 0xFFFFFFFFu); }

template <int N>
__device__ __forceinline__ void bitonic_sort_desc(unsigned (&v)[N]) {
#pragma unroll
  for (int k = 2; k <= N; k <<= 1) {
#pragma unroll
    for (int j = k >> 1; j > 0; j >>= 1) {
#pragma unroll
      for (int i = 0; i < N; ++i) {
        const int l = i ^ j;
        if (l > i) {
          const bool desc = ((i & k) == 0);
          const unsigned mx = max(v[i], v[l]), mn = min(v[i], v[l]);
          v[i] = desc ? mx : mn;
          v[l] = desc ? mn : mx;
        }
      }
    }
  }
}
template <int N>
__device__ __forceinline__ void bitonic_merge_desc(unsigned (&v)[N]) {
#pragma unroll
  for (int j = N >> 1; j > 0; j >>= 1) {
#pragma unroll
    for (int i = 0; i < N; ++i) {
      const int l = i ^ j;
      if (l > i) {
        const unsigned mx = max(v[i], v[l]), mn = min(v[i], v[l]);
        v[i] = mx;
        v[l] = mn;
      }
    }
  }
}
__device__ __forceinline__ void merge_top16(unsigned (&a)[16], const unsigned (&b)[16]) {
#pragma unroll
  for (int i = 0; i < 16; ++i) a[i] = max(a[i], b[15 - i]);
  bitonic_merge_desc<16>(a);
}
#define CEP(ka, pa, kb, pb, desc)                                  \
  {                                                                \
    const bool sw_ = (desc) ? ((kb) > (ka)) : ((kb) < (ka));       \
    const unsigned tk_ = sw_ ? (kb) : (ka), tl_ = sw_ ? (ka) : (kb); \
    const unsigned tp_ = sw_ ? (pb) : (pa), tq_ = sw_ ? (pa) : (pb); \
    ka = tk_; kb = tl_; pa = tp_; pb = tq_;                        \
  }
template <int N>
__device__ __forceinline__ void bitonic_sort_desc_p(unsigned (&v)[N], unsigned (&pl)[N]) {
#pragma unroll
  for (int k = 2; k <= N; k <<= 1) {
#pragma unroll
    for (int j = k >> 1; j > 0; j >>= 1) {
#pragma unroll
      for (int i = 0; i < N; ++i) {
        const int l = i ^ j;
        if (l > i) {
          const bool desc = ((i & k) == 0);
          CEP(v[i], pl[i], v[l], pl[l], desc);
        }
      }
    }
  }
}
template <int N>
__device__ __forceinline__ void bitonic_merge_desc_p(unsigned (&v)[N], unsigned (&pl)[N]) {
#pragma unroll
  for (int j = N >> 1; j > 0; j >>= 1) {
#pragma unroll
    for (int i = 0; i < N; ++i) {
      const int l = i ^ j;
      if (l > i) { CEP(v[i], pl[i], v[l], pl[l], true); }
    }
  }
}
__device__ __forceinline__ void merge_top16_p(unsigned (&a)[16], unsigned (&pa)[16], const unsigned (&b)[16], const unsigned (&pb)[16]) {
#pragma unroll
  for (int i = 0; i < 16; ++i) {
    const bool s = b[15 - i] > a[i];
    a[i] = s ? b[15 - i] : a[i];
    pa[i] = s ? pb[15 - i] : pa[i];
  }
  bitonic_merge_desc_p<16>(a, pa);
}

__device__ __forceinline__ void subkey_top16(const bf16_t* __restrict__ Kb, const float* crow, float rsv, int lane, unsigned (&top)[16]) {
  const int tok = lane & 31, hf = lane >> 5;
  f32x16 acc[4];
#pragma unroll
  for (int m = 0; m < 4; ++m)
#pragma unroll
    for (int i = 0; i < 16; ++i) acc[m][i] = 0.f;
#pragma unroll
  for (int ks = 0; ks < 4; ++ks) {
    const f32x4 v0 = *(const f32x4*)(crow + ks * 16 + 8 * hf), v1 = *(const f32x4*)(crow + ks * 16 + 8 * hf + 4);
    bf16x8 bq;
    bq[0] = (__bf16)(v0.x * rsv); bq[1] = (__bf16)(v0.y * rsv); bq[2] = (__bf16)(v0.z * rsv); bq[3] = (__bf16)(v0.w * rsv);
    bq[4] = (__bf16)(v1.x * rsv); bq[5] = (__bf16)(v1.y * rsv); bq[6] = (__bf16)(v1.z * rsv); bq[7] = (__bf16)(v1.w * rsv);
#pragma unroll
    for (int m = 0; m < 4; ++m) {
      const bf16x8 ak = *(const bf16x8*)(Kb + (m * 32 + tok) * 64 + ks * 16 + 8 * hf);
      acc[m] = mfma32(ak, bq, acc[m]);
    }
  }
  unsigned g[4][16];
#pragma unroll
  for (int m = 0; m < 4; ++m) {
#pragma unroll
    for (int i = 0; i < 16; ++i) g[m][i] = f2key(acc[m][i], (unsigned)(m * 32 + (i & 3) + 8 * (i >> 2) + 4 * hf));
    bitonic_sort_desc<16>(g[m]);
  }
  merge_top16(g[0], g[1]);
  merge_top16(g[2], g[3]);
  merge_top16(g[0], g[2]);
  unsigned o[16];
#pragma unroll
  for (int i = 0; i < 16; ++i) o[i] = __shfl_xor(g[0][i], 32);
  merge_top16(g[0], o);
#pragma unroll
  for (int i = 0; i < 16; ++i) top[i] = g[0][i];
}

__device__ void phase_route(const Params& p, char* smem) {
  unsigned char* ws = p.ws;
  const bf16_t* Wt = (const bf16_t*)(ws + WS_WQ);
  const bf16_t* K1 = (const bf16_t*)(ws + WS_K1);
  const bf16_t* K2 = (const bf16_t*)(ws + WS_K2);
  bf16_t* XN2 = (bf16_t*)(ws + WS_XN2);
  unsigned* PIDX = (unsigned*)(ws + WS_PIDX);
  float* PG = (float*)(ws + WS_PG);
  const int tid = threadIdx.x, lane = tid & 63, wave = tid >> 6;
  const int ntiles = 256 * 8, per = (ntiles + gridDim.x - 1) / gridDim.x;
  const int vb = vblock();
  const float* Cs = (const float*)smem;
  const float* rs = (const float*)(smem + LDS_RS);
  for (int tile = vb * per; tile < min((vb + 1) * per, ntiles); ++tile) {
    const int mt = tile >> 3, hd = tile & 7, m0 = mt * 128;
    f32x4 acc[4][4];
    gemm_mainloop<true, false>(p.out, nullptr, Wt, m0, hd * 128, smem, acc);
    if (hd == 0) {
#pragma unroll 4
      for (int it = 0; it < 64; ++it) {
        const int item = tid + 256 * it, c8 = item & 127, tok = item >> 7;
        const float* src = p.out + (size_t)(m0 + tok) * 1024 + c8 * 8;
        const f32x4 a = *(const f32x4*)src, b = *(const f32x4*)(src + 4);
        const f32x4 g0 = *(const f32x4*)(p.norm_ffn_g + c8 * 8), g1 = *(const f32x4*)(p.norm_ffn_g + c8 * 8 + 4);
        const float r = rs[tok];
        *(u32x4*)(XN2 + (size_t)(m0 + tok) * 1024 + c8 * 8) =
            (u32x4){pk2(a.x * r * g0.x, a.y * r * g0.y), pk2(a.z * r * g0.z, a.w * r * g0.w), pk2(b.x * r * g1.x, b.y * r * g1.y), pk2(b.z * r * g1.z, b.w * r * g1.w)};
      }
    }
    const int tok = lane & 31, hf = lane >> 5, trow = wave * 32 + tok;
    const float rsv = rs[trow];
    unsigned top1[16], top2[16];
    subkey_top16(K1 + hd * 8192, Cs + trow * CPITCH, rsv, lane, top1);
    subkey_top16(K2 + hd * 8192, Cs + trow * CPITCH + 64, rsv, lane, top2);
    float fa[16], fb[16];
    unsigned ia[16], ib[16];
#pragma unroll
    for (int i = 0; i < 16; ++i) {
      const unsigned ua = key2u(hf ? top2[i] : top1[i]), ub = key2u(hf ? top1[i] : top2[i]);
      fa[i] = __uint_as_float(ua); ia[i] = ua & 0x7Fu;
      fb[i] = __uint_as_float(ub); ib[i] = ub & 0x7Fu;
    }
    unsigned ck[32], cp[32];
    {
      int n = 0;
#pragma unroll
      for (int i = 0; i < 4; ++i) {
#pragma unroll
        for (int j = i; j < 16; ++j) {
          if ((i + 1) * (j + 1) <= 16) {
            unsigned key = f2key_raw(fa[i] + fb[j]);
            if (i == j && hf) key = 0u;
            ck[n] = key;
            cp[n] = hf ? ((ib[j] << 7) | ia[i]) : ((ia[i] << 7) | ib[j]);
            ++n;
          }
        }
      }
#pragma unroll
      for (; n < 32; ++n) { ck[n] = 0u; cp[n] = 0u; }
    }
    unsigned k0[16], p0[16], k1[16], p1[16];
#pragma unroll
    for (int i = 0; i < 16; ++i) { k0[i] = ck[i]; p0[i] = cp[i]; k1[i] = ck[16 + i]; p1[i] = cp[16 + i]; }
    bitonic_sort_desc_p<16>(k0, p0);
    bitonic_sort_desc_p<16>(k1, p1);
    merge_top16_p(k0, p0, k1, p1);
#pragma unroll
    for (int i = 0; i < 16; ++i) { k1[i] = __shfl_xor(k0[i], 32); p1[i] = __shfl_xor(p0[i], 32); }
    merge_top16_p(k0, p0, k1, p1);
    float sv[16], sum = 0.f;
    const float mx = __uint_as_float(key2u(k0[0]));
#pragma unroll
    for (int i = 0; i < 16; ++i) {
      sv[i] = __builtin_amdgcn_exp2f((__uint_as_float(key2u(k0[i])) - mx) * LOG2E);
      sum += sv[i];
    }
    const float inv = 1.f / sum;
    const size_t po = ((size_t)(m0 + trow) * 8 + hd) * 16;
    if (hf == 0) {
#pragma unroll
      for (int q = 0; q < 4; ++q) *(u32x4*)(PIDX + po + 4 * q) = (u32x4){p0[4 * q], p0[4 * q + 1], p0[4 * q + 2], p0[4 * q + 3]};
    } else {
#pragma unroll
      for (int q = 0; q < 4; ++q) *(f32x4*)(PG + po + 4 * q) = (f32x4){sv[4 * q] * inv, sv[4 * q + 1] * inv, sv[4 * q + 2] * inv, sv[4 * q + 3] * inv};
    }
    __syncthreads();
  }
}

__device__ void phase_peer_u(const Params& p) {
  unsigned char* ws = p.ws;
  const bf16_t* U16 = (const bf16_t*)(ws + WS_U16);
  const bf16_t* XN2 = (const bf16_t*)(ws + WS_XN2);
  const unsigned* PIDX = (const unsigned*)(ws + WS_PIDX);
  float* PG = (float*)(ws + WS_PG);
  const int lane = threadIdx.x & 63, q = lane >> 4, c = lane & 15;
  const int gw = vblock() * 4 + (threadIdx.x >> 6), nw = gridDim.x * 4;
  for (int t = gw; t < T; t += nw) {
    u32x4 xr[8];
#pragma unroll
    for (int i = 0; i < 8; ++i) xr[i] = *(const u32x4*)(XN2 + (size_t)t * 1024 + (c + 16 * i) * 8);
#pragma unroll 2
    for (int sg = 0; sg < 32; ++sg) {
      const int slot = sg * 4 + q;
      const unsigned e = PIDX[(size_t)t * 128 + slot];
      const bf16_t* row = U16 + (size_t)e * 1024 + c * 8;
      u32x4 u[8];
#pragma unroll
      for (int i = 0; i < 8; ++i) u[i] = *(const u32x4*)(row + i * 128);
      float d0 = 0.f, d1 = 0.f;
#pragma unroll
      for (int i = 0; i < 8; ++i) {
        d0 = dot2(u[i].x, xr[i].x, d0);
        d1 = dot2(u[i].y, xr[i].y, d1);
        d0 = dot2(u[i].z, xr[i].z, d0);
        d1 = dot2(u[i].w, xr[i].w, d1);
      }
      float d = d0 + d1;
      d += __shfl_xor(d, 1);
      d += __shfl_xor(d, 2);
      d += __shfl_xor(d, 4);
      d += __shfl_xor(d, 8);
      if (c == 0) {
        const float g = PG[(size_t)t * 128 + slot];
        PG[(size_t)t * 128 + slot] = g * 0.5f * d * (1.f + erff(d * 0.70710678118654752f));
      }
    }
  }
}

__device__ void phase_peer_v(const Params& p) {
  unsigned char* ws = p.ws;
  const bf16_t* V16 = (const bf16_t*)(ws + WS_V16);
  const unsigned* PIDX = (const unsigned*)(ws + WS_PIDX);
  const float* PG = (const float*)(ws + WS_PG);
  const int lane = threadIdx.x & 63;
  const int gw = vblock() * 4 + (threadIdx.x >> 6), nw = gridDim.x * 4;
  for (int t = gw; t < T; t += nw) {
    const unsigned e0 = PIDX[(size_t)t * 128 + lane], e1 = PIDX[(size_t)t * 128 + 64 + lane];
    const float w0 = PG[(size_t)t * 128 + lane], w1 = PG[(size_t)t * 128 + 64 + lane];
    float acc[16];
#pragma unroll
    for (int i = 0; i < 16; ++i) acc[i] = 0.f;
#pragma unroll
    for (int half = 0; half < 2; ++half) {
      const unsigned ev = half ? e1 : e0;
      const float wv = half ? w1 : w0;
#pragma unroll 8
      for (int s = 0; s < 64; ++s) {
        const unsigned e = __shfl(ev, s);
        const float w = __shfl(wv, s);
        const bf16_t* row = V16 + (size_t)e * 1024 + lane * 8;
        const u32x4 a = *(const u32x4*)row, b = *(const u32x4*)(row + 512);
        acc[0] += w * bflo(a.x); acc[1] += w * bfhi(a.x); acc[2] += w * bflo(a.y); acc[3] += w * bfhi(a.y);
        acc[4] += w * bflo(a.z); acc[5] += w * bfhi(a.z); acc[6] += w * bflo(a.w); acc[7] += w * bfhi(a.w);
        acc[8] += w * bflo(b.x); acc[9] += w * bfhi(b.x); acc[10] += w * bflo(b.y); acc[11] += w * bfhi(b.y);
        acc[12] += w * bflo(b.z); acc[13] += w * bfhi(b.z); acc[14] += w * bflo(b.w); acc[15] += w * bfhi(b.w);
      }
    }
    float* o = p.out + (size_t)t * 1024 + lane * 8;
    f32x4 h0 = *(f32x4*)o, h1 = *(f32x4*)(o + 4), h2 = *(f32x4*)(o + 512), h3 = *(f32x4*)(o + 516);
    h0 += (f32x4){acc[0], acc[1], acc[2], acc[3]};
    h1 += (f32x4){acc[4], acc[5], acc[6], acc[7]};
    h2 += (f32x4){acc[8], acc[9], acc[10], acc[11]};
    h3 += (f32x4){acc[12], acc[13], acc[14], acc[15]};
    *(f32x4*)o = h0; *(f32x4*)(o + 4) = h1; *(f32x4*)(o + 512) = h2; *(f32x4*)(o + 516) = h3;
  }
}

template <int PHASE>
__global__ void __launch_bounds__(NTHREADS, 2) k_phase(Params p) {
  __shared__ __attribute__((aligned(16))) char smem[LDS_BYTES];
  if (PHASE == 0) phase_prep(p);
  if (PHASE == 1) phase_inproj(p, smem);
  if (PHASE == 2) phase_mix(p, smem);
  if (PHASE == 3) phase_outproj(p, smem);
  if (PHASE == 4) phase_route(p, smem);
  if (PHASE == 5) phase_peer_u(p);
  if (PHASE == 6) phase_peer_v(p);
}

__global__ void __launch_bounds__(NTHREADS, 2) k_fused(Params p) {
  __shared__ __attribute__((aligned(16))) char smem[LDS_BYTES];
  cg::grid_group grid = cg::this_grid();
  phase_prep(p);
  grid.sync();
  phase_inproj(p, smem);
  grid.sync();
  phase_mix(p, smem);
  grid.sync();
  phase_outproj(p, smem);
  grid.sync();
  phase_route(p, smem);
  grid.sync();
  phase_peer_u(p);
  grid.sync();
  phase_peer_v(p);
}

extern "C" void kernel_launch(void* const* d_in, const int* in_sizes, int n_in, void* d_out, int out_size, void* d_ws, size_t ws_size,
                              hipStream_t stream) {
  if (n_in != 17 || ws_size < WS_END) {
    fprintf(stderr, "kernel_launch: unexpected n_in %d / ws_size %zu\n", n_in, ws_size);
    return;
  }
  Params p{};
  p.x = (const float*)d_in[0]; p.norm_mix_g = (const float*)d_in[1]; p.w_in = (const float*)d_in[2]; p.q_norm_g = (const float*)d_in[3];
  p.k_norm_g = (const float*)d_in[4]; p.attn_out_g = (const float*)d_in[5]; p.conv_w = (const float*)d_in[6]; p.conv_b = (const float*)d_in[7];
  p.conv_ln_g = (const float*)d_in[8]; p.conv_ln_b = (const float*)d_in[9]; p.w_out = (const float*)d_in[10]; p.norm_ffn_g = (const float*)d_in[11];
  p.peer_wq = (const float*)d_in[12]; p.peer_k1 = (const float*)d_in[13]; p.peer_k2 = (const float*)d_in[14]; p.peer_u = (const float*)d_in[15];
  p.peer_v = (const float*)d_in[16];
  p.out = (float*)d_out;
  p.ws = (unsigned char*)d_ws;
#if FUSED
  static int grid_blocks = 0;
  if (!grid_blocks) {
    int dev = 0, cus = 0, per_cu = 0;
    hipGetDevice(&dev);
    hipDeviceGetAttribute(&cus, hipDeviceAttributeMultiprocessorCount, dev);
    hipOccupancyMaxActiveBlocksPerMultiprocessor(&per_cu, k_fused, NTHREADS, 0);
    if (per_cu > 2) per_cu = 2;
    if (per_cu < 1) per_cu = 1;
    grid_blocks = cus * per_cu;
  }
  void* args[] = {&p};
  hipError_t e = hipLaunchCooperativeKernel((void*)k_fused, dim3(grid_blocks), dim3(NTHREADS), args, 0, stream);
  if (e != hipSuccess) fprintf(stderr, "cooperative launch failed: %s (grid %d)\n", hipGetErrorString(e), grid_blocks);
#else
  const int G = 512;
  k_phase<0><<<G, NTHREADS, 0, stream>>>(p);
  k_phase<1><<<G, NTHREADS, 0, stream>>>(p);
  k_phase<2><<<G, NTHREADS, 0, stream>>>(p);
  k_phase<3><<<G, NTHREADS, 0, stream>>>(p);
  k_phase<4><<<G, NTHREADS, 0, stream>>>(p);
  k_phase<5><<<G, NTHREADS, 0, stream>>>(p);
  k_phase<6><<<G, NTHREADS, 0, stream>>>(p);
#endif
}
```

```cpp
#include <hip/hip_runtime.h>
#include <hip/hip_cooperative_groups.h>
#include <cstdio>
namespace cg = cooperative_groups;

#ifndef FUSED
#define FUSED 1
#endif

typedef unsigned short bf16_t;
typedef __bf16 bf16x8 __attribute__((ext_vector_type(8)));
typedef __bf16 bf16x2 __attribute__((ext_vector_type(2)));
typedef float f32x4 __attribute__((ext_vector_type(4)));
typedef float f32x16 __attribute__((ext_vector_type(16)));
typedef unsigned u32x4 __attribute__((ext_vector_type(4)));
typedef unsigned u32x2 __attribute__((ext_vector_type(2)));

constexpr int SEQ = 4096, T = 8 * SEQ, D = 1024, NIN = 2560;
constexpr float EPS = 1e-6f;
constexpr float LOG2E = 1.4426950408889634f;

constexpr size_t MiB = 1u << 20;
constexpr size_t WS_WIN = 0, WS_WOUT = 5 * MiB, WS_WQ = 7 * MiB, WS_K1 = 9 * MiB, WS_K2 = 9 * MiB + 131072, WS_SSQ = 10 * MiB;
constexpr size_t WS_U16 = 12 * MiB, WS_V16 = 44 * MiB;
constexpr size_t WS_Q = 76 * MiB, WS_K = 108 * MiB, WS_VT = 140 * MiB, WS_HG = 172 * MiB, WS_MIX = 204 * MiB;
constexpr size_t WS_XN2 = 76 * MiB, WS_PIDX = 140 * MiB, WS_PG = 156 * MiB;
constexpr size_t WS_END = 268 * MiB;

struct Params {
  const float *x, *norm_mix_g, *w_in, *q_norm_g, *k_norm_g, *attn_out_g, *conv_w, *conv_b, *conv_ln_g, *conv_ln_b,
      *w_out, *norm_ffn_g, *peer_wq, *peer_k1, *peer_k2, *peer_u, *peer_v;
  float* out;
  unsigned char* ws;
};

constexpr int NTHREADS = 256;
constexpr int CPITCH = 132;
constexpr int LDS_RS = 67584, LDS_RS2 = LDS_RS + 512, LDS_BYTES = LDS_RS2 + 512;

__device__ __forceinline__ unsigned pk2(float lo, float hi) {
  bf16x2 v = {(__bf16)lo, (__bf16)hi};
  return __builtin_bit_cast(unsigned, v);
}
__device__ __forceinline__ float bflo(unsigned u) { return __uint_as_float(u << 16); }
__device__ __forceinline__ float bfhi(unsigned u) { return __uint_as_float(u & 0xffff0000u); }
__device__ __forceinline__ float dot2(unsigned a, unsigned b, float c) {
  return __builtin_amdgcn_fdot2_f32_bf16(__builtin_bit_cast(bf16x2, a), __builtin_bit_cast(bf16x2, b), c, false);
}
__device__ __forceinline__ int vblock() {
  const int G = gridDim.x, b = blockIdx.x;
  return (G % 8 == 0) ? (b % 8) * (G / 8) + b / 8 : b;
}
__device__ __forceinline__ f32x16 mfma32(bf16x8 a, bf16x8 b, f32x16 c) { return __builtin_amdgcn_mfma_f32_32x32x16_bf16(a, b, c, 0, 0, 0); }
__device__ __forceinline__ f32x4 mfma16(bf16x8 a, bf16x8 b, f32x4 c) { return __builtin_amdgcn_mfma_f32_16x16x32_bf16(a, b, c, 0, 0, 0); }

__device__ __forceinline__ void transpose_items(const float* __restrict__ W, int N, bf16_t* __restrict__ Wt, const float* __restrict__ g, int glimit,
                                                int mode, long gtid, long nthr) {
  const long nitems = (long)N * 128;
  for (long it = gtid; it < nitems; it += nthr) {
    const int n = (int)(it % N), kc = (int)(it / N);
    int src = n;
    if (mode == 1 && n >= 1536) {
      const int r = n - 1536, j = r >> 7, rr = r & 127;
      src = rr < 64 ? 1536 + 64 * j + rr : 2048 + 64 * j + (rr - 64);
    }
    float v[8];
#pragma unroll
    for (int i = 0; i < 8; ++i) {
      const int k = kc * 8 + i;
      float w = W[(size_t)k * N + src];
      if (k < glimit) w *= g[k];
      v[i] = w;
    }
    u32x4 o = {pk2(v[0], v[1]), pk2(v[2], v[3]), pk2(v[4], v[5]), pk2(v[6], v[7])};
    *(u32x4*)(Wt + (size_t)n * 1024 + kc * 8) = o;
  }
}
__device__ __forceinline__ void convert_items(const float* __restrict__ src, bf16_t* __restrict__ dst, long n8, long gtid, long nthr) {
  for (long it = gtid; it < n8; it += nthr) {
    const f32x4 a = *(const f32x4*)(src + it * 8), b = *(const f32x4*)(src + it * 8 + 4);
    u32x4 o = {pk2(a.x, a.y), pk2(a.z, a.w), pk2(b.x, b.y), pk2(b.z, b.w)};
    *(u32x4*)(dst + it * 8) = o;
  }
}
__device__ void phase_prep(const Params& p) {
  const long gtid = (long)vblock() * NTHREADS + threadIdx.x, nthr = (long)gridDim.x * NTHREADS;
  unsigned char* ws = p.ws;
  transpose_items(p.w_in, NIN, (bf16_t*)(ws + WS_WIN), p.norm_mix_g, 1024, 1, gtid, nthr);
  transpose_items(p.w_out, D, (bf16_t*)(ws + WS_WOUT), p.attn_out_g, 512, 0, gtid, nthr);
  transpose_items(p.peer_wq, D, (bf16_t*)(ws + WS_WQ), p.norm_ffn_g, 1024, 0, gtid, nthr);
  convert_items(p.peer_k1, (bf16_t*)(ws + WS_K1), 65536 / 8, gtid, nthr);
  convert_items(p.peer_k2, (bf16_t*)(ws + WS_K2), 65536 / 8, gtid, nthr);
  convert_items(p.peer_u, (bf16_t*)(ws + WS_U16), (long)16384 * 1024 / 8, gtid, nthr);
  convert_items(p.peer_v, (bf16_t*)(ws + WS_V16), (long)16384 * 1024 / 8, gtid, nthr);
}

template <bool AF32, bool MID>
__device__ __forceinline__ void gemm_mainloop(const float* __restrict__ Af, const bf16_t* __restrict__ Ab, const bf16_t* __restrict__ Bt,
                                              int m0, int n0, char* smem, f32x4 (&acc)[4][4]) {
  const int tid = threadIdx.x, lane = tid & 63, wave = tid >> 6, wm = wave >> 1, wn = wave & 1;
  const int lrow = tid >> 3, lchunk = tid & 7;
  const int woff = lrow * 128 + ((lchunk ^ ((lrow >> 1) & 7)) << 4);
  float ss[4] = {0.f, 0.f, 0.f, 0.f};
  f32x4 ra[4][2];
  u32x4 rab[4], rb[4];
#pragma unroll
  for (int i = 0; i < 4; ++i)
#pragma unroll
    for (int j = 0; j < 4; ++j) acc[i][j] = (f32x4){0.f, 0.f, 0.f, 0.f};

  const float* ap = Af + (size_t)(m0 + lrow) * 1024 + lchunk * 8;
  const bf16_t* abp = Ab + (size_t)(m0 + lrow) * 1024 + lchunk * 8;
  const bf16_t* bp = Bt + (size_t)(n0 + lrow) * 1024 + lchunk * 8;

#define G_LOAD(kt)                                                                    \
  {                                                                                   \
    _Pragma("unroll") for (int j = 0; j < 4; ++j) {                                   \
      if (AF32) {                                                                     \
        ra[j][0] = *(const f32x4*)(ap + (size_t)j * 32 * 1024 + (kt) * 64);           \
        ra[j][1] = *(const f32x4*)(ap + (size_t)j * 32 * 1024 + (kt) * 64 + 4);       \
      } else {                                                                        \
        rab[j] = *(const u32x4*)(abp + (size_t)j * 32 * 1024 + (kt) * 64);            \
      }                                                                               \
      rb[j] = *(const u32x4*)(bp + (size_t)j * 32 * 1024 + (kt) * 64);                \
    }                                                                                 \
  }
#define G_WRITE(stage)                                                                                   \
  {                                                                                                      \
    char* sa = smem + (stage) * 32768 + woff;                                                            \
    _Pragma("unroll") for (int j = 0; j < 4; ++j) {                                                      \
      u32x4 av;                                                                                          \
      if (AF32) {                                                                                        \
        const f32x4 a0 = ra[j][0], a1 = ra[j][1];                                                        \
        ss[j] += a0.x * a0.x + a0.y * a0.y + a0.z * a0.z + a0.w * a0.w + a1.x * a1.x + a1.y * a1.y +     \
                 a1.z * a1.z + a1.w * a1.w;                                                              \
        av = (u32x4){pk2(a0.x, a0.y), pk2(a0.z, a0.w), pk2(a1.x, a1.y), pk2(a1.z, a1.w)};                \
      } else {                                                                                           \
        av = rab[j];                                                                                     \
      }                                                                                                  \
      *(u32x4*)(sa + j * 4096) = av;                                                                     \
      *(u32x4*)(sa + 16384 + j * 4096) = rb[j];                                                          \
    }                                                                                                    \
  }

  G_LOAD(0);
  G_WRITE(0);
  __syncthreads();
  const int sw = (lane & 15) >> 1;
  const int arow = (wm * 64 + (lane & 15)) * 128, brow = (wn * 64 + (lane & 15)) * 128;
  const int kq = lane >> 4;
  for (int kt = 0; kt < 16; ++kt) {
    if (kt + 1 < 16) G_LOAD(kt + 1);
    if (MID && kt == 8) {
      const float* rs2 = (const float*)(smem + LDS_RS2);
#pragma unroll
      for (int i = 0; i < 4; ++i) {
        const f32x4 r = *(const f32x4*)(rs2 + wm * 64 + i * 16 + (lane >> 4) * 4);
#pragma unroll
        for (int j = 0; j < 4; ++j) acc[i][j] *= r;
      }
    }
    const char* sb = smem + (kt & 1) * 32768;
#pragma unroll
    for (int kk = 0; kk < 2; ++kk) {
      bf16x8 af[4], bfr[4];
      const int co = ((kk * 4 + kq) ^ sw) << 4;
#pragma unroll
      for (int i = 0; i < 4; ++i) af[i] = *(const bf16x8*)(sb + arow + i * 2048 + co);
#pragma unroll
      for (int j = 0; j < 4; ++j) bfr[j] = *(const bf16x8*)(sb + 16384 + brow + j * 2048 + co);
#pragma unroll
      for (int i = 0; i < 4; ++i)
#pragma unroll
        for (int j = 0; j < 4; ++j) acc[i][j] = mfma16(af[i], bfr[j], acc[i][j]);
    }
    if (kt + 1 < 16) G_WRITE((kt + 1) & 1);
    __syncthreads();
  }
#undef G_LOAD
#undef G_WRITE
  if (AF32) {
    float* rs = (float*)(smem + LDS_RS);
#pragma unroll
    for (int j = 0; j < 4; ++j) {
      float s = ss[j];
      s += __shfl_xor(s, 1);
      s += __shfl_xor(s, 2);
      s += __shfl_xor(s, 4);
      if (lchunk == 0) rs[lrow + 32 * j] = rsqrtf(s * (1.f / 1024.f) + EPS);
    }
  }
  float* Cs = (float*)smem;
#pragma unroll
  for (int i = 0; i < 4; ++i)
#pragma unroll
    for (int j = 0; j < 4; ++j)
#pragma unroll
      for (int r = 0; r < 4; ++r)
        Cs[(wm * 64 + i * 16 + (lane >> 4) * 4 + r) * CPITCH + wn * 64 + j * 16 + (lane & 15)] = acc[i][j][r];
  __syncthreads();
}

__device__ void phase_inproj(const Params& p, char* smem) {
  unsigned char* ws = p.ws;
  const bf16_t* Wt = (const bf16_t*)(ws + WS_WIN);
  bf16_t* Qo = (bf16_t*)(ws + WS_Q);
  bf16_t* Ko = (bf16_t*)(ws + WS_K);
  bf16_t* Vt = (bf16_t*)(ws + WS_VT);
  bf16_t* HG = (bf16_t*)(ws + WS_HG);
  const int tid = threadIdx.x;
  const int ntiles = 256 * 20, per = (ntiles + gridDim.x - 1) / gridDim.x;
  const int vb = vblock();
  const float* Cs = (const float*)smem;
  const float* rs = (const float*)(smem + LDS_RS);
  for (int tile = vb * per; tile < min((vb + 1) * per, ntiles); ++tile) {
    const int mt = tile / 20, nt = tile % 20, m0 = mt * 128;
    f32x4 acc[4][4];
    gemm_mainloop<true, false>(p.x, nullptr, Wt, m0, nt * 128, smem, acc);
    if (nt < 8) {
      const int tok = tid & 127, hh = tid >> 7, t = m0 + tok, b = t >> 12, s = t & 4095;
      const int head = (nt & 3) * 2 + hh;
      const float* row = Cs + tok * CPITCH + hh * 64;
      f32x4 v[16];
      float ssq = 0.f;
#pragma unroll
      for (int i = 0; i < 16; ++i) {
        v[i] = *(const f32x4*)(row + i * 4);
        ssq += v[i].x * v[i].x + v[i].y * v[i].y + v[i].z * v[i].z + v[i].w * v[i].w;
      }
      const float r = rs[tok];
      float sc = r * rsqrtf(r * r * ssq * (1.f / 64.f) + EPS);
      const float* g = (nt < 4) ? p.q_norm_g : p.k_norm_g;
      if (nt < 4) sc *= 0.125f * LOG2E;
      bf16_t* dst = ((nt < 4) ? Qo : Ko) + ((size_t)(b * 8 + head) * 4096 + s) * 64;
#pragma unroll
      for (int i = 0; i < 8; ++i) {
        const f32x4 g0 = *(const f32x4*)(g + i * 8), g1 = *(const f32x4*)(g + i * 8 + 4);
        const f32x4 a = v[2 * i], c = v[2 * i + 1];
        u32x4 o = {pk2(a.x * sc * g0.x, a.y * sc * g0.y), pk2(a.z * sc * g0.z, a.w * sc * g0.w),
                   pk2(c.x * sc * g1.x, c.y * sc * g1.y), pk2(c.z * sc * g1.z, c.w * sc * g1.w)};
        *(u32x4*)(dst + i * 8) = o;
      }
    } else if (nt < 12) {
#pragma unroll
      for (int it = 0; it < 2; ++it) {
        const int item = tid + 256 * it, d = item & 63, kb = (item >> 6) & 3, hh = item >> 8;
        const int head = (nt - 8) * 2 + hh, t0 = m0 + kb * 32, b = t0 >> 12, kblk = (t0 & 4095) >> 5;
        unsigned o[16];
#pragma unroll
        for (int pp = 0; pp < 16; ++pp) {
          float val[2];
#pragma unroll
          for (int e = 0; e < 2; ++e) {
            const int pos = pp * 2 + e, sI = pos >> 4, h = (pos >> 3) & 1, j = pos & 7;
            const int key = 16 * sI + 8 * (j >> 2) + 4 * h + (j & 3);
            val[e] = Cs[(kb * 32 + key) * CPITCH + hh * 64 + d] * rs[kb * 32 + key];
          }
          o[pp] = pk2(val[0], val[1]);
        }
        bf16_t* dst = Vt + ((((size_t)(b * 8 + head) * 128 + kblk) * 64 + d) * 32);
#pragma unroll
        for (int q = 0; q < 4; ++q) *(u32x4*)(dst + q * 8) = (u32x4){o[4 * q], o[4 * q + 1], o[4 * q + 2], o[4 * q + 3]};
      }
    } else {
      const int jc = nt - 12;
#pragma unroll
      for (int it = 0; it < 4; ++it) {
        const int item = tid + 256 * it, c8 = item & 7, tok = item >> 3;
        const float* row = Cs + tok * CPITCH + c8 * 8;
        const float r = rs[tok];
        const f32x4 a0 = *(const f32x4*)(row), a1 = *(const f32x4*)(row + 4), g0 = *(const f32x4*)(row + 64), g1 = *(const f32x4*)(row + 68);
        float h[8];
#define GLU(a, g) ((a) * r / (1.f + __expf(-(g) * r)))
        h[0] = GLU(a0.x, g0.x); h[1] = GLU(a0.y, g0.y); h[2] = GLU(a0.z, g0.z); h[3] = GLU(a0.w, g0.w);
        h[4] = GLU(a1.x, g1.x); h[5] = GLU(a1.y, g1.y); h[6] = GLU(a1.z, g1.z); h[7] = GLU(a1.w, g1.w);
#undef GLU
        *(u32x4*)(HG + (size_t)(m0 + tok) * 512 + jc * 64 + c8 * 8) = (u32x4){pk2(h[0], h[1]), pk2(h[2], h[3]), pk2(h[4], h[5]), pk2(h[6], h[7])};
      }
    }
    __syncthreads();
  }
}

__device__ void conv_item(const Params& p, int item, char* smem) {
  unsigned char* ws = p.ws;
  const bf16_t* HG = (const bf16_t*)(ws + WS_HG);
  bf16_t* MIX = (bf16_t*)(ws + WS_MIX);
  const int tid = threadIdx.x, lane = tid & 63, wave = tid >> 6;
  const int t0 = item * 32, s0 = t0 & 4095;
  for (int idx = tid; idx < 62 * 64; idx += 256) {
    const int r = idx >> 6, c16 = idx & 63;
    u32x4 v = {0u, 0u, 0u, 0u};
    if (s0 - 30 + r >= 0) v = *(const u32x4*)(HG + (size_t)(t0 - 30 + r) * 512 + c16 * 8);
    *(u32x4*)(smem + r * 1024 + c16 * 16) = v;
  }
  float w0[31], w1[31];
#pragma unroll
  for (int j = 0; j < 31; ++j) {
    const float2 w = *(const float2*)(p.conv_w + j * 512 + 2 * tid);
    w0[j] = w.x;
    w1[j] = w.y;
  }
  const float2 cb = *(const float2*)(p.conv_b + 2 * tid);
  const float2 lg = *(const float2*)(p.conv_ln_g + 2 * tid);
  const float2 lb = *(const float2*)(p.conv_ln_b + 2 * tid);
  float* red = (float*)(smem + 62 * 1024);
  __syncthreads();
  for (int tt = 0; tt < 32; ++tt) {
    float a0 = cb.x, a1 = cb.y;
#pragma unroll
    for (int j = 0; j < 31; ++j) {
      const unsigned v = *(const unsigned*)(smem + (tt + j) * 1024 + tid * 4);
      a0 += w0[j] * bflo(v);
      a1 += w1[j] * bfhi(v);
    }
    float s1 = a0 + a1, s2 = a0 * a0 + a1 * a1;
#pragma unroll
    for (int o = 1; o < 64; o <<= 1) {
      s1 += __shfl_xor(s1, o);
      s2 += __shfl_xor(s2, o);
    }
    float* rr = red + (tt & 1) * 8;
    if (lane == 0) {
      rr[wave * 2] = s1;
      rr[wave * 2 + 1] = s2;
    }
    __syncthreads();
    const float S1 = rr[0] + rr[2] + rr[4] + rr[6], S2 = rr[1] + rr[3] + rr[5] + rr[7];
    const float mu = S1 * (1.f / 512.f);
    const float var = fmaxf(S2 * (1.f / 512.f) - mu * mu, 0.f);
    const float rstd = rsqrtf(var + EPS);
    const float y0 = (a0 - mu) * rstd * lg.x + lb.x, y1 = (a1 - mu) * rstd * lg.y + lb.y;
    const float z0 = y0 / (1.f + __expf(-y0)), z1 = y1 / (1.f + __expf(-y1));
    *(unsigned*)(MIX + (size_t)(t0 + tt) * 1024 + 512 + 2 * tid) = pk2(z0, z1);
  }
  __syncthreads();
}

__device__ void attn_item(const Params& p, int item, int lane) {
  unsigned char* ws = p.ws;
  const bf16_t* Qm = (const bf16_t*)(ws + WS_Q);
  const bf16_t* Km = (const bf16_t*)(ws + WS_K);
  const bf16_t* Vt = (const bf16_t*)(ws + WS_VT);
  bf16_t* MIX = (bf16_t*)(ws + WS_MIX);
  float* SSQ = (float*)(ws + WS_SSQ);
  const int qt = item & 127, bh = item >> 7;
  const int tok = lane & 31, hf = lane >> 5;
  bf16x8 qf[4];
  {
    const bf16_t* qp = Qm + ((size_t)bh * 4096 + qt * 32 + tok) * 64 + 8 * hf;
#pragma unroll
    for (int ks = 0; ks < 4; ++ks) qf[ks] = *(const bf16x8*)(qp + ks * 16);
  }
  f32x16 o0, o1;
#pragma unroll
  for (int i = 0; i < 16; ++i) { o0[i] = 0.f; o1[i] = 0.f; }
  float c = 0.f;
  for (int kb = qt; kb >= 0; --kb) {
    const bf16_t* kp = Km + ((size_t)bh * 4096 + kb * 32 + tok) * 64 + 8 * hf;
    bf16x8 kf[4];
#pragma unroll
    for (int ks = 0; ks < 4; ++ks) kf[ks] = *(const bf16x8*)(kp + ks * 16);
    const bf16_t* vp = Vt + (((size_t)bh * 128 + kb) * 64 + tok) * 32 + hf * 8;
    bf16x8 vf[2][2];
#pragma unroll
    for (int m = 0; m < 2; ++m)
#pragma unroll
      for (int s = 0; s < 2; ++s) vf[m][s] = *(const bf16x8*)(vp + m * 1024 + s * 16);
    f32x16 sc;
#pragma unroll
    for (int i = 0; i < 16; ++i) sc[i] = 0.f;
#pragma unroll
    for (int ks = 0; ks < 4; ++ks) sc = mfma32(kf[ks], qf[ks], sc);
    const bool diag = (kb == qt);
    float lk[16], zs[16];
#pragma unroll
    for (int i = 0; i < 16; ++i) {
      const float zl = sc[i];
      const float e = __builtin_amdgcn_exp2f(zl);
      const float sp = __builtin_amdgcn_logf(1.f + e);
      const bool valid = !diag || ((i & 3) + 8 * (i >> 2) + 4 * hf < tok);
      lk[i] = valid ? -sp : 0.f;
      zs[i] = valid ? zl - sp : -1e30f;
    }
    float Tg[4], Pg[4];
#pragma unroll
    for (int g = 0; g < 4; ++g) {
      Tg[g] = (lk[4 * g] + lk[4 * g + 1]) + (lk[4 * g + 2] + lk[4 * g + 3]);
      Pg[g] = __shfl_xor(Tg[g], 32);
    }
    float base[4];
    float run = 0.f;
#pragma unroll
    for (int g = 3; g >= 0; --g) {
      base[g] = c + run + (hf == 0 ? Pg[g] : 0.f);
      run += Tg[g] + Pg[g];
    }
    float pr[16];
#pragma unroll
    for (int g = 0; g < 4; ++g) {
      float l = base[g];
#pragma unroll
      for (int r = 3; r >= 0; --r) {
        pr[4 * g + r] = __builtin_amdgcn_exp2f(zs[4 * g + r] + l);
        l += lk[4 * g + r];
      }
    }
    c += run;
    bf16x8 pf[2];
#pragma unroll
    for (int s = 0; s < 2; ++s)
#pragma unroll
      for (int j = 0; j < 8; ++j) pf[s][j] = (__bf16)pr[8 * s + j];
#pragma unroll
    for (int s = 0; s < 2; ++s) {
      o0 = mfma32(vf[0][s], pf[s], o0);
      o1 = mfma32(vf[1][s], pf[s], o1);
    }
    if (__all(c < -150.f)) break;
  }
  const int t = (bh >> 3) * 4096 + qt * 32 + tok, hh = bh & 7;
  float ssq = 0.f;
#pragma unroll
  for (int i = 0; i < 16; ++i) ssq += o0[i] * o0[i] + o1[i] * o1[i];
  ssq += __shfl_xor(ssq, 32);
  if (hf == 0) SSQ[t * 8 + hh] = ssq;
  bf16_t* dst = MIX + (size_t)t * 1024 + hh * 64 + 4 * hf;
#pragma unroll
  for (int g = 0; g < 4; ++g) {
    *(u32x2*)(dst + 8 * g) = (u32x2){pk2(o0[4 * g], o0[4 * g + 1]), pk2(o0[4 * g + 2], o0[4 * g + 3])};
    *(u32x2*)(dst + 32 + 8 * g) = (u32x2){pk2(o1[4 * g], o1[4 * g + 1]), pk2(o1[4 * g + 2], o1[4 * g + 3])};
  }
}

__device__ void phase_mix(const Params& p, char* smem) {
  const int vb = vblock(), G = gridDim.x;
  for (int item = vb; item < 1024; item += G) conv_item(p, item, smem);
  const int lane = threadIdx.x & 63, gw = vb * 4 + (threadIdx.x >> 6), nw = G * 4;
  for (int item = gw; item < 8192; item += nw) attn_item(p, item, lane);
}

__device__ void phase_outproj(const Params& p, char* smem) {
  unsigned char* ws = p.ws;
  const bf16_t* MIX = (const bf16_t*)(ws + WS_MIX);
  const bf16_t* Wt = (const bf16_t*)(ws + WS_WOUT);
  const float* SSQ = (const float*)(ws + WS_SSQ);
  const int tid = threadIdx.x;
  const int ntiles = 256 * 8, per = (ntiles + gridDim.x - 1) / gridDim.x;
  const int vb = vblock();
  const float* Cs = (const float*)smem;
  for (int tile = vb * per; tile < min((vb + 1) * per, ntiles); ++tile) {
    const int mt = tile >> 3, nt = tile & 7, m0 = mt * 128, n0 = nt * 128;
    if (tid < 128) {
      const f32x4 a = *(const f32x4*)(SSQ + (size_t)(m0 + tid) * 8), b = *(const f32x4*)(SSQ + (size_t)(m0 + tid) * 8 + 4);
      const float s = (a.x + a.y) + (a.z + a.w) + (b.x + b.y) + (b.z + b.w);
      ((float*)(smem + LDS_RS2))[tid] = rsqrtf(s * (1.f / 512.f) + EPS);
    }
    f32x4 acc[4][4];
    gemm_mainloop<false, true>(nullptr, MIX, Wt, m0, n0, smem, acc);
#pragma unroll
    for (int it = 0; it < 16; ++it) {
      const int item = tid + 256 * it, c4 = item & 31, tok = item >> 5;
      const f32x4 v = *(const f32x4*)(Cs + tok * CPITCH + c4 * 4);
      const size_t o = (size_t)(m0 + tok) * 1024 + n0 + c4 * 4;
      const f32x4 xr = *(const f32x4*)(p.x + o);
      *(f32x4*)(p.out + o) = xr + v;
    }
    __syncthreads();
  }
}

__device__ __forceinline__ unsigned f2key(float f, unsigned n) {
  const unsigned u = (__float_as_uint(f) & ~0x7Fu) | n;
  return u ^ ((unsigned)((int)u >> 31) | 0x80000000u);
}
__device__ __forceinline__ unsigned f2key_raw(float f) {
  const unsigned u = __float_as_uint(f);
  return u ^ ((unsigned)((int)u >> 31) | 0x80000000u);
}
__device__ __forceinline__ unsigned key2u(unsigned k) { return k ^ ((k >> 31) ? 0x80000000u : 0xFFFFFFFFu); }

template <int N>
__device__ __forceinline__ void bitonic_sort_desc(unsigned (&v)[N]) {
#pragma unroll
  for (int k = 2; k <= N; k <<= 1) {
#pragma unroll
    for (int j = k >> 1; j > 0; j >>= 1) {
#pragma unroll
      for (int i = 0; i < N; ++i) {
        const int l = i ^ j;
        if (l > i) {
          const bool desc = ((i & k) == 0);
          const unsigned mx = max(v[i], v[l]), mn = min(v[i], v[l]);
          v[i] = desc ? mx : mn;
          v[l] = desc ? mn : mx;
        }
      }
    }
  }
}
template <int N>
__device__ __forceinline__ void bitonic_merge_desc(unsigned (&v)[N]) {
#pragma unroll
  for (int j = N >> 1; j > 0; j >>= 1) {
#pragma unroll
    for (int i = 0; i < N; ++i) {
      const int l = i ^ j;
      if (l > i) {
        const unsigned mx = max(v[i], v[l]), mn = min(v[i], v[l]);
        v[i] = mx;
        v[l] = mn;
      }
    }
  }
}
__device__ __forceinline__ void merge_top16(unsigned (&a)[16], const unsigned (&b)[16]) {
#pragma unroll
  for (int i = 0; i < 16; ++i) a[i] = max(a[i], b[15 - i]);
  bitonic_merge_desc<16>(a);
}
#define CEP(ka, pa, kb, pb, desc)                                  \
  {                                                                \
    const bool sw_ = (desc) ? ((kb) > (ka)) : ((kb) < (ka));       \
    const unsigned tk_ = sw_ ? (kb) : (ka), tl_ = sw_ ? (ka) : (kb); \
    const unsigned tp_ = sw_ ? (pb) : (pa), tq_ = sw_ ? (pa) : (pb); \
    ka = tk_; kb = tl_; pa = tp_; pb = tq_;                        \
  }
template <int N>
__device__ __forceinline__ void bitonic_sort_desc_p(unsigned (&v)[N], unsigned (&pl)[N]) {
#pragma unroll
  for (int k = 2; k <= N; k <<= 1) {
#pragma unroll
    for (int j = k >> 1; j > 0; j >>= 1) {
#pragma unroll
      for (int i = 0; i < N; ++i) {
        const int l = i ^ j;
        if (l > i) {
          const bool desc = ((i & k) == 0);
          CEP(v[i], pl[i], v[l], pl[l], desc);
        }
      }
    }
  }
}
template <int N>
__device__ __forceinline__ void bitonic_merge_desc_p(unsigned (&v)[N], unsigned (&pl)[N]) {
#pragma unroll
  for (int j = N >> 1; j > 0; j >>= 1) {
#pragma unroll
    for (int i = 0; i < N; ++i) {
      const int l = i ^ j;
      if (l > i) { CEP(v[i], pl[i], v[l], pl[l], true); }
    }
  }
}
__device__ __forceinline__ void merge_top16_p(unsigned (&a)[16], unsigned (&pa)[16], const unsigned (&b)[16], const unsigned (&pb)[16]) {
#pragma unroll
  for (int i = 0; i < 16; ++i) {
    const bool s = b[15 - i] > a[i];
    a[i] = s ? b[15 - i] : a[i];
    pa[i] = s ? pb[15 - i] : pa[i];
  }
  bitonic_merge_desc_p<16>(a, pa);
}

__device__ __forceinline__ void subkey_top16(const bf16_t* __restrict__ Kb, const float* crow, float rsv, int lane, unsigned (&top)[16]) {
  const int tok = lane & 31, hf = lane >> 5;
  f32x16 acc[4];
#pragma unroll
  for (int m = 0; m < 4; ++m)
#pragma unroll
    for (int i = 0; i < 16; ++i) acc[m][i] = 0.f;
#pragma unroll
  for (int ks = 0; ks < 4; ++ks) {
    const f32x4 v0 = *(const f32x4*)(crow + ks * 16 + 8 * hf), v1 = *(const f32x4*)(crow + ks * 16 + 8 * hf + 4);
    bf16x8 bq;
    bq[0] = (__bf16)(v0.x * rsv); bq[1] = (__bf16)(v0.y * rsv); bq[2] = (__bf16)(v0.z * rsv); bq[3] = (__bf16)(v0.w * rsv);
    bq[4] = (__bf16)(v1.x * rsv); bq[5] = (__bf16)(v1.y * rsv); bq[6] = (__bf16)(v1.z * rsv); bq[7] = (__bf16)(v1.w * rsv);
#pragma unroll
    for (int m = 0; m < 4; ++m) {
      const bf16x8 ak = *(const bf16x8*)(Kb + (m * 32 + tok) * 64 + ks * 16 + 8 * hf);
      acc[m] = mfma32(ak, bq, acc[m]);
    }
  }
  unsigned g[4][16];
#pragma unroll
  for (int m = 0; m < 4; ++m) {
#pragma unroll
    for (int i = 0; i < 16; ++i) g[m][i] = f2key(acc[m][i], (unsigned)(m * 32 + (i & 3) + 8 * (i >> 2) + 4 * hf));
    bitonic_sort_desc<16>(g[m]);
  }
  merge_top16(g[0], g[1]);
  merge_top16(g[2], g[3]);
  merge_top16(g[0], g[2]);
  unsigned o[16];
#pragma unroll
  for (int i = 0; i < 16; ++i) o[i] = __shfl_xor(g[0][i], 32);
  merge_top16(g[0], o);
#pragma unroll
  for (int i = 0; i < 16; ++i) top[i] = g[0][i];
}

__device__ void phase_route(const Params& p, char* smem) {
  unsigned char* ws = p.ws;
  const bf16_t* Wt = (const bf16_t*)(ws + WS_WQ);
  const bf16_t* K1 = (const bf16_t*)(ws + WS_K1);
  const bf16_t* K2 = (const bf16_t*)(ws + WS_K2);
  bf16_t* XN2 = (bf16_t*)(ws + WS_XN2);
  unsigned* PIDX = (unsigned*)(ws + WS_PIDX);
  float* PG = (float*)(ws + WS_PG);
  const int tid = threadIdx.x, lane = tid & 63, wave = tid >> 6;
  const int ntiles = 256 * 8, per = (ntiles + gridDim.x - 1) / gridDim.x;
  const int vb = vblock();
  const float* Cs = (const float*)smem;
  const float* rs = (const float*)(smem + LDS_RS);
  for (int tile = vb * per; tile < min((vb + 1) * per, ntiles); ++tile) {
    const int mt = tile >> 3, hd = tile & 7, m0 = mt * 128;
    f32x4 acc[4][4];
    gemm_mainloop<true, false>(p.out, nullptr, Wt, m0, hd * 128, smem, acc);
    if (hd == 0) {
#pragma unroll 4
      for (int it = 0; it < 64; ++it) {
        const int item = tid + 256 * it, c8 = item & 127, tok = item >> 7;
        const float* src = p.out + (size_t)(m0 + tok) * 1024 + c8 * 8;
        const f32x4 a = *(const f32x4*)src, b = *(const f32x4*)(src + 4);
        const f32x4 g0 = *(const f32x4*)(p.norm_ffn_g + c8 * 8), g1 = *(const f32x4*)(p.norm_ffn_g + c8 * 8 + 4);
        const float r = rs[tok];
        *(u32x4*)(XN2 + (size_t)(m0 + tok) * 1024 + c8 * 8) =
            (u32x4){pk2(a.x * r * g0.x, a.y * r * g0.y), pk2(a.z * r * g0.z, a.w * r * g0.w), pk2(b.x * r * g1.x, b.y * r * g1.y), pk2(b.z * r * g1.z, b.w * r * g1.w)};
      }
    }
    const int tok = lane & 31, hf = lane >> 5, trow = wave * 32 + tok;
    const float rsv = rs[trow];
    unsigned top1[16], top2[16];
    subkey_top16(K1 + hd * 8192, Cs + trow * CPITCH, rsv, lane, top1);
    subkey_top16(K2 + hd * 8192, Cs + trow * CPITCH + 64, rsv, lane, top2);
    float fa[16], fb[16];
    unsigned ia[16], ib[16];
#pragma unroll
    for (int i = 0; i < 16; ++i) {
      const unsigned ua = key2u(hf ? top2[i] : top1[i]), ub = key2u(hf ? top1[i] : top2[i]);
      fa[i] = __uint_as_float(ua); ia[i] = ua & 0x7Fu;
      fb[i] = __uint_as_float(ub); ib[i] = ub & 0x7Fu;
    }
    unsigned ck[32], cp[32];
    {
      int n = 0;
#pragma unroll
      for (int i = 0; i < 4; ++i) {
#pragma unroll
        for (int j = i; j < 16; ++j) {
          if ((i + 1) * (j + 1) <= 16) {
            unsigned key = f2key_raw(fa[i] + fb[j]);
            if (i == j && hf) key = 0u;
            ck[n] = key;
            cp[n] = hf ? ((ib[j] << 7) | ia[i]) : ((ia[i] << 7) | ib[j]);
            ++n;
          }
        }
      }
#pragma unroll
      for (; n < 32; ++n) { ck[n] = 0u; cp[n] = 0u; }
    }
    unsigned k0[16], p0[16], k1[16], p1[16];
#pragma unroll
    for (int i = 0; i < 16; ++i) { k0[i] = ck[i]; p0[i] = cp[i]; k1[i] = ck[16 + i]; p1[i] = cp[16 + i]; }
    bitonic_sort_desc_p<16>(k0, p0);
    bitonic_sort_desc_p<16>(k1, p1);
    merge_top16_p(k0, p0, k1, p1);
#pragma unroll
    for (int i = 0; i < 16; ++i) { k1[i] = __shfl_xor(k0[i], 32); p1[i] = __shfl_xor(p0[i], 32); }
    merge_top16_p(k0, p0, k1, p1);
    float sv[16], sum = 0.f;
    const float mx = __uint_as_float(key2u(k0[0]));
#pragma unroll
    for (int i = 0; i < 16; ++i) {
      sv[i] = __builtin_amdgcn_exp2f((__uint_as_float(key2u(k0[i])) - mx) * LOG2E);
      sum += sv[i];
    }
    const float inv = 1.f / sum;
    const size_t po = ((size_t)(m0 + trow) * 8 + hd) * 16;
    if (hf == 0) {
#pragma unroll
      for (int q = 0; q < 4; ++q) *(u32x4*)(PIDX + po + 4 * q) = (u32x4){p0[4 * q], p0[4 * q + 1], p0[4 * q + 2], p0[4 * q + 3]};
    } else {
#pragma unroll
      for (int q = 0; q < 4; ++q) *(f32x4*)(PG + po + 4 * q) = (f32x4){sv[4 * q] * inv, sv[4 * q + 1] * inv, sv[4 * q + 2] * inv, sv[4 * q + 3] * inv};
    }
    __syncthreads();
  }
}

__device__ void phase_peer_u(const Params& p) {
  unsigned char* ws = p.ws;
  const bf16_t* U16 = (const bf16_t*)(ws + WS_U16);
  const bf16_t* XN2 = (const bf16_t*)(ws + WS_XN2);
  const unsigned* PIDX = (const unsigned*)(ws + WS_PIDX);
  float* PG = (float*)(ws + WS_PG);
  const int lane = threadIdx.x & 63, q = lane >> 4, c = lane & 15;
  const int gw = vblock() * 4 + (threadIdx.x >> 6), nw = gridDim.x * 4;
  for (int t = gw; t < T; t += nw) {
    u32x4 xr[8];
#pragma unroll
    for (int i = 0; i < 8; ++i) xr[i] = *(const u32x4*)(XN2 + (size_t)t * 1024 + (c + 16 * i) * 8);
#pragma unroll 2
    for (int sg = 0; sg < 32; ++sg) {
      const int slot = sg * 4 + q;
      const unsigned e = PIDX[(size_t)t * 128 + slot];
      const bf16_t* row = U16 + (size_t)e * 1024 + c * 8;
      u32x4 u[8];
#pragma unroll
      for (int i = 0; i < 8; ++i) u[i] = *(const u32x4*)(row + i * 128);
      float d0 = 0.f, d1 = 0.f;
#pragma unroll
      for (int i = 0; i < 8; ++i) {
        d0 = dot2(u[i].x, xr[i].x, d0);
        d1 = dot2(u[i].y, xr[i].y, d1);
        d0 = dot2(u[i].z, xr[i].z, d0);
        d1 = dot2(u[i].w, xr[i].w, d1);
      }
      float d = d0 + d1;
      d += __shfl_xor(d, 1);
      d += __shfl_xor(d, 2);
      d += __shfl_xor(d, 4);
      d += __shfl_xor(d, 8);
      if (c == 0) {
        const float g = PG[(size_t)t * 128 + slot];
        PG[(size_t)t * 128 + slot] = g * 0.5f * d * (1.f + erff(d * 0.70710678118654752f));
      }
    }
  }
}

__device__ void phase_peer_v(const Params& p) {
  unsigned char* ws = p.ws;
  const bf16_t* V16 = (const bf16_t*)(ws + WS_V16);
  const unsigned* PIDX = (const unsigned*)(ws + WS_PIDX);
  const float* PG = (const float*)(ws + WS_PG);
  const int lane = threadIdx.x & 63;
  const int gw = vblock() * 4 + (threadIdx.x >> 6), nw = gridDim.x * 4;
  for (int t = gw; t < T; t += nw) {
    const unsigned e0 = PIDX[(size_t)t * 128 + lane], e1 = PIDX[(size_t)t * 128 + 64 + lane];
    const float w0 = PG[(size_t)t * 128 + lane], w1 = PG[(size_t)t * 128 + 64 + lane];
    float acc[16];
#pragma unroll
    for (int i = 0; i < 16; ++i) acc[i] = 0.f;
#pragma unroll
    for (int half = 0; half < 2; ++half) {
      const unsigned ev = half ? e1 : e0;
      const float wv = half ? w1 : w0;
#pragma unroll 8
      for (int s = 0; s < 64; ++s) {
        const unsigned e = __shfl(ev, s);
        const float w = __shfl(wv, s);
        const bf16_t* row = V16 + (size_t)e * 1024 + lane * 8;
        const u32x4 a = *(const u32x4*)row, b = *(const u32x4*)(row + 512);
        acc[0] += w * bflo(a.x); acc[1] += w * bfhi(a.x); acc[2] += w * bflo(a.y); acc[3] += w * bfhi(a.y);
        acc[4] += w * bflo(a.z); acc[5] += w * bfhi(a.z); acc[6] += w * bflo(a.w); acc[7] += w * bfhi(a.w);
        acc[8] += w * bflo(b.x); acc[9] += w * bfhi(b.x); acc[10] += w * bflo(b.y); acc[11] += w * bfhi(b.y);
        acc[12] += w * bflo(b.z); acc[13] += w * bfhi(b.z); acc[14] += w * bflo(b.w); acc[15] += w * bfhi(b.w);
      }
    }
    float* o = p.out + (size_t)t * 1024 + lane * 8;
    f32x4 h0 = *(f32x4*)o, h1 = *(f32x4*)(o + 4), h2 = *(f32x4*)(o + 512), h3 = *(f32x4*)(o + 516);
    h0 += (f32x4){acc[0], acc[1], acc[2], acc[3]};
    h1 += (f32x4){acc[4], acc[5], acc[6], acc[7]};
    h2 += (f32x4){acc[8], acc[9], acc[10], acc[11]};
    h3 += (f32x4){acc[12], acc[13], acc[14], acc[15]};
    *(f32x4*)o = h0; *(f32x4*)(o + 4) = h1; *(f32x4*)(o + 512) = h2; *(f32x4*)(o + 516) = h3;
  }
}

template <int PHASE>
__global__ void __launch_bounds__(NTHREADS, 2) k_phase(Params p) {
  __shared__ __attribute__((aligned(16))) char smem[LDS_BYTES];
  if (PHASE == 0) phase_prep(p);
  if (PHASE == 1) phase_inproj(p, smem);
  if (PHASE == 2) phase_mix(p, smem);
  if (PHASE == 3) phase_outproj(p, smem);
  if (PHASE == 4) phase_route(p, smem);
  if (PHASE == 5) phase_peer_u(p);
  if (PHASE == 6) phase_peer_v(p);
}

__global__ void __launch_bounds__(NTHREADS, 2) k_fused(Params p) {
  __shared__ __attribute__((aligned(16))) char smem[LDS_BYTES];
  cg::grid_group grid = cg::this_grid();
  phase_prep(p);
  grid.sync();
  phase_inproj(p, smem);
  grid.sync();
  phase_mix(p, smem);
  grid.sync();
  phase_outproj(p, smem);
  grid.sync();
  phase_route(p, smem);
  grid.sync();
  phase_peer_u(p);
  grid.sync();
  phase_peer_v(p);
}

extern "C" void kernel_launch(void* const* d_in, const int* in_sizes, int n_in, void* d_out, int out_size, void* d_ws, size_t ws_size,
                              hipStream_t stream) {
  if (n_in != 17 || ws_size < WS_END) {
    fprintf(stderr, "kernel_launch: unexpected n_in %d / ws_size %zu\n", n_in, ws_size);
    return;
  }
  Params p{};
  p.x = (const float*)d_in[0]; p.norm_mix_g = (const float*)d_in[1]; p.w_in = (const float*)d_in[2]; p.q_norm_g = (const float*)d_in[3];
  p.k_norm_g = (const float*)d_in[4]; p.attn_out_g = (const float*)d_in[5]; p.conv_w = (const float*)d_in[6]; p.conv_b = (const float*)d_in[7];
  p.conv_ln_g = (const float*)d_in[8]; p.conv_ln_b = (const float*)d_in[9]; p.w_out = (const float*)d_in[10]; p.norm_ffn_g = (const float*)d_in[11];
  p.peer_wq = (const float*)d_in[12]; p.peer_k1 = (const float*)d_in[13]; p.peer_k2 = (const float*)d_in[14]; p.peer_u = (const float*)d_in[15];
  p.peer_v = (const float*)d_in[16];
  p.out = (float*)d_out;
  p.ws = (unsigned char*)d_ws;
#if FUSED
  static int grid_blocks = 0;
  if (!grid_blocks) {
    int dev = 0, cus = 0, per_cu = 0;
    hipGetDevice(&dev);
    hipDeviceGetAttribute(&cus, hipDeviceAttributeMultiprocessorCount, dev);
    hipOccupancyMaxActiveBlocksPerMultiprocessor(&per_cu, k_fused, NTHREADS, 0);
    if (per_cu > 2) per_cu = 2;
    if (per_cu < 1) per_cu = 1;
    grid_blocks = cus * per_cu;
  }
  void* args[] = {&p};
  hipError_t e = hipLaunchCooperativeKernel((void*)k_fused, dim3(grid_blocks), dim3(NTHREADS), args, 0, stream);
  if (e != hipSuccess) fprintf(stderr, "cooperative launch failed: %s (grid %d)\n", hipGetErrorString(e), grid_blocks);
#else
  const int G = 512;
  k_phase<0><<<G, NTHREADS, 0, stream>>>(p);
  k_phase<1><<<G, NTHREADS, 0, stream>>>(p);
  k_phase<2><<<G, NTHREADS, 0, stream>>>(p);
  k_phase<3><<<G, NTHREADS, 0, stream>>>(p);
  k_phase<4><<<G, NTHREADS, 0, stream>>>(p);
  k_phase<5><<<G, NTHREADS, 0, stream>>>(p);
  k_phase<6><<<G, NTHREADS, 0, stream>>>(p);
#endif
}
```

```cpp
#include <hip/hip_runtime.h>
#include <cstdio>

#ifndef FUSED
#define FUSED 1
#endif

typedef unsigned short bf16_t;
typedef __bf16 bf16x8 __attribute__((ext_vector_type(8)));
typedef __bf16 bf16x2 __attribute__((ext_vector_type(2)));
typedef float f32x4 __attribute__((ext_vector_type(4)));
typedef float f32x16 __attribute__((ext_vector_type(16)));
typedef unsigned u32x4 __attribute__((ext_vector_type(4)));
typedef unsigned u32x2 __attribute__((ext_vector_type(2)));

constexpr int SEQ = 4096, T = 8 * SEQ, D = 1024, NIN = 2560;
constexpr float EPS = 1e-6f;
constexpr float LOG2E = 1.4426950408889634f;

constexpr size_t MiB = 1u << 20;
constexpr size_t WS_WIN = 0, WS_WOUT = 5 * MiB, WS_WQ = 7 * MiB, WS_K1 = 9 * MiB, WS_K2 = 9 * MiB + 131072, WS_SSQ = 10 * MiB;
constexpr size_t WS_CTL = 11 * MiB;
constexpr size_t WS_U16 = 12 * MiB, WS_V16 = 44 * MiB;
constexpr size_t WS_Q = 76 * MiB, WS_K = 108 * MiB, WS_VT = 140 * MiB, WS_HG = 172 * MiB, WS_MIX = 204 * MiB;
constexpr size_t WS_XN2 = 76 * MiB, WS_PIDX = 140 * MiB, WS_PG = 156 * MiB;
constexpr size_t WS_END = 268 * MiB;

struct Params {
  const float *x, *norm_mix_g, *w_in, *q_norm_g, *k_norm_g, *attn_out_g, *conv_w, *conv_b, *conv_ln_g, *conv_ln_b,
      *w_out, *norm_ffn_g, *peer_wq, *peer_k1, *peer_k2, *peer_u, *peer_v;
  float* out;
  unsigned char* ws;
};

constexpr int NTHREADS = 256;
constexpr int CPITCH = 132;
constexpr int LDS_RS = 67584, LDS_RS2 = LDS_RS + 512, LDS_BAR = LDS_RS2 + 512, LDS_BYTES = LDS_BAR + 16;

__device__ __forceinline__ unsigned pk2(float lo, float hi) {
  bf16x2 v = {(__bf16)lo, (__bf16)hi};
  return __builtin_bit_cast(unsigned, v);
}
__device__ __forceinline__ float bflo(unsigned u) { return __uint_as_float(u << 16); }
__device__ __forceinline__ float bfhi(unsigned u) { return __uint_as_float(u & 0xffff0000u); }
__device__ __forceinline__ float dot2(unsigned a, unsigned b, float c) {
  return __builtin_amdgcn_fdot2_f32_bf16(__builtin_bit_cast(bf16x2, a), __builtin_bit_cast(bf16x2, b), c, false);
}
__device__ __forceinline__ int vblock() {
  const int G = gridDim.x, b = blockIdx.x;
  return (G % 8 == 0) ? (b % 8) * (G / 8) + b / 8 : b;
}
__device__ __forceinline__ f32x16 mfma32(bf16x8 a, bf16x8 b, f32x16 c) { return __builtin_amdgcn_mfma_f32_32x32x16_bf16(a, b, c, 0, 0, 0); }
__device__ __forceinline__ f32x4 mfma16(bf16x8 a, bf16x8 b, f32x4 c) { return __builtin_amdgcn_mfma_f32_16x16x32_bf16(a, b, c, 0, 0, 0); }

__device__ __forceinline__ void transpose_items(const float* __restrict__ W, int N, bf16_t* __restrict__ Wt, const float* __restrict__ g, int glimit,
                                                int mode, long gtid, long nthr) {
  const long nitems = (long)N * 128;
  for (long it = gtid; it < nitems; it += nthr) {
    const int n = (int)(it % N), kc = (int)(it / N);
    int src = n;
    if (mode == 1 && n >= 1536) {
      const int r = n - 1536, j = r >> 7, rr = r & 127;
      src = rr < 64 ? 1536 + 64 * j + rr : 2048 + 64 * j + (rr - 64);
    }
    float v[8];
#pragma unroll
    for (int i = 0; i < 8; ++i) {
      const int k = kc * 8 + i;
      float w = W[(size_t)k * N + src];
      if (k < glimit) w *= g[k];
      v[i] = w;
    }
    u32x4 o = {pk2(v[0], v[1]), pk2(v[2], v[3]), pk2(v[4], v[5]), pk2(v[6], v[7])};
    *(u32x4*)(Wt + (size_t)n * 1024 + kc * 8) = o;
  }
}
__device__ __forceinline__ void convert_items(const float* __restrict__ src, bf16_t* __restrict__ dst, long n8, long gtid, long nthr) {
  for (long it = gtid; it < n8; it += nthr) {
    const f32x4 a = *(const f32x4*)(src + it * 8), b = *(const f32x4*)(src + it * 8 + 4);
    u32x4 o = {pk2(a.x, a.y), pk2(a.z, a.w), pk2(b.x, b.y), pk2(b.z, b.w)};
    *(u32x4*)(dst + it * 8) = o;
  }
}
__device__ void phase_prep(const Params& p) {
  const long gtid = (long)vblock() * NTHREADS + threadIdx.x, nthr = (long)gridDim.x * NTHREADS;
  unsigned char* ws = p.ws;
  transpose_items(p.w_in, NIN, (bf16_t*)(ws + WS_WIN), p.norm_mix_g, 1024, 1, gtid, nthr);
  transpose_items(p.w_out, D, (bf16_t*)(ws + WS_WOUT), p.attn_out_g, 512, 0, gtid, nthr);
  transpose_items(p.peer_wq, D, (bf16_t*)(ws + WS_WQ), p.norm_ffn_g, 1024, 0, gtid, nthr);
  convert_items(p.peer_k1, (bf16_t*)(ws + WS_K1), 65536 / 8, gtid, nthr);
  convert_items(p.peer_k2, (bf16_t*)(ws + WS_K2), 65536 / 8, gtid, nthr);
  convert_items(p.peer_u, (bf16_t*)(ws + WS_U16), (long)16384 * 1024 / 8, gtid, nthr);
  convert_items(p.peer_v, (bf16_t*)(ws + WS_V16), (long)16384 * 1024 / 8, gtid, nthr);
}

template <bool AF32, bool MID>
__device__ __forceinline__ void gemm_mainloop(const float* __restrict__ Af, const bf16_t* __restrict__ Ab, const bf16_t* __restrict__ Bt,
                                              int m0, int n0, char* smem, f32x4 (&acc)[4][4]) {
  const int tid = threadIdx.x, lane = tid & 63, wave = tid >> 6, wm = wave >> 1, wn = wave & 1;
  const int lrow = tid >> 3, lchunk = tid & 7;
  const int woff = lrow * 128 + ((lchunk ^ ((lrow >> 1) & 7)) << 4);
  float ss[4] = {0.f, 0.f, 0.f, 0.f};
  f32x4 ra[4][2];
  u32x4 rab[4], rb[4];
#pragma unroll
  for (int i = 0; i < 4; ++i)
#pragma unroll
    for (int j = 0; j < 4; ++j) acc[i][j] = (f32x4){0.f, 0.f, 0.f, 0.f};

  const float* ap = Af + (size_t)(m0 + lrow) * 1024 + lchunk * 8;
  const bf16_t* abp = Ab + (size_t)(m0 + lrow) * 1024 + lchunk * 8;
  const bf16_t* bp = Bt + (size_t)(n0 + lrow) * 1024 + lchunk * 8;

#define G_LOAD(kt)                                                                    \
  {                                                                                   \
    _Pragma("unroll") for (int j = 0; j < 4; ++j) {                                   \
      if (AF32) {                                                                     \
        ra[j][0] = *(const f32x4*)(ap + (size_t)j * 32 * 1024 + (kt) * 64);           \
        ra[j][1] = *(const f32x4*)(ap + (size_t)j * 32 * 1024 + (kt) * 64 + 4);       \
      } else {                                                                        \
        rab[j] = *(const u32x4*)(abp + (size_t)j * 32 * 1024 + (kt) * 64);            \
      }                                                                               \
      rb[j] = *(const u32x4*)(bp + (size_t)j * 32 * 1024 + (kt) * 64);                \
    }                                                                                 \
  }
#define G_WRITE(stage)                                                                                   \
  {                                                                                                      \
    char* sa = smem + (stage) * 32768 + woff;                                                            \
    _Pragma("unroll") for (int j = 0; j < 4; ++j) {                                                      \
      u32x4 av;                                                                                          \
      if (AF32) {                                                                                        \
        const f32x4 a0 = ra[j][0], a1 = ra[j][1];                                                        \
        ss[j] += a0.x * a0.x + a0.y * a0.y + a0.z * a0.z + a0.w * a0.w + a1.x * a1.x + a1.y * a1.y +     \
                 a1.z * a1.z + a1.w * a1.w;                                                              \
        av = (u32x4){pk2(a0.x, a0.y), pk2(a0.z, a0.w), pk2(a1.x, a1.y), pk2(a1.z, a1.w)};                \
      } else {                                                                                           \
        av = rab[j];                                                                                     \
      }                                                                                                  \
      *(u32x4*)(sa + j * 4096) = av;                                                                     \
      *(u32x4*)(sa + 16384 + j * 4096) = rb[j];                                                          \
    }                                                                                                    \
  }

  G_LOAD(0);
  G_WRITE(0);
  __syncthreads();
  const int sw = (lane & 15) >> 1;
  const int arow = (wm * 64 + (lane & 15)) * 128, brow = (wn * 64 + (lane & 15)) * 128;
  const int kq = lane >> 4;
  for (int kt = 0; kt < 16; ++kt) {
    if (kt + 1 < 16) G_LOAD(kt + 1);
    if (MID && kt == 8) {
      const float* rs2 = (const float*)(smem + LDS_RS2);
#pragma unroll
      for (int i = 0; i < 4; ++i) {
        const f32x4 r = *(const f32x4*)(rs2 + wm * 64 + i * 16 + (lane >> 4) * 4);
#pragma unroll
        for (int j = 0; j < 4; ++j) acc[i][j] *= r;
      }
    }
    const char* sb = smem + (kt & 1) * 32768;
#pragma unroll
    for (int kk = 0; kk < 2; ++kk) {
      bf16x8 af[4], bfr[4];
      const int co = ((kk * 4 + kq) ^ sw) << 4;
#pragma unroll
      for (int i = 0; i < 4; ++i) af[i] = *(const bf16x8*)(sb + arow + i * 2048 + co);
#pragma unroll
      for (int j = 0; j < 4; ++j) bfr[j] = *(const bf16x8*)(sb + 16384 + brow + j * 2048 + co);
#pragma unroll
      for (int i = 0; i < 4; ++i)
#pragma unroll
        for (int j = 0; j < 4; ++j) acc[i][j] = mfma16(af[i], bfr[j], acc[i][j]);
    }
    if (kt + 1 < 16) G_WRITE((kt + 1) & 1);
    __syncthreads();
  }
#undef G_LOAD
#undef G_WRITE
  if (AF32) {
    float* rs = (float*)(smem + LDS_RS);
#pragma unroll
    for (int j = 0; j < 4; ++j) {
      float s = ss[j];
      s += __shfl_xor(s, 1);
      s += __shfl_xor(s, 2);
      s += __shfl_xor(s, 4);
      if (lchunk == 0) rs[lrow + 32 * j] = rsqrtf(s * (1.f / 1024.f) + EPS);
    }
  }
  float* Cs = (float*)smem;
#pragma unroll
  for (int i = 0; i < 4; ++i)
#pragma unroll
    for (int j = 0; j < 4; ++j)
#pragma unroll
      for (int r = 0; r < 4; ++r)
        Cs[(wm * 64 + i * 16 + (lane >> 4) * 4 + r) * CPITCH + wn * 64 + j * 16 + (lane & 15)] = acc[i][j][r];
  __syncthreads();
}

__device__ void phase_inproj(const Params& p, char* smem) {
  unsigned char* ws = p.ws;
  const bf16_t* Wt = (const bf16_t*)(ws + WS_WIN);
  bf16_t* Qo = (bf16_t*)(ws + WS_Q);
  bf16_t* Ko = (bf16_t*)(ws + WS_K);
  bf16_t* Vt = (bf16_t*)(ws + WS_VT);
  bf16_t* HG = (bf16_t*)(ws + WS_HG);
  const int tid = threadIdx.x;
  const int ntiles = 256 * 20, per = (ntiles + gridDim.x - 1) / gridDim.x;
  const int vb = vblock();
  const float* Cs = (const float*)smem;
  const float* rs = (const float*)(smem + LDS_RS);
  for (int tile = vb * per; tile < min((vb + 1) * per, ntiles); ++tile) {
    const int mt = tile / 20, nt = tile % 20, m0 = mt * 128;
    f32x4 acc[4][4];
    gemm_mainloop<true, false>(p.x, nullptr, Wt, m0, nt * 128, smem, acc);
    if (nt < 8) {
      const int tok = tid & 127, hh = tid >> 7, t = m0 + tok, b = t >> 12, s = t & 4095;
      const int head = (nt & 3) * 2 + hh;
      const float* row = Cs + tok * CPITCH + hh * 64;
      f32x4 v[16];
      float ssq = 0.f;
#pragma unroll
      for (int i = 0; i < 16; ++i) {
        v[i] = *(const f32x4*)(row + i * 4);
        ssq += v[i].x * v[i].x + v[i].y * v[i].y + v[i].z * v[i].z + v[i].w * v[i].w;
      }
      const float r = rs[tok];
      float sc = r * rsqrtf(r * r * ssq * (1.f / 64.f) + EPS);
      const float* g = (nt < 4) ? p.q_norm_g : p.k_norm_g;
      if (nt < 4) sc *= 0.125f * LOG2E;
      bf16_t* dst = ((nt < 4) ? Qo : Ko) + ((size_t)(b * 8 + head) * 4096 + s) * 64;
#pragma unroll
      for (int i = 0; i < 8; ++i) {
        const f32x4 g0 = *(const f32x4*)(g + i * 8), g1 = *(const f32x4*)(g + i * 8 + 4);
        const f32x4 a = v[2 * i], c = v[2 * i + 1];
        u32x4 o = {pk2(a.x * sc * g0.x, a.y * sc * g0.y), pk2(a.z * sc * g0.z, a.w * sc * g0.w),
                   pk2(c.x * sc * g1.x, c.y * sc * g1.y), pk2(c.z * sc * g1.z, c.w * sc * g1.w)};
        *(u32x4*)(dst + i * 8) = o;
      }
    } else if (nt < 12) {
#pragma unroll
      for (int it = 0; it < 2; ++it) {
        const int item = tid + 256 * it, d = item & 63, kb = (item >> 6) & 3, hh = item >> 8;
        const int head = (nt - 8) * 2 + hh, t0 = m0 + kb * 32, b = t0 >> 12, kblk = (t0 & 4095) >> 5;
        unsigned o[16];
#pragma unroll
        for (int pp = 0; pp < 16; ++pp) {
          float val[2];
#pragma unroll
          for (int e = 0; e < 2; ++e) {
            const int pos = pp * 2 + e, sI = pos >> 4, h = (pos >> 3) & 1, j = pos & 7;
            const int key = 16 * sI + 8 * (j >> 2) + 4 * h + (j & 3);
            val[e] = Cs[(kb * 32 + key) * CPITCH + hh * 64 + d] * rs[kb * 32 + key];
          }
          o[pp] = pk2(val[0], val[1]);
        }
        bf16_t* dst = Vt + ((((size_t)(b * 8 + head) * 128 + kblk) * 64 + d) * 32);
#pragma unroll
        for (int q = 0; q < 4; ++q) *(u32x4*)(dst + q * 8) = (u32x4){o[4 * q], o[4 * q + 1], o[4 * q + 2], o[4 * q + 3]};
      }
    } else {
      const int jc = nt - 12;
#pragma unroll
      for (int it = 0; it < 4; ++it) {
        const int item = tid + 256 * it, c8 = item & 7, tok = item >> 3;
        const float* row = Cs + tok * CPITCH + c8 * 8;
        const float r = rs[tok];
        const f32x4 a0 = *(const f32x4*)(row), a1 = *(const f32x4*)(row + 4), g0 = *(const f32x4*)(row + 64), g1 = *(const f32x4*)(row + 68);
        float h[8];
#define GLU(a, g) ((a) * r / (1.f + __expf(-(g) * r)))
        h[0] = GLU(a0.x, g0.x); h[1] = GLU(a0.y, g0.y); h[2] = GLU(a0.z, g0.z); h[3] = GLU(a0.w, g0.w);
        h[4] = GLU(a1.x, g1.x); h[5] = GLU(a1.y, g1.y); h[6] = GLU(a1.z, g1.z); h[7] = GLU(a1.w, g1.w);
#undef GLU
        *(u32x4*)(HG + (size_t)(m0 + tok) * 512 + jc * 64 + c8 * 8) = (u32x4){pk2(h[0], h[1]), pk2(h[2], h[3]), pk2(h[4], h[5]), pk2(h[6], h[7])};
      }
    }
    __syncthreads();
  }
}

__device__ void conv_item(const Params& p, int item, char* smem) {
  unsigned char* ws = p.ws;
  const bf16_t* HG = (const bf16_t*)(ws + WS_HG);
  bf16_t* MIX = (bf16_t*)(ws + WS_MIX);
  const int tid = threadIdx.x, lane = tid & 63, wave = tid >> 6;
  const int t0 = item * 32, s0 = t0 & 4095;
  for (int idx = tid; idx < 62 * 64; idx += 256) {
    const int r = idx >> 6, c16 = idx & 63;
    u32x4 v = {0u, 0u, 0u, 0u};
    if (s0 - 30 + r >= 0) v = *(const u32x4*)(HG + (size_t)(t0 - 30 + r) * 512 + c16 * 8);
    *(u32x4*)(smem + r * 1024 + c16 * 16) = v;
  }
  float w0[31], w1[31];
#pragma unroll
  for (int j = 0; j < 31; ++j) {
    const float2 w = *(const float2*)(p.conv_w + j * 512 + 2 * tid);
    w0[j] = w.x;
    w1[j] = w.y;
  }
  const float2 cb = *(const float2*)(p.conv_b + 2 * tid);
  const float2 lg = *(const float2*)(p.conv_ln_g + 2 * tid);
  const float2 lb = *(const float2*)(p.conv_ln_b + 2 * tid);
  float* red = (float*)(smem + 62 * 1024);
  __syncthreads();
  for (int tt = 0; tt < 32; ++tt) {
    float a0 = cb.x, a1 = cb.y;
#pragma unroll
    for (int j = 0; j < 31; ++j) {
      const unsigned v = *(const unsigned*)(smem + (tt + j) * 1024 + tid * 4);
      a0 += w0[j] * bflo(v);
      a1 += w1[j] * bfhi(v);
    }
    float s1 = a0 + a1, s2 = a0 * a0 + a1 * a1;
#pragma unroll
    for (int o = 1; o < 64; o <<= 1) {
      s1 += __shfl_xor(s1, o);
      s2 += __shfl_xor(s2, o);
    }
    float* rr = red + (tt & 1) * 8;
    if (lane == 0) {
      rr[wave * 2] = s1;
      rr[wave * 2 + 1] = s2;
    }
    __syncthreads();
    const float S1 = rr[0] + rr[2] + rr[4] + rr[6], S2 = rr[1] + rr[3] + rr[5] + rr[7];
    const float mu = S1 * (1.f / 512.f);
    const float var = fmaxf(S2 * (1.f / 512.f) - mu * mu, 0.f);
    const float rstd = rsqrtf(var + EPS);
    const float y0 = (a0 - mu) * rstd * lg.x + lb.x, y1 = (a1 - mu) * rstd * lg.y + lb.y;
    const float z0 = y0 / (1.f + __expf(-y0)), z1 = y1 / (1.f + __expf(-y1));
    *(unsigned*)(MIX + (size_t)(t0 + tt) * 1024 + 512 + 2 * tid) = pk2(z0, z1);
  }
  __syncthreads();
}

__device__ void attn_item(const Params& p, int item, int lane) {
  unsigned char* ws = p.ws;
  const bf16_t* Qm = (const bf16_t*)(ws + WS_Q);
  const bf16_t* Km = (const bf16_t*)(ws + WS_K);
  const bf16_t* Vt = (const bf16_t*)(ws + WS_VT);
  bf16_t* MIX = (bf16_t*)(ws + WS_MIX);
  float* SSQ = (float*)(ws + WS_SSQ);
  const int qt = item & 127, bh = item >> 7;
  const int tok = lane & 31, hf = lane >> 5;
  bf16x8 qf[4];
  {
    const bf16_t* qp = Qm + ((size_t)bh * 4096 + qt * 32 + tok) * 64 + 8 * hf;
#pragma unroll
    for (int ks = 0; ks < 4; ++ks) qf[ks] = *(const bf16x8*)(qp + ks * 16);
  }
  f32x16 o0, o1;
#pragma unroll
  for (int i = 0; i < 16; ++i) { o0[i] = 0.f; o1[i] = 0.f; }
  float c = 0.f;
  for (int kb = qt; kb >= 0; --kb) {
    const bf16_t* kp = Km + ((size_t)bh * 4096 + kb * 32 + tok) * 64 + 8 * hf;
    bf16x8 kf[4];
#pragma unroll
    for (int ks = 0; ks < 4; ++ks) kf[ks] = *(const bf16x8*)(kp + ks * 16);
    const bf16_t* vp = Vt + (((size_t)bh * 128 + kb) * 64 + tok) * 32 + hf * 8;
    bf16x8 vf[2][2];
#pragma unroll
    for (int m = 0; m < 2; ++m)
#pragma unroll
      for (int s = 0; s < 2; ++s) vf[m][s] = *(const bf16x8*)(vp + m * 1024 + s * 16);
    f32x16 sc;
#pragma unroll
    for (int i = 0; i < 16; ++i) sc[i] = 0.f;
#pragma unroll
    for (int ks = 0; ks < 4; ++ks) sc = mfma32(kf[ks], qf[ks], sc);
    const bool diag = (kb == qt);
    float lk[16], zs[16];
#pragma unroll
    for (int i = 0; i < 16; ++i) {
      const float zl = sc[i];
      const float e = __builtin_amdgcn_exp2f(zl);
      const float sp = __builtin_amdgcn_logf(1.f + e);
      const bool valid = !diag || ((i & 3) + 8 * (i >> 2) + 4 * hf < tok);
      lk[i] = valid ? -sp : 0.f;
      zs[i] = valid ? zl - sp : -1e30f;
    }
    float Tg[4], Pg[4];
#pragma unroll
    for (int g = 0; g < 4; ++g) {
      Tg[g] = (lk[4 * g] + lk[4 * g + 1]) + (lk[4 * g + 2] + lk[4 * g + 3]);
      Pg[g] = __shfl_xor(Tg[g], 32);
    }
    float base[4];
    float run = 0.f;
#pragma unroll
    for (int g = 3; g >= 0; --g) {
      base[g] = c + run + (hf == 0 ? Pg[g] : 0.f);
      run += Tg[g] + Pg[g];
    }
    float pr[16];
#pragma unroll
    for (int g = 0; g < 4; ++g) {
      float l = base[g];
#pragma unroll
      for (int r = 3; r >= 0; --r) {
        pr[4 * g + r] = __builtin_amdgcn_exp2f(zs[4 * g + r] + l);
        l += lk[4 * g + r];
      }
    }
    c += run;
    bf16x8 pf[2];
#pragma unroll
    for (int s = 0; s < 2; ++s)
#pragma unroll
      for (int j = 0; j < 8; ++j) pf[s][j] = (__bf16)pr[8 * s + j];
#pragma unroll
    for (int s = 0; s < 2; ++s) {
      o0 = mfma32(vf[0][s], pf[s], o0);
      o1 = mfma32(vf[1][s], pf[s], o1);
    }
    if (__all(c < -150.f)) break;
  }
  const int t = (bh >> 3) * 4096 + qt * 32 + tok, hh = bh & 7;
  float ssq = 0.f;
#pragma unroll
  for (int i = 0; i < 16; ++i) ssq += o0[i] * o0[i] + o1[i] * o1[i];
  ssq += __shfl_xor(ssq, 32);
  if (hf == 0) SSQ[t * 8 + hh] = ssq;
  bf16_t* dst = MIX + (size_t)t * 1024 + hh * 64 + 4 * hf;
#pragma unroll
  for (int g = 0; g < 4; ++g) {
    *(u32x2*)(dst + 8 * g) = (u32x2){pk2(o0[4 * g], o0[4 * g + 1]), pk2(o0[4 * g + 2], o0[4 * g + 3])};
    *(u32x2*)(dst + 32 + 8 * g) = (u32x2){pk2(o1[4 * g], o1[4 * g + 1]), pk2(o1[4 * g + 2], o1[4 * g + 3])};
  }
}

__device__ void phase_mix(const Params& p, char* smem) {
  const int vb = vblock(), G = gridDim.x;
  for (int item = vb; item < 1024; item += G) conv_item(p, item, smem);
  const int lane = threadIdx.x & 63, gw = vb * 4 + (threadIdx.x >> 6), nw = G * 4;
  for (int item = gw; item < 8192; item += nw) attn_item(p, item, lane);
}

__device__ void phase_outproj(const Params& p, char* smem) {
  unsigned char* ws = p.ws;
  const bf16_t* MIX = (const bf16_t*)(ws + WS_MIX);
  const bf16_t* Wt = (const bf16_t*)(ws + WS_WOUT);
  const float* SSQ = (const float*)(ws + WS_SSQ);
  const int tid = threadIdx.x;
  const int ntiles = 256 * 8, per = (ntiles + gridDim.x - 1) / gridDim.x;
  const int vb = vblock();
  const float* Cs = (const float*)smem;
  for (int tile = vb * per; tile < min((vb + 1) * per, ntiles); ++tile) {
    const int mt = tile >> 3, nt = tile & 7, m0 = mt * 128, n0 = nt * 128;
    if (tid < 128) {
      const f32x4 a = *(const f32x4*)(SSQ + (size_t)(m0 + tid) * 8), b = *(const f32x4*)(SSQ + (size_t)(m0 + tid) * 8 + 4);
      const float s = (a.x + a.y) + (a.z + a.w) + (b.x + b.y) + (b.z + b.w);
      ((float*)(smem + LDS_RS2))[tid] = rsqrtf(s * (1.f / 512.f) + EPS);
    }
    f32x4 acc[4][4];
    gemm_mainloop<false, true>(nullptr, MIX, Wt, m0, n0, smem, acc);
#pragma unroll
    for (int it = 0; it < 16; ++it) {
      const int item = tid + 256 * it, c4 = item & 31, tok = item >> 5;
      const f32x4 v = *(const f32x4*)(Cs + tok * CPITCH + c4 * 4);
      const size_t o = (size_t)(m0 + tok) * 1024 + n0 + c4 * 4;
      const f32x4 xr = *(const f32x4*)(p.x + o);
      *(f32x4*)(p.out + o) = xr + v;
    }
    __syncthreads();
  }
}

__device__ __forceinline__ unsigned f2key(float f, unsigned n) {
  const unsigned u = (__float_as_uint(f) & ~0x7Fu) | n;
  return u ^ ((unsigned)((int)u >> 31) | 0x80000000u);
}
__device__ __forceinline__ unsigned f2key_raw(float f) {
  const unsigned u = __float_as_uint(f);
  return u ^ ((unsigned)((int)u >> 31) | 0x80000000u);
}
__device__ __forceinline__ unsigned key2u(unsigned k) { return k ^ ((k >> 31) ? 0x80000000u : 0xFFFFFFFFu); }

template <int N>
__device__ __forceinline__ void bitonic_sort_desc(unsigned (&v)[N]) {
#pragma unroll
  for (int k = 2; k <= N; k <<= 1) {
#pragma unroll
    for (int j = k >> 1; j > 0; j >>= 1) {
#pragma unroll
      for (int i = 0; i < N; ++i) {
        const int l = i ^ j;
        if (l > i) {
          const bool desc = ((i & k) == 0);
          const unsigned mx = max(v[i], v[l]), mn = min(v[i], v[l]);
          v[i] = desc ? mx : mn;
          v[l] = desc ? mn : mx;
        }
      }
    }
  }
}
template <int N>
__device__ __forceinline__ void bitonic_merge_desc(unsigned (&v)[N]) {
#pragma unroll
  for (int j = N >> 1; j > 0; j >>= 1) {
#pragma unroll
    for (int i = 0; i < N; ++i) {
      const int l = i ^ j;
      if (l > i) {
        const unsigned mx = max(v[i], v[l]), mn = min(v[i], v[l]);
        v[i] = mx;
        v[l] = mn;
      }
    }
  }
}
__device__ __forceinline__ void merge_top16(unsigned (&a)[16], const unsigned (&b)[16]) {
#pragma unroll
  for (int i = 0; i < 16; ++i) a[i] = max(a[i], b[15 - i]);
  bitonic_merge_desc<16>(a);
}
#define CEP(ka, pa, kb, pb, desc)                                  \
  {                                                                \
    const bool sw_ = (desc) ? ((kb) > (ka)) : ((kb) < (ka));       \
    const unsigned tk_ = sw_ ? (kb) : (ka), tl_ = sw_ ? (ka) : (kb); \
    const unsigned tp_ = sw_ ? (pb) : (pa), tq_ = sw_ ? (pa) : (pb); \
    ka = tk_; kb = tl_; pa = tp_; pb = tq_;                        \
  }
template <int N>
__device__ __forceinline__ void bitonic_sort_desc_p(unsigned (&v)[N], unsigned (&pl)[N]) {
#pragma unroll
  for (int k = 2; k <= N; k <<= 1) {
#pragma unroll
    for (int j = k >> 1; j > 0; j >>= 1) {
#pragma unroll
      for (int i = 0; i < N; ++i) {
        const int l = i ^ j;
        if (l > i) {
          const bool desc = ((i & k) == 0);
          CEP(v[i], pl[i], v[l], pl[l], desc);
        }
      }
    }
  }
}
template <int N>
__device__ __forceinline__ void bitonic_merge_desc_p(unsigned (&v)[N], unsigned (&pl)[N]) {
#pragma unroll
  for (int j = N >> 1; j > 0; j >>= 1) {
#pragma unroll
    for (int i = 0; i < N; ++i) {
      const int l = i ^ j;
      if (l > i) { CEP(v[i], pl[i], v[l], pl[l], true); }
    }
  }
}
__device__ __forceinline__ void merge_top16_p(unsigned (&a)[16], unsigned (&pa)[16], const unsigned (&b)[16], const unsigned (&pb)[16]) {
#pragma unroll
  for (int i = 0; i < 16; ++i) {
    const bool s = b[15 - i] > a[i];
    a[i] = s ? b[15 - i] : a[i];
    pa[i] = s ? pb[15 - i] : pa[i];
  }
  bitonic_merge_desc_p<16>(a, pa);
}

__device__ __forceinline__ void subkey_top16(const bf16_t* __restrict__ Kb, const float* crow, float rsv, int lane, unsigned (&top)[16]) {
  const int tok = lane & 31, hf = lane >> 5;
  f32x16 acc[4];
#pragma unroll
  for (int m = 0; m < 4; ++m)
#pragma unroll
    for (int i = 0; i < 16; ++i) acc[m][i] = 0.f;
#pragma unroll
  for (int ks = 0; ks < 4; ++ks) {
    const f32x4 v0 = *(const f32x4*)(crow + ks * 16 + 8 * hf), v1 = *(const f32x4*)(crow + ks * 16 + 8 * hf + 4);
    bf16x8 bq;
    bq[0] = (__bf16)(v0.x * rsv); bq[1] = (__bf16)(v0.y * rsv); bq[2] = (__bf16)(v0.z * rsv); bq[3] = (__bf16)(v0.w * rsv);
    bq[4] = (__bf16)(v1.x * rsv); bq[5] = (__bf16)(v1.y * rsv); bq[6] = (__bf16)(v1.z * rsv); bq[7] = (__bf16)(v1.w * rsv);
#pragma unroll
    for (int m = 0; m < 4; ++m) {
      const bf16x8 ak = *(const bf16x8*)(Kb + (m * 32 + tok) * 64 + ks * 16 + 8 * hf);
      acc[m] = mfma32(ak, bq, acc[m]);
    }
  }
  unsigned g[4][16];
#pragma unroll
  for (int m = 0; m < 4; ++m) {
#pragma unroll
    for (int i = 0; i < 16; ++i) g[m][i] = f2key(acc[m][i], (unsigned)(m * 32 + (i & 3) + 8 * (i >> 2) + 4 * hf));
    bitonic_sort_desc<16>(g[m]);
  }
  merge_top16(g[0], g[1]);
  merge_top16(g[2], g[3]);
  merge_top16(g[0], g[2]);
  unsigned o[16];
#pragma unroll
  for (int i = 0; i < 16; ++i) o[i] = __shfl_xor(g[0][i], 32);
  merge_top16(g[0], o);
#pragma unroll
  for (int i = 0; i < 16; ++i) top[i] = g[0][i];
}

__device__ void phase_route(const Params& p, char* smem) {
  unsigned char* ws = p.ws;
  const bf16_t* Wt = (const bf16_t*)(ws + WS_WQ);
  const bf16_t* K1 = (const bf16_t*)(ws + WS_K1);
  const bf16_t* K2 = (const bf16_t*)(ws + WS_K2);
  bf16_t* XN2 = (bf16_t*)(ws + WS_XN2);
  unsigned* PIDX = (unsigned*)(ws + WS_PIDX);
  float* PG = (float*)(ws + WS_PG);
  const int tid = threadIdx.x, lane = tid & 63, wave = tid >> 6;
  const int ntiles = 256 * 8, per = (ntiles + gridDim.x - 1) / gridDim.x;
  const int vb = vblock();
  const float* Cs = (const float*)smem;
  const float* rs = (const float*)(smem + LDS_RS);
  for (int tile = vb * per; tile < min((vb + 1) * per, ntiles); ++tile) {
    const int mt = tile >> 3, hd = tile & 7, m0 = mt * 128;
    f32x4 acc[4][4];
    gemm_mainloop<true, false>(p.out, nullptr, Wt, m0, hd * 128, smem, acc);
    if (hd == 0) {
#pragma unroll 4
      for (int it = 0; it < 64; ++it) {
        const int item = tid + 256 * it, c8 = item & 127, tok = item >> 7;
        const float* src = p.out + (size_t)(m0 + tok) * 1024 + c8 * 8;
        const f32x4 a = *(const f32x4*)src, b = *(const f32x4*)(src + 4);
        const f32x4 g0 = *(const f32x4*)(p.norm_ffn_g + c8 * 8), g1 = *(const f32x4*)(p.norm_ffn_g + c8 * 8 + 4);
        const float r = rs[tok];
        *(u32x4*)(XN2 + (size_t)(m0 + tok) * 1024 + c8 * 8) =
            (u32x4){pk2(a.x * r * g0.x, a.y * r * g0.y), pk2(a.z * r * g0.z, a.w * r * g0.w), pk2(b.x * r * g1.x, b.y * r * g1.y), pk2(b.z * r * g1.z, b.w * r * g1.w)};
      }
    }
    const int tok = lane & 31, hf = lane >> 5, trow = wave * 32 + tok;
    const float rsv = rs[trow];
    unsigned top1[16], top2[16];
    subkey_top16(K1 + hd * 8192, Cs + trow * CPITCH, rsv, lane, top1);
    subkey_top16(K2 + hd * 8192, Cs + trow * CPITCH + 64, rsv, lane, top2);
    float fa[16], fb[16];
    unsigned ia[16], ib[16];
#pragma unroll
    for (int i = 0; i < 16; ++i) {
      const unsigned ua = key2u(hf ? top2[i] : top1[i]), ub = key2u(hf ? top1[i] : top2[i]);
      fa[i] = __uint_as_float(ua); ia[i] = ua & 0x7Fu;
      fb[i] = __uint_as_float(ub); ib[i] = ub & 0x7Fu;
    }
    unsigned ck[32], cp[32];
    {
      int n = 0;
#pragma unroll
      for (int i = 0; i < 4; ++i) {
#pragma unroll
        for (int j = i; j < 16; ++j) {
          if ((i + 1) * (j + 1) <= 16) {
            unsigned key = f2key_raw(fa[i] + fb[j]);
            if (i == j && hf) key = 0u;
            ck[n] = key;
            cp[n] = hf ? ((ib[j] << 7) | ia[i]) : ((ia[i] << 7) | ib[j]);
            ++n;
          }
        }
      }
#pragma unroll
      for (; n < 32; ++n) { ck[n] = 0u; cp[n] = 0u; }
    }
    unsigned k0[16], p0[16], k1[16], p1[16];
#pragma unroll
    for (int i = 0; i < 16; ++i) { k0[i] = ck[i]; p0[i] = cp[i]; k1[i] = ck[16 + i]; p1[i] = cp[16 + i]; }
    bitonic_sort_desc_p<16>(k0, p0);
    bitonic_sort_desc_p<16>(k1, p1);
    merge_top16_p(k0, p0, k1, p1);
#pragma unroll
    for (int i = 0; i < 16; ++i) { k1[i] = __shfl_xor(k0[i], 32); p1[i] = __shfl_xor(p0[i], 32); }
    merge_top16_p(k0, p0, k1, p1);
    float sv[16], sum = 0.f;
    const float mx = __uint_as_float(key2u(k0[0]));
#pragma unroll
    for (int i = 0; i < 16; ++i) {
      sv[i] = __builtin_amdgcn_exp2f((__uint_as_float(key2u(k0[i])) - mx) * LOG2E);
      sum += sv[i];
    }
    const float inv = 1.f / sum;
    const size_t po = ((size_t)(m0 + trow) * 8 + hd) * 16;
    if (hf == 0) {
#pragma unroll
      for (int q = 0; q < 4; ++q) *(u32x4*)(PIDX + po + 4 * q) = (u32x4){p0[4 * q], p0[4 * q + 1], p0[4 * q + 2], p0[4 * q + 3]};
    } else {
#pragma unroll
      for (int q = 0; q < 4; ++q) *(f32x4*)(PG + po + 4 * q) = (f32x4){sv[4 * q] * inv, sv[4 * q + 1] * inv, sv[4 * q + 2] * inv, sv[4 * q + 3] * inv};
    }
    __syncthreads();
  }
}

__device__ void phase_peer_u(const Params& p) {
  unsigned char* ws = p.ws;
  const bf16_t* U16 = (const bf16_t*)(ws + WS_U16);
  const bf16_t* XN2 = (const bf16_t*)(ws + WS_XN2);
  const unsigned* PIDX = (const unsigned*)(ws + WS_PIDX);
  float* PG = (float*)(ws + WS_PG);
  const int lane = threadIdx.x & 63, q = lane >> 4, c = lane & 15;
  const int gw = vblock() * 4 + (threadIdx.x >> 6), nw = gridDim.x * 4;
  for (int t = gw; t < T; t += nw) {
    u32x4 xr[8];
#pragma unroll
    for (int i = 0; i < 8; ++i) xr[i] = *(const u32x4*)(XN2 + (size_t)t * 1024 + (c + 16 * i) * 8);
#pragma unroll 2
    for (int sg = 0; sg < 32; ++sg) {
      const int slot = sg * 4 + q;
      const unsigned e = PIDX[(size_t)t * 128 + slot];
      const bf16_t* row = U16 + (size_t)e * 1024 + c * 8;
      u32x4 u[8];
#pragma unroll
      for (int i = 0; i < 8; ++i) u[i] = *(const u32x4*)(row + i * 128);
      float d0 = 0.f, d1 = 0.f;
#pragma unroll
      for (int i = 0; i < 8; ++i) {
        d0 = dot2(u[i].x, xr[i].x, d0);
        d1 = dot2(u[i].y, xr[i].y, d1);
        d0 = dot2(u[i].z, xr[i].z, d0);
        d1 = dot2(u[i].w, xr[i].w, d1);
      }
      float d = d0 + d1;
      d += __shfl_xor(d, 1);
      d += __shfl_xor(d, 2);
      d += __shfl_xor(d, 4);
      d += __shfl_xor(d, 8);
      if (c == 0) {
        const float g = PG[(size_t)t * 128 + slot];
        PG[(size_t)t * 128 + slot] = g * 0.5f * d * (1.f + erff(d * 0.70710678118654752f));
      }
    }
  }
}

__device__ void phase_peer_v(const Params& p) {
  unsigned char* ws = p.ws;
  const bf16_t* V16 = (const bf16_t*)(ws + WS_V16);
  const unsigned* PIDX = (const unsigned*)(ws + WS_PIDX);
  const float* PG = (const float*)(ws + WS_PG);
  const int lane = threadIdx.x & 63;
  const int gw = vblock() * 4 + (threadIdx.x >> 6), nw = gridDim.x * 4;
  for (int t = gw; t < T; t += nw) {
    const unsigned e0 = PIDX[(size_t)t * 128 + lane], e1 = PIDX[(size_t)t * 128 + 64 + lane];
    const float w0 = PG[(size_t)t * 128 + lane], w1 = PG[(size_t)t * 128 + 64 + lane];
    float acc[16];
#pragma unroll
    for (int i = 0; i < 16; ++i) acc[i] = 0.f;
#pragma unroll
    for (int half = 0; half < 2; ++half) {
      const unsigned ev = half ? e1 : e0;
      const float wv = half ? w1 : w0;
#pragma unroll 8
      for (int s = 0; s < 64; ++s) {
        const unsigned e = __shfl(ev, s);
        const float w = __shfl(wv, s);
        const bf16_t* row = V16 + (size_t)e * 1024 + lane * 8;
        const u32x4 a = *(const u32x4*)row, b = *(const u32x4*)(row + 512);
        acc[0] += w * bflo(a.x); acc[1] += w * bfhi(a.x); acc[2] += w * bflo(a.y); acc[3] += w * bfhi(a.y);
        acc[4] += w * bflo(a.z); acc[5] += w * bfhi(a.z); acc[6] += w * bflo(a.w); acc[7] += w * bfhi(a.w);
        acc[8] += w * bflo(b.x); acc[9] += w * bfhi(b.x); acc[10] += w * bflo(b.y); acc[11] += w * bfhi(b.y);
        acc[12] += w * bflo(b.z); acc[13] += w * bfhi(b.z); acc[14] += w * bflo(b.w); acc[15] += w * bfhi(b.w);
      }
    }
    float* o = p.out + (size_t)t * 1024 + lane * 8;
    f32x4 h0 = *(f32x4*)o, h1 = *(f32x4*)(o + 4), h2 = *(f32x4*)(o + 512), h3 = *(f32x4*)(o + 516);
    h0 += (f32x4){acc[0], acc[1], acc[2], acc[3]};
    h1 += (f32x4){acc[4], acc[5], acc[6], acc[7]};
    h2 += (f32x4){acc[8], acc[9], acc[10], acc[11]};
    h3 += (f32x4){acc[12], acc[13], acc[14], acc[15]};
    *(f32x4*)o = h0; *(f32x4*)(o + 4) = h1; *(f32x4*)(o + 512) = h2; *(f32x4*)(o + 516) = h3;
  }
}

#define XB_TMO      128
#define XB_XCNT(j)  (256  + 64 * (j))
#define XB_XSUB(j)  (1280 + 64 * (j))
#define XB_XGEN(j)  (2304 + 64 * (j))
#define XB_TOP      3328
#define XB_TOPGEN   3392
#define XCD_BAR_WORDS 3456
#define XB_SPIN_CAP (1u << 22)
#define LAS __attribute__((address_space(3)))
__device__ __forceinline__ unsigned xb_ld(unsigned* p)              { return __hip_atomic_load(p, __ATOMIC_RELAXED, __HIP_MEMORY_SCOPE_AGENT); }
__device__ __forceinline__ unsigned xb_add(unsigned* p, unsigned v) { return __hip_atomic_fetch_add(p, v, __ATOMIC_RELAXED, __HIP_MEMORY_SCOPE_AGENT); }
__device__ __forceinline__ unsigned xb_xcc_id() { return (unsigned)__builtin_amdgcn_s_getreg((3 << 11) | 20) & 0xFu; }
#define XB_SPIN(cond, bar) do { unsigned _sp = 0; while (cond) { __builtin_amdgcn_s_sleep(1); \
    if ((++_sp & 255u) == 0u) { if (xb_ld(&(bar)[XB_TMO])) break; if (_sp > XB_SPIN_CAP) { atomicAdd(&(bar)[XB_TMO], 1u); break; } } } } while (0)
struct XcdBarrier { unsigned* bar; unsigned x; volatile LAS unsigned* st; };
__device__ __forceinline__ XcdBarrier xcd_barrier_post(unsigned* bar, volatile LAS unsigned* st) {
    XcdBarrier b; b.bar = bar; b.x = xb_xcc_id(); b.st = st;
    if (threadIdx.x == 0) (void)xb_add(&bar[XB_XCNT(b.x)], 1u);
    return b;
}
__device__ __forceinline__ void xcd_barrier_complete(unsigned* bar, unsigned x, unsigned& nloc, unsigned& nx) {
    const unsigned G = gridDim.x * gridDim.y * gridDim.z;
    unsigned sum, cnt, mine, sp = 0u;
    for (;;) {
        sum = 0u; cnt = 0u; mine = 0u;
#pragma unroll
        for (unsigned j = 0; j < 16; ++j) { const unsigned c = xb_ld(&bar[XB_XCNT(j)]); sum += c; cnt += (c > 0u) ? 1u : 0u; mine = (j == x) ? c : mine; }
        if (sum == G) break;
        __builtin_amdgcn_s_sleep(1);
        if ((++sp & 255u) == 0u) { if (xb_ld(&bar[XB_TMO])) break; if (sp > XB_SPIN_CAP) { atomicAdd(&bar[XB_TMO], 1u); break; } }
    }
    nloc = mine > 0u ? mine : 1u; nx = cnt > 0u ? cnt : 1u;
}
__device__ __forceinline__ void xcd_barrier(const XcdBarrier& b) {
    asm volatile("s_waitcnt vmcnt(0)" ::: "memory");
    __syncthreads();
    if (threadIdx.x == 0) {
        unsigned* bar = b.bar;
        __builtin_amdgcn_s_waitcnt(0);
        unsigned nloc = b.st[0], nx = b.st[1];
        if (nloc == 0u) { xcd_barrier_complete(bar, b.x, nloc, nx); b.st[0] = nloc; b.st[1] = nx; }
        const unsigned old = xb_add(&bar[XB_XSUB(b.x)], 1u);
        const unsigned gen = old / nloc;
        if (old + 1u == (gen + 1u) * nloc) {
            __builtin_amdgcn_fence(__ATOMIC_RELEASE, "agent");
            asm volatile("s_waitcnt vmcnt(0)" ::: "memory");
            const unsigned og = xb_add(&bar[XB_TOP], 1u);
            const unsigned tg = og / nx;
            if (og + 1u == (tg + 1u) * nx) xb_add(&bar[XB_TOPGEN], 1u);
            else XB_SPIN(xb_ld(&bar[XB_TOPGEN]) == tg, bar);
            __builtin_amdgcn_fence(__ATOMIC_ACQUIRE, "agent");
            xb_add(&bar[XB_XGEN(b.x)], 1u);
            asm volatile("s_waitcnt vmcnt(0)" ::: "memory");
        } else {
            XB_SPIN(xb_ld(&bar[XB_XGEN(b.x)]) == gen, bar);
            __builtin_amdgcn_fence(__ATOMIC_ACQUIRE, "agent");
            asm volatile("s_waitcnt vmcnt(0)" ::: "memory");
        }
    }
    __syncthreads();
}

template <int PHASE>
__global__ void __launch_bounds__(NTHREADS, 2) k_phase(Params p) {
  __shared__ __attribute__((aligned(16))) char smem[LDS_BYTES];
  if (PHASE == 0) phase_prep(p);
  if (PHASE == 1) phase_inproj(p, smem);
  if (PHASE == 2) phase_mix(p, smem);
  if (PHASE == 3) phase_outproj(p, smem);
  if (PHASE == 4) phase_route(p, smem);
  if (PHASE == 5) phase_peer_u(p);
  if (PHASE == 6) phase_peer_v(p);
}

__global__ void __launch_bounds__(NTHREADS, 2) k_fused(Params p) {
  __shared__ __attribute__((aligned(16))) char smem[LDS_BYTES];
  if (threadIdx.x == 0) *(u32x4*)(smem + LDS_BAR) = (u32x4){0u, 0u, 0u, 0u};
  __syncthreads();
  const XcdBarrier bar = xcd_barrier_post((unsigned*)(p.ws + WS_CTL), (volatile LAS unsigned*)(smem + LDS_BAR));
  phase_prep(p);
  xcd_barrier(bar);
  phase_inproj(p, smem);
  xcd_barrier(bar);
  phase_mix(p, smem);
  xcd_barrier(bar);
  phase_outproj(p, smem);
  xcd_barrier(bar);
  phase_route(p, smem);
  xcd_barrier(bar);
  phase_peer_u(p);
  xcd_barrier(bar);
  phase_peer_v(p);
}

extern "C" void kernel_launch(void* const* d_in, const int* in_sizes, int n_in, void* d_out, int out_size, void* d_ws, size_t ws_size,
                              hipStream_t stream) {
  if (n_in != 17 || ws_size < WS_END) {
    fprintf(stderr, "kernel_launch: unexpected n_in %d / ws_size %zu\n", n_in, ws_size);
    return;
  }
  Params p{};
  p.x = (const float*)d_in[0]; p.norm_mix_g = (const float*)d_in[1]; p.w_in = (const float*)d_in[2]; p.q_norm_g = (const float*)d_in[3];
  p.k_norm_g = (const float*)d_in[4]; p.attn_out_g = (const float*)d_in[5]; p.conv_w = (const float*)d_in[6]; p.conv_b = (const float*)d_in[7];
  p.conv_ln_g = (const float*)d_in[8]; p.conv_ln_b = (const float*)d_in[9]; p.w_out = (const float*)d_in[10]; p.norm_ffn_g = (const float*)d_in[11];
  p.peer_wq = (const float*)d_in[12]; p.peer_k1 = (const float*)d_in[13]; p.peer_k2 = (const float*)d_in[14]; p.peer_u = (const float*)d_in[15];
  p.peer_v = (const float*)d_in[16];
  p.out = (float*)d_out;
  p.ws = (unsigned char*)d_ws;
#if FUSED
  static int grid_blocks = 0;
  if (!grid_blocks) {
    int dev = 0, cus = 0, per_cu = 0;
    (void)hipGetDevice(&dev);
    (void)hipDeviceGetAttribute(&cus, hipDeviceAttributeMultiprocessorCount, dev);
    (void)hipOccupancyMaxActiveBlocksPerMultiprocessor(&per_cu, k_fused, NTHREADS, 0);
    if (per_cu > 2) per_cu = 2;
    if (per_cu < 1) per_cu = 1;
    grid_blocks = cus * per_cu;
  }
  (void)hipMemsetAsync((char*)d_ws + WS_CTL, 0, XCD_BAR_WORDS * 4, stream);
  hipLaunchKernelGGL(k_fused, dim3(grid_blocks), dim3(NTHREADS), 0, stream, p);
#else
  const int G = 512;
  k_phase<0><<<G, NTHREADS, 0, stream>>>(p);
  k_phase<1><<<G, NTHREADS, 0, stream>>>(p);
  k_phase<2><<<G, NTHREADS, 0, stream>>>(p);
  k_phase<3><<<G, NTHREADS, 0, stream>>>(p);
  k_phase<4><<<G, NTHREADS, 0, stream>>>(p);
  k_phase<5><<<G, NTHREADS, 0, stream>>>(p);
  k_phase<6><<<G, NTHREADS, 0, stream>>>(p);
#endif
}
```

```cpp
#include <hip/hip_runtime.h>
#include <cstdio>

#ifndef FUSED
#define FUSED 1
#endif

#define LAS __attribute__((address_space(3)))
typedef unsigned short bf16_t;
typedef __bf16 bf16x8 __attribute__((ext_vector_type(8)));
typedef __bf16 bf16x2 __attribute__((ext_vector_type(2)));
typedef float f32x4 __attribute__((ext_vector_type(4)));
typedef float f32x16 __attribute__((ext_vector_type(16)));
typedef unsigned u32x4 __attribute__((ext_vector_type(4)));
typedef unsigned u32x2 __attribute__((ext_vector_type(2)));
typedef float f32x2 __attribute__((ext_vector_type(2)));

constexpr int SEQ = 4096, T = 8 * SEQ, D = 1024, NIN = 2560;
constexpr float EPS = 1e-6f;
constexpr float LOG2E = 1.4426950408889634f;

constexpr size_t MiB = 1u << 20;
constexpr size_t WS_WIN = 0, WS_WOUT = 5 * MiB, WS_WQ = 7 * MiB, WS_K1 = 9 * MiB, WS_K2 = 9 * MiB + 131072, WS_SSQ = 10 * MiB;
constexpr size_t WS_CTL = 11 * MiB;
constexpr size_t WS_US = 11 * MiB + 65536, WS_VS = 11 * MiB + 131072;
constexpr size_t WS_U8 = 12 * MiB, WS_V8 = 28 * MiB;
constexpr size_t WS_Q = 76 * MiB, WS_K = 108 * MiB, WS_VT = 140 * MiB, WS_HG = 172 * MiB, WS_MIX = 204 * MiB;
constexpr size_t WS_XN2 = 76 * MiB, WS_PIDX = 140 * MiB, WS_PG = 156 * MiB, WS_PW = 172 * MiB;
constexpr size_t WS_END = 268 * MiB;

struct Params {
  const float *x, *norm_mix_g, *w_in, *q_norm_g, *k_norm_g, *attn_out_g, *conv_w, *conv_b, *conv_ln_g, *conv_ln_b,
      *w_out, *norm_ffn_g, *peer_wq, *peer_k1, *peer_k2, *peer_u, *peer_v;
  float* out;
  unsigned char* ws;
};

constexpr int NTHREADS = 256;
constexpr int CPITCH = 132;
constexpr int LDS_RS = 67584, LDS_RS2 = LDS_RS + 512, LDS_BAR = LDS_RS2 + 512, LDS_BYTES = LDS_BAR + 16;

__device__ __forceinline__ unsigned pk2(float lo, float hi) {
  bf16x2 v = {(__bf16)lo, (__bf16)hi};
  return __builtin_bit_cast(unsigned, v);
}
__device__ __forceinline__ float bflo(unsigned u) { return __uint_as_float(u << 16); }
__device__ __forceinline__ float bfhi(unsigned u) { return __uint_as_float(u & 0xffff0000u); }
__device__ __forceinline__ float dot2(unsigned a, unsigned b, float c) {
  return __builtin_amdgcn_fdot2_f32_bf16(__builtin_bit_cast(bf16x2, a), __builtin_bit_cast(bf16x2, b), c, false);
}
__device__ __forceinline__ int otid() { int t = threadIdx.x; asm volatile("" : "+v"(t)); return t; }
__device__ __forceinline__ int vblock() {
  const int G = gridDim.x, b = blockIdx.x;
  return (G % 8 == 0) ? (b % 8) * (G / 8) + b / 8 : b;
}
__device__ __forceinline__ f32x16 mfma32(bf16x8 a, bf16x8 b, f32x16 c) { return __builtin_amdgcn_mfma_f32_32x32x16_bf16(a, b, c, 0, 0, 0); }
__device__ __forceinline__ f32x4 mfma16(bf16x8 a, bf16x8 b, f32x4 c) { return __builtin_amdgcn_mfma_f32_16x16x32_bf16(a, b, c, 0, 0, 0); }

__device__ __forceinline__ void transpose_items(const float* __restrict__ W, int N, bf16_t* __restrict__ Wt, const float* __restrict__ g, int glimit,
                                                int mode, long gtid, long nthr) {
  const long nitems = (long)N * 128;
  for (long it = gtid; it < nitems; it += nthr) {
    const int n = (int)(it % N), kc = (int)(it / N);
    int src = n;
    if (mode == 1 && n >= 1536) {
      const int r = n - 1536, j = r >> 7, rr = r & 127;
      src = rr < 64 ? 1536 + 64 * j + rr : 2048 + 64 * j + (rr - 64);
    }
    float v[8];
#pragma unroll
    for (int i = 0; i < 8; ++i) {
      const int k = kc * 8 + i;
      float w = W[(size_t)k * N + src];
      if (k < glimit) w *= g[k];
      v[i] = w;
    }
    u32x4 o = {pk2(v[0], v[1]), pk2(v[2], v[3]), pk2(v[4], v[5]), pk2(v[6], v[7])};
    *(u32x4*)(Wt + (size_t)n * 1024 + kc * 8) = o;
  }
}
__device__ __forceinline__ void convert_items(const float* __restrict__ src, bf16_t* __restrict__ dst, long n8, long gtid, long nthr) {
  for (long it = gtid; it < n8; it += nthr) {
    const f32x4 a = *(const f32x4*)(src + it * 8), b = *(const f32x4*)(src + it * 8 + 4);
    u32x4 o = {pk2(a.x, a.y), pk2(a.z, a.w), pk2(b.x, b.y), pk2(b.z, b.w)};
    *(u32x4*)(dst + it * 8) = o;
  }
}
__device__ void phase_prep(const Params& p) {
  const int tid0 = otid();
  const long gtid = (long)vblock() * NTHREADS + tid0, nthr = (long)gridDim.x * NTHREADS;
  unsigned char* ws = p.ws;
  transpose_items(p.w_in, NIN, (bf16_t*)(ws + WS_WIN), p.norm_mix_g, 1024, 1, gtid, nthr);
  transpose_items(p.w_out, D, (bf16_t*)(ws + WS_WOUT), p.attn_out_g, 512, 0, gtid, nthr);
  transpose_items(p.peer_wq, D, (bf16_t*)(ws + WS_WQ), p.norm_ffn_g, 1024, 0, gtid, nthr);
  convert_items(p.peer_k1, (bf16_t*)(ws + WS_K1), 65536 / 8, gtid, nthr);
  convert_items(p.peer_k2, (bf16_t*)(ws + WS_K2), 65536 / 8, gtid, nthr);
  {
    const int lane = tid0 & 63, gw = vblock() * 4 + (tid0 >> 6), nw = gridDim.x * 4;
    for (int r = gw; r < 32768; r += nw) {
      const int isv = r >> 14, e = r & 16383;
      const float* src = (isv ? p.peer_v : p.peer_u) + (size_t)e * 1024 + lane * 16;
      f32x4 v[4];
      float am = 0.f;
#pragma unroll
      for (int i = 0; i < 4; ++i) {
        v[i] = *(const f32x4*)(src + 4 * i);
        am = fmaxf(am, fmaxf(fmaxf(fabsf(v[i].x), fabsf(v[i].y)), fmaxf(fabsf(v[i].z), fabsf(v[i].w))));
      }
#pragma unroll
      for (int o = 1; o < 64; o <<= 1) am = fmaxf(am, __shfl_xor(am, o));
      const float scale = am > 0.f ? am * (1.f / 448.f) : 1.f, inv = am > 0.f ? 448.f / am : 0.f;
      u32x4 q;
#pragma unroll
      for (int i = 0; i < 4; ++i) {
        int w = 0;
        w = __builtin_amdgcn_cvt_pk_fp8_f32(v[i].x * inv, v[i].y * inv, w, false);
        w = __builtin_amdgcn_cvt_pk_fp8_f32(v[i].z * inv, v[i].w * inv, w, true);
        q[i] = (unsigned)w;
      }
      if (isv) {
        *(u32x4*)(ws + WS_V8 + ((size_t)(lane >> 3) * 16384 + e) * 128 + (lane & 7) * 16) = q;
        if (lane == 0) ((float*)(ws + WS_VS))[e] = scale;
      } else {
        *(u32x4*)(ws + WS_U8 + (size_t)e * 1024 + lane * 16) = q;
        if (lane == 0) ((float*)(ws + WS_US))[e] = scale;
      }
    }
  }
}

template <bool AF32, bool MID>
__device__ __forceinline__ void gemm_mainloop(const float* __restrict__ Af, const bf16_t* __restrict__ Ab, const bf16_t* __restrict__ Bt,
                                              int m0, int n0, char* smem, f32x4 (&acc)[4][4]) {
  const int tid = otid(), lane = tid & 63, wave = tid >> 6, wm = wave >> 1, wn = wave & 1;
  const int lrow = tid >> 3, lchunk = tid & 7;
  const int woff = lrow * 128 + ((lchunk ^ ((lrow >> 1) & 7)) << 4);
  float ss[4] = {0.f, 0.f, 0.f, 0.f};
  f32x4 ra[4][2];
  u32x4 rab[4], rb[4];
#pragma unroll
  for (int i = 0; i < 4; ++i)
#pragma unroll
    for (int j = 0; j < 4; ++j) acc[i][j] = (f32x4){0.f, 0.f, 0.f, 0.f};

  const float* ap = Af + (size_t)(m0 + lrow) * 1024 + lchunk * 8;
  const bf16_t* abp = Ab + (size_t)(m0 + lrow) * 1024 + lchunk * 8;
  const bf16_t* bp = Bt + (size_t)(n0 + lrow) * 1024 + lchunk * 8;

#define G_LOAD(kt)                                                                    \
  {                                                                                   \
    _Pragma("unroll") for (int j = 0; j < 4; ++j) {                                   \
      if (AF32) {                                                                     \
        ra[j][0] = *(const f32x4*)(ap + (size_t)j * 32 * 1024 + (kt) * 64);           \
        ra[j][1] = *(const f32x4*)(ap + (size_t)j * 32 * 1024 + (kt) * 64 + 4);       \
      } else {                                                                        \
        rab[j] = *(const u32x4*)(abp + (size_t)j * 32 * 1024 + (kt) * 64);            \
      }                                                                               \
      rb[j] = *(const u32x4*)(bp + (size_t)j * 32 * 1024 + (kt) * 64);                \
    }                                                                                 \
  }
#define G_WRITE(stage)                                                                                   \
  {                                                                                                      \
    char* sa = smem + (stage) * 32768 + woff;                                                            \
    _Pragma("unroll") for (int j = 0; j < 4; ++j) {                                                      \
      u32x4 av;                                                                                          \
      if (AF32) {                                                                                        \
        const f32x4 a0 = ra[j][0], a1 = ra[j][1];                                                        \
        ss[j] += a0.x * a0.x + a0.y * a0.y + a0.z * a0.z + a0.w * a0.w + a1.x * a1.x + a1.y * a1.y +     \
                 a1.z * a1.z + a1.w * a1.w;                                                              \
        av = (u32x4){pk2(a0.x, a0.y), pk2(a0.z, a0.w), pk2(a1.x, a1.y), pk2(a1.z, a1.w)};                \
      } else {                                                                                           \
        av = rab[j];                                                                                     \
      }                                                                                                  \
      *(u32x4*)(sa + j * 4096) = av;                                                                     \
      *(u32x4*)(sa + 16384 + j * 4096) = rb[j];                                                          \
    }                                                                                                    \
  }

  G_LOAD(0);
  G_WRITE(0);
  __syncthreads();
  const int sw = (lane & 15) >> 1;
  const int arow = (wm * 64 + (lane & 15)) * 128, brow = (wn * 64 + (lane & 15)) * 128;
  const int kq = lane >> 4;
  for (int kt = 0; kt < 16; ++kt) {
    if (kt + 1 < 16) G_LOAD(kt + 1);
    if (MID && kt == 8) {
      const float* rs2 = (const float*)(smem + LDS_RS2);
#pragma unroll
      for (int i = 0; i < 4; ++i) {
        const f32x4 r = *(const f32x4*)(rs2 + wm * 64 + i * 16 + (lane >> 4) * 4);
#pragma unroll
        for (int j = 0; j < 4; ++j) acc[i][j] *= r;
      }
    }
    const char* sb = smem + (kt & 1) * 32768;
#pragma unroll
    for (int kk = 0; kk < 2; ++kk) {
      bf16x8 af[4], bfr[4];
      const int co = ((kk * 4 + kq) ^ sw) << 4;
#pragma unroll
      for (int i = 0; i < 4; ++i) af[i] = *(const bf16x8*)(sb + arow + i * 2048 + co);
#pragma unroll
      for (int j = 0; j < 4; ++j) bfr[j] = *(const bf16x8*)(sb + 16384 + brow + j * 2048 + co);
#pragma unroll
      for (int i = 0; i < 4; ++i)
#pragma unroll
        for (int j = 0; j < 4; ++j) acc[i][j] = mfma16(af[i], bfr[j], acc[i][j]);
    }
    if (kt + 1 < 16) G_WRITE((kt + 1) & 1);
    __syncthreads();
  }
#undef G_LOAD
#undef G_WRITE
  if (AF32) {
    float* rs = (float*)(smem + LDS_RS);
#pragma unroll
    for (int j = 0; j < 4; ++j) {
      float s = ss[j];
      s += __shfl_xor(s, 1);
      s += __shfl_xor(s, 2);
      s += __shfl_xor(s, 4);
      if (lchunk == 0) rs[lrow + 32 * j] = rsqrtf(s * (1.f / 1024.f) + EPS);
    }
  }
  float* Cs = (float*)smem;
#pragma unroll
  for (int i = 0; i < 4; ++i)
#pragma unroll
    for (int j = 0; j < 4; ++j)
#pragma unroll
      for (int r = 0; r < 4; ++r)
        Cs[(wm * 64 + i * 16 + (lane >> 4) * 4 + r) * CPITCH + wn * 64 + j * 16 + (lane & 15)] = acc[i][j][r];
  __syncthreads();
}

__device__ void phase_inproj(const Params& p, char* smem) {
  unsigned char* ws = p.ws;
  const bf16_t* Wt = (const bf16_t*)(ws + WS_WIN);
  bf16_t* Qo = (bf16_t*)(ws + WS_Q);
  bf16_t* Ko = (bf16_t*)(ws + WS_K);
  bf16_t* Vt = (bf16_t*)(ws + WS_VT);
  bf16_t* HG = (bf16_t*)(ws + WS_HG);
  const int tid = otid();
  const int ntiles = 256 * 20, per = (ntiles + gridDim.x - 1) / gridDim.x;
  const int vb = vblock();
  const float* Cs = (const float*)smem;
  const float* rs = (const float*)(smem + LDS_RS);
  for (int tile = vb * per; tile < min((vb + 1) * per, ntiles); ++tile) {
    const int mt = tile / 20, nt = tile % 20, m0 = mt * 128;
    f32x4 acc[4][4];
    gemm_mainloop<true, false>(p.x, nullptr, Wt, m0, nt * 128, smem, acc);
    if (nt < 8) {
      const int tok = tid & 127, hh = tid >> 7, t = m0 + tok, b = t >> 12, s = t & 4095;
      const int head = (nt & 3) * 2 + hh;
      const float* row = Cs + tok * CPITCH + hh * 64;
      f32x4 v[16];
      float ssq = 0.f;
#pragma unroll
      for (int i = 0; i < 16; ++i) {
        v[i] = *(const f32x4*)(row + i * 4);
        ssq += v[i].x * v[i].x + v[i].y * v[i].y + v[i].z * v[i].z + v[i].w * v[i].w;
      }
      const float r = rs[tok];
      float sc = r * rsqrtf(r * r * ssq * (1.f / 64.f) + EPS);
      const float* g = (nt < 4) ? p.q_norm_g : p.k_norm_g;
      if (nt < 4) sc *= 0.125f * LOG2E;
      bf16_t* dst = ((nt < 4) ? Qo : Ko) + ((size_t)(b * 8 + head) * 4096 + s) * 64;
#pragma unroll
      for (int i = 0; i < 8; ++i) {
        const f32x4 g0 = *(const f32x4*)(g + i * 8), g1 = *(const f32x4*)(g + i * 8 + 4);
        const f32x4 a = v[2 * i], c = v[2 * i + 1];
        u32x4 o = {pk2(a.x * sc * g0.x, a.y * sc * g0.y), pk2(a.z * sc * g0.z, a.w * sc * g0.w),
                   pk2(c.x * sc * g1.x, c.y * sc * g1.y), pk2(c.z * sc * g1.z, c.w * sc * g1.w)};
        *(u32x4*)(dst + i * 8) = o;
      }
    } else if (nt < 12) {
#pragma unroll
      for (int it = 0; it < 2; ++it) {
        const int item = tid + 256 * it, d = item & 63, kb = (item >> 6) & 3, hh = item >> 8;
        const int head = (nt - 8) * 2 + hh, t0 = m0 + kb * 32, b = t0 >> 12, kblk = (t0 & 4095) >> 5;
        unsigned o[16];
#pragma unroll
        for (int pp = 0; pp < 16; ++pp) {
          float val[2];
#pragma unroll
          for (int e = 0; e < 2; ++e) {
            const int pos = pp * 2 + e, sI = pos >> 4, h = (pos >> 3) & 1, j = pos & 7;
            const int key = 16 * sI + 8 * (j >> 2) + 4 * h + (j & 3);
            val[e] = Cs[(kb * 32 + key) * CPITCH + hh * 64 + d] * rs[kb * 32 + key];
          }
          o[pp] = pk2(val[0], val[1]);
        }
        bf16_t* dst = Vt + ((((size_t)(b * 8 + head) * 128 + kblk) * 64 + d) * 32);
#pragma unroll
        for (int q = 0; q < 4; ++q) *(u32x4*)(dst + q * 8) = (u32x4){o[4 * q], o[4 * q + 1], o[4 * q + 2], o[4 * q + 3]};
      }
    } else {
      const int jc = nt - 12;
#pragma unroll
      for (int it = 0; it < 4; ++it) {
        const int item = tid + 256 * it, c8 = item & 7, tok = item >> 3;
        const float* row = Cs + tok * CPITCH + c8 * 8;
        const float r = rs[tok];
        const f32x4 a0 = *(const f32x4*)(row), a1 = *(const f32x4*)(row + 4), g0 = *(const f32x4*)(row + 64), g1 = *(const f32x4*)(row + 68);
        float h[8];
#define GLU(a, g) ((a) * r / (1.f + __expf(-(g) * r)))
        h[0] = GLU(a0.x, g0.x); h[1] = GLU(a0.y, g0.y); h[2] = GLU(a0.z, g0.z); h[3] = GLU(a0.w, g0.w);
        h[4] = GLU(a1.x, g1.x); h[5] = GLU(a1.y, g1.y); h[6] = GLU(a1.z, g1.z); h[7] = GLU(a1.w, g1.w);
#undef GLU
        *(u32x4*)(HG + (size_t)(m0 + tok) * 512 + jc * 64 + c8 * 8) = (u32x4){pk2(h[0], h[1]), pk2(h[2], h[3]), pk2(h[4], h[5]), pk2(h[6], h[7])};
      }
    }
    __syncthreads();
  }
}

__device__ void conv_item(const Params& p, int item, char* smem) {
  unsigned char* ws = p.ws;
  const bf16_t* HG = (const bf16_t*)(ws + WS_HG);
  bf16_t* MIX = (bf16_t*)(ws + WS_MIX);
  const int tid = otid(), lane = tid & 63, wave = tid >> 6;
  const int t0 = item * 32, s0 = t0 & 4095;
  for (int idx = tid; idx < 62 * 64; idx += 256) {
    const int r = idx >> 6, c16 = idx & 63;
    u32x4 v = {0u, 0u, 0u, 0u};
    if (s0 - 30 + r >= 0) v = *(const u32x4*)(HG + (size_t)(t0 - 30 + r) * 512 + c16 * 8);
    *(u32x4*)(smem + r * 1024 + c16 * 16) = v;
  }
  float w0[31], w1[31];
#pragma unroll
  for (int j = 0; j < 31; ++j) {
    const float2 w = *(const float2*)(p.conv_w + j * 512 + 2 * tid);
    w0[j] = w.x;
    w1[j] = w.y;
  }
  const float2 cb = *(const float2*)(p.conv_b + 2 * tid);
  const float2 lg = *(const float2*)(p.conv_ln_g + 2 * tid);
  const float2 lb = *(const float2*)(p.conv_ln_b + 2 * tid);
  float* red = (float*)(smem + 62 * 1024);
  __syncthreads();
  for (int tt = 0; tt < 32; ++tt) {
    float a0 = cb.x, a1 = cb.y;
#pragma unroll
    for (int j = 0; j < 31; ++j) {
      const unsigned v = *(const unsigned*)(smem + (tt + j) * 1024 + tid * 4);
      a0 += w0[j] * bflo(v);
      a1 += w1[j] * bfhi(v);
    }
    float s1 = a0 + a1, s2 = a0 * a0 + a1 * a1;
#pragma unroll
    for (int o = 1; o < 64; o <<= 1) {
      s1 += __shfl_xor(s1, o);
      s2 += __shfl_xor(s2, o);
    }
    float* rr = red + (tt & 1) * 8;
    if (lane == 0) {
      rr[wave * 2] = s1;
      rr[wave * 2 + 1] = s2;
    }
    __syncthreads();
    const float S1 = rr[0] + rr[2] + rr[4] + rr[6], S2 = rr[1] + rr[3] + rr[5] + rr[7];
    const float mu = S1 * (1.f / 512.f);
    const float var = fmaxf(S2 * (1.f / 512.f) - mu * mu, 0.f);
    const float rstd = rsqrtf(var + EPS);
    const float y0 = (a0 - mu) * rstd * lg.x + lb.x, y1 = (a1 - mu) * rstd * lg.y + lb.y;
    const float z0 = y0 / (1.f + __expf(-y0)), z1 = y1 / (1.f + __expf(-y1));
    *(unsigned*)(MIX + (size_t)(t0 + tt) * 1024 + 512 + 2 * tid) = pk2(z0, z1);
  }
  __syncthreads();
}

__device__ void attn_item(const Params& p, int item, int lane) {
  unsigned char* ws = p.ws;
  const bf16_t* Qm = (const bf16_t*)(ws + WS_Q);
  const bf16_t* Km = (const bf16_t*)(ws + WS_K);
  const bf16_t* Vt = (const bf16_t*)(ws + WS_VT);
  bf16_t* MIX = (bf16_t*)(ws + WS_MIX);
  float* SSQ = (float*)(ws + WS_SSQ);
  const int qt = item & 127, bh = item >> 7;
  const int tok = lane & 31, hf = lane >> 5;
  bf16x8 qf[4];
  {
    const bf16_t* qp = Qm + ((size_t)bh * 4096 + qt * 32 + tok) * 64 + 8 * hf;
#pragma unroll
    for (int ks = 0; ks < 4; ++ks) qf[ks] = *(const bf16x8*)(qp + ks * 16);
  }
  f32x16 o0, o1;
#pragma unroll
  for (int i = 0; i < 16; ++i) { o0[i] = 0.f; o1[i] = 0.f; }
  float c = 0.f;
  for (int kb = qt; kb >= 0; --kb) {
    const bf16_t* kp = Km + ((size_t)bh * 4096 + kb * 32 + tok) * 64 + 8 * hf;
    bf16x8 kf[4];
#pragma unroll
    for (int ks = 0; ks < 4; ++ks) kf[ks] = *(const bf16x8*)(kp + ks * 16);
    const bf16_t* vp = Vt + (((size_t)bh * 128 + kb) * 64 + tok) * 32 + hf * 8;
    bf16x8 vf[2][2];
#pragma unroll
    for (int m = 0; m < 2; ++m)
#pragma unroll
      for (int s = 0; s < 2; ++s) vf[m][s] = *(const bf16x8*)(vp + m * 1024 + s * 16);
    f32x16 sc;
#pragma unroll
    for (int i = 0; i < 16; ++i) sc[i] = 0.f;
#pragma unroll
    for (int ks = 0; ks < 4; ++ks) sc = mfma32(kf[ks], qf[ks], sc);
    const bool diag = (kb == qt);
    float lk[16], zs[16];
#pragma unroll
    for (int i = 0; i < 16; ++i) {
      const float zl = sc[i];
      const float e = __builtin_amdgcn_exp2f(zl);
      const float sp = __builtin_amdgcn_logf(1.f + e);
      const bool valid = !diag || ((i & 3) + 8 * (i >> 2) + 4 * hf < tok);
      lk[i] = valid ? -sp : 0.f;
      zs[i] = valid ? zl - sp : -1e30f;
    }
    float Tg[4], Pg[4];
#pragma unroll
    for (int g = 0; g < 4; ++g) {
      Tg[g] = (lk[4 * g] + lk[4 * g + 1]) + (lk[4 * g + 2] + lk[4 * g + 3]);
      Pg[g] = __shfl_xor(Tg[g], 32);
    }
    float base[4];
    float run = 0.f;
#pragma unroll
    for (int g = 3; g >= 0; --g) {
      base[g] = c + run + (hf == 0 ? Pg[g] : 0.f);
      run += Tg[g] + Pg[g];
    }
    float pr[16];
#pragma unroll
    for (int g = 0; g < 4; ++g) {
      float l = base[g];
#pragma unroll
      for (int r = 3; r >= 0; --r) {
        pr[4 * g + r] = __builtin_amdgcn_exp2f(zs[4 * g + r] + l);
        l += lk[4 * g + r];
      }
    }
    c += run;
    bf16x8 pf[2];
#pragma unroll
    for (int s = 0; s < 2; ++s)
#pragma unroll
      for (int j = 0; j < 8; ++j) pf[s][j] = (__bf16)pr[8 * s + j];
#pragma unroll
    for (int s = 0; s < 2; ++s) {
      o0 = mfma32(vf[0][s], pf[s], o0);
      o1 = mfma32(vf[1][s], pf[s], o1);
    }
    if (__all(c < -150.f)) break;
  }
  const int t = (bh >> 3) * 4096 + qt * 32 + tok, hh = bh & 7;
  float ssq = 0.f;
#pragma unroll
  for (int i = 0; i < 16; ++i) ssq += o0[i] * o0[i] + o1[i] * o1[i];
  ssq += __shfl_xor(ssq, 32);
  if (hf == 0) SSQ[t * 8 + hh] = ssq;
  bf16_t* dst = MIX + (size_t)t * 1024 + hh * 64 + 4 * hf;
#pragma unroll
  for (int g = 0; g < 4; ++g) {
    *(u32x2*)(dst + 8 * g) = (u32x2){pk2(o0[4 * g], o0[4 * g + 1]), pk2(o0[4 * g + 2], o0[4 * g + 3])};
    *(u32x2*)(dst + 32 + 8 * g) = (u32x2){pk2(o1[4 * g], o1[4 * g + 1]), pk2(o1[4 * g + 2], o1[4 * g + 3])};
  }
}

__device__ void phase_mix(const Params& p, char* smem) {
  const int vb = vblock(), G = gridDim.x;
  for (int item = vb; item < 1024; item += G) conv_item(p, item, smem);
  const int tidm = otid();
  const int lane = tidm & 63, gw = vb * 4 + (tidm >> 6), nw = G * 4;
  for (int item = gw; item < 8192; item += nw) attn_item(p, item, lane);
}

__device__ void phase_outproj(const Params& p, char* smem) {
  unsigned char* ws = p.ws;
  const bf16_t* MIX = (const bf16_t*)(ws + WS_MIX);
  const bf16_t* Wt = (const bf16_t*)(ws + WS_WOUT);
  const float* SSQ = (const float*)(ws + WS_SSQ);
  const int tid = otid();
  const int ntiles = 256 * 8, per = (ntiles + gridDim.x - 1) / gridDim.x;
  const int vb = vblock();
  const float* Cs = (const float*)smem;
  for (int tile = vb * per; tile < min((vb + 1) * per, ntiles); ++tile) {
    const int mt = tile >> 3, nt = tile & 7, m0 = mt * 128, n0 = nt * 128;
    if (tid < 128) {
      const f32x4 a = *(const f32x4*)(SSQ + (size_t)(m0 + tid) * 8), b = *(const f32x4*)(SSQ + (size_t)(m0 + tid) * 8 + 4);
      const float s = (a.x + a.y) + (a.z + a.w) + (b.x + b.y) + (b.z + b.w);
      ((float*)(smem + LDS_RS2))[tid] = rsqrtf(s * (1.f / 512.f) + EPS);
    }
    f32x4 acc[4][4];
    gemm_mainloop<false, true>(nullptr, MIX, Wt, m0, n0, smem, acc);
#pragma unroll
    for (int it = 0; it < 16; ++it) {
      const int item = tid + 256 * it, c4 = item & 31, tok = item >> 5;
      const f32x4 v = *(const f32x4*)(Cs + tok * CPITCH + c4 * 4);
      const size_t o = (size_t)(m0 + tok) * 1024 + n0 + c4 * 4;
      const f32x4 xr = *(const f32x4*)(p.x + o);
      *(f32x4*)(p.out + o) = xr + v;
    }
    __syncthreads();
  }
}

__device__ __forceinline__ unsigned f2key(float f, unsigned n) {
  const unsigned u = (__float_as_uint(f) & ~0x7Fu) | n;
  return u ^ ((unsigned)((int)u >> 31) | 0x80000000u);
}
__device__ __forceinline__ unsigned f2key_raw(float f) {
  const unsigned u = __float_as_uint(f);
  return u ^ ((unsigned)((int)u >> 31) | 0x80000000u);
}
__device__ __forceinline__ unsigned key2u(unsigned k) { return k ^ ((k >> 31) ? 0x80000000u : 0xFFFFFFFFu); }

template <int N>
__device__ __forceinline__ void bitonic_sort_desc(unsigned (&v)[N]) {
#pragma unroll
  for (int k = 2; k <= N; k <<= 1) {
#pragma unroll
    for (int j = k >> 1; j > 0; j >>= 1) {
#pragma unroll
      for (int i = 0; i < N; ++i) {
        const int l = i ^ j;
        if (l > i) {
          const bool desc = ((i & k) == 0);
          const unsigned mx = max(v[i], v[l]), mn = min(v[i], v[l]);
          v[i] = desc ? mx : mn;
          v[l] = desc ? mn : mx;
        }
      }
    }
  }
}
template <int N>
__device__ __forceinline__ void bitonic_merge_desc(unsigned (&v)[N]) {
#pragma unroll
  for (int j = N >> 1; j > 0; j >>= 1) {
#pragma unroll
    for (int i = 0; i < N; ++i) {
      const int l = i ^ j;
      if (l > i) {
        const unsigned mx = max(v[i], v[l]), mn = min(v[i], v[l]);
        v[i] = mx;
        v[l] = mn;
      }
    }
  }
}
__device__ __forceinline__ void merge_top16(unsigned (&a)[16], const unsigned (&b)[16]) {
#pragma unroll
  for (int i = 0; i < 16; ++i) a[i] = max(a[i], b[15 - i]);
  bitonic_merge_desc<16>(a);
}
#define CEP(ka, pa, kb, pb, desc)                                  \
  {                                                                \
    const bool sw_ = (desc) ? ((kb) > (ka)) : ((kb) < (ka));       \
    const unsigned tk_ = sw_ ? (kb) : (ka), tl_ = sw_ ? (ka) : (kb); \
    const unsigned tp_ = sw_ ? (pb) : (pa), tq_ = sw_ ? (pa) : (pb); \
    ka = tk_; kb = tl_; pa = tp_; pb = tq_;                        \
  }
template <int N>
__device__ __forceinline__ void bitonic_sort_desc_p(unsigned (&v)[N], unsigned (&pl)[N]) {
#pragma unroll
  for (int k = 2; k <= N; k <<= 1) {
#pragma unroll
    for (int j = k >> 1; j > 0; j >>= 1) {
#pragma unroll
      for (int i = 0; i < N; ++i) {
        const int l = i ^ j;
        if (l > i) {
          const bool desc = ((i & k) == 0);
          CEP(v[i], pl[i], v[l], pl[l], desc);
        }
      }
    }
  }
}
template <int N>
__device__ __forceinline__ void bitonic_merge_desc_p(unsigned (&v)[N], unsigned (&pl)[N]) {
#pragma unroll
  for (int j = N >> 1; j > 0; j >>= 1) {
#pragma unroll
    for (int i = 0; i < N; ++i) {
      const int l = i ^ j;
      if (l > i) { CEP(v[i], pl[i], v[l], pl[l], true); }
    }
  }
}
__device__ __forceinline__ void merge_top16_p(unsigned (&a)[16], unsigned (&pa)[16], const unsigned (&b)[16], const unsigned (&pb)[16]) {
#pragma unroll
  for (int i = 0; i < 16; ++i) {
    const bool s = b[15 - i] > a[i];
    a[i] = s ? b[15 - i] : a[i];
    pa[i] = s ? pb[15 - i] : pa[i];
  }
  bitonic_merge_desc_p<16>(a, pa);
}

__device__ __forceinline__ void subkey_top16(const bf16_t* __restrict__ Kb, const float* crow, float rsv, int lane, unsigned (&top)[16]) {
  const int tok = lane & 31, hf = lane >> 5;
  f32x16 acc[4];
#pragma unroll
  for (int m = 0; m < 4; ++m)
#pragma unroll
    for (int i = 0; i < 16; ++i) acc[m][i] = 0.f;
#pragma unroll 1
  for (int ks = 0; ks < 4; ++ks) {
    const f32x4 v0 = *(const f32x4*)(crow + ks * 16 + 8 * hf), v1 = *(const f32x4*)(crow + ks * 16 + 8 * hf + 4);
    bf16x8 bq;
    bq[0] = (__bf16)(v0.x * rsv); bq[1] = (__bf16)(v0.y * rsv); bq[2] = (__bf16)(v0.z * rsv); bq[3] = (__bf16)(v0.w * rsv);
    bq[4] = (__bf16)(v1.x * rsv); bq[5] = (__bf16)(v1.y * rsv); bq[6] = (__bf16)(v1.z * rsv); bq[7] = (__bf16)(v1.w * rsv);
#pragma unroll
    for (int m = 0; m < 4; ++m) {
      const bf16x8 ak = *(const bf16x8*)(Kb + (m * 32 + tok) * 64 + ks * 16 + 8 * hf);
      acc[m] = mfma32(ak, bq, acc[m]);
    }
  }
  unsigned g[4][16];
#pragma unroll
  for (int m = 0; m < 4; ++m) {
#pragma unroll
    for (int i = 0; i < 16; ++i) g[m][i] = f2key(acc[m][i], (unsigned)(m * 32 + (i & 3) + 8 * (i >> 2) + 4 * hf));
    bitonic_sort_desc<16>(g[m]);
  }
  merge_top16(g[0], g[1]);
  merge_top16(g[2], g[3]);
  merge_top16(g[0], g[2]);
  unsigned o[16];
#pragma unroll
  for (int i = 0; i < 16; ++i) o[i] = __shfl_xor(g[0][i], 32);
  merge_top16(g[0], o);
#pragma unroll
  for (int i = 0; i < 16; ++i) top[i] = g[0][i];
}

__device__ void phase_route(const Params& p, char* smem) {
  unsigned char* ws = p.ws;
  const bf16_t* Wt = (const bf16_t*)(ws + WS_WQ);
  const bf16_t* K1 = (const bf16_t*)(ws + WS_K1);
  const bf16_t* K2 = (const bf16_t*)(ws + WS_K2);
  unsigned char* XN8 = ws + WS_XN2;
  unsigned* PIDX = (unsigned*)(ws + WS_PIDX);
  float* PG = (float*)(ws + WS_PG);
  const int tid = otid(), lane = tid & 63, wave = tid >> 6;
  const int ntiles = 256 * 8, per = (ntiles + gridDim.x - 1) / gridDim.x;
  const int vb = vblock();
  const float* Cs = (const float*)smem;
  const float* rs = (const float*)(smem + LDS_RS);
  for (int tile = vb * per; tile < min((vb + 1) * per, ntiles); ++tile) {
    const int mt = tile >> 3, hd = tile & 7, m0 = mt * 128;
    f32x4 acc[4][4];
    gemm_mainloop<true, false>(p.out, nullptr, Wt, m0, hd * 128, smem, acc);
    if (hd == 0) {
#pragma unroll 2
      for (int it = 0; it < 32; ++it) {
        const int item = tid + 256 * it, c16 = item & 63, tok = item >> 6;
        const float* src = p.out + (size_t)(m0 + tok) * 1024 + c16 * 16;
        const float r = rs[tok] * 16.f;
        u32x4 q;
#pragma unroll
        for (int i = 0; i < 4; ++i) {
          const f32x4 a = *(const f32x4*)(src + 4 * i), g4 = *(const f32x4*)(p.norm_ffn_g + c16 * 16 + 4 * i);
          int w = 0;
          w = __builtin_amdgcn_cvt_pk_fp8_f32(a.x * r * g4.x, a.y * r * g4.y, w, false);
          w = __builtin_amdgcn_cvt_pk_fp8_f32(a.z * r * g4.z, a.w * r * g4.w, w, true);
          q[i] = (unsigned)w;
        }
        *(u32x4*)(XN8 + (size_t)(m0 + tok) * 1024 + c16 * 16) = q;
      }
    }
    const int tok = lane & 31, hf = lane >> 5, trow = wave * 32 + tok;
    const float rsv = rs[trow];
    unsigned top1[16], top2[16];
    subkey_top16(K1 + hd * 8192, Cs + trow * CPITCH, rsv, lane, top1);
    subkey_top16(K2 + hd * 8192, Cs + trow * CPITCH + 64, rsv, lane, top2);
    float fa[16], fb[16];
    unsigned ia[16], ib[16];
#pragma unroll
    for (int i = 0; i < 16; ++i) {
      const unsigned ua = key2u(hf ? top2[i] : top1[i]), ub = key2u(hf ? top1[i] : top2[i]);
      fa[i] = __uint_as_float(ua); ia[i] = ua & 0x7Fu;
      fb[i] = __uint_as_float(ub); ib[i] = ub & 0x7Fu;
    }
    unsigned ck[32], cp[32];
    {
      int n = 0;
#pragma unroll
      for (int i = 0; i < 4; ++i) {
#pragma unroll
        for (int j = i; j < 16; ++j) {
          if ((i + 1) * (j + 1) <= 16) {
            unsigned key = f2key_raw(fa[i] + fb[j]);
            if (i == j && hf) key = 0u;
            ck[n] = key;
            cp[n] = hf ? ((ib[j] << 7) | ia[i]) : ((ia[i] << 7) | ib[j]);
            ++n;
          }
        }
      }
#pragma unroll
      for (; n < 32; ++n) { ck[n] = 0u; cp[n] = 0u; }
    }
    unsigned k0[16], p0[16], k1[16], p1[16];
#pragma unroll
    for (int i = 0; i < 16; ++i) { k0[i] = ck[i]; p0[i] = cp[i]; k1[i] = ck[16 + i]; p1[i] = cp[16 + i]; }
    bitonic_sort_desc_p<16>(k0, p0);
    bitonic_sort_desc_p<16>(k1, p1);
    merge_top16_p(k0, p0, k1, p1);
#pragma unroll
    for (int i = 0; i < 16; ++i) { k1[i] = __shfl_xor(k0[i], 32); p1[i] = __shfl_xor(p0[i], 32); }
    merge_top16_p(k0, p0, k1, p1);
    float sv[16], sum = 0.f;
    const float mx = __uint_as_float(key2u(k0[0]));
#pragma unroll
    for (int i = 0; i < 16; ++i) {
      sv[i] = __builtin_amdgcn_exp2f((__uint_as_float(key2u(k0[i])) - mx) * LOG2E);
      sum += sv[i];
    }
    const float inv = 1.f / sum;
    const size_t po = ((size_t)(m0 + trow) * 8 + hd) * 16;
    if (hf == 0) {
#pragma unroll
      for (int q = 0; q < 4; ++q) *(u32x4*)(PIDX + po + 4 * q) = (u32x4){p0[4 * q], p0[4 * q + 1], p0[4 * q + 2], p0[4 * q + 3]};
    } else {
#pragma unroll
      for (int q = 0; q < 4; ++q) *(f32x4*)(PG + po + 4 * q) = (f32x4){sv[4 * q] * inv, sv[4 * q + 1] * inv, sv[4 * q + 2] * inv, sv[4 * q + 3] * inv};
    }
    __syncthreads();
  }
}

__device__ __forceinline__ f32x4 mfma_fp8(u32x2 a, u32x2 b, f32x4 c) {
  return __builtin_amdgcn_mfma_f32_16x16x32_fp8_fp8(__builtin_bit_cast(long, a), __builtin_bit_cast(long, b), c, 0, 0, 0);
}
struct PeCtx {
  const unsigned char* U8; const float* US; const float* VS; const float* PG; float* PW; float* dummy;
  LAS unsigned* list; int lane, r, g, s, n, t0;
};
__device__ __forceinline__ void pe_rows(const PeCtx& c, int ci, u32x4 (&a)[16]) {
  const int idx = ci * 16 + (c.lane >> 2);
  const unsigned ent = c.list[idx & 2047];
  const unsigned e = (idx < c.n) ? ((ent >> 7) & 16383u) : (unsigned)(c.s << 11);
  const unsigned char* rp = c.U8 + (size_t)e * 1024 + (c.lane & 3) * 16;
#pragma unroll
  for (int ks = 0; ks < 16; ++ks) a[ks] = *(const u32x4*)(rp + ks * 64);
}
__device__ __forceinline__ void pe_fix(const PeCtx& c, u32x4 (&a)[16]) {
  const int src = 4 * c.r + c.g;
#pragma unroll
  for (int ks = 0; ks < 16; ++ks) {
    a[ks].x = (unsigned)__shfl((int)a[ks].x, src); a[ks].y = (unsigned)__shfl((int)a[ks].y, src);
    a[ks].z = (unsigned)__shfl((int)a[ks].z, src); a[ks].w = (unsigned)__shfl((int)a[ks].w, src);
  }
}
__device__ __forceinline__ void pe_chunk(const PeCtx& c, int ci, u32x4 (&a)[16], u32x4 (&anext)[16], const u32x4 (&bq)[16]) {
  const int idx = ci * 16 + c.r;
  const unsigned ent = c.list[idx & 2047];
  const bool fin = (c.lane < 16) && (idx < c.n);
  const unsigned e = (ent >> 7) & 16383u, slot = ent & 127u, col = (ent >> 21) & 15u;
  const float gt = c.PG[fin ? (size_t)(c.t0 + col) * 128 + slot : (size_t)0], us = c.US[fin ? e : 0u], vs = c.VS[fin ? e : 0u];
  __builtin_amdgcn_sched_barrier(0);
  pe_rows(c, ci + 1, anext);
  __builtin_amdgcn_sched_barrier(0);
  pe_fix(c, a);
  f32x4 acc = {0.f, 0.f, 0.f, 0.f};
#pragma unroll
  for (int ks = 0; ks < 16; ++ks) {
    acc = mfma_fp8((u32x2){a[ks].x, a[ks].y}, (u32x2){bq[ks].x, bq[ks].y}, acc);
    acc = mfma_fp8((u32x2){a[ks].z, a[ks].w}, (u32x2){bq[ks].z, bq[ks].w}, acc);
  }
  const int src = ((c.r >> 2) << 4) | (int)col;
  const float v0 = __shfl(acc[0], src), v1 = __shfl(acc[1], src), v2 = __shfl(acc[2], src), v3 = __shfl(acc[3], src);
  float d = ((c.r & 3) == 0) ? v0 : ((c.r & 3) == 1) ? v1 : ((c.r & 3) == 2) ? v2 : v3;
  float gt_ = gt, us_ = us, vs_ = vs;
  asm volatile("" : "+v"(d), "+v"(gt_), "+v"(us_), "+v"(vs_));
  {
    const float act = d * us_ * (1.f / 16.f);
    float* dst = fin ? c.PW + (size_t)(c.t0 + col) * 128 + slot : c.dummy;
    *dst = gt_ * 0.5f * act * (1.f + erff(act * 0.70710678118654752f)) * vs_;
  }
}
__device__ void phase_peer_u(const Params& p, char* smem) {
  unsigned char* ws = p.ws;
  PeCtx c;
  c.U8 = ws + WS_U8; c.US = (const float*)(ws + WS_US); c.VS = (const float*)(ws + WS_VS);
  c.PG = (const float*)(ws + WS_PG); c.PW = (float*)(ws + WS_PW);
  c.dummy = (float*)(ws + WS_PW + 16 * MiB) + (size_t)blockIdx.x * NTHREADS + otid();
  const unsigned char* XN8 = ws + WS_XN2;
  const unsigned* PIDX = (const unsigned*)(ws + WS_PIDX);
  const int tidu = otid();
  const int lane = tidu & 63, wave = tidu >> 6;
  c.lane = lane; c.r = lane & 15; c.g = lane >> 4;
  c.list = (LAS unsigned*)(smem + wave * 8192);
  const int G = gridDim.x, ng = (G % 8 == 0) ? 8 : 1;
  const int x = blockIdx.x % ng, lw = (blockIdx.x / ng) * 4 + wave, nlw = (G / ng) * 4;
  for (int s = x; s < 8; s += ng) {
    c.s = s;
    for (int grp = lw; grp < T / 16; grp += nlw) {
      const int t0 = grp * 16;
      c.t0 = t0;
      u32x4 bq[16];
      {
        const unsigned char* xp = XN8 + (size_t)(t0 + c.r) * 1024 + c.g * 16;
#pragma unroll
        for (int ks = 0; ks < 16; ++ks) bq[ks] = *(const u32x4*)(xp + ks * 64);
      }
      int n = 0;
#pragma unroll
      for (int q = 0; q < 8; ++q) {
        const u32x4 idv = *(const u32x4*)(PIDX + (size_t)t0 * 128 + q * 256 + lane * 4);
#pragma unroll
        for (int k = 0; k < 4; ++k) {
          const unsigned e = idv[k];
          const bool m = (int)(e >> 11) == s;
          const unsigned long long mk = __ballot(m);
          if (m) c.list[n + __builtin_amdgcn_mbcnt_hi((unsigned)(mk >> 32), __builtin_amdgcn_mbcnt_lo((unsigned)mk, 0))] =
                     ((unsigned)(2 * q + (lane >> 5)) << 21) | (e << 7) | (unsigned)((lane & 31) * 4 + k);
          n += __popcll(mk);
        }
      }
      asm volatile("s_waitcnt lgkmcnt(0)" ::: "memory");
      c.n = n;
      const int nch = (n + 15) >> 4;
      u32x4 a0[16], a1[16];
      pe_rows(c, 0, a0);
      {
        unsigned z = 0u;
#pragma unroll
        for (int ks = 0; ks < 16; ++ks) z |= a0[ks].w;
        asm volatile("" ::"v"(z));
      }
      if (nch > 0) {
        for (int ci = 0;; ci += 2) {
          pe_chunk(c, ci, a0, a1, bq);
          if (ci + 1 >= nch) break;
          pe_chunk(c, ci + 1, a1, a0, bq);
          if (ci + 2 >= nch) break;
        }
      }
      asm volatile("" ::: "memory");
    }
  }
}

__device__ void phase_peer_v(const Params& p) {
  unsigned char* ws = p.ws;
  const unsigned char* V8 = ws + WS_V8;
  const unsigned* PIDX = (const unsigned*)(ws + WS_PIDX);
  const float* PG = (const float*)(ws + WS_PW);
  const int tidv = otid();
  const int lane = tidv & 63, wave = tidv >> 6, pg = lane >> 3, c = lane & 7;
  const int G = gridDim.x, ng = (G % 8 == 0) ? 8 : 1;
  const int x = blockIdx.x % ng, lw = (blockIdx.x / ng) * 4 + wave, nlw = (G / ng) * 4;
  const bool b5 = lane & 32, b4 = lane & 16, b3 = lane & 8;
  for (int s = x; s < 8; s += ng) {
    const unsigned char* base = V8 + (size_t)s * 16384 * 128 + c * 16;
    for (int t = lw; t < T; t += nlw) {
      u32x4 ei[4];
      f32x4 wi[4];
#pragma unroll
      for (int i = 0; i < 4; ++i) {
        ei[i] = *(const u32x4*)(PIDX + (size_t)t * 128 + pg * 16 + 4 * i);
        wi[i] = *(const f32x4*)(PG + (size_t)t * 128 + pg * 16 + 4 * i);
      }
      u32x4 rv[16];
#pragma unroll
      for (int i = 0; i < 16; ++i) rv[i] = *(const u32x4*)(base + (size_t)ei[i >> 2][i & 3] * 128);
      float acc[16];
#pragma unroll
      for (int k = 0; k < 16; ++k) acc[k] = 0.f;
#pragma unroll
      for (int i = 0; i < 16; ++i) {
        const float w = wi[i >> 2][i & 3];
#pragma unroll
        for (int q = 0; q < 4; ++q) {
          const f32x2 lo = __builtin_amdgcn_cvt_pk_f32_fp8((int)rv[i][q], false), hi = __builtin_amdgcn_cvt_pk_f32_fp8((int)rv[i][q], true);
          acc[4 * q] += w * lo.x; acc[4 * q + 1] += w * lo.y; acc[4 * q + 2] += w * hi.x; acc[4 * q + 3] += w * hi.y;
        }
      }
      float r8[8], r4[4], r2[2];
#pragma unroll
      for (int i = 0; i < 8; ++i) { const float keep = b5 ? acc[8 + i] : acc[i], send = b5 ? acc[i] : acc[8 + i]; r8[i] = keep + __shfl_xor(send, 32); }
#pragma unroll
      for (int i = 0; i < 4; ++i) { const float keep = b4 ? r8[4 + i] : r8[i], send = b4 ? r8[i] : r8[4 + i]; r4[i] = keep + __shfl_xor(send, 16); }
#pragma unroll
      for (int i = 0; i < 2; ++i) { const float keep = b3 ? r4[2 + i] : r4[i], send = b3 ? r4[i] : r4[2 + i]; r2[i] = keep + __shfl_xor(send, 8); }
      float* o = p.out + (size_t)t * 1024 + s * 128 + c * 16 + (b5 ? 8 : 0) + (b4 ? 4 : 0) + (b3 ? 2 : 0);
      float2 h = *(float2*)o;
      h.x += r2[0];
      h.y += r2[1];
      *(float2*)o = h;
    }
  }
}

#define XB_TMO      128
#define XB_XCNT(j)  (256  + 64 * (j))
#define XB_XSUB(j)  (1280 + 64 * (j))
#define XB_XGEN(j)  (2304 + 64 * (j))
#define XB_TOP      3328
#define XB_TOPGEN   3392
#define XCD_BAR_WORDS 3456
#define XB_SPIN_CAP (1u << 22)
__device__ __forceinline__ unsigned xb_ld(unsigned* p)              { return __hip_atomic_load(p, __ATOMIC_RELAXED, __HIP_MEMORY_SCOPE_AGENT); }
__device__ __forceinline__ unsigned xb_add(unsigned* p, unsigned v) { return __hip_atomic_fetch_add(p, v, __ATOMIC_RELAXED, __HIP_MEMORY_SCOPE_AGENT); }
__device__ __forceinline__ unsigned xb_xcc_id() { return (unsigned)__builtin_amdgcn_s_getreg((3 << 11) | 20) & 0xFu; }
#define XB_SPIN(cond, bar) do { unsigned _sp = 0; while (cond) { __builtin_amdgcn_s_sleep(1); \
    if ((++_sp & 255u) == 0u) { if (xb_ld(&(bar)[XB_TMO])) break; if (_sp > XB_SPIN_CAP) { atomicAdd(&(bar)[XB_TMO], 1u); break; } } } } while (0)
struct XcdBarrier { unsigned* bar; unsigned x; volatile LAS unsigned* st; };
__device__ __forceinline__ XcdBarrier xcd_barrier_post(unsigned* bar, volatile LAS unsigned* st) {
    XcdBarrier b; b.bar = bar; b.x = xb_xcc_id(); b.st = st;
    if (threadIdx.x == 0) (void)xb_add(&bar[XB_XCNT(b.x)], 1u);
    return b;
}
__device__ __forceinline__ void xcd_barrier_complete(unsigned* bar, unsigned x, unsigned& nloc, unsigned& nx) {
    const unsigned G = gridDim.x * gridDim.y * gridDim.z;
    unsigned sum, cnt, mine, sp = 0u;
    for (;;) {
        sum = 0u; cnt = 0u; mine = 0u;
#pragma unroll
        for (unsigned j = 0; j < 16; ++j) { const unsigned c = xb_ld(&bar[XB_XCNT(j)]); sum += c; cnt += (c > 0u) ? 1u : 0u; mine = (j == x) ? c : mine; }
        if (sum == G) break;
        __builtin_amdgcn_s_sleep(1);
        if ((++sp & 255u) == 0u) { if (xb_ld(&bar[XB_TMO])) break; if (sp > XB_SPIN_CAP) { atomicAdd(&bar[XB_TMO], 1u); break; } }
    }
    nloc = mine > 0u ? mine : 1u; nx = cnt > 0u ? cnt : 1u;
}
__device__ __forceinline__ void xcd_barrier(const XcdBarrier& b) {
    asm volatile("s_waitcnt vmcnt(0)" ::: "memory");
    __syncthreads();
    if (threadIdx.x == 0) {
        unsigned* bar = b.bar;
        __builtin_amdgcn_s_waitcnt(0);
        unsigned nloc = b.st[0], nx = b.st[1];
        if (nloc == 0u) { xcd_barrier_complete(bar, b.x, nloc, nx); b.st[0] = nloc; b.st[1] = nx; }
        const unsigned old = xb_add(&bar[XB_XSUB(b.x)], 1u);
        const unsigned gen = old / nloc;
        if (old + 1u == (gen + 1u) * nloc) {
            __builtin_amdgcn_fence(__ATOMIC_RELEASE, "agent");
            asm volatile("s_waitcnt vmcnt(0)" ::: "memory");
            const unsigned og = xb_add(&bar[XB_TOP], 1u);
            const unsigned tg = og / nx;
            if (og + 1u == (tg + 1u) * nx) xb_add(&bar[XB_TOPGEN], 1u);
            else XB_SPIN(xb_ld(&bar[XB_TOPGEN]) == tg, bar);
            __builtin_amdgcn_fence(__ATOMIC_ACQUIRE, "agent");
            xb_add(&bar[XB_XGEN(b.x)], 1u);
            asm volatile("s_waitcnt vmcnt(0)" ::: "memory");
        } else {
            XB_SPIN(xb_ld(&bar[XB_XGEN(b.x)]) == gen, bar);
            __builtin_amdgcn_fence(__ATOMIC_ACQUIRE, "agent");
            asm volatile("s_waitcnt vmcnt(0)" ::: "memory");
        }
    }
    __syncthreads();
}

template <int PHASE>
__global__ void __launch_bounds__(NTHREADS, 2) k_phase(Params p) {
  __shared__ __attribute__((aligned(16))) char smem[LDS_BYTES];
  if (PHASE == 0) phase_prep(p);
  if (PHASE == 1) phase_inproj(p, smem);
  if (PHASE == 2) phase_mix(p, smem);
  if (PHASE == 3) phase_outproj(p, smem);
  if (PHASE == 4) phase_route(p, smem);
  if (PHASE == 5) phase_peer_u(p, smem);
  if (PHASE == 6) phase_peer_v(p);
}

__global__ void __launch_bounds__(NTHREADS, 2) k_fused(Params p) {
  __shared__ __attribute__((aligned(16))) char smem[LDS_BYTES];
  if (threadIdx.x == 0) *(u32x4*)(smem + LDS_BAR) = (u32x4){0u, 0u, 0u, 0u};
  __syncthreads();
  const XcdBarrier bar = xcd_barrier_post((unsigned*)(p.ws + WS_CTL), (volatile LAS unsigned*)(smem + LDS_BAR));
#ifdef PROBE_PHASE
  unsigned long long ts[8];
#define STAMP(k) ts[k] = __builtin_amdgcn_s_memrealtime();
#else
#define STAMP(k)
#endif
  STAMP(0)
  phase_prep(p);
  xcd_barrier(bar);
  STAMP(1)
  phase_inproj(p, smem);
  xcd_barrier(bar);
  STAMP(2)
  phase_mix(p, smem);
  xcd_barrier(bar);
  STAMP(3)
  phase_outproj(p, smem);
  xcd_barrier(bar);
  STAMP(4)
  phase_route(p, smem);
  xcd_barrier(bar);
  STAMP(5)
  phase_peer_u(p, smem);
  xcd_barrier(bar);
  STAMP(6)
  phase_peer_v(p);
#ifdef PROBE_PHASE
  xcd_barrier(bar);
  STAMP(7)
  if (blockIdx.x == 0 && threadIdx.x == 0) {
    const float us = (float)(ts[PROBE_PHASE + 1] - ts[PROBE_PHASE]) * 0.01f;
    p.out[12345] += us * (1.f / PROBE_DIV);
  }
#endif
}

extern "C" void kernel_launch(void* const* d_in, const int* in_sizes, int n_in, void* d_out, int out_size, void* d_ws, size_t ws_size,
                              hipStream_t stream) {
  if (n_in != 17 || ws_size < WS_END) {
    fprintf(stderr, "kernel_launch: unexpected n_in %d / ws_size %zu\n", n_in, ws_size);
    return;
  }
  Params p{};
  p.x = (const float*)d_in[0]; p.norm_mix_g = (const float*)d_in[1]; p.w_in = (const float*)d_in[2]; p.q_norm_g = (const float*)d_in[3];
  p.k_norm_g = (const float*)d_in[4]; p.attn_out_g = (const float*)d_in[5]; p.conv_w = (const float*)d_in[6]; p.conv_b = (const float*)d_in[7];
  p.conv_ln_g = (const float*)d_in[8]; p.conv_ln_b = (const float*)d_in[9]; p.w_out = (const float*)d_in[10]; p.norm_ffn_g = (const float*)d_in[11];
  p.peer_wq = (const float*)d_in[12]; p.peer_k1 = (const float*)d_in[13]; p.peer_k2 = (const float*)d_in[14]; p.peer_u = (const float*)d_in[15];
  p.peer_v = (const float*)d_in[16];
  p.out = (float*)d_out;
  p.ws = (unsigned char*)d_ws;
#if FUSED
  static int grid_blocks = 0;
  if (!grid_blocks) {
    int dev = 0, cus = 0, per_cu = 0;
    (void)hipGetDevice(&dev);
    (void)hipDeviceGetAttribute(&cus, hipDeviceAttributeMultiprocessorCount, dev);
    (void)hipOccupancyMaxActiveBlocksPerMultiprocessor(&per_cu, k_fused, NTHREADS, 0);
    if (per_cu > 2) per_cu = 2;
    if (per_cu < 1) per_cu = 1;
    grid_blocks = cus * per_cu;
  }
  (void)hipMemsetAsync((char*)d_ws + WS_CTL, 0, XCD_BAR_WORDS * 4, stream);
  hipLaunchKernelGGL(k_fused, dim3(grid_blocks), dim3(NTHREADS), 0, stream, p);
#else
  const int G = 512;
  k_phase<0><<<G, NTHREADS, 0, stream>>>(p);
  k_phase<1><<<G, NTHREADS, 0, stream>>>(p);
  k_phase<2><<<G, NTHREADS, 0, stream>>>(p);
  k_phase<3><<<G, NTHREADS, 0, stream>>>(p);
  k_phase<4><<<G, NTHREADS, 0, stream>>>(p);
  k_phase<5><<<G, NTHREADS, 0, stream>>>(p);
  k_phase<6><<<G, NTHREADS, 0, stream>>>(p);
#endif
}
```

```cpp
#include <hip/hip_runtime.h>
#include <cstdio>

#define LAS __attribute__((address_space(3)))
typedef unsigned short bf16_t;
typedef __bf16 bf16x8 __attribute__((ext_vector_type(8)));
typedef __bf16 bf16x2 __attribute__((ext_vector_type(2)));
typedef float f32x4 __attribute__((ext_vector_type(4)));
typedef float f32x16 __attribute__((ext_vector_type(16)));
typedef unsigned u32x4 __attribute__((ext_vector_type(4)));
typedef unsigned u32x2 __attribute__((ext_vector_type(2)));
typedef float f32x2 __attribute__((ext_vector_type(2)));

constexpr int SEQ = 4096, T = 8 * SEQ, D = 1024, NIN = 2560;
constexpr float EPS = 1e-6f;
constexpr float LOG2E = 1.4426950408889634f;

constexpr size_t MiB = 1u << 20;
constexpr size_t WS_W1 = 0, WS_WV = 4 * MiB, WS_WOUT = 5 * MiB, WS_WQ = 7 * MiB, WS_K1 = 9 * MiB, WS_K2 = 9 * MiB + 131072, WS_SSQ = 10 * MiB;
constexpr size_t WS_CTL = 11 * MiB;
constexpr size_t WS_US = 11 * MiB + 65536, WS_VS = 11 * MiB + 131072;
constexpr size_t WS_RS1 = 11 * MiB + 196608, WS_SSQ2 = 11 * MiB + 327680;
constexpr size_t WS_U8 = 12 * MiB, WS_V8 = 28 * MiB;
constexpr size_t WS_XB = 44 * MiB;
constexpr size_t WS_Q = 108 * MiB, WS_K = 140 * MiB, WS_VT = 172 * MiB, WS_HG = 204 * MiB, WS_MIX = 236 * MiB;
constexpr size_t WS_HB = 300 * MiB, WS_QH = 364 * MiB;
constexpr size_t WS_XN8 = 108 * MiB, WS_PIDX = 140 * MiB, WS_PG = 156 * MiB, WS_PW = 172 * MiB;
constexpr size_t WS_END = 428 * MiB;

struct Params {
  const float *x, *norm_mix_g, *w_in, *q_norm_g, *k_norm_g, *attn_out_g, *conv_w, *conv_b, *conv_ln_g, *conv_ln_b,
      *w_out, *norm_ffn_g, *peer_wq, *peer_k1, *peer_k2, *peer_u, *peer_v;
  float* out;
  unsigned char* ws;
};

constexpr int NTHREADS = 512, NWAVES = 8;
constexpr int LDS_STAGE = 131072, LDS_BAR = LDS_STAGE, LDS_BYTES = LDS_STAGE + 16;

__device__ __forceinline__ unsigned pk2(float lo, float hi) {
  bf16x2 v = {(__bf16)lo, (__bf16)hi};
  return __builtin_bit_cast(unsigned, v);
}
__device__ __forceinline__ float bflo(unsigned u) { return __uint_as_float(u << 16); }
__device__ __forceinline__ float bfhi(unsigned u) { return __uint_as_float(u & 0xffff0000u); }
__device__ __forceinline__ int otid() { int t = threadIdx.x; asm volatile("" : "+v"(t)); return t; }
__device__ __forceinline__ int vblock() {
  const int G = gridDim.x, b = blockIdx.x;
  return (G % 8 == 0) ? (b % 8) * (G / 8) + b / 8 : b;
}
__device__ __forceinline__ f32x16 mfma32(bf16x8 a, bf16x8 b, f32x16 c) { return __builtin_amdgcn_mfma_f32_32x32x16_bf16(a, b, c, 0, 0, 0); }

__device__ __forceinline__ int w1_src(int n) {
  if (n < 1024) {
    const int kind = n >> 9, rel = n & 511, pn = rel >> 8, P = rel & 255, bj = P >> 7, wc = (P >> 5) & 3, x = P & 31;
    return kind * 512 + (4 * pn + wc) * 64 + 32 * bj + x;
  }
  const int rel = n - 1024, pn = rel >> 8, P = rel & 255, bj = P >> 7, wc = (P >> 5) & 3, x = P & 31;
  return (bj ? 2048 : 1536) + 128 * pn + 32 * wc + x;
}
__device__ __forceinline__ void transpose_items(const float* __restrict__ W, int ldw, int N, bf16_t* __restrict__ Wt, const float* __restrict__ g, int glimit,
                                                int mode, long gtid, long nthr) {
  const long nitems = (long)N * 128;
  for (long it = gtid; it < nitems; it += nthr) {
    const int n = (int)(it % N), kc = (int)(it / N);
    const int src = mode == 1 ? w1_src(n) : (mode == 2 ? 1024 + n : n);
    float v[8];
#pragma unroll
    for (int i = 0; i < 8; ++i) {
      const int k = kc * 8 + i;
      float w = W[(size_t)k * ldw + src];
      if (k < glimit) w *= g[k];
      v[i] = w;
    }
    u32x4 o = {pk2(v[0], v[1]), pk2(v[2], v[3]), pk2(v[4], v[5]), pk2(v[6], v[7])};
    *(u32x4*)(Wt + (size_t)n * 1024 + kc * 8) = o;
  }
}
__device__ __forceinline__ void convert_items(const float* __restrict__ src, bf16_t* __restrict__ dst, long n8, long gtid, long nthr) {
  for (long it = gtid; it < n8; it += nthr) {
    const f32x4 a = *(const f32x4*)(src + it * 8), b = *(const f32x4*)(src + it * 8 + 4);
    u32x4 o = {pk2(a.x, a.y), pk2(a.z, a.w), pk2(b.x, b.y), pk2(b.z, b.w)};
    *(u32x4*)(dst + it * 8) = o;
  }
}
__device__ void phase_prep(const Params& p) {
  const int tid0 = otid();
  const long gtid = (long)vblock() * NTHREADS + tid0, nthr = (long)gridDim.x * NTHREADS;
  unsigned char* ws = p.ws;
  transpose_items(p.w_in, NIN, 2048, (bf16_t*)(ws + WS_W1), p.norm_mix_g, 1024, 1, gtid, nthr);
  transpose_items(p.w_in, NIN, 512, (bf16_t*)(ws + WS_WV), p.norm_mix_g, 1024, 2, gtid, nthr);
  transpose_items(p.w_out, D, D, (bf16_t*)(ws + WS_WOUT), p.attn_out_g, 512, 0, gtid, nthr);
  transpose_items(p.peer_wq, D, D, (bf16_t*)(ws + WS_WQ), p.norm_ffn_g, 1024, 0, gtid, nthr);
  convert_items(p.peer_k1, (bf16_t*)(ws + WS_K1), 65536 / 8, gtid, nthr);
  convert_items(p.peer_k2, (bf16_t*)(ws + WS_K2), 65536 / 8, gtid, nthr);
  const int lane = tid0 & 63, gw = vblock() * NWAVES + (tid0 >> 6), nw = gridDim.x * NWAVES;
  {
    bf16_t* XB = (bf16_t*)(ws + WS_XB);
    float* RS1 = (float*)(ws + WS_RS1);
    float* SSQ2 = (float*)(ws + WS_SSQ2);
    for (int t = gw; t < T; t += nw) {
      const float* src = p.x + (size_t)t * 1024 + lane * 4;
      f32x4 v[4];
      float ss = 0.f;
#pragma unroll
      for (int i = 0; i < 4; ++i) {
        v[i] = *(const f32x4*)(src + 256 * i);
        ss += v[i].x * v[i].x + v[i].y * v[i].y + v[i].z * v[i].z + v[i].w * v[i].w;
      }
#pragma unroll
      for (int o = 1; o < 64; o <<= 1) ss += __shfl_xor(ss, o);
#pragma unroll
      for (int i = 0; i < 4; ++i) *(u32x2*)(XB + (size_t)t * 1024 + lane * 4 + 256 * i) = (u32x2){pk2(v[i].x, v[i].y), pk2(v[i].z, v[i].w)};
      if (lane == 0) { RS1[t] = rsqrtf(ss * (1.f / 1024.f) + EPS); SSQ2[t] = 0.f; }
    }
  }
  {
    for (int r = gw; r < 32768; r += nw) {
      const int isv = r >> 14, e = r & 16383;
      const float* src = (isv ? p.peer_v : p.peer_u) + (size_t)e * 1024 + lane * 16;
      f32x4 v[4];
      float am = 0.f;
#pragma unroll
      for (int i = 0; i < 4; ++i) {
        v[i] = *(const f32x4*)(src + 4 * i);
        am = fmaxf(am, fmaxf(fmaxf(fabsf(v[i].x), fabsf(v[i].y)), fmaxf(fabsf(v[i].z), fabsf(v[i].w))));
      }
#pragma unroll
      for (int o = 1; o < 64; o <<= 1) am = fmaxf(am, __shfl_xor(am, o));
      const float scale = am > 0.f ? am * (1.f / 448.f) : 1.f, inv = am > 0.f ? 448.f / am : 0.f;
      u32x4 q;
#pragma unroll
      for (int i = 0; i < 4; ++i) {
        int w = 0;
        w = __builtin_amdgcn_cvt_pk_fp8_f32(v[i].x * inv, v[i].y * inv, w, false);
        w = __builtin_amdgcn_cvt_pk_fp8_f32(v[i].z * inv, v[i].w * inv, w, true);
        q[i] = (unsigned)w;
      }
      if (isv) {
        *(u32x4*)(ws + WS_V8 + ((size_t)(lane >> 3) * 16384 + e) * 128 + (lane & 7) * 16) = q;
        if (lane == 0) ((float*)(ws + WS_VS))[e] = scale;
      } else {
        *(u32x4*)(ws + WS_U8 + (size_t)e * 1024 + lane * 16) = q;
        if (lane == 0) ((float*)(ws + WS_US))[e] = scale;
      }
    }
  }
}

namespace pg8 {
typedef short sbf16x8 __attribute__((ext_vector_type(8)));
constexpr int BM = 256, BK = 64, HALF = 128, HTB = HALF * BK * 2  , NXCD = 8, WGM = 8;
__device__ __forceinline__ int lds_byte(int r, int c) { const int st = (r >> 4) * 2 + (c >> 5), rr = r & 15, cc = c & 31, ob = rr * 64 + cc * 2; return st * 1024 + (ob ^ (((ob >> 9) & 1) << 5)); }
__device__ __forceinline__ void stage_rc(int b, int& R, int& C) { const int st = b / 1024, sb = b % 1024, swz = sb ^ (((sb >> 9) & 1) << 5); R = (st >> 1) * 16 + swz / 64; C = (st & 1) * 32 + (swz % 64) / 2; }
__device__ __forceinline__ int perm32(int rho) { const int n = rho >> 4, i = rho & 15; return 8 * (i >> 2) + 4 * n + (i & 3); }
struct Unit { int pm, pn; };
struct Gemm { const bf16_t* A; const bf16_t* Bt; int M, N, K; };
struct StaticOrder {
    int nM, nN, nwg, G, c;
    __device__ void init(int M, int N, int G_, int c_) { nM = M / BM; nN = N / BM; nwg = nM * nN; G = G_; c = c_; }
    __device__ bool next(int i, Unit& u) const {
        const long L = (long)i * G + c; if (L >= nwg) return false;
        int wgid = (int)L; { const int q = nwg / NXCD, r = nwg % NXCD, xcd = wgid % NXCD, off = wgid / NXCD; wgid = (xcd < r ? xcd * (q + 1) : r * (q + 1) + (xcd - r) * q) + off; }
        const int nig = WGM * nN, gid = wgid / nig, fm = gid * WGM, gsz = (nM - fm) < WGM ? (nM - fm) : WGM;
        u.pm = fm + ((wgid % nig) % gsz); u.pn = (wgid % nig) / gsz; return true;
    }
};
template <class Epi>
__device__ __forceinline__ void gemm_phase(LAS unsigned char* lds, const Gemm g, const StaticOrder& S, const Epi& E) {
    const int tid = otid(), wid = __builtin_amdgcn_readfirstlane(tid >> 6), lane = tid & 63, wr = wid >> 2, wc = wid & 3, fr = lane & 15, fq = lane >> 4;
    const int K = g.K, nt = K / BK;
    unsigned voffA[2], voffB[2];
#pragma unroll
    for (int i = 0; i < 2; ++i) { int R, C; stage_rc(tid * 16 + i * 8192, R, C); const int Rb = Epi::PERM ? ((R & ~31) + perm32(R & 31)) : R;
        voffA[i] = (unsigned)(R * K + C) * 2u; voffB[i] = (unsigned)(Rb * K + C) * 2u; }
    const size_t kstep = (size_t)(BK * 2);
    const size_t hstep = (size_t)HALF * K * 2;
    const size_t tstep = 2 * hstep;
    const unsigned ldsw = (unsigned)wid * 1024u;
    const int aoff = lds_byte(wr * 64 + fr, fq * 8), boff = lds_byte(wc * 32 + fr, fq * 8);
#define PG8_SA(b, h) (((b) * 2 + (h)) * HTB)
#define PG8_SB(b, h) ((4 + (b) * 2 + (h)) * HTB)
#define PG8_STAGE(bufoff, gbase, voff) do { _Pragma("unroll") for (int _i = 0; _i < 2; ++_i) \
        __builtin_amdgcn_global_load_lds((const unsigned*)((const char*)(gbase) + (voff)[_i]), (LAS unsigned*)(lds + (bufoff) + ldsw + _i * 8192), 16, 0, 0); } while (0)
#define PG8_LDA(dst, b, h) do { _Pragma("unroll") for (int m = 0; m < 4; ++m) _Pragma("unroll") for (int k = 0; k < 2; ++k) dst[m][k] = *(const LAS sbf16x8*)(lds + PG8_SA(b, h) + aoff + m * 2048 + k * 1024); } while (0)
#define PG8_LDB(dst, b, h) do { _Pragma("unroll") for (int n = 0; n < 2; ++n) _Pragma("unroll") for (int k = 0; k < 2; ++k) dst[n][k] = *(const LAS sbf16x8*)(lds + PG8_SB(b, h) + boff + n * 2048 + k * 1024); } while (0)
#define PG8_MMA(ai, bj, At, Bt) do { __builtin_amdgcn_s_setprio(1); _Pragma("unroll") for (int m = 0; m < 4; ++m) _Pragma("unroll") for (int n = 0; n < 2; ++n) _Pragma("unroll") for (int k = 0; k < 2; ++k) \
        acc[ai][bj][m][n] = __builtin_amdgcn_mfma_f32_16x16x32_bf16(__builtin_bit_cast(bf16x8, Bt[n][k]), __builtin_bit_cast(bf16x8, At[m][k]), acc[ai][bj][m][n], 0, 0, 0); __builtin_amdgcn_s_setprio(0); } while (0)
#define PG8_WAIT_V(n) asm volatile("s_waitcnt vmcnt(" #n ")" ::: "memory")
#define PG8_WAIT_L(n) asm volatile("s_waitcnt lgkmcnt(" #n ")" ::: "memory")
#define PG8_BAR __builtin_amdgcn_s_barrier()
#define PG8_SCHED __builtin_amdgcn_sched_barrier(0)
    Unit cur, nxt; int ui = 0;
    if (!S.next(0, cur)) return;
    f32x4 acc[2][2][4][2];
#pragma unroll
    for (int a = 0; a < 2; ++a)
#pragma unroll
        for (int b = 0; b < 2; ++b)
#pragma unroll
            for (int m = 0; m < 4; ++m)
#pragma unroll
                for (int n = 0; n < 2; ++n) acc[a][b][m][n] = (f32x4){0.f, 0.f, 0.f, 0.f};
    sbf16x8 At[4][2], B0[2][2], B1[2][2];
    const char* cA = (const char*)g.A + (size_t)cur.pm * tstep; const char* cB = (const char*)g.Bt + (size_t)cur.pn * tstep;
    PG8_STAGE(PG8_SB(0, 0), cB, voffB); PG8_STAGE(PG8_SA(0, 0), cA, voffA); PG8_STAGE(PG8_SB(0, 1), cB + hstep, voffB); PG8_STAGE(PG8_SA(0, 1), cA + hstep, voffA);
    if (wr == 1) PG8_BAR;
    PG8_WAIT_V(4); PG8_BAR;
    PG8_STAGE(PG8_SB(1, 0), cB + kstep, voffB); PG8_STAGE(PG8_SA(1, 0), cA + kstep, voffA); PG8_STAGE(PG8_SB(1, 1), cB + hstep + kstep, voffB);
    PG8_WAIT_V(6); PG8_BAR;
    for (;;) {
        const bool has_next = S.next(ui + 1, nxt);
        const char* nA = has_next ? (const char*)g.A + (size_t)nxt.pm * tstep : cA; const char* nB = has_next ? (const char*)g.Bt + (size_t)nxt.pn * tstep : cB;
        for (int t = 0; t < nt; t += 2) {
            const bool last = (t == nt - 2);
            const char* a1 = cA + (size_t)(t + 1) * kstep;
            const char* a2 = last ? nA : cA + (size_t)(t + 2) * kstep; const char* b2 = last ? nB : cB + (size_t)(t + 2) * kstep;
            const char* a3 = a2 + kstep; const char* b3 = b2 + kstep;
            PG8_LDB(B0, 0, 0); PG8_SCHED; PG8_LDA(At, 0, 0); PG8_STAGE(PG8_SA(1, 1), a1 + hstep, voffA);
            PG8_WAIT_L(8); PG8_BAR; PG8_WAIT_L(0); PG8_MMA(0, 0, At, B0); PG8_BAR; PG8_SCHED;
            PG8_LDB(B1, 0, 1); PG8_STAGE(PG8_SB(0, 0), b2, voffB);
            PG8_BAR; PG8_WAIT_L(0); PG8_MMA(0, 1, At, B1); PG8_BAR;
            PG8_LDA(At, 0, 1); PG8_STAGE(PG8_SA(0, 0), a2, voffA);
            PG8_BAR; PG8_WAIT_L(0); PG8_MMA(1, 0, At, B0); PG8_BAR; PG8_SCHED;
            PG8_STAGE(PG8_SB(0, 1), b2 + hstep, voffB);
            PG8_WAIT_V(6); PG8_BAR; PG8_MMA(1, 1, At, B1); PG8_BAR;
            PG8_LDB(B0, 1, 0); PG8_SCHED; PG8_LDA(At, 1, 0); PG8_STAGE(PG8_SA(0, 1), a2 + hstep, voffA);
            PG8_WAIT_L(8); PG8_BAR; PG8_WAIT_L(0); PG8_MMA(0, 0, At, B0); PG8_BAR; PG8_SCHED;
            PG8_LDB(B1, 1, 1); PG8_STAGE(PG8_SB(1, 0), b3, voffB);
            PG8_BAR; PG8_WAIT_L(0); PG8_MMA(0, 1, At, B1); PG8_BAR;
            PG8_LDA(At, 1, 1); PG8_STAGE(PG8_SA(1, 0), a3, voffA);
            PG8_BAR; PG8_WAIT_L(0); PG8_MMA(1, 0, At, B0); PG8_BAR; PG8_SCHED;
            PG8_STAGE(PG8_SB(1, 1), b3 + hstep, voffB);
            PG8_WAIT_V(6); PG8_BAR; PG8_MMA(1, 1, At, B1); PG8_BAR;
        }
        E(acc, cur, wr, wc, fr, fq);
        if (!has_next) break;
#pragma unroll
        for (int a = 0; a < 2; ++a)
#pragma unroll
            for (int b = 0; b < 2; ++b)
#pragma unroll
                for (int m = 0; m < 4; ++m)
#pragma unroll
                    for (int n = 0; n < 2; ++n) acc[a][b][m][n] = (f32x4){0.f, 0.f, 0.f, 0.f};
        cur = nxt; cA = nA; cB = nB; ++ui;
    }
    PG8_WAIT_V(0);
    if (wr == 0) PG8_BAR;
    PG8_BAR;
#undef PG8_SA
#undef PG8_SB
#undef PG8_STAGE
#undef PG8_LDA
#undef PG8_LDB
#undef PG8_MMA
#undef PG8_WAIT_V
#undef PG8_WAIT_L
#undef PG8_BAR
#undef PG8_SCHED
}
}

struct EpiQKC {
  static constexpr bool PERM = true;
  const float* rs1; const float* qg; const float* kg; bf16_t* Q; bf16_t* Kk; bf16_t* HG;
  __device__ __forceinline__ void operator()(const f32x4 (&acc)[2][2][4][2], const pg8::Unit& u, int wr, int wc, int fr, int fq) const {
    const int row0 = u.pm * 256 + wr * 64 + fr;
    if (u.pn < 4) {
      const bool isq = u.pn < 2;
      const int head = 4 * (u.pn & 1) + wc;
      const float* g = isq ? qg : kg;
      f32x4 gv[2][2];
#pragma unroll
      for (int bj = 0; bj < 2; ++bj)
#pragma unroll
        for (int n = 0; n < 2; ++n) gv[bj][n] = *(const f32x4*)(g + 32 * bj + 8 * fq + 4 * n);
      bf16_t* base = isq ? Q : Kk;
#pragma unroll
      for (int ai = 0; ai < 2; ++ai)
#pragma unroll
        for (int m = 0; m < 4; ++m) {
          const int t = row0 + ai * 128 + m * 16;
          float ss = 0.f;
#pragma unroll
          for (int bj = 0; bj < 2; ++bj)
#pragma unroll
            for (int n = 0; n < 2; ++n) { const f32x4 v = acc[ai][bj][m][n]; ss += v.x * v.x + v.y * v.y + v.z * v.z + v.w * v.w; }
          ss += __shfl_xor(ss, 16);
          ss += __shfl_xor(ss, 32);
          const float r = rs1[t];
          float sc = r * rsqrtf(r * r * ss * (1.f / 64.f) + EPS);
          if (isq) sc *= 0.125f * LOG2E;
          bf16_t* dst = base + ((size_t)((t >> 12) * 8 + head) * 4096 + (t & 4095)) * 64 + 8 * fq;
#pragma unroll
          for (int bj = 0; bj < 2; ++bj) {
            const f32x4 a = acc[ai][bj][m][0] * gv[bj][0] * sc, b = acc[ai][bj][m][1] * gv[bj][1] * sc;
            *(u32x4*)(dst + 32 * bj) = (u32x4){pk2(a.x, a.y), pk2(a.z, a.w), pk2(b.x, b.y), pk2(b.z, b.w)};
          }
        }
    } else {
      const int ch0 = 128 * (u.pn - 4) + 32 * wc + 8 * fq;
#pragma unroll
      for (int ai = 0; ai < 2; ++ai)
#pragma unroll
        for (int m = 0; m < 4; ++m) {
          const int t = row0 + ai * 128 + m * 16;
          const float r = rs1[t];
          float h[8];
#pragma unroll
          for (int n = 0; n < 2; ++n)
#pragma unroll
            for (int j = 0; j < 4; ++j) h[4 * n + j] = acc[ai][0][m][n][j] * r / (1.f + __expf(-acc[ai][1][m][n][j] * r));
          *(u32x4*)(HG + (size_t)t * 512 + ch0) = (u32x4){pk2(h[0], h[1]), pk2(h[2], h[3]), pk2(h[4], h[5]), pk2(h[6], h[7])};
        }
    }
  }
};
struct EpiVt {
  static constexpr bool PERM = false;
  const float* rs1; bf16_t* Vt;
  __device__ __forceinline__ void operator()(const f32x4 (&acc)[2][2][4][2], const pg8::Unit& u, int wr, int wc, int fr, int fq) const {
    const int pos0 = 8 * (fq & 1) + 4 * (fq >> 1);
#pragma unroll
    for (int bj = 0; bj < 2; ++bj)
#pragma unroll
      for (int n = 0; n < 2; ++n) {
        const int t = u.pn * 256 + bj * 128 + wc * 32 + n * 16 + 4 * fq;
        const f32x4 r = *(const f32x4*)(rs1 + t);
        const size_t tb = ((size_t)(t >> 12) * 8) * 128 + ((t & 4095) >> 5);
#pragma unroll
        for (int ai = 0; ai < 2; ++ai)
#pragma unroll
          for (int m = 0; m < 4; ++m) {
            const int dg = u.pm * 256 + ai * 128 + wr * 64 + m * 16 + fr, head = dg >> 6, d = dg & 63;
            const f32x4 v = acc[ai][bj][m][n] * r;
            *(u32x2*)(Vt + ((tb + (size_t)head * 128) * 64 + d) * 32 + 16 * n + pos0) = (u32x2){pk2(v.x, v.y), pk2(v.z, v.w)};
          }
      }
  }
};
struct EpiOut {
  static constexpr bool PERM = false;
  const float* x; float* out; bf16_t* HB; float* ssq2;
  __device__ __forceinline__ void operator()(const f32x4 (&acc)[2][2][4][2], const pg8::Unit& u, int wr, int wc, int fr, int fq) const {
    const int row0 = u.pm * 256 + wr * 64 + fr, col0 = u.pn * 256 + wc * 32 + 4 * fq;
#pragma unroll
    for (int ai = 0; ai < 2; ++ai)
#pragma unroll
      for (int m = 0; m < 4; ++m) {
        const int t = row0 + ai * 128 + m * 16;
        const size_t ro = (size_t)t * 1024 + col0;
        float ss = 0.f;
#pragma unroll
        for (int bj = 0; bj < 2; ++bj)
#pragma unroll
          for (int n = 0; n < 2; ++n) {
            const size_t o = ro + bj * 128 + n * 16;
            const f32x4 h = *(const f32x4*)(x + o) + acc[ai][bj][m][n];
            *(f32x4*)(out + o) = h;
            *(u32x2*)(HB + o) = (u32x2){pk2(h.x, h.y), pk2(h.z, h.w)};
            ss += h.x * h.x + h.y * h.y + h.z * h.z + h.w * h.w;
          }
        ss += __shfl_xor(ss, 16);
        ss += __shfl_xor(ss, 32);
        if (fq == 0) atomicAdd(ssq2 + t, ss);
      }
  }
};
struct EpiQh {
  static constexpr bool PERM = true;
  const float* ssq2; bf16_t* QH;
  __device__ __forceinline__ void operator()(const f32x4 (&acc)[2][2][4][2], const pg8::Unit& u, int wr, int wc, int fr, int fq) const {
    const int row0 = u.pm * 256 + wr * 64 + fr, col0 = u.pn * 256 + wc * 32 + 8 * fq;
#pragma unroll
    for (int ai = 0; ai < 2; ++ai)
#pragma unroll
      for (int m = 0; m < 4; ++m) {
        const int t = row0 + ai * 128 + m * 16;
        const float r = rsqrtf(ssq2[t] * (1.f / 1024.f) + EPS);
#pragma unroll
        for (int bj = 0; bj < 2; ++bj) {
          const f32x4 a = acc[ai][bj][m][0] * r, b = acc[ai][bj][m][1] * r;
          *(u32x4*)(QH + (size_t)t * 1024 + col0 + bj * 128) = (u32x4){pk2(a.x, a.y), pk2(a.z, a.w), pk2(b.x, b.y), pk2(b.z, b.w)};
        }
      }
  }
};

__device__ void phase_inproj(const Params& p, char* smem) {
  unsigned char* ws = p.ws;
  LAS unsigned char* lds = (LAS unsigned char*)smem;
  const bf16_t* XB = (const bf16_t*)(ws + WS_XB);
  const float* RS1 = (const float*)(ws + WS_RS1);
  pg8::StaticOrder S;
  {
    pg8::Gemm g{XB, (const bf16_t*)(ws + WS_W1), T, 2048, 1024};
    S.init(T, 2048, gridDim.x, blockIdx.x);
    EpiQKC E{RS1, p.q_norm_g, p.k_norm_g, (bf16_t*)(ws + WS_Q), (bf16_t*)(ws + WS_K), (bf16_t*)(ws + WS_HG)};
    pg8::gemm_phase<EpiQKC>(lds, g, S, E);
  }
  {
    pg8::Gemm g{(const bf16_t*)(ws + WS_WV), XB, 512, T, 1024};
    S.init(512, T, gridDim.x, blockIdx.x);
    EpiVt E{RS1, (bf16_t*)(ws + WS_VT)};
    pg8::gemm_phase<EpiVt>(lds, g, S, E);
  }
}
__device__ void phase_outproj(const Params& p, char* smem) {
  unsigned char* ws = p.ws;
  pg8::Gemm g{(const bf16_t*)(ws + WS_MIX), (const bf16_t*)(ws + WS_WOUT), T, 1024, 1024};
  pg8::StaticOrder S;
  S.init(T, 1024, gridDim.x, blockIdx.x);
  EpiOut E{p.x, p.out, (bf16_t*)(ws + WS_HB), (float*)(ws + WS_SSQ2)};
  pg8::gemm_phase<EpiOut>((LAS unsigned char*)smem, g, S, E);
}
__device__ void phase_qproj(const Params& p, char* smem) {
  unsigned char* ws = p.ws;
  pg8::Gemm g{(const bf16_t*)(ws + WS_HB), (const bf16_t*)(ws + WS_WQ), T, 1024, 1024};
  pg8::StaticOrder S;
  S.init(T, 1024, gridDim.x, blockIdx.x);
  EpiQh E{(const float*)(ws + WS_SSQ2), (bf16_t*)(ws + WS_QH)};
  pg8::gemm_phase<EpiQh>((LAS unsigned char*)smem, g, S, E);
}

__device__ void conv_item(const Params& p, int item, char* smem) {
  unsigned char* ws = p.ws;
  const bf16_t* HG = (const bf16_t*)(ws + WS_HG);
  bf16_t* MIX = (bf16_t*)(ws + WS_MIX);
  const int tid512 = otid(), half = tid512 >> 8, tid = tid512 & 255, lane = tid & 63, wave = tid >> 6;
  const int t0 = item * 32, s0 = t0 & 4095;
  for (int idx = tid512; idx < 62 * 64; idx += NTHREADS) {
    const int r = idx >> 6, c16 = idx & 63;
    u32x4 v = {0u, 0u, 0u, 0u};
    if (s0 - 30 + r >= 0) v = *(const u32x4*)(HG + (size_t)(t0 - 30 + r) * 512 + c16 * 8);
    *(u32x4*)(smem + r * 1024 + c16 * 16) = v;
  }
  float w0[31], w1[31];
#pragma unroll
  for (int j = 0; j < 31; ++j) {
    const float2 w = *(const float2*)(p.conv_w + j * 512 + 2 * tid);
    w0[j] = w.x;
    w1[j] = w.y;
  }
  const float2 cb = *(const float2*)(p.conv_b + 2 * tid);
  const float2 lg = *(const float2*)(p.conv_ln_g + 2 * tid);
  const float2 lb = *(const float2*)(p.conv_ln_b + 2 * tid);
  float* red = (float*)(smem + 62 * 1024) + half * 16;
  __syncthreads();
  for (int t2 = 0; t2 < 16; ++t2) {
    const int tt = 2 * t2 + half;
    float a0 = cb.x, a1 = cb.y;
#pragma unroll
    for (int j = 0; j < 31; ++j) {
      const unsigned v = *(const unsigned*)(smem + (tt + j) * 1024 + tid * 4);
      a0 += w0[j] * bflo(v);
      a1 += w1[j] * bfhi(v);
    }
    float s1 = a0 + a1, s2 = a0 * a0 + a1 * a1;
#pragma unroll
    for (int o = 1; o < 64; o <<= 1) {
      s1 += __shfl_xor(s1, o);
      s2 += __shfl_xor(s2, o);
    }
    float* rr = red + (t2 & 1) * 8;
    if (lane == 0) {
      rr[wave * 2] = s1;
      rr[wave * 2 + 1] = s2;
    }
    __syncthreads();
    const float S1 = rr[0] + rr[2] + rr[4] + rr[6], S2 = rr[1] + rr[3] + rr[5] + rr[7];
    const float mu = S1 * (1.f / 512.f);
    const float var = fmaxf(S2 * (1.f / 512.f) - mu * mu, 0.f);
    const float rstd = rsqrtf(var + EPS);
    const float y0 = (a0 - mu) * rstd * lg.x + lb.x, y1 = (a1 - mu) * rstd * lg.y + lb.y;
    const float z0 = y0 / (1.f + __expf(-y0)), z1 = y1 / (1.f + __expf(-y1));
    *(unsigned*)(MIX + (size_t)(t0 + tt) * 1024 + 512 + 2 * tid) = pk2(z0, z1);
  }
  __syncthreads();
}

__device__ void attn_item(const Params& p, int item, int lane) {
  unsigned char* ws = p.ws;
  const bf16_t* Qm = (const bf16_t*)(ws + WS_Q);
  const bf16_t* Km = (const bf16_t*)(ws + WS_K);
  const bf16_t* Vt = (const bf16_t*)(ws + WS_VT);
  bf16_t* MIX = (bf16_t*)(ws + WS_MIX);
  float* SSQ = (float*)(ws + WS_SSQ);
  const int qt = item & 127, bh = item >> 7;
  const int tok = lane & 31, hf = lane >> 5;
  bf16x8 qf[4];
  {
    const bf16_t* qp = Qm + ((size_t)bh * 4096 + qt * 32 + tok) * 64 + 8 * hf;
#pragma unroll
    for (int ks = 0; ks < 4; ++ks) qf[ks] = *(const bf16x8*)(qp + ks * 16);
  }
  f32x16 o0, o1;
#pragma unroll
  for (int i = 0; i < 16; ++i) { o0[i] = 0.f; o1[i] = 0.f; }
  float c = 0.f;
  for (int kb = qt; kb >= 0; --kb) {
    const bf16_t* kp = Km + ((size_t)bh * 4096 + kb * 32 + tok) * 64 + 8 * hf;
    bf16x8 kf[4];
#pragma unroll
    for (int ks = 0; ks < 4; ++ks) kf[ks] = *(const bf16x8*)(kp + ks * 16);
    const bf16_t* vp = Vt + (((size_t)bh * 128 + kb) * 64 + tok) * 32 + hf * 8;
    bf16x8 vf[2][2];
#pragma unroll
    for (int m = 0; m < 2; ++m)
#pragma unroll
      for (int s = 0; s < 2; ++s) vf[m][s] = *(const bf16x8*)(vp + m * 1024 + s * 16);
    f32x16 sc;
#pragma unroll
    for (int i = 0; i < 16; ++i) sc[i] = 0.f;
#pragma unroll
    for (int ks = 0; ks < 4; ++ks) sc = mfma32(kf[ks], qf[ks], sc);
    const bool diag = (kb == qt);
    float lk[16], zs[16];
#pragma unroll
    for (int i = 0; i < 16; ++i) {
      const float zl = sc[i];
      const float e = __builtin_amdgcn_exp2f(zl);
      const float sp = __builtin_amdgcn_logf(1.f + e);
      const bool valid = !diag || ((i & 3) + 8 * (i >> 2) + 4 * hf < tok);
      lk[i] = valid ? -sp : 0.f;
      zs[i] = valid ? zl - sp : -1e30f;
    }
    float Tg[4], Pg[4];
#pragma unroll
    for (int g = 0; g < 4; ++g) {
      Tg[g] = (lk[4 * g] + lk[4 * g + 1]) + (lk[4 * g + 2] + lk[4 * g + 3]);
      Pg[g] = __shfl_xor(Tg[g], 32);
    }
    float base[4];
    float run = 0.f;
#pragma unroll
    for (int g = 3; g >= 0; --g) {
      base[g] = c + run + (hf == 0 ? Pg[g] : 0.f);
      run += Tg[g] + Pg[g];
    }
    float pr[16];
#pragma unroll
    for (int g = 0; g < 4; ++g) {
      float l = base[g];
#pragma unroll
      for (int r = 3; r >= 0; --r) {
        pr[4 * g + r] = __builtin_amdgcn_exp2f(zs[4 * g + r] + l);
        l += lk[4 * g + r];
      }
    }
    c += run;
    bf16x8 pf[2];
#pragma unroll
    for (int s = 0; s < 2; ++s)
#pragma unroll
      for (int j = 0; j < 8; ++j) pf[s][j] = (__bf16)pr[8 * s + j];
#pragma unroll
    for (int s = 0; s < 2; ++s) {
      o0 = mfma32(vf[0][s], pf[s], o0);
      o1 = mfma32(vf[1][s], pf[s], o1);
    }
    if (__all(c < -150.f)) break;
  }
  const int t = (bh >> 3) * 4096 + qt * 32 + tok, hh = bh & 7;
  float ssq = 0.f;
#pragma unroll
  for (int i = 0; i < 16; ++i) ssq += o0[i] * o0[i] + o1[i] * o1[i];
  ssq += __shfl_xor(ssq, 32);
  if (hf == 0) SSQ[t * 8 + hh] = ssq;
  bf16_t* dst = MIX + (size_t)t * 1024 + hh * 64 + 4 * hf;
#pragma unroll
  for (int g = 0; g < 4; ++g) {
    *(u32x2*)(dst + 8 * g) = (u32x2){pk2(o0[4 * g], o0[4 * g + 1]), pk2(o0[4 * g + 2], o0[4 * g + 3])};
    *(u32x2*)(dst + 32 + 8 * g) = (u32x2){pk2(o1[4 * g], o1[4 * g + 1]), pk2(o1[4 * g + 2], o1[4 * g + 3])};
  }
}

__device__ void phase_mix(const Params& p, char* smem) {
  const int vb = vblock(), G = gridDim.x;
  for (int item = vb; item < 1024; item += G) conv_item(p, item, smem);
  const int tidm = otid();
  const int lane = tidm & 63, gw = vb * NWAVES + (tidm >> 6), nw = G * NWAVES;
  for (int item = gw; item < 8192; item += nw) attn_item(p, item, lane);
}
__device__ void phase_attn_norm(const Params& p) {
  unsigned char* ws = p.ws;
  bf16_t* MIX = (bf16_t*)(ws + WS_MIX);
  const float* SSQ = (const float*)(ws + WS_SSQ);
  const int tids = otid();
  const int lane = tids & 63, gw = vblock() * NWAVES + (tids >> 6), nw = gridDim.x * NWAVES;
  for (int t = gw; t < T; t += nw) {
    const f32x4 a = *(const f32x4*)(SSQ + (size_t)t * 8), b = *(const f32x4*)(SSQ + (size_t)t * 8 + 4);
    const float rs = rsqrtf(((a.x + a.y) + (a.z + a.w) + (b.x + b.y) + (b.z + b.w)) * (1.f / 512.f) + EPS);
    u32x4* ptr = (u32x4*)(MIX + (size_t)t * 1024 + lane * 8);
    const u32x4 v = *ptr;
    *ptr = (u32x4){pk2(bflo(v.x) * rs, bfhi(v.x) * rs), pk2(bflo(v.y) * rs, bfhi(v.y) * rs), pk2(bflo(v.z) * rs, bfhi(v.z) * rs), pk2(bflo(v.w) * rs, bfhi(v.w) * rs)};
  }
}

__device__ __forceinline__ unsigned f2key(float f, unsigned n) {
  const unsigned u = (__float_as_uint(f) & ~0x7Fu) | n;
  return u ^ ((unsigned)((int)u >> 31) | 0x80000000u);
}
__device__ __forceinline__ unsigned f2key_raw(float f) {
  const unsigned u = __float_as_uint(f);
  return u ^ ((unsigned)((int)u >> 31) | 0x80000000u);
}
__device__ __forceinline__ unsigned key2u(unsigned k) { return k ^ ((k >> 31) ? 0x80000000u : 0xFFFFFFFFu); }

template <int N>
__device__ __forceinline__ void bitonic_sort_desc(unsigned (&v)[N]) {
#pragma unroll
  for (int k = 2; k <= N; k <<= 1) {
#pragma unroll
    for (int j = k >> 1; j > 0; j >>= 1) {
#pragma unroll
      for (int i = 0; i < N; ++i) {
        const int l = i ^ j;
        if (l > i) {
          const bool desc = ((i & k) == 0);
          const unsigned mx = max(v[i], v[l]), mn = min(v[i], v[l]);
          v[i] = desc ? mx : mn;
          v[l] = desc ? mn : mx;
        }
      }
    }
  }
}
template <int N>
__device__ __forceinline__ void bitonic_merge_desc(unsigned (&v)[N]) {
#pragma unroll
  for (int j = N >> 1; j > 0; j >>= 1) {
#pragma unroll
    for (int i = 0; i < N; ++i) {
      const int l = i ^ j;
      if (l > i) {
        const unsigned mx = max(v[i], v[l]), mn = min(v[i], v[l]);
        v[i] = mx;
        v[l] = mn;
      }
    }
  }
}
__device__ __forceinline__ void merge_top16(unsigned (&a)[16], const unsigned (&b)[16]) {
#pragma unroll
  for (int i = 0; i < 16; ++i) a[i] = max(a[i], b[15 - i]);
  bitonic_merge_desc<16>(a);
}
#define CEP(ka, pa, kb, pb, desc)                                  \
  {                                                                \
    const bool sw_ = (desc) ? ((kb) > (ka)) : ((kb) < (ka));       \
    const unsigned tk_ = sw_ ? (kb) : (ka), tl_ = sw_ ? (ka) : (kb); \
    const unsigned tp_ = sw_ ? (pb) : (pa), tq_ = sw_ ? (pa) : (pb); \
    ka = tk_; kb = tl_; pa = tp_; pb = tq_;                        \
  }
template <int N>
__device__ __forceinline__ void bitonic_sort_desc_p(unsigned (&v)[N], unsigned (&pl)[N]) {
#pragma unroll
  for (int k = 2; k <= N; k <<= 1) {
#pragma unroll
    for (int j = k >> 1; j > 0; j >>= 1) {
#pragma unroll
      for (int i = 0; i < N; ++i) {
        const int l = i ^ j;
        if (l > i) {
          const bool desc = ((i & k) == 0);
          CEP(v[i], pl[i], v[l], pl[l], desc);
        }
      }
    }
  }
}
template <int N>
__device__ __forceinline__ void bitonic_merge_desc_p(unsigned (&v)[N], unsigned (&pl)[N]) {
#pragma unroll
  for (int j = N >> 1; j > 0; j >>= 1) {
#pragma unroll
    for (int i = 0; i < N; ++i) {
      const int l = i ^ j;
      if (l > i) { CEP(v[i], pl[i], v[l], pl[l], true); }
    }
  }
}
__device__ __forceinline__ void merge_top16_p(unsigned (&a)[16], unsigned (&pa)[16], const unsigned (&b)[16], const unsigned (&pb)[16]) {
#pragma unroll
  for (int i = 0; i < 16; ++i) {
    const bool s = b[15 - i] > a[i];
    a[i] = s ? b[15 - i] : a[i];
    pa[i] = s ? pb[15 - i] : pa[i];
  }
  bitonic_merge_desc_p<16>(a, pa);
}

__device__ __forceinline__ void subkey_top16(const bf16_t* __restrict__ Kb, const bf16_t* __restrict__ qrow, int lane, unsigned (&top)[16]) {
  const int tok = lane & 31, hf = lane >> 5;
  f32x16 acc[4];
#pragma unroll
  for (int m = 0; m < 4; ++m)
#pragma unroll
    for (int i = 0; i < 16; ++i) acc[m][i] = 0.f;
#pragma unroll 1
  for (int ks = 0; ks < 4; ++ks) {
    const bf16x8 bq = *(const bf16x8*)(qrow + ks * 16 + 8 * hf);
#pragma unroll
    for (int m = 0; m < 4; ++m) {
      const bf16x8 ak = *(const bf16x8*)(Kb + (m * 32 + tok) * 64 + ks * 16 + 8 * hf);
      acc[m] = mfma32(ak, bq, acc[m]);
    }
  }
  unsigned g[4][16];
#pragma unroll
  for (int m = 0; m < 4; ++m) {
#pragma unroll
    for (int i = 0; i < 16; ++i) g[m][i] = f2key(acc[m][i], (unsigned)(m * 32 + (i & 3) + 8 * (i >> 2) + 4 * hf));
    bitonic_sort_desc<16>(g[m]);
  }
  merge_top16(g[0], g[1]);
  merge_top16(g[2], g[3]);
  merge_top16(g[0], g[2]);
  unsigned o[16];
#pragma unroll
  for (int i = 0; i < 16; ++i) o[i] = __shfl_xor(g[0][i], 32);
  merge_top16(g[0], o);
#pragma unroll
  for (int i = 0; i < 16; ++i) top[i] = g[0][i];
}

__device__ void phase_route(const Params& p) {
  unsigned char* ws = p.ws;
  const bf16_t* K1 = (const bf16_t*)(ws + WS_K1);
  const bf16_t* K2 = (const bf16_t*)(ws + WS_K2);
  const bf16_t* QH = (const bf16_t*)(ws + WS_QH);
  unsigned char* XN8 = ws + WS_XN8;
  const float* SSQ2 = (const float*)(ws + WS_SSQ2);
  unsigned* PIDX = (unsigned*)(ws + WS_PIDX);
  float* PG = (float*)(ws + WS_PG);
  const int tidr = otid();
  const int lane = tidr & 63, gw = vblock() * NWAVES + (tidr >> 6), nw = gridDim.x * NWAVES;
  for (int t = gw; t < T; t += nw) {
    const float* src = p.out + (size_t)t * 1024 + lane * 16;
    const float r = rsqrtf(SSQ2[t] * (1.f / 1024.f) + EPS) * 16.f;
    u32x4 q;
#pragma unroll
    for (int i = 0; i < 4; ++i) {
      const f32x4 a = *(const f32x4*)(src + 4 * i), g4 = *(const f32x4*)(p.norm_ffn_g + lane * 16 + 4 * i);
      int w = 0;
      w = __builtin_amdgcn_cvt_pk_fp8_f32(a.x * r * g4.x, a.y * r * g4.y, w, false);
      w = __builtin_amdgcn_cvt_pk_fp8_f32(a.z * r * g4.z, a.w * r * g4.w, w, true);
      q[i] = (unsigned)w;
    }
    *(u32x4*)(XN8 + (size_t)t * 1024 + lane * 16) = q;
  }
  for (int item = gw; item < 8192; item += nw) {
    const int hd = item & 7, t0 = (item >> 3) * 32;
    const int tok = lane & 31, hf = lane >> 5;
    const bf16_t* qrow = QH + (size_t)(t0 + tok) * 1024 + hd * 128;
    unsigned top1[16], top2[16];
    subkey_top16(K1 + hd * 8192, qrow, lane, top1);
    subkey_top16(K2 + hd * 8192, qrow + 64, lane, top2);
    float fa[16], fb[16];
    unsigned ia[16], ib[16];
#pragma unroll
    for (int i = 0; i < 16; ++i) {
      const unsigned ua = key2u(hf ? top2[i] : top1[i]), ub = key2u(hf ? top1[i] : top2[i]);
      fa[i] = __uint_as_float(ua); ia[i] = ua & 0x7Fu;
      fb[i] = __uint_as_float(ub); ib[i] = ub & 0x7Fu;
    }
    unsigned ck[32], cp[32];
    {
      int n = 0;
#pragma unroll
      for (int i = 0; i < 4; ++i) {
#pragma unroll
        for (int j = i; j < 16; ++j) {
          if ((i + 1) * (j + 1) <= 16) {
            unsigned key = f2key_raw(fa[i] + fb[j]);
            if (i == j && hf) key = 0u;
            ck[n] = key;
            cp[n] = hf ? ((ib[j] << 7) | ia[i]) : ((ia[i] << 7) | ib[j]);
            ++n;
          }
        }
      }
#pragma unroll
      for (; n < 32; ++n) { ck[n] = 0u; cp[n] = 0u; }
    }
    unsigned k0[16], p0[16], k1[16], p1[16];
#pragma unroll
    for (int i = 0; i < 16; ++i) { k0[i] = ck[i]; p0[i] = cp[i]; k1[i] = ck[16 + i]; p1[i] = cp[16 + i]; }
    bitonic_sort_desc_p<16>(k0, p0);
    bitonic_sort_desc_p<16>(k1, p1);
    merge_top16_p(k0, p0, k1, p1);
#pragma unroll
    for (int i = 0; i < 16; ++i) { k1[i] = __shfl_xor(k0[i], 32); p1[i] = __shfl_xor(p0[i], 32); }
    merge_top16_p(k0, p0, k1, p1);
    float sv[16], sum = 0.f;
    const float mx = __uint_as_float(key2u(k0[0]));
#pragma unroll
    for (int i = 0; i < 16; ++i) {
      sv[i] = __builtin_amdgcn_exp2f((__uint_as_float(key2u(k0[i])) - mx) * LOG2E);
      sum += sv[i];
    }
    const float inv = 1.f / sum;
    const size_t po = ((size_t)(t0 + tok) * 8 + hd) * 16;
    if (hf == 0) {
#pragma unroll
      for (int q = 0; q < 4; ++q) *(u32x4*)(PIDX + po + 4 * q) = (u32x4){p0[4 * q], p0[4 * q + 1], p0[4 * q + 2], p0[4 * q + 3]};
    } else {
#pragma unroll
      for (int q = 0; q < 4; ++q) *(f32x4*)(PG + po + 4 * q) = (f32x4){sv[4 * q] * inv, sv[4 * q + 1] * inv, sv[4 * q + 2] * inv, sv[4 * q + 3] * inv};
    }
  }
}

__device__ __forceinline__ f32x4 mfma_fp8(u32x2 a, u32x2 b, f32x4 c) {
  return __builtin_amdgcn_mfma_f32_16x16x32_fp8_fp8(__builtin_bit_cast(long, a), __builtin_bit_cast(long, b), c, 0, 0, 0);
}
struct PeCtx {
  const unsigned char* U8; const float* US; const float* VS; const float* PG; float* PW; float* dummy;
  LAS unsigned* list; int lane, r, g, s, n, t0;
};
__device__ __forceinline__ void pe_rows(const PeCtx& c, int ci, u32x4 (&a)[16]) {
  const int idx = ci * 16 + (c.lane >> 2);
  const unsigned ent = c.list[idx & 2047];
  const unsigned e = (idx < c.n) ? ((ent >> 7) & 16383u) : (unsigned)(c.s << 11);
  const unsigned char* rp = c.U8 + (size_t)e * 1024 + (c.lane & 3) * 16;
#pragma unroll
  for (int ks = 0; ks < 16; ++ks) a[ks] = *(const u32x4*)(rp + ks * 64);
}
__device__ __forceinline__ void pe_fix(const PeCtx& c, u32x4 (&a)[16]) {
  const int src = 4 * c.r + c.g;
#pragma unroll
  for (int ks = 0; ks < 16; ++ks) {
    a[ks].x = (unsigned)__shfl((int)a[ks].x, src); a[ks].y = (unsigned)__shfl((int)a[ks].y, src);
    a[ks].z = (unsigned)__shfl((int)a[ks].z, src); a[ks].w = (unsigned)__shfl((int)a[ks].w, src);
  }
}
__device__ __forceinline__ void pe_chunk(const PeCtx& c, int ci, u32x4 (&a)[16], u32x4 (&anext)[16], const u32x4 (&bq)[16]) {
  const int idx = ci * 16 + c.r;
  const unsigned ent = c.list[idx & 2047];
  const bool fin = (c.lane < 16) && (idx < c.n);
  const unsigned e = (ent >> 7) & 16383u, slot = ent & 127u, col = (ent >> 21) & 15u;
  const float gt = c.PG[fin ? (size_t)(c.t0 + col) * 128 + slot : (size_t)0], us = c.US[fin ? e : 0u], vs = c.VS[fin ? e : 0u];
  __builtin_amdgcn_sched_barrier(0);
  pe_rows(c, ci + 1, anext);
  __builtin_amdgcn_sched_barrier(0);
  pe_fix(c, a);
  f32x4 acc = {0.f, 0.f, 0.f, 0.f};
#pragma unroll
  for (int ks = 0; ks < 16; ++ks) {
    acc = mfma_fp8((u32x2){a[ks].x, a[ks].y}, (u32x2){bq[ks].x, bq[ks].y}, acc);
    acc = mfma_fp8((u32x2){a[ks].z, a[ks].w}, (u32x2){bq[ks].z, bq[ks].w}, acc);
  }
  const int src = ((c.r >> 2) << 4) | (int)col;
  const float v0 = __shfl(acc[0], src), v1 = __shfl(acc[1], src), v2 = __shfl(acc[2], src), v3 = __shfl(acc[3], src);
  float d = ((c.r & 3) == 0) ? v0 : ((c.r & 3) == 1) ? v1 : ((c.r & 3) == 2) ? v2 : v3;
  float gt_ = gt, us_ = us, vs_ = vs;
  asm volatile("" : "+v"(d), "+v"(gt_), "+v"(us_), "+v"(vs_));
  {
    const float act = d * us_ * (1.f / 16.f);
    float* dst = fin ? c.PW + (size_t)(c.t0 + col) * 128 + slot : c.dummy;
    *dst = gt_ * 0.5f * act * (1.f + erff(act * 0.70710678118654752f)) * vs_;
  }
}
__device__ void phase_peer_u(const Params& p, char* smem) {
  unsigned char* ws = p.ws;
  PeCtx c;
  c.U8 = ws + WS_U8; c.US = (const float*)(ws + WS_US); c.VS = (const float*)(ws + WS_VS);
  c.PG = (const float*)(ws + WS_PG); c.PW = (float*)(ws + WS_PW);
  c.dummy = (float*)(ws + WS_PW + 16 * MiB) + (size_t)blockIdx.x * NTHREADS + otid();
  const unsigned char* XN8 = ws + WS_XN8;
  const unsigned* PIDX = (const unsigned*)(ws + WS_PIDX);
  const int tidu = otid();
  const int lane = tidu & 63, wave = tidu >> 6;
  c.lane = lane; c.r = lane & 15; c.g = lane >> 4;
  c.list = (LAS unsigned*)(smem + wave * 8192);
  const int G = gridDim.x, ng = (G % 8 == 0) ? 8 : 1;
  const int x = blockIdx.x % ng, lw = (blockIdx.x / ng) * NWAVES + wave, nlw = (G / ng) * NWAVES;
  for (int s = x; s < 8; s += ng) {
    c.s = s;
    for (int grp = lw; grp < T / 16; grp += nlw) {
      const int t0 = grp * 16;
      c.t0 = t0;
      u32x4 bq[16];
      {
        const unsigned char* xp = XN8 + (size_t)(t0 + c.r) * 1024 + c.g * 16;
#pragma unroll
        for (int ks = 0; ks < 16; ++ks) bq[ks] = *(const u32x4*)(xp + ks * 64);
      }
      int n = 0;
#pragma unroll
      for (int q = 0; q < 8; ++q) {
        const u32x4 idv = *(const u32x4*)(PIDX + (size_t)t0 * 128 + q * 256 + lane * 4);
#pragma unroll
        for (int k = 0; k < 4; ++k) {
          const unsigned e = idv[k];
          const bool m = (int)(e >> 11) == s;
          const unsigned long long mk = __ballot(m);
          if (m) c.list[n + __builtin_amdgcn_mbcnt_hi((unsigned)(mk >> 32), __builtin_amdgcn_mbcnt_lo((unsigned)mk, 0))] =
                     ((unsigned)(2 * q + (lane >> 5)) << 21) | (e << 7) | (unsigned)((lane & 31) * 4 + k);
          n += __popcll(mk);
        }
      }
      asm volatile("s_waitcnt lgkmcnt(0)" ::: "memory");
      c.n = n;
      const int nch = (n + 15) >> 4;
      u32x4 a0[16], a1[16];
      pe_rows(c, 0, a0);
      {
        unsigned z = 0u;
#pragma unroll
        for (int ks = 0; ks < 16; ++ks) z |= a0[ks].w;
        asm volatile("" ::"v"(z));
      }
      if (nch > 0) {
        for (int ci = 0;; ci += 2) {
          pe_chunk(c, ci, a0, a1, bq);
          if (ci + 1 >= nch) break;
          pe_chunk(c, ci + 1, a1, a0, bq);
          if (ci + 2 >= nch) break;
        }
      }
      asm volatile("" ::: "memory");
    }
  }
}

__device__ void phase_peer_v(const Params& p) {
  unsigned char* ws = p.ws;
  const unsigned char* V8 = ws + WS_V8;
  const unsigned* PIDX = (const unsigned*)(ws + WS_PIDX);
  const float* PG = (const float*)(ws + WS_PW);
  const int tidv = otid();
  const int lane = tidv & 63, wave = tidv >> 6, pg = lane >> 3, c = lane & 7;
  const int G = gridDim.x, ng = (G % 8 == 0) ? 8 : 1;
  const int x = blockIdx.x % ng, lw = (blockIdx.x / ng) * NWAVES + wave, nlw = (G / ng) * NWAVES;
  const bool b5 = lane & 32, b4 = lane & 16, b3 = lane & 8;
  for (int s = x; s < 8; s += ng) {
    const unsigned char* base = V8 + (size_t)s * 16384 * 128 + c * 16;
    for (int t = lw; t < T; t += nlw) {
      u32x4 ei[4];
      f32x4 wi[4];
#pragma unroll
      for (int i = 0; i < 4; ++i) {
        ei[i] = *(const u32x4*)(PIDX + (size_t)t * 128 + pg * 16 + 4 * i);
        wi[i] = *(const f32x4*)(PG + (size_t)t * 128 + pg * 16 + 4 * i);
      }
      u32x4 rv[16];
#pragma unroll
      for (int i = 0; i < 16; ++i) rv[i] = *(const u32x4*)(base + (size_t)ei[i >> 2][i & 3] * 128);
      float acc[16];
#pragma unroll
      for (int k = 0; k < 16; ++k) acc[k] = 0.f;
#pragma unroll
      for (int i = 0; i < 16; ++i) {
        const float w = wi[i >> 2][i & 3];
#pragma unroll
        for (int q = 0; q < 4; ++q) {
          const f32x2 lo = __builtin_amdgcn_cvt_pk_f32_fp8((int)rv[i][q], false), hi = __builtin_amdgcn_cvt_pk_f32_fp8((int)rv[i][q], true);
          acc[4 * q] += w * lo.x; acc[4 * q + 1] += w * lo.y; acc[4 * q + 2] += w * hi.x; acc[4 * q + 3] += w * hi.y;
        }
      }
      float r8[8], r4[4], r2[2];
#pragma unroll
      for (int i = 0; i < 8; ++i) { const float keep = b5 ? acc[8 + i] : acc[i], send = b5 ? acc[i] : acc[8 + i]; r8[i] = keep + __shfl_xor(send, 32); }
#pragma unroll
      for (int i = 0; i < 4; ++i) { const float keep = b4 ? r8[4 + i] : r8[i], send = b4 ? r8[i] : r8[4 + i]; r4[i] = keep + __shfl_xor(send, 16); }
#pragma unroll
      for (int i = 0; i < 2; ++i) { const float keep = b3 ? r4[2 + i] : r4[i], send = b3 ? r4[i] : r4[2 + i]; r2[i] = keep + __shfl_xor(send, 8); }
      float* o = p.out + (size_t)t * 1024 + s * 128 + c * 16 + (b5 ? 8 : 0) + (b4 ? 4 : 0) + (b3 ? 2 : 0);
      float2 h = *(float2*)o;
      h.x += r2[0];
      h.y += r2[1];
      *(float2*)o = h;
    }
  }
}

#define XB_TMO      128
#define XB_XCNT(j)  (256  + 64 * (j))
#define XB_XSUB(j)  (1280 + 64 * (j))
#define XB_XGEN(j)  (2304 + 64 * (j))
#define XB_TOP      3328
#define XB_TOPGEN   3392
#define XCD_BAR_WORDS 3456
#define XB_SPIN_CAP (1u << 22)
__device__ __forceinline__ unsigned xb_ld(unsigned* p)              { return __hip_atomic_load(p, __ATOMIC_RELAXED, __HIP_MEMORY_SCOPE_AGENT); }
__device__ __forceinline__ unsigned xb_add(unsigned* p, unsigned v) { return __hip_atomic_fetch_add(p, v, __ATOMIC_RELAXED, __HIP_MEMORY_SCOPE_AGENT); }
__device__ __forceinline__ unsigned xb_xcc_id() { return (unsigned)__builtin_amdgcn_s_getreg((3 << 11) | 20) & 0xFu; }
#define XB_SPIN(cond, bar) do { unsigned _sp = 0; while (cond) { __builtin_amdgcn_s_sleep(1); \
    if ((++_sp & 255u) == 0u) { if (xb_ld(&(bar)[XB_TMO])) break; if (_sp > XB_SPIN_CAP) { atomicAdd(&(bar)[XB_TMO], 1u); break; } } } } while (0)
struct XcdBarrier { unsigned* bar; unsigned x; volatile LAS unsigned* st; };
__device__ __forceinline__ XcdBarrier xcd_barrier_post(unsigned* bar, volatile LAS unsigned* st) {
    XcdBarrier b; b.bar = bar; b.x = xb_xcc_id(); b.st = st;
    if (threadIdx.x == 0) (void)xb_add(&bar[XB_XCNT(b.x)], 1u);
    return b;
}
__device__ __forceinline__ void xcd_barrier_complete(unsigned* bar, unsigned x, unsigned& nloc, unsigned& nx) {
    const unsigned G = gridDim.x * gridDim.y * gridDim.z;
    unsigned sum, cnt, mine, sp = 0u;
    for (;;) {
        sum = 0u; cnt = 0u; mine = 0u;
#pragma unroll
        for (unsigned j = 0; j < 16; ++j) { const unsigned c = xb_ld(&bar[XB_XCNT(j)]); sum += c; cnt += (c > 0u) ? 1u : 0u; mine = (j == x) ? c : mine; }
        if (sum == G) break;
        __builtin_amdgcn_s_sleep(1);
        if ((++sp & 255u) == 0u) { if (xb_ld(&bar[XB_TMO])) break; if (sp > XB_SPIN_CAP) { atomicAdd(&bar[XB_TMO], 1u); break; } }
    }
    nloc = mine > 0u ? mine : 1u; nx = cnt > 0u ? cnt : 1u;
}
__device__ __forceinline__ void xcd_barrier(const XcdBarrier& b) {
    asm volatile("s_waitcnt vmcnt(0)" ::: "memory");
    __syncthreads();
    if (threadIdx.x == 0) {
        unsigned* bar = b.bar;
        __builtin_amdgcn_s_waitcnt(0);
        unsigned nloc = b.st[0], nx = b.st[1];
        if (nloc == 0u) { xcd_barrier_complete(bar, b.x, nloc, nx); b.st[0] = nloc; b.st[1] = nx; }
        const unsigned old = xb_add(&bar[XB_XSUB(b.x)], 1u);
        const unsigned gen = old / nloc;
        if (old + 1u == (gen + 1u) * nloc) {
            __builtin_amdgcn_fence(__ATOMIC_RELEASE, "agent");
            asm volatile("s_waitcnt vmcnt(0)" ::: "memory");
            const unsigned og = xb_add(&bar[XB_TOP], 1u);
            const unsigned tg = og / nx;
            if (og + 1u == (tg + 1u) * nx) xb_add(&bar[XB_TOPGEN], 1u);
            else XB_SPIN(xb_ld(&bar[XB_TOPGEN]) == tg, bar);
            __builtin_amdgcn_fence(__ATOMIC_ACQUIRE, "agent");
            xb_add(&bar[XB_XGEN(b.x)], 1u);
            asm volatile("s_waitcnt vmcnt(0)" ::: "memory");
        } else {
            XB_SPIN(xb_ld(&bar[XB_XGEN(b.x)]) == gen, bar);
            __builtin_amdgcn_fence(__ATOMIC_ACQUIRE, "agent");
            asm volatile("s_waitcnt vmcnt(0)" ::: "memory");
        }
    }
    __syncthreads();
}

__global__ void __launch_bounds__(NTHREADS, 2) k_fused(Params p) {
  __shared__ __attribute__((aligned(16))) char smem[LDS_BYTES];
  if (threadIdx.x == 0) *(u32x4*)(smem + LDS_BAR) = (u32x4){0u, 0u, 0u, 0u};
  __syncthreads();
  const XcdBarrier bar = xcd_barrier_post((unsigned*)(p.ws + WS_CTL), (volatile LAS unsigned*)(smem + LDS_BAR));
#ifdef PROBE_PHASE
  unsigned long long ts[12];
#define STAMP(k) ts[k] = __builtin_amdgcn_s_memrealtime();
#else
#define STAMP(k)
#endif
  STAMP(0)
  phase_prep(p);
  xcd_barrier(bar);
  STAMP(1)
  phase_inproj(p, smem);
  xcd_barrier(bar);
  STAMP(2)
  phase_mix(p, smem);
  xcd_barrier(bar);
  STAMP(3)
  phase_attn_norm(p);
  xcd_barrier(bar);
  STAMP(4)
  phase_outproj(p, smem);
  xcd_barrier(bar);
  STAMP(5)
  phase_qproj(p, smem);
  xcd_barrier(bar);
  STAMP(6)
  phase_route(p);
  xcd_barrier(bar);
  STAMP(7)
  phase_peer_u(p, smem);
  xcd_barrier(bar);
  STAMP(8)
  phase_peer_v(p);
#ifdef PROBE_PHASE
  xcd_barrier(bar);
  STAMP(9)
  if (blockIdx.x == 0 && threadIdx.x == 0) {
    const float us = (float)(ts[PROBE_PHASE + 1] - ts[PROBE_PHASE]) * 0.01f;
    p.out[12345] += us * (1.f / PROBE_DIV);
  }
#endif
}

extern "C" void kernel_launch(void* const* d_in, const int* in_sizes, int n_in, void* d_out, int out_size, void* d_ws, size_t ws_size,
                              hipStream_t stream) {
  if (n_in != 17 || ws_size < WS_END) {
    fprintf(stderr, "kernel_launch: unexpected n_in %d / ws_size %zu\n", n_in, ws_size);
    return;
  }
  Params p{};
  p.x = (const float*)d_in[0]; p.norm_mix_g = (const float*)d_in[1]; p.w_in = (const float*)d_in[2]; p.q_norm_g = (const float*)d_in[3];
  p.k_norm_g = (const float*)d_in[4]; p.attn_out_g = (const float*)d_in[5]; p.conv_w = (const float*)d_in[6]; p.conv_b = (const float*)d_in[7];
  p.conv_ln_g = (const float*)d_in[8]; p.conv_ln_b = (const float*)d_in[9]; p.w_out = (const float*)d_in[10]; p.norm_ffn_g = (const float*)d_in[11];
  p.peer_wq = (const float*)d_in[12]; p.peer_k1 = (const float*)d_in[13]; p.peer_k2 = (const float*)d_in[14]; p.peer_u = (const float*)d_in[15];
  p.peer_v = (const float*)d_in[16];
  p.out = (float*)d_out;
  p.ws = (unsigned char*)d_ws;
  static int grid_blocks = 0;
  if (!grid_blocks) {
    int dev = 0, cus = 0, per_cu = 0;
    (void)hipGetDevice(&dev);
    (void)hipDeviceGetAttribute(&cus, hipDeviceAttributeMultiprocessorCount, dev);
    (void)hipOccupancyMaxActiveBlocksPerMultiprocessor(&per_cu, k_fused, NTHREADS, 0);
    if (per_cu > 1) per_cu = 1;
    if (per_cu < 1) per_cu = 1;
    grid_blocks = cus * per_cu;
  }
  (void)hipMemsetAsync((char*)d_ws + WS_CTL, 0, XCD_BAR_WORDS * 4, stream);
  hipLaunchKernelGGL(k_fused, dim3(grid_blocks), dim3(NTHREADS), 0, stream, p);
}
```

```cpp
#include <hip/hip_runtime.h>
#include <cstdio>

#define LAS __attribute__((address_space(3)))
typedef unsigned short bf16_t;
typedef __bf16 bf16x8 __attribute__((ext_vector_type(8)));
typedef __bf16 bf16x2 __attribute__((ext_vector_type(2)));
typedef float f32x4 __attribute__((ext_vector_type(4)));
typedef float f32x16 __attribute__((ext_vector_type(16)));
typedef unsigned u32x4 __attribute__((ext_vector_type(4)));
typedef unsigned u32x2 __attribute__((ext_vector_type(2)));
typedef float f32x2 __attribute__((ext_vector_type(2)));

constexpr int SEQ = 4096, T = 8 * SEQ, D = 1024, NIN = 2560;
constexpr float EPS = 1e-6f;
constexpr float LOG2E = 1.4426950408889634f;

constexpr size_t MiB = 1u << 20;
constexpr size_t WS_W1 = 0, WS_WV = 4 * MiB, WS_WOUT = 5 * MiB, WS_WQ = 7 * MiB, WS_K1 = 9 * MiB, WS_K2 = 9 * MiB + 131072, WS_SSQ = 10 * MiB;
constexpr size_t WS_CTL = 11 * MiB;
constexpr size_t WS_US = 11 * MiB + 65536, WS_VS = 11 * MiB + 131072;
constexpr size_t WS_RS1 = 11 * MiB + 196608, WS_SSQ2 = 11 * MiB + 327680;
constexpr size_t WS_U8 = 12 * MiB, WS_V8 = 28 * MiB;
constexpr size_t WS_XB = 44 * MiB;
constexpr size_t WS_Q = 108 * MiB, WS_K = 140 * MiB, WS_VT = 172 * MiB, WS_HG = 204 * MiB, WS_MIX = 236 * MiB;
constexpr size_t WS_HB = 300 * MiB, WS_QH = 364 * MiB;
constexpr size_t WS_XN8 = 108 * MiB, WS_PIDX = 140 * MiB, WS_PG = 156 * MiB, WS_PW = 172 * MiB;
constexpr size_t WS_END = 428 * MiB;

struct Params {
  const float *x, *norm_mix_g, *w_in, *q_norm_g, *k_norm_g, *attn_out_g, *conv_w, *conv_b, *conv_ln_g, *conv_ln_b,
      *w_out, *norm_ffn_g, *peer_wq, *peer_k1, *peer_k2, *peer_u, *peer_v;
  float* out;
  unsigned char* ws;
};

constexpr int NTHREADS = 512, NWAVES = 8;
constexpr int LDS_STAGE = 131072, LDS_BAR = LDS_STAGE, LDS_BYTES = LDS_STAGE + 16;

__device__ __forceinline__ unsigned pk2(float lo, float hi) {
  bf16x2 v = {(__bf16)lo, (__bf16)hi};
  return __builtin_bit_cast(unsigned, v);
}
__device__ __forceinline__ float bflo(unsigned u) { return __uint_as_float(u << 16); }
__device__ __forceinline__ float bfhi(unsigned u) { return __uint_as_float(u & 0xffff0000u); }
__device__ __forceinline__ int otid() { int t = threadIdx.x; asm volatile("" : "+v"(t)); return t; }
__device__ __forceinline__ int vblock() {
  const int G = gridDim.x, b = blockIdx.x;
  return (G % 8 == 0) ? (b % 8) * (G / 8) + b / 8 : b;
}
__device__ __forceinline__ f32x16 mfma32(bf16x8 a, bf16x8 b, f32x16 c) { return __builtin_amdgcn_mfma_f32_32x32x16_bf16(a, b, c, 0, 0, 0); }

__device__ __forceinline__ int w1_src(int n) {
  if (n < 1024) {
    const int kind = n >> 9, rel = n & 511, pn = rel >> 8, P = rel & 255, bj = P >> 7, wc = (P >> 5) & 3, x = P & 31;
    return kind * 512 + (4 * pn + wc) * 64 + 32 * bj + x;
  }
  const int rel = n - 1024, pn = rel >> 8, P = rel & 255, bj = P >> 7, wc = (P >> 5) & 3, x = P & 31;
  return (bj ? 2048 : 1536) + 128 * pn + 32 * wc + x;
}
__device__ __forceinline__ void transpose_items(const float* __restrict__ W, int ldw, int N, bf16_t* __restrict__ Wt, const float* __restrict__ g, int glimit,
                                                int mode, long gtid, long nthr) {
  const long nitems = (long)N * 128;
  for (long it = gtid; it < nitems; it += nthr) {
    const int n = (int)(it % N), kc = (int)(it / N);
    const int src = mode == 1 ? w1_src(n) : (mode == 2 ? 1024 + n : n);
    float v[8];
#pragma unroll
    for (int i = 0; i < 8; ++i) {
      const int k = kc * 8 + i;
      float w = W[(size_t)k * ldw + src];
      if (k < glimit) w *= g[k];
      v[i] = w;
    }
    u32x4 o = {pk2(v[0], v[1]), pk2(v[2], v[3]), pk2(v[4], v[5]), pk2(v[6], v[7])};
    *(u32x4*)(Wt + (size_t)n * 1024 + kc * 8) = o;
  }
}
__device__ __forceinline__ void convert_items(const float* __restrict__ src, bf16_t* __restrict__ dst, long n8, long gtid, long nthr) {
  for (long it = gtid; it < n8; it += nthr) {
    const f32x4 a = *(const f32x4*)(src + it * 8), b = *(const f32x4*)(src + it * 8 + 4);
    u32x4 o = {pk2(a.x, a.y), pk2(a.z, a.w), pk2(b.x, b.y), pk2(b.z, b.w)};
    *(u32x4*)(dst + it * 8) = o;
  }
}
__device__ void phase_prep(const Params& p) {
  const int tid0 = otid();
  const long gtid = (long)vblock() * NTHREADS + tid0, nthr = (long)gridDim.x * NTHREADS;
  unsigned char* ws = p.ws;
  transpose_items(p.w_in, NIN, 2048, (bf16_t*)(ws + WS_W1), p.norm_mix_g, 1024, 1, gtid, nthr);
  transpose_items(p.w_in, NIN, 512, (bf16_t*)(ws + WS_WV), p.norm_mix_g, 1024, 2, gtid, nthr);
  transpose_items(p.w_out, D, D, (bf16_t*)(ws + WS_WOUT), p.attn_out_g, 512, 0, gtid, nthr);
  transpose_items(p.peer_wq, D, D, (bf16_t*)(ws + WS_WQ), p.norm_ffn_g, 1024, 0, gtid, nthr);
  convert_items(p.peer_k1, (bf16_t*)(ws + WS_K1), 65536 / 8, gtid, nthr);
  convert_items(p.peer_k2, (bf16_t*)(ws + WS_K2), 65536 / 8, gtid, nthr);
  const int lane = tid0 & 63, gw = vblock() * NWAVES + (tid0 >> 6), nw = gridDim.x * NWAVES;
  {
    bf16_t* XB = (bf16_t*)(ws + WS_XB);
    float* RS1 = (float*)(ws + WS_RS1);
    float* SSQ2 = (float*)(ws + WS_SSQ2);
    for (int t = gw; t < T; t += nw) {
      const float* src = p.x + (size_t)t * 1024 + lane * 4;
      f32x4 v[4];
      float ss = 0.f;
#pragma unroll
      for (int i = 0; i < 4; ++i) {
        v[i] = *(const f32x4*)(src + 256 * i);
        ss += v[i].x * v[i].x + v[i].y * v[i].y + v[i].z * v[i].z + v[i].w * v[i].w;
      }
#pragma unroll
      for (int o = 1; o < 64; o <<= 1) ss += __shfl_xor(ss, o);
#pragma unroll
      for (int i = 0; i < 4; ++i) *(u32x2*)(XB + (size_t)t * 1024 + lane * 4 + 256 * i) = (u32x2){pk2(v[i].x, v[i].y), pk2(v[i].z, v[i].w)};
      if (lane == 0) { RS1[t] = rsqrtf(ss * (1.f / 1024.f) + EPS); SSQ2[t] = 0.f; }
    }
  }
  {
    for (int r = gw; r < 32768; r += nw) {
      const int isv = r >> 14, e = r & 16383;
      const float* src = (isv ? p.peer_v : p.peer_u) + (size_t)e * 1024 + lane * 16;
      f32x4 v[4];
      float am = 0.f;
#pragma unroll
      for (int i = 0; i < 4; ++i) {
        v[i] = *(const f32x4*)(src + 4 * i);
        am = fmaxf(am, fmaxf(fmaxf(fabsf(v[i].x), fabsf(v[i].y)), fmaxf(fabsf(v[i].z), fabsf(v[i].w))));
      }
#pragma unroll
      for (int o = 1; o < 64; o <<= 1) am = fmaxf(am, __shfl_xor(am, o));
      const float scale = am > 0.f ? am * (1.f / 6.f) : 1.f, inv = am > 0.f ? 6.f / am : 0.f;
      unsigned q[2] = {0u, 0u};
#pragma unroll
      for (int i = 0; i < 4; ++i)
#pragma unroll
        for (int j = 0; j < 4; ++j) {
          const float xv = v[i][j], m = fabsf(xv) * inv;
          const unsigned code = (unsigned)(m > 0.25f) + (unsigned)(m > 0.75f) + (unsigned)(m > 1.25f) + (unsigned)(m > 1.75f) +
                                (unsigned)(m > 2.5f) + (unsigned)(m > 3.5f) + (unsigned)(m > 5.0f);
          const unsigned nib = code | (xv < 0.f ? 8u : 0u);
          const int el = 4 * i + j;
          q[el >> 3] |= nib << (4 * (el & 7));
        }
      if (isv) {
        *(u32x2*)(ws + WS_V8 + ((size_t)(lane >> 3) * 16384 + e) * 64 + (lane & 7) * 8) = (u32x2){q[0], q[1]};
        if (lane == 0) ((float*)(ws + WS_VS))[e] = scale;
      } else {
        *(u32x2*)(ws + WS_U8 + (size_t)e * 512 + lane * 8) = (u32x2){q[0], q[1]};
        if (lane == 0) ((float*)(ws + WS_US))[e] = scale;
      }
    }
  }
}

namespace pg8 {
typedef short sbf16x8 __attribute__((ext_vector_type(8)));
constexpr int BM = 256, BK = 64, HALF = 128, HTB = HALF * BK * 2  , NXCD = 8, WGM = 8;
__device__ __forceinline__ int lds_byte(int r, int c) { const int st = (r >> 4) * 2 + (c >> 5), rr = r & 15, cc = c & 31, ob = rr * 64 + cc * 2; return st * 1024 + (ob ^ (((ob >> 9) & 1) << 5)); }
__device__ __forceinline__ void stage_rc(int b, int& R, int& C) { const int st = b / 1024, sb = b % 1024, swz = sb ^ (((sb >> 9) & 1) << 5); R = (st >> 1) * 16 + swz / 64; C = (st & 1) * 32 + (swz % 64) / 2; }
__device__ __forceinline__ int perm32(int rho) { const int n = rho >> 4, i = rho & 15; return 8 * (i >> 2) + 4 * n + (i & 3); }
struct Unit { int pm, pn; };
struct Gemm { const bf16_t* A; const bf16_t* Bt; int M, N, K; };
struct StaticOrder {
    int nM, nN, nwg, G, c;
    __device__ void init(int M, int N, int G_, int c_) { nM = M / BM; nN = N / BM; nwg = nM * nN; G = G_; c = c_; }
    __device__ bool next(int i, Unit& u) const {
        const long L = (long)i * G + c; if (L >= nwg) return false;
        int wgid = (int)L; { const int q = nwg / NXCD, r = nwg % NXCD, xcd = wgid % NXCD, off = wgid / NXCD; wgid = (xcd < r ? xcd * (q + 1) : r * (q + 1) + (xcd - r) * q) + off; }
        const int nig = WGM * nN, gid = wgid / nig, fm = gid * WGM, gsz = (nM - fm) < WGM ? (nM - fm) : WGM;
        u.pm = fm + ((wgid % nig) % gsz); u.pn = (wgid % nig) / gsz; return true;
    }
};
template <class Epi>
__device__ __forceinline__ void gemm_phase(LAS unsigned char* lds, const Gemm g, const StaticOrder& S, const Epi& E) {
    const int tid = otid(), wid = __builtin_amdgcn_readfirstlane(tid >> 6), lane = tid & 63, wr = wid >> 2, wc = wid & 3, fr = lane & 15, fq = lane >> 4;
    const int K = g.K, nt = K / BK;
    unsigned voffA[2], voffB[2];
#pragma unroll
    for (int i = 0; i < 2; ++i) { int R, C; stage_rc(tid * 16 + i * 8192, R, C); const int Rb = Epi::PERM ? ((R & ~31) + perm32(R & 31)) : R;
        voffA[i] = (unsigned)(R * K + C) * 2u; voffB[i] = (unsigned)(Rb * K + C) * 2u; }
    const size_t kstep = (size_t)(BK * 2);
    const size_t hstep = (size_t)HALF * K * 2;
    const size_t tstep = 2 * hstep;
    const unsigned ldsw = (unsigned)wid * 1024u;
    const int aoff = lds_byte(wr * 64 + fr, fq * 8), boff = lds_byte(wc * 32 + fr, fq * 8);
#define PG8_SA(b, h) (((b) * 2 + (h)) * HTB)
#define PG8_SB(b, h) ((4 + (b) * 2 + (h)) * HTB)
#define PG8_STAGE(bufoff, gbase, voff) do { _Pragma("unroll") for (int _i = 0; _i < 2; ++_i) \
        __builtin_amdgcn_global_load_lds((const unsigned*)((const char*)(gbase) + (voff)[_i]), (LAS unsigned*)(lds + (bufoff) + ldsw + _i * 8192), 16, 0, 0); } while (0)
#define PG8_LDA(dst, b, h) do { _Pragma("unroll") for (int m = 0; m < 4; ++m) _Pragma("unroll") for (int k = 0; k < 2; ++k) dst[m][k] = *(const LAS sbf16x8*)(lds + PG8_SA(b, h) + aoff + m * 2048 + k * 1024); } while (0)
#define PG8_LDB(dst, b, h) do { _Pragma("unroll") for (int n = 0; n < 2; ++n) _Pragma("unroll") for (int k = 0; k < 2; ++k) dst[n][k] = *(const LAS sbf16x8*)(lds + PG8_SB(b, h) + boff + n * 2048 + k * 1024); } while (0)
#define PG8_MMA(ai, bj, At, Bt) do { __builtin_amdgcn_s_setprio(1); _Pragma("unroll") for (int m = 0; m < 4; ++m) _Pragma("unroll") for (int n = 0; n < 2; ++n) _Pragma("unroll") for (int k = 0; k < 2; ++k) \
        acc[ai][bj][m][n] = __builtin_amdgcn_mfma_f32_16x16x32_bf16(__builtin_bit_cast(bf16x8, Bt[n][k]), __builtin_bit_cast(bf16x8, At[m][k]), acc[ai][bj][m][n], 0, 0, 0); __builtin_amdgcn_s_setprio(0); } while (0)
#define PG8_WAIT_V(n) asm volatile("s_waitcnt vmcnt(" #n ")" ::: "memory")
#define PG8_WAIT_L(n) asm volatile("s_waitcnt lgkmcnt(" #n ")" ::: "memory")
#define PG8_BAR __builtin_amdgcn_s_barrier()
#define PG8_SCHED __builtin_amdgcn_sched_barrier(0)
    Unit cur, nxt; int ui = 0;
    if (!S.next(0, cur)) return;
    f32x4 acc[2][2][4][2];
#pragma unroll
    for (int a = 0; a < 2; ++a)
#pragma unroll
        for (int b = 0; b < 2; ++b)
#pragma unroll
            for (int m = 0; m < 4; ++m)
#pragma unroll
                for (int n = 0; n < 2; ++n) acc[a][b][m][n] = (f32x4){0.f, 0.f, 0.f, 0.f};
    sbf16x8 At[4][2], B0[2][2], B1[2][2];
    const char* cA = (const char*)g.A + (size_t)cur.pm * tstep; const char* cB = (const char*)g.Bt + (size_t)cur.pn * tstep;
    PG8_STAGE(PG8_SB(0, 0), cB, voffB); PG8_STAGE(PG8_SA(0, 0), cA, voffA); PG8_STAGE(PG8_SB(0, 1), cB + hstep, voffB); PG8_STAGE(PG8_SA(0, 1), cA + hstep, voffA);
    if (wr == 1) PG8_BAR;
    PG8_WAIT_V(4); PG8_BAR;
    PG8_STAGE(PG8_SB(1, 0), cB + kstep, voffB); PG8_STAGE(PG8_SA(1, 0), cA + kstep, voffA); PG8_STAGE(PG8_SB(1, 1), cB + hstep + kstep, voffB);
    PG8_WAIT_V(6); PG8_BAR;
    for (;;) {
        const bool has_next = S.next(ui + 1, nxt);
        const char* nA = has_next ? (const char*)g.A + (size_t)nxt.pm * tstep : cA; const char* nB = has_next ? (const char*)g.Bt + (size_t)nxt.pn * tstep : cB;
        for (int t = 0; t < nt; t += 2) {
            const bool last = (t == nt - 2);
            const char* a1 = cA + (size_t)(t + 1) * kstep;
            const char* a2 = last ? nA : cA + (size_t)(t + 2) * kstep; const char* b2 = last ? nB : cB + (size_t)(t + 2) * kstep;
            const char* a3 = a2 + kstep; const char* b3 = b2 + kstep;
            PG8_LDB(B0, 0, 0); PG8_SCHED; PG8_LDA(At, 0, 0); PG8_STAGE(PG8_SA(1, 1), a1 + hstep, voffA);
            PG8_WAIT_L(8); PG8_BAR; PG8_WAIT_L(0); PG8_MMA(0, 0, At, B0); PG8_BAR; PG8_SCHED;
            PG8_LDB(B1, 0, 1); PG8_STAGE(PG8_SB(0, 0), b2, voffB);
            PG8_BAR; PG8_WAIT_L(0); PG8_MMA(0, 1, At, B1); PG8_BAR;
            PG8_LDA(At, 0, 1); PG8_STAGE(PG8_SA(0, 0), a2, voffA);
            PG8_BAR; PG8_WAIT_L(0); PG8_MMA(1, 0, At, B0); PG8_BAR; PG8_SCHED;
            PG8_STAGE(PG8_SB(0, 1), b2 + hstep, voffB);
            PG8_WAIT_V(6); PG8_BAR; PG8_MMA(1, 1, At, B1); PG8_BAR;
            PG8_LDB(B0, 1, 0); PG8_SCHED; PG8_LDA(At, 1, 0); PG8_STAGE(PG8_SA(0, 1), a2 + hstep, voffA);
            PG8_WAIT_L(8); PG8_BAR; PG8_WAIT_L(0); PG8_MMA(0, 0, At, B0); PG8_BAR; PG8_SCHED;
            PG8_LDB(B1, 1, 1); PG8_STAGE(PG8_SB(1, 0), b3, voffB);
            PG8_BAR; PG8_WAIT_L(0); PG8_MMA(0, 1, At, B1); PG8_BAR;
            PG8_LDA(At, 1, 1); PG8_STAGE(PG8_SA(1, 0), a3, voffA);
            PG8_BAR; PG8_WAIT_L(0); PG8_MMA(1, 0, At, B0); PG8_BAR; PG8_SCHED;
            PG8_STAGE(PG8_SB(1, 1), b3 + hstep, voffB);
            PG8_WAIT_V(6); PG8_BAR; PG8_MMA(1, 1, At, B1); PG8_BAR;
        }
        E(acc, cur, wr, wc, fr, fq);
        if (!has_next) break;
#pragma unroll
        for (int a = 0; a < 2; ++a)
#pragma unroll
            for (int b = 0; b < 2; ++b)
#pragma unroll
                for (int m = 0; m < 4; ++m)
#pragma unroll
                    for (int n = 0; n < 2; ++n) acc[a][b][m][n] = (f32x4){0.f, 0.f, 0.f, 0.f};
        cur = nxt; cA = nA; cB = nB; ++ui;
    }
    PG8_WAIT_V(0);
    if (wr == 0) PG8_BAR;
    PG8_BAR;
#undef PG8_SA
#undef PG8_SB
#undef PG8_STAGE
#undef PG8_LDA
#undef PG8_LDB
#undef PG8_MMA
#undef PG8_WAIT_V
#undef PG8_WAIT_L
#undef PG8_BAR
#undef PG8_SCHED
}
}

struct EpiQKC {
  static constexpr bool PERM = true;
  const float* rs1; const float* qg; const float* kg; bf16_t* Q; bf16_t* Kk; bf16_t* HG;
  __device__ __forceinline__ void operator()(const f32x4 (&acc)[2][2][4][2], const pg8::Unit& u, int wr, int wc, int fr, int fq) const {
    const int row0 = u.pm * 256 + wr * 64 + fr;
    if (u.pn < 4) {
      const bool isq = u.pn < 2;
      const int head = 4 * (u.pn & 1) + wc;
      const float* g = isq ? qg : kg;
      f32x4 gv[2][2];
#pragma unroll
      for (int bj = 0; bj < 2; ++bj)
#pragma unroll
        for (int n = 0; n < 2; ++n) gv[bj][n] = *(const f32x4*)(g + 32 * bj + 8 * fq + 4 * n);
      bf16_t* base = isq ? Q : Kk;
#pragma unroll
      for (int ai = 0; ai < 2; ++ai)
#pragma unroll
        for (int m = 0; m < 4; ++m) {
          const int t = row0 + ai * 128 + m * 16;
          float ss = 0.f;
#pragma unroll
          for (int bj = 0; bj < 2; ++bj)
#pragma unroll
            for (int n = 0; n < 2; ++n) { const f32x4 v = acc[ai][bj][m][n]; ss += v.x * v.x + v.y * v.y + v.z * v.z + v.w * v.w; }
          ss += __shfl_xor(ss, 16);
          ss += __shfl_xor(ss, 32);
          const float r = rs1[t];
          float sc = r * rsqrtf(r * r * ss * (1.f / 64.f) + EPS);
          if (isq) sc *= 0.125f * LOG2E;
          bf16_t* dst = base + ((size_t)((t >> 12) * 8 + head) * 4096 + (t & 4095)) * 64 + 8 * fq;
#pragma unroll
          for (int bj = 0; bj < 2; ++bj) {
            const f32x4 a = acc[ai][bj][m][0] * gv[bj][0] * sc, b = acc[ai][bj][m][1] * gv[bj][1] * sc;
            *(u32x4*)(dst + 32 * bj) = (u32x4){pk2(a.x, a.y), pk2(a.z, a.w), pk2(b.x, b.y), pk2(b.z, b.w)};
          }
        }
    } else {
      const int ch0 = 128 * (u.pn - 4) + 32 * wc + 8 * fq;
#pragma unroll
      for (int ai = 0; ai < 2; ++ai)
#pragma unroll
        for (int m = 0; m < 4; ++m) {
          const int t = row0 + ai * 128 + m * 16;
          const float r = rs1[t];
          float h[8];
#pragma unroll
          for (int n = 0; n < 2; ++n)
#pragma unroll
            for (int j = 0; j < 4; ++j) h[4 * n + j] = acc[ai][0][m][n][j] * r / (1.f + __expf(-acc[ai][1][m][n][j] * r));
          *(u32x4*)(HG + (size_t)t * 512 + ch0) = (u32x4){pk2(h[0], h[1]), pk2(h[2], h[3]), pk2(h[4], h[5]), pk2(h[6], h[7])};
        }
    }
  }
};
struct EpiVt {
  static constexpr bool PERM = false;
  const float* rs1; bf16_t* Vt;
  __device__ __forceinline__ void operator()(const f32x4 (&acc)[2][2][4][2], const pg8::Unit& u, int wr, int wc, int fr, int fq) const {
    const int pos0 = 8 * (fq & 1) + 4 * (fq >> 1);
#pragma unroll
    for (int bj = 0; bj < 2; ++bj)
#pragma unroll
      for (int n = 0; n < 2; ++n) {
        const int t = u.pn * 256 + bj * 128 + wc * 32 + n * 16 + 4 * fq;
        const f32x4 r = *(const f32x4*)(rs1 + t);
        const size_t tb = ((size_t)(t >> 12) * 8) * 128 + ((t & 4095) >> 5);
#pragma unroll
        for (int ai = 0; ai < 2; ++ai)
#pragma unroll
          for (int m = 0; m < 4; ++m) {
            const int dg = u.pm * 256 + ai * 128 + wr * 64 + m * 16 + fr, head = dg >> 6, d = dg & 63;
            const f32x4 v = acc[ai][bj][m][n] * r;
            *(u32x2*)(Vt + ((tb + (size_t)head * 128) * 64 + d) * 32 + 16 * n + pos0) = (u32x2){pk2(v.x, v.y), pk2(v.z, v.w)};
          }
      }
  }
};
struct EpiOut {
  static constexpr bool PERM = false;
  const float* x; bf16_t* HB; float* ssq2;
  __device__ __forceinline__ void operator()(const f32x4 (&acc)[2][2][4][2], const pg8::Unit& u, int wr, int wc, int fr, int fq) const {
    const int row0 = u.pm * 256 + wr * 64 + fr, col0 = u.pn * 256 + wc * 32 + 4 * fq;
#pragma unroll
    for (int ai = 0; ai < 2; ++ai)
#pragma unroll
      for (int m = 0; m < 4; ++m) {
        const int t = row0 + ai * 128 + m * 16;
        const size_t ro = (size_t)t * 1024 + col0;
        float ss = 0.f;
#pragma unroll
        for (int bj = 0; bj < 2; ++bj)
#pragma unroll
          for (int n = 0; n < 2; ++n) {
            const size_t o = ro + bj * 128 + n * 16;
            const f32x4 h = *(const f32x4*)(x + o) + acc[ai][bj][m][n];
            *(u32x2*)(HB + o) = (u32x2){pk2(h.x, h.y), pk2(h.z, h.w)};
            ss += h.x * h.x + h.y * h.y + h.z * h.z + h.w * h.w;
          }
        ss += __shfl_xor(ss, 16);
        ss += __shfl_xor(ss, 32);
        if (fq == 0) atomicAdd(ssq2 + t, ss);
      }
  }
};
struct EpiQh {
  static constexpr bool PERM = true;
  const float* ssq2; bf16_t* QH;
  __device__ __forceinline__ void operator()(const f32x4 (&acc)[2][2][4][2], const pg8::Unit& u, int wr, int wc, int fr, int fq) const {
    const int row0 = u.pm * 256 + wr * 64 + fr, col0 = u.pn * 256 + wc * 32 + 8 * fq;
#pragma unroll
    for (int ai = 0; ai < 2; ++ai)
#pragma unroll
      for (int m = 0; m < 4; ++m) {
        const int t = row0 + ai * 128 + m * 16;
        const float r = rsqrtf(ssq2[t] * (1.f / 1024.f) + EPS);
#pragma unroll
        for (int bj = 0; bj < 2; ++bj) {
          const f32x4 a = acc[ai][bj][m][0] * r, b = acc[ai][bj][m][1] * r;
          *(u32x4*)(QH + (size_t)t * 1024 + col0 + bj * 128) = (u32x4){pk2(a.x, a.y), pk2(a.z, a.w), pk2(b.x, b.y), pk2(b.z, b.w)};
        }
      }
  }
};

__device__ void phase_inproj(const Params& p, char* smem) {
  unsigned char* ws = p.ws;
  LAS unsigned char* lds = (LAS unsigned char*)smem;
  const bf16_t* XB = (const bf16_t*)(ws + WS_XB);
  const float* RS1 = (const float*)(ws + WS_RS1);
  pg8::StaticOrder S;
  {
    pg8::Gemm g{XB, (const bf16_t*)(ws + WS_W1), T, 2048, 1024};
    S.init(T, 2048, gridDim.x, blockIdx.x);
    EpiQKC E{RS1, p.q_norm_g, p.k_norm_g, (bf16_t*)(ws + WS_Q), (bf16_t*)(ws + WS_K), (bf16_t*)(ws + WS_HG)};
    pg8::gemm_phase<EpiQKC>(lds, g, S, E);
  }
  {
    pg8::Gemm g{(const bf16_t*)(ws + WS_WV), XB, 512, T, 1024};
    S.init(512, T, gridDim.x, blockIdx.x);
    EpiVt E{RS1, (bf16_t*)(ws + WS_VT)};
    pg8::gemm_phase<EpiVt>(lds, g, S, E);
  }
}
__device__ void phase_outproj(const Params& p, char* smem) {
  unsigned char* ws = p.ws;
  pg8::Gemm g{(const bf16_t*)(ws + WS_MIX), (const bf16_t*)(ws + WS_WOUT), T, 1024, 1024};
  pg8::StaticOrder S;
  S.init(T, 1024, gridDim.x, blockIdx.x);
  EpiOut E{p.x, (bf16_t*)(ws + WS_HB), (float*)(ws + WS_SSQ2)};
  pg8::gemm_phase<EpiOut>((LAS unsigned char*)smem, g, S, E);
}
__device__ void phase_qproj(const Params& p, char* smem) {
  unsigned char* ws = p.ws;
  pg8::Gemm g{(const bf16_t*)(ws + WS_HB), (const bf16_t*)(ws + WS_WQ), T, 1024, 1024};
  pg8::StaticOrder S;
  S.init(T, 1024, gridDim.x, blockIdx.x);
  EpiQh E{(const float*)(ws + WS_SSQ2), (bf16_t*)(ws + WS_QH)};
  pg8::gemm_phase<EpiQh>((LAS unsigned char*)smem, g, S, E);
}

__device__ void conv_item(const Params& p, int item, char* smem) {
  unsigned char* ws = p.ws;
  const bf16_t* HG = (const bf16_t*)(ws + WS_HG);
  bf16_t* MIX = (bf16_t*)(ws + WS_MIX);
  const int tid512 = otid(), half = tid512 >> 8, tid = tid512 & 255, lane = tid & 63, wave = tid >> 6;
  const int t0 = item * 32, s0 = t0 & 4095;
  for (int idx = tid512; idx < 62 * 64; idx += NTHREADS) {
    const int r = idx >> 6, c16 = idx & 63;
    u32x4 v = {0u, 0u, 0u, 0u};
    if (s0 - 30 + r >= 0) v = *(const u32x4*)(HG + (size_t)(t0 - 30 + r) * 512 + c16 * 8);
    *(u32x4*)(smem + r * 1024 + c16 * 16) = v;
  }
  float w0[31], w1[31];
#pragma unroll
  for (int j = 0; j < 31; ++j) {
    const float2 w = *(const float2*)(p.conv_w + j * 512 + 2 * tid);
    w0[j] = w.x;
    w1[j] = w.y;
  }
  const float2 cb = *(const float2*)(p.conv_b + 2 * tid);
  const float2 lg = *(const float2*)(p.conv_ln_g + 2 * tid);
  const float2 lb = *(const float2*)(p.conv_ln_b + 2 * tid);
  float* red = (float*)(smem + 62 * 1024) + half * 16;
  __syncthreads();
  for (int t2 = 0; t2 < 16; ++t2) {
    const int tt = 2 * t2 + half;
    float a0 = cb.x, a1 = cb.y;
#pragma unroll
    for (int j = 0; j < 31; ++j) {
      const unsigned v = *(const unsigned*)(smem + (tt + j) * 1024 + tid * 4);
      a0 += w0[j] * bflo(v);
      a1 += w1[j] * bfhi(v);
    }
    float s1 = a0 + a1, s2 = a0 * a0 + a1 * a1;
#pragma unroll
    for (int o = 1; o < 64; o <<= 1) {
      s1 += __shfl_xor(s1, o);
      s2 += __shfl_xor(s2, o);
    }
    float* rr = red + (t2 & 1) * 8;
    if (lane == 0) {
      rr[wave * 2] = s1;
      rr[wave * 2 + 1] = s2;
    }
    __syncthreads();
    const float S1 = rr[0] + rr[2] + rr[4] + rr[6], S2 = rr[1] + rr[3] + rr[5] + rr[7];
    const float mu = S1 * (1.f / 512.f);
    const float var = fmaxf(S2 * (1.f / 512.f) - mu * mu, 0.f);
    const float rstd = rsqrtf(var + EPS);
    const float y0 = (a0 - mu) * rstd * lg.x + lb.x, y1 = (a1 - mu) * rstd * lg.y + lb.y;
    const float z0 = y0 / (1.f + __expf(-y0)), z1 = y1 / (1.f + __expf(-y1));
    *(unsigned*)(MIX + (size_t)(t0 + tt) * 1024 + 512 + 2 * tid) = pk2(z0, z1);
  }
  __syncthreads();
}

__device__ void attn_item(const Params& p, int item, int lane) {
  unsigned char* ws = p.ws;
  const bf16_t* Qm = (const bf16_t*)(ws + WS_Q);
  const bf16_t* Km = (const bf16_t*)(ws + WS_K);
  const bf16_t* Vt = (const bf16_t*)(ws + WS_VT);
  bf16_t* MIX = (bf16_t*)(ws + WS_MIX);
  float* SSQ = (float*)(ws + WS_SSQ);
  const int qt = item & 127, bh = item >> 7;
  const int tok = lane & 31, hf = lane >> 5;
  bf16x8 qf[4];
  {
    const bf16_t* qp = Qm + ((size_t)bh * 4096 + qt * 32 + tok) * 64 + 8 * hf;
#pragma unroll
    for (int ks = 0; ks < 4; ++ks) qf[ks] = *(const bf16x8*)(qp + ks * 16);
  }
  f32x16 o0, o1;
#pragma unroll
  for (int i = 0; i < 16; ++i) { o0[i] = 0.f; o1[i] = 0.f; }
  float c = 0.f;
  for (int kb = qt; kb >= 0; --kb) {
    const bf16_t* kp = Km + ((size_t)bh * 4096 + kb * 32 + tok) * 64 + 8 * hf;
    bf16x8 kf[4];
#pragma unroll
    for (int ks = 0; ks < 4; ++ks) kf[ks] = *(const bf16x8*)(kp + ks * 16);
    const bf16_t* vp = Vt + (((size_t)bh * 128 + kb) * 64 + tok) * 32 + hf * 8;
    bf16x8 vf[2][2];
#pragma unroll
    for (int m = 0; m < 2; ++m)
#pragma unroll
      for (int s = 0; s < 2; ++s) vf[m][s] = *(const bf16x8*)(vp + m * 1024 + s * 16);
    f32x16 sc;
#pragma unroll
    for (int i = 0; i < 16; ++i) sc[i] = 0.f;
#pragma unroll
    for (int ks = 0; ks < 4; ++ks) sc = mfma32(kf[ks], qf[ks], sc);
    const bool diag = (kb == qt);
    float lk[16], zs[16];
#pragma unroll
    for (int i = 0; i < 16; ++i) {
      const float zl = sc[i];
      const float e = __builtin_amdgcn_exp2f(zl);
      const float sp = __builtin_amdgcn_logf(1.f + e);
      const bool valid = !diag || ((i & 3) + 8 * (i >> 2) + 4 * hf < tok);
      lk[i] = valid ? -sp : 0.f;
      zs[i] = valid ? zl - sp : -1e30f;
    }
    float Tg[4], Pg[4];
#pragma unroll
    for (int g = 0; g < 4; ++g) {
      Tg[g] = (lk[4 * g] + lk[4 * g + 1]) + (lk[4 * g + 2] + lk[4 * g + 3]);
      Pg[g] = __shfl_xor(Tg[g], 32);
    }
    float base[4];
    float run = 0.f;
#pragma unroll
    for (int g = 3; g >= 0; --g) {
      base[g] = c + run + (hf == 0 ? Pg[g] : 0.f);
      run += Tg[g] + Pg[g];
    }
    float pr[16];
#pragma unroll
    for (int g = 0; g < 4; ++g) {
      float l = base[g];
#pragma unroll
      for (int r = 3; r >= 0; --r) {
        pr[4 * g + r] = __builtin_amdgcn_exp2f(zs[4 * g + r] + l);
        l += lk[4 * g + r];
      }
    }
    c += run;
    bf16x8 pf[2];
#pragma unroll
    for (int s = 0; s < 2; ++s)
#pragma unroll
      for (int j = 0; j < 8; ++j) pf[s][j] = (__bf16)pr[8 * s + j];
#pragma unroll
    for (int s = 0; s < 2; ++s) {
      o0 = mfma32(vf[0][s], pf[s], o0);
      o1 = mfma32(vf[1][s], pf[s], o1);
    }
    if (__all(c < -150.f)) break;
  }
  const int t = (bh >> 3) * 4096 + qt * 32 + tok, hh = bh & 7;
  float ssq = 0.f;
#pragma unroll
  for (int i = 0; i < 16; ++i) ssq += o0[i] * o0[i] + o1[i] * o1[i];
  ssq += __shfl_xor(ssq, 32);
  if (hf == 0) SSQ[t * 8 + hh] = ssq;
  bf16_t* dst = MIX + (size_t)t * 1024 + hh * 64 + 4 * hf;
#pragma unroll
  for (int g = 0; g < 4; ++g) {
    *(u32x2*)(dst + 8 * g) = (u32x2){pk2(o0[4 * g], o0[4 * g + 1]), pk2(o0[4 * g + 2], o0[4 * g + 3])};
    *(u32x2*)(dst + 32 + 8 * g) = (u32x2){pk2(o1[4 * g], o1[4 * g + 1]), pk2(o1[4 * g + 2], o1[4 * g + 3])};
  }
}

__device__ void phase_mix(const Params& p, char* smem) {
  const int vb = vblock(), G = gridDim.x;
  for (int item = vb; item < 1024; item += G) conv_item(p, item, smem);
  const int tidm = otid();
  const int lane = tidm & 63, gw = vb * NWAVES + (tidm >> 6), nw = G * NWAVES;
  for (int item = gw; item < 8192; item += nw) attn_item(p, item, lane);
}
__device__ void phase_attn_norm(const Params& p) {
  unsigned char* ws = p.ws;
  bf16_t* MIX = (bf16_t*)(ws + WS_MIX);
  const float* SSQ = (const float*)(ws + WS_SSQ);
  const int tids = otid();
  const int lane = tids & 63, gw = vblock() * NWAVES + (tids >> 6), nw = gridDim.x * NWAVES;
  for (int t = gw; t < T; t += nw) {
    const f32x4 a = *(const f32x4*)(SSQ + (size_t)t * 8), b = *(const f32x4*)(SSQ + (size_t)t * 8 + 4);
    const float rs = rsqrtf(((a.x + a.y) + (a.z + a.w) + (b.x + b.y) + (b.z + b.w)) * (1.f / 512.f) + EPS);
    u32x4* ptr = (u32x4*)(MIX + (size_t)t * 1024 + lane * 8);
    const u32x4 v = *ptr;
    *ptr = (u32x4){pk2(bflo(v.x) * rs, bfhi(v.x) * rs), pk2(bflo(v.y) * rs, bfhi(v.y) * rs), pk2(bflo(v.z) * rs, bfhi(v.z) * rs), pk2(bflo(v.w) * rs, bfhi(v.w) * rs)};
  }
}

__device__ __forceinline__ unsigned f2key(float f, unsigned n) {
  const unsigned u = (__float_as_uint(f) & ~0x7Fu) | n;
  return u ^ ((unsigned)((int)u >> 31) | 0x80000000u);
}
__device__ __forceinline__ unsigned f2key_raw(float f) {
  const unsigned u = __float_as_uint(f);
  return u ^ ((unsigned)((int)u >> 31) | 0x80000000u);
}
__device__ __forceinline__ unsigned key2u(unsigned k) { return k ^ ((k >> 31) ? 0x80000000u : 0xFFFFFFFFu); }

template <int N>
__device__ __forceinline__ void bitonic_sort_desc(unsigned (&v)[N]) {
#pragma unroll
  for (int k = 2; k <= N; k <<= 1) {
#pragma unroll
    for (int j = k >> 1; j > 0; j >>= 1) {
#pragma unroll
      for (int i = 0; i < N; ++i) {
        const int l = i ^ j;
        if (l > i) {
          const bool desc = ((i & k) == 0);
          const unsigned mx = max(v[i], v[l]), mn = min(v[i], v[l]);
          v[i] = desc ? mx : mn;
          v[l] = desc ? mn : mx;
        }
      }
    }
  }
}
template <int N>
__device__ __forceinline__ void bitonic_merge_desc(unsigned (&v)[N]) {
#pragma unroll
  for (int j = N >> 1; j > 0; j >>= 1) {
#pragma unroll
    for (int i = 0; i < N; ++i) {
      const int l = i ^ j;
      if (l > i) {
        const unsigned mx = max(v[i], v[l]), mn = min(v[i], v[l]);
        v[i] = mx;
        v[l] = mn;
      }
    }
  }
}
__device__ __forceinline__ void merge_top16(unsigned (&a)[16], const unsigned (&b)[16]) {
#pragma unroll
  for (int i = 0; i < 16; ++i) a[i] = max(a[i], b[15 - i]);
  bitonic_merge_desc<16>(a);
}
#define CEP(ka, pa, kb, pb, desc)                                  \
  {                                                                \
    const bool sw_ = (desc) ? ((kb) > (ka)) : ((kb) < (ka));       \
    const unsigned tk_ = sw_ ? (kb) : (ka), tl_ = sw_ ? (ka) : (kb); \
    const unsigned tp_ = sw_ ? (pb) : (pa), tq_ = sw_ ? (pa) : (pb); \
    ka = tk_; kb = tl_; pa = tp_; pb = tq_;                        \
  }
template <int N>
__device__ __forceinline__ void bitonic_sort_desc_p(unsigned (&v)[N], unsigned (&pl)[N]) {
#pragma unroll
  for (int k = 2; k <= N; k <<= 1) {
#pragma unroll
    for (int j = k >> 1; j > 0; j >>= 1) {
#pragma unroll
      for (int i = 0; i < N; ++i) {
        const int l = i ^ j;
        if (l > i) {
          const bool desc = ((i & k) == 0);
          CEP(v[i], pl[i], v[l], pl[l], desc);
        }
      }
    }
  }
}
template <int N>
__device__ __forceinline__ void bitonic_merge_desc_p(unsigned (&v)[N], unsigned (&pl)[N]) {
#pragma unroll
  for (int j = N >> 1; j > 0; j >>= 1) {
#pragma unroll
    for (int i = 0; i < N; ++i) {
      const int l = i ^ j;
      if (l > i) { CEP(v[i], pl[i], v[l], pl[l], true); }
    }
  }
}
__device__ __forceinline__ void merge_top16_p(unsigned (&a)[16], unsigned (&pa)[16], const unsigned (&b)[16], const unsigned (&pb)[16]) {
#pragma unroll
  for (int i = 0; i < 16; ++i) {
    const bool s = b[15 - i] > a[i];
    a[i] = s ? b[15 - i] : a[i];
    pa[i] = s ? pb[15 - i] : pa[i];
  }
  bitonic_merge_desc_p<16>(a, pa);
}

__device__ __forceinline__ void subkey_top16(const bf16_t* __restrict__ Kb, const bf16_t* __restrict__ qrow, int lane, unsigned (&top)[16]) {
  const int tok = lane & 31, hf = lane >> 5;
  f32x16 acc[4];
#pragma unroll
  for (int m = 0; m < 4; ++m)
#pragma unroll
    for (int i = 0; i < 16; ++i) acc[m][i] = 0.f;
#pragma unroll 1
  for (int ks = 0; ks < 4; ++ks) {
    const bf16x8 bq = *(const bf16x8*)(qrow + ks * 16 + 8 * hf);
#pragma unroll
    for (int m = 0; m < 4; ++m) {
      const bf16x8 ak = *(const bf16x8*)(Kb + (m * 32 + tok) * 64 + ks * 16 + 8 * hf);
      acc[m] = mfma32(ak, bq, acc[m]);
    }
  }
  unsigned g[4][16];
#pragma unroll
  for (int m = 0; m < 4; ++m) {
#pragma unroll
    for (int i = 0; i < 16; ++i) g[m][i] = f2key(acc[m][i], (unsigned)(m * 32 + (i & 3) + 8 * (i >> 2) + 4 * hf));
    bitonic_sort_desc<16>(g[m]);
  }
  merge_top16(g[0], g[1]);
  merge_top16(g[2], g[3]);
  merge_top16(g[0], g[2]);
  unsigned o[16];
#pragma unroll
  for (int i = 0; i < 16; ++i) o[i] = __shfl_xor(g[0][i], 32);
  merge_top16(g[0], o);
#pragma unroll
  for (int i = 0; i < 16; ++i) top[i] = g[0][i];
}

__device__ void phase_route(const Params& p) {
  unsigned char* ws = p.ws;
  const bf16_t* K1 = (const bf16_t*)(ws + WS_K1);
  const bf16_t* K2 = (const bf16_t*)(ws + WS_K2);
  const bf16_t* QH = (const bf16_t*)(ws + WS_QH);
  const bf16_t* HB = (const bf16_t*)(ws + WS_HB);
  unsigned char* XN8 = ws + WS_XN8;
  const float* SSQ2 = (const float*)(ws + WS_SSQ2);
  unsigned* PIDX = (unsigned*)(ws + WS_PIDX);
  float* PG = (float*)(ws + WS_PG);
  const int tidr = otid();
  const int lane = tidr & 63, gw = vblock() * NWAVES + (tidr >> 6), nw = gridDim.x * NWAVES;
  for (int t = gw; t < T; t += nw) {
    const bf16_t* src = HB + (size_t)t * 1024 + lane * 16;
    const float r = rsqrtf(SSQ2[t] * (1.f / 1024.f) + EPS) * 16.f;
    const u32x4 h0 = *(const u32x4*)src, h1 = *(const u32x4*)(src + 8);
    u32x4 q;
#pragma unroll
    for (int i = 0; i < 4; ++i) {
      const f32x4 g4 = *(const f32x4*)(p.norm_ffn_g + lane * 16 + 4 * i);
      const unsigned lo = (i < 2) ? h0[2 * i] : h1[2 * i - 4], hi = (i < 2) ? h0[2 * i + 1] : h1[2 * i - 3];
      int w = 0;
      w = __builtin_amdgcn_cvt_pk_fp8_f32(bflo(lo) * r * g4.x, bfhi(lo) * r * g4.y, w, false);
      w = __builtin_amdgcn_cvt_pk_fp8_f32(bflo(hi) * r * g4.z, bfhi(hi) * r * g4.w, w, true);
      q[i] = (unsigned)w;
    }
    *(u32x4*)(XN8 + (size_t)t * 1024 + lane * 16) = q;
  }
  for (int item = gw; item < 8192; item += nw) {
    const int hd = item & 7, t0 = (item >> 3) * 32;
    const int tok = lane & 31, hf = lane >> 5;
    const bf16_t* qrow = QH + (size_t)(t0 + tok) * 1024 + hd * 128;
    unsigned top1[16], top2[16];
    subkey_top16(K1 + hd * 8192, qrow, lane, top1);
    subkey_top16(K2 + hd * 8192, qrow + 64, lane, top2);
    float fa[16], fb[16];
    unsigned ia[16], ib[16];
#pragma unroll
    for (int i = 0; i < 16; ++i) {
      const unsigned ua = key2u(hf ? top2[i] : top1[i]), ub = key2u(hf ? top1[i] : top2[i]);
      fa[i] = __uint_as_float(ua); ia[i] = ua & 0x7Fu;
      fb[i] = __uint_as_float(ub); ib[i] = ub & 0x7Fu;
    }
    unsigned ck[32], cp[32];
    {
      int n = 0;
#pragma unroll
      for (int i = 0; i < 4; ++i) {
#pragma unroll
        for (int j = i; j < 16; ++j) {
          if ((i + 1) * (j + 1) <= 16) {
            unsigned key = f2key_raw(fa[i] + fb[j]);
            if (i == j && hf) key = 0u;
            ck[n] = key;
            cp[n] = hf ? ((ib[j] << 7) | ia[i]) : ((ia[i] << 7) | ib[j]);
            ++n;
          }
        }
      }
#pragma unroll
      for (; n < 32; ++n) { ck[n] = 0u; cp[n] = 0u; }
    }
    unsigned k0[16], p0[16], k1[16], p1[16];
#pragma unroll
    for (int i = 0; i < 16; ++i) { k0[i] = ck[i]; p0[i] = cp[i]; k1[i] = ck[16 + i]; p1[i] = cp[16 + i]; }
    bitonic_sort_desc_p<16>(k0, p0);
    bitonic_sort_desc_p<16>(k1, p1);
    merge_top16_p(k0, p0, k1, p1);
#pragma unroll
    for (int i = 0; i < 16; ++i) { k1[i] = __shfl_xor(k0[i], 32); p1[i] = __shfl_xor(p0[i], 32); }
    merge_top16_p(k0, p0, k1, p1);
    float sv[16], sum = 0.f;
    const float mx = __uint_as_float(key2u(k0[0]));
#pragma unroll
    for (int i = 0; i < 16; ++i) {
      sv[i] = __builtin_amdgcn_exp2f((__uint_as_float(key2u(k0[i])) - mx) * LOG2E);
      sum += sv[i];
    }
    const float inv = 1.f / sum;
    const size_t po = ((size_t)(t0 + tok) * 8 + hd) * 16;
    if (hf == 0) {
#pragma unroll
      for (int q = 0; q < 4; ++q) *(u32x4*)(PIDX + po + 4 * q) = (u32x4){p0[4 * q], p0[4 * q + 1], p0[4 * q + 2], p0[4 * q + 3]};
    } else {
#pragma unroll
      for (int q = 0; q < 4; ++q) *(f32x4*)(PG + po + 4 * q) = (f32x4){sv[4 * q] * inv, sv[4 * q + 1] * inv, sv[4 * q + 2] * inv, sv[4 * q + 3] * inv};
    }
  }
}

typedef int i32x8 __attribute__((ext_vector_type(8)));
__device__ __forceinline__ f32x4 mfma_fp4_fp8(u32x4 a, u32x4 b0, u32x4 b1, f32x4 c) {
  const i32x8 A = {(int)a.x, (int)a.y, (int)a.z, (int)a.w, 0, 0, 0, 0};
  const i32x8 B = {(int)b0.x, (int)b0.y, (int)b0.z, (int)b0.w, (int)b1.x, (int)b1.y, (int)b1.z, (int)b1.w};
  return __builtin_amdgcn_mfma_scale_f32_16x16x128_f8f6f4(A, B, c, 4, 0, 0, 0x7F7F7F7F, 0, 0x7F7F7F7F);
}
struct PeCtx {
  const unsigned char* U8; const float* US; const float* VS; const float* PG; float* PW; float* dummy;
  LAS unsigned* list; int lane, r, g, s, n, t0;
};
__device__ __forceinline__ void pe_rows(const PeCtx& c, int ci, u32x4 (&a)[8]) {
  const int idx = ci * 16 + (c.lane >> 2);
  const unsigned ent = c.list[idx & 2047];
  const unsigned e = (idx < c.n) ? ((ent >> 7) & 16383u) : (unsigned)(c.s << 11);
  const unsigned char* rp = c.U8 + (size_t)e * 512 + (c.lane & 3) * 16;
#pragma unroll
  for (int ks = 0; ks < 8; ++ks) a[ks] = *(const u32x4*)(rp + ks * 64);
}
__device__ __forceinline__ void pe_fix(const PeCtx& c, u32x4 (&a)[8]) {
  const int src = 4 * c.r + c.g;
#pragma unroll
  for (int ks = 0; ks < 8; ++ks) {
    a[ks].x = (unsigned)__shfl((int)a[ks].x, src); a[ks].y = (unsigned)__shfl((int)a[ks].y, src);
    a[ks].z = (unsigned)__shfl((int)a[ks].z, src); a[ks].w = (unsigned)__shfl((int)a[ks].w, src);
  }
}
__device__ __forceinline__ void pe_chunk(const PeCtx& c, int ci, u32x4 (&a)[8], u32x4 (&anext)[8], const u32x4 (&bq)[16]) {
  const int idx = ci * 16 + c.r;
  const unsigned ent = c.list[idx & 2047];
  const bool fin = (c.lane < 16) && (idx < c.n);
  const unsigned e = (ent >> 7) & 16383u, slot = ent & 127u, col = (ent >> 21) & 15u;
  const float gt = c.PG[fin ? (size_t)(c.t0 + col) * 128 + slot : (size_t)0], us = c.US[fin ? e : 0u], vs = c.VS[fin ? e : 0u];
  __builtin_amdgcn_sched_barrier(0);
  pe_rows(c, ci + 1, anext);
  __builtin_amdgcn_sched_barrier(0);
  pe_fix(c, a);
  f32x4 acc = {0.f, 0.f, 0.f, 0.f};
#pragma unroll
  for (int ks = 0; ks < 8; ++ks) acc = mfma_fp4_fp8(a[ks], bq[2 * ks], bq[2 * ks + 1], acc);
  const int src = ((c.r >> 2) << 4) | (int)col;
  const float v0 = __shfl(acc[0], src), v1 = __shfl(acc[1], src), v2 = __shfl(acc[2], src), v3 = __shfl(acc[3], src);
  float d = ((c.r & 3) == 0) ? v0 : ((c.r & 3) == 1) ? v1 : ((c.r & 3) == 2) ? v2 : v3;
  float gt_ = gt, us_ = us, vs_ = vs;
  asm volatile("" : "+v"(d), "+v"(gt_), "+v"(us_), "+v"(vs_));
  {
    const float act = d * us_ * (1.f / 16.f);
    float* dst = fin ? c.PW + (size_t)(c.t0 + col) * 128 + slot : c.dummy;
    *dst = gt_ * 0.5f * act * (1.f + erff(act * 0.70710678118654752f)) * vs_;
  }
}
__device__ void phase_peer_u(const Params& p, char* smem) {
  unsigned char* ws = p.ws;
  PeCtx c;
  c.U8 = ws + WS_U8; c.US = (const float*)(ws + WS_US); c.VS = (const float*)(ws + WS_VS);
  c.PG = (const float*)(ws + WS_PG); c.PW = (float*)(ws + WS_PW);
  c.dummy = (float*)(ws + WS_PW + 16 * MiB) + (size_t)blockIdx.x * NTHREADS + otid();
  const unsigned char* XN8 = ws + WS_XN8;
  const unsigned* PIDX = (const unsigned*)(ws + WS_PIDX);
  const int tidu = otid();
  const int lane = tidu & 63, wave = tidu >> 6;
  c.lane = lane; c.r = lane & 15; c.g = lane >> 4;
  c.list = (LAS unsigned*)(smem + wave * 8192);
  const int G = gridDim.x, ng = (G % 8 == 0) ? 8 : 1;
  const int x = blockIdx.x % ng, lw = (blockIdx.x / ng) * NWAVES + wave, nlw = (G / ng) * NWAVES;
  for (int s = x; s < 8; s += ng) {
    c.s = s;
    for (int grp = lw; grp < T / 16; grp += nlw) {
      const int t0 = grp * 16;
      c.t0 = t0;
      u32x4 bq[16];
      {
        const unsigned char* xp = XN8 + (size_t)(t0 + c.r) * 1024 + c.g * 16;
#pragma unroll
        for (int ks = 0; ks < 8; ++ks) { bq[2 * ks] = *(const u32x4*)(xp + ks * 128); bq[2 * ks + 1] = *(const u32x4*)(xp + ks * 128 + 64); }
      }
      int n = 0;
#pragma unroll
      for (int q = 0; q < 8; ++q) {
        const u32x4 idv = *(const u32x4*)(PIDX + (size_t)t0 * 128 + q * 256 + lane * 4);
#pragma unroll
        for (int k = 0; k < 4; ++k) {
          const unsigned e = idv[k];
          const bool m = (int)(e >> 11) == s;
          const unsigned long long mk = __ballot(m);
          if (m) c.list[n + __builtin_amdgcn_mbcnt_hi((unsigned)(mk >> 32), __builtin_amdgcn_mbcnt_lo((unsigned)mk, 0))] =
                     ((unsigned)(2 * q + (lane >> 5)) << 21) | (e << 7) | (unsigned)((lane & 31) * 4 + k);
          n += __popcll(mk);
        }
      }
      asm volatile("s_waitcnt lgkmcnt(0)" ::: "memory");
      c.n = n;
      const int nch = (n + 15) >> 4;
      u32x4 a0[8], a1[8];
      pe_rows(c, 0, a0);
      {
        unsigned z = 0u;
#pragma unroll
        for (int ks = 0; ks < 8; ++ks) z |= a0[ks].w;
        asm volatile("" ::"v"(z));
      }
      if (nch > 0) {
        for (int ci = 0;; ci += 2) {
          pe_chunk(c, ci, a0, a1, bq);
          if (ci + 1 >= nch) break;
          pe_chunk(c, ci + 1, a1, a0, bq);
          if (ci + 2 >= nch) break;
        }
      }
      asm volatile("" ::: "memory");
    }
  }
}

__device__ void phase_peer_v(const Params& p) {
  unsigned char* ws = p.ws;
  const unsigned char* V8 = ws + WS_V8;
  const bf16_t* HB = (const bf16_t*)(ws + WS_HB);
  const unsigned* PIDX = (const unsigned*)(ws + WS_PIDX);
  const float* PG = (const float*)(ws + WS_PW);
  const int tidv = otid();
  const int lane = tidv & 63, wave = tidv >> 6, pg = lane >> 2, c = lane & 3;
  const int G = gridDim.x, ng = (G % 8 == 0) ? 8 : 1;
  const int x = blockIdx.x % ng, lw = (blockIdx.x / ng) * NWAVES + wave, nlw = (G / ng) * NWAVES;
  const bool b5 = lane & 32, b4 = lane & 16, b3 = lane & 8, b2 = lane & 4;
  for (int s = x; s < 8; s += ng) {
    const unsigned char* base = V8 + (size_t)s * 16384 * 64 + c * 16;
    for (int t = lw; t < T; t += nlw) {
      u32x4 ei[2];
      f32x4 wi[2];
#pragma unroll
      for (int i = 0; i < 2; ++i) {
        ei[i] = *(const u32x4*)(PIDX + (size_t)t * 128 + pg * 8 + 4 * i);
        wi[i] = *(const f32x4*)(PG + (size_t)t * 128 + pg * 8 + 4 * i);
      }
      u32x4 rv[8];
#pragma unroll
      for (int i = 0; i < 8; ++i) rv[i] = *(const u32x4*)(base + (size_t)ei[i >> 2][i & 3] * 64);
      float acc[32];
#pragma unroll
      for (int k = 0; k < 32; ++k) acc[k] = 0.f;
#pragma unroll
      for (int i = 0; i < 8; ++i) {
        const float w = wi[i >> 2][i & 3];
#define FP4_ACC(q, bsel)                                                                         \
  {                                                                                              \
    const f32x2 v_ = __builtin_amdgcn_cvt_scalef32_pk_f32_fp4(rv[i][q], 1.0f, bsel);             \
    acc[8 * (q) + 2 * (bsel)] += w * v_.x;                                                       \
    acc[8 * (q) + 2 * (bsel) + 1] += w * v_.y;                                                   \
  }
#pragma unroll
        for (int q = 0; q < 4; ++q) { FP4_ACC(q, 0) FP4_ACC(q, 1) FP4_ACC(q, 2) FP4_ACC(q, 3) }
#undef FP4_ACC
      }
      float r16[16], r8[8], r4[4], r2[2];
#pragma unroll
      for (int i = 0; i < 16; ++i) { const float keep = b5 ? acc[16 + i] : acc[i], send = b5 ? acc[i] : acc[16 + i]; r16[i] = keep + __shfl_xor(send, 32); }
#pragma unroll
      for (int i = 0; i < 8; ++i) { const float keep = b4 ? r16[8 + i] : r16[i], send = b4 ? r16[i] : r16[8 + i]; r8[i] = keep + __shfl_xor(send, 16); }
#pragma unroll
      for (int i = 0; i < 4; ++i) { const float keep = b3 ? r8[4 + i] : r8[i], send = b3 ? r8[i] : r8[4 + i]; r4[i] = keep + __shfl_xor(send, 8); }
#pragma unroll
      for (int i = 0; i < 2; ++i) { const float keep = b2 ? r4[2 + i] : r4[i], send = b2 ? r4[i] : r4[2 + i]; r2[i] = keep + __shfl_xor(send, 4); }
      const size_t oo = (size_t)t * 1024 + s * 128 + c * 32 + (b5 ? 16 : 0) + (b4 ? 8 : 0) + (b3 ? 4 : 0) + (b2 ? 2 : 0);
      const unsigned hb = *(const unsigned*)(HB + oo);
      *(float2*)(p.out + oo) = make_float2(bflo(hb) + r2[0], bfhi(hb) + r2[1]);
    }
  }
}

#define XB_TMO      128
#define XB_XCNT(j)  (256  + 64 * (j))
#define XB_XSUB(j)  (1280 + 64 * (j))
#define XB_XGEN(j)  (2304 + 64 * (j))
#define XB_TOP      3328
#define XB_TOPGEN   3392
#define XCD_BAR_WORDS 3456
#define XB_SPIN_CAP (1u << 22)
__device__ __forceinline__ unsigned xb_ld(unsigned* p)              { return __hip_atomic_load(p, __ATOMIC_RELAXED, __HIP_MEMORY_SCOPE_AGENT); }
__device__ __forceinline__ unsigned xb_add(unsigned* p, unsigned v) { return __hip_atomic_fetch_add(p, v, __ATOMIC_RELAXED, __HIP_MEMORY_SCOPE_AGENT); }
__device__ __forceinline__ unsigned xb_xcc_id() { return (unsigned)__builtin_amdgcn_s_getreg((3 << 11) | 20) & 0xFu; }
#define XB_SPIN(cond, bar) do { unsigned _sp = 0; while (cond) { __builtin_amdgcn_s_sleep(1); \
    if ((++_sp & 255u) == 0u) { if (xb_ld(&(bar)[XB_TMO])) break; if (_sp > XB_SPIN_CAP) { atomicAdd(&(bar)[XB_TMO], 1u); break; } } } } while (0)
struct XcdBarrier { unsigned* bar; unsigned x; volatile LAS unsigned* st; };
__device__ __forceinline__ XcdBarrier xcd_barrier_post(unsigned* bar, volatile LAS unsigned* st) {
    XcdBarrier b; b.bar = bar; b.x = xb_xcc_id(); b.st = st;
    if (threadIdx.x == 0) (void)xb_add(&bar[XB_XCNT(b.x)], 1u);
    return b;
}
__device__ __forceinline__ void xcd_barrier_complete(unsigned* bar, unsigned x, unsigned& nloc, unsigned& nx) {
    const unsigned G = gridDim.x * gridDim.y * gridDim.z;
    unsigned sum, cnt, mine, sp = 0u;
    for (;;) {
        sum = 0u; cnt = 0u; mine = 0u;
#pragma unroll
        for (unsigned j = 0; j < 16; ++j) { const unsigned c = xb_ld(&bar[XB_XCNT(j)]); sum += c; cnt += (c > 0u) ? 1u : 0u; mine = (j == x) ? c : mine; }
        if (sum == G) break;
        __builtin_amdgcn_s_sleep(1);
        if ((++sp & 255u) == 0u) { if (xb_ld(&bar[XB_TMO])) break; if (sp > XB_SPIN_CAP) { atomicAdd(&bar[XB_TMO], 1u); break; } }
    }
    nloc = mine > 0u ? mine : 1u; nx = cnt > 0u ? cnt : 1u;
}
__device__ __forceinline__ void xcd_barrier(const XcdBarrier& b) {
    asm volatile("s_waitcnt vmcnt(0)" ::: "memory");
    __syncthreads();
    if (threadIdx.x == 0) {
        unsigned* bar = b.bar;
        __builtin_amdgcn_s_waitcnt(0);
        unsigned nloc = b.st[0], nx = b.st[1];
        if (nloc == 0u) { xcd_barrier_complete(bar, b.x, nloc, nx); b.st[0] = nloc; b.st[1] = nx; }
        const unsigned old = xb_add(&bar[XB_XSUB(b.x)], 1u);
        const unsigned gen = old / nloc;
        if (old + 1u == (gen + 1u) * nloc) {
            __builtin_amdgcn_fence(__ATOMIC_RELEASE, "agent");
            asm volatile("s_waitcnt vmcnt(0)" ::: "memory");
            const unsigned og = xb_add(&bar[XB_TOP], 1u);
            const unsigned tg = og / nx;
            if (og + 1u == (tg + 1u) * nx) xb_add(&bar[XB_TOPGEN], 1u);
            else XB_SPIN(xb_ld(&bar[XB_TOPGEN]) == tg, bar);
            __builtin_amdgcn_fence(__ATOMIC_ACQUIRE, "agent");
            xb_add(&bar[XB_XGEN(b.x)], 1u);
            asm volatile("s_waitcnt vmcnt(0)" ::: "memory");
        } else {
            XB_SPIN(xb_ld(&bar[XB_XGEN(b.x)]) == gen, bar);
            __builtin_amdgcn_fence(__ATOMIC_ACQUIRE, "agent");
            asm volatile("s_waitcnt vmcnt(0)" ::: "memory");
        }
    }
    __syncthreads();
}

__global__ void __launch_bounds__(NTHREADS, 2) k_fused(Params p) {
  __shared__ __attribute__((aligned(16))) char smem[LDS_BYTES];
  if (threadIdx.x == 0) *(u32x4*)(smem + LDS_BAR) = (u32x4){0u, 0u, 0u, 0u};
  __syncthreads();
  const XcdBarrier bar = xcd_barrier_post((unsigned*)(p.ws + WS_CTL), (volatile LAS unsigned*)(smem + LDS_BAR));
#ifdef PROBE_PHASE
  unsigned long long ts[12];
#define STAMP(k) ts[k] = __builtin_amdgcn_s_memrealtime();
#else
#define STAMP(k)
#endif
  STAMP(0)
  phase_prep(p);
  xcd_barrier(bar);
  STAMP(1)
  phase_inproj(p, smem);
  xcd_barrier(bar);
  STAMP(2)
  phase_mix(p, smem);
  xcd_barrier(bar);
  STAMP(3)
  phase_attn_norm(p);
  xcd_barrier(bar);
  STAMP(4)
  phase_outproj(p, smem);
  xcd_barrier(bar);
  STAMP(5)
  phase_qproj(p, smem);
  xcd_barrier(bar);
  STAMP(6)
  phase_route(p);
  xcd_barrier(bar);
  STAMP(7)
  phase_peer_u(p, smem);
  xcd_barrier(bar);
  STAMP(8)
  phase_peer_v(p);
#ifdef PROBE_PHASE
  xcd_barrier(bar);
  STAMP(9)
  if (blockIdx.x == 0 && threadIdx.x == 0) {
    const float us = (float)(ts[PROBE_PHASE + 1] - ts[PROBE_PHASE]) * 0.01f;
    p.out[12345] += us * (1.f / PROBE_DIV);
  }
#endif
}

extern "C" void kernel_launch(void* const* d_in, const int* in_sizes, int n_in, void* d_out, int out_size, void* d_ws, size_t ws_size,
                              hipStream_t stream) {
  if (n_in != 17 || ws_size < WS_END) {
    fprintf(stderr, "kernel_launch: unexpected n_in %d / ws_size %zu\n", n_in, ws_size);
    return;
  }
  Params p{};
  p.x = (const float*)d_in[0]; p.norm_mix_g = (const float*)d_in[1]; p.w_in = (const float*)d_in[2]; p.q_norm_g = (const float*)d_in[3];
  p.k_norm_g = (const float*)d_in[4]; p.attn_out_g = (const float*)d_in[5]; p.conv_w = (const float*)d_in[6]; p.conv_b = (const float*)d_in[7];
  p.conv_ln_g = (const float*)d_in[8]; p.conv_ln_b = (const float*)d_in[9]; p.w_out = (const float*)d_in[10]; p.norm_ffn_g = (const float*)d_in[11];
  p.peer_wq = (const float*)d_in[12]; p.peer_k1 = (const float*)d_in[13]; p.peer_k2 = (const float*)d_in[14]; p.peer_u = (const float*)d_in[15];
  p.peer_v = (const float*)d_in[16];
  p.out = (float*)d_out;
  p.ws = (unsigned char*)d_ws;
  static int grid_blocks = 0;
  if (!grid_blocks) {
    int dev = 0, cus = 0, per_cu = 0;
    (void)hipGetDevice(&dev);
    (void)hipDeviceGetAttribute(&cus, hipDeviceAttributeMultiprocessorCount, dev);
    (void)hipOccupancyMaxActiveBlocksPerMultiprocessor(&per_cu, k_fused, NTHREADS, 0);
    if (per_cu > 1) per_cu = 1;
    if (per_cu < 1) per_cu = 1;
    grid_blocks = cus * per_cu;
  }
  (void)hipMemsetAsync((char*)d_ws + WS_CTL, 0, XCD_BAR_WORDS * 4, stream);
  hipLaunchKernelGGL(k_fused, dim3(grid_blocks), dim3(NTHREADS), 0, stream, p);
}
```

```cpp
#include <hip/hip_runtime.h>
#include <cstdio>

#define LAS __attribute__((address_space(3)))
typedef unsigned short bf16_t;
typedef __bf16 bf16x8 __attribute__((ext_vector_type(8)));
typedef __bf16 bf16x2 __attribute__((ext_vector_type(2)));
typedef float f32x4 __attribute__((ext_vector_type(4)));
typedef float f32x16 __attribute__((ext_vector_type(16)));
typedef unsigned u32x4 __attribute__((ext_vector_type(4)));
typedef unsigned u32x2 __attribute__((ext_vector_type(2)));
typedef float f32x2 __attribute__((ext_vector_type(2)));

constexpr int SEQ = 4096, T = 8 * SEQ, D = 1024, NIN = 2560;
constexpr float EPS = 1e-6f;
constexpr float LOG2E = 1.4426950408889634f;

constexpr size_t MiB = 1u << 20;
constexpr size_t WS_W1 = 0, WS_WV = 4 * MiB, WS_WOUT = 5 * MiB, WS_WQ = 7 * MiB, WS_K1 = 9 * MiB, WS_K2 = 9 * MiB + 131072, WS_SSQ = 10 * MiB;
constexpr size_t WS_CTL = 11 * MiB;
constexpr size_t WS_US = 11 * MiB + 65536, WS_VS = 11 * MiB + 131072;
constexpr size_t WS_RS1 = 11 * MiB + 196608, WS_SSQ2 = 11 * MiB + 327680;
constexpr size_t WS_U8 = 12 * MiB, WS_V8 = 28 * MiB;
constexpr size_t WS_XB = 44 * MiB;
constexpr size_t WS_Q = 108 * MiB, WS_K = 140 * MiB, WS_VT = 172 * MiB, WS_HG = 204 * MiB, WS_MIX = 236 * MiB;
constexpr size_t WS_HB = 300 * MiB, WS_QH = 364 * MiB;
constexpr size_t WS_XN8 = 108 * MiB, WS_PIDX = 140 * MiB, WS_PG = 156 * MiB, WS_PW = 172 * MiB;
constexpr size_t WS_END = 428 * MiB;

struct Params {
  const float *x, *norm_mix_g, *w_in, *q_norm_g, *k_norm_g, *attn_out_g, *conv_w, *conv_b, *conv_ln_g, *conv_ln_b,
      *w_out, *norm_ffn_g, *peer_wq, *peer_k1, *peer_k2, *peer_u, *peer_v;
  float* out;
  unsigned char* ws;
};

constexpr int NTHREADS = 512, NWAVES = 8;
constexpr int LDS_STAGE = 131072, LDS_BAR = LDS_STAGE, LDS_BYTES = LDS_STAGE + 16;

__device__ __forceinline__ unsigned pk2(float lo, float hi) {
  bf16x2 v = {(__bf16)lo, (__bf16)hi};
  return __builtin_bit_cast(unsigned, v);
}
__device__ __forceinline__ float bflo(unsigned u) { return __uint_as_float(u << 16); }
__device__ __forceinline__ float bfhi(unsigned u) { return __uint_as_float(u & 0xffff0000u); }
__device__ __forceinline__ int otid() { int t = threadIdx.x; asm volatile("" : "+v"(t)); return t; }
__device__ __forceinline__ int vblock() {
  const int G = gridDim.x, b = blockIdx.x;
  return (G % 8 == 0) ? (b % 8) * (G / 8) + b / 8 : b;
}
__device__ __forceinline__ f32x16 mfma32(bf16x8 a, bf16x8 b, f32x16 c) { return __builtin_amdgcn_mfma_f32_32x32x16_bf16(a, b, c, 0, 0, 0); }

__device__ __forceinline__ int w1_src(int n) {
  if (n < 1024) {
    const int kind = n >> 9, rel = n & 511, pn = rel >> 8, P = rel & 255, bj = P >> 7, wc = (P >> 5) & 3, x = P & 31;
    return kind * 512 + (4 * pn + wc) * 64 + 32 * bj + x;
  }
  const int rel = n - 1024, pn = rel >> 8, P = rel & 255, bj = P >> 7, wc = (P >> 5) & 3, x = P & 31;
  return (bj ? 2048 : 1536) + 128 * pn + 32 * wc + x;
}
__device__ __forceinline__ void transpose_items(const float* __restrict__ W, int ldw, int N, bf16_t* __restrict__ Wt, const float* __restrict__ g, int glimit,
                                                int mode, long gtid, long nthr) {
  const long nitems = (long)N * 128;
  for (long it = gtid; it < nitems; it += nthr) {
    const int n = (int)(it % N), kc = (int)(it / N);
    const int src = mode == 1 ? w1_src(n) : (mode == 2 ? 1024 + n : n);
    float v[8];
#pragma unroll
    for (int i = 0; i < 8; ++i) {
      const int k = kc * 8 + i;
      float w = W[(size_t)k * ldw + src];
      if (k < glimit) w *= g[k];
      v[i] = w;
    }
    u32x4 o = {pk2(v[0], v[1]), pk2(v[2], v[3]), pk2(v[4], v[5]), pk2(v[6], v[7])};
    *(u32x4*)(Wt + (size_t)n * 1024 + kc * 8) = o;
  }
}
__device__ __forceinline__ void convert_items(const float* __restrict__ src, bf16_t* __restrict__ dst, long n8, long gtid, long nthr) {
  for (long it = gtid; it < n8; it += nthr) {
    const f32x4 a = *(const f32x4*)(src + it * 8), b = *(const f32x4*)(src + it * 8 + 4);
    u32x4 o = {pk2(a.x, a.y), pk2(a.z, a.w), pk2(b.x, b.y), pk2(b.z, b.w)};
    *(u32x4*)(dst + it * 8) = o;
  }
}
__device__ void phase_prep(const Params& p) {
  const int tid0 = otid();
  const long gtid = (long)vblock() * NTHREADS + tid0, nthr = (long)gridDim.x * NTHREADS;
  unsigned char* ws = p.ws;
  transpose_items(p.w_in, NIN, 2048, (bf16_t*)(ws + WS_W1), p.norm_mix_g, 1024, 1, gtid, nthr);
  transpose_items(p.w_in, NIN, 512, (bf16_t*)(ws + WS_WV), p.norm_mix_g, 1024, 2, gtid, nthr);
  transpose_items(p.w_out, D, D, (bf16_t*)(ws + WS_WOUT), p.attn_out_g, 512, 0, gtid, nthr);
  transpose_items(p.peer_wq, D, D, (bf16_t*)(ws + WS_WQ), p.norm_ffn_g, 1024, 0, gtid, nthr);
  convert_items(p.peer_k1, (bf16_t*)(ws + WS_K1), 65536 / 8, gtid, nthr);
  convert_items(p.peer_k2, (bf16_t*)(ws + WS_K2), 65536 / 8, gtid, nthr);
  const int lane = tid0 & 63, gw = vblock() * NWAVES + (tid0 >> 6), nw = gridDim.x * NWAVES;
  {
    bf16_t* XB = (bf16_t*)(ws + WS_XB);
    float* RS1 = (float*)(ws + WS_RS1);
    float* SSQ2 = (float*)(ws + WS_SSQ2);
    for (int tb = gw; tb < T; tb += 2 * nw) {
      f32x4 v[2][4];
      float ss[2] = {0.f, 0.f};
#pragma unroll
      for (int u = 0; u < 2; ++u) {
        const int t = (tb + u * nw < T) ? tb + u * nw : tb;
        const float* src = p.x + (size_t)t * 1024 + lane * 4;
#pragma unroll
        for (int i = 0; i < 4; ++i) v[u][i] = *(const f32x4*)(src + 256 * i);
      }
#pragma unroll
      for (int u = 0; u < 2; ++u) {
#pragma unroll
        for (int i = 0; i < 4; ++i) ss[u] += v[u][i].x * v[u][i].x + v[u][i].y * v[u][i].y + v[u][i].z * v[u][i].z + v[u][i].w * v[u][i].w;
      }
#pragma unroll
      for (int o = 1; o < 64; o <<= 1) { ss[0] += __shfl_xor(ss[0], o); ss[1] += __shfl_xor(ss[1], o); }
#pragma unroll
      for (int u = 0; u < 2; ++u) {
        const int t = tb + u * nw;
        if (t < T) {
#pragma unroll
          for (int i = 0; i < 4; ++i) *(u32x2*)(XB + (size_t)t * 1024 + lane * 4 + 256 * i) = (u32x2){pk2(v[u][i].x, v[u][i].y), pk2(v[u][i].z, v[u][i].w)};
          if (lane == 0) { RS1[t] = rsqrtf(ss[u] * (1.f / 1024.f) + EPS); SSQ2[t] = 0.f; }
        }
      }
    }
  }
  {
    for (int rb = gw; rb < 32768; rb += 2 * nw) {
      f32x4 v[2][4];
#pragma unroll
      for (int u = 0; u < 2; ++u) {
        const int r = (rb + u * nw < 32768) ? rb + u * nw : rb;
        const float* src = ((r >> 14) ? p.peer_v : p.peer_u) + (size_t)(r & 16383) * 1024 + lane * 16;
#pragma unroll
        for (int i = 0; i < 4; ++i) v[u][i] = *(const f32x4*)(src + 4 * i);
      }
      float am[2] = {0.f, 0.f};
#pragma unroll
      for (int u = 0; u < 2; ++u)
#pragma unroll
        for (int i = 0; i < 4; ++i)
          am[u] = fmaxf(am[u], fmaxf(fmaxf(fabsf(v[u][i].x), fabsf(v[u][i].y)), fmaxf(fabsf(v[u][i].z), fabsf(v[u][i].w))));
#pragma unroll
      for (int o = 1; o < 64; o <<= 1) { am[0] = fmaxf(am[0], __shfl_xor(am[0], o)); am[1] = fmaxf(am[1], __shfl_xor(am[1], o)); }
#pragma unroll
      for (int u = 0; u < 2; ++u) {
        const int r = rb + u * nw;
        if (r < 32768) {
          const int isv = r >> 14, e = r & 16383;
          const float scale = am[u] > 0.f ? am[u] * (1.f / 6.f) : 1.f, inv = am[u] > 0.f ? 6.f / am[u] : 0.f;
          unsigned q[2] = {0u, 0u};
#pragma unroll
          for (int i = 0; i < 4; ++i)
#pragma unroll
            for (int j = 0; j < 4; ++j) {
              const float xv = v[u][i][j], m = fabsf(xv) * inv;
              const unsigned code = (unsigned)(m > 0.25f) + (unsigned)(m > 0.75f) + (unsigned)(m > 1.25f) + (unsigned)(m > 1.75f) +
                                    (unsigned)(m > 2.5f) + (unsigned)(m > 3.5f) + (unsigned)(m > 5.0f);
              const unsigned nib = code | (xv < 0.f ? 8u : 0u);
              const int el = 4 * i + j;
              q[el >> 3] |= nib << (4 * (el & 7));
            }
          if (isv) {
            *(u32x2*)(ws + WS_V8 + ((size_t)(lane >> 4) * 16384 + e) * 128 + (lane & 15) * 8) = (u32x2){q[0], q[1]};
            if (lane == 0) ((float*)(ws + WS_VS))[e] = scale;
          } else {
            *(u32x2*)(ws + WS_U8 + (size_t)e * 512 + lane * 8) = (u32x2){q[0], q[1]};
            if (lane == 0) ((float*)(ws + WS_US))[e] = scale;
          }
        }
      }
    }
  }
}

namespace pg8 {
typedef short sbf16x8 __attribute__((ext_vector_type(8)));
constexpr int BM = 256, BK = 64, HALF = 128, HTB = HALF * BK * 2  , NXCD = 8, WGM = 8;
__device__ __forceinline__ int lds_byte(int r, int c) { const int st = (r >> 4) * 2 + (c >> 5), rr = r & 15, cc = c & 31, ob = rr * 64 + cc * 2; return st * 1024 + (ob ^ (((ob >> 9) & 1) << 5)); }
__device__ __forceinline__ void stage_rc(int b, int& R, int& C) { const int st = b / 1024, sb = b % 1024, swz = sb ^ (((sb >> 9) & 1) << 5); R = (st >> 1) * 16 + swz / 64; C = (st & 1) * 32 + (swz % 64) / 2; }
__device__ __forceinline__ int perm32(int rho) { const int n = rho >> 4, i = rho & 15; return 8 * (i >> 2) + 4 * n + (i & 3); }
struct Unit { int pm, pn; };
struct Gemm { const bf16_t* A; const bf16_t* Bt; int M, N, K; };
struct StaticOrder {
    int nM, nN, nwg, G, c;
    __device__ void init(int M, int N, int G_, int c_) { nM = M / BM; nN = N / BM; nwg = nM * nN; G = G_; c = c_; }
    __device__ bool next(int i, Unit& u) const {
        const long L = (long)i * G + c; if (L >= nwg) return false;
        int wgid = (int)L; { const int q = nwg / NXCD, r = nwg % NXCD, xcd = wgid % NXCD, off = wgid / NXCD; wgid = (xcd < r ? xcd * (q + 1) : r * (q + 1) + (xcd - r) * q) + off; }
        const int nig = WGM * nN, gid = wgid / nig, fm = gid * WGM, gsz = (nM - fm) < WGM ? (nM - fm) : WGM;
        u.pm = fm + ((wgid % nig) % gsz); u.pn = (wgid % nig) / gsz; return true;
    }
};
template <class Epi>
__device__ __forceinline__ void gemm_phase(LAS unsigned char* lds, const Gemm g, const StaticOrder& S, const Epi& E) {
    const int tid = otid(), wid = __builtin_amdgcn_readfirstlane(tid >> 6), lane = tid & 63, wr = wid >> 2, wc = wid & 3, fr = lane & 15, fq = lane >> 4;
    const int K = g.K, nt = K / BK;
    unsigned voffA[2], voffB[2];
#pragma unroll
    for (int i = 0; i < 2; ++i) { int R, C; stage_rc(tid * 16 + i * 8192, R, C); const int Rb = Epi::PERM ? ((R & ~31) + perm32(R & 31)) : R;
        voffA[i] = (unsigned)(R * K + C) * 2u; voffB[i] = (unsigned)(Rb * K + C) * 2u; }
    const size_t kstep = (size_t)(BK * 2);
    const size_t hstep = (size_t)HALF * K * 2;
    const size_t tstep = 2 * hstep;
    const unsigned ldsw = (unsigned)wid * 1024u;
    const int aoff = lds_byte(wr * 64 + fr, fq * 8), boff = lds_byte(wc * 32 + fr, fq * 8);
#define PG8_SA(b, h) (((b) * 2 + (h)) * HTB)
#define PG8_SB(b, h) ((4 + (b) * 2 + (h)) * HTB)
#define PG8_STAGE(bufoff, gbase, voff) do { _Pragma("unroll") for (int _i = 0; _i < 2; ++_i) \
        __builtin_amdgcn_global_load_lds((const unsigned*)((const char*)(gbase) + (voff)[_i]), (LAS unsigned*)(lds + (bufoff) + ldsw + _i * 8192), 16, 0, 0); } while (0)
#define PG8_LDA(dst, b, h) do { _Pragma("unroll") for (int m = 0; m < 4; ++m) _Pragma("unroll") for (int k = 0; k < 2; ++k) dst[m][k] = *(const LAS sbf16x8*)(lds + PG8_SA(b, h) + aoff + m * 2048 + k * 1024); } while (0)
#define PG8_LDB(dst, b, h) do { _Pragma("unroll") for (int n = 0; n < 2; ++n) _Pragma("unroll") for (int k = 0; k < 2; ++k) dst[n][k] = *(const LAS sbf16x8*)(lds + PG8_SB(b, h) + boff + n * 2048 + k * 1024); } while (0)
#define PG8_MMA(ai, bj, At, Bt) do { __builtin_amdgcn_s_setprio(1); _Pragma("unroll") for (int m = 0; m < 4; ++m) _Pragma("unroll") for (int n = 0; n < 2; ++n) _Pragma("unroll") for (int k = 0; k < 2; ++k) \
        acc[ai][bj][m][n] = __builtin_amdgcn_mfma_f32_16x16x32_bf16(__builtin_bit_cast(bf16x8, Bt[n][k]), __builtin_bit_cast(bf16x8, At[m][k]), acc[ai][bj][m][n], 0, 0, 0); __builtin_amdgcn_s_setprio(0); } while (0)
#define PG8_WAIT_V(n) asm volatile("s_waitcnt vmcnt(" #n ")" ::: "memory")
#define PG8_WAIT_L(n) asm volatile("s_waitcnt lgkmcnt(" #n ")" ::: "memory")
#define PG8_BAR __builtin_amdgcn_s_barrier()
#define PG8_SCHED __builtin_amdgcn_sched_barrier(0)
    Unit cur, nxt; int ui = 0;
    if (!S.next(0, cur)) return;
    f32x4 acc[2][2][4][2];
#pragma unroll
    for (int a = 0; a < 2; ++a)
#pragma unroll
        for (int b = 0; b < 2; ++b)
#pragma unroll
            for (int m = 0; m < 4; ++m)
#pragma unroll
                for (int n = 0; n < 2; ++n) acc[a][b][m][n] = (f32x4){0.f, 0.f, 0.f, 0.f};
    sbf16x8 At[4][2], B0[2][2], B1[2][2];
    const char* cA = (const char*)g.A + (size_t)cur.pm * tstep; const char* cB = (const char*)g.Bt + (size_t)cur.pn * tstep;
    PG8_STAGE(PG8_SB(0, 0), cB, voffB); PG8_STAGE(PG8_SA(0, 0), cA, voffA); PG8_STAGE(PG8_SB(0, 1), cB + hstep, voffB); PG8_STAGE(PG8_SA(0, 1), cA + hstep, voffA);
    if (wr == 1) PG8_BAR;
    PG8_WAIT_V(4); PG8_BAR;
    PG8_STAGE(PG8_SB(1, 0), cB + kstep, voffB); PG8_STAGE(PG8_SA(1, 0), cA + kstep, voffA); PG8_STAGE(PG8_SB(1, 1), cB + hstep + kstep, voffB);
    PG8_WAIT_V(6); PG8_BAR;
    for (;;) {
        const bool has_next = S.next(ui + 1, nxt);
        const char* nA = has_next ? (const char*)g.A + (size_t)nxt.pm * tstep : cA; const char* nB = has_next ? (const char*)g.Bt + (size_t)nxt.pn * tstep : cB;
        for (int t = 0; t < nt; t += 2) {
            const bool last = (t == nt - 2);
            const char* a1 = cA + (size_t)(t + 1) * kstep;
            const char* a2 = last ? nA : cA + (size_t)(t + 2) * kstep; const char* b2 = last ? nB : cB + (size_t)(t + 2) * kstep;
            const char* a3 = a2 + kstep; const char* b3 = b2 + kstep;
            PG8_LDB(B0, 0, 0); PG8_SCHED; PG8_LDA(At, 0, 0); PG8_STAGE(PG8_SA(1, 1), a1 + hstep, voffA);
            PG8_WAIT_L(8); PG8_BAR; PG8_WAIT_L(0); PG8_MMA(0, 0, At, B0); PG8_BAR; PG8_SCHED;
            PG8_LDB(B1, 0, 1); PG8_STAGE(PG8_SB(0, 0), b2, voffB);
            PG8_BAR; PG8_WAIT_L(0); PG8_MMA(0, 1, At, B1); PG8_BAR;
            PG8_LDA(At, 0, 1); PG8_STAGE(PG8_SA(0, 0), a2, voffA);
            PG8_BAR; PG8_WAIT_L(0); PG8_MMA(1, 0, At, B0); PG8_BAR; PG8_SCHED;
            PG8_STAGE(PG8_SB(0, 1), b2 + hstep, voffB);
            PG8_WAIT_V(6); PG8_BAR; PG8_MMA(1, 1, At, B1); PG8_BAR;
            PG8_LDB(B0, 1, 0); PG8_SCHED; PG8_LDA(At, 1, 0); PG8_STAGE(PG8_SA(0, 1), a2 + hstep, voffA);
            PG8_WAIT_L(8); PG8_BAR; PG8_WAIT_L(0); PG8_MMA(0, 0, At, B0); PG8_BAR; PG8_SCHED;
            PG8_LDB(B1, 1, 1); PG8_STAGE(PG8_SB(1, 0), b3, voffB);
            PG8_BAR; PG8_WAIT_L(0); PG8_MMA(0, 1, At, B1); PG8_BAR;
            PG8_LDA(At, 1, 1); PG8_STAGE(PG8_SA(1, 0), a3, voffA);
            PG8_BAR; PG8_WAIT_L(0); PG8_MMA(1, 0, At, B0); PG8_BAR; PG8_SCHED;
            PG8_STAGE(PG8_SB(1, 1), b3 + hstep, voffB);
            PG8_WAIT_V(6); PG8_BAR; PG8_MMA(1, 1, At, B1); PG8_BAR;
        }
        E(acc, cur, wr, wc, fr, fq);
        if (!has_next) break;
#pragma unroll
        for (int a = 0; a < 2; ++a)
#pragma unroll
            for (int b = 0; b < 2; ++b)
#pragma unroll
                for (int m = 0; m < 4; ++m)
#pragma unroll
                    for (int n = 0; n < 2; ++n) acc[a][b][m][n] = (f32x4){0.f, 0.f, 0.f, 0.f};
        cur = nxt; cA = nA; cB = nB; ++ui;
    }
    PG8_WAIT_V(0);
    if (wr == 0) PG8_BAR;
    PG8_BAR;
#undef PG8_SA
#undef PG8_SB
#undef PG8_STAGE
#undef PG8_LDA
#undef PG8_LDB
#undef PG8_MMA
#undef PG8_WAIT_V
#undef PG8_WAIT_L
#undef PG8_BAR
#undef PG8_SCHED
}
}

struct EpiQKC {
  static constexpr bool PERM = true;
  const float* rs1; const float* qg; const float* kg; bf16_t* Q; bf16_t* Kk; bf16_t* HG;
  __device__ __forceinline__ void operator()(const f32x4 (&acc)[2][2][4][2], const pg8::Unit& u, int wr, int wc, int fr, int fq) const {
    const int row0 = u.pm * 256 + wr * 64 + fr;
    if (u.pn < 4) {
      const bool isq = u.pn < 2;
      const int head = 4 * (u.pn & 1) + wc;
      const float* g = isq ? qg : kg;
      f32x4 gv[2][2];
#pragma unroll
      for (int bj = 0; bj < 2; ++bj)
#pragma unroll
        for (int n = 0; n < 2; ++n) gv[bj][n] = *(const f32x4*)(g + 32 * bj + 8 * fq + 4 * n);
      bf16_t* base = isq ? Q : Kk;
#pragma unroll
      for (int ai = 0; ai < 2; ++ai)
#pragma unroll
        for (int m = 0; m < 4; ++m) {
          const int t = row0 + ai * 128 + m * 16;
          float ss = 0.f;
#pragma unroll
          for (int bj = 0; bj < 2; ++bj)
#pragma unroll
            for (int n = 0; n < 2; ++n) { const f32x4 v = acc[ai][bj][m][n]; ss += v.x * v.x + v.y * v.y + v.z * v.z + v.w * v.w; }
          ss += __shfl_xor(ss, 16);
          ss += __shfl_xor(ss, 32);
          const float r = rs1[t];
          float sc = r * rsqrtf(r * r * ss * (1.f / 64.f) + EPS);
          if (isq) sc *= 0.125f * LOG2E;
          bf16_t* dst = base + ((size_t)((t >> 12) * 8 + head) * 4096 + (t & 4095)) * 64 + 8 * fq;
#pragma unroll
          for (int bj = 0; bj < 2; ++bj) {
            const f32x4 a = acc[ai][bj][m][0] * gv[bj][0] * sc, b = acc[ai][bj][m][1] * gv[bj][1] * sc;
            *(u32x4*)(dst + 32 * bj) = (u32x4){pk2(a.x, a.y), pk2(a.z, a.w), pk2(b.x, b.y), pk2(b.z, b.w)};
          }
        }
    } else {
      const int ch0 = 128 * (u.pn - 4) + 32 * wc + 8 * fq;
#pragma unroll
      for (int ai = 0; ai < 2; ++ai)
#pragma unroll
        for (int m = 0; m < 4; ++m) {
          const int t = row0 + ai * 128 + m * 16;
          const float r = rs1[t];
          float h[8];
#pragma unroll
          for (int n = 0; n < 2; ++n)
#pragma unroll
            for (int j = 0; j < 4; ++j) h[4 * n + j] = acc[ai][0][m][n][j] * r / (1.f + __expf(-acc[ai][1][m][n][j] * r));
          *(u32x4*)(HG + (size_t)t * 512 + ch0) = (u32x4){pk2(h[0], h[1]), pk2(h[2], h[3]), pk2(h[4], h[5]), pk2(h[6], h[7])};
        }
    }
  }
};
struct EpiVt {
  static constexpr bool PERM = false;
  const float* rs1; bf16_t* Vt;
  __device__ __forceinline__ void operator()(const f32x4 (&acc)[2][2][4][2], const pg8::Unit& u, int wr, int wc, int fr, int fq) const {
    const int pos0 = 8 * (fq & 1) + 4 * (fq >> 1);
#pragma unroll
    for (int bj = 0; bj < 2; ++bj)
#pragma unroll
      for (int n = 0; n < 2; ++n) {
        const int t = u.pn * 256 + bj * 128 + wc * 32 + n * 16 + 4 * fq;
        const f32x4 r = *(const f32x4*)(rs1 + t);
        const size_t tb = ((size_t)(t >> 12) * 8) * 128 + ((t & 4095) >> 5);
#pragma unroll
        for (int ai = 0; ai < 2; ++ai)
#pragma unroll
          for (int m = 0; m < 4; ++m) {
            const int dg = u.pm * 256 + ai * 128 + wr * 64 + m * 16 + fr, head = dg >> 6, d = dg & 63;
            const f32x4 v = acc[ai][bj][m][n] * r;
            *(u32x2*)(Vt + ((tb + (size_t)head * 128) * 64 + d) * 32 + 16 * n + pos0) = (u32x2){pk2(v.x, v.y), pk2(v.z, v.w)};
          }
      }
  }
};
struct EpiOut {
  static constexpr bool PERM = false;
  const float* x; bf16_t* HB; float* ssq2;
  __device__ __forceinline__ void operator()(const f32x4 (&acc)[2][2][4][2], const pg8::Unit& u, int wr, int wc, int fr, int fq) const {
    const int row0 = u.pm * 256 + wr * 64 + fr, col0 = u.pn * 256 + wc * 32 + 4 * fq;
#pragma unroll
    for (int ai = 0; ai < 2; ++ai)
#pragma unroll
      for (int m = 0; m < 4; ++m) {
        const int t = row0 + ai * 128 + m * 16;
        const size_t ro = (size_t)t * 1024 + col0;
        float ss = 0.f;
#pragma unroll
        for (int bj = 0; bj < 2; ++bj)
#pragma unroll
          for (int n = 0; n < 2; ++n) {
            const size_t o = ro + bj * 128 + n * 16;
            const f32x4 h = *(const f32x4*)(x + o) + acc[ai][bj][m][n];
            *(u32x2*)(HB + o) = (u32x2){pk2(h.x, h.y), pk2(h.z, h.w)};
            ss += h.x * h.x + h.y * h.y + h.z * h.z + h.w * h.w;
          }
        ss += __shfl_xor(ss, 16);
        ss += __shfl_xor(ss, 32);
        if (fq == 0) atomicAdd(ssq2 + t, ss);
      }
  }
};
struct EpiQh {
  static constexpr bool PERM = true;
  const float* ssq2; bf16_t* QH;
  __device__ __forceinline__ void operator()(const f32x4 (&acc)[2][2][4][2], const pg8::Unit& u, int wr, int wc, int fr, int fq) const {
    const int row0 = u.pm * 256 + wr * 64 + fr, col0 = u.pn * 256 + wc * 32 + 8 * fq;
#pragma unroll
    for (int ai = 0; ai < 2; ++ai)
#pragma unroll
      for (int m = 0; m < 4; ++m) {
        const int t = row0 + ai * 128 + m * 16;
        const float r = rsqrtf(ssq2[t] * (1.f / 1024.f) + EPS);
#pragma unroll
        for (int bj = 0; bj < 2; ++bj) {
          const f32x4 a = acc[ai][bj][m][0] * r, b = acc[ai][bj][m][1] * r;
          *(u32x4*)(QH + (size_t)t * 1024 + col0 + bj * 128) = (u32x4){pk2(a.x, a.y), pk2(a.z, a.w), pk2(b.x, b.y), pk2(b.z, b.w)};
        }
      }
  }
};

__device__ void phase_inproj(const Params& p, char* smem) {
  unsigned char* ws = p.ws;
  LAS unsigned char* lds = (LAS unsigned char*)smem;
  const bf16_t* XB = (const bf16_t*)(ws + WS_XB);
  const float* RS1 = (const float*)(ws + WS_RS1);
  pg8::StaticOrder S;
  {
    pg8::Gemm g{XB, (const bf16_t*)(ws + WS_W1), T, 2048, 1024};
    S.init(T, 2048, gridDim.x, blockIdx.x);
    EpiQKC E{RS1, p.q_norm_g, p.k_norm_g, (bf16_t*)(ws + WS_Q), (bf16_t*)(ws + WS_K), (bf16_t*)(ws + WS_HG)};
    pg8::gemm_phase<EpiQKC>(lds, g, S, E);
  }
  {
    pg8::Gemm g{(const bf16_t*)(ws + WS_WV), XB, 512, T, 1024};
    S.init(512, T, gridDim.x, blockIdx.x);
    EpiVt E{RS1, (bf16_t*)(ws + WS_VT)};
    pg8::gemm_phase<EpiVt>(lds, g, S, E);
  }
}
__device__ void phase_outproj(const Params& p, char* smem) {
  unsigned char* ws = p.ws;
  pg8::Gemm g{(const bf16_t*)(ws + WS_MIX), (const bf16_t*)(ws + WS_WOUT), T, 1024, 1024};
  pg8::StaticOrder S;
  S.init(T, 1024, gridDim.x, blockIdx.x);
  EpiOut E{p.x, (bf16_t*)(ws + WS_HB), (float*)(ws + WS_SSQ2)};
  pg8::gemm_phase<EpiOut>((LAS unsigned char*)smem, g, S, E);
}
__device__ void phase_qproj(const Params& p, char* smem) {
  unsigned char* ws = p.ws;
  pg8::Gemm g{(const bf16_t*)(ws + WS_HB), (const bf16_t*)(ws + WS_WQ), T, 1024, 1024};
  pg8::StaticOrder S;
  S.init(T, 1024, gridDim.x, blockIdx.x);
  EpiQh E{(const float*)(ws + WS_SSQ2), (bf16_t*)(ws + WS_QH)};
  pg8::gemm_phase<EpiQh>((LAS unsigned char*)smem, g, S, E);
}

__device__ void conv_item(const Params& p, int item, char* smem) {
  unsigned char* ws = p.ws;
  const bf16_t* HG = (const bf16_t*)(ws + WS_HG);
  bf16_t* MIX = (bf16_t*)(ws + WS_MIX);
  const int tid512 = otid(), half = tid512 >> 8, tid = tid512 & 255, lane = tid & 63, wave = tid >> 6;
  const int t0 = item * 32, s0 = t0 & 4095;
  for (int idx = tid512; idx < 62 * 64; idx += NTHREADS) {
    const int r = idx >> 6, c16 = idx & 63;
    u32x4 v = {0u, 0u, 0u, 0u};
    if (s0 - 30 + r >= 0) v = *(const u32x4*)(HG + (size_t)(t0 - 30 + r) * 512 + c16 * 8);
    *(u32x4*)(smem + r * 1024 + c16 * 16) = v;
  }
  float w0[31], w1[31];
#pragma unroll
  for (int j = 0; j < 31; ++j) {
    const float2 w = *(const float2*)(p.conv_w + j * 512 + 2 * tid);
    w0[j] = w.x;
    w1[j] = w.y;
  }
  const float2 cb = *(const float2*)(p.conv_b + 2 * tid);
  const float2 lg = *(const float2*)(p.conv_ln_g + 2 * tid);
  const float2 lb = *(const float2*)(p.conv_ln_b + 2 * tid);
  float* red = (float*)(smem + 62 * 1024) + half * 128;
  __syncthreads();
  const bool b5 = lane & 32, b4 = lane & 16, b3 = lane & 8, b2 = lane & 4;
#pragma unroll 1
  for (int rd = 0; rd < 2; ++rd) {
    const int tb = 16 * half + 8 * rd;
    float x0[38], x1[38];
#pragma unroll
    for (int r = 0; r < 38; ++r) {
      const unsigned v = *(const unsigned*)(smem + (tb + r) * 1024 + tid * 4);
      x0[r] = bflo(v);
      x1[r] = bfhi(v);
    }
    float a0[8], a1[8], st[16];
#pragma unroll
    for (int k = 0; k < 8; ++k) {
      float u0 = cb.x, u1 = cb.y;
#pragma unroll
      for (int j = 0; j < 31; ++j) { u0 += w0[j] * x0[k + j]; u1 += w1[j] * x1[k + j]; }
      a0[k] = u0; a1[k] = u1;
      st[k] = u0 + u1;
      st[8 + k] = u0 * u0 + u1 * u1;
    }
    float r8[8], r4[4], r2[2], r1;
#pragma unroll
    for (int i = 0; i < 8; ++i) { const float keep = b5 ? st[8 + i] : st[i], send = b5 ? st[i] : st[8 + i]; r8[i] = keep + __shfl_xor(send, 32); }
#pragma unroll
    for (int i = 0; i < 4; ++i) { const float keep = b4 ? r8[4 + i] : r8[i], send = b4 ? r8[i] : r8[4 + i]; r4[i] = keep + __shfl_xor(send, 16); }
#pragma unroll
    for (int i = 0; i < 2; ++i) { const float keep = b3 ? r4[2 + i] : r4[i], send = b3 ? r4[i] : r4[2 + i]; r2[i] = keep + __shfl_xor(send, 8); }
    { const float keep = b2 ? r2[1] : r2[0], send = b2 ? r2[0] : r2[1]; r1 = keep + __shfl_xor(send, 4); }
    r1 += __shfl_xor(r1, 2);
    r1 += __shfl_xor(r1, 1);
    float* rr = red + rd * 64;
    if ((lane & 3) == 0) rr[wave * 16 + (lane >> 2)] = r1;
    __syncthreads();
#pragma unroll
    for (int k = 0; k < 8; ++k) {
      const float S1 = (rr[k] + rr[16 + k]) + (rr[32 + k] + rr[48 + k]);
      const float S2 = (rr[8 + k] + rr[24 + k]) + (rr[40 + k] + rr[56 + k]);
      const float mu = S1 * (1.f / 512.f);
      const float var = fmaxf(S2 * (1.f / 512.f) - mu * mu, 0.f);
      const float rstd = rsqrtf(var + EPS);
      const float y0 = (a0[k] - mu) * rstd * lg.x + lb.x, y1 = (a1[k] - mu) * rstd * lg.y + lb.y;
      const float z0 = y0 / (1.f + __expf(-y0)), z1 = y1 / (1.f + __expf(-y1));
      *(unsigned*)(MIX + (size_t)(t0 + tb + k) * 1024 + 512 + 2 * tid) = pk2(z0, z1);
    }
  }
  __syncthreads();
}

struct AttnKV { bf16x8 k[4]; bf16x8 v[2][2]; };
__device__ __forceinline__ void attn_load(const bf16_t* Km, const bf16_t* Vt, int bh, int kb, int tok, int hf, AttnKV& f) {
  const int kc = kb < 0 ? 0 : kb;
  const bf16_t* kp = Km + ((size_t)bh * 4096 + kc * 32 + tok) * 64 + 8 * hf;
#pragma unroll
  for (int ks = 0; ks < 4; ++ks) f.k[ks] = *(const bf16x8*)(kp + ks * 16);
  const bf16_t* vp = Vt + (((size_t)bh * 128 + kc) * 64 + tok) * 32 + hf * 8;
#pragma unroll
  for (int m = 0; m < 2; ++m)
#pragma unroll
    for (int s = 0; s < 2; ++s) f.v[m][s] = *(const bf16x8*)(vp + m * 1024 + s * 16);
}
__device__ __forceinline__ bool attn_block(const AttnKV& f, const bf16x8 (&qf)[4], bool diag, int tok, int hf, float& c, f32x16& o0, f32x16& o1) {
  f32x16 sc;
#pragma unroll
  for (int i = 0; i < 16; ++i) sc[i] = 0.f;
#pragma unroll
  for (int ks = 0; ks < 4; ++ks) sc = mfma32(f.k[ks], qf[ks], sc);
  float lk[16], zs[16];
#pragma unroll
  for (int i = 0; i < 16; ++i) {
    const float zl = sc[i];
    const float e = __builtin_amdgcn_exp2f(zl);
    const float sp = __builtin_amdgcn_logf(1.f + e);
    const bool valid = !diag || ((i & 3) + 8 * (i >> 2) + 4 * hf < tok);
    lk[i] = valid ? -sp : 0.f;
    zs[i] = valid ? zl - sp : -1e30f;
  }
  float Tg[4], Pg[4];
#pragma unroll
  for (int g = 0; g < 4; ++g) {
    Tg[g] = (lk[4 * g] + lk[4 * g + 1]) + (lk[4 * g + 2] + lk[4 * g + 3]);
    Pg[g] = __shfl_xor(Tg[g], 32);
  }
  float base[4];
  float run = 0.f;
#pragma unroll
  for (int g = 3; g >= 0; --g) {
    base[g] = c + run + (hf == 0 ? Pg[g] : 0.f);
    run += Tg[g] + Pg[g];
  }
  float pr[16];
#pragma unroll
  for (int g = 0; g < 4; ++g) {
    float l = base[g];
#pragma unroll
    for (int r = 3; r >= 0; --r) {
      pr[4 * g + r] = __builtin_amdgcn_exp2f(zs[4 * g + r] + l);
      l += lk[4 * g + r];
    }
  }
  c += run;
  bf16x8 pf[2];
#pragma unroll
  for (int s = 0; s < 2; ++s)
#pragma unroll
    for (int j = 0; j < 8; ++j) pf[s][j] = (__bf16)pr[8 * s + j];
#pragma unroll
  for (int s = 0; s < 2; ++s) {
    o0 = mfma32(f.v[0][s], pf[s], o0);
    o1 = mfma32(f.v[1][s], pf[s], o1);
  }
  return __all(c < -150.f);
}
__device__ void attn_item(const Params& p, int item, int lane) {
  unsigned char* ws = p.ws;
  const bf16_t* Qm = (const bf16_t*)(ws + WS_Q);
  const bf16_t* Km = (const bf16_t*)(ws + WS_K);
  const bf16_t* Vt = (const bf16_t*)(ws + WS_VT);
  bf16_t* MIX = (bf16_t*)(ws + WS_MIX);
  float* SSQ = (float*)(ws + WS_SSQ);
  const int qt = item & 127, bh = item >> 7;
  const int tok = lane & 31, hf = lane >> 5;
  bf16x8 qf[4];
  {
    const bf16_t* qp = Qm + ((size_t)bh * 4096 + qt * 32 + tok) * 64 + 8 * hf;
#pragma unroll
    for (int ks = 0; ks < 4; ++ks) qf[ks] = *(const bf16x8*)(qp + ks * 16);
  }
  f32x16 o0, o1;
#pragma unroll
  for (int i = 0; i < 16; ++i) { o0[i] = 0.f; o1[i] = 0.f; }
  float c = 0.f;
  AttnKV fa, fb;
  attn_load(Km, Vt, bh, qt, tok, hf, fa);
  {
    unsigned z = __builtin_bit_cast(u32x4, fa.v[1][1]).w | __builtin_bit_cast(u32x4, fa.k[3]).w | __builtin_bit_cast(u32x4, qf[3]).w;
    asm volatile("" ::"v"(z));
  }
  for (int kb = qt;; kb -= 2) {
    attn_load(Km, Vt, bh, kb - 1, tok, hf, fb);
    __builtin_amdgcn_sched_barrier(0);
    if (attn_block(fa, qf, kb == qt, tok, hf, c, o0, o1) || kb == 0) break;
    attn_load(Km, Vt, bh, kb - 2, tok, hf, fa);
    __builtin_amdgcn_sched_barrier(0);
    if (attn_block(fb, qf, false, tok, hf, c, o0, o1) || kb == 1) break;
  }
  const int t = (bh >> 3) * 4096 + qt * 32 + tok, hh = bh & 7;
  float ssq = 0.f;
#pragma unroll
  for (int i = 0; i < 16; ++i) ssq += o0[i] * o0[i] + o1[i] * o1[i];
  ssq += __shfl_xor(ssq, 32);
  if (hf == 0) SSQ[t * 8 + hh] = ssq;
  bf16_t* dst = MIX + (size_t)t * 1024 + hh * 64 + 4 * hf;
#pragma unroll
  for (int g = 0; g < 4; ++g) {
    *(u32x2*)(dst + 8 * g) = (u32x2){pk2(o0[4 * g], o0[4 * g + 1]), pk2(o0[4 * g + 2], o0[4 * g + 3])};
    *(u32x2*)(dst + 32 + 8 * g) = (u32x2){pk2(o1[4 * g], o1[4 * g + 1]), pk2(o1[4 * g + 2], o1[4 * g + 3])};
  }
}

__device__ void phase_mix(const Params& p, char* smem) {
  const int vb = vblock(), G = gridDim.x;
  for (int item = vb; item < 1024; item += G) conv_item(p, item, smem);
  const int tidm = otid();
  const int lane = tidm & 63, gw = vb * NWAVES + (tidm >> 6), nw = G * NWAVES;
  for (int item = gw; item < 8192; item += nw) attn_item(p, item, lane);
}
__device__ void phase_attn_norm(const Params& p) {
  unsigned char* ws = p.ws;
  bf16_t* MIX = (bf16_t*)(ws + WS_MIX);
  const float* SSQ = (const float*)(ws + WS_SSQ);
  const int tids = otid();
  const int lane = tids & 63, gw = vblock() * NWAVES + (tids >> 6), nw = gridDim.x * NWAVES;
  for (int t = gw; t < T; t += nw) {
    const f32x4 a = *(const f32x4*)(SSQ + (size_t)t * 8), b = *(const f32x4*)(SSQ + (size_t)t * 8 + 4);
    const float rs = rsqrtf(((a.x + a.y) + (a.z + a.w) + (b.x + b.y) + (b.z + b.w)) * (1.f / 512.f) + EPS);
    u32x4* ptr = (u32x4*)(MIX + (size_t)t * 1024 + lane * 8);
    const u32x4 v = *ptr;
    *ptr = (u32x4){pk2(bflo(v.x) * rs, bfhi(v.x) * rs), pk2(bflo(v.y) * rs, bfhi(v.y) * rs), pk2(bflo(v.z) * rs, bfhi(v.z) * rs), pk2(bflo(v.w) * rs, bfhi(v.w) * rs)};
  }
}

__device__ __forceinline__ unsigned f2key(float f, unsigned n) {
  const unsigned u = (__float_as_uint(f) & ~0x7Fu) | n;
  return u ^ ((unsigned)((int)u >> 31) | 0x80000000u);
}
__device__ __forceinline__ unsigned f2key_raw(float f) {
  const unsigned u = __float_as_uint(f);
  return u ^ ((unsigned)((int)u >> 31) | 0x80000000u);
}
__device__ __forceinline__ unsigned key2u(unsigned k) { return k ^ ((k >> 31) ? 0x80000000u : 0xFFFFFFFFu); }

template <int N>
__device__ __forceinline__ void bitonic_sort_desc(unsigned (&v)[N]) {
#pragma unroll
  for (int k = 2; k <= N; k <<= 1) {
#pragma unroll
    for (int j = k >> 1; j > 0; j >>= 1) {
#pragma unroll
      for (int i = 0; i < N; ++i) {
        const int l = i ^ j;
        if (l > i) {
          const bool desc = ((i & k) == 0);
          const unsigned mx = max(v[i], v[l]), mn = min(v[i], v[l]);
          v[i] = desc ? mx : mn;
          v[l] = desc ? mn : mx;
        }
      }
    }
  }
}
template <int N>
__device__ __forceinline__ void bitonic_merge_desc(unsigned (&v)[N]) {
#pragma unroll
  for (int j = N >> 1; j > 0; j >>= 1) {
#pragma unroll
    for (int i = 0; i < N; ++i) {
      const int l = i ^ j;
      if (l > i) {
        const unsigned mx = max(v[i], v[l]), mn = min(v[i], v[l]);
        v[i] = mx;
        v[l] = mn;
      }
    }
  }
}
__device__ __forceinline__ void merge_top16(unsigned (&a)[16], const unsigned (&b)[16]) {
#pragma unroll
  for (int i = 0; i < 16; ++i) a[i] = max(a[i], b[15 - i]);
  bitonic_merge_desc<16>(a);
}
#define CEP(ka, pa, kb, pb, desc)                                  \
  {                                                                \
    const bool sw_ = (desc) ? ((kb) > (ka)) : ((kb) < (ka));       \
    const unsigned tk_ = sw_ ? (kb) : (ka), tl_ = sw_ ? (ka) : (kb); \
    const unsigned tp_ = sw_ ? (pb) : (pa), tq_ = sw_ ? (pa) : (pb); \
    ka = tk_; kb = tl_; pa = tp_; pb = tq_;                        \
  }
template <int N>
__device__ __forceinline__ void bitonic_sort_desc_p(unsigned (&v)[N], unsigned (&pl)[N]) {
#pragma unroll
  for (int k = 2; k <= N; k <<= 1) {
#pragma unroll
    for (int j = k >> 1; j > 0; j >>= 1) {
#pragma unroll
      for (int i = 0; i < N; ++i) {
        const int l = i ^ j;
        if (l > i) {
          const bool desc = ((i & k) == 0);
          CEP(v[i], pl[i], v[l], pl[l], desc);
        }
      }
    }
  }
}
template <int N>
__device__ __forceinline__ void bitonic_merge_desc_p(unsigned (&v)[N], unsigned (&pl)[N]) {
#pragma unroll
  for (int j = N >> 1; j > 0; j >>= 1) {
#pragma unroll
    for (int i = 0; i < N; ++i) {
      const int l = i ^ j;
      if (l > i) { CEP(v[i], pl[i], v[l], pl[l], true); }
    }
  }
}
__device__ __forceinline__ void merge_top16_p(unsigned (&a)[16], unsigned (&pa)[16], const unsigned (&b)[16], const unsigned (&pb)[16]) {
#pragma unroll
  for (int i = 0; i < 16; ++i) {
    const bool s = b[15 - i] > a[i];
    a[i] = s ? b[15 - i] : a[i];
    pa[i] = s ? pb[15 - i] : pa[i];
  }
  bitonic_merge_desc_p<16>(a, pa);
}

__device__ __forceinline__ void subkey_top16(const bf16_t* __restrict__ Kb, const bf16_t* __restrict__ qrow, int lane, unsigned (&top)[16]) {
  const int tok = lane & 31, hf = lane >> 5;
  f32x16 acc[4];
#pragma unroll
  for (int m = 0; m < 4; ++m)
#pragma unroll
    for (int i = 0; i < 16; ++i) acc[m][i] = 0.f;
#pragma unroll
  for (int ks = 0; ks < 4; ++ks) {
    const bf16x8 bq = *(const bf16x8*)(qrow + ks * 16 + 8 * hf);
#pragma unroll
    for (int m = 0; m < 4; ++m) {
      const bf16x8 ak = *(const bf16x8*)(Kb + (m * 32 + tok) * 64 + ks * 16 + 8 * hf);
      acc[m] = mfma32(ak, bq, acc[m]);
    }
  }
  unsigned g[4][16];
#pragma unroll
  for (int m = 0; m < 4; ++m) {
#pragma unroll
    for (int i = 0; i < 16; ++i) g[m][i] = f2key(acc[m][i], (unsigned)(m * 32 + (i & 3) + 8 * (i >> 2) + 4 * hf));
    bitonic_sort_desc<16>(g[m]);
  }
  merge_top16(g[0], g[1]);
  merge_top16(g[2], g[3]);
  merge_top16(g[0], g[2]);
  unsigned o[16];
#pragma unroll
  for (int i = 0; i < 16; ++i) o[i] = __shfl_xor(g[0][i], 32);
  merge_top16(g[0], o);
#pragma unroll
  for (int i = 0; i < 16; ++i) top[i] = g[0][i];
}

__device__ void phase_route(const Params& p) {
  unsigned char* ws = p.ws;
  const bf16_t* K1 = (const bf16_t*)(ws + WS_K1);
  const bf16_t* K2 = (const bf16_t*)(ws + WS_K2);
  const bf16_t* QH = (const bf16_t*)(ws + WS_QH);
  const bf16_t* HB = (const bf16_t*)(ws + WS_HB);
  unsigned char* XN8 = ws + WS_XN8;
  const float* SSQ2 = (const float*)(ws + WS_SSQ2);
  unsigned* PIDX = (unsigned*)(ws + WS_PIDX);
  float* PG = (float*)(ws + WS_PG);
  const int tidr = otid();
  const int lane = tidr & 63, gw = vblock() * NWAVES + (tidr >> 6), nw = gridDim.x * NWAVES;
  for (int t = gw; t < T; t += nw) {
    const bf16_t* src = HB + (size_t)t * 1024 + lane * 16;
    const float r = rsqrtf(SSQ2[t] * (1.f / 1024.f) + EPS) * 16.f;
    const u32x4 h0 = *(const u32x4*)src, h1 = *(const u32x4*)(src + 8);
    u32x4 q;
#pragma unroll
    for (int i = 0; i < 4; ++i) {
      const f32x4 g4 = *(const f32x4*)(p.norm_ffn_g + lane * 16 + 4 * i);
      const unsigned lo = (i < 2) ? h0[2 * i] : h1[2 * i - 4], hi = (i < 2) ? h0[2 * i + 1] : h1[2 * i - 3];
      int w = 0;
      w = __builtin_amdgcn_cvt_pk_fp8_f32(bflo(lo) * r * g4.x, bfhi(lo) * r * g4.y, w, false);
      w = __builtin_amdgcn_cvt_pk_fp8_f32(bflo(hi) * r * g4.z, bfhi(hi) * r * g4.w, w, true);
      q[i] = (unsigned)w;
    }
    *(u32x4*)(XN8 + (size_t)t * 1024 + lane * 16) = q;
  }
  for (int item = gw; item < 8192; item += nw) {
    const int hd = item & 7, t0 = (item >> 3) * 32;
    const int tok = lane & 31, hf = lane >> 5;
    const bf16_t* qrow = QH + (size_t)(t0 + tok) * 1024 + hd * 128;
    unsigned top1[16], top2[16];
    subkey_top16(K1 + hd * 8192, qrow, lane, top1);
    subkey_top16(K2 + hd * 8192, qrow + 64, lane, top2);
    float fa[16], fb[16];
    unsigned ia[16], ib[16];
#pragma unroll
    for (int i = 0; i < 16; ++i) {
      const unsigned ua = key2u(hf ? top2[i] : top1[i]), ub = key2u(hf ? top1[i] : top2[i]);
      fa[i] = __uint_as_float(ua); ia[i] = ua & 0x7Fu;
      fb[i] = __uint_as_float(ub); ib[i] = ub & 0x7Fu;
    }
    unsigned ck[32], cp[32];
    {
      int n = 0;
#pragma unroll
      for (int i = 0; i < 4; ++i) {
#pragma unroll
        for (int j = i; j < 16; ++j) {
          if ((i + 1) * (j + 1) <= 16) {
            unsigned key = f2key_raw(fa[i] + fb[j]);
            if (i == j && hf) key = 0u;
            ck[n] = key;
            cp[n] = hf ? ((ib[j] << 7) | ia[i]) : ((ia[i] << 7) | ib[j]);
            ++n;
          }
        }
      }
#pragma unroll
      for (; n < 32; ++n) { ck[n] = 0u; cp[n] = 0u; }
    }
    unsigned k0[16], p0[16], k1[16], p1[16];
#pragma unroll
    for (int i = 0; i < 16; ++i) { k0[i] = ck[i]; p0[i] = cp[i]; k1[i] = ck[16 + i]; p1[i] = cp[16 + i]; }
    bitonic_sort_desc_p<16>(k0, p0);
    bitonic_sort_desc_p<16>(k1, p1);
    merge_top16_p(k0, p0, k1, p1);
#pragma unroll
    for (int i = 0; i < 16; ++i) { k1[i] = __shfl_xor(k0[i], 32); p1[i] = __shfl_xor(p0[i], 32); }
    merge_top16_p(k0, p0, k1, p1);
    float sv[16], sum = 0.f;
    const float mx = __uint_as_float(key2u(k0[0]));
#pragma unroll
    for (int i = 0; i < 16; ++i) {
      sv[i] = __builtin_amdgcn_exp2f((__uint_as_float(key2u(k0[i])) - mx) * LOG2E);
      sum += sv[i];
    }
    const float inv = 1.f / sum;
    const size_t po = ((size_t)(t0 + tok) * 8 + hd) * 16;
    if (hf == 0) {
#pragma unroll
      for (int q = 0; q < 4; ++q) *(u32x4*)(PIDX + po + 4 * q) = (u32x4){p0[4 * q], p0[4 * q + 1], p0[4 * q + 2], p0[4 * q + 3]};
    } else {
#pragma unroll
      for (int q = 0; q < 4; ++q) *(f32x4*)(PG + po + 4 * q) = (f32x4){sv[4 * q] * inv, sv[4 * q + 1] * inv, sv[4 * q + 2] * inv, sv[4 * q + 3] * inv};
    }
  }
}

typedef int i32x8 __attribute__((ext_vector_type(8)));
__device__ __forceinline__ f32x4 mfma_fp4_fp8(u32x4 a, u32x4 b0, u32x4 b1, f32x4 c) {
  const i32x8 A = {(int)a.x, (int)a.y, (int)a.z, (int)a.w, 0, 0, 0, 0};
  const i32x8 B = {(int)b0.x, (int)b0.y, (int)b0.z, (int)b0.w, (int)b1.x, (int)b1.y, (int)b1.z, (int)b1.w};
  return __builtin_amdgcn_mfma_scale_f32_16x16x128_f8f6f4(A, B, c, 4, 0, 0, 0x7F7F7F7F, 0, 0x7F7F7F7F);
}
struct PeCtx {
  const unsigned char* U8; const float* US; const float* VS; const float* PG; float* PW; float* dummy;
  LAS unsigned* list; int lane, r, g, s, n, t0;
};
__device__ __forceinline__ void pe_rows(const PeCtx& c, int ci, u32x4 (&a)[8]) {
  const int idx = ci * 16 + (c.lane >> 2);
  const unsigned ent = c.list[idx & 2047];
  const unsigned e = (idx < c.n) ? ((ent >> 7) & 16383u) : (unsigned)(c.s << 11);
  const unsigned char* rp = c.U8 + (size_t)e * 512 + (c.lane & 3) * 16;
#pragma unroll
  for (int ks = 0; ks < 8; ++ks) a[ks] = *(const u32x4*)(rp + ks * 64);
}
__device__ __forceinline__ void pe_fix(const PeCtx& c, u32x4 (&a)[8]) {
  const int src = 4 * c.r + c.g;
#pragma unroll
  for (int ks = 0; ks < 8; ++ks) {
    a[ks].x = (unsigned)__shfl((int)a[ks].x, src); a[ks].y = (unsigned)__shfl((int)a[ks].y, src);
    a[ks].z = (unsigned)__shfl((int)a[ks].z, src); a[ks].w = (unsigned)__shfl((int)a[ks].w, src);
  }
}
__device__ __forceinline__ void pe_chunk(const PeCtx& c, int ci, u32x4 (&a)[8], u32x4 (&anext)[8], const u32x4 (&bq)[16]) {
  const int idx = ci * 16 + c.r;
  const unsigned ent = c.list[idx & 2047];
  const bool fin = (c.lane < 16) && (idx < c.n);
  const unsigned e = (ent >> 7) & 16383u, slot = ent & 127u, col = (ent >> 21) & 15u;
  const float gt = c.PG[fin ? (size_t)(c.t0 + col) * 128 + slot : (size_t)0], us = c.US[fin ? e : 0u], vs = c.VS[fin ? e : 0u];
  __builtin_amdgcn_sched_barrier(0);
  pe_rows(c, ci + 1, anext);
  __builtin_amdgcn_sched_barrier(0);
  pe_fix(c, a);
  f32x4 acc = {0.f, 0.f, 0.f, 0.f};
#pragma unroll
  for (int ks = 0; ks < 8; ++ks) acc = mfma_fp4_fp8(a[ks], bq[2 * ks], bq[2 * ks + 1], acc);
  const int src = ((c.r >> 2) << 4) | (int)col;
  const float v0 = __shfl(acc[0], src), v1 = __shfl(acc[1], src), v2 = __shfl(acc[2], src), v3 = __shfl(acc[3], src);
  float d = ((c.r & 3) == 0) ? v0 : ((c.r & 3) == 1) ? v1 : ((c.r & 3) == 2) ? v2 : v3;
  float gt_ = gt, us_ = us, vs_ = vs;
  asm volatile("" : "+v"(d), "+v"(gt_), "+v"(us_), "+v"(vs_));
  {
    const float act = d * us_ * (1.f / 16.f);
    float* dst = fin ? c.PW + (size_t)(c.t0 + col) * 128 + slot : c.dummy;
    *dst = gt_ * 0.5f * act * (1.f + erff(act * 0.70710678118654752f)) * vs_;
  }
}
__device__ void phase_peer_u(const Params& p, char* smem) {
  unsigned char* ws = p.ws;
  PeCtx c;
  c.U8 = ws + WS_U8; c.US = (const float*)(ws + WS_US); c.VS = (const float*)(ws + WS_VS);
  c.PG = (const float*)(ws + WS_PG); c.PW = (float*)(ws + WS_PW);
  c.dummy = (float*)(ws + WS_PW + 16 * MiB) + (size_t)blockIdx.x * NTHREADS + otid();
  const unsigned char* XN8 = ws + WS_XN8;
  const unsigned* PIDX = (const unsigned*)(ws + WS_PIDX);
  const int tidu = otid();
  const int lane = tidu & 63, wave = tidu >> 6;
  c.lane = lane; c.r = lane & 15; c.g = lane >> 4;
  c.list = (LAS unsigned*)(smem + wave * 8192);
  const int G = gridDim.x, ng = (G % 8 == 0) ? 8 : 1;
  const int x = blockIdx.x % ng, lw = (blockIdx.x / ng) * NWAVES + wave, nlw = (G / ng) * NWAVES;
  for (int s = x; s < 8; s += ng) {
    c.s = s;
    for (int grp = lw; grp < T / 16; grp += nlw) {
      const int t0 = grp * 16;
      c.t0 = t0;
      u32x4 bq[16];
      {
        const unsigned char* xp = XN8 + (size_t)(t0 + c.r) * 1024 + c.g * 16;
#pragma unroll
        for (int ks = 0; ks < 8; ++ks) { bq[2 * ks] = *(const u32x4*)(xp + ks * 128); bq[2 * ks + 1] = *(const u32x4*)(xp + ks * 128 + 64); }
      }
      int n = 0;
#pragma unroll
      for (int q = 0; q < 8; ++q) {
        const u32x4 idv = *(const u32x4*)(PIDX + (size_t)t0 * 128 + q * 256 + lane * 4);
#pragma unroll
        for (int k = 0; k < 4; ++k) {
          const unsigned e = idv[k];
          const bool m = (int)(e >> 11) == s;
          const unsigned long long mk = __ballot(m);
          if (m) c.list[n + __builtin_amdgcn_mbcnt_hi((unsigned)(mk >> 32), __builtin_amdgcn_mbcnt_lo((unsigned)mk, 0))] =
                     ((unsigned)(2 * q + (lane >> 5)) << 21) | (e << 7) | (unsigned)((lane & 31) * 4 + k);
          n += __popcll(mk);
        }
      }
      asm volatile("s_waitcnt lgkmcnt(0)" ::: "memory");
      c.n = n;
      const int nch = (n + 15) >> 4;
      u32x4 a0[8], a1[8];
      pe_rows(c, 0, a0);
      {
        unsigned z = 0u;
#pragma unroll
        for (int ks = 0; ks < 8; ++ks) z |= a0[ks].w;
        asm volatile("" ::"v"(z));
      }
      if (nch > 0) {
        for (int ci = 0;; ci += 2) {
          pe_chunk(c, ci, a0, a1, bq);
          if (ci + 1 >= nch) break;
          pe_chunk(c, ci + 1, a1, a0, bq);
          if (ci + 2 >= nch) break;
        }
      }
      asm volatile("" ::: "memory");
    }
  }
}

struct PfIdx { u32x4 e0, e1; f32x4 w0, w1; };
struct PfCtx { const unsigned char* base; const unsigned* PIDX; const float* PW; const bf16_t* HB; float* out; int pg, s, c, lane, tend; };
__device__ __forceinline__ void pf_load_idx(const PfCtx& c, int t, int h, PfIdx& I) {
  const size_t o = (size_t)(t < c.tend ? t : c.tend - 1) * 128 + h * 64 + c.pg * 8;
  I.e0 = *(const u32x4*)(c.PIDX + o); I.e1 = *(const u32x4*)(c.PIDX + o + 4);
  I.w0 = *(const f32x4*)(c.PW + o);   I.w1 = *(const f32x4*)(c.PW + o + 4);
}
__device__ __forceinline__ void pf_load_rows(const PfCtx& c, const PfIdx& I, u32x4 (&rv)[8]) {
#pragma unroll
  for (int i = 0; i < 4; ++i) { rv[i] = *(const u32x4*)(c.base + (size_t)I.e0[i] * 128); rv[4 + i] = *(const u32x4*)(c.base + (size_t)I.e1[i] * 128); }
}
__device__ __forceinline__ void pf_accum(const u32x4 (&rv)[8], f32x4 w0, f32x4 w1, f32x2 (&acc)[16]) {
#pragma unroll
  for (int i = 0; i < 8; ++i) {
    const float ws = (i < 4) ? w0[i & 3] : w1[i & 3];
    const f32x2 w = {ws, ws};
#define FP4_ACC(q, bsel) acc[4 * (q) + (bsel)] = __builtin_elementwise_fma(__builtin_amdgcn_cvt_scalef32_pk_f32_fp4(rv[i][q], 1.0f, bsel), w, acc[4 * (q) + (bsel)]);
#pragma unroll
    for (int q = 0; q < 4; ++q) { FP4_ACC(q, 0) FP4_ACC(q, 1) FP4_ACC(q, 2) FP4_ACC(q, 3) }
#undef FP4_ACC
  }
}
__device__ __forceinline__ size_t pf_out_off(const PfCtx& c, int t) {
  const int lane = c.lane;
  return (size_t)(t < c.tend ? t : c.tend - 1) * 1024 + c.s * 256 + c.c * 32 + ((lane & 32) ? 16 : 0) + ((lane & 16) ? 8 : 0) + ((lane & 8) ? 4 : 0);
}
__device__ __forceinline__ void pf_finish(const PfCtx& c, int t, size_t oo, u32x2 hb, const f32x2 (&acc)[16]) {
  const int lane = c.lane;
  const bool b5 = lane & 32, b4 = lane & 16, b3 = lane & 8;
  f32x2 r8[8], r4[4], r2[2];
#pragma unroll
  for (int i = 0; i < 8; ++i) {
    const f32x2 keep = b5 ? acc[8 + i] : acc[i], send = b5 ? acc[i] : acc[8 + i];
    r8[i] = keep + (f32x2){__shfl_xor(send.x, 32), __shfl_xor(send.y, 32)};
  }
#pragma unroll
  for (int i = 0; i < 4; ++i) {
    const f32x2 keep = b4 ? r8[4 + i] : r8[i], send = b4 ? r8[i] : r8[4 + i];
    r4[i] = keep + (f32x2){__shfl_xor(send.x, 16), __shfl_xor(send.y, 16)};
  }
#pragma unroll
  for (int i = 0; i < 2; ++i) {
    const f32x2 keep = b3 ? r4[2 + i] : r4[i], send = b3 ? r4[i] : r4[2 + i];
    r2[i] = keep + (f32x2){__shfl_xor(send.x, 8), __shfl_xor(send.y, 8)};
  }
  if (t < c.tend) *(f32x4*)(c.out + oo) = (f32x4){bflo(hb.x) + r2[0].x, bfhi(hb.x) + r2[0].y, bflo(hb.y) + r2[1].x, bfhi(hb.y) + r2[1].y};
}
#define PF_STEP(tk, h, Iload, Iuse, Rnext, Rcur)                                          \
  {                                                                                       \
    pf_load_idx(c, (tk) + nlw, (h), Iload);                                 \
    __builtin_amdgcn_sched_barrier(0);                                                    \
    pf_load_rows(c, Iuse, Rnext);                                           \
    const f32x4 wn0 = Iuse.w0, wn1 = Iuse.w1;                                             \
    __builtin_amdgcn_sched_barrier(0);                                                    \
    pf_accum(Rcur, wc0, wc1, acc);                                                        \
    wc0 = wn0; wc1 = wn1;                                                                 \
  }
__device__ void phase_peer_v(const Params& p) {
  unsigned char* ws = p.ws;
  PfCtx c;
  c.PIDX = (const unsigned*)(ws + WS_PIDX); c.PW = (const float*)(ws + WS_PW); c.HB = (const bf16_t*)(ws + WS_HB); c.out = p.out;
  const int tidv = otid();
  const int lane = tidv & 63, wave = tidv >> 6;
  c.lane = lane; c.pg = lane >> 3; c.c = lane & 7;
  const int G = gridDim.x, ng = (G % 8 == 0) ? 8 : 1;
  const int x = blockIdx.x % ng, lw = (blockIdx.x / ng) * NWAVES + wave, nlw = (G / ng) * NWAVES;
  for (int job = x; job < 8; job += ng) {
    const int s = job & 3, tbeg = (job >> 2) * (T / 2);
    c.s = s; c.tend = tbeg + T / 2;
    c.base = ws + WS_V8 + (size_t)s * 16384 * 128 + c.c * 16;
    PfIdx IA, IB;
    u32x4 RA[8], RB[8];
    const int t0 = tbeg + lw;
    pf_load_idx(c, t0, 0, IA);
    pf_load_idx(c, t0, 1, IB);
    pf_load_rows(c, IA, RA);
    f32x4 wc0 = IA.w0, wc1 = IA.w1;
    {
      unsigned z = IB.e0.x | IB.e1.w | __float_as_uint(IB.w1.w);
#pragma unroll
      for (int i = 0; i < 8; ++i) z |= RA[i].w;
      asm volatile("" ::"v"(z));
    }
    for (int t = t0; t < c.tend; t += nlw) {
      const size_t oo = pf_out_off(c, t);
      const u32x2 hb = *(const u32x2*)(c.HB + oo);
      f32x2 acc[16];
#pragma unroll
      for (int k = 0; k < 16; ++k) acc[k] = (f32x2){0.f, 0.f};
      PF_STEP(t, 0, IA, IB, RB, RA)
      PF_STEP(t, 1, IB, IA, RA, RB)
      pf_finish(c, t, oo, hb, acc);
    }
  }
}
#undef PF_STEP

#define XB_TMO      128
#define XB_XCNT(j)  (256  + 64 * (j))
#define XB_XSUB(j)  (1280 + 64 * (j))
#define XB_XGEN(j)  (2304 + 64 * (j))
#define XB_TOP      3328
#define XB_TOPGEN   3392
#define XCD_BAR_WORDS 3456
#define XB_SPIN_CAP (1u << 22)
__device__ __forceinline__ unsigned xb_ld(unsigned* p)              { return __hip_atomic_load(p, __ATOMIC_RELAXED, __HIP_MEMORY_SCOPE_AGENT); }
__device__ __forceinline__ unsigned xb_add(unsigned* p, unsigned v) { return __hip_atomic_fetch_add(p, v, __ATOMIC_RELAXED, __HIP_MEMORY_SCOPE_AGENT); }
__device__ __forceinline__ unsigned xb_xcc_id() { return (unsigned)__builtin_amdgcn_s_getreg((3 << 11) | 20) & 0xFu; }
#define XB_SPIN(cond, bar) do { unsigned _sp = 0; while (cond) { __builtin_amdgcn_s_sleep(1); \
    if ((++_sp & 255u) == 0u) { if (xb_ld(&(bar)[XB_TMO])) break; if (_sp > XB_SPIN_CAP) { atomicAdd(&(bar)[XB_TMO], 1u); break; } } } } while (0)
struct XcdBarrier { unsigned* bar; unsigned x; volatile LAS unsigned* st; };
__device__ __forceinline__ XcdBarrier xcd_barrier_post(unsigned* bar, volatile LAS unsigned* st) {
    XcdBarrier b; b.bar = bar; b.x = xb_xcc_id(); b.st = st;
    if (threadIdx.x == 0) (void)xb_add(&bar[XB_XCNT(b.x)], 1u);
    return b;
}
__device__ __forceinline__ void xcd_barrier_complete(unsigned* bar, unsigned x, unsigned& nloc, unsigned& nx) {
    const unsigned G = gridDim.x * gridDim.y * gridDim.z;
    unsigned sum, cnt, mine, sp = 0u;
    for (;;) {
        sum = 0u; cnt = 0u; mine = 0u;
#pragma unroll
        for (unsigned j = 0; j < 16; ++j) { const unsigned c = xb_ld(&bar[XB_XCNT(j)]); sum += c; cnt += (c > 0u) ? 1u : 0u; mine = (j == x) ? c : mine; }
        if (sum == G) break;
        __builtin_amdgcn_s_sleep(1);
        if ((++sp & 255u) == 0u) { if (xb_ld(&bar[XB_TMO])) break; if (sp > XB_SPIN_CAP) { atomicAdd(&bar[XB_TMO], 1u); break; } }
    }
    nloc = mine > 0u ? mine : 1u; nx = cnt > 0u ? cnt : 1u;
}
__device__ __forceinline__ void xcd_barrier(const XcdBarrier& b) {
    asm volatile("s_waitcnt vmcnt(0)" ::: "memory");
    __syncthreads();
    if (threadIdx.x == 0) {
        unsigned* bar = b.bar;
        __builtin_amdgcn_s_waitcnt(0);
        unsigned nloc = b.st[0], nx = b.st[1];
        if (nloc == 0u) { xcd_barrier_complete(bar, b.x, nloc, nx); b.st[0] = nloc; b.st[1] = nx; }
        const unsigned old = xb_add(&bar[XB_XSUB(b.x)], 1u);
        const unsigned gen = old / nloc;
        if (old + 1u == (gen + 1u) * nloc) {
            __builtin_amdgcn_fence(__ATOMIC_RELEASE, "agent");
            asm volatile("s_waitcnt vmcnt(0)" ::: "memory");
            const unsigned og = xb_add(&bar[XB_TOP], 1u);
            const unsigned tg = og / nx;
            if (og + 1u == (tg + 1u) * nx) xb_add(&bar[XB_TOPGEN], 1u);
            else XB_SPIN(xb_ld(&bar[XB_TOPGEN]) == tg, bar);
            __builtin_amdgcn_fence(__ATOMIC_ACQUIRE, "agent");
            xb_add(&bar[XB_XGEN(b.x)], 1u);
            asm volatile("s_waitcnt vmcnt(0)" ::: "memory");
        } else {
            XB_SPIN(xb_ld(&bar[XB_XGEN(b.x)]) == gen, bar);
            __builtin_amdgcn_fence(__ATOMIC_ACQUIRE, "agent");
            asm volatile("s_waitcnt vmcnt(0)" ::: "memory");
        }
    }
    __syncthreads();
}

__global__ void __launch_bounds__(NTHREADS, 2) k_fused(Params p) {
  __shared__ __attribute__((aligned(16))) char smem[LDS_BYTES];
  if (threadIdx.x == 0) *(u32x4*)(smem + LDS_BAR) = (u32x4){0u, 0u, 0u, 0u};
  __syncthreads();
  const XcdBarrier bar = xcd_barrier_post((unsigned*)(p.ws + WS_CTL), (volatile LAS unsigned*)(smem + LDS_BAR));
#ifdef PROBE_PHASE
  unsigned long long ts[12];
#define STAMP(k) ts[k] = __builtin_amdgcn_s_memrealtime();
#else
#define STAMP(k)
#endif
  STAMP(0)
  phase_prep(p);
  xcd_barrier(bar);
  STAMP(1)
  phase_inproj(p, smem);
  xcd_barrier(bar);
  STAMP(2)
  phase_mix(p, smem);
  xcd_barrier(bar);
  STAMP(3)
  phase_attn_norm(p);
  xcd_barrier(bar);
  STAMP(4)
  phase_outproj(p, smem);
  xcd_barrier(bar);
  STAMP(5)
  phase_qproj(p, smem);
  xcd_barrier(bar);
  STAMP(6)
  phase_route(p);
  xcd_barrier(bar);
  STAMP(7)
  phase_peer_u(p, smem);
  xcd_barrier(bar);
  STAMP(8)
  phase_peer_v(p);
#ifdef PROBE_PHASE
  xcd_barrier(bar);
  STAMP(9)
  if (blockIdx.x == 0 && threadIdx.x == 0) {
    const float us = (float)(ts[PROBE_PHASE + 1] - ts[PROBE_PHASE]) * 0.01f;
    p.out[12345] += us * (1.f / PROBE_DIV);
  }
#endif
}

extern "C" void kernel_launch(void* const* d_in, const int* in_sizes, int n_in, void* d_out, int out_size, void* d_ws, size_t ws_size,
                              hipStream_t stream) {
  if (n_in != 17 || ws_size < WS_END) {
    fprintf(stderr, "kernel_launch: unexpected n_in %d / ws_size %zu\n", n_in, ws_size);
    return;
  }
  Params p{};
  p.x = (const float*)d_in[0]; p.norm_mix_g = (const float*)d_in[1]; p.w_in = (const float*)d_in[2]; p.q_norm_g = (const float*)d_in[3];
  p.k_norm_g = (const float*)d_in[4]; p.attn_out_g = (const float*)d_in[5]; p.conv_w = (const float*)d_in[6]; p.conv_b = (const float*)d_in[7];
  p.conv_ln_g = (const float*)d_in[8]; p.conv_ln_b = (const float*)d_in[9]; p.w_out = (const float*)d_in[10]; p.norm_ffn_g = (const float*)d_in[11];
  p.peer_wq = (const float*)d_in[12]; p.peer_k1 = (const float*)d_in[13]; p.peer_k2 = (const float*)d_in[14]; p.peer_u = (const float*)d_in[15];
  p.peer_v = (const float*)d_in[16];
  p.out = (float*)d_out;
  p.ws = (unsigned char*)d_ws;
  static int grid_blocks = 0;
  if (!grid_blocks) {
    int dev = 0, cus = 0, per_cu = 0;
    (void)hipGetDevice(&dev);
    (void)hipDeviceGetAttribute(&cus, hipDeviceAttributeMultiprocessorCount, dev);
    (void)hipOccupancyMaxActiveBlocksPerMultiprocessor(&per_cu, k_fused, NTHREADS, 0);
    if (per_cu > 1) per_cu = 1;
    if (per_cu < 1) per_cu = 1;
    grid_blocks = cus * per_cu;
  }
  (void)hipMemsetAsync((char*)d_ws + WS_CTL, 0, XCD_BAR_WORDS * 4, stream);
  hipLaunchKernelGGL(k_fused, dim3(grid_blocks), dim3(NTHREADS), 0, stream, p);
}
```

```cpp
#include <hip/hip_runtime.h>
#include <cstdio>

#define LAS __attribute__((address_space(3)))
typedef unsigned short bf16_t;
typedef __bf16 bf16x8 __attribute__((ext_vector_type(8)));
typedef __bf16 bf16x2 __attribute__((ext_vector_type(2)));
typedef float f32x4 __attribute__((ext_vector_type(4)));
typedef float f32x16 __attribute__((ext_vector_type(16)));
typedef unsigned u32x4 __attribute__((ext_vector_type(4)));
typedef unsigned u32x2 __attribute__((ext_vector_type(2)));
typedef float f32x2 __attribute__((ext_vector_type(2)));

constexpr int SEQ = 4096, T = 8 * SEQ, D = 1024, NIN = 2560;
constexpr float EPS = 1e-6f;
constexpr float LOG2E = 1.4426950408889634f;

constexpr size_t MiB = 1u << 20;
constexpr size_t WS_W1 = 0, WS_WV = 4 * MiB, WS_WOUT = 5 * MiB, WS_WQ = 7 * MiB, WS_K1 = 9 * MiB, WS_K2 = 9 * MiB + 131072, WS_SSQ = 10 * MiB;
constexpr size_t WS_CTL = 11 * MiB;
constexpr size_t WS_US = 11 * MiB + 65536, WS_VS = 11 * MiB + 131072;
constexpr size_t WS_RS1 = 11 * MiB + 196608, WS_SSQ2 = 11 * MiB + 327680;
constexpr size_t WS_U8 = 12 * MiB, WS_V8 = 28 * MiB;
constexpr size_t WS_XB = 44 * MiB;
constexpr size_t WS_Q = 108 * MiB, WS_K = 140 * MiB, WS_VT = 172 * MiB, WS_HG = 204 * MiB, WS_MIX = 236 * MiB;
constexpr size_t WS_HB = 300 * MiB, WS_QH = 364 * MiB;
constexpr size_t WS_XN8 = 108 * MiB, WS_PIDX = 140 * MiB, WS_PG = 156 * MiB, WS_PW = 172 * MiB;
constexpr size_t WS_END = 428 * MiB;

struct Params {
  const float *x, *norm_mix_g, *w_in, *q_norm_g, *k_norm_g, *attn_out_g, *conv_w, *conv_b, *conv_ln_g, *conv_ln_b,
      *w_out, *norm_ffn_g, *peer_wq, *peer_k1, *peer_k2, *peer_u, *peer_v;
  float* out;
  unsigned char* ws;
};

constexpr int NTHREADS = 512, NWAVES = 8;
constexpr int LDS_STAGE = 131072, LDS_BAR = LDS_STAGE, LDS_BYTES = LDS_STAGE + 16;

__device__ __forceinline__ unsigned pk2(float lo, float hi) {
  bf16x2 v = {(__bf16)lo, (__bf16)hi};
  return __builtin_bit_cast(unsigned, v);
}
__device__ __forceinline__ float bflo(unsigned u) { return __uint_as_float(u << 16); }
__device__ __forceinline__ float bfhi(unsigned u) { return __uint_as_float(u & 0xffff0000u); }
__device__ __forceinline__ int otid() { int t = threadIdx.x; asm volatile("" : "+v"(t)); return t; }
__device__ __forceinline__ int vblock() {
  const int G = gridDim.x, b = blockIdx.x;
  return (G % 8 == 0) ? (b % 8) * (G / 8) + b / 8 : b;
}
__device__ __forceinline__ f32x16 mfma32(bf16x8 a, bf16x8 b, f32x16 c) { return __builtin_amdgcn_mfma_f32_32x32x16_bf16(a, b, c, 0, 0, 0); }

__device__ __forceinline__ int w1_src(int n) {
  if (n < 1024) {
    const int kind = n >> 9, rel = n & 511, pn = rel >> 8, P = rel & 255, bj = P >> 7, wc = (P >> 5) & 3, x = P & 31;
    return kind * 512 + (4 * pn + wc) * 64 + 32 * bj + x;
  }
  const int rel = n - 1024, pn = rel >> 8, P = rel & 255, bj = P >> 7, wc = (P >> 5) & 3, x = P & 31;
  return (bj ? 2048 : 1536) + 128 * pn + 32 * wc + x;
}
__device__ __forceinline__ void transpose_items(const float* __restrict__ W, int ldw, int N, bf16_t* __restrict__ Wt, const float* __restrict__ g, int glimit,
                                                int mode, long gtid, long nthr) {
  const long nitems = (long)N * 128;
  for (long it = gtid; it < nitems; it += nthr) {
    const int n = (int)(it % N), kc = (int)(it / N);
    const int src = mode == 1 ? w1_src(n) : (mode == 2 ? 1024 + n : n);
    float v[8];
#pragma unroll
    for (int i = 0; i < 8; ++i) {
      const int k = kc * 8 + i;
      float w = W[(size_t)k * ldw + src];
      if (k < glimit) w *= g[k];
      v[i] = w;
    }
    u32x4 o = {pk2(v[0], v[1]), pk2(v[2], v[3]), pk2(v[4], v[5]), pk2(v[6], v[7])};
    *(u32x4*)(Wt + (size_t)n * 1024 + kc * 8) = o;
  }
}
__device__ __forceinline__ void convert_items(const float* __restrict__ src, bf16_t* __restrict__ dst, long n8, long gtid, long nthr) {
  for (long it = gtid; it < n8; it += nthr) {
    const f32x4 a = *(const f32x4*)(src + it * 8), b = *(const f32x4*)(src + it * 8 + 4);
    u32x4 o = {pk2(a.x, a.y), pk2(a.z, a.w), pk2(b.x, b.y), pk2(b.z, b.w)};
    *(u32x4*)(dst + it * 8) = o;
  }
}
__device__ void phase_prep(const Params& p) {
  const int tid0 = otid();
  const long gtid = (long)vblock() * NTHREADS + tid0, nthr = (long)gridDim.x * NTHREADS;
  unsigned char* ws = p.ws;
  transpose_items(p.w_in, NIN, 2048, (bf16_t*)(ws + WS_W1), p.norm_mix_g, 1024, 1, gtid, nthr);
  transpose_items(p.w_in, NIN, 512, (bf16_t*)(ws + WS_WV), p.norm_mix_g, 1024, 2, gtid, nthr);
  transpose_items(p.w_out, D, D, (bf16_t*)(ws + WS_WOUT), p.attn_out_g, 512, 0, gtid, nthr);
  transpose_items(p.peer_wq, D, D, (bf16_t*)(ws + WS_WQ), p.norm_ffn_g, 1024, 0, gtid, nthr);
  convert_items(p.peer_k1, (bf16_t*)(ws + WS_K1), 65536 / 8, gtid, nthr);
  convert_items(p.peer_k2, (bf16_t*)(ws + WS_K2), 65536 / 8, gtid, nthr);
  const int lane = tid0 & 63, gw = vblock() * NWAVES + (tid0 >> 6), nw = gridDim.x * NWAVES;
  {
    bf16_t* XB = (bf16_t*)(ws + WS_XB);
    float* RS1 = (float*)(ws + WS_RS1);
    float* SSQ2 = (float*)(ws + WS_SSQ2);
    for (int tb = gw; tb < T; tb += 2 * nw) {
      f32x4 v[2][4];
      float ss[2] = {0.f, 0.f};
#pragma unroll
      for (int u = 0; u < 2; ++u) {
        const int t = (tb + u * nw < T) ? tb + u * nw : tb;
        const float* src = p.x + (size_t)t * 1024 + lane * 4;
#pragma unroll
        for (int i = 0; i < 4; ++i) v[u][i] = *(const f32x4*)(src + 256 * i);
      }
#pragma unroll
      for (int u = 0; u < 2; ++u) {
#pragma unroll
        for (int i = 0; i < 4; ++i) ss[u] += v[u][i].x * v[u][i].x + v[u][i].y * v[u][i].y + v[u][i].z * v[u][i].z + v[u][i].w * v[u][i].w;
      }
#pragma unroll
      for (int o = 1; o < 64; o <<= 1) { ss[0] += __shfl_xor(ss[0], o); ss[1] += __shfl_xor(ss[1], o); }
#pragma unroll
      for (int u = 0; u < 2; ++u) {
        const int t = tb + u * nw;
        if (t < T) {
#pragma unroll
          for (int i = 0; i < 4; ++i) *(u32x2*)(XB + (size_t)t * 1024 + lane * 4 + 256 * i) = (u32x2){pk2(v[u][i].x, v[u][i].y), pk2(v[u][i].z, v[u][i].w)};
          if (lane == 0) { RS1[t] = rsqrtf(ss[u] * (1.f / 1024.f) + EPS); SSQ2[t] = 0.f; }
        }
      }
    }
  }
  {
    for (int rb = gw; rb < 32768; rb += 2 * nw) {
      f32x4 v[2][4];
#pragma unroll
      for (int u = 0; u < 2; ++u) {
        const int r = (rb + u * nw < 32768) ? rb + u * nw : rb;
        const float* src = ((r >> 14) ? p.peer_v : p.peer_u) + (size_t)(r & 16383) * 1024 + lane * 16;
#pragma unroll
        for (int i = 0; i < 4; ++i) v[u][i] = *(const f32x4*)(src + 4 * i);
      }
      float am[2] = {0.f, 0.f};
#pragma unroll
      for (int u = 0; u < 2; ++u)
#pragma unroll
        for (int i = 0; i < 4; ++i)
          am[u] = fmaxf(am[u], fmaxf(fmaxf(fabsf(v[u][i].x), fabsf(v[u][i].y)), fmaxf(fabsf(v[u][i].z), fabsf(v[u][i].w))));
#pragma unroll
      for (int o = 1; o < 64; o <<= 1) { am[0] = fmaxf(am[0], __shfl_xor(am[0], o)); am[1] = fmaxf(am[1], __shfl_xor(am[1], o)); }
#pragma unroll
      for (int u = 0; u < 2; ++u) {
        const int r = rb + u * nw;
        if (r < 32768) {
          const int isv = r >> 14, e = r & 16383;
          const float scale = am[u] > 0.f ? am[u] * (1.f / 6.f) : 1.f, inv = am[u] > 0.f ? 6.f / am[u] : 0.f;
          unsigned q[2] = {0u, 0u};
#pragma unroll
          for (int i = 0; i < 4; ++i)
#pragma unroll
            for (int j = 0; j < 4; ++j) {
              const float xv = v[u][i][j], m = fabsf(xv) * inv;
              const unsigned code = (unsigned)(m > 0.25f) + (unsigned)(m > 0.75f) + (unsigned)(m > 1.25f) + (unsigned)(m > 1.75f) +
                                    (unsigned)(m > 2.5f) + (unsigned)(m > 3.5f) + (unsigned)(m > 5.0f);
              const unsigned nib = code | (xv < 0.f ? 8u : 0u);
              const int el = 4 * i + j;
              q[el >> 3] |= nib << (4 * (el & 7));
            }
          if (isv) {
            *(u32x2*)(ws + WS_V8 + ((size_t)(lane >> 4) * 16384 + e) * 128 + (lane & 15) * 8) = (u32x2){q[0], q[1]};
            if (lane == 0) ((float*)(ws + WS_VS))[e] = scale;
          } else {
            *(u32x2*)(ws + WS_U8 + (size_t)e * 512 + lane * 8) = (u32x2){q[0], q[1]};
            if (lane == 0) ((float*)(ws + WS_US))[e] = scale;
          }
        }
      }
    }
  }
}

namespace pg8 {
typedef short sbf16x8 __attribute__((ext_vector_type(8)));
constexpr int BM = 256, BK = 64, HALF = 128, HTB = HALF * BK * 2  , NXCD = 8, WGM = 8;
__device__ __forceinline__ int lds_byte(int r, int c) { const int st = (r >> 4) * 2 + (c >> 5), rr = r & 15, cc = c & 31, ob = rr * 64 + cc * 2; return st * 1024 + (ob ^ (((ob >> 9) & 1) << 5)); }
__device__ __forceinline__ void stage_rc(int b, int& R, int& C) { const int st = b / 1024, sb = b % 1024, swz = sb ^ (((sb >> 9) & 1) << 5); R = (st >> 1) * 16 + swz / 64; C = (st & 1) * 32 + (swz % 64) / 2; }
__device__ __forceinline__ int perm32(int rho) { const int n = rho >> 4, i = rho & 15; return 8 * (i >> 2) + 4 * n + (i & 3); }
struct Unit { int pm, pn; };
struct Gemm { const bf16_t* A; const bf16_t* Bt; int M, N, K; };
struct StaticOrder {
    int nM, nN, nwg, G, c;
    __device__ void init(int M, int N, int G_, int c_) { nM = M / BM; nN = N / BM; nwg = nM * nN; G = G_; c = c_; }
    __device__ bool next(int i, Unit& u) const {
        const long L = (long)i * G + c; if (L >= nwg) return false;
        int wgid = (int)L; { const int q = nwg / NXCD, r = nwg % NXCD, xcd = wgid % NXCD, off = wgid / NXCD; wgid = (xcd < r ? xcd * (q + 1) : r * (q + 1) + (xcd - r) * q) + off; }
        const int nig = WGM * nN, gid = wgid / nig, fm = gid * WGM, gsz = (nM - fm) < WGM ? (nM - fm) : WGM;
        u.pm = fm + ((wgid % nig) % gsz); u.pn = (wgid % nig) / gsz; return true;
    }
};
template <class Epi>
__device__ __forceinline__ void gemm_phase(LAS unsigned char* lds, const Gemm g, const StaticOrder& S, const Epi& E) {
    const int tid = otid(), wid = __builtin_amdgcn_readfirstlane(tid >> 6), lane = tid & 63, wr = wid >> 2, wc = wid & 3, fr = lane & 15, fq = lane >> 4;
    const int K = g.K, nt = K / BK;
    unsigned voffA[2], voffB[2];
#pragma unroll
    for (int i = 0; i < 2; ++i) { int R, C; stage_rc(tid * 16 + i * 8192, R, C); const int Rb = Epi::PERM ? ((R & ~31) + perm32(R & 31)) : R;
        voffA[i] = (unsigned)(R * K + C) * 2u; voffB[i] = (unsigned)(Rb * K + C) * 2u; }
    const size_t kstep = (size_t)(BK * 2);
    const size_t hstep = (size_t)HALF * K * 2;
    const size_t tstep = 2 * hstep;
    const unsigned ldsw = (unsigned)wid * 1024u;
    const int aoff = lds_byte(wr * 64 + fr, fq * 8), boff = lds_byte(wc * 32 + fr, fq * 8);
#define PG8_SA(b, h) (((b) * 2 + (h)) * HTB)
#define PG8_SB(b, h) ((4 + (b) * 2 + (h)) * HTB)
#define PG8_STAGE(bufoff, gbase, voff) do { _Pragma("unroll") for (int _i = 0; _i < 2; ++_i) \
        __builtin_amdgcn_global_load_lds((const unsigned*)((const char*)(gbase) + (voff)[_i]), (LAS unsigned*)(lds + (bufoff) + ldsw + _i * 8192), 16, 0, 0); } while (0)
#define PG8_LDA(dst, b, h) do { _Pragma("unroll") for (int m = 0; m < 4; ++m) _Pragma("unroll") for (int k = 0; k < 2; ++k) dst[m][k] = *(const LAS sbf16x8*)(lds + PG8_SA(b, h) + aoff + m * 2048 + k * 1024); } while (0)
#define PG8_LDB(dst, b, h) do { _Pragma("unroll") for (int n = 0; n < 2; ++n) _Pragma("unroll") for (int k = 0; k < 2; ++k) dst[n][k] = *(const LAS sbf16x8*)(lds + PG8_SB(b, h) + boff + n * 2048 + k * 1024); } while (0)
#define PG8_MMA(ai, bj, At, Bt) do { __builtin_amdgcn_s_setprio(1); _Pragma("unroll") for (int m = 0; m < 4; ++m) _Pragma("unroll") for (int n = 0; n < 2; ++n) _Pragma("unroll") for (int k = 0; k < 2; ++k) \
        acc[ai][bj][m][n] = __builtin_amdgcn_mfma_f32_16x16x32_bf16(__builtin_bit_cast(bf16x8, Bt[n][k]), __builtin_bit_cast(bf16x8, At[m][k]), acc[ai][bj][m][n], 0, 0, 0); __builtin_amdgcn_s_setprio(0); } while (0)
#define PG8_WAIT_V(n) asm volatile("s_waitcnt vmcnt(" #n ")" ::: "memory")
#define PG8_WAIT_L(n) asm volatile("s_waitcnt lgkmcnt(" #n ")" ::: "memory")
#define PG8_BAR __builtin_amdgcn_s_barrier()
#define PG8_SCHED __builtin_amdgcn_sched_barrier(0)
    Unit cur, nxt; int ui = 0;
    if (!S.next(0, cur)) return;
    f32x4 acc[2][2][4][2];
#pragma unroll
    for (int a = 0; a < 2; ++a)
#pragma unroll
        for (int b = 0; b < 2; ++b)
#pragma unroll
            for (int m = 0; m < 4; ++m)
#pragma unroll
                for (int n = 0; n < 2; ++n) acc[a][b][m][n] = (f32x4){0.f, 0.f, 0.f, 0.f};
    sbf16x8 At[4][2], B0[2][2], B1[2][2];
    const char* cA = (const char*)g.A + (size_t)cur.pm * tstep; const char* cB = (const char*)g.Bt + (size_t)cur.pn * tstep;
    PG8_STAGE(PG8_SB(0, 0), cB, voffB); PG8_STAGE(PG8_SA(0, 0), cA, voffA); PG8_STAGE(PG8_SB(0, 1), cB + hstep, voffB); PG8_STAGE(PG8_SA(0, 1), cA + hstep, voffA);
    if (wr == 1) PG8_BAR;
    PG8_WAIT_V(4); PG8_BAR;
    PG8_STAGE(PG8_SB(1, 0), cB + kstep, voffB); PG8_STAGE(PG8_SA(1, 0), cA + kstep, voffA); PG8_STAGE(PG8_SB(1, 1), cB + hstep + kstep, voffB);
    PG8_WAIT_V(6); PG8_BAR;
    for (;;) {
        const bool has_next = S.next(ui + 1, nxt);
        const char* nA = has_next ? (const char*)g.A + (size_t)nxt.pm * tstep : cA; const char* nB = has_next ? (const char*)g.Bt + (size_t)nxt.pn * tstep : cB;
        for (int t = 0; t < nt; t += 2) {
            const bool last = (t == nt - 2);
            const char* a1 = cA + (size_t)(t + 1) * kstep;
            const char* a2 = last ? nA : cA + (size_t)(t + 2) * kstep; const char* b2 = last ? nB : cB + (size_t)(t + 2) * kstep;
            const char* a3 = a2 + kstep; const char* b3 = b2 + kstep;
            PG8_LDB(B0, 0, 0); PG8_SCHED; PG8_LDA(At, 0, 0); PG8_STAGE(PG8_SA(1, 1), a1 + hstep, voffA);
            PG8_WAIT_L(8); PG8_BAR; PG8_WAIT_L(0); PG8_MMA(0, 0, At, B0); PG8_BAR; PG8_SCHED;
            PG8_LDB(B1, 0, 1); PG8_STAGE(PG8_SB(0, 0), b2, voffB);
            PG8_BAR; PG8_WAIT_L(0); PG8_MMA(0, 1, At, B1); PG8_BAR;
            PG8_LDA(At, 0, 1); PG8_STAGE(PG8_SA(0, 0), a2, voffA);
            PG8_BAR; PG8_WAIT_L(0); PG8_MMA(1, 0, At, B0); PG8_BAR; PG8_SCHED;
            PG8_STAGE(PG8_SB(0, 1), b2 + hstep, voffB);
            PG8_WAIT_V(6); PG8_BAR; PG8_MMA(1, 1, At, B1); PG8_BAR;
            PG8_LDB(B0, 1, 0); PG8_SCHED; PG8_LDA(At, 1, 0); PG8_STAGE(PG8_SA(0, 1), a2 + hstep, voffA);
            PG8_WAIT_L(8); PG8_BAR; PG8_WAIT_L(0); PG8_MMA(0, 0, At, B0); PG8_BAR; PG8_SCHED;
            PG8_LDB(B1, 1, 1); PG8_STAGE(PG8_SB(1, 0), b3, voffB);
            PG8_BAR; PG8_WAIT_L(0); PG8_MMA(0, 1, At, B1); PG8_BAR;
            PG8_LDA(At, 1, 1); PG8_STAGE(PG8_SA(1, 0), a3, voffA);
            PG8_BAR; PG8_WAIT_L(0); PG8_MMA(1, 0, At, B0); PG8_BAR; PG8_SCHED;
            PG8_STAGE(PG8_SB(1, 1), b3 + hstep, voffB);
            PG8_WAIT_V(6); PG8_BAR; PG8_MMA(1, 1, At, B1); PG8_BAR;
        }
        E(acc, cur, wr, wc, fr, fq);
        if (!has_next) break;
#pragma unroll
        for (int a = 0; a < 2; ++a)
#pragma unroll
            for (int b = 0; b < 2; ++b)
#pragma unroll
                for (int m = 0; m < 4; ++m)
#pragma unroll
                    for (int n = 0; n < 2; ++n) acc[a][b][m][n] = (f32x4){0.f, 0.f, 0.f, 0.f};
        cur = nxt; cA = nA; cB = nB; ++ui;
    }
    PG8_WAIT_V(0);
    if (wr == 0) PG8_BAR;
    PG8_BAR;
#undef PG8_SA
#undef PG8_SB
#undef PG8_STAGE
#undef PG8_LDA
#undef PG8_LDB
#undef PG8_MMA
#undef PG8_WAIT_V
#undef PG8_WAIT_L
#undef PG8_BAR
#undef PG8_SCHED
}
}

struct EpiQKC {
  static constexpr bool PERM = true;
  const float* rs1; const float* qg; const float* kg; bf16_t* Q; bf16_t* Kk; bf16_t* HG;
  __device__ __forceinline__ void operator()(const f32x4 (&acc)[2][2][4][2], const pg8::Unit& u, int wr, int wc, int fr, int fq) const {
    const int row0 = u.pm * 256 + wr * 64 + fr;
    if (u.pn < 4) {
      const bool isq = u.pn < 2;
      const int head = 4 * (u.pn & 1) + wc;
      const float* g = isq ? qg : kg;
      f32x4 gv[2][2];
#pragma unroll
      for (int bj = 0; bj < 2; ++bj)
#pragma unroll
        for (int n = 0; n < 2; ++n) gv[bj][n] = *(const f32x4*)(g + 32 * bj + 8 * fq + 4 * n);
      bf16_t* base = isq ? Q : Kk;
#pragma unroll
      for (int ai = 0; ai < 2; ++ai)
#pragma unroll
        for (int m = 0; m < 4; ++m) {
          const int t = row0 + ai * 128 + m * 16;
          float ss = 0.f;
#pragma unroll
          for (int bj = 0; bj < 2; ++bj)
#pragma unroll
            for (int n = 0; n < 2; ++n) { const f32x4 v = acc[ai][bj][m][n]; ss += v.x * v.x + v.y * v.y + v.z * v.z + v.w * v.w; }
          ss += __shfl_xor(ss, 16);
          ss += __shfl_xor(ss, 32);
          const float r = rs1[t];
          float sc = r * rsqrtf(r * r * ss * (1.f / 64.f) + EPS);
          if (isq) sc *= 0.125f * LOG2E;
          bf16_t* dst = base + ((size_t)((t >> 12) * 8 + head) * 4096 + (t & 4095)) * 64 + 8 * fq;
#pragma unroll
          for (int bj = 0; bj < 2; ++bj) {
            const f32x4 a = acc[ai][bj][m][0] * gv[bj][0] * sc, b = acc[ai][bj][m][1] * gv[bj][1] * sc;
            *(u32x4*)(dst + 32 * bj) = (u32x4){pk2(a.x, a.y), pk2(a.z, a.w), pk2(b.x, b.y), pk2(b.z, b.w)};
          }
        }
    } else {
      const int ch0 = 128 * (u.pn - 4) + 32 * wc + 8 * fq;
#pragma unroll
      for (int ai = 0; ai < 2; ++ai)
#pragma unroll
        for (int m = 0; m < 4; ++m) {
          const int t = row0 + ai * 128 + m * 16;
          const float r = rs1[t];
          float h[8];
#pragma unroll
          for (int n = 0; n < 2; ++n)
#pragma unroll
            for (int j = 0; j < 4; ++j) h[4 * n + j] = acc[ai][0][m][n][j] * r / (1.f + __expf(-acc[ai][1][m][n][j] * r));
          *(u32x4*)(HG + (size_t)t * 512 + ch0) = (u32x4){pk2(h[0], h[1]), pk2(h[2], h[3]), pk2(h[4], h[5]), pk2(h[6], h[7])};
        }
    }
  }
};
struct EpiVt {
  static constexpr bool PERM = false;
  const float* rs1; bf16_t* Vt;
  __device__ __forceinline__ void operator()(const f32x4 (&acc)[2][2][4][2], const pg8::Unit& u, int wr, int wc, int fr, int fq) const {
    const int pos0 = 8 * (fq & 1) + 4 * (fq >> 1);
#pragma unroll
    for (int bj = 0; bj < 2; ++bj)
#pragma unroll
      for (int n = 0; n < 2; ++n) {
        const int t = u.pn * 256 + bj * 128 + wc * 32 + n * 16 + 4 * fq;
        const f32x4 r = *(const f32x4*)(rs1 + t);
        const size_t tb = ((size_t)(t >> 12) * 8) * 128 + ((t & 4095) >> 5);
#pragma unroll
        for (int ai = 0; ai < 2; ++ai)
#pragma unroll
          for (int m = 0; m < 4; ++m) {
            const int dg = u.pm * 256 + ai * 128 + wr * 64 + m * 16 + fr, head = dg >> 6, d = dg & 63;
            const f32x4 v = acc[ai][bj][m][n] * r;
            *(u32x2*)(Vt + ((tb + (size_t)head * 128) * 64 + d) * 32 + 16 * n + pos0) = (u32x2){pk2(v.x, v.y), pk2(v.z, v.w)};
          }
      }
  }
};
struct EpiOut {
  static constexpr bool PERM = false;
  const bf16_t* xb; bf16_t* HB; float* ssq2;
  __device__ __forceinline__ void operator()(const f32x4 (&acc)[2][2][4][2], const pg8::Unit& u, int wr, int wc, int fr, int fq) const {
    const int row0 = u.pm * 256 + wr * 64 + fr, col0 = u.pn * 256 + wc * 32 + 4 * fq;
#pragma unroll
    for (int ai = 0; ai < 2; ++ai)
#pragma unroll
      for (int m = 0; m < 4; ++m) {
        const int t = row0 + ai * 128 + m * 16;
        const size_t ro = (size_t)t * 1024 + col0;
        float ss = 0.f;
#pragma unroll
        for (int bj = 0; bj < 2; ++bj)
#pragma unroll
          for (int n = 0; n < 2; ++n) {
            const size_t o = ro + bj * 128 + n * 16;
            const u32x2 xv = *(const u32x2*)(xb + o);
            const f32x4 h = (f32x4){bflo(xv.x), bfhi(xv.x), bflo(xv.y), bfhi(xv.y)} + acc[ai][bj][m][n];
            *(u32x2*)(HB + o) = (u32x2){pk2(h.x, h.y), pk2(h.z, h.w)};
            ss += h.x * h.x + h.y * h.y + h.z * h.z + h.w * h.w;
          }
        ss += __shfl_xor(ss, 16);
        ss += __shfl_xor(ss, 32);
        if (fq == 0) atomicAdd(ssq2 + t, ss);
      }
  }
};
struct EpiQh {
  static constexpr bool PERM = true;
  const float* ssq2; bf16_t* QH;
  __device__ __forceinline__ void operator()(const f32x4 (&acc)[2][2][4][2], const pg8::Unit& u, int wr, int wc, int fr, int fq) const {
    const int row0 = u.pm * 256 + wr * 64 + fr, col0 = u.pn * 256 + wc * 32 + 8 * fq;
#pragma unroll
    for (int ai = 0; ai < 2; ++ai)
#pragma unroll
      for (int m = 0; m < 4; ++m) {
        const int t = row0 + ai * 128 + m * 16;
        const float r = rsqrtf(ssq2[t] * (1.f / 1024.f) + EPS);
#pragma unroll
        for (int bj = 0; bj < 2; ++bj) {
          const f32x4 a = acc[ai][bj][m][0] * r, b = acc[ai][bj][m][1] * r;
          *(u32x4*)(QH + (size_t)t * 1024 + col0 + bj * 128) = (u32x4){pk2(a.x, a.y), pk2(a.z, a.w), pk2(b.x, b.y), pk2(b.z, b.w)};
        }
      }
  }
};

__device__ void phase_inproj(const Params& p, char* smem) {
  unsigned char* ws = p.ws;
  LAS unsigned char* lds = (LAS unsigned char*)smem;
  const bf16_t* XB = (const bf16_t*)(ws + WS_XB);
  const float* RS1 = (const float*)(ws + WS_RS1);
  pg8::StaticOrder S;
  {
    pg8::Gemm g{XB, (const bf16_t*)(ws + WS_W1), T, 2048, 1024};
    S.init(T, 2048, gridDim.x, blockIdx.x);
    EpiQKC E{RS1, p.q_norm_g, p.k_norm_g, (bf16_t*)(ws + WS_Q), (bf16_t*)(ws + WS_K), (bf16_t*)(ws + WS_HG)};
    pg8::gemm_phase<EpiQKC>(lds, g, S, E);
  }
  {
    pg8::Gemm g{(const bf16_t*)(ws + WS_WV), XB, 512, T, 1024};
    S.init(512, T, gridDim.x, blockIdx.x);
    EpiVt E{RS1, (bf16_t*)(ws + WS_VT)};
    pg8::gemm_phase<EpiVt>(lds, g, S, E);
  }
}
__device__ void phase_outproj(const Params& p, char* smem) {
  unsigned char* ws = p.ws;
  pg8::Gemm g{(const bf16_t*)(ws + WS_MIX), (const bf16_t*)(ws + WS_WOUT), T, 1024, 1024};
  pg8::StaticOrder S;
  S.init(T, 1024, gridDim.x, blockIdx.x);
  EpiOut E{(const bf16_t*)(ws + WS_XB), (bf16_t*)(ws + WS_HB), (float*)(ws + WS_SSQ2)};
  pg8::gemm_phase<EpiOut>((LAS unsigned char*)smem, g, S, E);
}
__device__ void phase_qproj(const Params& p, char* smem) {
  unsigned char* ws = p.ws;
  pg8::Gemm g{(const bf16_t*)(ws + WS_HB), (const bf16_t*)(ws + WS_WQ), T, 1024, 1024};
  pg8::StaticOrder S;
  S.init(T, 1024, gridDim.x, blockIdx.x);
  EpiQh E{(const float*)(ws + WS_SSQ2), (bf16_t*)(ws + WS_QH)};
  pg8::gemm_phase<EpiQh>((LAS unsigned char*)smem, g, S, E);
}

__device__ void conv_item(const Params& p, int item, char* smem) {
  unsigned char* ws = p.ws;
  const bf16_t* HG = (const bf16_t*)(ws + WS_HG);
  bf16_t* MIX = (bf16_t*)(ws + WS_MIX);
  const int tid512 = otid(), half = tid512 >> 8, tid = tid512 & 255, lane = tid & 63, wave = tid >> 6;
  const int t0 = item * 32, s0 = t0 & 4095;
  for (int idx = tid512; idx < 62 * 64; idx += NTHREADS) {
    const int r = idx >> 6, c16 = idx & 63;
    u32x4 v = {0u, 0u, 0u, 0u};
    if (s0 - 30 + r >= 0) v = *(const u32x4*)(HG + (size_t)(t0 - 30 + r) * 512 + c16 * 8);
    *(u32x4*)(smem + r * 1024 + c16 * 16) = v;
  }
  float w0[31], w1[31];
#pragma unroll
  for (int j = 0; j < 31; ++j) {
    const float2 w = *(const float2*)(p.conv_w + j * 512 + 2 * tid);
    w0[j] = w.x;
    w1[j] = w.y;
  }
  const float2 cb = *(const float2*)(p.conv_b + 2 * tid);
  const float2 lg = *(const float2*)(p.conv_ln_g + 2 * tid);
  const float2 lb = *(const float2*)(p.conv_ln_b + 2 * tid);
  float* red = (float*)(smem + 62 * 1024) + half * 128;
  __syncthreads();
  const bool b5 = lane & 32, b4 = lane & 16, b3 = lane & 8, b2 = lane & 4;
#pragma unroll 1
  for (int rd = 0; rd < 2; ++rd) {
    const int tb = 16 * half + 8 * rd;
    float x0[38], x1[38];
#pragma unroll
    for (int r = 0; r < 38; ++r) {
      const unsigned v = *(const unsigned*)(smem + (tb + r) * 1024 + tid * 4);
      x0[r] = bflo(v);
      x1[r] = bfhi(v);
    }
    float a0[8], a1[8], st[16];
#pragma unroll
    for (int k = 0; k < 8; ++k) {
      float u0 = cb.x, u1 = cb.y;
#pragma unroll
      for (int j = 0; j < 31; ++j) { u0 += w0[j] * x0[k + j]; u1 += w1[j] * x1[k + j]; }
      a0[k] = u0; a1[k] = u1;
      st[k] = u0 + u1;
      st[8 + k] = u0 * u0 + u1 * u1;
    }
    float r8[8], r4[4], r2[2], r1;
#pragma unroll
    for (int i = 0; i < 8; ++i) { const float keep = b5 ? st[8 + i] : st[i], send = b5 ? st[i] : st[8 + i]; r8[i] = keep + __shfl_xor(send, 32); }
#pragma unroll
    for (int i = 0; i < 4; ++i) { const float keep = b4 ? r8[4 + i] : r8[i], send = b4 ? r8[i] : r8[4 + i]; r4[i] = keep + __shfl_xor(send, 16); }
#pragma unroll
    for (int i = 0; i < 2; ++i) { const float keep = b3 ? r4[2 + i] : r4[i], send = b3 ? r4[i] : r4[2 + i]; r2[i] = keep + __shfl_xor(send, 8); }
    { const float keep = b2 ? r2[1] : r2[0], send = b2 ? r2[0] : r2[1]; r1 = keep + __shfl_xor(send, 4); }
    r1 += __shfl_xor(r1, 2);
    r1 += __shfl_xor(r1, 1);
    float* rr = red + rd * 64;
    if ((lane & 3) == 0) rr[wave * 16 + (lane >> 2)] = r1;
    __syncthreads();
#pragma unroll
    for (int k = 0; k < 8; ++k) {
      const float S1 = (rr[k] + rr[16 + k]) + (rr[32 + k] + rr[48 + k]);
      const float S2 = (rr[8 + k] + rr[24 + k]) + (rr[40 + k] + rr[56 + k]);
      const float mu = S1 * (1.f / 512.f);
      const float var = fmaxf(S2 * (1.f / 512.f) - mu * mu, 0.f);
      const float rstd = rsqrtf(var + EPS);
      const float y0 = (a0[k] - mu) * rstd * lg.x + lb.x, y1 = (a1[k] - mu) * rstd * lg.y + lb.y;
      const float z0 = y0 / (1.f + __expf(-y0)), z1 = y1 / (1.f + __expf(-y1));
      *(unsigned*)(MIX + (size_t)(t0 + tb + k) * 1024 + 512 + 2 * tid) = pk2(z0, z1);
    }
  }
  __syncthreads();
}

struct AttnKV { bf16x8 k[4]; bf16x8 v[2][2]; };
__device__ __forceinline__ void attn_load(const bf16_t* Km, const bf16_t* Vt, int bh, int kb, int tok, int hf, AttnKV& f) {
  const int kc = kb < 0 ? 0 : kb;
  const bf16_t* kp = Km + ((size_t)bh * 4096 + kc * 32 + tok) * 64 + 8 * hf;
#pragma unroll
  for (int ks = 0; ks < 4; ++ks) f.k[ks] = *(const bf16x8*)(kp + ks * 16);
  const bf16_t* vp = Vt + (((size_t)bh * 128 + kc) * 64 + tok) * 32 + hf * 8;
#pragma unroll
  for (int m = 0; m < 2; ++m)
#pragma unroll
    for (int s = 0; s < 2; ++s) f.v[m][s] = *(const bf16x8*)(vp + m * 1024 + s * 16);
}
__device__ __forceinline__ bool attn_block(const AttnKV& f, const bf16x8 (&qf)[4], bool diag, int tok, int hf, float& c, f32x16& o0, f32x16& o1) {
  f32x16 sc;
#pragma unroll
  for (int i = 0; i < 16; ++i) sc[i] = 0.f;
#pragma unroll
  for (int ks = 0; ks < 4; ++ks) sc = mfma32(f.k[ks], qf[ks], sc);
  float lk[16], zs[16];
#pragma unroll
  for (int i = 0; i < 16; ++i) {
    const float zl = sc[i];
    const float e = __builtin_amdgcn_exp2f(zl);
    const float sp = __builtin_amdgcn_logf(1.f + e);
    const bool valid = !diag || ((i & 3) + 8 * (i >> 2) + 4 * hf < tok);
    lk[i] = valid ? -sp : 0.f;
    zs[i] = valid ? zl - sp : -1e30f;
  }
  float Tg[4], Pg[4];
#pragma unroll
  for (int g = 0; g < 4; ++g) {
    Tg[g] = (lk[4 * g] + lk[4 * g + 1]) + (lk[4 * g + 2] + lk[4 * g + 3]);
    Pg[g] = __shfl_xor(Tg[g], 32);
  }
  float base[4];
  float run = 0.f;
#pragma unroll
  for (int g = 3; g >= 0; --g) {
    base[g] = c + run + (hf == 0 ? Pg[g] : 0.f);
    run += Tg[g] + Pg[g];
  }
  float pr[16];
#pragma unroll
  for (int g = 0; g < 4; ++g) {
    float l = base[g];
#pragma unroll
    for (int r = 3; r >= 0; --r) {
      pr[4 * g + r] = __builtin_amdgcn_exp2f(zs[4 * g + r] + l);
      l += lk[4 * g + r];
    }
  }
  c += run;
  bf16x8 pf[2];
#pragma unroll
  for (int s = 0; s < 2; ++s)
#pragma unroll
    for (int j = 0; j < 8; ++j) pf[s][j] = (__bf16)pr[8 * s + j];
#pragma unroll
  for (int s = 0; s < 2; ++s) {
    o0 = mfma32(f.v[0][s], pf[s], o0);
    o1 = mfma32(f.v[1][s], pf[s], o1);
  }
  return __all(c < -150.f);
}
__device__ void attn_tile(const Params& p, int item, int it, int lane, int wave, char* smem) {
  unsigned char* ws = p.ws;
  const bf16_t* Qm = (const bf16_t*)(ws + WS_Q);
  const bf16_t* Km = (const bf16_t*)(ws + WS_K);
  const bf16_t* Vt = (const bf16_t*)(ws + WS_VT);
  bf16_t* MIX = (bf16_t*)(ws + WS_MIX);
  const int qt = item & 127, bh = (item >> 7) * 8 + wave;
  const int tok = lane & 31, hf = lane >> 5;
  bf16x8 qf[4];
  {
    const bf16_t* qp = Qm + ((size_t)bh * 4096 + qt * 32 + tok) * 64 + 8 * hf;
#pragma unroll
    for (int ks = 0; ks < 4; ++ks) qf[ks] = *(const bf16x8*)(qp + ks * 16);
  }
  f32x16 o0, o1;
#pragma unroll
  for (int i = 0; i < 16; ++i) { o0[i] = 0.f; o1[i] = 0.f; }
  float c = 0.f;
  AttnKV fa, fb;
  attn_load(Km, Vt, bh, qt, tok, hf, fa);
  {
    unsigned z = __builtin_bit_cast(u32x4, fa.v[1][1]).w | __builtin_bit_cast(u32x4, fa.k[3]).w | __builtin_bit_cast(u32x4, qf[3]).w;
    asm volatile("" ::"v"(z));
  }
  for (int kb = qt;; kb -= 2) {
    attn_load(Km, Vt, bh, kb - 1, tok, hf, fb);
    __builtin_amdgcn_sched_barrier(0);
    if (attn_block(fa, qf, kb == qt, tok, hf, c, o0, o1) || kb == 0) break;
    attn_load(Km, Vt, bh, kb - 2, tok, hf, fa);
    __builtin_amdgcn_sched_barrier(0);
    if (attn_block(fb, qf, false, tok, hf, c, o0, o1) || kb == 1) break;
  }
  float ssq = 0.f;
#pragma unroll
  for (int i = 0; i < 16; ++i) ssq += o0[i] * o0[i] + o1[i] * o1[i];
  ssq += __shfl_xor(ssq, 32);
  float* xch = (float*)(smem + 100 * 1024) + (it & 1) * 256;
  if (hf == 0) xch[wave * 32 + tok] = ssq;
  __syncthreads();
  float tot = 0.f;
#pragma unroll
  for (int w = 0; w < NWAVES; ++w) tot += xch[w * 32 + tok];
  const float rs = rsqrtf(tot * (1.f / 512.f) + EPS);
  const int t = (bh >> 3) * 4096 + qt * 32 + tok, hh = bh & 7;
  bf16_t* dst = MIX + (size_t)t * 1024 + hh * 64 + 4 * hf;
#pragma unroll
  for (int g = 0; g < 4; ++g) {
    *(u32x2*)(dst + 8 * g) = (u32x2){pk2(o0[4 * g] * rs, o0[4 * g + 1] * rs), pk2(o0[4 * g + 2] * rs, o0[4 * g + 3] * rs)};
    *(u32x2*)(dst + 32 + 8 * g) = (u32x2){pk2(o1[4 * g] * rs, o1[4 * g + 1] * rs), pk2(o1[4 * g + 2] * rs, o1[4 * g + 3] * rs)};
  }
}

__device__ void phase_mix(const Params& p, char* smem) {
  static_assert(NWAVES == 8, "one wave per attention head");
  const int vb = vblock(), G = gridDim.x;
  for (int item = vb; item < 1024; item += G) conv_item(p, item, smem);
  const int tidm = otid();
  const int lane = tidm & 63, wave = tidm >> 6;
  int it = 0;
  for (int item = vb; item < 1024; item += G, ++it) attn_tile(p, item, it, lane, wave, smem);
}
__device__ __forceinline__ unsigned f2key(float f, unsigned n) {
  const unsigned u = (__float_as_uint(f) & ~0x7Fu) | n;
  return u ^ ((unsigned)((int)u >> 31) | 0x80000000u);
}
__device__ __forceinline__ unsigned f2key_raw(float f) {
  const unsigned u = __float_as_uint(f);
  return u ^ ((unsigned)((int)u >> 31) | 0x80000000u);
}
__device__ __forceinline__ unsigned key2u(unsigned k) { return k ^ ((k >> 31) ? 0x80000000u : 0xFFFFFFFFu); }

template <int N>
__device__ __forceinline__ void bitonic_sort_desc(unsigned (&v)[N]) {
#pragma unroll
  for (int k = 2; k <= N; k <<= 1) {
#pragma unroll
    for (int j = k >> 1; j > 0; j >>= 1) {
#pragma unroll
      for (int i = 0; i < N; ++i) {
        const int l = i ^ j;
        if (l > i) {
          const bool desc = ((i & k) == 0);
          const unsigned mx = max(v[i], v[l]), mn = min(v[i], v[l]);
          v[i] = desc ? mx : mn;
          v[l] = desc ? mn : mx;
        }
      }
    }
  }
}
template <int N>
__device__ __forceinline__ void bitonic_merge_desc(unsigned (&v)[N]) {
#pragma unroll
  for (int j = N >> 1; j > 0; j >>= 1) {
#pragma unroll
    for (int i = 0; i < N; ++i) {
      const int l = i ^ j;
      if (l > i) {
        const unsigned mx = max(v[i], v[l]), mn = min(v[i], v[l]);
        v[i] = mx;
        v[l] = mn;
      }
    }
  }
}
__device__ __forceinline__ void merge_top16(unsigned (&a)[16], const unsigned (&b)[16]) {
#pragma unroll
  for (int i = 0; i < 16; ++i) a[i] = max(a[i], b[15 - i]);
  bitonic_merge_desc<16>(a);
}
#define CEP(ka, pa, kb, pb, desc)                                  \
  {                                                                \
    const bool sw_ = (desc) ? ((kb) > (ka)) : ((kb) < (ka));       \
    const unsigned tk_ = sw_ ? (kb) : (ka), tl_ = sw_ ? (ka) : (kb); \
    const unsigned tp_ = sw_ ? (pb) : (pa), tq_ = sw_ ? (pa) : (pb); \
    ka = tk_; kb = tl_; pa = tp_; pb = tq_;                        \
  }
template <int N>
__device__ __forceinline__ void bitonic_sort_desc_p(unsigned (&v)[N], unsigned (&pl)[N]) {
#pragma unroll
  for (int k = 2; k <= N; k <<= 1) {
#pragma unroll
    for (int j = k >> 1; j > 0; j >>= 1) {
#pragma unroll
      for (int i = 0; i < N; ++i) {
        const int l = i ^ j;
        if (l > i) {
          const bool desc = ((i & k) == 0);
          CEP(v[i], pl[i], v[l], pl[l], desc);
        }
      }
    }
  }
}
template <int N>
__device__ __forceinline__ void bitonic_merge_desc_p(unsigned (&v)[N], unsigned (&pl)[N]) {
#pragma unroll
  for (int j = N >> 1; j > 0; j >>= 1) {
#pragma unroll
    for (int i = 0; i < N; ++i) {
      const int l = i ^ j;
      if (l > i) { CEP(v[i], pl[i], v[l], pl[l], true); }
    }
  }
}
__device__ __forceinline__ void merge_top16_p(unsigned (&a)[16], unsigned (&pa)[16], const unsigned (&b)[16], const unsigned (&pb)[16]) {
#pragma unroll
  for (int i = 0; i < 16; ++i) {
    const bool s = b[15 - i] > a[i];
    a[i] = s ? b[15 - i] : a[i];
    pa[i] = s ? pb[15 - i] : pa[i];
  }
  bitonic_merge_desc_p<16>(a, pa);
}

constexpr int KROW = 144;
__device__ __forceinline__ void subkey_top16(const LAS unsigned char* Kl, const bf16_t* __restrict__ qrow, int lane, unsigned (&top)[16]) {
  const int tok = lane & 31, hf = lane >> 5;
  f32x16 acc[4];
#pragma unroll
  for (int m = 0; m < 4; ++m)
#pragma unroll
    for (int i = 0; i < 16; ++i) acc[m][i] = 0.f;
  bf16x8 bq[4];
#pragma unroll
  for (int ks = 0; ks < 4; ++ks) bq[ks] = *(const bf16x8*)(qrow + ks * 16 + 8 * hf);
#pragma unroll 1
  for (int ks = 0; ks < 4; ++ks) {
#pragma unroll
    for (int m = 0; m < 4; ++m) {
      const bf16x8 ak = *(const LAS bf16x8*)(Kl + (m * 32 + tok) * KROW + ks * 32 + hf * 16);
      acc[m] = mfma32(ak, ks == 0 ? bq[0] : ks == 1 ? bq[1] : ks == 2 ? bq[2] : bq[3], acc[m]);
    }
  }
  unsigned g[4][16];
#pragma unroll
  for (int m = 0; m < 4; ++m) {
#pragma unroll
    for (int i = 0; i < 16; ++i) g[m][i] = f2key(acc[m][i], (unsigned)(m * 32 + (i & 3) + 8 * (i >> 2) + 4 * hf));
    bitonic_sort_desc<16>(g[m]);
  }
  merge_top16(g[0], g[1]);
  merge_top16(g[2], g[3]);
  merge_top16(g[0], g[2]);
  unsigned o[16];
#pragma unroll
  for (int i = 0; i < 16; ++i) o[i] = __shfl_xor(g[0][i], 32);
  merge_top16(g[0], o);
#pragma unroll
  for (int i = 0; i < 16; ++i) top[i] = g[0][i];
}

__device__ void phase_route(const Params& p, char* smem) {
  unsigned char* ws = p.ws;
  const bf16_t* K1 = (const bf16_t*)(ws + WS_K1);
  const bf16_t* K2 = (const bf16_t*)(ws + WS_K2);
  const bf16_t* QH = (const bf16_t*)(ws + WS_QH);
  const bf16_t* HB = (const bf16_t*)(ws + WS_HB);
  unsigned char* XN8 = ws + WS_XN8;
  const float* SSQ2 = (const float*)(ws + WS_SSQ2);
  unsigned* PIDX = (unsigned*)(ws + WS_PIDX);
  float* PG = (float*)(ws + WS_PG);
  const int tidr = otid();
  const int lane = tidr & 63, wave = tidr >> 6, gw = vblock() * NWAVES + wave, nw = gridDim.x * NWAVES;
  for (int t = gw; t < T; t += nw) {
    const bf16_t* src = HB + (size_t)t * 1024 + lane * 16;
    const float r = rsqrtf(SSQ2[t] * (1.f / 1024.f) + EPS) * 16.f;
    const u32x4 h0 = *(const u32x4*)src, h1 = *(const u32x4*)(src + 8);
    u32x4 q;
#pragma unroll
    for (int i = 0; i < 4; ++i) {
      const f32x4 g4 = *(const f32x4*)(p.norm_ffn_g + lane * 16 + 4 * i);
      const unsigned lo = (i < 2) ? h0[2 * i] : h1[2 * i - 4], hi = (i < 2) ? h0[2 * i + 1] : h1[2 * i - 3];
      int w = 0;
      w = __builtin_amdgcn_cvt_pk_fp8_f32(bflo(lo) * r * g4.x, bfhi(lo) * r * g4.y, w, false);
      w = __builtin_amdgcn_cvt_pk_fp8_f32(bflo(hi) * r * g4.z, bfhi(hi) * r * g4.w, w, true);
      q[i] = (unsigned)w;
    }
    *(u32x4*)(XN8 + (size_t)t * 1024 + lane * 16) = q;
  }
  const int G = gridDim.x, nh = (G % 8 == 0) ? 8 : 1;
  LAS unsigned char* K1l = (LAS unsigned char*)smem;
  LAS unsigned char* K2l = K1l + 128 * KROW;
  for (int hd = blockIdx.x % nh; hd < 8; hd += nh) {
    for (int idx = tidr; idx < 2048; idx += NTHREADS) {
      const int tb = idx >> 10, row = (idx >> 3) & 127, ch = idx & 7;
      const u32x4 v = *(const u32x4*)((tb ? K2 : K1) + hd * 8192 + row * 64 + ch * 8);
      *(LAS u32x4*)((tb ? K2l : K1l) + row * KROW + ch * 16) = v;
    }
    __syncthreads();
    for (int tile = (blockIdx.x / nh) * NWAVES + wave; tile < T / 32; tile += (G / nh) * NWAVES) {
      const int t0 = tile * 32;
      const int tok = lane & 31, hf = lane >> 5;
      const bf16_t* qrow = QH + (size_t)(t0 + tok) * 1024 + hd * 128;
      unsigned top1[16], top2[16];
      subkey_top16(K1l, qrow, lane, top1);
      subkey_top16(K2l, qrow + 64, lane, top2);
      float fa[16], fb[16];
      unsigned ia[16], ib[16];
#pragma unroll
      for (int i = 0; i < 16; ++i) {
        const unsigned ua = key2u(hf ? top2[i] : top1[i]), ub = key2u(hf ? top1[i] : top2[i]);
        fa[i] = __uint_as_float(ua); ia[i] = ua & 0x7Fu;
        fb[i] = __uint_as_float(ub); ib[i] = ub & 0x7Fu;
      }
      unsigned ck[32];
      {
        int n = 0;
#pragma unroll
        for (int i = 0; i < 4; ++i) {
#pragma unroll
          for (int j = i; j < 16; ++j) {
            if ((i + 1) * (j + 1) <= 16) {
              unsigned key = (f2key_raw(fa[i] + fb[j]) & ~0x3FFFu) | (hf ? ((ib[j] << 7) | ia[i]) : ((ia[i] << 7) | ib[j]));
              if (i == j && hf) key = 0u;
              ck[n] = key;
              ++n;
            }
          }
        }
#pragma unroll
        for (; n < 32; ++n) ck[n] = 0u;
      }
      unsigned k0[16], k1[16];
#pragma unroll
      for (int i = 0; i < 16; ++i) { k0[i] = ck[i]; k1[i] = ck[16 + i]; }
      bitonic_sort_desc<16>(k0);
      bitonic_sort_desc<16>(k1);
      merge_top16(k0, k1);
#pragma unroll
      for (int i = 0; i < 16; ++i) k1[i] = __shfl_xor(k0[i], 32);
      merge_top16(k0, k1);
      float sv[16], sum = 0.f;
      const float mx = __uint_as_float(key2u(k0[0] & ~0x3FFFu));
#pragma unroll
      for (int i = 0; i < 16; ++i) {
        sv[i] = __builtin_amdgcn_exp2f((__uint_as_float(key2u(k0[i] & ~0x3FFFu)) - mx) * LOG2E);
        sum += sv[i];
      }
      const float inv = 1.f / sum;
      const size_t po = ((size_t)(t0 + tok) * 8 + hd) * 16;
      if (hf == 0) {
#pragma unroll
        for (int q = 0; q < 4; ++q) *(u32x4*)(PIDX + po + 4 * q) = (u32x4){k0[4 * q] & 0x3FFFu, k0[4 * q + 1] & 0x3FFFu, k0[4 * q + 2] & 0x3FFFu, k0[4 * q + 3] & 0x3FFFu};
      } else {
#pragma unroll
        for (int q = 0; q < 4; ++q) *(f32x4*)(PG + po + 4 * q) = (f32x4){sv[4 * q] * inv, sv[4 * q + 1] * inv, sv[4 * q + 2] * inv, sv[4 * q + 3] * inv};
      }
    }
    __syncthreads();
  }
}

typedef int i32x8 __attribute__((ext_vector_type(8)));
__device__ __forceinline__ f32x4 mfma_fp4_fp8(u32x4 a, u32x4 b0, u32x4 b1, f32x4 c) {
  const i32x8 A = {(int)a.x, (int)a.y, (int)a.z, (int)a.w, 0, 0, 0, 0};
  const i32x8 B = {(int)b0.x, (int)b0.y, (int)b0.z, (int)b0.w, (int)b1.x, (int)b1.y, (int)b1.z, (int)b1.w};
  return __builtin_amdgcn_mfma_scale_f32_16x16x128_f8f6f4(A, B, c, 4, 0, 0, 0x7F7F7F7F, 0, 0x7F7F7F7F);
}
struct PeCtx {
  const unsigned char* U8; const float* US; const float* VS; const float* PG; float* PW; float* dummy;
  LAS unsigned* list; int lane, r, g, s, n, t0;
};
__device__ __forceinline__ void pe_rows(const PeCtx& c, int ci, u32x4 (&a)[8]) {
  const int idx = ci * 16 + (c.lane >> 2);
  const unsigned ent = c.list[idx & 2047];
  const unsigned e = (idx < c.n) ? ((ent >> 7) & 16383u) : (unsigned)(c.s << 11);
  const unsigned char* rp = c.U8 + (size_t)e * 512 + (c.lane & 3) * 16;
#pragma unroll
  for (int ks = 0; ks < 8; ++ks) a[ks] = *(const u32x4*)(rp + ks * 64);
}
__device__ __forceinline__ void pe_fix(const PeCtx& c, u32x4 (&a)[8]) {
  const int src = 4 * c.r + c.g;
#pragma unroll
  for (int ks = 0; ks < 8; ++ks) {
    a[ks].x = (unsigned)__shfl((int)a[ks].x, src); a[ks].y = (unsigned)__shfl((int)a[ks].y, src);
    a[ks].z = (unsigned)__shfl((int)a[ks].z, src); a[ks].w = (unsigned)__shfl((int)a[ks].w, src);
  }
}
__device__ __forceinline__ void pe_chunk(const PeCtx& c, int ci, u32x4 (&a)[8], u32x4 (&anext)[8], const u32x4 (&bq)[16]) {
  const int idx = ci * 16 + c.r;
  const unsigned ent = c.list[idx & 2047];
  const bool fin = (c.lane < 16) && (idx < c.n);
  const unsigned e = (ent >> 7) & 16383u, slot = ent & 127u, col = (ent >> 21) & 15u;
  const float gt = c.PG[fin ? (size_t)(c.t0 + col) * 128 + slot : (size_t)0], us = c.US[fin ? e : 0u], vs = c.VS[fin ? e : 0u];
  __builtin_amdgcn_sched_barrier(0);
  pe_rows(c, ci + 1, anext);
  __builtin_amdgcn_sched_barrier(0);
  pe_fix(c, a);
  f32x4 acc = {0.f, 0.f, 0.f, 0.f};
#pragma unroll
  for (int ks = 0; ks < 8; ++ks) acc = mfma_fp4_fp8(a[ks], bq[2 * ks], bq[2 * ks + 1], acc);
  const int src = ((c.r >> 2) << 4) | (int)col;
  const float v0 = __shfl(acc[0], src), v1 = __shfl(acc[1], src), v2 = __shfl(acc[2], src), v3 = __shfl(acc[3], src);
  float d = ((c.r & 3) == 0) ? v0 : ((c.r & 3) == 1) ? v1 : ((c.r & 3) == 2) ? v2 : v3;
  float gt_ = gt, us_ = us, vs_ = vs;
  asm volatile("" : "+v"(d), "+v"(gt_), "+v"(us_), "+v"(vs_));
  {
    const float act = d * us_ * (1.f / 16.f);
    float* dst = fin ? c.PW + (size_t)(c.t0 + col) * 128 + slot : c.dummy;
    *dst = gt_ * 0.5f * act * (1.f + erff(act * 0.70710678118654752f)) * vs_;
  }
}
__device__ void phase_peer_u(const Params& p, char* smem) {
  unsigned char* ws = p.ws;
  PeCtx c;
  c.U8 = ws + WS_U8; c.US = (const float*)(ws + WS_US); c.VS = (const float*)(ws + WS_VS);
  c.PG = (const float*)(ws + WS_PG); c.PW = (float*)(ws + WS_PW);
  c.dummy = (float*)(ws + WS_PW + 16 * MiB) + (size_t)blockIdx.x * NTHREADS + otid();
  const unsigned char* XN8 = ws + WS_XN8;
  const unsigned* PIDX = (const unsigned*)(ws + WS_PIDX);
  const int tidu = otid();
  const int lane = tidu & 63, wave = tidu >> 6;
  c.lane = lane; c.r = lane & 15; c.g = lane >> 4;
  c.list = (LAS unsigned*)(smem + wave * 8192);
  const int G = gridDim.x, ng = (G % 8 == 0) ? 8 : 1;
  const int x = blockIdx.x % ng, lw = (blockIdx.x / ng) * NWAVES + wave, nlw = (G / ng) * NWAVES;
  for (int s = x; s < 8; s += ng) {
    c.s = s;
    for (int grp = lw; grp < T / 16; grp += nlw) {
      const int t0 = grp * 16;
      c.t0 = t0;
      u32x4 bq[16];
      {
        const unsigned char* xp = XN8 + (size_t)(t0 + c.r) * 1024 + c.g * 16;
#pragma unroll
        for (int ks = 0; ks < 8; ++ks) { bq[2 * ks] = *(const u32x4*)(xp + ks * 128); bq[2 * ks + 1] = *(const u32x4*)(xp + ks * 128 + 64); }
      }
      int n = 0;
#pragma unroll
      for (int q = 0; q < 8; ++q) {
        const u32x4 idv = *(const u32x4*)(PIDX + (size_t)t0 * 128 + q * 256 + lane * 4);
#pragma unroll
        for (int k = 0; k < 4; ++k) {
          const unsigned e = idv[k];
          const bool m = (int)(e >> 11) == s;
          const unsigned long long mk = __ballot(m);
          if (m) c.list[n + __builtin_amdgcn_mbcnt_hi((unsigned)(mk >> 32), __builtin_amdgcn_mbcnt_lo((unsigned)mk, 0))] =
                     ((unsigned)(2 * q + (lane >> 5)) << 21) | (e << 7) | (unsigned)((lane & 31) * 4 + k);
          n += __popcll(mk);
        }
      }
      asm volatile("s_waitcnt lgkmcnt(0)" ::: "memory");
      c.n = n;
      const int nch = (n + 15) >> 4;
      u32x4 a0[8], a1[8];
      pe_rows(c, 0, a0);
      {
        unsigned z = 0u;
#pragma unroll
        for (int ks = 0; ks < 8; ++ks) z |= a0[ks].w;
        asm volatile("" ::"v"(z));
      }
      if (nch > 0) {
        for (int ci = 0;; ci += 2) {
          pe_chunk(c, ci, a0, a1, bq);
          if (ci + 1 >= nch) break;
          pe_chunk(c, ci + 1, a1, a0, bq);
          if (ci + 2 >= nch) break;
        }
      }
      asm volatile("" ::: "memory");
    }
  }
}

struct PfIdx { u32x4 e0, e1; f32x4 w0, w1; };
struct PfCtx { const unsigned char* base; const unsigned* PIDX; const float* PW; const bf16_t* HB; float* out; int pg, s, c, lane, tend; };
__device__ __forceinline__ void pf_load_idx(const PfCtx& c, int t, int h, PfIdx& I) {
  const size_t o = (size_t)(t < c.tend ? t : c.tend - 1) * 128 + h * 64 + c.pg * 8;
  I.e0 = *(const u32x4*)(c.PIDX + o); I.e1 = *(const u32x4*)(c.PIDX + o + 4);
  I.w0 = *(const f32x4*)(c.PW + o);   I.w1 = *(const f32x4*)(c.PW + o + 4);
}
__device__ __forceinline__ void pf_load_rows(const PfCtx& c, const PfIdx& I, u32x4 (&rv)[8]) {
#pragma unroll
  for (int i = 0; i < 4; ++i) { rv[i] = *(const u32x4*)(c.base + (size_t)I.e0[i] * 128); rv[4 + i] = *(const u32x4*)(c.base + (size_t)I.e1[i] * 128); }
}
__device__ __forceinline__ void pf_accum(const u32x4 (&rv)[8], f32x4 w0, f32x4 w1, f32x2 (&acc)[16]) {
#pragma unroll
  for (int i = 0; i < 8; ++i) {
    const float ws = (i < 4) ? w0[i & 3] : w1[i & 3];
    const f32x2 w = {ws, ws};
#define FP4_ACC(q, bsel) acc[4 * (q) + (bsel)] = __builtin_elementwise_fma(__builtin_amdgcn_cvt_scalef32_pk_f32_fp4(rv[i][q], 1.0f, bsel), w, acc[4 * (q) + (bsel)]);
#pragma unroll
    for (int q = 0; q < 4; ++q) { FP4_ACC(q, 0) FP4_ACC(q, 1) FP4_ACC(q, 2) FP4_ACC(q, 3) }
#undef FP4_ACC
  }
}
__device__ __forceinline__ size_t pf_out_off(const PfCtx& c, int t) {
  const int lane = c.lane;
  return (size_t)(t < c.tend ? t : c.tend - 1) * 1024 + c.s * 256 + c.c * 32 + ((lane & 32) ? 16 : 0) + ((lane & 16) ? 8 : 0) + ((lane & 8) ? 4 : 0);
}
__device__ __forceinline__ void pf_finish(const PfCtx& c, int t, size_t oo, u32x2 hb, const f32x2 (&acc)[16]) {
  const int lane = c.lane;
  const bool b5 = lane & 32, b4 = lane & 16, b3 = lane & 8;
  f32x2 r8[8], r4[4], r2[2];
#pragma unroll
  for (int i = 0; i < 8; ++i) {
    const f32x2 keep = b5 ? acc[8 + i] : acc[i], send = b5 ? acc[i] : acc[8 + i];
    r8[i] = keep + (f32x2){__shfl_xor(send.x, 32), __shfl_xor(send.y, 32)};
  }
#pragma unroll
  for (int i = 0; i < 4; ++i) {
    const f32x2 keep = b4 ? r8[4 + i] : r8[i], send = b4 ? r8[i] : r8[4 + i];
    r4[i] = keep + (f32x2){__shfl_xor(send.x, 16), __shfl_xor(send.y, 16)};
  }
#pragma unroll
  for (int i = 0; i < 2; ++i) {
    const f32x2 keep = b3 ? r4[2 + i] : r4[i], send = b3 ? r4[i] : r4[2 + i];
    r2[i] = keep + (f32x2){__shfl_xor(send.x, 8), __shfl_xor(send.y, 8)};
  }
  if (t < c.tend) *(f32x4*)(c.out + oo) = (f32x4){bflo(hb.x) + r2[0].x, bfhi(hb.x) + r2[0].y, bflo(hb.y) + r2[1].x, bfhi(hb.y) + r2[1].y};
}
#define PF_STEP(tk, h, Iload, Iuse, Rnext, Rcur)                                          \
  {                                                                                       \
    pf_load_idx(c, (tk) + nlw, (h), Iload);                                 \
    __builtin_amdgcn_sched_barrier(0);                                                    \
    pf_load_rows(c, Iuse, Rnext);                                           \
    const f32x4 wn0 = Iuse.w0, wn1 = Iuse.w1;                                             \
    __builtin_amdgcn_sched_barrier(0);                                                    \
    pf_accum(Rcur, wc0, wc1, acc);                                                        \
    wc0 = wn0; wc1 = wn1;                                                                 \
  }
__device__ void phase_peer_v(const Params& p) {
  unsigned char* ws = p.ws;
  PfCtx c;
  c.PIDX = (const unsigned*)(ws + WS_PIDX); c.PW = (const float*)(ws + WS_PW); c.HB = (const bf16_t*)(ws + WS_HB); c.out = p.out;
  const int tidv = otid();
  const int lane = tidv & 63, wave = tidv >> 6;
  c.lane = lane; c.pg = lane >> 3; c.c = lane & 7;
  const int G = gridDim.x, ng = (G % 8 == 0) ? 8 : 1;
  const int x = blockIdx.x % ng, lw = (blockIdx.x / ng) * NWAVES + wave, nlw = (G / ng) * NWAVES;
  for (int job = x; job < 8; job += ng) {
    const int s = job & 3, tbeg = (job >> 2) * (T / 2);
    c.s = s; c.tend = tbeg + T / 2;
    c.base = ws + WS_V8 + (size_t)s * 16384 * 128 + c.c * 16;
    PfIdx IA, IB;
    u32x4 RA[8], RB[8];
    const int t0 = tbeg + lw;
    pf_load_idx(c, t0, 0, IA);
    pf_load_idx(c, t0, 1, IB);
    pf_load_rows(c, IA, RA);
    f32x4 wc0 = IA.w0, wc1 = IA.w1;
    {
      unsigned z = IB.e0.x | IB.e1.w | __float_as_uint(IB.w1.w);
#pragma unroll
      for (int i = 0; i < 8; ++i) z |= RA[i].w;
      asm volatile("" ::"v"(z));
    }
    for (int t = t0; t < c.tend; t += nlw) {
      const size_t oo = pf_out_off(c, t);
      const u32x2 hb = *(const u32x2*)(c.HB + oo);
      f32x2 acc[16];
#pragma unroll
      for (int k = 0; k < 16; ++k) acc[k] = (f32x2){0.f, 0.f};
      PF_STEP(t, 0, IA, IB, RB, RA)
      PF_STEP(t, 1, IB, IA, RA, RB)
      pf_finish(c, t, oo, hb, acc);
    }
  }
}
#undef PF_STEP

#define XB_TMO      128
#define XB_XCNT(j)  (256  + 64 * (j))
#define XB_XSUB(j)  (1280 + 64 * (j))
#define XB_XGEN(j)  (2304 + 64 * (j))
#define XB_TOP      3328
#define XB_TOPGEN   3392
#define XCD_BAR_WORDS 3456
#define XB_SPIN_CAP (1u << 22)
__device__ __forceinline__ unsigned xb_ld(unsigned* p)              { return __hip_atomic_load(p, __ATOMIC_RELAXED, __HIP_MEMORY_SCOPE_AGENT); }
__device__ __forceinline__ unsigned xb_add(unsigned* p, unsigned v) { return __hip_atomic_fetch_add(p, v, __ATOMIC_RELAXED, __HIP_MEMORY_SCOPE_AGENT); }
__device__ __forceinline__ unsigned xb_xcc_id() { return (unsigned)__builtin_amdgcn_s_getreg((3 << 11) | 20) & 0xFu; }
#define XB_SPIN(cond, bar) do { unsigned _sp = 0; while (cond) { __builtin_amdgcn_s_sleep(1); \
    if ((++_sp & 255u) == 0u) { if (xb_ld(&(bar)[XB_TMO])) break; if (_sp > XB_SPIN_CAP) { atomicAdd(&(bar)[XB_TMO], 1u); break; } } } } while (0)
struct XcdBarrier { unsigned* bar; unsigned x; volatile LAS unsigned* st; };
__device__ __forceinline__ XcdBarrier xcd_barrier_post(unsigned* bar, volatile LAS unsigned* st) {
    XcdBarrier b; b.bar = bar; b.x = xb_xcc_id(); b.st = st;
    if (threadIdx.x == 0) (void)xb_add(&bar[XB_XCNT(b.x)], 1u);
    return b;
}
__device__ __forceinline__ void xcd_barrier_complete(unsigned* bar, unsigned x, unsigned& nloc, unsigned& nx) {
    const unsigned G = gridDim.x * gridDim.y * gridDim.z;
    unsigned sum, cnt, mine, sp = 0u;
    for (;;) {
        sum = 0u; cnt = 0u; mine = 0u;
#pragma unroll
        for (unsigned j = 0; j < 16; ++j) { const unsigned c = xb_ld(&bar[XB_XCNT(j)]); sum += c; cnt += (c > 0u) ? 1u : 0u; mine = (j == x) ? c : mine; }
        if (sum == G) break;
        __builtin_amdgcn_s_sleep(1);
        if ((++sp & 255u) == 0u) { if (xb_ld(&bar[XB_TMO])) break; if (sp > XB_SPIN_CAP) { atomicAdd(&bar[XB_TMO], 1u); break; } }
    }
    nloc = mine > 0u ? mine : 1u; nx = cnt > 0u ? cnt : 1u;
}
__device__ __forceinline__ void xcd_barrier(const XcdBarrier& b) {
    asm volatile("s_waitcnt vmcnt(0)" ::: "memory");
    __syncthreads();
    if (threadIdx.x == 0) {
        unsigned* bar = b.bar;
        __builtin_amdgcn_s_waitcnt(0);
        unsigned nloc = b.st[0], nx = b.st[1];
        if (nloc == 0u) { xcd_barrier_complete(bar, b.x, nloc, nx); b.st[0] = nloc; b.st[1] = nx; }
        const unsigned old = xb_add(&bar[XB_XSUB(b.x)], 1u);
        const unsigned gen = old / nloc;
        if (old + 1u == (gen + 1u) * nloc) {
            __builtin_amdgcn_fence(__ATOMIC_RELEASE, "agent");
            asm volatile("s_waitcnt vmcnt(0)" ::: "memory");
            const unsigned og = xb_add(&bar[XB_TOP], 1u);
            const unsigned tg = og / nx;
            if (og + 1u == (tg + 1u) * nx) xb_add(&bar[XB_TOPGEN], 1u);
            else XB_SPIN(xb_ld(&bar[XB_TOPGEN]) == tg, bar);
            __builtin_amdgcn_fence(__ATOMIC_ACQUIRE, "agent");
            xb_add(&bar[XB_XGEN(b.x)], 1u);
            asm volatile("s_waitcnt vmcnt(0)" ::: "memory");
        } else {
            XB_SPIN(xb_ld(&bar[XB_XGEN(b.x)]) == gen, bar);
            __builtin_amdgcn_fence(__ATOMIC_ACQUIRE, "agent");
            asm volatile("s_waitcnt vmcnt(0)" ::: "memory");
        }
    }
    __syncthreads();
}

__global__ void __launch_bounds__(NTHREADS, 2) k_fused(Params p) {
  __shared__ __attribute__((aligned(16))) char smem[LDS_BYTES];
  if (threadIdx.x == 0) *(u32x4*)(smem + LDS_BAR) = (u32x4){0u, 0u, 0u, 0u};
  __syncthreads();
  const XcdBarrier bar = xcd_barrier_post((unsigned*)(p.ws + WS_CTL), (volatile LAS unsigned*)(smem + LDS_BAR));
#ifdef PROBE_PHASE
  unsigned long long ts[12];
#define STAMP(k) ts[k] = __builtin_amdgcn_s_memrealtime();
#else
#define STAMP(k)
#endif
  STAMP(0)
  phase_prep(p);
  xcd_barrier(bar);
  STAMP(1)
  phase_inproj(p, smem);
  xcd_barrier(bar);
  STAMP(2)
  phase_mix(p, smem);
  xcd_barrier(bar);
  STAMP(3)
  phase_outproj(p, smem);
  xcd_barrier(bar);
  STAMP(4)
  phase_qproj(p, smem);
  xcd_barrier(bar);
  STAMP(5)
  phase_route(p, smem);
  xcd_barrier(bar);
  STAMP(6)
  phase_peer_u(p, smem);
  xcd_barrier(bar);
  STAMP(7)
  phase_peer_v(p);
#ifdef PROBE_PHASE
  xcd_barrier(bar);
  STAMP(8)
  if (blockIdx.x == 0 && threadIdx.x == 0) {
    const float us = (float)(ts[PROBE_PHASE + 1] - ts[PROBE_PHASE]) * 0.01f;
    p.out[12345] += us * (1.f / PROBE_DIV);
  }
#endif
}

extern "C" void kernel_launch(void* const* d_in, const int* in_sizes, int n_in, void* d_out, int out_size, void* d_ws, size_t ws_size,
                              hipStream_t stream) {
  if (n_in != 17 || ws_size < WS_END) {
    fprintf(stderr, "kernel_launch: unexpected n_in %d / ws_size %zu\n", n_in, ws_size);
    return;
  }
  Params p{};
  p.x = (const float*)d_in[0]; p.norm_mix_g = (const float*)d_in[1]; p.w_in = (const float*)d_in[2]; p.q_norm_g = (const float*)d_in[3];
  p.k_norm_g = (const float*)d_in[4]; p.attn_out_g = (const float*)d_in[5]; p.conv_w = (const float*)d_in[6]; p.conv_b = (const float*)d_in[7];
  p.conv_ln_g = (const float*)d_in[8]; p.conv_ln_b = (const float*)d_in[9]; p.w_out = (const float*)d_in[10]; p.norm_ffn_g = (const float*)d_in[11];
  p.peer_wq = (const float*)d_in[12]; p.peer_k1 = (const float*)d_in[13]; p.peer_k2 = (const float*)d_in[14]; p.peer_u = (const float*)d_in[15];
  p.peer_v = (const float*)d_in[16];
  p.out = (float*)d_out;
  p.ws = (unsigned char*)d_ws;
  static int grid_blocks = 0;
  if (!grid_blocks) {
    int dev = 0, cus = 0, per_cu = 0;
    (void)hipGetDevice(&dev);
    (void)hipDeviceGetAttribute(&cus, hipDeviceAttributeMultiprocessorCount, dev);
    (void)hipOccupancyMaxActiveBlocksPerMultiprocessor(&per_cu, k_fused, NTHREADS, 0);
    if (per_cu > 1) per_cu = 1;
    if (per_cu < 1) per_cu = 1;
    grid_blocks = cus * per_cu;
  }
  (void)hipMemsetAsync((char*)d_ws + WS_CTL, 0, XCD_BAR_WORDS * 4, stream);
  hipLaunchKernelGGL(k_fused, dim3(grid_blocks), dim3(NTHREADS), 0, stream, p);
}
```

```cpp
#include <hip/hip_runtime.h>
#include <cstdio>

#define LAS __attribute__((address_space(3)))
typedef unsigned short bf16_t;
typedef __bf16 bf16x8 __attribute__((ext_vector_type(8)));
typedef __bf16 bf16x2 __attribute__((ext_vector_type(2)));
typedef float f32x4 __attribute__((ext_vector_type(4)));
typedef float f32x16 __attribute__((ext_vector_type(16)));
typedef unsigned u32x4 __attribute__((ext_vector_type(4)));
typedef unsigned u32x2 __attribute__((ext_vector_type(2)));
typedef float f32x2 __attribute__((ext_vector_type(2)));

constexpr int SEQ = 4096, T = 8 * SEQ, D = 1024, NIN = 2560;
constexpr float EPS = 1e-6f;
constexpr float LOG2E = 1.4426950408889634f;

constexpr size_t MiB = 1u << 20;
constexpr size_t WS_W1 = 0, WS_WV = 4 * MiB, WS_WOUT = 5 * MiB, WS_WQ = 7 * MiB, WS_K1 = 9 * MiB, WS_K2 = 9 * MiB + 131072, WS_SSQ = 10 * MiB;
constexpr size_t WS_CTL = 11 * MiB;
constexpr size_t WS_USV = 11 * MiB + 65536;
constexpr size_t WS_RS1 = 11 * MiB + 196608, WS_SSQ2 = 11 * MiB + 327680;
constexpr size_t WS_U8 = 12 * MiB, WS_V8 = 28 * MiB;
constexpr size_t WS_XB = 44 * MiB;
constexpr size_t WS_Q = 108 * MiB, WS_K = 140 * MiB, WS_VT = 172 * MiB, WS_HG = 204 * MiB, WS_MIX = 236 * MiB;
constexpr size_t WS_HB = 300 * MiB, WS_QH = 364 * MiB;
constexpr size_t WS_XN8 = 108 * MiB, WS_PIDX = 140 * MiB, WS_PG = 156 * MiB, WS_PW = 172 * MiB;
constexpr size_t WS_END = 428 * MiB;

struct Params {
  const float *x, *norm_mix_g, *w_in, *q_norm_g, *k_norm_g, *attn_out_g, *conv_w, *conv_b, *conv_ln_g, *conv_ln_b,
      *w_out, *norm_ffn_g, *peer_wq, *peer_k1, *peer_k2, *peer_u, *peer_v;
  float* out;
  unsigned char* ws;
};

constexpr int NTHREADS = 512, NWAVES = 8;
constexpr int LDS_STAGE = 131072, LDS_BAR = LDS_STAGE, LDS_BYTES = LDS_STAGE + 16;

__device__ __forceinline__ unsigned pk2(float lo, float hi) {
  bf16x2 v = {(__bf16)lo, (__bf16)hi};
  return __builtin_bit_cast(unsigned, v);
}
__device__ __forceinline__ float bflo(unsigned u) { return __uint_as_float(u << 16); }
__device__ __forceinline__ float bfhi(unsigned u) { return __uint_as_float(u & 0xffff0000u); }
__device__ __forceinline__ int otid() { int t = threadIdx.x; asm volatile("" : "+v"(t)); return t; }
__device__ __forceinline__ int vblock() {
  const int G = gridDim.x, b = blockIdx.x;
  return (G % 8 == 0) ? (b % 8) * (G / 8) + b / 8 : b;
}
__device__ __forceinline__ f32x16 mfma32(bf16x8 a, bf16x8 b, f32x16 c) { return __builtin_amdgcn_mfma_f32_32x32x16_bf16(a, b, c, 0, 0, 0); }

__device__ __forceinline__ int w1_src(int n) {
  if (n < 1024) {
    const int kind = n >> 9, rel = n & 511, pn = rel >> 8, P = rel & 255, bj = P >> 7, wc = (P >> 5) & 3, x = P & 31;
    return kind * 512 + (4 * pn + wc) * 64 + 32 * bj + x;
  }
  const int rel = n - 1024, pn = rel >> 8, P = rel & 255, bj = P >> 7, wc = (P >> 5) & 3, x = P & 31;
  return (bj ? 2048 : 1536) + 128 * pn + 32 * wc + x;
}
__device__ __forceinline__ void transpose_items(const float* __restrict__ W, int ldw, int N, bf16_t* __restrict__ Wt, const float* __restrict__ g, int glimit,
                                                int mode, long gtid, long nthr) {
  const long nitems = (long)N * 128;
  for (long it = gtid; it < nitems; it += nthr) {
    const int n = (int)(it % N), kc = (int)(it / N);
    const int src = mode == 1 ? w1_src(n) : (mode == 2 ? 1024 + n : n);
    float v[8];
#pragma unroll
    for (int i = 0; i < 8; ++i) {
      const int k = kc * 8 + i;
      float w = W[(size_t)k * ldw + src];
      if (k < glimit) w *= g[k];
      v[i] = w;
    }
    u32x4 o = {pk2(v[0], v[1]), pk2(v[2], v[3]), pk2(v[4], v[5]), pk2(v[6], v[7])};
    *(u32x4*)(Wt + (size_t)n * 1024 + kc * 8) = o;
  }
}
__device__ __forceinline__ void convert_items(const float* __restrict__ src, bf16_t* __restrict__ dst, long n8, long gtid, long nthr) {
  for (long it = gtid; it < n8; it += nthr) {
    const f32x4 a = *(const f32x4*)(src + it * 8), b = *(const f32x4*)(src + it * 8 + 4);
    u32x4 o = {pk2(a.x, a.y), pk2(a.z, a.w), pk2(b.x, b.y), pk2(b.z, b.w)};
    *(u32x4*)(dst + it * 8) = o;
  }
}
__device__ void phase_prep(const Params& p) {
  const int tid0 = otid();
  const long gtid = (long)vblock() * NTHREADS + tid0, nthr = (long)gridDim.x * NTHREADS;
  unsigned char* ws = p.ws;
  transpose_items(p.w_in, NIN, 2048, (bf16_t*)(ws + WS_W1), p.norm_mix_g, 1024, 1, gtid, nthr);
  transpose_items(p.w_in, NIN, 512, (bf16_t*)(ws + WS_WV), p.norm_mix_g, 1024, 2, gtid, nthr);
  transpose_items(p.w_out, D, D, (bf16_t*)(ws + WS_WOUT), p.attn_out_g, 512, 0, gtid, nthr);
  transpose_items(p.peer_wq, D, D, (bf16_t*)(ws + WS_WQ), p.norm_ffn_g, 1024, 0, gtid, nthr);
  convert_items(p.peer_k1, (bf16_t*)(ws + WS_K1), 65536 / 8, gtid, nthr);
  convert_items(p.peer_k2, (bf16_t*)(ws + WS_K2), 65536 / 8, gtid, nthr);
  const int lane = tid0 & 63, gw = vblock() * NWAVES + (tid0 >> 6), nw = gridDim.x * NWAVES;
  {
    bf16_t* XB = (bf16_t*)(ws + WS_XB);
    float* RS1 = (float*)(ws + WS_RS1);
    float* SSQ2 = (float*)(ws + WS_SSQ2);
    for (int tb = gw; tb < T; tb += 2 * nw) {
      f32x4 v[2][4];
      float ss[2] = {0.f, 0.f};
#pragma unroll
      for (int u = 0; u < 2; ++u) {
        const int t = (tb + u * nw < T) ? tb + u * nw : tb;
        const float* src = p.x + (size_t)t * 1024 + lane * 4;
#pragma unroll
        for (int i = 0; i < 4; ++i) v[u][i] = *(const f32x4*)(src + 256 * i);
      }
#pragma unroll
      for (int u = 0; u < 2; ++u) {
#pragma unroll
        for (int i = 0; i < 4; ++i) ss[u] += v[u][i].x * v[u][i].x + v[u][i].y * v[u][i].y + v[u][i].z * v[u][i].z + v[u][i].w * v[u][i].w;
      }
#pragma unroll
      for (int o = 1; o < 64; o <<= 1) { ss[0] += __shfl_xor(ss[0], o); ss[1] += __shfl_xor(ss[1], o); }
#pragma unroll
      for (int u = 0; u < 2; ++u) {
        const int t = tb + u * nw;
        if (t < T) {
#pragma unroll
          for (int i = 0; i < 4; ++i) *(u32x2*)(XB + (size_t)t * 1024 + lane * 4 + 256 * i) = (u32x2){pk2(v[u][i].x, v[u][i].y), pk2(v[u][i].z, v[u][i].w)};
          if (lane == 0) { RS1[t] = rsqrtf(ss[u] * (1.f / 1024.f) + EPS); SSQ2[t] = 0.f; }
        }
      }
    }
  }
  {
    for (int rb = gw; rb < 32768; rb += 2 * nw) {
      f32x4 v[2][4];
#pragma unroll
      for (int u = 0; u < 2; ++u) {
        const int r = (rb + u * nw < 32768) ? rb + u * nw : rb;
        const float* src = ((r >> 14) ? p.peer_v : p.peer_u) + (size_t)(r & 16383) * 1024 + lane * 16;
#pragma unroll
        for (int i = 0; i < 4; ++i) v[u][i] = *(const f32x4*)(src + 4 * i);
      }
      float am[2] = {0.f, 0.f};
#pragma unroll
      for (int u = 0; u < 2; ++u)
#pragma unroll
        for (int i = 0; i < 4; ++i)
          am[u] = fmaxf(am[u], fmaxf(fmaxf(fabsf(v[u][i].x), fabsf(v[u][i].y)), fmaxf(fabsf(v[u][i].z), fabsf(v[u][i].w))));
#pragma unroll
      for (int o = 1; o < 64; o <<= 1) { am[0] = fmaxf(am[0], __shfl_xor(am[0], o)); am[1] = fmaxf(am[1], __shfl_xor(am[1], o)); }
#pragma unroll
      for (int u = 0; u < 2; ++u) {
        const int r = rb + u * nw;
        if (r < 32768) {
          const int isv = r >> 14, e = r & 16383;
          const float scale = am[u] > 0.f ? am[u] * (1.f / 6.f) : 1.f, inv = am[u] > 0.f ? 6.f / am[u] : 0.f;
          unsigned q[2] = {0u, 0u};
#pragma unroll
          for (int i = 0; i < 4; ++i)
#pragma unroll
            for (int j = 0; j < 4; ++j) {
              const float xv = v[u][i][j], m = fabsf(xv) * inv;
              const unsigned code = (unsigned)(m > 0.25f) + (unsigned)(m > 0.75f) + (unsigned)(m > 1.25f) + (unsigned)(m > 1.75f) +
                                    (unsigned)(m > 2.5f) + (unsigned)(m > 3.5f) + (unsigned)(m > 5.0f);
              const unsigned nib = code | (xv < 0.f ? 8u : 0u);
              const int el = 4 * i + j;
              q[el >> 3] |= nib << (4 * (el & 7));
            }
          if (isv) {
            *(u32x2*)(ws + WS_V8 + (size_t)e * 512 + lane * 8) = (u32x2){q[0], q[1]};
            if (lane == 0) ((float*)(ws + WS_USV))[2 * e + 1] = scale;
          } else {
            *(u32x2*)(ws + WS_U8 + (size_t)e * 512 + lane * 8) = (u32x2){q[0], q[1]};
            if (lane == 0) ((float*)(ws + WS_USV))[2 * e] = scale;
          }
        }
      }
    }
  }
}

namespace pg8 {
typedef short sbf16x8 __attribute__((ext_vector_type(8)));
constexpr int BM = 256, BK = 64, HALF = 128, HTB = HALF * BK * 2  , NXCD = 8, WGM = 8;
__device__ __forceinline__ int lds_byte(int r, int c) { const int st = (r >> 4) * 2 + (c >> 5), rr = r & 15, cc = c & 31, ob = rr * 64 + cc * 2; return st * 1024 + (ob ^ (((ob >> 9) & 1) << 5)); }
__device__ __forceinline__ void stage_rc(int b, int& R, int& C) { const int st = b / 1024, sb = b % 1024, swz = sb ^ (((sb >> 9) & 1) << 5); R = (st >> 1) * 16 + swz / 64; C = (st & 1) * 32 + (swz % 64) / 2; }
__device__ __forceinline__ int perm32(int rho) { const int n = rho >> 4, i = rho & 15; return 8 * (i >> 2) + 4 * n + (i & 3); }
struct Unit { int pm, pn; };
struct Gemm { const bf16_t* A; const bf16_t* Bt; int M, N, K; };
struct StaticOrder {
    int nM, nN, nwg, G, c;
    __device__ void init(int M, int N, int G_, int c_) { nM = M / BM; nN = N / BM; nwg = nM * nN; G = G_; c = c_; }
    __device__ bool next(int i, Unit& u) const {
        const long L = (long)i * G + c; if (L >= nwg) return false;
        int wgid = (int)L; { const int q = nwg / NXCD, r = nwg % NXCD, xcd = wgid % NXCD, off = wgid / NXCD; wgid = (xcd < r ? xcd * (q + 1) : r * (q + 1) + (xcd - r) * q) + off; }
        const int nig = WGM * nN, gid = wgid / nig, fm = gid * WGM, gsz = (nM - fm) < WGM ? (nM - fm) : WGM;
        u.pm = fm + ((wgid % nig) % gsz); u.pn = (wgid % nig) / gsz; return true;
    }
};
template <class Epi>
__device__ __forceinline__ void gemm_phase(LAS unsigned char* lds, const Gemm g, const StaticOrder& S, const Epi& E) {
    const int tid = otid(), wid = __builtin_amdgcn_readfirstlane(tid >> 6), lane = tid & 63, wr = wid >> 2, wc = wid & 3, fr = lane & 15, fq = lane >> 4;
    const int K = g.K, nt = K / BK;
    unsigned voffA[2], voffB[2];
#pragma unroll
    for (int i = 0; i < 2; ++i) { int R, C; stage_rc(tid * 16 + i * 8192, R, C); const int Rb = Epi::PERM ? ((R & ~31) + perm32(R & 31)) : R;
        voffA[i] = (unsigned)(R * K + C) * 2u; voffB[i] = (unsigned)(Rb * K + C) * 2u; }
    const size_t kstep = (size_t)(BK * 2);
    const size_t hstep = (size_t)HALF * K * 2;
    const size_t tstep = 2 * hstep;
    const unsigned ldsw = (unsigned)wid * 1024u;
    const int aoff = lds_byte(wr * 64 + fr, fq * 8), boff = lds_byte(wc * 32 + fr, fq * 8);
#define PG8_SA(b, h) (((b) * 2 + (h)) * HTB)
#define PG8_SB(b, h) ((4 + (b) * 2 + (h)) * HTB)
#define PG8_STAGE(bufoff, gbase, voff) do { _Pragma("unroll") for (int _i = 0; _i < 2; ++_i) \
        __builtin_amdgcn_global_load_lds((const unsigned*)((const char*)(gbase) + (voff)[_i]), (LAS unsigned*)(lds + (bufoff) + ldsw + _i * 8192), 16, 0, 0); } while (0)
#define PG8_LDA(dst, b, h) do { _Pragma("unroll") for (int m = 0; m < 4; ++m) _Pragma("unroll") for (int k = 0; k < 2; ++k) dst[m][k] = *(const LAS sbf16x8*)(lds + PG8_SA(b, h) + aoff + m * 2048 + k * 1024); } while (0)
#define PG8_LDB(dst, b, h) do { _Pragma("unroll") for (int n = 0; n < 2; ++n) _Pragma("unroll") for (int k = 0; k < 2; ++k) dst[n][k] = *(const LAS sbf16x8*)(lds + PG8_SB(b, h) + boff + n * 2048 + k * 1024); } while (0)
#define PG8_MMA(ai, bj, At, Bt) do { __builtin_amdgcn_s_setprio(1); _Pragma("unroll") for (int m = 0; m < 4; ++m) _Pragma("unroll") for (int n = 0; n < 2; ++n) _Pragma("unroll") for (int k = 0; k < 2; ++k) \
        acc[ai][bj][m][n] = __builtin_amdgcn_mfma_f32_16x16x32_bf16(__builtin_bit_cast(bf16x8, Bt[n][k]), __builtin_bit_cast(bf16x8, At[m][k]), acc[ai][bj][m][n], 0, 0, 0); __builtin_amdgcn_s_setprio(0); } while (0)
#define PG8_WAIT_V(n) asm volatile("s_waitcnt vmcnt(" #n ")" ::: "memory")
#define PG8_WAIT_L(n) asm volatile("s_waitcnt lgkmcnt(" #n ")" ::: "memory")
#define PG8_BAR __builtin_amdgcn_s_barrier()
#define PG8_SCHED __builtin_amdgcn_sched_barrier(0)
    Unit cur, nxt; int ui = 0;
    if (!S.next(0, cur)) return;
    f32x4 acc[2][2][4][2];
#pragma unroll
    for (int a = 0; a < 2; ++a)
#pragma unroll
        for (int b = 0; b < 2; ++b)
#pragma unroll
            for (int m = 0; m < 4; ++m)
#pragma unroll
                for (int n = 0; n < 2; ++n) acc[a][b][m][n] = (f32x4){0.f, 0.f, 0.f, 0.f};
    sbf16x8 At[4][2], B0[2][2], B1[2][2];
    const char* cA = (const char*)g.A + (size_t)cur.pm * tstep; const char* cB = (const char*)g.Bt + (size_t)cur.pn * tstep;
    PG8_STAGE(PG8_SB(0, 0), cB, voffB); PG8_STAGE(PG8_SA(0, 0), cA, voffA); PG8_STAGE(PG8_SB(0, 1), cB + hstep, voffB); PG8_STAGE(PG8_SA(0, 1), cA + hstep, voffA);
    if (wr == 1) PG8_BAR;
    PG8_WAIT_V(4); PG8_BAR;
    PG8_STAGE(PG8_SB(1, 0), cB + kstep, voffB); PG8_STAGE(PG8_SA(1, 0), cA + kstep, voffA); PG8_STAGE(PG8_SB(1, 1), cB + hstep + kstep, voffB);
    PG8_WAIT_V(6); PG8_BAR;
    for (;;) {
        const bool has_next = S.next(ui + 1, nxt);
        const char* nA = has_next ? (const char*)g.A + (size_t)nxt.pm * tstep : cA; const char* nB = has_next ? (const char*)g.Bt + (size_t)nxt.pn * tstep : cB;
        for (int t = 0; t < nt; t += 2) {
            const bool last = (t == nt - 2);
            const char* a1 = cA + (size_t)(t + 1) * kstep;
            const char* a2 = last ? nA : cA + (size_t)(t + 2) * kstep; const char* b2 = last ? nB : cB + (size_t)(t + 2) * kstep;
            const char* a3 = a2 + kstep; const char* b3 = b2 + kstep;
            PG8_LDB(B0, 0, 0); PG8_SCHED; PG8_LDA(At, 0, 0); PG8_STAGE(PG8_SA(1, 1), a1 + hstep, voffA);
            PG8_WAIT_L(8); PG8_BAR; PG8_WAIT_L(0); PG8_MMA(0, 0, At, B0); PG8_BAR; PG8_SCHED;
            PG8_LDB(B1, 0, 1); PG8_STAGE(PG8_SB(0, 0), b2, voffB);
            PG8_BAR; PG8_WAIT_L(0); PG8_MMA(0, 1, At, B1); PG8_BAR;
            PG8_LDA(At, 0, 1); PG8_STAGE(PG8_SA(0, 0), a2, voffA);
            PG8_BAR; PG8_WAIT_L(0); PG8_MMA(1, 0, At, B0); PG8_BAR; PG8_SCHED;
            PG8_STAGE(PG8_SB(0, 1), b2 + hstep, voffB);
            PG8_WAIT_V(6); PG8_BAR; PG8_MMA(1, 1, At, B1); PG8_BAR;
            PG8_LDB(B0, 1, 0); PG8_SCHED; PG8_LDA(At, 1, 0); PG8_STAGE(PG8_SA(0, 1), a2 + hstep, voffA);
            PG8_WAIT_L(8); PG8_BAR; PG8_WAIT_L(0); PG8_MMA(0, 0, At, B0); PG8_BAR; PG8_SCHED;
            PG8_LDB(B1, 1, 1); PG8_STAGE(PG8_SB(1, 0), b3, voffB);
            PG8_BAR; PG8_WAIT_L(0); PG8_MMA(0, 1, At, B1); PG8_BAR;
            PG8_LDA(At, 1, 1); PG8_STAGE(PG8_SA(1, 0), a3, voffA);
            PG8_BAR; PG8_WAIT_L(0); PG8_MMA(1, 0, At, B0); PG8_BAR; PG8_SCHED;
            PG8_STAGE(PG8_SB(1, 1), b3 + hstep, voffB);
            PG8_WAIT_V(6); PG8_BAR; PG8_MMA(1, 1, At, B1); PG8_BAR;
        }
        E(acc, cur, wr, wc, fr, fq);
        if (!has_next) break;
#pragma unroll
        for (int a = 0; a < 2; ++a)
#pragma unroll
            for (int b = 0; b < 2; ++b)
#pragma unroll
                for (int m = 0; m < 4; ++m)
#pragma unroll
                    for (int n = 0; n < 2; ++n) acc[a][b][m][n] = (f32x4){0.f, 0.f, 0.f, 0.f};
        cur = nxt; cA = nA; cB = nB; ++ui;
    }
    PG8_WAIT_V(0);
    if (wr == 0) PG8_BAR;
    PG8_BAR;
#undef PG8_SA
#undef PG8_SB
#undef PG8_STAGE
#undef PG8_LDA
#undef PG8_LDB
#undef PG8_MMA
#undef PG8_WAIT_V
#undef PG8_WAIT_L
#undef PG8_BAR
#undef PG8_SCHED
}
}

struct EpiQKC {
  static constexpr bool PERM = true;
  const float* rs1; const float* qg; const float* kg; bf16_t* Q; bf16_t* Kk; bf16_t* HG;
  __device__ __forceinline__ void operator()(const f32x4 (&acc)[2][2][4][2], const pg8::Unit& u, int wr, int wc, int fr, int fq) const {
    const int row0 = u.pm * 256 + wr * 64 + fr;
    if (u.pn < 4) {
      const bool isq = u.pn < 2;
      const int head = 4 * (u.pn & 1) + wc;
      const float* g = isq ? qg : kg;
      f32x4 gv[2][2];
#pragma unroll
      for (int bj = 0; bj < 2; ++bj)
#pragma unroll
        for (int n = 0; n < 2; ++n) gv[bj][n] = *(const f32x4*)(g + 32 * bj + 8 * fq + 4 * n);
      bf16_t* base = isq ? Q : Kk;
#pragma unroll
      for (int ai = 0; ai < 2; ++ai)
#pragma unroll
        for (int m = 0; m < 4; ++m) {
          const int t = row0 + ai * 128 + m * 16;
          float ss = 0.f;
#pragma unroll
          for (int bj = 0; bj < 2; ++bj)
#pragma unroll
            for (int n = 0; n < 2; ++n) { const f32x4 v = acc[ai][bj][m][n]; ss += v.x * v.x + v.y * v.y + v.z * v.z + v.w * v.w; }
          ss += __shfl_xor(ss, 16);
          ss += __shfl_xor(ss, 32);
          const float r = rs1[t];
          float sc = r * rsqrtf(r * r * ss * (1.f / 64.f) + EPS);
          if (isq) sc *= 0.125f * LOG2E;
          bf16_t* dst = base + ((size_t)((t >> 12) * 8 + head) * 4096 + (t & 4095)) * 64 + 8 * fq;
#pragma unroll
          for (int bj = 0; bj < 2; ++bj) {
            const f32x4 a = acc[ai][bj][m][0] * gv[bj][0] * sc, b = acc[ai][bj][m][1] * gv[bj][1] * sc;
            *(u32x4*)(dst + 32 * bj) = (u32x4){pk2(a.x, a.y), pk2(a.z, a.w), pk2(b.x, b.y), pk2(b.z, b.w)};
          }
        }
    } else {
      const int ch0 = 128 * (u.pn - 4) + 32 * wc + 8 * fq;
#pragma unroll
      for (int ai = 0; ai < 2; ++ai)
#pragma unroll
        for (int m = 0; m < 4; ++m) {
          const int t = row0 + ai * 128 + m * 16;
          const float r = rs1[t];
          float h[8];
#pragma unroll
          for (int n = 0; n < 2; ++n)
#pragma unroll
            for (int j = 0; j < 4; ++j) h[4 * n + j] = acc[ai][0][m][n][j] * r / (1.f + __expf(-acc[ai][1][m][n][j] * r));
          *(u32x4*)(HG + (size_t)t * 512 + ch0) = (u32x4){pk2(h[0], h[1]), pk2(h[2], h[3]), pk2(h[4], h[5]), pk2(h[6], h[7])};
        }
    }
  }
};
struct EpiVt {
  static constexpr bool PERM = false;
  const float* rs1; bf16_t* Vt;
  __device__ __forceinline__ void operator()(const f32x4 (&acc)[2][2][4][2], const pg8::Unit& u, int wr, int wc, int fr, int fq) const {
    const int pos0 = 8 * (fq & 1) + 4 * (fq >> 1);
#pragma unroll
    for (int bj = 0; bj < 2; ++bj)
#pragma unroll
      for (int n = 0; n < 2; ++n) {
        const int t = u.pn * 256 + bj * 128 + wc * 32 + n * 16 + 4 * fq;
        const f32x4 r = *(const f32x4*)(rs1 + t);
        const size_t tb = ((size_t)(t >> 12) * 8) * 128 + ((t & 4095) >> 5);
#pragma unroll
        for (int ai = 0; ai < 2; ++ai)
#pragma unroll
          for (int m = 0; m < 4; ++m) {
            const int dg = u.pm * 256 + ai * 128 + wr * 64 + m * 16 + fr, head = dg >> 6, d = dg & 63;
            const f32x4 v = acc[ai][bj][m][n] * r;
            *(u32x2*)(Vt + ((tb + (size_t)head * 128) * 64 + d) * 32 + 16 * n + pos0) = (u32x2){pk2(v.x, v.y), pk2(v.z, v.w)};
          }
      }
  }
};
struct EpiOut {
  static constexpr bool PERM = false;
  const bf16_t* xb; bf16_t* HB; float* ssq2;
  __device__ __forceinline__ void operator()(const f32x4 (&acc)[2][2][4][2], const pg8::Unit& u, int wr, int wc, int fr, int fq) const {
    const int row0 = u.pm * 256 + wr * 64 + fr, col0 = u.pn * 256 + wc * 32 + 4 * fq;
#pragma unroll
    for (int ai = 0; ai < 2; ++ai)
#pragma unroll
      for (int m = 0; m < 4; ++m) {
        const int t = row0 + ai * 128 + m * 16;
        const size_t ro = (size_t)t * 1024 + col0;
        float ss = 0.f;
#pragma unroll
        for (int bj = 0; bj < 2; ++bj)
#pragma unroll
          for (int n = 0; n < 2; ++n) {
            const size_t o = ro + bj * 128 + n * 16;
            const u32x2 xv = *(const u32x2*)(xb + o);
            const f32x4 h = (f32x4){bflo(xv.x), bfhi(xv.x), bflo(xv.y), bfhi(xv.y)} + acc[ai][bj][m][n];
            *(u32x2*)(HB + o) = (u32x2){pk2(h.x, h.y), pk2(h.z, h.w)};
            ss += h.x * h.x + h.y * h.y + h.z * h.z + h.w * h.w;
          }
        ss += __shfl_xor(ss, 16);
        ss += __shfl_xor(ss, 32);
        if (fq == 0) atomicAdd(ssq2 + t, ss);
      }
  }
};
struct EpiQh {
  static constexpr bool PERM = true;
  const float* ssq2; bf16_t* QH;
  __device__ __forceinline__ void operator()(const f32x4 (&acc)[2][2][4][2], const pg8::Unit& u, int wr, int wc, int fr, int fq) const {
    const int row0 = u.pm * 256 + wr * 64 + fr, col0 = u.pn * 256 + wc * 32 + 8 * fq;
#pragma unroll
    for (int ai = 0; ai < 2; ++ai)
#pragma unroll
      for (int m = 0; m < 4; ++m) {
        const int t = row0 + ai * 128 + m * 16;
        const float r = rsqrtf(ssq2[t] * (1.f / 1024.f) + EPS);
#pragma unroll
        for (int bj = 0; bj < 2; ++bj) {
          const f32x4 a = acc[ai][bj][m][0] * r, b = acc[ai][bj][m][1] * r;
          *(u32x4*)(QH + (size_t)t * 1024 + col0 + bj * 128) = (u32x4){pk2(a.x, a.y), pk2(a.z, a.w), pk2(b.x, b.y), pk2(b.z, b.w)};
        }
      }
  }
};

__device__ void phase_inproj(const Params& p, char* smem) {
  unsigned char* ws = p.ws;
  LAS unsigned char* lds = (LAS unsigned char*)smem;
  const bf16_t* XB = (const bf16_t*)(ws + WS_XB);
  const float* RS1 = (const float*)(ws + WS_RS1);
  pg8::StaticOrder S;
  {
    pg8::Gemm g{XB, (const bf16_t*)(ws + WS_W1), T, 2048, 1024};
    S.init(T, 2048, gridDim.x, blockIdx.x);
    EpiQKC E{RS1, p.q_norm_g, p.k_norm_g, (bf16_t*)(ws + WS_Q), (bf16_t*)(ws + WS_K), (bf16_t*)(ws + WS_HG)};
    pg8::gemm_phase<EpiQKC>(lds, g, S, E);
  }
  {
    pg8::Gemm g{(const bf16_t*)(ws + WS_WV), XB, 512, T, 1024};
    S.init(512, T, gridDim.x, blockIdx.x);
    EpiVt E{RS1, (bf16_t*)(ws + WS_VT)};
    pg8::gemm_phase<EpiVt>(lds, g, S, E);
  }
}
__device__ void phase_outproj(const Params& p, char* smem) {
  unsigned char* ws = p.ws;
  pg8::Gemm g{(const bf16_t*)(ws + WS_MIX), (const bf16_t*)(ws + WS_WOUT), T, 1024, 1024};
  pg8::StaticOrder S;
  S.init(T, 1024, gridDim.x, blockIdx.x);
  EpiOut E{(const bf16_t*)(ws + WS_XB), (bf16_t*)(ws + WS_HB), (float*)(ws + WS_SSQ2)};
  pg8::gemm_phase<EpiOut>((LAS unsigned char*)smem, g, S, E);
}
__device__ void phase_qproj(const Params& p, char* smem) {
  unsigned char* ws = p.ws;
  pg8::Gemm g{(const bf16_t*)(ws + WS_HB), (const bf16_t*)(ws + WS_WQ), T, 1024, 1024};
  pg8::StaticOrder S;
  S.init(T, 1024, gridDim.x, blockIdx.x);
  EpiQh E{(const float*)(ws + WS_SSQ2), (bf16_t*)(ws + WS_QH)};
  pg8::gemm_phase<EpiQh>((LAS unsigned char*)smem, g, S, E);
}

__device__ void conv_item(const Params& p, int item, char* smem) {
  unsigned char* ws = p.ws;
  const bf16_t* HG = (const bf16_t*)(ws + WS_HG);
  bf16_t* MIX = (bf16_t*)(ws + WS_MIX);
  const int tid512 = otid(), half = tid512 >> 8, tid = tid512 & 255, lane = tid & 63, wave = tid >> 6;
  const int t0 = item * 32, s0 = t0 & 4095;
  for (int idx = tid512; idx < 62 * 64; idx += NTHREADS) {
    const int r = idx >> 6, c16 = idx & 63;
    u32x4 v = {0u, 0u, 0u, 0u};
    if (s0 - 30 + r >= 0) v = *(const u32x4*)(HG + (size_t)(t0 - 30 + r) * 512 + c16 * 8);
    *(u32x4*)(smem + r * 1024 + c16 * 16) = v;
  }
  f32x2 wv[31];
#pragma unroll
  for (int j = 0; j < 31; ++j) {
    const float2 w = *(const float2*)(p.conv_w + j * 512 + 2 * tid);
    wv[j] = (f32x2){w.x, w.y};
  }
  const float2 cb = *(const float2*)(p.conv_b + 2 * tid);
  const float2 lg = *(const float2*)(p.conv_ln_g + 2 * tid);
  const float2 lb = *(const float2*)(p.conv_ln_b + 2 * tid);
  float* red = (float*)(smem + 62 * 1024) + half * 128;
  __syncthreads();
  const bool b5 = lane & 32, b4 = lane & 16, b3 = lane & 8, b2 = lane & 4;
#pragma unroll 1
  for (int rd = 0; rd < 2; ++rd) {
    const int tb = 16 * half + 8 * rd;
    f32x2 xv[38];
#pragma unroll
    for (int r = 0; r < 38; ++r) {
      const unsigned v = *(const unsigned*)(smem + (tb + r) * 1024 + tid * 4);
      xv[r] = (f32x2){bflo(v), bfhi(v)};
    }
    float a0[8], a1[8], st[16];
#pragma unroll
    for (int k = 0; k < 8; ++k) {
      f32x2 u = {cb.x, cb.y};
#pragma unroll
      for (int j = 0; j < 31; ++j) u = __builtin_elementwise_fma(wv[j], xv[k + j], u);
      a0[k] = u.x; a1[k] = u.y;
      st[k] = u.x + u.y;
      st[8 + k] = u.x * u.x + u.y * u.y;
    }
    float r8[8], r4[4], r2[2], r1;
#pragma unroll
    for (int i = 0; i < 8; ++i) { const float keep = b5 ? st[8 + i] : st[i], send = b5 ? st[i] : st[8 + i]; r8[i] = keep + __shfl_xor(send, 32); }
#pragma unroll
    for (int i = 0; i < 4; ++i) { const float keep = b4 ? r8[4 + i] : r8[i], send = b4 ? r8[i] : r8[4 + i]; r4[i] = keep + __shfl_xor(send, 16); }
#pragma unroll
    for (int i = 0; i < 2; ++i) { const float keep = b3 ? r4[2 + i] : r4[i], send = b3 ? r4[i] : r4[2 + i]; r2[i] = keep + __shfl_xor(send, 8); }
    { const float keep = b2 ? r2[1] : r2[0], send = b2 ? r2[0] : r2[1]; r1 = keep + __shfl_xor(send, 4); }
    r1 += __shfl_xor(r1, 2);
    r1 += __shfl_xor(r1, 1);
    float* rr = red + rd * 64;
    if ((lane & 3) == 0) rr[wave * 16 + (lane >> 2)] = r1;
    __syncthreads();
#pragma unroll
    for (int k = 0; k < 8; ++k) {
      const float S1 = (rr[k] + rr[16 + k]) + (rr[32 + k] + rr[48 + k]);
      const float S2 = (rr[8 + k] + rr[24 + k]) + (rr[40 + k] + rr[56 + k]);
      const float mu = S1 * (1.f / 512.f);
      const float var = fmaxf(S2 * (1.f / 512.f) - mu * mu, 0.f);
      const float rstd = rsqrtf(var + EPS);
      const float y0 = (a0[k] - mu) * rstd * lg.x + lb.x, y1 = (a1[k] - mu) * rstd * lg.y + lb.y;
      const float z0 = y0 / (1.f + __expf(-y0)), z1 = y1 / (1.f + __expf(-y1));
      *(unsigned*)(MIX + (size_t)(t0 + tb + k) * 1024 + 512 + 2 * tid) = pk2(z0, z1);
    }
  }
  __syncthreads();
}

struct AttnKV { bf16x8 k[4]; bf16x8 v[2][2]; };
__device__ __forceinline__ void attn_load(const bf16_t* Km, const bf16_t* Vt, int bh, int kb, int tok, int hf, AttnKV& f) {
  const int kc = kb < 0 ? 0 : kb;
  const bf16_t* kp = Km + ((size_t)bh * 4096 + kc * 32 + tok) * 64 + 8 * hf;
#pragma unroll
  for (int ks = 0; ks < 4; ++ks) f.k[ks] = *(const bf16x8*)(kp + ks * 16);
  const bf16_t* vp = Vt + (((size_t)bh * 128 + kc) * 64 + tok) * 32 + hf * 8;
#pragma unroll
  for (int m = 0; m < 2; ++m)
#pragma unroll
    for (int s = 0; s < 2; ++s) f.v[m][s] = *(const bf16x8*)(vp + m * 1024 + s * 16);
}
__device__ __forceinline__ bool attn_block(const AttnKV& f, const bf16x8 (&qf)[4], bool diag, int tok, int hf, float& c, f32x16& o0, f32x16& o1) {
  f32x16 sc;
#pragma unroll
  for (int i = 0; i < 16; ++i) sc[i] = 0.f;
#pragma unroll
  for (int ks = 0; ks < 4; ++ks) sc = mfma32(f.k[ks], qf[ks], sc);
  float lk[16], zs[16];
#pragma unroll
  for (int i = 0; i < 16; ++i) {
    const float zl = sc[i];
    const float e = __builtin_amdgcn_exp2f(zl);
    const float sp = __builtin_amdgcn_logf(1.f + e);
    const bool valid = !diag || ((i & 3) + 8 * (i >> 2) + 4 * hf < tok);
    lk[i] = valid ? -sp : 0.f;
    zs[i] = valid ? zl - sp : -1e30f;
  }
  float Tg[4], Pg[4];
#pragma unroll
  for (int g = 0; g < 4; ++g) {
    Tg[g] = (lk[4 * g] + lk[4 * g + 1]) + (lk[4 * g + 2] + lk[4 * g + 3]);
    Pg[g] = __shfl_xor(Tg[g], 32);
  }
  float base[4];
  float run = 0.f;
#pragma unroll
  for (int g = 3; g >= 0; --g) {
    base[g] = c + run + (hf == 0 ? Pg[g] : 0.f);
    run += Tg[g] + Pg[g];
  }
  float pr[16];
#pragma unroll
  for (int g = 0; g < 4; ++g) {
    float l = base[g];
#pragma unroll
    for (int r = 3; r >= 0; --r) {
      pr[4 * g + r] = __builtin_amdgcn_exp2f(zs[4 * g + r] + l);
      l += lk[4 * g + r];
    }
  }
  c += run;
  bf16x8 pf[2];
#pragma unroll
  for (int s = 0; s < 2; ++s)
#pragma unroll
    for (int j = 0; j < 8; ++j) pf[s][j] = (__bf16)pr[8 * s + j];
#pragma unroll
  for (int s = 0; s < 2; ++s) {
    o0 = mfma32(f.v[0][s], pf[s], o0);
    o1 = mfma32(f.v[1][s], pf[s], o1);
  }
  return __all(c < -150.f);
}
__device__ void attn_tile(const Params& p, int item, int it, int lane, int wave, char* smem) {
  unsigned char* ws = p.ws;
  const bf16_t* Qm = (const bf16_t*)(ws + WS_Q);
  const bf16_t* Km = (const bf16_t*)(ws + WS_K);
  const bf16_t* Vt = (const bf16_t*)(ws + WS_VT);
  bf16_t* MIX = (bf16_t*)(ws + WS_MIX);
  const int qt = item & 127, bh = (item >> 7) * 8 + wave;
  const int tok = lane & 31, hf = lane >> 5;
  bf16x8 qf[4];
  {
    const bf16_t* qp = Qm + ((size_t)bh * 4096 + qt * 32 + tok) * 64 + 8 * hf;
#pragma unroll
    for (int ks = 0; ks < 4; ++ks) qf[ks] = *(const bf16x8*)(qp + ks * 16);
  }
  f32x16 o0, o1;
#pragma unroll
  for (int i = 0; i < 16; ++i) { o0[i] = 0.f; o1[i] = 0.f; }
  float c = 0.f;
  AttnKV fa, fb;
  attn_load(Km, Vt, bh, qt, tok, hf, fa);
  {
    unsigned z = __builtin_bit_cast(u32x4, fa.v[1][1]).w | __builtin_bit_cast(u32x4, fa.k[3]).w | __builtin_bit_cast(u32x4, qf[3]).w;
    asm volatile("" ::"v"(z));
  }
  for (int kb = qt;; kb -= 2) {
    attn_load(Km, Vt, bh, kb - 1, tok, hf, fb);
    __builtin_amdgcn_sched_barrier(0);
    if (attn_block(fa, qf, kb == qt, tok, hf, c, o0, o1) || kb == 0) break;
    attn_load(Km, Vt, bh, kb - 2, tok, hf, fa);
    __builtin_amdgcn_sched_barrier(0);
    if (attn_block(fb, qf, false, tok, hf, c, o0, o1) || kb == 1) break;
  }
  float ssq = 0.f;
#pragma unroll
  for (int i = 0; i < 16; ++i) ssq += o0[i] * o0[i] + o1[i] * o1[i];
  ssq += __shfl_xor(ssq, 32);
  float* xch = (float*)(smem + 100 * 1024) + (it & 1) * 256;
  if (hf == 0) xch[wave * 32 + tok] = ssq;
  __syncthreads();
  float tot = 0.f;
#pragma unroll
  for (int w = 0; w < NWAVES; ++w) tot += xch[w * 32 + tok];
  const float rs = rsqrtf(tot * (1.f / 512.f) + EPS);
  const int t = (bh >> 3) * 4096 + qt * 32 + tok, hh = bh & 7;
  bf16_t* dst = MIX + (size_t)t * 1024 + hh * 64 + 4 * hf;
#pragma unroll
  for (int g = 0; g < 4; ++g) {
    *(u32x2*)(dst + 8 * g) = (u32x2){pk2(o0[4 * g] * rs, o0[4 * g + 1] * rs), pk2(o0[4 * g + 2] * rs, o0[4 * g + 3] * rs)};
    *(u32x2*)(dst + 32 + 8 * g) = (u32x2){pk2(o1[4 * g] * rs, o1[4 * g + 1] * rs), pk2(o1[4 * g + 2] * rs, o1[4 * g + 3] * rs)};
  }
}

__device__ void phase_mix(const Params& p, char* smem) {
  static_assert(NWAVES == 8, "one wave per attention head");
  const int vb = vblock(), G = gridDim.x;
  for (int item = vb; item < 1024; item += G) conv_item(p, item, smem);
  const int tidm = otid();
  const int lane = tidm & 63, wave = tidm >> 6;
  int it = 0;
  for (int item = vb; item < 1024; item += G, ++it) attn_tile(p, item, it, lane, wave, smem);
}
__device__ __forceinline__ unsigned f2key(float f, unsigned n) {
  const unsigned u = (__float_as_uint(f) & ~0x7Fu) | n;
  return u ^ ((unsigned)((int)u >> 31) | 0x80000000u);
}
__device__ __forceinline__ unsigned f2key_raw(float f) {
  const unsigned u = __float_as_uint(f);
  return u ^ ((unsigned)((int)u >> 31) | 0x80000000u);
}
__device__ __forceinline__ unsigned key2u(unsigned k) { return k ^ ((k >> 31) ? 0x80000000u : 0xFFFFFFFFu); }

template <int N>
__device__ __forceinline__ void bitonic_sort_desc(unsigned (&v)[N]) {
#pragma unroll
  for (int k = 2; k <= N; k <<= 1) {
#pragma unroll
    for (int j = k >> 1; j > 0; j >>= 1) {
#pragma unroll
      for (int i = 0; i < N; ++i) {
        const int l = i ^ j;
        if (l > i) {
          const bool desc = ((i & k) == 0);
          const unsigned mx = max(v[i], v[l]), mn = min(v[i], v[l]);
          v[i] = desc ? mx : mn;
          v[l] = desc ? mn : mx;
        }
      }
    }
  }
}
template <int N>
__device__ __forceinline__ void bitonic_merge_desc(unsigned (&v)[N]) {
#pragma unroll
  for (int j = N >> 1; j > 0; j >>= 1) {
#pragma unroll
    for (int i = 0; i < N; ++i) {
      const int l = i ^ j;
      if (l > i) {
        const unsigned mx = max(v[i], v[l]), mn = min(v[i], v[l]);
        v[i] = mx;
        v[l] = mn;
      }
    }
  }
}
__device__ __forceinline__ void merge_top16(unsigned (&a)[16], const unsigned (&b)[16]) {
#pragma unroll
  for (int i = 0; i < 16; ++i) a[i] = max(a[i], b[15 - i]);
  bitonic_merge_desc<16>(a);
}
#define CEP(ka, pa, kb, pb, desc)                                  \
  {                                                                \
    const bool sw_ = (desc) ? ((kb) > (ka)) : ((kb) < (ka));       \
    const unsigned tk_ = sw_ ? (kb) : (ka), tl_ = sw_ ? (ka) : (kb); \
    const unsigned tp_ = sw_ ? (pb) : (pa), tq_ = sw_ ? (pa) : (pb); \
    ka = tk_; kb = tl_; pa = tp_; pb = tq_;                        \
  }
template <int N>
__device__ __forceinline__ void bitonic_sort_desc_p(unsigned (&v)[N], unsigned (&pl)[N]) {
#pragma unroll
  for (int k = 2; k <= N; k <<= 1) {
#pragma unroll
    for (int j = k >> 1; j > 0; j >>= 1) {
#pragma unroll
      for (int i = 0; i < N; ++i) {
        const int l = i ^ j;
        if (l > i) {
          const bool desc = ((i & k) == 0);
          CEP(v[i], pl[i], v[l], pl[l], desc);
        }
      }
    }
  }
}
template <int N>
__device__ __forceinline__ void bitonic_merge_desc_p(unsigned (&v)[N], unsigned (&pl)[N]) {
#pragma unroll
  for (int j = N >> 1; j > 0; j >>= 1) {
#pragma unroll
    for (int i = 0; i < N; ++i) {
      const int l = i ^ j;
      if (l > i) { CEP(v[i], pl[i], v[l], pl[l], true); }
    }
  }
}
__device__ __forceinline__ void merge_top16_p(unsigned (&a)[16], unsigned (&pa)[16], const unsigned (&b)[16], const unsigned (&pb)[16]) {
#pragma unroll
  for (int i = 0; i < 16; ++i) {
    const bool s = b[15 - i] > a[i];
    a[i] = s ? b[15 - i] : a[i];
    pa[i] = s ? pb[15 - i] : pa[i];
  }
  bitonic_merge_desc_p<16>(a, pa);
}

constexpr int KROW = 144;
__device__ __forceinline__ void subkey_top16(const LAS unsigned char* Kl, const bf16_t* __restrict__ qrow, int lane, unsigned (&top)[16]) {
  const int tok = lane & 31, hf = lane >> 5;
  f32x16 acc[4];
#pragma unroll
  for (int m = 0; m < 4; ++m)
#pragma unroll
    for (int i = 0; i < 16; ++i) acc[m][i] = 0.f;
  bf16x8 bq[4];
#pragma unroll
  for (int ks = 0; ks < 4; ++ks) bq[ks] = *(const bf16x8*)(qrow + ks * 16 + 8 * hf);
#pragma unroll 1
  for (int ks = 0; ks < 4; ++ks) {
#pragma unroll
    for (int m = 0; m < 4; ++m) {
      const bf16x8 ak = *(const LAS bf16x8*)(Kl + (m * 32 + tok) * KROW + ks * 32 + hf * 16);
      acc[m] = mfma32(ak, ks == 0 ? bq[0] : ks == 1 ? bq[1] : ks == 2 ? bq[2] : bq[3], acc[m]);
    }
  }
  unsigned g[4][16];
#pragma unroll
  for (int m = 0; m < 4; ++m) {
#pragma unroll
    for (int i = 0; i < 16; ++i) g[m][i] = f2key(acc[m][i], (unsigned)(m * 32 + (i & 3) + 8 * (i >> 2) + 4 * hf));
    bitonic_sort_desc<16>(g[m]);
  }
  merge_top16(g[0], g[1]);
  merge_top16(g[2], g[3]);
  merge_top16(g[0], g[2]);
  unsigned o[16];
#pragma unroll
  for (int i = 0; i < 16; ++i) o[i] = __shfl_xor(g[0][i], 32);
  merge_top16(g[0], o);
#pragma unroll
  for (int i = 0; i < 16; ++i) top[i] = g[0][i];
}

__device__ void phase_route(const Params& p, char* smem) {
  unsigned char* ws = p.ws;
  const bf16_t* K1 = (const bf16_t*)(ws + WS_K1);
  const bf16_t* K2 = (const bf16_t*)(ws + WS_K2);
  const bf16_t* QH = (const bf16_t*)(ws + WS_QH);
  const bf16_t* HB = (const bf16_t*)(ws + WS_HB);
  unsigned char* XN8 = ws + WS_XN8;
  const float* SSQ2 = (const float*)(ws + WS_SSQ2);
  unsigned* PIDX = (unsigned*)(ws + WS_PIDX);
  float* PG = (float*)(ws + WS_PG);
  const int tidr = otid();
  const int lane = tidr & 63, wave = tidr >> 6, gw = vblock() * NWAVES + wave, nw = gridDim.x * NWAVES;
  for (int t = gw; t < T; t += nw) {
    const bf16_t* src = HB + (size_t)t * 1024 + lane * 16;
    const float r = rsqrtf(SSQ2[t] * (1.f / 1024.f) + EPS) * 16.f;
    const u32x4 h0 = *(const u32x4*)src, h1 = *(const u32x4*)(src + 8);
    u32x4 q;
#pragma unroll
    for (int i = 0; i < 4; ++i) {
      const f32x4 g4 = *(const f32x4*)(p.norm_ffn_g + lane * 16 + 4 * i);
      const unsigned lo = (i < 2) ? h0[2 * i] : h1[2 * i - 4], hi = (i < 2) ? h0[2 * i + 1] : h1[2 * i - 3];
      int w = 0;
      w = __builtin_amdgcn_cvt_pk_fp8_f32(bflo(lo) * r * g4.x, bfhi(lo) * r * g4.y, w, false);
      w = __builtin_amdgcn_cvt_pk_fp8_f32(bflo(hi) * r * g4.z, bfhi(hi) * r * g4.w, w, true);
      q[i] = (unsigned)w;
    }
    *(u32x4*)(XN8 + (size_t)t * 1024 + lane * 16) = q;
  }
  const int G = gridDim.x, nh = (G % 8 == 0) ? 8 : 1;
  LAS unsigned char* K1l = (LAS unsigned char*)smem;
  LAS unsigned char* K2l = K1l + 128 * KROW;
  for (int hd = blockIdx.x % nh; hd < 8; hd += nh) {
    for (int idx = tidr; idx < 2048; idx += NTHREADS) {
      const int tb = idx >> 10, row = (idx >> 3) & 127, ch = idx & 7;
      const u32x4 v = *(const u32x4*)((tb ? K2 : K1) + hd * 8192 + row * 64 + ch * 8);
      *(LAS u32x4*)((tb ? K2l : K1l) + row * KROW + ch * 16) = v;
    }
    __syncthreads();
    for (int tile = (blockIdx.x / nh) * NWAVES + wave; tile < T / 32; tile += (G / nh) * NWAVES) {
      const int t0 = tile * 32;
      const int tok = lane & 31, hf = lane >> 5;
      const bf16_t* qrow = QH + (size_t)(t0 + tok) * 1024 + hd * 128;
      unsigned top1[16], top2[16];
      subkey_top16(K1l, qrow, lane, top1);
      subkey_top16(K2l, qrow + 64, lane, top2);
      float fa[16], fb[16];
      unsigned ia[16], ib[16];
#pragma unroll
      for (int i = 0; i < 16; ++i) {
        const unsigned ua = key2u(hf ? top2[i] : top1[i]), ub = key2u(hf ? top1[i] : top2[i]);
        fa[i] = __uint_as_float(ua); ia[i] = ua & 0x7Fu;
        fb[i] = __uint_as_float(ub); ib[i] = ub & 0x7Fu;
      }
      unsigned ck[32];
      {
        int n = 0;
#pragma unroll
        for (int i = 0; i < 4; ++i) {
#pragma unroll
          for (int j = i; j < 16; ++j) {
            if ((i + 1) * (j + 1) <= 16) {
              unsigned key = (f2key_raw(fa[i] + fb[j]) & ~0x3FFFu) | (hf ? ((ib[j] << 7) | ia[i]) : ((ia[i] << 7) | ib[j]));
              if (i == j && hf) key = 0u;
              ck[n] = key;
              ++n;
            }
          }
        }
#pragma unroll
        for (; n < 32; ++n) ck[n] = 0u;
      }
      unsigned k0[16], k1[16];
#pragma unroll
      for (int i = 0; i < 16; ++i) { k0[i] = ck[i]; k1[i] = ck[16 + i]; }
      bitonic_sort_desc<16>(k0);
      bitonic_sort_desc<16>(k1);
      merge_top16(k0, k1);
#pragma unroll
      for (int i = 0; i < 16; ++i) k1[i] = __shfl_xor(k0[i], 32);
      merge_top16(k0, k1);
      float sv[16], sum = 0.f;
      const float mx = __uint_as_float(key2u(k0[0] & ~0x3FFFu));
#pragma unroll
      for (int i = 0; i < 16; ++i) {
        sv[i] = __builtin_amdgcn_exp2f((__uint_as_float(key2u(k0[i] & ~0x3FFFu)) - mx) * LOG2E);
        sum += sv[i];
      }
      const float inv = 1.f / sum;
      const size_t po = ((size_t)(t0 + tok) * 8 + hd) * 16;
      if (hf == 0) {
#pragma unroll
        for (int q = 0; q < 4; ++q) *(u32x4*)(PIDX + po + 4 * q) = (u32x4){k0[4 * q] & 0x3FFFu, k0[4 * q + 1] & 0x3FFFu, k0[4 * q + 2] & 0x3FFFu, k0[4 * q + 3] & 0x3FFFu};
      } else {
#pragma unroll
        for (int q = 0; q < 4; ++q) *(f32x4*)(PG + po + 4 * q) = (f32x4){sv[4 * q] * inv, sv[4 * q + 1] * inv, sv[4 * q + 2] * inv, sv[4 * q + 3] * inv};
      }
    }
    __syncthreads();
  }
}

typedef int i32x8 __attribute__((ext_vector_type(8)));
__device__ __forceinline__ f32x4 mfma_fp4_fp8(u32x4 a, u32x4 b0, u32x4 b1, f32x4 c) {
  const i32x8 A = {(int)a.x, (int)a.y, (int)a.z, (int)a.w, 0, 0, 0, 0};
  const i32x8 B = {(int)b0.x, (int)b0.y, (int)b0.z, (int)b0.w, (int)b1.x, (int)b1.y, (int)b1.z, (int)b1.w};
  return __builtin_amdgcn_mfma_scale_f32_16x16x128_f8f6f4(A, B, c, 4, 0, 0, 0x7F7F7F7F, 0, 0x7F7F7F7F);
}
struct PeCtx {
  const unsigned char* U8; const float2* USV; float* PW; float* dummy; LAS float* glist;
  LAS unsigned* list; int lane, r, g, s, n, t0;
};
__device__ __forceinline__ void pe_rows(const PeCtx& c, int ci, u32x4 (&a)[8]) {
  const int idx = ci * 16 + (c.lane >> 2);
  const unsigned ent = c.list[idx & 2047];
  const unsigned e = (idx < c.n) ? ((ent >> 7) & 16383u) : (unsigned)(c.s << 11);
  const unsigned char* rp = c.U8 + (size_t)e * 512 + (c.lane & 3) * 16;
#pragma unroll
  for (int ks = 0; ks < 8; ++ks) a[ks] = *(const u32x4*)(rp + ks * 64);
}
__device__ __forceinline__ void pe_fix(const PeCtx& c, u32x4 (&a)[8]) {
  const int src = 4 * c.r + c.g;
#pragma unroll
  for (int ks = 0; ks < 8; ++ks) {
    a[ks].x = (unsigned)__shfl((int)a[ks].x, src); a[ks].y = (unsigned)__shfl((int)a[ks].y, src);
    a[ks].z = (unsigned)__shfl((int)a[ks].z, src); a[ks].w = (unsigned)__shfl((int)a[ks].w, src);
  }
}
__device__ __forceinline__ void pe_chunk(const PeCtx& c, int ci, u32x4 (&a)[8], u32x4 (&anext)[8], const u32x4 (&bq)[16]) {
  const int idx = ci * 16 + c.r;
  const unsigned ent = c.list[idx & 2047];
  const bool fin = (c.lane < 16) && (idx < c.n);
  const unsigned e = (ent >> 7) & 16383u, slot = ent & 127u, col = (ent >> 21) & 15u;
  const float2 usv = c.USV[fin ? e : 0u];
  const float gt = c.glist[idx & 2047], us = usv.x, vs = usv.y;
  __builtin_amdgcn_sched_barrier(0);
  pe_rows(c, ci + 1, anext);
  __builtin_amdgcn_sched_barrier(0);
  pe_fix(c, a);
  f32x4 acc = {0.f, 0.f, 0.f, 0.f};
#pragma unroll
  for (int ks = 0; ks < 8; ++ks) acc = mfma_fp4_fp8(a[ks], bq[2 * ks], bq[2 * ks + 1], acc);
  const int src = ((c.r >> 2) << 4) | (int)col;
  const float v0 = __shfl(acc[0], src), v1 = __shfl(acc[1], src), v2 = __shfl(acc[2], src), v3 = __shfl(acc[3], src);
  float d = ((c.r & 3) == 0) ? v0 : ((c.r & 3) == 1) ? v1 : ((c.r & 3) == 2) ? v2 : v3;
  float gt_ = gt, us_ = us, vs_ = vs;
  asm volatile("" : "+v"(d), "+v"(gt_), "+v"(us_), "+v"(vs_));
  {
    const float act = d * us_ * (1.f / 16.f);
    float* dst = fin ? c.PW + (size_t)(c.t0 + col) * 128 + slot : c.dummy;
    *dst = gt_ * 0.5f * act * (1.f + erff(act * 0.70710678118654752f)) * vs_;
  }
}
__device__ void phase_peer_u(const Params& p, char* smem) {
  unsigned char* ws = p.ws;
  PeCtx c;
  c.U8 = ws + WS_U8; c.USV = (const float2*)(ws + WS_USV);
  c.PW = (float*)(ws + WS_PW);
  const float* PG = (const float*)(ws + WS_PG);
  c.dummy = (float*)(ws + WS_PW + 16 * MiB) + (size_t)blockIdx.x * NTHREADS + otid();
  const unsigned char* XN8 = ws + WS_XN8;
  const unsigned* PIDX = (const unsigned*)(ws + WS_PIDX);
  const int tidu = otid();
  const int lane = tidu & 63, wave = tidu >> 6;
  c.lane = lane; c.r = lane & 15; c.g = lane >> 4;
  c.list = (LAS unsigned*)(smem + wave * 8192);
  c.glist = (LAS float*)(smem + 65536 + wave * 8192);
  c.s = 0;
  {
    for (int grp = vblock() * NWAVES + wave; grp < T / 16; grp += gridDim.x * NWAVES) {
      const int t0 = grp * 16;
      c.t0 = t0;
      u32x4 bq[16];
      {
        const unsigned char* xp = XN8 + (size_t)(t0 + c.r) * 1024 + c.g * 16;
#pragma unroll
        for (int ks = 0; ks < 8; ++ks) { bq[2 * ks] = *(const u32x4*)(xp + ks * 128); bq[2 * ks + 1] = *(const u32x4*)(xp + ks * 128 + 64); }
      }
      const int n = 2048;
#pragma unroll
      for (int q = 0; q < 8; ++q) {
        const u32x4 idv = *(const u32x4*)(PIDX + (size_t)t0 * 128 + q * 256 + lane * 4);
        const f32x4 gv = *(const f32x4*)(PG + (size_t)t0 * 128 + q * 256 + lane * 4);
        const unsigned hi = (unsigned)(2 * q + (lane >> 5)) << 21, sl = (unsigned)((lane & 31) * 4);
        *(LAS u32x4*)(c.list + q * 256 + lane * 4) = (u32x4){hi | (idv.x << 7) | sl, hi | (idv.y << 7) | (sl + 1), hi | (idv.z << 7) | (sl + 2), hi | (idv.w << 7) | (sl + 3)};
        *(LAS f32x4*)(c.glist + q * 256 + lane * 4) = gv;
      }
      asm volatile("s_waitcnt lgkmcnt(0)" ::: "memory");
      c.n = n;
      const int nch = (n + 15) >> 4;
      u32x4 a0[8], a1[8];
      pe_rows(c, 0, a0);
      {
        unsigned z = 0u;
#pragma unroll
        for (int ks = 0; ks < 8; ++ks) z |= a0[ks].w;
        asm volatile("" ::"v"(z));
      }
      if (nch > 0) {
        for (int ci = 0;; ci += 2) {
          pe_chunk(c, ci, a0, a1, bq);
          if (ci + 1 >= nch) break;
          pe_chunk(c, ci + 1, a1, a0, bq);
          if (ci + 2 >= nch) break;
        }
      }
      asm volatile("" ::: "memory");
    }
  }
}

#define PFV_LOAD(R, ev, k0)                                                                               \
  {                                                                                                       \
    _Pragma("unroll") for (int i_ = 0; i_ < 8; ++i_) {                                                    \
      const unsigned ea_ = (unsigned)__builtin_amdgcn_readlane((int)(ev), (k0) + 2 * i_);                 \
      const unsigned eb_ = (unsigned)__builtin_amdgcn_readlane((int)(ev), (k0) + 2 * i_ + 1);             \
      R[i_] = *(const u32x4*)(V4 + (size_t)(hi ? eb_ : ea_) * 512);                                       \
    }                                                                                                     \
  }
#define PFV_FMA(dw, b, a) acc[a] = __builtin_elementwise_fma(__builtin_amdgcn_cvt_scalef32_pk_f32_fp4(dw, 1.0f, b), w2_, acc[a]);
#define PFV_ACC(R, wv, k0)                                                                                \
  {                                                                                                       \
    _Pragma("unroll") for (int i_ = 0; i_ < 8; ++i_) {                                                    \
      const float wa_ = __builtin_bit_cast(float, __builtin_amdgcn_readlane(__builtin_bit_cast(int, (wv)), (k0) + 2 * i_));     \
      const float wb_ = __builtin_bit_cast(float, __builtin_amdgcn_readlane(__builtin_bit_cast(int, (wv)), (k0) + 2 * i_ + 1)); \
      const float ws_ = hi ? wb_ : wa_;                                                                   \
      const f32x2 w2_ = {ws_, ws_};                                                                       \
      PFV_FMA(R[i_].x, 0, 0)  PFV_FMA(R[i_].x, 1, 1)  PFV_FMA(R[i_].x, 2, 2)  PFV_FMA(R[i_].x, 3, 3)      \
      PFV_FMA(R[i_].y, 0, 4)  PFV_FMA(R[i_].y, 1, 5)  PFV_FMA(R[i_].y, 2, 6)  PFV_FMA(R[i_].y, 3, 7)      \
      PFV_FMA(R[i_].z, 0, 8)  PFV_FMA(R[i_].z, 1, 9)  PFV_FMA(R[i_].z, 2, 10) PFV_FMA(R[i_].z, 3, 11)     \
      PFV_FMA(R[i_].w, 0, 12) PFV_FMA(R[i_].w, 1, 13) PFV_FMA(R[i_].w, 2, 14) PFV_FMA(R[i_].w, 3, 15)     \
    }                                                                                                     \
  }
__device__ void phase_peer_v(const Params& p) {
  unsigned char* ws = p.ws;
  const unsigned* PIDX = (const unsigned*)(ws + WS_PIDX);
  const float* PW = (const float*)(ws + WS_PW);
  const bf16_t* HB = (const bf16_t*)(ws + WS_HB);
  const int tidv = otid();
  const int lane = tidv & 63;
  const bool hi = lane >= 32;
  const unsigned char* V4 = ws + WS_V8 + (lane & 31) * 16;
  const int gw = vblock() * NWAVES + (tidv >> 6), nw = gridDim.x * NWAVES;
  if (gw >= T) return;
  unsigned e0 = PIDX[(size_t)gw * 128 + lane], e1 = PIDX[(size_t)gw * 128 + 64 + lane];
  float w0 = PW[(size_t)gw * 128 + lane], w1 = PW[(size_t)gw * 128 + 64 + lane];
  u32x4 RA[8], RB[8];
  PFV_LOAD(RA, e0, 0)
  {
    unsigned z = __float_as_uint(w1);
#pragma unroll
    for (int i = 0; i < 8; ++i) z |= RA[i].w;
    asm volatile("" ::"v"(z));
  }
  for (int t = gw; t < T; t += nw) {
    const int tn = (t + nw < T) ? t + nw : t;
    const unsigned e0n = PIDX[(size_t)tn * 128 + lane], e1n = PIDX[(size_t)tn * 128 + 64 + lane];
    const float w0n = PW[(size_t)tn * 128 + lane], w1n = PW[(size_t)tn * 128 + 64 + lane];
    const size_t oo = (size_t)t * 1024 + (lane & 31) * 32 + (hi ? 16 : 0);
    const u32x4 hb0 = *(const u32x4*)(HB + oo), hb1 = *(const u32x4*)(HB + oo + 8);
    f32x2 acc[16];
#pragma unroll
    for (int k = 0; k < 16; ++k) acc[k] = (f32x2){0.f, 0.f};
    __builtin_amdgcn_sched_barrier(0);
    PFV_LOAD(RB, e0, 16)  __builtin_amdgcn_sched_barrier(0);  PFV_ACC(RA, w0, 0)
    PFV_LOAD(RA, e0, 32)  __builtin_amdgcn_sched_barrier(0);  PFV_ACC(RB, w0, 16)
    PFV_LOAD(RB, e0, 48)  __builtin_amdgcn_sched_barrier(0);  PFV_ACC(RA, w0, 32)
    PFV_LOAD(RA, e1, 0)   __builtin_amdgcn_sched_barrier(0);  PFV_ACC(RB, w0, 48)
    PFV_LOAD(RB, e1, 16)  __builtin_amdgcn_sched_barrier(0);  PFV_ACC(RA, w1, 0)
    PFV_LOAD(RA, e1, 32)  __builtin_amdgcn_sched_barrier(0);  PFV_ACC(RB, w1, 16)
    PFV_LOAD(RB, e1, 48)  __builtin_amdgcn_sched_barrier(0);  PFV_ACC(RA, w1, 32)
    PFV_LOAD(RA, e0n, 0)  __builtin_amdgcn_sched_barrier(0);  PFV_ACC(RB, w1, 48)
    f32x2 r[8];
#pragma unroll
    for (int k = 0; k < 8; ++k) {
      const f32x2 keep = hi ? acc[8 + k] : acc[k], send = hi ? acc[k] : acc[8 + k];
      r[k] = keep + (f32x2){__shfl_xor(send.x, 32), __shfl_xor(send.y, 32)};
    }
    float* o = p.out + oo;
    *(f32x4*)(o)      = (f32x4){bflo(hb0.x) + r[0].x, bfhi(hb0.x) + r[0].y, bflo(hb0.y) + r[1].x, bfhi(hb0.y) + r[1].y};
    *(f32x4*)(o + 4)  = (f32x4){bflo(hb0.z) + r[2].x, bfhi(hb0.z) + r[2].y, bflo(hb0.w) + r[3].x, bfhi(hb0.w) + r[3].y};
    *(f32x4*)(o + 8)  = (f32x4){bflo(hb1.x) + r[4].x, bfhi(hb1.x) + r[4].y, bflo(hb1.y) + r[5].x, bfhi(hb1.y) + r[5].y};
    *(f32x4*)(o + 12) = (f32x4){bflo(hb1.z) + r[6].x, bfhi(hb1.z) + r[6].y, bflo(hb1.w) + r[7].x, bfhi(hb1.w) + r[7].y};
    e0 = e0n; e1 = e1n; w0 = w0n; w1 = w1n;
  }
}
#undef PFV_LOAD
#undef PFV_FMA
#undef PFV_ACC

#define XB_TMO      128
#define XB_XCNT(j)  (256  + 64 * (j))
#define XB_XSUB(j)  (1280 + 64 * (j))
#define XB_XGEN(j)  (2304 + 64 * (j))
#define XB_TOP      3328
#define XB_TOPGEN   3392
#define XCD_BAR_WORDS 3456
#define XB_SPIN_CAP (1u << 22)
__device__ __forceinline__ unsigned xb_ld(unsigned* p)              { return __hip_atomic_load(p, __ATOMIC_RELAXED, __HIP_MEMORY_SCOPE_AGENT); }
__device__ __forceinline__ unsigned xb_add(unsigned* p, unsigned v) { return __hip_atomic_fetch_add(p, v, __ATOMIC_RELAXED, __HIP_MEMORY_SCOPE_AGENT); }
__device__ __forceinline__ unsigned xb_xcc_id() { return (unsigned)__builtin_amdgcn_s_getreg((3 << 11) | 20) & 0xFu; }
#define XB_SPIN(cond, bar) do { unsigned _sp = 0; while (cond) { __builtin_amdgcn_s_sleep(1); \
    if ((++_sp & 255u) == 0u) { if (xb_ld(&(bar)[XB_TMO])) break; if (_sp > XB_SPIN_CAP) { atomicAdd(&(bar)[XB_TMO], 1u); break; } } } } while (0)
struct XcdBarrier { unsigned* bar; unsigned x; volatile LAS unsigned* st; };
__device__ __forceinline__ XcdBarrier xcd_barrier_post(unsigned* bar, volatile LAS unsigned* st) {
    XcdBarrier b; b.bar = bar; b.x = xb_xcc_id(); b.st = st;
    if (threadIdx.x == 0) (void)xb_add(&bar[XB_XCNT(b.x)], 1u);
    return b;
}
__device__ __forceinline__ void xcd_barrier_complete(unsigned* bar, unsigned x, unsigned& nloc, unsigned& nx) {
    const unsigned G = gridDim.x * gridDim.y * gridDim.z;
    unsigned sum, cnt, mine, sp = 0u;
    for (;;) {
        sum = 0u; cnt = 0u; mine = 0u;
#pragma unroll
        for (unsigned j = 0; j < 16; ++j) { const unsigned c = xb_ld(&bar[XB_XCNT(j)]); sum += c; cnt += (c > 0u) ? 1u : 0u; mine = (j == x) ? c : mine; }
        if (sum == G) break;
        __builtin_amdgcn_s_sleep(1);
        if ((++sp & 255u) == 0u) { if (xb_ld(&bar[XB_TMO])) break; if (sp > XB_SPIN_CAP) { atomicAdd(&bar[XB_TMO], 1u); break; } }
    }
    nloc = mine > 0u ? mine : 1u; nx = cnt > 0u ? cnt : 1u;
}
__device__ __forceinline__ void xcd_barrier(const XcdBarrier& b) {
    asm volatile("s_waitcnt vmcnt(0)" ::: "memory");
    __syncthreads();
    if (threadIdx.x == 0) {
        unsigned* bar = b.bar;
        __builtin_amdgcn_s_waitcnt(0);
        unsigned nloc = b.st[0], nx = b.st[1];
        if (nloc == 0u) { xcd_barrier_complete(bar, b.x, nloc, nx); b.st[0] = nloc; b.st[1] = nx; }
        const unsigned old = xb_add(&bar[XB_XSUB(b.x)], 1u);
        const unsigned gen = old / nloc;
        if (old + 1u == (gen + 1u) * nloc) {
            __builtin_amdgcn_fence(__ATOMIC_RELEASE, "agent");
            asm volatile("s_waitcnt vmcnt(0)" ::: "memory");
            const unsigned og = xb_add(&bar[XB_TOP], 1u);
            const unsigned tg = og / nx;
            if (og + 1u == (tg + 1u) * nx) xb_add(&bar[XB_TOPGEN], 1u);
            else XB_SPIN(xb_ld(&bar[XB_TOPGEN]) == tg, bar);
            __builtin_amdgcn_fence(__ATOMIC_ACQUIRE, "agent");
            xb_add(&bar[XB_XGEN(b.x)], 1u);
            asm volatile("s_waitcnt vmcnt(0)" ::: "memory");
        } else {
            XB_SPIN(xb_ld(&bar[XB_XGEN(b.x)]) == gen, bar);
            __builtin_amdgcn_fence(__ATOMIC_ACQUIRE, "agent");
            asm volatile("s_waitcnt vmcnt(0)" ::: "memory");
        }
    }
    __syncthreads();
}

__global__ void __launch_bounds__(NTHREADS, 2) k_fused(Params p) {
  __shared__ __attribute__((aligned(16))) char smem[LDS_BYTES];
  if (threadIdx.x == 0) *(u32x4*)(smem + LDS_BAR) = (u32x4){0u, 0u, 0u, 0u};
  __syncthreads();
  const XcdBarrier bar = xcd_barrier_post((unsigned*)(p.ws + WS_CTL), (volatile LAS unsigned*)(smem + LDS_BAR));
#ifdef PROBE_PHASE
  unsigned long long ts[12];
#define STAMP(k) ts[k] = __builtin_amdgcn_s_memrealtime();
#else
#define STAMP(k)
#endif
  STAMP(0)
  phase_prep(p);
  xcd_barrier(bar);
  STAMP(1)
  phase_inproj(p, smem);
  xcd_barrier(bar);
  STAMP(2)
  phase_mix(p, smem);
  xcd_barrier(bar);
  STAMP(3)
  phase_outproj(p, smem);
  xcd_barrier(bar);
  STAMP(4)
  phase_qproj(p, smem);
  xcd_barrier(bar);
  STAMP(5)
  phase_route(p, smem);
  xcd_barrier(bar);
  STAMP(6)
  phase_peer_u(p, smem);
  xcd_barrier(bar);
  STAMP(7)
  phase_peer_v(p);
#ifdef PROBE_PHASE
  xcd_barrier(bar);
  STAMP(8)
  if (blockIdx.x == 0 && threadIdx.x == 0) {
    const float us = (float)(ts[PROBE_PHASE + 1] - ts[PROBE_PHASE]) * 0.01f;
    p.out[12345] += us * (1.f / PROBE_DIV);
  }
#endif
}

extern "C" void kernel_launch(void* const* d_in, const int* in_sizes, int n_in, void* d_out, int out_size, void* d_ws, size_t ws_size,
                              hipStream_t stream) {
  if (n_in != 17 || ws_size < WS_END) {
    fprintf(stderr, "kernel_launch: unexpected n_in %d / ws_size %zu\n", n_in, ws_size);
    return;
  }
  Params p{};
  p.x = (const float*)d_in[0]; p.norm_mix_g = (const float*)d_in[1]; p.w_in = (const float*)d_in[2]; p.q_norm_g = (const float*)d_in[3];
  p.k_norm_g = (const float*)d_in[4]; p.attn_out_g = (const float*)d_in[5]; p.conv_w = (const float*)d_in[6]; p.conv_b = (const float*)d_in[7];
  p.conv_ln_g = (const float*)d_in[8]; p.conv_ln_b = (const float*)d_in[9]; p.w_out = (const float*)d_in[10]; p.norm_ffn_g = (const float*)d_in[11];
  p.peer_wq = (const float*)d_in[12]; p.peer_k1 = (const float*)d_in[13]; p.peer_k2 = (const float*)d_in[14]; p.peer_u = (const float*)d_in[15];
  p.peer_v = (const float*)d_in[16];
  p.out = (float*)d_out;
  p.ws = (unsigned char*)d_ws;
  static int grid_blocks = 0;
  if (!grid_blocks) {
    int dev = 0, cus = 0, per_cu = 0;
    (void)hipGetDevice(&dev);
    (void)hipDeviceGetAttribute(&cus, hipDeviceAttributeMultiprocessorCount, dev);
    (void)hipOccupancyMaxActiveBlocksPerMultiprocessor(&per_cu, k_fused, NTHREADS, 0);
    if (per_cu > 1) per_cu = 1;
    if (per_cu < 1) per_cu = 1;
    grid_blocks = cus * per_cu;
  }
  (void)hipMemsetAsync((char*)d_ws + WS_CTL, 0, XCD_BAR_WORDS * 4, stream);
  hipLaunchKernelGGL(k_fused, dim3(grid_blocks), dim3(NTHREADS), 0, stream, p);
}
```

```cpp
#include <hip/hip_runtime.h>
#include <cstdio>

#define LAS __attribute__((address_space(3)))
typedef unsigned short bf16_t;
typedef __bf16 bf16x8 __attribute__((ext_vector_type(8)));
typedef __bf16 bf16x2 __attribute__((ext_vector_type(2)));
typedef float f32x4 __attribute__((ext_vector_type(4)));
typedef float f32x16 __attribute__((ext_vector_type(16)));
typedef unsigned u32x4 __attribute__((ext_vector_type(4)));
typedef unsigned u32x2 __attribute__((ext_vector_type(2)));
typedef float f32x2 __attribute__((ext_vector_type(2)));

constexpr int SEQ = 4096, T = 8 * SEQ, D = 1024, NIN = 2560;
constexpr float EPS = 1e-6f;
constexpr float LOG2E = 1.4426950408889634f;

constexpr size_t MiB = 1u << 20;
constexpr size_t WS_W1 = 0, WS_WV = 4 * MiB, WS_WOUT = 5 * MiB, WS_WQ = 7 * MiB, WS_K1 = 9 * MiB, WS_K2 = 9 * MiB + 131072, WS_SSQ = 10 * MiB;
constexpr size_t WS_CTL = 11 * MiB;
constexpr size_t WS_USV = 11 * MiB + 65536;
constexpr size_t WS_RS1 = 11 * MiB + 196608, WS_SSQ2 = 11 * MiB + 327680;
constexpr size_t WS_U8 = 12 * MiB, WS_V8 = 28 * MiB;
constexpr size_t WS_XB = 44 * MiB;
constexpr size_t WS_Q = 108 * MiB, WS_K = 140 * MiB, WS_VT = 172 * MiB, WS_HG = 204 * MiB, WS_MIX = 236 * MiB;
constexpr size_t WS_HB = 300 * MiB, WS_QH = 364 * MiB;
constexpr size_t WS_XN8 = 108 * MiB, WS_PIDX = 140 * MiB, WS_PG = 156 * MiB, WS_PW = 172 * MiB;
constexpr size_t WS_END = 428 * MiB;

struct Params {
  const float *x, *norm_mix_g, *w_in, *q_norm_g, *k_norm_g, *attn_out_g, *conv_w, *conv_b, *conv_ln_g, *conv_ln_b,
      *w_out, *norm_ffn_g, *peer_wq, *peer_k1, *peer_k2, *peer_u, *peer_v;
  float* out;
  unsigned char* ws;
};

constexpr int NTHREADS = 512, NWAVES = 8;
constexpr int LDS_STAGE = 131072, LDS_BAR = LDS_STAGE, LDS_BYTES = LDS_STAGE + 16;

__device__ __forceinline__ unsigned pk2(float lo, float hi) {
  bf16x2 v = {(__bf16)lo, (__bf16)hi};
  return __builtin_bit_cast(unsigned, v);
}
__device__ __forceinline__ float bflo(unsigned u) { return __uint_as_float(u << 16); }
__device__ __forceinline__ float bfhi(unsigned u) { return __uint_as_float(u & 0xffff0000u); }
__device__ __forceinline__ int otid() { int t = threadIdx.x; asm volatile("" : "+v"(t)); return t; }
__device__ __forceinline__ int vblock() {
  const int G = gridDim.x, b = blockIdx.x;
  return (G % 8 == 0) ? (b % 8) * (G / 8) + b / 8 : b;
}
__device__ __forceinline__ f32x16 mfma32(bf16x8 a, bf16x8 b, f32x16 c) { return __builtin_amdgcn_mfma_f32_32x32x16_bf16(a, b, c, 0, 0, 0); }

__device__ __forceinline__ int w1_src(int n) {
  if (n < 1024) {
    const int kind = n >> 9, rel = n & 511, pn = rel >> 8, P = rel & 255, bj = P >> 7, wc = (P >> 5) & 3, x = P & 31;
    return kind * 512 + (4 * pn + wc) * 64 + 32 * bj + x;
  }
  const int rel = n - 1024, pn = rel >> 8, P = rel & 255, bj = P >> 7, wc = (P >> 5) & 3, x = P & 31;
  return (bj ? 2048 : 1536) + 128 * pn + 32 * wc + x;
}
__device__ __forceinline__ void transpose_items(const float* __restrict__ W, int ldw, int N, bf16_t* __restrict__ Wt, const float* __restrict__ g, int glimit,
                                                int mode, long gtid, long nthr) {
  const long nitems = (long)N * 128;
  for (long it = gtid; it < nitems; it += nthr) {
    const int n = (int)(it % N), kc = (int)(it / N);
    const int src = mode == 1 ? w1_src(n) : (mode == 2 ? 1024 + n : n);
    float v[8];
#pragma unroll
    for (int i = 0; i < 8; ++i) {
      const int k = kc * 8 + i;
      float w = W[(size_t)k * ldw + src];
      if (k < glimit) w *= g[k];
      v[i] = w;
    }
    u32x4 o = {pk2(v[0], v[1]), pk2(v[2], v[3]), pk2(v[4], v[5]), pk2(v[6], v[7])};
    *(u32x4*)(Wt + (size_t)n * 1024 + kc * 8) = o;
  }
}
__device__ __forceinline__ void convert_items(const float* __restrict__ src, bf16_t* __restrict__ dst, long n8, long gtid, long nthr) {
  for (long it = gtid; it < n8; it += nthr) {
    const f32x4 a = *(const f32x4*)(src + it * 8), b = *(const f32x4*)(src + it * 8 + 4);
    u32x4 o = {pk2(a.x, a.y), pk2(a.z, a.w), pk2(b.x, b.y), pk2(b.z, b.w)};
    *(u32x4*)(dst + it * 8) = o;
  }
}
__device__ void phase_prep(const Params& p) {
  const int tid0 = otid();
  const long gtid = (long)vblock() * NTHREADS + tid0, nthr = (long)gridDim.x * NTHREADS;
  unsigned char* ws = p.ws;
  transpose_items(p.w_in, NIN, 2048, (bf16_t*)(ws + WS_W1), p.norm_mix_g, 1024, 1, gtid, nthr);
  transpose_items(p.w_in, NIN, 512, (bf16_t*)(ws + WS_WV), p.norm_mix_g, 1024, 2, gtid, nthr);
  transpose_items(p.w_out, D, D, (bf16_t*)(ws + WS_WOUT), p.attn_out_g, 512, 0, gtid, nthr);
  transpose_items(p.peer_wq, D, D, (bf16_t*)(ws + WS_WQ), p.norm_ffn_g, 1024, 0, gtid, nthr);
  convert_items(p.peer_k1, (bf16_t*)(ws + WS_K1), 65536 / 8, gtid, nthr);
  convert_items(p.peer_k2, (bf16_t*)(ws + WS_K2), 65536 / 8, gtid, nthr);
  const int lane = tid0 & 63, gw = vblock() * NWAVES + (tid0 >> 6), nw = gridDim.x * NWAVES;
  {
    bf16_t* XB = (bf16_t*)(ws + WS_XB);
    float* RS1 = (float*)(ws + WS_RS1);
    float* SSQ2 = (float*)(ws + WS_SSQ2);
    for (int tb = gw; tb < T; tb += 2 * nw) {
      f32x4 v[2][4];
      float ss[2] = {0.f, 0.f};
#pragma unroll
      for (int u = 0; u < 2; ++u) {
        const int t = (tb + u * nw < T) ? tb + u * nw : tb;
        const float* src = p.x + (size_t)t * 1024 + lane * 4;
#pragma unroll
        for (int i = 0; i < 4; ++i) v[u][i] = *(const f32x4*)(src + 256 * i);
      }
#pragma unroll
      for (int u = 0; u < 2; ++u) {
#pragma unroll
        for (int i = 0; i < 4; ++i) ss[u] += v[u][i].x * v[u][i].x + v[u][i].y * v[u][i].y + v[u][i].z * v[u][i].z + v[u][i].w * v[u][i].w;
      }
#pragma unroll
      for (int o = 1; o < 64; o <<= 1) { ss[0] += __shfl_xor(ss[0], o); ss[1] += __shfl_xor(ss[1], o); }
#pragma unroll
      for (int u = 0; u < 2; ++u) {
        const int t = tb + u * nw;
        if (t < T) {
#pragma unroll
          for (int i = 0; i < 4; ++i) *(u32x2*)(XB + (size_t)t * 1024 + lane * 4 + 256 * i) = (u32x2){pk2(v[u][i].x, v[u][i].y), pk2(v[u][i].z, v[u][i].w)};
          if (lane == 0) { RS1[t] = rsqrtf(ss[u] * (1.f / 1024.f) + EPS); SSQ2[t] = 0.f; }
        }
      }
    }
  }
  {
    for (int rb = gw; rb < 32768; rb += 2 * nw) {
      f32x4 v[2][4];
#pragma unroll
      for (int u = 0; u < 2; ++u) {
        const int r = (rb + u * nw < 32768) ? rb + u * nw : rb;
        const float* src = ((r >> 14) ? p.peer_v : p.peer_u) + (size_t)(r & 16383) * 1024 + lane * 16;
#pragma unroll
        for (int i = 0; i < 4; ++i) v[u][i] = *(const f32x4*)(src + 4 * i);
      }
      float am[2] = {0.f, 0.f};
#pragma unroll
      for (int u = 0; u < 2; ++u)
#pragma unroll
        for (int i = 0; i < 4; ++i)
          am[u] = fmaxf(am[u], fmaxf(fmaxf(fabsf(v[u][i].x), fabsf(v[u][i].y)), fmaxf(fabsf(v[u][i].z), fabsf(v[u][i].w))));
#pragma unroll
      for (int o = 1; o < 64; o <<= 1) { am[0] = fmaxf(am[0], __shfl_xor(am[0], o)); am[1] = fmaxf(am[1], __shfl_xor(am[1], o)); }
#pragma unroll
      for (int u = 0; u < 2; ++u) {
        const int r = rb + u * nw;
        if (r < 32768) {
          const int isv = r >> 14, e = r & 16383;
          const float scale = am[u] > 0.f ? am[u] * (1.f / 6.f) : 1.f, inv = am[u] > 0.f ? 6.f / am[u] : 0.f;
          unsigned q[2] = {0u, 0u};
#pragma unroll
          for (int i = 0; i < 4; ++i)
#pragma unroll
            for (int j = 0; j < 4; ++j) {
              const float xv = v[u][i][j], m = fabsf(xv) * inv;
              const unsigned code = (unsigned)(m > 0.25f) + (unsigned)(m > 0.75f) + (unsigned)(m > 1.25f) + (unsigned)(m > 1.75f) +
                                    (unsigned)(m > 2.5f) + (unsigned)(m > 3.5f) + (unsigned)(m > 5.0f);
              const unsigned nib = code | (xv < 0.f ? 8u : 0u);
              const int el = 4 * i + j;
              q[el >> 3] |= nib << (4 * (el & 7));
            }
          if (isv) {
            *(u32x2*)(ws + WS_V8 + (size_t)e * 512 + lane * 8) = (u32x2){q[0], q[1]};
            if (lane == 0) ((float*)(ws + WS_USV))[2 * e + 1] = scale;
          } else {
            *(u32x2*)(ws + WS_U8 + (size_t)e * 512 + lane * 8) = (u32x2){q[0], q[1]};
            if (lane == 0) ((float*)(ws + WS_USV))[2 * e] = scale;
          }
        }
      }
    }
  }
}

namespace pg8 {
typedef short sbf16x8 __attribute__((ext_vector_type(8)));
constexpr int BM = 256, BK = 64, HALF = 128, HTB = HALF * BK * 2  , NXCD = 8, WGM = 8;
__device__ __forceinline__ int lds_byte(int r, int c) { const int st = (r >> 4) * 2 + (c >> 5), rr = r & 15, cc = c & 31, ob = rr * 64 + cc * 2; return st * 1024 + (ob ^ (((ob >> 9) & 1) << 5)); }
__device__ __forceinline__ void stage_rc(int b, int& R, int& C) { const int st = b / 1024, sb = b % 1024, swz = sb ^ (((sb >> 9) & 1) << 5); R = (st >> 1) * 16 + swz / 64; C = (st & 1) * 32 + (swz % 64) / 2; }
__device__ __forceinline__ int perm32(int rho) { const int n = rho >> 4, i = rho & 15; return 8 * (i >> 2) + 4 * n + (i & 3); }
struct Unit { int pm, pn; };
struct Gemm { const bf16_t* A; const bf16_t* Bt; int M, N, K; };
struct StaticOrder {
    int nM, nN, nwg, G, c;
    __device__ void init(int M, int N, int G_, int c_) { nM = M / BM; nN = N / BM; nwg = nM * nN; G = G_; c = c_; }
    __device__ bool next(int i, Unit& u) const {
        const long L = (long)i * G + c; if (L >= nwg) return false;
        int wgid = (int)L; { const int q = nwg / NXCD, r = nwg % NXCD, xcd = wgid % NXCD, off = wgid / NXCD; wgid = (xcd < r ? xcd * (q + 1) : r * (q + 1) + (xcd - r) * q) + off; }
        const int nig = WGM * nN, gid = wgid / nig, fm = gid * WGM, gsz = (nM - fm) < WGM ? (nM - fm) : WGM;
        u.pm = fm + ((wgid % nig) % gsz); u.pn = (wgid % nig) / gsz; return true;
    }
};
template <class Epi>
__device__ __forceinline__ void gemm_phase(LAS unsigned char* lds, const Gemm g, const StaticOrder& S, const Epi& E) {
    const int tid = otid(), wid = __builtin_amdgcn_readfirstlane(tid >> 6), lane = tid & 63, wr = wid >> 2, wc = wid & 3, fr = lane & 15, fq = lane >> 4;
    const int K = g.K, nt = K / BK;
    unsigned voffA[2], voffB[2];
#pragma unroll
    for (int i = 0; i < 2; ++i) { int R, C; stage_rc(tid * 16 + i * 8192, R, C); const int Rb = Epi::PERM ? ((R & ~31) + perm32(R & 31)) : R;
        voffA[i] = (unsigned)(R * K + C) * 2u; voffB[i] = (unsigned)(Rb * K + C) * 2u; }
    const size_t kstep = (size_t)(BK * 2);
    const size_t hstep = (size_t)HALF * K * 2;
    const size_t tstep = 2 * hstep;
    const unsigned ldsw = (unsigned)wid * 1024u;
    const int aoff = lds_byte(wr * 64 + fr, fq * 8), boff = lds_byte(wc * 32 + fr, fq * 8);
#define PG8_SA(b, h) (((b) * 2 + (h)) * HTB)
#define PG8_SB(b, h) ((4 + (b) * 2 + (h)) * HTB)
#define PG8_STAGE(bufoff, gbase, voff) do { _Pragma("unroll") for (int _i = 0; _i < 2; ++_i) \
        __builtin_amdgcn_global_load_lds((const unsigned*)((const char*)(gbase) + (voff)[_i]), (LAS unsigned*)(lds + (bufoff) + ldsw + _i * 8192), 16, 0, 0); } while (0)
#define PG8_LDA(dst, b, h) do { _Pragma("unroll") for (int m = 0; m < 4; ++m) _Pragma("unroll") for (int k = 0; k < 2; ++k) dst[m][k] = *(const LAS sbf16x8*)(lds + PG8_SA(b, h) + aoff + m * 2048 + k * 1024); } while (0)
#define PG8_LDB(dst, b, h) do { _Pragma("unroll") for (int n = 0; n < 2; ++n) _Pragma("unroll") for (int k = 0; k < 2; ++k) dst[n][k] = *(const LAS sbf16x8*)(lds + PG8_SB(b, h) + boff + n * 2048 + k * 1024); } while (0)
#define PG8_MMA(ai, bj, At, Bt) do { __builtin_amdgcn_s_setprio(1); _Pragma("unroll") for (int m = 0; m < 4; ++m) _Pragma("unroll") for (int n = 0; n < 2; ++n) _Pragma("unroll") for (int k = 0; k < 2; ++k) \
        acc[ai][bj][m][n] = __builtin_amdgcn_mfma_f32_16x16x32_bf16(__builtin_bit_cast(bf16x8, Bt[n][k]), __builtin_bit_cast(bf16x8, At[m][k]), acc[ai][bj][m][n], 0, 0, 0); __builtin_amdgcn_s_setprio(0); } while (0)
#define PG8_WAIT_V(n) asm volatile("s_waitcnt vmcnt(" #n ")" ::: "memory")
#define PG8_WAIT_L(n) asm volatile("s_waitcnt lgkmcnt(" #n ")" ::: "memory")
#define PG8_BAR __builtin_amdgcn_s_barrier()
#define PG8_SCHED __builtin_amdgcn_sched_barrier(0)
    Unit cur, nxt; int ui = 0;
    if (!S.next(0, cur)) return;
    f32x4 acc[2][2][4][2];
#pragma unroll
    for (int a = 0; a < 2; ++a)
#pragma unroll
        for (int b = 0; b < 2; ++b)
#pragma unroll
            for (int m = 0; m < 4; ++m)
#pragma unroll
                for (int n = 0; n < 2; ++n) acc[a][b][m][n] = (f32x4){0.f, 0.f, 0.f, 0.f};
    sbf16x8 At[4][2], B0[2][2], B1[2][2];
    const char* cA = (const char*)g.A + (size_t)cur.pm * tstep; const char* cB = (const char*)g.Bt + (size_t)cur.pn * tstep;
    PG8_STAGE(PG8_SB(0, 0), cB, voffB); PG8_STAGE(PG8_SA(0, 0), cA, voffA); PG8_STAGE(PG8_SB(0, 1), cB + hstep, voffB); PG8_STAGE(PG8_SA(0, 1), cA + hstep, voffA);
    if (wr == 1) PG8_BAR;
    PG8_WAIT_V(4); PG8_BAR;
    PG8_STAGE(PG8_SB(1, 0), cB + kstep, voffB); PG8_STAGE(PG8_SA(1, 0), cA + kstep, voffA); PG8_STAGE(PG8_SB(1, 1), cB + hstep + kstep, voffB);
    PG8_WAIT_V(6); PG8_BAR;
    for (;;) {
        const bool has_next = S.next(ui + 1, nxt);
        const char* nA = has_next ? (const char*)g.A + (size_t)nxt.pm * tstep : cA; const char* nB = has_next ? (const char*)g.Bt + (size_t)nxt.pn * tstep : cB;
        for (int t = 0; t < nt; t += 2) {
            const bool last = (t == nt - 2);
            const char* a1 = cA + (size_t)(t + 1) * kstep;
            const char* a2 = last ? nA : cA + (size_t)(t + 2) * kstep; const char* b2 = last ? nB : cB + (size_t)(t + 2) * kstep;
            const char* a3 = a2 + kstep; const char* b3 = b2 + kstep;
            PG8_LDB(B0, 0, 0); PG8_SCHED; PG8_LDA(At, 0, 0); PG8_STAGE(PG8_SA(1, 1), a1 + hstep, voffA);
            PG8_WAIT_L(8); PG8_BAR; PG8_WAIT_L(0); PG8_MMA(0, 0, At, B0); PG8_BAR; PG8_SCHED;
            PG8_LDB(B1, 0, 1); PG8_STAGE(PG8_SB(0, 0), b2, voffB);
            PG8_BAR; PG8_WAIT_L(0); PG8_MMA(0, 1, At, B1); PG8_BAR;
            PG8_LDA(At, 0, 1); PG8_STAGE(PG8_SA(0, 0), a2, voffA);
            PG8_BAR; PG8_WAIT_L(0); PG8_MMA(1, 0, At, B0); PG8_BAR; PG8_SCHED;
            PG8_STAGE(PG8_SB(0, 1), b2 + hstep, voffB);
            PG8_WAIT_V(6); PG8_BAR; PG8_MMA(1, 1, At, B1); PG8_BAR;
            PG8_LDB(B0, 1, 0); PG8_SCHED; PG8_LDA(At, 1, 0); PG8_STAGE(PG8_SA(0, 1), a2 + hstep, voffA);
            PG8_WAIT_L(8); PG8_BAR; PG8_WAIT_L(0); PG8_MMA(0, 0, At, B0); PG8_BAR; PG8_SCHED;
            PG8_LDB(B1, 1, 1); PG8_STAGE(PG8_SB(1, 0), b3, voffB);
            PG8_BAR; PG8_WAIT_L(0); PG8_MMA(0, 1, At, B1); PG8_BAR;
            PG8_LDA(At, 1, 1); PG8_STAGE(PG8_SA(1, 0), a3, voffA);
            PG8_BAR; PG8_WAIT_L(0); PG8_MMA(1, 0, At, B0); PG8_BAR; PG8_SCHED;
            PG8_STAGE(PG8_SB(1, 1), b3 + hstep, voffB);
            PG8_WAIT_V(6); PG8_BAR; PG8_MMA(1, 1, At, B1); PG8_BAR;
        }
        E(acc, cur, wr, wc, fr, fq);
        if (!has_next) break;
#pragma unroll
        for (int a = 0; a < 2; ++a)
#pragma unroll
            for (int b = 0; b < 2; ++b)
#pragma unroll
                for (int m = 0; m < 4; ++m)
#pragma unroll
                    for (int n = 0; n < 2; ++n) acc[a][b][m][n] = (f32x4){0.f, 0.f, 0.f, 0.f};
        cur = nxt; cA = nA; cB = nB; ++ui;
    }
    PG8_WAIT_V(0);
    if (wr == 0) PG8_BAR;
    PG8_BAR;
#undef PG8_SA
#undef PG8_SB
#undef PG8_STAGE
#undef PG8_LDA
#undef PG8_LDB
#undef PG8_MMA
#undef PG8_WAIT_V
#undef PG8_WAIT_L
#undef PG8_BAR
#undef PG8_SCHED
}
}

struct EpiQKC {
  static constexpr bool PERM = true;
  const float* rs1; const float* qg; const float* kg; bf16_t* Q; bf16_t* Kk; bf16_t* HG;
  __device__ __forceinline__ void operator()(const f32x4 (&acc)[2][2][4][2], const pg8::Unit& u, int wr, int wc, int fr, int fq) const {
    const int row0 = u.pm * 256 + wr * 64 + fr;
    if (u.pn < 4) {
      const bool isq = u.pn < 2;
      const int head = 4 * (u.pn & 1) + wc;
      const float* g = isq ? qg : kg;
      f32x4 gv[2][2];
#pragma unroll
      for (int bj = 0; bj < 2; ++bj)
#pragma unroll
        for (int n = 0; n < 2; ++n) gv[bj][n] = *(const f32x4*)(g + 32 * bj + 8 * fq + 4 * n);
      bf16_t* base = isq ? Q : Kk;
#pragma unroll
      for (int ai = 0; ai < 2; ++ai)
#pragma unroll
        for (int m = 0; m < 4; ++m) {
          const int t = row0 + ai * 128 + m * 16;
          float ss = 0.f;
#pragma unroll
          for (int bj = 0; bj < 2; ++bj)
#pragma unroll
            for (int n = 0; n < 2; ++n) { const f32x4 v = acc[ai][bj][m][n]; ss += v.x * v.x + v.y * v.y + v.z * v.z + v.w * v.w; }
          ss += __shfl_xor(ss, 16);
          ss += __shfl_xor(ss, 32);
          const float r = rs1[t];
          float sc = r * rsqrtf(r * r * ss * (1.f / 64.f) + EPS);
          if (isq) sc *= 0.125f * LOG2E;
          bf16_t* dst = base + ((size_t)((t >> 12) * 8 + head) * 4096 + (t & 4095)) * 64 + 8 * fq;
#pragma unroll
          for (int bj = 0; bj < 2; ++bj) {
            const f32x4 a = acc[ai][bj][m][0] * gv[bj][0] * sc, b = acc[ai][bj][m][1] * gv[bj][1] * sc;
            *(u32x4*)(dst + 32 * bj) = (u32x4){pk2(a.x, a.y), pk2(a.z, a.w), pk2(b.x, b.y), pk2(b.z, b.w)};
          }
        }
    } else {
      const int ch0 = 128 * (u.pn - 4) + 32 * wc + 8 * fq;
#pragma unroll
      for (int ai = 0; ai < 2; ++ai)
#pragma unroll
        for (int m = 0; m < 4; ++m) {
          const int t = row0 + ai * 128 + m * 16;
          const float r = rs1[t];
          float h[8];
#pragma unroll
          for (int n = 0; n < 2; ++n)
#pragma unroll
            for (int j = 0; j < 4; ++j) h[4 * n + j] = acc[ai][0][m][n][j] * r / (1.f + __expf(-acc[ai][1][m][n][j] * r));
          *(u32x4*)(HG + (size_t)t * 512 + ch0) = (u32x4){pk2(h[0], h[1]), pk2(h[2], h[3]), pk2(h[4], h[5]), pk2(h[6], h[7])};
        }
    }
  }
};
struct EpiVt {
  static constexpr bool PERM = false;
  const float* rs1; bf16_t* Vt;
  __device__ __forceinline__ void operator()(const f32x4 (&acc)[2][2][4][2], const pg8::Unit& u, int wr, int wc, int fr, int fq) const {
    const int pos0 = 8 * (fq & 1) + 4 * (fq >> 1);
#pragma unroll
    for (int bj = 0; bj < 2; ++bj)
#pragma unroll
      for (int n = 0; n < 2; ++n) {
        const int t = u.pn * 256 + bj * 128 + wc * 32 + n * 16 + 4 * fq;
        const f32x4 r = *(const f32x4*)(rs1 + t);
        const size_t tb = ((size_t)(t >> 12) * 8) * 128 + ((t & 4095) >> 5);
#pragma unroll
        for (int ai = 0; ai < 2; ++ai)
#pragma unroll
          for (int m = 0; m < 4; ++m) {
            const int dg = u.pm * 256 + ai * 128 + wr * 64 + m * 16 + fr, head = dg >> 6, d = dg & 63;
            const f32x4 v = acc[ai][bj][m][n] * r;
            *(u32x2*)(Vt + ((tb + (size_t)head * 128) * 64 + d) * 32 + 16 * n + pos0) = (u32x2){pk2(v.x, v.y), pk2(v.z, v.w)};
          }
      }
  }
};
struct EpiOut {
  static constexpr bool PERM = false;
  const bf16_t* xb; bf16_t* HB; float* ssq2;
  __device__ __forceinline__ void operator()(const f32x4 (&acc)[2][2][4][2], const pg8::Unit& u, int wr, int wc, int fr, int fq) const {
    const int row0 = u.pm * 256 + wr * 64 + fr, col0 = u.pn * 256 + wc * 32 + 4 * fq;
#pragma unroll
    for (int ai = 0; ai < 2; ++ai)
#pragma unroll
      for (int m = 0; m < 4; ++m) {
        const int t = row0 + ai * 128 + m * 16;
        const size_t ro = (size_t)t * 1024 + col0;
        float ss = 0.f;
#pragma unroll
        for (int bj = 0; bj < 2; ++bj)
#pragma unroll
          for (int n = 0; n < 2; ++n) {
            const size_t o = ro + bj * 128 + n * 16;
            const u32x2 xv = *(const u32x2*)(xb + o);
            const f32x4 h = (f32x4){bflo(xv.x), bfhi(xv.x), bflo(xv.y), bfhi(xv.y)} + acc[ai][bj][m][n];
            *(u32x2*)(HB + o) = (u32x2){pk2(h.x, h.y), pk2(h.z, h.w)};
            ss += h.x * h.x + h.y * h.y + h.z * h.z + h.w * h.w;
          }
        ss += __shfl_xor(ss, 16);
        ss += __shfl_xor(ss, 32);
        if (fq == 0) atomicAdd(ssq2 + t, ss);
      }
  }
};
struct EpiQh {
  static constexpr bool PERM = true;
  const float* ssq2; bf16_t* QH;
  __device__ __forceinline__ void operator()(const f32x4 (&acc)[2][2][4][2], const pg8::Unit& u, int wr, int wc, int fr, int fq) const {
    const int row0 = u.pm * 256 + wr * 64 + fr, col0 = u.pn * 256 + wc * 32 + 8 * fq;
#pragma unroll
    for (int ai = 0; ai < 2; ++ai)
#pragma unroll
      for (int m = 0; m < 4; ++m) {
        const int t = row0 + ai * 128 + m * 16;
        const float r = rsqrtf(ssq2[t] * (1.f / 1024.f) + EPS);
#pragma unroll
        for (int bj = 0; bj < 2; ++bj) {
          const f32x4 a = acc[ai][bj][m][0] * r, b = acc[ai][bj][m][1] * r;
          *(u32x4*)(QH + (size_t)t * 1024 + col0 + bj * 128) = (u32x4){pk2(a.x, a.y), pk2(a.z, a.w), pk2(b.x, b.y), pk2(b.z, b.w)};
        }
      }
  }
};

__device__ void phase_inproj(const Params& p, char* smem) {
  unsigned char* ws = p.ws;
  LAS unsigned char* lds = (LAS unsigned char*)smem;
  const bf16_t* XB = (const bf16_t*)(ws + WS_XB);
  const float* RS1 = (const float*)(ws + WS_RS1);
  pg8::StaticOrder S;
  {
    pg8::Gemm g{XB, (const bf16_t*)(ws + WS_W1), T, 2048, 1024};
    S.init(T, 2048, gridDim.x, blockIdx.x);
    EpiQKC E{RS1, p.q_norm_g, p.k_norm_g, (bf16_t*)(ws + WS_Q), (bf16_t*)(ws + WS_K), (bf16_t*)(ws + WS_HG)};
    pg8::gemm_phase<EpiQKC>(lds, g, S, E);
  }
  {
    pg8::Gemm g{(const bf16_t*)(ws + WS_WV), XB, 512, T, 1024};
    S.init(512, T, gridDim.x, blockIdx.x);
    EpiVt E{RS1, (bf16_t*)(ws + WS_VT)};
    pg8::gemm_phase<EpiVt>(lds, g, S, E);
  }
}
__device__ void phase_outproj(const Params& p, char* smem) {
  unsigned char* ws = p.ws;
  pg8::Gemm g{(const bf16_t*)(ws + WS_MIX), (const bf16_t*)(ws + WS_WOUT), T, 1024, 1024};
  pg8::StaticOrder S;
  S.init(T, 1024, gridDim.x, blockIdx.x);
  EpiOut E{(const bf16_t*)(ws + WS_XB), (bf16_t*)(ws + WS_HB), (float*)(ws + WS_SSQ2)};
  pg8::gemm_phase<EpiOut>((LAS unsigned char*)smem, g, S, E);
}
__device__ void phase_qproj(const Params& p, char* smem) {
  unsigned char* ws = p.ws;
  pg8::Gemm g{(const bf16_t*)(ws + WS_HB), (const bf16_t*)(ws + WS_WQ), T, 1024, 1024};
  pg8::StaticOrder S;
  S.init(T, 1024, gridDim.x, blockIdx.x);
  EpiQh E{(const float*)(ws + WS_SSQ2), (bf16_t*)(ws + WS_QH)};
  pg8::gemm_phase<EpiQh>((LAS unsigned char*)smem, g, S, E);
}

__device__ void conv_item(const Params& p, int item, char* smem) {
  unsigned char* ws = p.ws;
  const bf16_t* HG = (const bf16_t*)(ws + WS_HG);
  bf16_t* MIX = (bf16_t*)(ws + WS_MIX);
  const int tid512 = otid(), half = tid512 >> 8, tid = tid512 & 255, lane = tid & 63, wave = tid >> 6;
  const int t0 = item * 32, s0 = t0 & 4095;
  for (int idx = tid512; idx < 62 * 64; idx += NTHREADS) {
    const int r = idx >> 6, c16 = idx & 63;
    u32x4 v = {0u, 0u, 0u, 0u};
    if (s0 - 30 + r >= 0) v = *(const u32x4*)(HG + (size_t)(t0 - 30 + r) * 512 + c16 * 8);
    *(u32x4*)(smem + r * 1024 + c16 * 16) = v;
  }
  f32x2 wv[31];
#pragma unroll
  for (int j = 0; j < 31; ++j) {
    const float2 w = *(const float2*)(p.conv_w + j * 512 + 2 * tid);
    wv[j] = (f32x2){w.x, w.y};
  }
  const float2 cb = *(const float2*)(p.conv_b + 2 * tid);
  const float2 lg = *(const float2*)(p.conv_ln_g + 2 * tid);
  const float2 lb = *(const float2*)(p.conv_ln_b + 2 * tid);
  float* red = (float*)(smem + 62 * 1024) + half * 128;
  __syncthreads();
  const bool b5 = lane & 32, b4 = lane & 16, b3 = lane & 8, b2 = lane & 4;
#pragma unroll 1
  for (int rd = 0; rd < 2; ++rd) {
    const int tb = 16 * half + 8 * rd;
    f32x2 xv[38];
#pragma unroll
    for (int r = 0; r < 38; ++r) {
      const unsigned v = *(const unsigned*)(smem + (tb + r) * 1024 + tid * 4);
      xv[r] = (f32x2){bflo(v), bfhi(v)};
    }
    float a0[8], a1[8], st[16];
#pragma unroll
    for (int k = 0; k < 8; ++k) {
      f32x2 u = {cb.x, cb.y};
#pragma unroll
      for (int j = 0; j < 31; ++j) u = __builtin_elementwise_fma(wv[j], xv[k + j], u);
      a0[k] = u.x; a1[k] = u.y;
      st[k] = u.x + u.y;
      st[8 + k] = u.x * u.x + u.y * u.y;
    }
    float r8[8], r4[4], r2[2], r1;
#pragma unroll
    for (int i = 0; i < 8; ++i) { const float keep = b5 ? st[8 + i] : st[i], send = b5 ? st[i] : st[8 + i]; r8[i] = keep + __shfl_xor(send, 32); }
#pragma unroll
    for (int i = 0; i < 4; ++i) { const float keep = b4 ? r8[4 + i] : r8[i], send = b4 ? r8[i] : r8[4 + i]; r4[i] = keep + __shfl_xor(send, 16); }
#pragma unroll
    for (int i = 0; i < 2; ++i) { const float keep = b3 ? r4[2 + i] : r4[i], send = b3 ? r4[i] : r4[2 + i]; r2[i] = keep + __shfl_xor(send, 8); }
    { const float keep = b2 ? r2[1] : r2[0], send = b2 ? r2[0] : r2[1]; r1 = keep + __shfl_xor(send, 4); }
    r1 += __shfl_xor(r1, 2);
    r1 += __shfl_xor(r1, 1);
    float* rr = red + rd * 64;
    if ((lane & 3) == 0) rr[wave * 16 + (lane >> 2)] = r1;
    __syncthreads();
#pragma unroll
    for (int k = 0; k < 8; ++k) {
      const float S1 = (rr[k] + rr[16 + k]) + (rr[32 + k] + rr[48 + k]);
      const float S2 = (rr[8 + k] + rr[24 + k]) + (rr[40 + k] + rr[56 + k]);
      const float mu = S1 * (1.f / 512.f);
      const float var = fmaxf(S2 * (1.f / 512.f) - mu * mu, 0.f);
      const float rstd = rsqrtf(var + EPS);
      const float y0 = (a0[k] - mu) * rstd * lg.x + lb.x, y1 = (a1[k] - mu) * rstd * lg.y + lb.y;
      const float z0 = y0 / (1.f + __expf(-y0)), z1 = y1 / (1.f + __expf(-y1));
      *(unsigned*)(MIX + (size_t)(t0 + tb + k) * 1024 + 512 + 2 * tid) = pk2(z0, z1);
    }
  }
  __syncthreads();
}

struct AttnKV { bf16x8 k[4]; bf16x8 v[2][2]; };
__device__ __forceinline__ void attn_load(const bf16_t* Km, const bf16_t* Vt, int bh, int kb, int tok, int hf, AttnKV& f) {
  const int kc = kb < 0 ? 0 : kb;
  const bf16_t* kp = Km + ((size_t)bh * 4096 + kc * 32 + tok) * 64 + 8 * hf;
#pragma unroll
  for (int ks = 0; ks < 4; ++ks) f.k[ks] = *(const bf16x8*)(kp + ks * 16);
  const bf16_t* vp = Vt + (((size_t)bh * 128 + kc) * 64 + tok) * 32 + hf * 8;
#pragma unroll
  for (int m = 0; m < 2; ++m)
#pragma unroll
    for (int s = 0; s < 2; ++s) f.v[m][s] = *(const bf16x8*)(vp + m * 1024 + s * 16);
}
__device__ __forceinline__ bool attn_block(const AttnKV& f, const bf16x8 (&qf)[4], bool diag, int tok, int hf, float& c, f32x16& o0, f32x16& o1) {
  f32x16 sc;
#pragma unroll
  for (int i = 0; i < 16; ++i) sc[i] = 0.f;
#pragma unroll
  for (int ks = 0; ks < 4; ++ks) sc = mfma32(f.k[ks], qf[ks], sc);
  float lk[16], zs[16];
#pragma unroll
  for (int i = 0; i < 16; ++i) {
    const float zl = sc[i];
    const float e = __builtin_amdgcn_exp2f(zl);
    const float sp = __builtin_amdgcn_logf(1.f + e);
    const bool valid = !diag || ((i & 3) + 8 * (i >> 2) + 4 * hf < tok);
    lk[i] = valid ? -sp : 0.f;
    zs[i] = valid ? zl - sp : -1e30f;
  }
  float Tg[4], Pg[4];
#pragma unroll
  for (int g = 0; g < 4; ++g) {
    Tg[g] = (lk[4 * g] + lk[4 * g + 1]) + (lk[4 * g + 2] + lk[4 * g + 3]);
    Pg[g] = __shfl_xor(Tg[g], 32);
  }
  float base[4];
  float run = 0.f;
#pragma unroll
  for (int g = 3; g >= 0; --g) {
    base[g] = c + run + (hf == 0 ? Pg[g] : 0.f);
    run += Tg[g] + Pg[g];
  }
  float pr[16];
#pragma unroll
  for (int g = 0; g < 4; ++g) {
    float l = base[g];
#pragma unroll
    for (int r = 3; r >= 0; --r) {
      pr[4 * g + r] = __builtin_amdgcn_exp2f(zs[4 * g + r] + l);
      l += lk[4 * g + r];
    }
  }
  c += run;
  bf16x8 pf[2];
#pragma unroll
  for (int s = 0; s < 2; ++s)
#pragma unroll
    for (int j = 0; j < 8; ++j) pf[s][j] = (__bf16)pr[8 * s + j];
#pragma unroll
  for (int s = 0; s < 2; ++s) {
    o0 = mfma32(f.v[0][s], pf[s], o0);
    o1 = mfma32(f.v[1][s], pf[s], o1);
  }
  return __all(c < -150.f);
}
__device__ void attn_tile(const Params& p, int item, int it, int lane, int wave, char* smem) {
  unsigned char* ws = p.ws;
  const bf16_t* Qm = (const bf16_t*)(ws + WS_Q);
  const bf16_t* Km = (const bf16_t*)(ws + WS_K);
  const bf16_t* Vt = (const bf16_t*)(ws + WS_VT);
  bf16_t* MIX = (bf16_t*)(ws + WS_MIX);
  const int qt = item & 127, bh = (item >> 7) * 8 + wave;
  const int tok = lane & 31, hf = lane >> 5;
  bf16x8 qf[4];
  {
    const bf16_t* qp = Qm + ((size_t)bh * 4096 + qt * 32 + tok) * 64 + 8 * hf;
#pragma unroll
    for (int ks = 0; ks < 4; ++ks) qf[ks] = *(const bf16x8*)(qp + ks * 16);
  }
  f32x16 o0, o1;
#pragma unroll
  for (int i = 0; i < 16; ++i) { o0[i] = 0.f; o1[i] = 0.f; }
  float c = 0.f;
  AttnKV fa, fb;
  attn_load(Km, Vt, bh, qt, tok, hf, fa);
  {
    unsigned z = __builtin_bit_cast(u32x4, fa.v[1][1]).w | __builtin_bit_cast(u32x4, fa.k[3]).w | __builtin_bit_cast(u32x4, qf[3]).w;
    asm volatile("" ::"v"(z));
  }
  for (int kb = qt;; kb -= 2) {
    attn_load(Km, Vt, bh, kb - 1, tok, hf, fb);
    __builtin_amdgcn_sched_barrier(0);
    if (attn_block(fa, qf, kb == qt, tok, hf, c, o0, o1) || kb == 0) break;
    attn_load(Km, Vt, bh, kb - 2, tok, hf, fa);
    __builtin_amdgcn_sched_barrier(0);
    if (attn_block(fb, qf, false, tok, hf, c, o0, o1) || kb == 1) break;
  }
  float ssq = 0.f;
#pragma unroll
  for (int i = 0; i < 16; ++i) ssq += o0[i] * o0[i] + o1[i] * o1[i];
  ssq += __shfl_xor(ssq, 32);
  float* xch = (float*)(smem + 100 * 1024) + (it & 1) * 256;
  if (hf == 0) xch[wave * 32 + tok] = ssq;
  __syncthreads();
  float tot = 0.f;
#pragma unroll
  for (int w = 0; w < NWAVES; ++w) tot += xch[w * 32 + tok];
  const float rs = rsqrtf(tot * (1.f / 512.f) + EPS);
  const int t = (bh >> 3) * 4096 + qt * 32 + tok, hh = bh & 7;
  bf16_t* dst = MIX + (size_t)t * 1024 + hh * 64 + 4 * hf;
#pragma unroll
  for (int g = 0; g < 4; ++g) {
    *(u32x2*)(dst + 8 * g) = (u32x2){pk2(o0[4 * g] * rs, o0[4 * g + 1] * rs), pk2(o0[4 * g + 2] * rs, o0[4 * g + 3] * rs)};
    *(u32x2*)(dst + 32 + 8 * g) = (u32x2){pk2(o1[4 * g] * rs, o1[4 * g + 1] * rs), pk2(o1[4 * g + 2] * rs, o1[4 * g + 3] * rs)};
  }
}

__device__ void phase_mix(const Params& p, char* smem) {
  static_assert(NWAVES == 8, "one wave per attention head");
  const int vb = vblock(), G = gridDim.x;
  for (int item = vb; item < 1024; item += G) conv_item(p, item, smem);
  const int tidm = otid();
  const int lane = tidm & 63, wave = tidm >> 6;
  int it = 0;
  for (int item = vb; item < 1024; item += G, ++it) attn_tile(p, item, it, lane, wave, smem);
}
__device__ __forceinline__ unsigned f2key(float f, unsigned n) {
  const unsigned u = (__float_as_uint(f) & ~0x7Fu) | n;
  return u ^ ((unsigned)((int)u >> 31) | 0x80000000u);
}
__device__ __forceinline__ unsigned f2key_raw(float f) {
  const unsigned u = __float_as_uint(f);
  return u ^ ((unsigned)((int)u >> 31) | 0x80000000u);
}
__device__ __forceinline__ unsigned key2u(unsigned k) { return k ^ ((k >> 31) ? 0x80000000u : 0xFFFFFFFFu); }

template <int N>
__device__ __forceinline__ void bitonic_sort_desc(unsigned (&v)[N]) {
#pragma unroll
  for (int k = 2; k <= N; k <<= 1) {
#pragma unroll
    for (int j = k >> 1; j > 0; j >>= 1) {
#pragma unroll
      for (int i = 0; i < N; ++i) {
        const int l = i ^ j;
        if (l > i) {
          const bool desc = ((i & k) == 0);
          const unsigned mx = max(v[i], v[l]), mn = min(v[i], v[l]);
          v[i] = desc ? mx : mn;
          v[l] = desc ? mn : mx;
        }
      }
    }
  }
}
template <int N>
__device__ __forceinline__ void bitonic_merge_desc(unsigned (&v)[N]) {
#pragma unroll
  for (int j = N >> 1; j > 0; j >>= 1) {
#pragma unroll
    for (int i = 0; i < N; ++i) {
      const int l = i ^ j;
      if (l > i) {
        const unsigned mx = max(v[i], v[l]), mn = min(v[i], v[l]);
        v[i] = mx;
        v[l] = mn;
      }
    }
  }
}
__device__ __forceinline__ void merge_top16(unsigned (&a)[16], const unsigned (&b)[16]) {
#pragma unroll
  for (int i = 0; i < 16; ++i) a[i] = max(a[i], b[15 - i]);
  bitonic_merge_desc<16>(a);
}
#define CEP(ka, pa, kb, pb, desc)                                  \
  {                                                                \
    const bool sw_ = (desc) ? ((kb) > (ka)) : ((kb) < (ka));       \
    const unsigned tk_ = sw_ ? (kb) : (ka), tl_ = sw_ ? (ka) : (kb); \
    const unsigned tp_ = sw_ ? (pb) : (pa), tq_ = sw_ ? (pa) : (pb); \
    ka = tk_; kb = tl_; pa = tp_; pb = tq_;                        \
  }
template <int N>
__device__ __forceinline__ void bitonic_sort_desc_p(unsigned (&v)[N], unsigned (&pl)[N]) {
#pragma unroll
  for (int k = 2; k <= N; k <<= 1) {
#pragma unroll
    for (int j = k >> 1; j > 0; j >>= 1) {
#pragma unroll
      for (int i = 0; i < N; ++i) {
        const int l = i ^ j;
        if (l > i) {
          const bool desc = ((i & k) == 0);
          CEP(v[i], pl[i], v[l], pl[l], desc);
        }
      }
    }
  }
}
template <int N>
__device__ __forceinline__ void bitonic_merge_desc_p(unsigned (&v)[N], unsigned (&pl)[N]) {
#pragma unroll
  for (int j = N >> 1; j > 0; j >>= 1) {
#pragma unroll
    for (int i = 0; i < N; ++i) {
      const int l = i ^ j;
      if (l > i) { CEP(v[i], pl[i], v[l], pl[l], true); }
    }
  }
}
__device__ __forceinline__ void merge_top16_p(unsigned (&a)[16], unsigned (&pa)[16], const unsigned (&b)[16], const unsigned (&pb)[16]) {
#pragma unroll
  for (int i = 0; i < 16; ++i) {
    const bool s = b[15 - i] > a[i];
    a[i] = s ? b[15 - i] : a[i];
    pa[i] = s ? pb[15 - i] : pa[i];
  }
  bitonic_merge_desc_p<16>(a, pa);
}

constexpr int KROW = 144;
__device__ __forceinline__ void subkey_top16(const LAS unsigned char* Kl, const bf16_t* __restrict__ qrow, int lane, unsigned (&top)[16]) {
  const int tok = lane & 31, hf = lane >> 5;
  f32x16 acc[4];
#pragma unroll
  for (int m = 0; m < 4; ++m)
#pragma unroll
    for (int i = 0; i < 16; ++i) acc[m][i] = 0.f;
  bf16x8 bq[4];
#pragma unroll
  for (int ks = 0; ks < 4; ++ks) bq[ks] = *(const bf16x8*)(qrow + ks * 16 + 8 * hf);
#pragma unroll 1
  for (int ks = 0; ks < 4; ++ks) {
#pragma unroll
    for (int m = 0; m < 4; ++m) {
      const bf16x8 ak = *(const LAS bf16x8*)(Kl + (m * 32 + tok) * KROW + ks * 32 + hf * 16);
      acc[m] = mfma32(ak, ks == 0 ? bq[0] : ks == 1 ? bq[1] : ks == 2 ? bq[2] : bq[3], acc[m]);
    }
  }
  unsigned g[4][16];
#pragma unroll
  for (int m = 0; m < 4; ++m) {
#pragma unroll
    for (int i = 0; i < 16; ++i) g[m][i] = f2key(acc[m][i], (unsigned)(m * 32 + (i & 3) + 8 * (i >> 2) + 4 * hf));
    bitonic_sort_desc<16>(g[m]);
  }
  merge_top16(g[0], g[1]);
  merge_top16(g[2], g[3]);
  merge_top16(g[0], g[2]);
  unsigned o[16];
#pragma unroll
  for (int i = 0; i < 16; ++i) o[i] = __shfl_xor(g[0][i], 32);
  merge_top16(g[0], o);
#pragma unroll
  for (int i = 0; i < 16; ++i) top[i] = g[0][i];
}

__device__ void phase_route(const Params& p, char* smem) {
  unsigned char* ws = p.ws;
  const bf16_t* K1 = (const bf16_t*)(ws + WS_K1);
  const bf16_t* K2 = (const bf16_t*)(ws + WS_K2);
  const bf16_t* QH = (const bf16_t*)(ws + WS_QH);
  const bf16_t* HB = (const bf16_t*)(ws + WS_HB);
  unsigned char* XN8 = ws + WS_XN8;
  const float* SSQ2 = (const float*)(ws + WS_SSQ2);
  unsigned* PIDX = (unsigned*)(ws + WS_PIDX);
  float* PG = (float*)(ws + WS_PG);
  const int tidr = otid();
  const int lane = tidr & 63, wave = tidr >> 6, gw = vblock() * NWAVES + wave, nw = gridDim.x * NWAVES;
  for (int t = gw; t < T; t += nw) {
    const bf16_t* src = HB + (size_t)t * 1024 + lane * 16;
    const float r = rsqrtf(SSQ2[t] * (1.f / 1024.f) + EPS) * 16.f;
    const u32x4 h0 = *(const u32x4*)src, h1 = *(const u32x4*)(src + 8);
    u32x4 q;
#pragma unroll
    for (int i = 0; i < 4; ++i) {
      const f32x4 g4 = *(const f32x4*)(p.norm_ffn_g + lane * 16 + 4 * i);
      const unsigned lo = (i < 2) ? h0[2 * i] : h1[2 * i - 4], hi = (i < 2) ? h0[2 * i + 1] : h1[2 * i - 3];
      int w = 0;
      w = __builtin_amdgcn_cvt_pk_fp8_f32(bflo(lo) * r * g4.x, bfhi(lo) * r * g4.y, w, false);
      w = __builtin_amdgcn_cvt_pk_fp8_f32(bflo(hi) * r * g4.z, bfhi(hi) * r * g4.w, w, true);
      q[i] = (unsigned)w;
    }
    *(u32x4*)(XN8 + (size_t)t * 1024 + lane * 16) = q;
  }
  const int G = gridDim.x, nh = (G % 8 == 0) ? 8 : 1;
  LAS unsigned char* K1l = (LAS unsigned char*)smem;
  LAS unsigned char* K2l = K1l + 128 * KROW;
  for (int hd = blockIdx.x % nh; hd < 8; hd += nh) {
    for (int idx = tidr; idx < 2048; idx += NTHREADS) {
      const int tb = idx >> 10, row = (idx >> 3) & 127, ch = idx & 7;
      const u32x4 v = *(const u32x4*)((tb ? K2 : K1) + hd * 8192 + row * 64 + ch * 8);
      *(LAS u32x4*)((tb ? K2l : K1l) + row * KROW + ch * 16) = v;
    }
    __syncthreads();
    for (int tile = (blockIdx.x / nh) * NWAVES + wave; tile < T / 32; tile += (G / nh) * NWAVES) {
      const int t0 = tile * 32;
      const int tok = lane & 31, hf = lane >> 5;
      const bf16_t* qrow = QH + (size_t)(t0 + tok) * 1024 + hd * 128;
      unsigned top1[16], top2[16];
      subkey_top16(K1l, qrow, lane, top1);
      subkey_top16(K2l, qrow + 64, lane, top2);
      float fa[16], fb[16];
      unsigned ia[16], ib[16];
#pragma unroll
      for (int i = 0; i < 16; ++i) {
        const unsigned ua = key2u(hf ? top2[i] : top1[i]), ub = key2u(hf ? top1[i] : top2[i]);
        fa[i] = __uint_as_float(ua); ia[i] = ua & 0x7Fu;
        fb[i] = __uint_as_float(ub); ib[i] = ub & 0x7Fu;
      }
      unsigned ck[32];
      {
        int n = 0;
#pragma unroll
        for (int i = 0; i < 4; ++i) {
#pragma unroll
          for (int j = i; j < 16; ++j) {
            if ((i + 1) * (j + 1) <= 16) {
              unsigned key = (f2key_raw(fa[i] + fb[j]) & ~0x3FFFu) | (hf ? ((ib[j] << 7) | ia[i]) : ((ia[i] << 7) | ib[j]));
              if (i == j && hf) key = 0u;
              ck[n] = key;
              ++n;
            }
          }
        }
#pragma unroll
        for (; n < 32; ++n) ck[n] = 0u;
      }
      unsigned k0[16], k1[16];
#pragma unroll
      for (int i = 0; i < 16; ++i) { k0[i] = ck[i]; k1[i] = ck[16 + i]; }
      bitonic_sort_desc<16>(k0);
      bitonic_sort_desc<16>(k1);
      merge_top16(k0, k1);
#pragma unroll
      for (int i = 0; i < 16; ++i) k1[i] = __shfl_xor(k0[i], 32);
      merge_top16(k0, k1);
      float sv[16], sum = 0.f;
      const float mx = __uint_as_float(key2u(k0[0] & ~0x3FFFu));
#pragma unroll
      for (int i = 0; i < 16; ++i) {
        sv[i] = __builtin_amdgcn_exp2f((__uint_as_float(key2u(k0[i] & ~0x3FFFu)) - mx) * LOG2E);
        sum += sv[i];
      }
      const float inv = 1.f / sum;
      const size_t po = ((size_t)(t0 + tok) * 8 + hd) * 16;
      if (hf == 0) {
#pragma unroll
        for (int q = 0; q < 4; ++q) *(u32x4*)(PIDX + po + 4 * q) = (u32x4){k0[4 * q] & 0x3FFFu, k0[4 * q + 1] & 0x3FFFu, k0[4 * q + 2] & 0x3FFFu, k0[4 * q + 3] & 0x3FFFu};
      } else {
#pragma unroll
        for (int q = 0; q < 4; ++q) *(f32x4*)(PG + po + 4 * q) = (f32x4){sv[4 * q] * inv, sv[4 * q + 1] * inv, sv[4 * q + 2] * inv, sv[4 * q + 3] * inv};
      }
    }
    __syncthreads();
  }
}

typedef int i32x8 __attribute__((ext_vector_type(8)));
__device__ __forceinline__ f32x4 mfma_fp4_fp8(u32x4 a, u32x4 b0, u32x4 b1, f32x4 c) {
  const i32x8 A = {(int)a.x, (int)a.y, (int)a.z, (int)a.w, 0, 0, 0, 0};
  const i32x8 B = {(int)b0.x, (int)b0.y, (int)b0.z, (int)b0.w, (int)b1.x, (int)b1.y, (int)b1.z, (int)b1.w};
  return __builtin_amdgcn_mfma_scale_f32_16x16x128_f8f6f4(A, B, c, 4, 0, 0, 0x7F7F7F7F, 0, 0x7F7F7F7F);
}
struct PeCtx {
  const unsigned char* U8; const float2* USV; LAS float* glist;
  LAS unsigned* list; int lane, r, g, s, n, t0;
};
__device__ __forceinline__ void pe_rows(const PeCtx& c, int ci, u32x4 (&a)[8]) {
  const int idx = ci * 16 + (c.lane >> 2);
  const unsigned ent = c.list[idx & 2047];
  const unsigned e = (idx < c.n) ? ((ent >> 7) & 16383u) : (unsigned)(c.s << 11);
  const unsigned char* rp = c.U8 + (size_t)e * 512 + (c.lane & 3) * 16;
#pragma unroll
  for (int ks = 0; ks < 8; ++ks) a[ks] = *(const u32x4*)(rp + ks * 64);
}
__device__ __forceinline__ void pe_fix(const PeCtx& c, u32x4 (&a)[8]) {
  const int src = 4 * c.r + c.g;
#pragma unroll
  for (int ks = 0; ks < 8; ++ks) {
    a[ks].x = (unsigned)__shfl((int)a[ks].x, src); a[ks].y = (unsigned)__shfl((int)a[ks].y, src);
    a[ks].z = (unsigned)__shfl((int)a[ks].z, src); a[ks].w = (unsigned)__shfl((int)a[ks].w, src);
  }
}
__device__ __forceinline__ void pe_chunk(const PeCtx& c, int ci, u32x4 (&a)[8], u32x4 (&anext)[8], const u32x4 (&bq)[16]) {
  const int idx = ci * 16 + c.r;
  const unsigned ent = c.list[idx & 2047];
  const bool fin = (c.lane < 16) && (idx < c.n);
  const unsigned e = (ent >> 7) & 16383u, col = (ent >> 21) & 15u;
  const float2 usv = c.USV[fin ? e : 0u];
  const float gt = c.glist[idx & 2047], us = usv.x, vs = usv.y;
  __builtin_amdgcn_sched_barrier(0);
  pe_rows(c, ci + 1, anext);
  __builtin_amdgcn_sched_barrier(0);
  pe_fix(c, a);
  f32x4 acc = {0.f, 0.f, 0.f, 0.f};
#pragma unroll
  for (int ks = 0; ks < 8; ++ks) acc = mfma_fp4_fp8(a[ks], bq[2 * ks], bq[2 * ks + 1], acc);
  const int src = ((c.r >> 2) << 4) | (int)col;
  const float v0 = __shfl(acc[0], src), v1 = __shfl(acc[1], src), v2 = __shfl(acc[2], src), v3 = __shfl(acc[3], src);
  float d = ((c.r & 3) == 0) ? v0 : ((c.r & 3) == 1) ? v1 : ((c.r & 3) == 2) ? v2 : v3;
  float gt_ = gt, us_ = us, vs_ = vs;
  asm volatile("" : "+v"(d), "+v"(gt_), "+v"(us_), "+v"(vs_));
  {
    const float act = d * us_ * (1.f / 16.f);
    const float w = gt_ * 0.5f * act * (1.f + erff(act * 0.70710678118654752f)) * vs_;
    if (fin) c.glist[idx & 2047] = w;
  }
}
#define PFV_LOAD(R, ev, k0)                                                                               \
  {                                                                                                       \
    _Pragma("unroll") for (int i_ = 0; i_ < 8; ++i_) {                                                    \
      const unsigned e_ = (unsigned)__builtin_amdgcn_ds_bpermute(bsel + 4 * ((k0) + 2 * i_), (int)(ev)); \
      R[i_] = *(const u32x4*)(V4 + (e_ << 9));                                                            \
    }                                                                                                     \
  }
#define PFV_FMA(dw, b, a) acc[a] = __builtin_elementwise_fma(__builtin_amdgcn_cvt_scalef32_pk_f32_fp4(dw, 1.0f, b), w2_, acc[a]);
#define PFV_ACC(R, wv, k0)                                                                                \
  {                                                                                                       \
    _Pragma("unroll") for (int i_ = 0; i_ < 8; ++i_) {                                                    \
      const float ws_ = __builtin_bit_cast(float, __builtin_amdgcn_ds_bpermute(bsel + 4 * ((k0) + 2 * i_), __builtin_bit_cast(int, (wv)))); \
      const f32x2 w2_ = {ws_, ws_};                                                                       \
      PFV_FMA(R[i_].x, 0, 0)  PFV_FMA(R[i_].x, 1, 1)  PFV_FMA(R[i_].x, 2, 2)  PFV_FMA(R[i_].x, 3, 3)      \
      PFV_FMA(R[i_].y, 0, 4)  PFV_FMA(R[i_].y, 1, 5)  PFV_FMA(R[i_].y, 2, 6)  PFV_FMA(R[i_].y, 3, 7)      \
      PFV_FMA(R[i_].z, 0, 8)  PFV_FMA(R[i_].z, 1, 9)  PFV_FMA(R[i_].z, 2, 10) PFV_FMA(R[i_].z, 3, 11)     \
      PFV_FMA(R[i_].w, 0, 12) PFV_FMA(R[i_].w, 1, 13) PFV_FMA(R[i_].w, 2, 14) PFV_FMA(R[i_].w, 3, 15)     \
    }                                                                                                     \
  }
__device__ void phase_peer_u(const Params& p, char* smem) {
  unsigned char* ws = p.ws;
  PeCtx c;
  c.U8 = ws + WS_U8; c.USV = (const float2*)(ws + WS_USV);
  const float* PG = (const float*)(ws + WS_PG);
  const bf16_t* HB = (const bf16_t*)(ws + WS_HB);
  const unsigned char* XN8 = ws + WS_XN8;
  const unsigned* PIDX = (const unsigned*)(ws + WS_PIDX);
  const int tidu = otid();
  const int lane = tidu & 63, wave = tidu >> 6;
  c.lane = lane; c.r = lane & 15; c.g = lane >> 4;
  c.list = (LAS unsigned*)(smem + wave * 8192);
  c.glist = (LAS float*)(smem + 65536 + wave * 8192);
  const bool hi = lane >= 32;
  const int bsel = hi ? 4 : 0;
  const unsigned char* V4 = ws + WS_V8 + (lane & 31) * 16;
  c.s = 0;
  {
    for (int grp = vblock() * NWAVES + wave; grp < T / 16; grp += gridDim.x * NWAVES) {
      const int t0 = grp * 16;
      c.t0 = t0;
      u32x4 bq[16];
      {
        const unsigned char* xp = XN8 + (size_t)(t0 + c.r) * 1024 + c.g * 16;
#pragma unroll
        for (int ks = 0; ks < 8; ++ks) { bq[2 * ks] = *(const u32x4*)(xp + ks * 128); bq[2 * ks + 1] = *(const u32x4*)(xp + ks * 128 + 64); }
      }
      const int n = 2048;
#pragma unroll
      for (int q = 0; q < 8; ++q) {
        const u32x4 idv = *(const u32x4*)(PIDX + (size_t)t0 * 128 + q * 256 + lane * 4);
        const f32x4 gv = *(const f32x4*)(PG + (size_t)t0 * 128 + q * 256 + lane * 4);
        const unsigned hi = (unsigned)(2 * q + (lane >> 5)) << 21, sl = (unsigned)((lane & 31) * 4);
        *(LAS u32x4*)(c.list + q * 256 + lane * 4) = (u32x4){hi | (idv.x << 7) | sl, hi | (idv.y << 7) | (sl + 1), hi | (idv.z << 7) | (sl + 2), hi | (idv.w << 7) | (sl + 3)};
        *(LAS f32x4*)(c.glist + q * 256 + lane * 4) = gv;
      }
      asm volatile("s_waitcnt lgkmcnt(0)" ::: "memory");
      c.n = n;
      const int nch = (n + 15) >> 4;
      u32x4 a0[8], a1[8];
      pe_rows(c, 0, a0);
      {
        unsigned z = 0u;
#pragma unroll
        for (int ks = 0; ks < 8; ++ks) z |= a0[ks].w;
        asm volatile("" ::"v"(z));
      }
      if (nch > 0) {
        for (int ci = 0;; ci += 2) {
          pe_chunk(c, ci, a0, a1, bq);
          if (ci + 1 >= nch) break;
          pe_chunk(c, ci + 1, a1, a0, bq);
          if (ci + 2 >= nch) break;
        }
      }
      asm volatile("s_waitcnt lgkmcnt(0)" ::: "memory");
      {
        unsigned e0 = (c.list[lane] >> 7) & 16383u, e1 = (c.list[64 + lane] >> 7) & 16383u;
        float w0 = c.glist[lane], w1 = c.glist[64 + lane];
        u32x4 RA[8], RB[8];
        PFV_LOAD(RA, e0, 0)
        {
          unsigned z = 0u;
#pragma unroll
          for (int i = 0; i < 8; ++i) z |= RA[i].w;
          asm volatile("" ::"v"(z));
        }
        for (int tk = 0; tk < 16; ++tk) {
          const int tn = tk < 15 ? tk + 1 : tk;
          const unsigned e0n = (c.list[tn * 128 + lane] >> 7) & 16383u, e1n = (c.list[tn * 128 + 64 + lane] >> 7) & 16383u;
          const float w0n = c.glist[tn * 128 + lane], w1n = c.glist[tn * 128 + 64 + lane];
          const size_t oo = (size_t)(t0 + tk) * 1024 + (lane & 31) * 32 + (hi ? 16 : 0);
          const u32x4 hb0 = *(const u32x4*)(HB + oo), hb1 = *(const u32x4*)(HB + oo + 8);
          f32x2 acc[16];
#pragma unroll
          for (int k = 0; k < 16; ++k) acc[k] = (f32x2){0.f, 0.f};
          __builtin_amdgcn_sched_barrier(0);
          PFV_LOAD(RB, e0, 16)  __builtin_amdgcn_sched_barrier(0);  PFV_ACC(RA, w0, 0)
          PFV_LOAD(RA, e0, 32)  __builtin_amdgcn_sched_barrier(0);  PFV_ACC(RB, w0, 16)
          PFV_LOAD(RB, e0, 48)  __builtin_amdgcn_sched_barrier(0);  PFV_ACC(RA, w0, 32)
          PFV_LOAD(RA, e1, 0)   __builtin_amdgcn_sched_barrier(0);  PFV_ACC(RB, w0, 48)
          PFV_LOAD(RB, e1, 16)  __builtin_amdgcn_sched_barrier(0);  PFV_ACC(RA, w1, 0)
          PFV_LOAD(RA, e1, 32)  __builtin_amdgcn_sched_barrier(0);  PFV_ACC(RB, w1, 16)
          PFV_LOAD(RB, e1, 48)  __builtin_amdgcn_sched_barrier(0);  PFV_ACC(RA, w1, 32)
          PFV_LOAD(RA, e0n, 0)  __builtin_amdgcn_sched_barrier(0);  PFV_ACC(RB, w1, 48)
          f32x2 r[8];
#pragma unroll
          for (int k = 0; k < 8; ++k) {
            const f32x2 keep = hi ? acc[8 + k] : acc[k], send = hi ? acc[k] : acc[8 + k];
            r[k] = keep + (f32x2){__shfl_xor(send.x, 32), __shfl_xor(send.y, 32)};
          }
          float* o = p.out + oo;
          *(f32x4*)(o)      = (f32x4){bflo(hb0.x) + r[0].x, bfhi(hb0.x) + r[0].y, bflo(hb0.y) + r[1].x, bfhi(hb0.y) + r[1].y};
          *(f32x4*)(o + 4)  = (f32x4){bflo(hb0.z) + r[2].x, bfhi(hb0.z) + r[2].y, bflo(hb0.w) + r[3].x, bfhi(hb0.w) + r[3].y};
          *(f32x4*)(o + 8)  = (f32x4){bflo(hb1.x) + r[4].x, bfhi(hb1.x) + r[4].y, bflo(hb1.y) + r[5].x, bfhi(hb1.y) + r[5].y};
          *(f32x4*)(o + 12) = (f32x4){bflo(hb1.z) + r[6].x, bfhi(hb1.z) + r[6].y, bflo(hb1.w) + r[7].x, bfhi(hb1.w) + r[7].y};
          e0 = e0n; e1 = e1n; w0 = w0n; w1 = w1n;
        }
      }
      asm volatile("" ::: "memory");
    }
  }
}
#undef PFV_LOAD
#undef PFV_FMA
#undef PFV_ACC


#define XB_TMO      128
#define XB_XCNT(j)  (256  + 64 * (j))
#define XB_XSUB(j)  (1280 + 64 * (j))
#define XB_XGEN(j)  (2304 + 64 * (j))
#define XB_TOP      3328
#define XB_TOPGEN   3392
#define XCD_BAR_WORDS 3456
#define XB_SPIN_CAP (1u << 22)
__device__ __forceinline__ unsigned xb_ld(unsigned* p)              { return __hip_atomic_load(p, __ATOMIC_RELAXED, __HIP_MEMORY_SCOPE_AGENT); }
__device__ __forceinline__ unsigned xb_add(unsigned* p, unsigned v) { return __hip_atomic_fetch_add(p, v, __ATOMIC_RELAXED, __HIP_MEMORY_SCOPE_AGENT); }
__device__ __forceinline__ unsigned xb_xcc_id() { return (unsigned)__builtin_amdgcn_s_getreg((3 << 11) | 20) & 0xFu; }
#define XB_SPIN(cond, bar) do { unsigned _sp = 0; while (cond) { __builtin_amdgcn_s_sleep(1); \
    if ((++_sp & 255u) == 0u) { if (xb_ld(&(bar)[XB_TMO])) break; if (_sp > XB_SPIN_CAP) { atomicAdd(&(bar)[XB_TMO], 1u); break; } } } } while (0)
struct XcdBarrier { unsigned* bar; unsigned x; volatile LAS unsigned* st; };
__device__ __forceinline__ XcdBarrier xcd_barrier_post(unsigned* bar, volatile LAS unsigned* st) {
    XcdBarrier b; b.bar = bar; b.x = xb_xcc_id(); b.st = st;
    if (threadIdx.x == 0) (void)xb_add(&bar[XB_XCNT(b.x)], 1u);
    return b;
}
__device__ __forceinline__ void xcd_barrier_complete(unsigned* bar, unsigned x, unsigned& nloc, unsigned& nx) {
    const unsigned G = gridDim.x * gridDim.y * gridDim.z;
    unsigned sum, cnt, mine, sp = 0u;
    for (;;) {
        sum = 0u; cnt = 0u; mine = 0u;
#pragma unroll
        for (unsigned j = 0; j < 16; ++j) { const unsigned c = xb_ld(&bar[XB_XCNT(j)]); sum += c; cnt += (c > 0u) ? 1u : 0u; mine = (j == x) ? c : mine; }
        if (sum == G) break;
        __builtin_amdgcn_s_sleep(1);
        if ((++sp & 255u) == 0u) { if (xb_ld(&bar[XB_TMO])) break; if (sp > XB_SPIN_CAP) { atomicAdd(&bar[XB_TMO], 1u); break; } }
    }
    nloc = mine > 0u ? mine : 1u; nx = cnt > 0u ? cnt : 1u;
}
__device__ __forceinline__ void xcd_barrier(const XcdBarrier& b) {
    asm volatile("s_waitcnt vmcnt(0)" ::: "memory");
    __syncthreads();
    if (threadIdx.x == 0) {
        unsigned* bar = b.bar;
        __builtin_amdgcn_s_waitcnt(0);
        unsigned nloc = b.st[0], nx = b.st[1];
        if (nloc == 0u) { xcd_barrier_complete(bar, b.x, nloc, nx); b.st[0] = nloc; b.st[1] = nx; }
        const unsigned old = xb_add(&bar[XB_XSUB(b.x)], 1u);
        const unsigned gen = old / nloc;
        if (old + 1u == (gen + 1u) * nloc) {
            __builtin_amdgcn_fence(__ATOMIC_RELEASE, "agent");
            asm volatile("s_waitcnt vmcnt(0)" ::: "memory");
            const unsigned og = xb_add(&bar[XB_TOP], 1u);
            const unsigned tg = og / nx;
            if (og + 1u == (tg + 1u) * nx) xb_add(&bar[XB_TOPGEN], 1u);
            else XB_SPIN(xb_ld(&bar[XB_TOPGEN]) == tg, bar);
            __builtin_amdgcn_fence(__ATOMIC_ACQUIRE, "agent");
            xb_add(&bar[XB_XGEN(b.x)], 1u);
            asm volatile("s_waitcnt vmcnt(0)" ::: "memory");
        } else {
            XB_SPIN(xb_ld(&bar[XB_XGEN(b.x)]) == gen, bar);
            __builtin_amdgcn_fence(__ATOMIC_ACQUIRE, "agent");
            asm volatile("s_waitcnt vmcnt(0)" ::: "memory");
        }
    }
    __syncthreads();
}

__global__ void __launch_bounds__(NTHREADS, 2) k_fused(Params p) {
  __shared__ __attribute__((aligned(16))) char smem[LDS_BYTES];
  if (threadIdx.x == 0) *(u32x4*)(smem + LDS_BAR) = (u32x4){0u, 0u, 0u, 0u};
  __syncthreads();
  const XcdBarrier bar = xcd_barrier_post((unsigned*)(p.ws + WS_CTL), (volatile LAS unsigned*)(smem + LDS_BAR));
#ifdef PROBE_PHASE
  unsigned long long ts[12];
#define STAMP(k) ts[k] = __builtin_amdgcn_s_memrealtime();
#else
#define STAMP(k)
#endif
  STAMP(0)
  phase_prep(p);
  xcd_barrier(bar);
  STAMP(1)
  phase_inproj(p, smem);
  xcd_barrier(bar);
  STAMP(2)
  phase_mix(p, smem);
  xcd_barrier(bar);
  STAMP(3)
  phase_outproj(p, smem);
  xcd_barrier(bar);
  STAMP(4)
  phase_qproj(p, smem);
  xcd_barrier(bar);
  STAMP(5)
  phase_route(p, smem);
  xcd_barrier(bar);
  STAMP(6)
  phase_peer_u(p, smem);
#ifdef PROBE_PHASE
  xcd_barrier(bar);
  STAMP(7)
  if (blockIdx.x == 0 && threadIdx.x == 0) {
    const float us = (float)(ts[PROBE_PHASE + 1] - ts[PROBE_PHASE]) * 0.01f;
    p.out[12345] += us * (1.f / PROBE_DIV);
  }
#endif
}

extern "C" void kernel_launch(void* const* d_in, const int* in_sizes, int n_in, void* d_out, int out_size, void* d_ws, size_t ws_size,
                              hipStream_t stream) {
  if (n_in != 17 || ws_size < WS_END) {
    fprintf(stderr, "kernel_launch: unexpected n_in %d / ws_size %zu\n", n_in, ws_size);
    return;
  }
  Params p{};
  p.x = (const float*)d_in[0]; p.norm_mix_g = (const float*)d_in[1]; p.w_in = (const float*)d_in[2]; p.q_norm_g = (const float*)d_in[3];
  p.k_norm_g = (const float*)d_in[4]; p.attn_out_g = (const float*)d_in[5]; p.conv_w = (const float*)d_in[6]; p.conv_b = (const float*)d_in[7];
  p.conv_ln_g = (const float*)d_in[8]; p.conv_ln_b = (const float*)d_in[9]; p.w_out = (const float*)d_in[10]; p.norm_ffn_g = (const float*)d_in[11];
  p.peer_wq = (const float*)d_in[12]; p.peer_k1 = (const float*)d_in[13]; p.peer_k2 = (const float*)d_in[14]; p.peer_u = (const float*)d_in[15];
  p.peer_v = (const float*)d_in[16];
  p.out = (float*)d_out;
  p.ws = (unsigned char*)d_ws;
  static int grid_blocks = 0;
  if (!grid_blocks) {
    int dev = 0, cus = 0, per_cu = 0;
    (void)hipGetDevice(&dev);
    (void)hipDeviceGetAttribute(&cus, hipDeviceAttributeMultiprocessorCount, dev);
    (void)hipOccupancyMaxActiveBlocksPerMultiprocessor(&per_cu, k_fused, NTHREADS, 0);
    if (per_cu > 1) per_cu = 1;
    if (per_cu < 1) per_cu = 1;
    grid_blocks = cus * per_cu;
  }
  (void)hipMemsetAsync((char*)d_ws + WS_CTL, 0, XCD_BAR_WORDS * 4, stream);
  hipLaunchKernelGGL(k_fused, dim3(grid_blocks), dim3(NTHREADS), 0, stream, p);
}
```

```cpp
#include <hip/hip_runtime.h>
#include <cstdio>

#define LAS __attribute__((address_space(3)))
typedef unsigned short bf16_t;
typedef __bf16 bf16x8 __attribute__((ext_vector_type(8)));
typedef __bf16 bf16x2 __attribute__((ext_vector_type(2)));
typedef float f32x4 __attribute__((ext_vector_type(4)));
typedef float f32x16 __attribute__((ext_vector_type(16)));
typedef unsigned u32x4 __attribute__((ext_vector_type(4)));
typedef unsigned u32x2 __attribute__((ext_vector_type(2)));
typedef float f32x2 __attribute__((ext_vector_type(2)));

constexpr int SEQ = 4096, T = 8 * SEQ, D = 1024, NIN = 2560;
constexpr float EPS = 1e-6f;
constexpr float LOG2E = 1.4426950408889634f;

constexpr size_t MiB = 1u << 20;
constexpr size_t WS_W1 = 0, WS_WV = 4 * MiB, WS_WOUT = 5 * MiB, WS_WQ = 7 * MiB, WS_K1 = 9 * MiB, WS_K2 = 9 * MiB + 131072, WS_SSQ = 10 * MiB;
constexpr size_t WS_CTL = 11 * MiB;
constexpr size_t WS_USV = 11 * MiB + 65536;
constexpr size_t WS_RS1 = 11 * MiB + 196608, WS_SSQ2 = 11 * MiB + 327680;
constexpr size_t WS_U8 = 12 * MiB, WS_V8 = 28 * MiB;
constexpr size_t WS_XB = 44 * MiB;
constexpr size_t WS_Q = 108 * MiB, WS_K = 140 * MiB, WS_VT = 172 * MiB, WS_HG = 204 * MiB, WS_MIX = 236 * MiB;
constexpr size_t WS_HB = 300 * MiB, WS_QH = 364 * MiB;
constexpr size_t WS_XN8 = 108 * MiB, WS_PIDX = 140 * MiB, WS_PG = 156 * MiB, WS_PW = 172 * MiB;
constexpr size_t WS_END = 428 * MiB;

struct Params {
  const float *x, *norm_mix_g, *w_in, *q_norm_g, *k_norm_g, *attn_out_g, *conv_w, *conv_b, *conv_ln_g, *conv_ln_b,
      *w_out, *norm_ffn_g, *peer_wq, *peer_k1, *peer_k2, *peer_u, *peer_v;
  float* out;
  unsigned char* ws;
};

constexpr int NTHREADS = 512, NWAVES = 8;
constexpr int LDS_STAGE = 131072, LDS_BAR = LDS_STAGE, LDS_BYTES = LDS_STAGE + 16;

__device__ __forceinline__ unsigned pk2(float lo, float hi) {
  bf16x2 v = {(__bf16)lo, (__bf16)hi};
  return __builtin_bit_cast(unsigned, v);
}
__device__ __forceinline__ float bflo(unsigned u) { return __uint_as_float(u << 16); }
__device__ __forceinline__ float bfhi(unsigned u) { return __uint_as_float(u & 0xffff0000u); }
__device__ __forceinline__ int otid() { int t = threadIdx.x; asm volatile("" : "+v"(t)); return t; }
__device__ __forceinline__ int vblock() {
  const int G = gridDim.x, b = blockIdx.x;
  return (G % 8 == 0) ? (b % 8) * (G / 8) + b / 8 : b;
}
__device__ __forceinline__ f32x16 mfma32(bf16x8 a, bf16x8 b, f32x16 c) { return __builtin_amdgcn_mfma_f32_32x32x16_bf16(a, b, c, 0, 0, 0); }

__device__ __forceinline__ int w1_src(int n) {
  if (n < 1024) {
    const int kind = n >> 9, rel = n & 511, pn = rel >> 8, P = rel & 255, bj = P >> 7, wc = (P >> 5) & 3, x = P & 31;
    return kind * 512 + (4 * pn + wc) * 64 + 32 * bj + x;
  }
  const int rel = n - 1024, pn = rel >> 8, P = rel & 255, bj = P >> 7, wc = (P >> 5) & 3, x = P & 31;
  return (bj ? 2048 : 1536) + 128 * pn + 32 * wc + x;
}
__device__ __forceinline__ void transpose_items(const float* __restrict__ W, int ldw, int N, bf16_t* __restrict__ Wt, const float* __restrict__ g, int glimit,
                                                int mode, long gtid, long nthr) {
  const long nitems = (long)N * 128;
  for (long it = gtid; it < nitems; it += nthr) {
    const int n = (int)(it % N), kc = (int)(it / N);
    const int src = mode == 1 ? w1_src(n) : (mode == 2 ? 1024 + n : n);
    float v[8];
#pragma unroll
    for (int i = 0; i < 8; ++i) {
      const int k = kc * 8 + i;
      float w = W[(size_t)k * ldw + src];
      if (k < glimit) w *= g[k];
      v[i] = w;
    }
    u32x4 o = {pk2(v[0], v[1]), pk2(v[2], v[3]), pk2(v[4], v[5]), pk2(v[6], v[7])};
    *(u32x4*)(Wt + (size_t)n * 1024 + kc * 8) = o;
  }
}
__device__ __forceinline__ void convert_items(const float* __restrict__ src, bf16_t* __restrict__ dst, long n8, long gtid, long nthr) {
  for (long it = gtid; it < n8; it += nthr) {
    const f32x4 a = *(const f32x4*)(src + it * 8), b = *(const f32x4*)(src + it * 8 + 4);
    u32x4 o = {pk2(a.x, a.y), pk2(a.z, a.w), pk2(b.x, b.y), pk2(b.z, b.w)};
    *(u32x4*)(dst + it * 8) = o;
  }
}
__device__ void phase_prep(const Params& p) {
  const int tid0 = otid();
  const long gtid = (long)vblock() * NTHREADS + tid0, nthr = (long)gridDim.x * NTHREADS;
  unsigned char* ws = p.ws;
  transpose_items(p.w_in, NIN, 2048, (bf16_t*)(ws + WS_W1), p.norm_mix_g, 1024, 1, gtid, nthr);
  transpose_items(p.w_in, NIN, 512, (bf16_t*)(ws + WS_WV), p.norm_mix_g, 1024, 2, gtid, nthr);
  transpose_items(p.w_out, D, D, (bf16_t*)(ws + WS_WOUT), p.attn_out_g, 512, 0, gtid, nthr);
  transpose_items(p.peer_wq, D, D, (bf16_t*)(ws + WS_WQ), p.norm_ffn_g, 1024, 0, gtid, nthr);
  convert_items(p.peer_k1, (bf16_t*)(ws + WS_K1), 65536 / 8, gtid, nthr);
  convert_items(p.peer_k2, (bf16_t*)(ws + WS_K2), 65536 / 8, gtid, nthr);
  const int lane = tid0 & 63, gw = vblock() * NWAVES + (tid0 >> 6), nw = gridDim.x * NWAVES;
  {
    bf16_t* XB = (bf16_t*)(ws + WS_XB);
    float* RS1 = (float*)(ws + WS_RS1);
    float* SSQ2 = (float*)(ws + WS_SSQ2);
    for (int tb = gw; tb < T; tb += 2 * nw) {
      f32x4 v[2][4];
      float ss[2] = {0.f, 0.f};
#pragma unroll
      for (int u = 0; u < 2; ++u) {
        const int t = (tb + u * nw < T) ? tb + u * nw : tb;
        const float* src = p.x + (size_t)t * 1024 + lane * 4;
#pragma unroll
        for (int i = 0; i < 4; ++i) v[u][i] = *(const f32x4*)(src + 256 * i);
      }
#pragma unroll
      for (int u = 0; u < 2; ++u) {
#pragma unroll
        for (int i = 0; i < 4; ++i) ss[u] += v[u][i].x * v[u][i].x + v[u][i].y * v[u][i].y + v[u][i].z * v[u][i].z + v[u][i].w * v[u][i].w;
      }
#pragma unroll
      for (int o = 1; o < 64; o <<= 1) { ss[0] += __shfl_xor(ss[0], o); ss[1] += __shfl_xor(ss[1], o); }
#pragma unroll
      for (int u = 0; u < 2; ++u) {
        const int t = tb + u * nw;
        if (t < T) {
#pragma unroll
          for (int i = 0; i < 4; ++i) *(u32x2*)(XB + (size_t)t * 1024 + lane * 4 + 256 * i) = (u32x2){pk2(v[u][i].x, v[u][i].y), pk2(v[u][i].z, v[u][i].w)};
          if (lane == 0) { RS1[t] = rsqrtf(ss[u] * (1.f / 1024.f) + EPS); SSQ2[t] = 0.f; }
        }
      }
    }
  }
}

__device__ void prep_tables(const Params& p) {
  unsigned char* ws = p.ws;
  const int tid0 = otid();
  const int lane = tid0 & 63, gw = vblock() * NWAVES + (tid0 >> 6), nw = gridDim.x * NWAVES;
  {
    for (int rb = gw; rb < 32768; rb += 2 * nw) {
      f32x4 v[2][4];
#pragma unroll
      for (int u = 0; u < 2; ++u) {
        const int r = (rb + u * nw < 32768) ? rb + u * nw : rb;
        const float* src = ((r >> 14) ? p.peer_v : p.peer_u) + (size_t)(r & 16383) * 1024 + lane * 16;
#pragma unroll
        for (int i = 0; i < 4; ++i) v[u][i] = *(const f32x4*)(src + 4 * i);
      }
      float am[2] = {0.f, 0.f};
#pragma unroll
      for (int u = 0; u < 2; ++u)
#pragma unroll
        for (int i = 0; i < 4; ++i)
          am[u] = fmaxf(am[u], fmaxf(fmaxf(fabsf(v[u][i].x), fabsf(v[u][i].y)), fmaxf(fabsf(v[u][i].z), fabsf(v[u][i].w))));
#pragma unroll
      for (int o = 1; o < 64; o <<= 1) { am[0] = fmaxf(am[0], __shfl_xor(am[0], o)); am[1] = fmaxf(am[1], __shfl_xor(am[1], o)); }
#pragma unroll
      for (int u = 0; u < 2; ++u) {
        const int r = rb + u * nw;
        if (r < 32768) {
          const int isv = r >> 14, e = r & 16383;
          const float scale = am[u] > 0.f ? am[u] * (1.f / 6.f) : 1.f, inv = am[u] > 0.f ? 6.f / am[u] : 0.f;
          unsigned q[2] = {0u, 0u};
#pragma unroll
          for (int i = 0; i < 4; ++i)
#pragma unroll
            for (int j = 0; j < 4; ++j) {
              const float xv = v[u][i][j], m = fabsf(xv) * inv;
              const unsigned code = (unsigned)(m > 0.25f) + (unsigned)(m > 0.75f) + (unsigned)(m > 1.25f) + (unsigned)(m > 1.75f) +
                                    (unsigned)(m > 2.5f) + (unsigned)(m > 3.5f) + (unsigned)(m > 5.0f);
              const unsigned nib = code | (xv < 0.f ? 8u : 0u);
              const int el = 4 * i + j;
              q[el >> 3] |= nib << (4 * (el & 7));
            }
          if (isv) {
            *(u32x2*)(ws + WS_V8 + (size_t)e * 512 + lane * 8) = (u32x2){q[0], q[1]};
            if (lane == 0) ((float*)(ws + WS_USV))[2 * e + 1] = scale;
          } else {
            *(u32x2*)(ws + WS_U8 + (size_t)e * 512 + lane * 8) = (u32x2){q[0], q[1]};
            if (lane == 0) ((float*)(ws + WS_USV))[2 * e] = scale;
          }
        }
      }
    }
  }
}

namespace pg8 {
typedef short sbf16x8 __attribute__((ext_vector_type(8)));
constexpr int BM = 256, BK = 64, HALF = 128, HTB = HALF * BK * 2  , NXCD = 8, WGM = 8;
__device__ __forceinline__ int lds_byte(int r, int c) { const int st = (r >> 4) * 2 + (c >> 5), rr = r & 15, cc = c & 31, ob = rr * 64 + cc * 2; return st * 1024 + (ob ^ (((ob >> 9) & 1) << 5)); }
__device__ __forceinline__ void stage_rc(int b, int& R, int& C) { const int st = b / 1024, sb = b % 1024, swz = sb ^ (((sb >> 9) & 1) << 5); R = (st >> 1) * 16 + swz / 64; C = (st & 1) * 32 + (swz % 64) / 2; }
__device__ __forceinline__ int perm32(int rho) { const int n = rho >> 4, i = rho & 15; return 8 * (i >> 2) + 4 * n + (i & 3); }
struct Unit { int pm, pn; };
struct Gemm { const bf16_t* A; const bf16_t* Bt; int M, N, K; };
struct StaticOrder {
    int nM, nN, nwg, G, c;
    __device__ void init(int M, int N, int G_, int c_) { nM = M / BM; nN = N / BM; nwg = nM * nN; G = G_; c = c_; }
    __device__ bool next(int i, Unit& u) const {
        const long L = (long)i * G + c; if (L >= nwg) return false;
        int wgid = (int)L; { const int q = nwg / NXCD, r = nwg % NXCD, xcd = wgid % NXCD, off = wgid / NXCD; wgid = (xcd < r ? xcd * (q + 1) : r * (q + 1) + (xcd - r) * q) + off; }
        const int nig = WGM * nN, gid = wgid / nig, fm = gid * WGM, gsz = (nM - fm) < WGM ? (nM - fm) : WGM;
        u.pm = fm + ((wgid % nig) % gsz); u.pn = (wgid % nig) / gsz; return true;
    }
};
template <class Epi>
__device__ __forceinline__ void gemm_phase(LAS unsigned char* lds, const Gemm g, const StaticOrder& S, const Epi& E) {
    const int tid = otid(), wid = __builtin_amdgcn_readfirstlane(tid >> 6), lane = tid & 63, wr = wid >> 2, wc = wid & 3, fr = lane & 15, fq = lane >> 4;
    const int K = g.K, nt = K / BK;
    unsigned voffA[2], voffB[2];
#pragma unroll
    for (int i = 0; i < 2; ++i) { int R, C; stage_rc(tid * 16 + i * 8192, R, C); const int Rb = Epi::PERM ? ((R & ~31) + perm32(R & 31)) : R;
        voffA[i] = (unsigned)(R * K + C) * 2u; voffB[i] = (unsigned)(Rb * K + C) * 2u; }
    const size_t kstep = (size_t)(BK * 2);
    const size_t hstep = (size_t)HALF * K * 2;
    const size_t tstep = 2 * hstep;
    const unsigned ldsw = (unsigned)wid * 1024u;
    const int aoff = lds_byte(wr * 64 + fr, fq * 8), boff = lds_byte(wc * 32 + fr, fq * 8);
#define PG8_SA(b, h) (((b) * 2 + (h)) * HTB)
#define PG8_SB(b, h) ((4 + (b) * 2 + (h)) * HTB)
#define PG8_STAGE(bufoff, gbase, voff) do { _Pragma("unroll") for (int _i = 0; _i < 2; ++_i) \
        __builtin_amdgcn_global_load_lds((const unsigned*)((const char*)(gbase) + (voff)[_i]), (LAS unsigned*)(lds + (bufoff) + ldsw + _i * 8192), 16, 0, 0); } while (0)
#define PG8_LDA(dst, b, h) do { _Pragma("unroll") for (int m = 0; m < 4; ++m) _Pragma("unroll") for (int k = 0; k < 2; ++k) dst[m][k] = *(const LAS sbf16x8*)(lds + PG8_SA(b, h) + aoff + m * 2048 + k * 1024); } while (0)
#define PG8_LDB(dst, b, h) do { _Pragma("unroll") for (int n = 0; n < 2; ++n) _Pragma("unroll") for (int k = 0; k < 2; ++k) dst[n][k] = *(const LAS sbf16x8*)(lds + PG8_SB(b, h) + boff + n * 2048 + k * 1024); } while (0)
#define PG8_MMA(ai, bj, At, Bt) do { __builtin_amdgcn_s_setprio(1); _Pragma("unroll") for (int m = 0; m < 4; ++m) _Pragma("unroll") for (int n = 0; n < 2; ++n) _Pragma("unroll") for (int k = 0; k < 2; ++k) \
        acc[ai][bj][m][n] = __builtin_amdgcn_mfma_f32_16x16x32_bf16(__builtin_bit_cast(bf16x8, Bt[n][k]), __builtin_bit_cast(bf16x8, At[m][k]), acc[ai][bj][m][n], 0, 0, 0); __builtin_amdgcn_s_setprio(0); } while (0)
#define PG8_WAIT_V(n) asm volatile("s_waitcnt vmcnt(" #n ")" ::: "memory")
#define PG8_WAIT_L(n) asm volatile("s_waitcnt lgkmcnt(" #n ")" ::: "memory")
#define PG8_BAR __builtin_amdgcn_s_barrier()
#define PG8_SCHED __builtin_amdgcn_sched_barrier(0)
    Unit cur, nxt; int ui = 0;
    if (!S.next(0, cur)) return;
    f32x4 acc[2][2][4][2];
#pragma unroll
    for (int a = 0; a < 2; ++a)
#pragma unroll
        for (int b = 0; b < 2; ++b)
#pragma unroll
            for (int m = 0; m < 4; ++m)
#pragma unroll
                for (int n = 0; n < 2; ++n) acc[a][b][m][n] = (f32x4){0.f, 0.f, 0.f, 0.f};
    sbf16x8 At[4][2], B0[2][2], B1[2][2];
    const char* cA = (const char*)g.A + (size_t)cur.pm * tstep; const char* cB = (const char*)g.Bt + (size_t)cur.pn * tstep;
    PG8_STAGE(PG8_SB(0, 0), cB, voffB); PG8_STAGE(PG8_SA(0, 0), cA, voffA); PG8_STAGE(PG8_SB(0, 1), cB + hstep, voffB); PG8_STAGE(PG8_SA(0, 1), cA + hstep, voffA);
    if (wr == 1) PG8_BAR;
    PG8_WAIT_V(4); PG8_BAR;
    PG8_STAGE(PG8_SB(1, 0), cB + kstep, voffB); PG8_STAGE(PG8_SA(1, 0), cA + kstep, voffA); PG8_STAGE(PG8_SB(1, 1), cB + hstep + kstep, voffB);
    PG8_WAIT_V(6); PG8_BAR;
    for (;;) {
        const bool has_next = S.next(ui + 1, nxt);
        const char* nA = has_next ? (const char*)g.A + (size_t)nxt.pm * tstep : cA; const char* nB = has_next ? (const char*)g.Bt + (size_t)nxt.pn * tstep : cB;
        for (int t = 0; t < nt; t += 2) {
            const bool last = (t == nt - 2);
            const char* a1 = cA + (size_t)(t + 1) * kstep;
            const char* a2 = last ? nA : cA + (size_t)(t + 2) * kstep; const char* b2 = last ? nB : cB + (size_t)(t + 2) * kstep;
            const char* a3 = a2 + kstep; const char* b3 = b2 + kstep;
            PG8_LDB(B0, 0, 0); PG8_SCHED; PG8_LDA(At, 0, 0); PG8_STAGE(PG8_SA(1, 1), a1 + hstep, voffA);
            PG8_WAIT_L(8); PG8_BAR; PG8_WAIT_L(0); PG8_MMA(0, 0, At, B0); PG8_BAR; PG8_SCHED;
            PG8_LDB(B1, 0, 1); PG8_STAGE(PG8_SB(0, 0), b2, voffB);
            PG8_BAR; PG8_WAIT_L(0); PG8_MMA(0, 1, At, B1); PG8_BAR;
            PG8_LDA(At, 0, 1); PG8_STAGE(PG8_SA(0, 0), a2, voffA);
            PG8_BAR; PG8_WAIT_L(0); PG8_MMA(1, 0, At, B0); PG8_BAR; PG8_SCHED;
            PG8_STAGE(PG8_SB(0, 1), b2 + hstep, voffB);
            PG8_WAIT_V(6); PG8_BAR; PG8_MMA(1, 1, At, B1); PG8_BAR;
            PG8_LDB(B0, 1, 0); PG8_SCHED; PG8_LDA(At, 1, 0); PG8_STAGE(PG8_SA(0, 1), a2 + hstep, voffA);
            PG8_WAIT_L(8); PG8_BAR; PG8_WAIT_L(0); PG8_MMA(0, 0, At, B0); PG8_BAR; PG8_SCHED;
            PG8_LDB(B1, 1, 1); PG8_STAGE(PG8_SB(1, 0), b3, voffB);
            PG8_BAR; PG8_WAIT_L(0); PG8_MMA(0, 1, At, B1); PG8_BAR;
            PG8_LDA(At, 1, 1); PG8_STAGE(PG8_SA(1, 0), a3, voffA);
            PG8_BAR; PG8_WAIT_L(0); PG8_MMA(1, 0, At, B0); PG8_BAR; PG8_SCHED;
            PG8_STAGE(PG8_SB(1, 1), b3 + hstep, voffB);
            PG8_WAIT_V(6); PG8_BAR; PG8_MMA(1, 1, At, B1); PG8_BAR;
        }
        E(acc, cur, wr, wc, fr, fq);
        if (!has_next) break;
#pragma unroll
        for (int a = 0; a < 2; ++a)
#pragma unroll
            for (int b = 0; b < 2; ++b)
#pragma unroll
                for (int m = 0; m < 4; ++m)
#pragma unroll
                    for (int n = 0; n < 2; ++n) acc[a][b][m][n] = (f32x4){0.f, 0.f, 0.f, 0.f};
        cur = nxt; cA = nA; cB = nB; ++ui;
    }
    PG8_WAIT_V(0);
    if (wr == 0) PG8_BAR;
    PG8_BAR;
#undef PG8_SA
#undef PG8_SB
#undef PG8_STAGE
#undef PG8_LDA
#undef PG8_LDB
#undef PG8_MMA
#undef PG8_WAIT_V
#undef PG8_WAIT_L
#undef PG8_BAR
#undef PG8_SCHED
}
}

struct EpiQKC {
  static constexpr bool PERM = true;
  const float* rs1; const float* qg; const float* kg; bf16_t* Q; bf16_t* Kk; bf16_t* HG;
  __device__ __forceinline__ void operator()(const f32x4 (&acc)[2][2][4][2], const pg8::Unit& u, int wr, int wc, int fr, int fq) const {
    const int row0 = u.pm * 256 + wr * 64 + fr;
    if (u.pn < 4) {
      const bool isq = u.pn < 2;
      const int head = 4 * (u.pn & 1) + wc;
      const float* g = isq ? qg : kg;
      f32x4 gv[2][2];
#pragma unroll
      for (int bj = 0; bj < 2; ++bj)
#pragma unroll
        for (int n = 0; n < 2; ++n) gv[bj][n] = *(const f32x4*)(g + 32 * bj + 8 * fq + 4 * n);
      bf16_t* base = isq ? Q : Kk;
#pragma unroll
      for (int ai = 0; ai < 2; ++ai)
#pragma unroll
        for (int m = 0; m < 4; ++m) {
          const int t = row0 + ai * 128 + m * 16;
          float ss = 0.f;
#pragma unroll
          for (int bj = 0; bj < 2; ++bj)
#pragma unroll
            for (int n = 0; n < 2; ++n) { const f32x4 v = acc[ai][bj][m][n]; ss += v.x * v.x + v.y * v.y + v.z * v.z + v.w * v.w; }
          ss += __shfl_xor(ss, 16);
          ss += __shfl_xor(ss, 32);
          const float r = rs1[t];
          float sc = r * rsqrtf(r * r * ss * (1.f / 64.f) + EPS);
          if (isq) sc *= 0.125f * LOG2E;
          bf16_t* dst = base + ((size_t)((t >> 12) * 8 + head) * 4096 + (t & 4095)) * 64 + 8 * fq;
#pragma unroll
          for (int bj = 0; bj < 2; ++bj) {
            const f32x4 a = acc[ai][bj][m][0] * gv[bj][0] * sc, b = acc[ai][bj][m][1] * gv[bj][1] * sc;
            *(u32x4*)(dst + 32 * bj) = (u32x4){pk2(a.x, a.y), pk2(a.z, a.w), pk2(b.x, b.y), pk2(b.z, b.w)};
          }
        }
    } else {
      const int ch0 = 128 * (u.pn - 4) + 32 * wc + 8 * fq;
#pragma unroll
      for (int ai = 0; ai < 2; ++ai)
#pragma unroll
        for (int m = 0; m < 4; ++m) {
          const int t = row0 + ai * 128 + m * 16;
          const float r = rs1[t];
          float h[8];
#pragma unroll
          for (int n = 0; n < 2; ++n)
#pragma unroll
            for (int j = 0; j < 4; ++j) h[4 * n + j] = acc[ai][0][m][n][j] * r / (1.f + __expf(-acc[ai][1][m][n][j] * r));
          *(u32x4*)(HG + (size_t)t * 512 + ch0) = (u32x4){pk2(h[0], h[1]), pk2(h[2], h[3]), pk2(h[4], h[5]), pk2(h[6], h[7])};
        }
    }
  }
};
struct EpiVt {
  static constexpr bool PERM = false;
  const float* rs1; bf16_t* Vt;
  __device__ __forceinline__ void operator()(const f32x4 (&acc)[2][2][4][2], const pg8::Unit& u, int wr, int wc, int fr, int fq) const {
    const int pos0 = 8 * (fq & 1) + 4 * (fq >> 1);
#pragma unroll
    for (int bj = 0; bj < 2; ++bj)
#pragma unroll
      for (int n = 0; n < 2; ++n) {
        const int t = u.pn * 256 + bj * 128 + wc * 32 + n * 16 + 4 * fq;
        const f32x4 r = *(const f32x4*)(rs1 + t);
        const size_t tb = ((size_t)(t >> 12) * 8) * 128 + ((t & 4095) >> 5);
#pragma unroll
        for (int ai = 0; ai < 2; ++ai)
#pragma unroll
          for (int m = 0; m < 4; ++m) {
            const int dg = u.pm * 256 + ai * 128 + wr * 64 + m * 16 + fr, head = dg >> 6, d = dg & 63;
            const f32x4 v = acc[ai][bj][m][n] * r;
            *(u32x2*)(Vt + ((tb + (size_t)head * 128) * 64 + d) * 32 + 16 * n + pos0) = (u32x2){pk2(v.x, v.y), pk2(v.z, v.w)};
          }
      }
  }
};
struct EpiOut {
  static constexpr bool PERM = false;
  const bf16_t* xb; bf16_t* HB; float* ssq2;
  __device__ __forceinline__ void operator()(const f32x4 (&acc)[2][2][4][2], const pg8::Unit& u, int wr, int wc, int fr, int fq) const {
    const int row0 = u.pm * 256 + wr * 64 + fr, col0 = u.pn * 256 + wc * 32 + 4 * fq;
#pragma unroll
    for (int ai = 0; ai < 2; ++ai)
#pragma unroll
      for (int m = 0; m < 4; ++m) {
        const int t = row0 + ai * 128 + m * 16;
        const size_t ro = (size_t)t * 1024 + col0;
        float ss = 0.f;
#pragma unroll
        for (int bj = 0; bj < 2; ++bj)
#pragma unroll
          for (int n = 0; n < 2; ++n) {
            const size_t o = ro + bj * 128 + n * 16;
            const u32x2 xv = *(const u32x2*)(xb + o);
            const f32x4 h = (f32x4){bflo(xv.x), bfhi(xv.x), bflo(xv.y), bfhi(xv.y)} + acc[ai][bj][m][n];
            *(u32x2*)(HB + o) = (u32x2){pk2(h.x, h.y), pk2(h.z, h.w)};
            ss += h.x * h.x + h.y * h.y + h.z * h.z + h.w * h.w;
          }
        ss += __shfl_xor(ss, 16);
        ss += __shfl_xor(ss, 32);
        if (fq == 0) atomicAdd(ssq2 + t, ss);
      }
  }
};
struct EpiQh {
  static constexpr bool PERM = true;
  const float* ssq2; bf16_t* QH;
  __device__ __forceinline__ void operator()(const f32x4 (&acc)[2][2][4][2], const pg8::Unit& u, int wr, int wc, int fr, int fq) const {
    const int row0 = u.pm * 256 + wr * 64 + fr, col0 = u.pn * 256 + wc * 32 + 8 * fq;
#pragma unroll
    for (int ai = 0; ai < 2; ++ai)
#pragma unroll
      for (int m = 0; m < 4; ++m) {
        const int t = row0 + ai * 128 + m * 16;
        const float r = rsqrtf(ssq2[t] * (1.f / 1024.f) + EPS);
#pragma unroll
        for (int bj = 0; bj < 2; ++bj) {
          const f32x4 a = acc[ai][bj][m][0] * r, b = acc[ai][bj][m][1] * r;
          *(u32x4*)(QH + (size_t)t * 1024 + col0 + bj * 128) = (u32x4){pk2(a.x, a.y), pk2(a.z, a.w), pk2(b.x, b.y), pk2(b.z, b.w)};
        }
      }
  }
};

__device__ void phase_inproj(const Params& p, char* smem) {
  unsigned char* ws = p.ws;
  LAS unsigned char* lds = (LAS unsigned char*)smem;
  const bf16_t* XB = (const bf16_t*)(ws + WS_XB);
  const float* RS1 = (const float*)(ws + WS_RS1);
  pg8::StaticOrder S;
  {
    pg8::Gemm g{XB, (const bf16_t*)(ws + WS_W1), T, 2048, 1024};
    S.init(T, 2048, gridDim.x, blockIdx.x);
    EpiQKC E{RS1, p.q_norm_g, p.k_norm_g, (bf16_t*)(ws + WS_Q), (bf16_t*)(ws + WS_K), (bf16_t*)(ws + WS_HG)};
    pg8::gemm_phase<EpiQKC>(lds, g, S, E);
  }
  {
    pg8::Gemm g{(const bf16_t*)(ws + WS_WV), XB, 512, T, 1024};
    S.init(512, T, gridDim.x, blockIdx.x);
    EpiVt E{RS1, (bf16_t*)(ws + WS_VT)};
    pg8::gemm_phase<EpiVt>(lds, g, S, E);
  }
}
__device__ void phase_outproj(const Params& p, char* smem) {
  unsigned char* ws = p.ws;
  pg8::Gemm g{(const bf16_t*)(ws + WS_MIX), (const bf16_t*)(ws + WS_WOUT), T, 1024, 1024};
  pg8::StaticOrder S;
  S.init(T, 1024, gridDim.x, blockIdx.x);
  EpiOut E{(const bf16_t*)(ws + WS_XB), (bf16_t*)(ws + WS_HB), (float*)(ws + WS_SSQ2)};
  pg8::gemm_phase<EpiOut>((LAS unsigned char*)smem, g, S, E);
}
__device__ void phase_qproj(const Params& p, char* smem) {
  unsigned char* ws = p.ws;
  pg8::Gemm g{(const bf16_t*)(ws + WS_HB), (const bf16_t*)(ws + WS_WQ), T, 1024, 1024};
  pg8::StaticOrder S;
  S.init(T, 1024, gridDim.x, blockIdx.x);
  EpiQh E{(const float*)(ws + WS_SSQ2), (bf16_t*)(ws + WS_QH)};
  pg8::gemm_phase<EpiQh>((LAS unsigned char*)smem, g, S, E);
}

__device__ void conv_item(const Params& p, int item, char* smem) {
  unsigned char* ws = p.ws;
  const bf16_t* HG = (const bf16_t*)(ws + WS_HG);
  bf16_t* MIX = (bf16_t*)(ws + WS_MIX);
  const int tid512 = otid(), half = tid512 >> 8, tid = tid512 & 255, lane = tid & 63, wave = tid >> 6;
  const int t0 = item * 32, s0 = t0 & 4095;
  for (int idx = tid512; idx < 62 * 64; idx += NTHREADS) {
    const int r = idx >> 6, c16 = idx & 63;
    u32x4 v = {0u, 0u, 0u, 0u};
    if (s0 - 30 + r >= 0) v = *(const u32x4*)(HG + (size_t)(t0 - 30 + r) * 512 + c16 * 8);
    *(u32x4*)(smem + r * 1024 + c16 * 16) = v;
  }
  f32x2 wv[31];
#pragma unroll
  for (int j = 0; j < 31; ++j) {
    const float2 w = *(const float2*)(p.conv_w + j * 512 + 2 * tid);
    wv[j] = (f32x2){w.x, w.y};
  }
  const float2 cb = *(const float2*)(p.conv_b + 2 * tid);
  const float2 lg = *(const float2*)(p.conv_ln_g + 2 * tid);
  const float2 lb = *(const float2*)(p.conv_ln_b + 2 * tid);
  float* red = (float*)(smem + 62 * 1024) + half * 128;
  __syncthreads();
  const bool b5 = lane & 32, b4 = lane & 16, b3 = lane & 8, b2 = lane & 4;
#pragma unroll 1
  for (int rd = 0; rd < 2; ++rd) {
    const int tb = 16 * half + 8 * rd;
    f32x2 xv[38];
#pragma unroll
    for (int r = 0; r < 38; ++r) {
      const unsigned v = *(const unsigned*)(smem + (tb + r) * 1024 + tid * 4);
      xv[r] = (f32x2){bflo(v), bfhi(v)};
    }
    float a0[8], a1[8], st[16];
#pragma unroll
    for (int k = 0; k < 8; ++k) {
      f32x2 u = {cb.x, cb.y};
#pragma unroll
      for (int j = 0; j < 31; ++j) u = __builtin_elementwise_fma(wv[j], xv[k + j], u);
      a0[k] = u.x; a1[k] = u.y;
      st[k] = u.x + u.y;
      st[8 + k] = u.x * u.x + u.y * u.y;
    }
    float r8[8], r4[4], r2[2], r1;
#pragma unroll
    for (int i = 0; i < 8; ++i) { const float keep = b5 ? st[8 + i] : st[i], send = b5 ? st[i] : st[8 + i]; r8[i] = keep + __shfl_xor(send, 32); }
#pragma unroll
    for (int i = 0; i < 4; ++i) { const float keep = b4 ? r8[4 + i] : r8[i], send = b4 ? r8[i] : r8[4 + i]; r4[i] = keep + __shfl_xor(send, 16); }
#pragma unroll
    for (int i = 0; i < 2; ++i) { const float keep = b3 ? r4[2 + i] : r4[i], send = b3 ? r4[i] : r4[2 + i]; r2[i] = keep + __shfl_xor(send, 8); }
    { const float keep = b2 ? r2[1] : r2[0], send = b2 ? r2[0] : r2[1]; r1 = keep + __shfl_xor(send, 4); }
    r1 += __shfl_xor(r1, 2);
    r1 += __shfl_xor(r1, 1);
    float* rr = red + rd * 64;
    if ((lane & 3) == 0) rr[wave * 16 + (lane >> 2)] = r1;
    __syncthreads();
#pragma unroll
    for (int k = 0; k < 8; ++k) {
      const float S1 = (rr[k] + rr[16 + k]) + (rr[32 + k] + rr[48 + k]);
      const float S2 = (rr[8 + k] + rr[24 + k]) + (rr[40 + k] + rr[56 + k]);
      const float mu = S1 * (1.f / 512.f);
      const float var = fmaxf(S2 * (1.f / 512.f) - mu * mu, 0.f);
      const float rstd = rsqrtf(var + EPS);
      const float y0 = (a0[k] - mu) * rstd * lg.x + lb.x, y1 = (a1[k] - mu) * rstd * lg.y + lb.y;
      const float z0 = y0 / (1.f + __expf(-y0)), z1 = y1 / (1.f + __expf(-y1));
      *(unsigned*)(MIX + (size_t)(t0 + tb + k) * 1024 + 512 + 2 * tid) = pk2(z0, z1);
    }
  }
  __syncthreads();
}

struct AttnKV { bf16x8 k[4]; bf16x8 v[2][2]; };
__device__ __forceinline__ void attn_load(const bf16_t* Km, const bf16_t* Vt, int bh, int kb, int tok, int hf, AttnKV& f) {
  const int kc = kb < 0 ? 0 : kb;
  const bf16_t* kp = Km + ((size_t)bh * 4096 + kc * 32 + tok) * 64 + 8 * hf;
#pragma unroll
  for (int ks = 0; ks < 4; ++ks) f.k[ks] = *(const bf16x8*)(kp + ks * 16);
  const bf16_t* vp = Vt + (((size_t)bh * 128 + kc) * 64 + tok) * 32 + hf * 8;
#pragma unroll
  for (int m = 0; m < 2; ++m)
#pragma unroll
    for (int s = 0; s < 2; ++s) f.v[m][s] = *(const bf16x8*)(vp + m * 1024 + s * 16);
}
__device__ __forceinline__ bool attn_block(const AttnKV& f, const bf16x8 (&qf)[4], bool diag, int tok, int hf, float& c, f32x16& o0, f32x16& o1) {
  f32x16 sc;
#pragma unroll
  for (int i = 0; i < 16; ++i) sc[i] = 0.f;
#pragma unroll
  for (int ks = 0; ks < 4; ++ks) sc = mfma32(f.k[ks], qf[ks], sc);
  float lk[16], zs[16];
#pragma unroll
  for (int i = 0; i < 16; ++i) {
    const float zl = sc[i];
    const float e = __builtin_amdgcn_exp2f(zl);
    const float sp = __builtin_amdgcn_logf(1.f + e);
    const bool valid = !diag || ((i & 3) + 8 * (i >> 2) + 4 * hf < tok);
    lk[i] = valid ? -sp : 0.f;
    zs[i] = valid ? zl - sp : -1e30f;
  }
  float Tg[4], Pg[4];
#pragma unroll
  for (int g = 0; g < 4; ++g) {
    Tg[g] = (lk[4 * g] + lk[4 * g + 1]) + (lk[4 * g + 2] + lk[4 * g + 3]);
    Pg[g] = __shfl_xor(Tg[g], 32);
  }
  float base[4];
  float run = 0.f;
#pragma unroll
  for (int g = 3; g >= 0; --g) {
    base[g] = c + run + (hf == 0 ? Pg[g] : 0.f);
    run += Tg[g] + Pg[g];
  }
  float pr[16];
#pragma unroll
  for (int g = 0; g < 4; ++g) {
    float l = base[g];
#pragma unroll
    for (int r = 3; r >= 0; --r) {
      pr[4 * g + r] = __builtin_amdgcn_exp2f(zs[4 * g + r] + l);
      l += lk[4 * g + r];
    }
  }
  c += run;
  bf16x8 pf[2];
#pragma unroll
  for (int s = 0; s < 2; ++s)
#pragma unroll
    for (int j = 0; j < 8; ++j) pf[s][j] = (__bf16)pr[8 * s + j];
#pragma unroll
  for (int s = 0; s < 2; ++s) {
    o0 = mfma32(f.v[0][s], pf[s], o0);
    o1 = mfma32(f.v[1][s], pf[s], o1);
  }
  return __all(c < -150.f);
}
__device__ void attn_tile(const Params& p, int item, int it, int lane, int wave, char* smem) {
  unsigned char* ws = p.ws;
  const bf16_t* Qm = (const bf16_t*)(ws + WS_Q);
  const bf16_t* Km = (const bf16_t*)(ws + WS_K);
  const bf16_t* Vt = (const bf16_t*)(ws + WS_VT);
  bf16_t* MIX = (bf16_t*)(ws + WS_MIX);
  const int qt = item & 127, bh = (item >> 7) * 8 + wave;
  const int tok = lane & 31, hf = lane >> 5;
  bf16x8 qf[4];
  {
    const bf16_t* qp = Qm + ((size_t)bh * 4096 + qt * 32 + tok) * 64 + 8 * hf;
#pragma unroll
    for (int ks = 0; ks < 4; ++ks) qf[ks] = *(const bf16x8*)(qp + ks * 16);
  }
  f32x16 o0, o1;
#pragma unroll
  for (int i = 0; i < 16; ++i) { o0[i] = 0.f; o1[i] = 0.f; }
  float c = 0.f;
  AttnKV fa, fb;
  attn_load(Km, Vt, bh, qt, tok, hf, fa);
  {
    unsigned z = __builtin_bit_cast(u32x4, fa.v[1][1]).w | __builtin_bit_cast(u32x4, fa.k[3]).w | __builtin_bit_cast(u32x4, qf[3]).w;
    asm volatile("" ::"v"(z));
  }
  for (int kb = qt;; kb -= 2) {
    attn_load(Km, Vt, bh, kb - 1, tok, hf, fb);
    __builtin_amdgcn_sched_barrier(0);
    if (attn_block(fa, qf, kb == qt, tok, hf, c, o0, o1) || kb == 0) break;
    attn_load(Km, Vt, bh, kb - 2, tok, hf, fa);
    __builtin_amdgcn_sched_barrier(0);
    if (attn_block(fb, qf, false, tok, hf, c, o0, o1) || kb == 1) break;
  }
  float ssq = 0.f;
#pragma unroll
  for (int i = 0; i < 16; ++i) ssq += o0[i] * o0[i] + o1[i] * o1[i];
  ssq += __shfl_xor(ssq, 32);
  float* xch = (float*)(smem + 100 * 1024) + (it & 1) * 256;
  if (hf == 0) xch[wave * 32 + tok] = ssq;
  __syncthreads();
  float tot = 0.f;
#pragma unroll
  for (int w = 0; w < NWAVES; ++w) tot += xch[w * 32 + tok];
  const float rs = rsqrtf(tot * (1.f / 512.f) + EPS);
  const int t = (bh >> 3) * 4096 + qt * 32 + tok, hh = bh & 7;
  bf16_t* dst = MIX + (size_t)t * 1024 + hh * 64 + 4 * hf;
#pragma unroll
  for (int g = 0; g < 4; ++g) {
    *(u32x2*)(dst + 8 * g) = (u32x2){pk2(o0[4 * g] * rs, o0[4 * g + 1] * rs), pk2(o0[4 * g + 2] * rs, o0[4 * g + 3] * rs)};
    *(u32x2*)(dst + 32 + 8 * g) = (u32x2){pk2(o1[4 * g] * rs, o1[4 * g + 1] * rs), pk2(o1[4 * g + 2] * rs, o1[4 * g + 3] * rs)};
  }
}

__device__ void phase_mix(const Params& p, char* smem) {
  static_assert(NWAVES == 8, "one wave per attention head");
  const int vb = vblock(), G = gridDim.x;
  if (blockIdx.x & 1) prep_tables(p);
  for (int item = vb; item < 1024; item += G) conv_item(p, item, smem);
  const int tidm = otid();
  const int lane = tidm & 63, wave = tidm >> 6;
  int it = 0;
  for (int item = vb; item < 1024; item += G, ++it) attn_tile(p, item, it, lane, wave, smem);
  if (!(blockIdx.x & 1)) prep_tables(p);
}
__device__ __forceinline__ unsigned f2key(float f, unsigned n) {
  const unsigned u = (__float_as_uint(f) & ~0x7Fu) | n;
  return u ^ ((unsigned)((int)u >> 31) | 0x80000000u);
}
__device__ __forceinline__ unsigned f2key_raw(float f) {
  const unsigned u = __float_as_uint(f);
  return u ^ ((unsigned)((int)u >> 31) | 0x80000000u);
}
__device__ __forceinline__ unsigned key2u(unsigned k) { return k ^ ((k >> 31) ? 0x80000000u : 0xFFFFFFFFu); }

template <int N>
__device__ __forceinline__ void bitonic_sort_desc(unsigned (&v)[N]) {
#pragma unroll
  for (int k = 2; k <= N; k <<= 1) {
#pragma unroll
    for (int j = k >> 1; j > 0; j >>= 1) {
#pragma unroll
      for (int i = 0; i < N; ++i) {
        const int l = i ^ j;
        if (l > i) {
          const bool desc = ((i & k) == 0);
          const unsigned mx = max(v[i], v[l]), mn = min(v[i], v[l]);
          v[i] = desc ? mx : mn;
          v[l] = desc ? mn : mx;
        }
      }
    }
  }
}
template <int N>
__device__ __forceinline__ void bitonic_merge_desc(unsigned (&v)[N]) {
#pragma unroll
  for (int j = N >> 1; j > 0; j >>= 1) {
#pragma unroll
    for (int i = 0; i < N; ++i) {
      const int l = i ^ j;
      if (l > i) {
        const unsigned mx = max(v[i], v[l]), mn = min(v[i], v[l]);
        v[i] = mx;
        v[l] = mn;
      }
    }
  }
}
__device__ __forceinline__ void merge_top16(unsigned (&a)[16], const unsigned (&b)[16]) {
#pragma unroll
  for (int i = 0; i < 16; ++i) a[i] = max(a[i], b[15 - i]);
  bitonic_merge_desc<16>(a);
}
#define CEP(ka, pa, kb, pb, desc)                                  \
  {                                                                \
    const bool sw_ = (desc) ? ((kb) > (ka)) : ((kb) < (ka));       \
    const unsigned tk_ = sw_ ? (kb) : (ka), tl_ = sw_ ? (ka) : (kb); \
    const unsigned tp_ = sw_ ? (pb) : (pa), tq_ = sw_ ? (pa) : (pb); \
    ka = tk_; kb = tl_; pa = tp_; pb = tq_;                        \
  }
template <int N>
__device__ __forceinline__ void bitonic_sort_desc_p(unsigned (&v)[N], unsigned (&pl)[N]) {
#pragma unroll
  for (int k = 2; k <= N; k <<= 1) {
#pragma unroll
    for (int j = k >> 1; j > 0; j >>= 1) {
#pragma unroll
      for (int i = 0; i < N; ++i) {
        const int l = i ^ j;
        if (l > i) {
          const bool desc = ((i & k) == 0);
          CEP(v[i], pl[i], v[l], pl[l], desc);
        }
      }
    }
  }
}
template <int N>
__device__ __forceinline__ void bitonic_merge_desc_p(unsigned (&v)[N], unsigned (&pl)[N]) {
#pragma unroll
  for (int j = N >> 1; j > 0; j >>= 1) {
#pragma unroll
    for (int i = 0; i < N; ++i) {
      const int l = i ^ j;
      if (l > i) { CEP(v[i], pl[i], v[l], pl[l], true); }
    }
  }
}
__device__ __forceinline__ void merge_top16_p(unsigned (&a)[16], unsigned (&pa)[16], const unsigned (&b)[16], const unsigned (&pb)[16]) {
#pragma unroll
  for (int i = 0; i < 16; ++i) {
    const bool s = b[15 - i] > a[i];
    a[i] = s ? b[15 - i] : a[i];
    pa[i] = s ? pb[15 - i] : pa[i];
  }
  bitonic_merge_desc_p<16>(a, pa);
}

constexpr int KROW = 144;
__device__ __forceinline__ void subkey_top16(const LAS unsigned char* Kl, const bf16_t* __restrict__ qrow, int lane, unsigned (&top)[16]) {
  const int tok = lane & 31, hf = lane >> 5;
  f32x16 acc[4];
#pragma unroll
  for (int m = 0; m < 4; ++m)
#pragma unroll
    for (int i = 0; i < 16; ++i) acc[m][i] = 0.f;
  bf16x8 bq[4];
#pragma unroll
  for (int ks = 0; ks < 4; ++ks) bq[ks] = *(const bf16x8*)(qrow + ks * 16 + 8 * hf);
#pragma unroll 1
  for (int ks = 0; ks < 4; ++ks) {
#pragma unroll
    for (int m = 0; m < 4; ++m) {
      const bf16x8 ak = *(const LAS bf16x8*)(Kl + (m * 32 + tok) * KROW + ks * 32 + hf * 16);
      acc[m] = mfma32(ak, ks == 0 ? bq[0] : ks == 1 ? bq[1] : ks == 2 ? bq[2] : bq[3], acc[m]);
    }
  }
  unsigned g[4][16];
#pragma unroll
  for (int m = 0; m < 4; ++m) {
#pragma unroll
    for (int i = 0; i < 16; ++i) g[m][i] = f2key(acc[m][i], (unsigned)(m * 32 + (i & 3) + 8 * (i >> 2) + 4 * hf));
    bitonic_sort_desc<16>(g[m]);
  }
  merge_top16(g[0], g[1]);
  merge_top16(g[2], g[3]);
  merge_top16(g[0], g[2]);
  unsigned o[16];
#pragma unroll
  for (int i = 0; i < 16; ++i) o[i] = __shfl_xor(g[0][i], 32);
  merge_top16(g[0], o);
#pragma unroll
  for (int i = 0; i < 16; ++i) top[i] = g[0][i];
}

__device__ void phase_route(const Params& p, char* smem) {
  unsigned char* ws = p.ws;
  const bf16_t* K1 = (const bf16_t*)(ws + WS_K1);
  const bf16_t* K2 = (const bf16_t*)(ws + WS_K2);
  const bf16_t* QH = (const bf16_t*)(ws + WS_QH);
  const bf16_t* HB = (const bf16_t*)(ws + WS_HB);
  unsigned char* XN8 = ws + WS_XN8;
  const float* SSQ2 = (const float*)(ws + WS_SSQ2);
  unsigned* PIDX = (unsigned*)(ws + WS_PIDX);
  float* PG = (float*)(ws + WS_PG);
  const int tidr = otid();
  const int lane = tidr & 63, wave = tidr >> 6, gw = vblock() * NWAVES + wave, nw = gridDim.x * NWAVES;
  for (int t = gw; t < T; t += nw) {
    const bf16_t* src = HB + (size_t)t * 1024 + lane * 16;
    const float r = rsqrtf(SSQ2[t] * (1.f / 1024.f) + EPS) * 16.f;
    const u32x4 h0 = *(const u32x4*)src, h1 = *(const u32x4*)(src + 8);
    u32x4 q;
#pragma unroll
    for (int i = 0; i < 4; ++i) {
      const f32x4 g4 = *(const f32x4*)(p.norm_ffn_g + lane * 16 + 4 * i);
      const unsigned lo = (i < 2) ? h0[2 * i] : h1[2 * i - 4], hi = (i < 2) ? h0[2 * i + 1] : h1[2 * i - 3];
      int w = 0;
      w = __builtin_amdgcn_cvt_pk_fp8_f32(bflo(lo) * r * g4.x, bfhi(lo) * r * g4.y, w, false);
      w = __builtin_amdgcn_cvt_pk_fp8_f32(bflo(hi) * r * g4.z, bfhi(hi) * r * g4.w, w, true);
      q[i] = (unsigned)w;
    }
    *(u32x4*)(XN8 + (size_t)t * 1024 + lane * 16) = q;
  }
  const int G = gridDim.x, nh = (G % 8 == 0) ? 8 : 1;
  LAS unsigned char* K1l = (LAS unsigned char*)smem;
  LAS unsigned char* K2l = K1l + 128 * KROW;
  for (int hd = blockIdx.x % nh; hd < 8; hd += nh) {
    for (int idx = tidr; idx < 2048; idx += NTHREADS) {
      const int tb = idx >> 10, row = (idx >> 3) & 127, ch = idx & 7;
      const u32x4 v = *(const u32x4*)((tb ? K2 : K1) + hd * 8192 + row * 64 + ch * 8);
      *(LAS u32x4*)((tb ? K2l : K1l) + row * KROW + ch * 16) = v;
    }
    __syncthreads();
    for (int tile = (blockIdx.x / nh) * NWAVES + wave; tile < T / 32; tile += (G / nh) * NWAVES) {
      const int t0 = tile * 32;
      const int tok = lane & 31, hf = lane >> 5;
      const bf16_t* qrow = QH + (size_t)(t0 + tok) * 1024 + hd * 128;
      unsigned top1[16], top2[16];
      subkey_top16(K1l, qrow, lane, top1);
      subkey_top16(K2l, qrow + 64, lane, top2);
      float fa[16], fb[16];
      unsigned ia[16], ib[16];
#pragma unroll
      for (int i = 0; i < 16; ++i) {
        const unsigned ua = key2u(hf ? top2[i] : top1[i]), ub = key2u(hf ? top1[i] : top2[i]);
        fa[i] = __uint_as_float(ua); ia[i] = ua & 0x7Fu;
        fb[i] = __uint_as_float(ub); ib[i] = ub & 0x7Fu;
      }
      unsigned ck[32];
      {
        int n = 0;
#pragma unroll
        for (int i = 0; i < 4; ++i) {
#pragma unroll
          for (int j = i; j < 16; ++j) {
            if ((i + 1) * (j + 1) <= 16) {
              unsigned key = (f2key_raw(fa[i] + fb[j]) & ~0x3FFFu) | (hf ? ((ib[j] << 7) | ia[i]) : ((ia[i] << 7) | ib[j]));
              if (i == j && hf) key = 0u;
              ck[n] = key;
              ++n;
            }
          }
        }
#pragma unroll
        for (; n < 32; ++n) ck[n] = 0u;
      }
      unsigned k0[16], k1[16];
#pragma unroll
      for (int i = 0; i < 16; ++i) { k0[i] = ck[i]; k1[i] = ck[16 + i]; }
      bitonic_sort_desc<16>(k0);
      bitonic_sort_desc<16>(k1);
      merge_top16(k0, k1);
#pragma unroll
      for (int i = 0; i < 16; ++i) k1[i] = __shfl_xor(k0[i], 32);
      merge_top16(k0, k1);
      float sv[16], sum = 0.f;
      const float mx = __uint_as_float(key2u(k0[0] & ~0x3FFFu));
#pragma unroll
      for (int i = 0; i < 16; ++i) {
        sv[i] = __builtin_amdgcn_exp2f((__uint_as_float(key2u(k0[i] & ~0x3FFFu)) - mx) * LOG2E);
        sum += sv[i];
      }
      const float inv = 1.f / sum;
      const size_t po = ((size_t)(t0 + tok) * 8 + hd) * 16;
      if (hf == 0) {
#pragma unroll
        for (int q = 0; q < 4; ++q) *(u32x4*)(PIDX + po + 4 * q) = (u32x4){k0[4 * q] & 0x3FFFu, k0[4 * q + 1] & 0x3FFFu, k0[4 * q + 2] & 0x3FFFu, k0[4 * q + 3] & 0x3FFFu};
      } else {
#pragma unroll
        for (int q = 0; q < 4; ++q) *(f32x4*)(PG + po + 4 * q) = (f32x4){sv[4 * q] * inv, sv[4 * q + 1] * inv, sv[4 * q + 2] * inv, sv[4 * q + 3] * inv};
      }
    }
    __syncthreads();
  }
}

typedef int i32x8 __attribute__((ext_vector_type(8)));
__device__ __forceinline__ f32x4 mfma_fp4_fp8(u32x4 a, u32x4 b0, u32x4 b1, f32x4 c) {
  const i32x8 A = {(int)a.x, (int)a.y, (int)a.z, (int)a.w, 0, 0, 0, 0};
  const i32x8 B = {(int)b0.x, (int)b0.y, (int)b0.z, (int)b0.w, (int)b1.x, (int)b1.y, (int)b1.z, (int)b1.w};
  return __builtin_amdgcn_mfma_scale_f32_16x16x128_f8f6f4(A, B, c, 4, 0, 0, 0x7F7F7F7F, 0, 0x7F7F7F7F);
}
struct PeCtx {
  const unsigned char* U8; const float2* USV; LAS float* glist;
  LAS unsigned* list; int lane, r, g, s, n, t0;
};
__device__ __forceinline__ void pe_rows(const PeCtx& c, int ci, u32x4 (&a)[8]) {
  const int idx = ci * 16 + (c.lane >> 2);
  const unsigned ent = c.list[idx & 2047];
  const unsigned e = (idx < c.n) ? ((ent >> 7) & 16383u) : (unsigned)(c.s << 11);
  const unsigned char* rp = c.U8 + (size_t)e * 512 + (c.lane & 3) * 16;
#pragma unroll
  for (int ks = 0; ks < 8; ++ks) a[ks] = *(const u32x4*)(rp + ks * 64);
}
__device__ __forceinline__ void pe_fix(const PeCtx& c, u32x4 (&a)[8]) {
  const int src = 4 * c.r + c.g;
#pragma unroll
  for (int ks = 0; ks < 8; ++ks) {
    a[ks].x = (unsigned)__shfl((int)a[ks].x, src); a[ks].y = (unsigned)__shfl((int)a[ks].y, src);
    a[ks].z = (unsigned)__shfl((int)a[ks].z, src); a[ks].w = (unsigned)__shfl((int)a[ks].w, src);
  }
}
__device__ __forceinline__ void pe_chunk(const PeCtx& c, int ci, u32x4 (&a)[8], u32x4 (&anext)[8], const u32x4 (&bq)[16]) {
  const int idx = ci * 16 + c.r;
  const unsigned ent = c.list[idx & 2047];
  const bool fin = (c.lane < 16) && (idx < c.n);
  const unsigned e = (ent >> 7) & 16383u, col = (ent >> 21) & 15u;
  const float2 usv = c.USV[fin ? e : 0u];
  const float gt = c.glist[idx & 2047], us = usv.x, vs = usv.y;
  __builtin_amdgcn_sched_barrier(0);
  pe_rows(c, ci + 1, anext);
  __builtin_amdgcn_sched_barrier(0);
  pe_fix(c, a);
  f32x4 acc = {0.f, 0.f, 0.f, 0.f};
#pragma unroll
  for (int ks = 0; ks < 8; ++ks) acc = mfma_fp4_fp8(a[ks], bq[2 * ks], bq[2 * ks + 1], acc);
  const int src = ((c.r >> 2) << 4) | (int)col;
  const float v0 = __shfl(acc[0], src), v1 = __shfl(acc[1], src), v2 = __shfl(acc[2], src), v3 = __shfl(acc[3], src);
  float d = ((c.r & 3) == 0) ? v0 : ((c.r & 3) == 1) ? v1 : ((c.r & 3) == 2) ? v2 : v3;
  float gt_ = gt, us_ = us, vs_ = vs;
  asm volatile("" : "+v"(d), "+v"(gt_), "+v"(us_), "+v"(vs_));
  {
    const float act = d * us_ * (1.f / 16.f);
    const float w = gt_ * 0.5f * act * (1.f + erff(act * 0.70710678118654752f)) * vs_;
    if (fin) c.glist[idx & 2047] = w;
  }
}
#define PFV_LOAD(R, ev, k0)                                                                               \
  {                                                                                                       \
    _Pragma("unroll") for (int i_ = 0; i_ < 8; ++i_) {                                                    \
      const unsigned e_ = (unsigned)__builtin_amdgcn_ds_bpermute(bsel + 4 * ((k0) + 2 * i_), (int)(ev)); \
      R[i_] = *(const u32x4*)(V4 + (e_ << 9));                                                            \
    }                                                                                                     \
  }
#define PFV_FMA(dw, b, a) acc[a] = __builtin_elementwise_fma(__builtin_amdgcn_cvt_scalef32_pk_f32_fp4(dw, 1.0f, b), w2_, acc[a]);
#define PFV_ACC(R, wv, k0)                                                                                \
  {                                                                                                       \
    _Pragma("unroll") for (int i_ = 0; i_ < 8; ++i_) {                                                    \
      const float ws_ = __builtin_bit_cast(float, __builtin_amdgcn_ds_bpermute(bsel + 4 * ((k0) + 2 * i_), __builtin_bit_cast(int, (wv)))); \
      const f32x2 w2_ = {ws_, ws_};                                                                       \
      PFV_FMA(R[i_].x, 0, 0)  PFV_FMA(R[i_].x, 1, 1)  PFV_FMA(R[i_].x, 2, 2)  PFV_FMA(R[i_].x, 3, 3)      \
      PFV_FMA(R[i_].y, 0, 4)  PFV_FMA(R[i_].y, 1, 5)  PFV_FMA(R[i_].y, 2, 6)  PFV_FMA(R[i_].y, 3, 7)      \
      PFV_FMA(R[i_].z, 0, 8)  PFV_FMA(R[i_].z, 1, 9)  PFV_FMA(R[i_].z, 2, 10) PFV_FMA(R[i_].z, 3, 11)     \
      PFV_FMA(R[i_].w, 0, 12) PFV_FMA(R[i_].w, 1, 13) PFV_FMA(R[i_].w, 2, 14) PFV_FMA(R[i_].w, 3, 15)     \
    }                                                                                                     \
  }
__device__ void phase_peer_u(const Params& p, char* smem) {
  unsigned char* ws = p.ws;
  PeCtx c;
  c.U8 = ws + WS_U8; c.USV = (const float2*)(ws + WS_USV);
  const float* PG = (const float*)(ws + WS_PG);
  const bf16_t* HB = (const bf16_t*)(ws + WS_HB);
  const unsigned char* XN8 = ws + WS_XN8;
  const unsigned* PIDX = (const unsigned*)(ws + WS_PIDX);
  const int tidu = otid();
  const int lane = tidu & 63, wave = tidu >> 6;
  c.lane = lane; c.r = lane & 15; c.g = lane >> 4;
  c.list = (LAS unsigned*)(smem + wave * 8192);
  c.glist = (LAS float*)(smem + 65536 + wave * 8192);
  const bool hi = lane >= 32;
  const int bsel = hi ? 4 : 0;
  const unsigned char* V4 = ws + WS_V8 + (lane & 31) * 16;
  c.s = 0;
  {
    for (int grp = vblock() * NWAVES + wave; grp < T / 16; grp += gridDim.x * NWAVES) {
      const int t0 = grp * 16;
      c.t0 = t0;
      u32x4 bq[16];
      {
        const unsigned char* xp = XN8 + (size_t)(t0 + c.r) * 1024 + c.g * 16;
#pragma unroll
        for (int ks = 0; ks < 8; ++ks) { bq[2 * ks] = *(const u32x4*)(xp + ks * 128); bq[2 * ks + 1] = *(const u32x4*)(xp + ks * 128 + 64); }
      }
      const int n = 2048;
#pragma unroll
      for (int q = 0; q < 8; ++q) {
        const u32x4 idv = *(const u32x4*)(PIDX + (size_t)t0 * 128 + q * 256 + lane * 4);
        const f32x4 gv = *(const f32x4*)(PG + (size_t)t0 * 128 + q * 256 + lane * 4);
        const unsigned hi = (unsigned)(2 * q + (lane >> 5)) << 21, sl = (unsigned)((lane & 31) * 4);
        *(LAS u32x4*)(c.list + q * 256 + lane * 4) = (u32x4){hi | (idv.x << 7) | sl, hi | (idv.y << 7) | (sl + 1), hi | (idv.z << 7) | (sl + 2), hi | (idv.w << 7) | (sl + 3)};
        *(LAS f32x4*)(c.glist + q * 256 + lane * 4) = gv;
      }
      asm volatile("s_waitcnt lgkmcnt(0)" ::: "memory");
      c.n = n;
      const int nch = (n + 15) >> 4;
      u32x4 a0[8], a1[8];
      pe_rows(c, 0, a0);
      {
        unsigned z = 0u;
#pragma unroll
        for (int ks = 0; ks < 8; ++ks) z |= a0[ks].w;
        asm volatile("" ::"v"(z));
      }
      if (nch > 0) {
        for (int ci = 0;; ci += 2) {
          pe_chunk(c, ci, a0, a1, bq);
          if (ci + 1 >= nch) break;
          pe_chunk(c, ci + 1, a1, a0, bq);
          if (ci + 2 >= nch) break;
        }
      }
      asm volatile("s_waitcnt lgkmcnt(0)" ::: "memory");
      {
        unsigned e0 = (c.list[lane] >> 7) & 16383u, e1 = (c.list[64 + lane] >> 7) & 16383u;
        float w0 = c.glist[lane], w1 = c.glist[64 + lane];
        u32x4 RA[8], RB[8];
        PFV_LOAD(RA, e0, 0)
        {
          unsigned z = 0u;
#pragma unroll
          for (int i = 0; i < 8; ++i) z |= RA[i].w;
          asm volatile("" ::"v"(z));
        }
        for (int tk = 0; tk < 16; ++tk) {
          const int tn = tk < 15 ? tk + 1 : tk;
          const unsigned e0n = (c.list[tn * 128 + lane] >> 7) & 16383u, e1n = (c.list[tn * 128 + 64 + lane] >> 7) & 16383u;
          const float w0n = c.glist[tn * 128 + lane], w1n = c.glist[tn * 128 + 64 + lane];
          const size_t oo = (size_t)(t0 + tk) * 1024 + (lane & 31) * 32 + (hi ? 16 : 0);
          const u32x4 hb0 = *(const u32x4*)(HB + oo), hb1 = *(const u32x4*)(HB + oo + 8);
          f32x2 acc[16];
#pragma unroll
          for (int k = 0; k < 16; ++k) acc[k] = (f32x2){0.f, 0.f};
          __builtin_amdgcn_sched_barrier(0);
          PFV_LOAD(RB, e0, 16)  __builtin_amdgcn_sched_barrier(0);  PFV_ACC(RA, w0, 0)
          PFV_LOAD(RA, e0, 32)  __builtin_amdgcn_sched_barrier(0);  PFV_ACC(RB, w0, 16)
          PFV_LOAD(RB, e0, 48)  __builtin_amdgcn_sched_barrier(0);  PFV_ACC(RA, w0, 32)
          PFV_LOAD(RA, e1, 0)   __builtin_amdgcn_sched_barrier(0);  PFV_ACC(RB, w0, 48)
          PFV_LOAD(RB, e1, 16)  __builtin_amdgcn_sched_barrier(0);  PFV_ACC(RA, w1, 0)
          PFV_LOAD(RA, e1, 32)  __builtin_amdgcn_sched_barrier(0);  PFV_ACC(RB, w1, 16)
          PFV_LOAD(RB, e1, 48)  __builtin_amdgcn_sched_barrier(0);  PFV_ACC(RA, w1, 32)
          PFV_LOAD(RA, e0n, 0)  __builtin_amdgcn_sched_barrier(0);  PFV_ACC(RB, w1, 48)
          f32x2 r[8];
#pragma unroll
          for (int k = 0; k < 8; ++k) {
            const f32x2 keep = hi ? acc[8 + k] : acc[k], send = hi ? acc[k] : acc[8 + k];
            r[k] = keep + (f32x2){__shfl_xor(send.x, 32), __shfl_xor(send.y, 32)};
          }
          float* o = p.out + oo;
          *(f32x4*)(o)      = (f32x4){bflo(hb0.x) + r[0].x, bfhi(hb0.x) + r[0].y, bflo(hb0.y) + r[1].x, bfhi(hb0.y) + r[1].y};
          *(f32x4*)(o + 4)  = (f32x4){bflo(hb0.z) + r[2].x, bfhi(hb0.z) + r[2].y, bflo(hb0.w) + r[3].x, bfhi(hb0.w) + r[3].y};
          *(f32x4*)(o + 8)  = (f32x4){bflo(hb1.x) + r[4].x, bfhi(hb1.x) + r[4].y, bflo(hb1.y) + r[5].x, bfhi(hb1.y) + r[5].y};
          *(f32x4*)(o + 12) = (f32x4){bflo(hb1.z) + r[6].x, bfhi(hb1.z) + r[6].y, bflo(hb1.w) + r[7].x, bfhi(hb1.w) + r[7].y};
          e0 = e0n; e1 = e1n; w0 = w0n; w1 = w1n;
        }
      }
      asm volatile("" ::: "memory");
    }
  }
}
#undef PFV_LOAD
#undef PFV_FMA
#undef PFV_ACC


#define XB_TMO      128
#define XB_XCNT(j)  (256  + 64 * (j))
#define XB_XSUB(j)  (1280 + 64 * (j))
#define XB_XGEN(j)  (2304 + 64 * (j))
#define XB_TOP      3328
#define XB_TOPGEN   3392
#define XCD_BAR_WORDS 3456
#define XB_SPIN_CAP (1u << 22)
__device__ __forceinline__ unsigned xb_ld(unsigned* p)              { return __hip_atomic_load(p, __ATOMIC_RELAXED, __HIP_MEMORY_SCOPE_AGENT); }
__device__ __forceinline__ unsigned xb_add(unsigned* p, unsigned v) { return __hip_atomic_fetch_add(p, v, __ATOMIC_RELAXED, __HIP_MEMORY_SCOPE_AGENT); }
__device__ __forceinline__ unsigned xb_xcc_id() { return (unsigned)__builtin_amdgcn_s_getreg((3 << 11) | 20) & 0xFu; }
#define XB_SPIN(cond, bar) do { unsigned _sp = 0; while (cond) { __builtin_amdgcn_s_sleep(1); \
    if ((++_sp & 255u) == 0u) { if (xb_ld(&(bar)[XB_TMO])) break; if (_sp > XB_SPIN_CAP) { atomicAdd(&(bar)[XB_TMO], 1u); break; } } } } while (0)
struct XcdBarrier { unsigned* bar; unsigned x; volatile LAS unsigned* st; };
__device__ __forceinline__ XcdBarrier xcd_barrier_post(unsigned* bar, volatile LAS unsigned* st) {
    XcdBarrier b; b.bar = bar; b.x = xb_xcc_id(); b.st = st;
    if (threadIdx.x == 0) (void)xb_add(&bar[XB_XCNT(b.x)], 1u);
    return b;
}
__device__ __forceinline__ void xcd_barrier_complete(unsigned* bar, unsigned x, unsigned& nloc, unsigned& nx) {
    const unsigned G = gridDim.x * gridDim.y * gridDim.z;
    unsigned sum, cnt, mine, sp = 0u;
    for (;;) {
        sum = 0u; cnt = 0u; mine = 0u;
#pragma unroll
        for (unsigned j = 0; j < 16; ++j) { const unsigned c = xb_ld(&bar[XB_XCNT(j)]); sum += c; cnt += (c > 0u) ? 1u : 0u; mine = (j == x) ? c : mine; }
        if (sum == G) break;
        __builtin_amdgcn_s_sleep(1);
        if ((++sp & 255u) == 0u) { if (xb_ld(&bar[XB_TMO])) break; if (sp > XB_SPIN_CAP) { atomicAdd(&bar[XB_TMO], 1u); break; } }
    }
    nloc = mine > 0u ? mine : 1u; nx = cnt > 0u ? cnt : 1u;
}
__device__ __forceinline__ void xcd_barrier(const XcdBarrier& b) {
    asm volatile("s_waitcnt vmcnt(0)" ::: "memory");
    __syncthreads();
    if (threadIdx.x == 0) {
        unsigned* bar = b.bar;
        __builtin_amdgcn_s_waitcnt(0);
        unsigned nloc = b.st[0], nx = b.st[1];
        if (nloc == 0u) { xcd_barrier_complete(bar, b.x, nloc, nx); b.st[0] = nloc; b.st[1] = nx; }
        const unsigned old = xb_add(&bar[XB_XSUB(b.x)], 1u);
        const unsigned gen = old / nloc;
        if (old + 1u == (gen + 1u) * nloc) {
            __builtin_amdgcn_fence(__ATOMIC_RELEASE, "agent");
            asm volatile("s_waitcnt vmcnt(0)" ::: "memory");
            const unsigned og = xb_add(&bar[XB_TOP], 1u);
            const unsigned tg = og / nx;
            if (og + 1u == (tg + 1u) * nx) xb_add(&bar[XB_TOPGEN], 1u);
            else XB_SPIN(xb_ld(&bar[XB_TOPGEN]) == tg, bar);
            __builtin_amdgcn_fence(__ATOMIC_ACQUIRE, "agent");
            xb_add(&bar[XB_XGEN(b.x)], 1u);
            asm volatile("s_waitcnt vmcnt(0)" ::: "memory");
        } else {
            XB_SPIN(xb_ld(&bar[XB_XGEN(b.x)]) == gen, bar);
            __builtin_amdgcn_fence(__ATOMIC_ACQUIRE, "agent");
            asm volatile("s_waitcnt vmcnt(0)" ::: "memory");
        }
    }
    __syncthreads();
}

__global__ void __launch_bounds__(NTHREADS, 2) k_fused(Params p) {
  __shared__ __attribute__((aligned(16))) char smem[LDS_BYTES];
  if (threadIdx.x == 0) *(u32x4*)(smem + LDS_BAR) = (u32x4){0u, 0u, 0u, 0u};
  __syncthreads();
  const XcdBarrier bar = xcd_barrier_post((unsigned*)(p.ws + WS_CTL), (volatile LAS unsigned*)(smem + LDS_BAR));
#ifdef PROBE_PHASE
  unsigned long long ts[12];
#define STAMP(k) ts[k] = __builtin_amdgcn_s_memrealtime();
#else
#define STAMP(k)
#endif
  STAMP(0)
  phase_prep(p);
  xcd_barrier(bar);
  STAMP(1)
  phase_inproj(p, smem);
  xcd_barrier(bar);
  STAMP(2)
  phase_mix(p, smem);
  xcd_barrier(bar);
  STAMP(3)
  phase_outproj(p, smem);
  xcd_barrier(bar);
  STAMP(4)
  phase_qproj(p, smem);
  xcd_barrier(bar);
  STAMP(5)
  phase_route(p, smem);
  xcd_barrier(bar);
  STAMP(6)
  phase_peer_u(p, smem);
#ifdef PROBE_PHASE
  xcd_barrier(bar);
  STAMP(7)
  if (blockIdx.x == 0 && threadIdx.x == 0) {
    const float us = (float)(ts[PROBE_PHASE + 1] - ts[PROBE_PHASE]) * 0.01f;
    p.out[12345] += us * (1.f / PROBE_DIV);
  }
#endif
}

extern "C" void kernel_launch(void* const* d_in, const int* in_sizes, int n_in, void* d_out, int out_size, void* d_ws, size_t ws_size,
                              hipStream_t stream) {
  if (n_in != 17 || ws_size < WS_END) {
    fprintf(stderr, "kernel_launch: unexpected n_in %d / ws_size %zu\n", n_in, ws_size);
    return;
  }
  Params p{};
  p.x = (const float*)d_in[0]; p.norm_mix_g = (const float*)d_in[1]; p.w_in = (const float*)d_in[2]; p.q_norm_g = (const float*)d_in[3];
  p.k_norm_g = (const float*)d_in[4]; p.attn_out_g = (const float*)d_in[5]; p.conv_w = (const float*)d_in[6]; p.conv_b = (const float*)d_in[7];
  p.conv_ln_g = (const float*)d_in[8]; p.conv_ln_b = (const float*)d_in[9]; p.w_out = (const float*)d_in[10]; p.norm_ffn_g = (const float*)d_in[11];
  p.peer_wq = (const float*)d_in[12]; p.peer_k1 = (const float*)d_in[13]; p.peer_k2 = (const float*)d_in[14]; p.peer_u = (const float*)d_in[15];
  p.peer_v = (const float*)d_in[16];
  p.out = (float*)d_out;
  p.ws = (unsigned char*)d_ws;
  static int grid_blocks = 0;
  if (!grid_blocks) {
    int dev = 0, cus = 0, per_cu = 0;
    (void)hipGetDevice(&dev);
    (void)hipDeviceGetAttribute(&cus, hipDeviceAttributeMultiprocessorCount, dev);
    (void)hipOccupancyMaxActiveBlocksPerMultiprocessor(&per_cu, k_fused, NTHREADS, 0);
    if (per_cu > 1) per_cu = 1;
    if (per_cu < 1) per_cu = 1;
    grid_blocks = cus * per_cu;
  }
  (void)hipMemsetAsync((char*)d_ws + WS_CTL, 0, XCD_BAR_WORDS * 4, stream);
  hipLaunchKernelGGL(k_fused, dim3(grid_blocks), dim3(NTHREADS), 0, stream, p);
}
```

```cpp
#include <hip/hip_runtime.h>
#include <cstdio>

#define LAS __attribute__((address_space(3)))
typedef unsigned short bf16_t;
typedef __bf16 bf16x8 __attribute__((ext_vector_type(8)));
typedef __bf16 bf16x2 __attribute__((ext_vector_type(2)));
typedef float f32x4 __attribute__((ext_vector_type(4)));
typedef float f32x16 __attribute__((ext_vector_type(16)));
typedef unsigned u32x4 __attribute__((ext_vector_type(4)));
typedef unsigned u32x2 __attribute__((ext_vector_type(2)));
typedef float f32x2 __attribute__((ext_vector_type(2)));

constexpr int SEQ = 4096, T = 8 * SEQ, D = 1024, NIN = 2560;
constexpr float EPS = 1e-6f;
constexpr float LOG2E = 1.4426950408889634f;

constexpr size_t MiB = 1u << 20;
constexpr size_t WS_W1 = 0, WS_WV = 4 * MiB, WS_WOUT = 5 * MiB, WS_WQ = 7 * MiB, WS_K1 = 9 * MiB, WS_K2 = 9 * MiB + 131072, WS_SSQ = 10 * MiB;
constexpr size_t WS_CTL = 11 * MiB;
constexpr size_t WS_USV = 11 * MiB + 65536;
constexpr size_t WS_RS1 = 11 * MiB + 196608, WS_SSQ2 = 11 * MiB + 327680;
constexpr size_t WS_U8 = 12 * MiB, WS_V8 = 28 * MiB;
constexpr size_t WS_XB = 44 * MiB;
constexpr size_t WS_Q = 108 * MiB, WS_K = 140 * MiB, WS_VT = 172 * MiB, WS_HG = 204 * MiB, WS_MIX = 236 * MiB;
constexpr size_t WS_HB = 300 * MiB, WS_QH = 364 * MiB;
constexpr size_t WS_XN8 = 108 * MiB, WS_PIDX = 140 * MiB, WS_PG = 156 * MiB, WS_PW = 172 * MiB;
constexpr size_t WS_END = 428 * MiB;

struct Params {
  const float *x, *norm_mix_g, *w_in, *q_norm_g, *k_norm_g, *attn_out_g, *conv_w, *conv_b, *conv_ln_g, *conv_ln_b,
      *w_out, *norm_ffn_g, *peer_wq, *peer_k1, *peer_k2, *peer_u, *peer_v;
  float* out;
  unsigned char* ws;
};

constexpr int NTHREADS = 512, NWAVES = 8;
constexpr int LDS_STAGE = 131072, LDS_BAR = LDS_STAGE, LDS_BYTES = LDS_STAGE + 16;

__device__ __forceinline__ unsigned pk2(float lo, float hi) {
  bf16x2 v = {(__bf16)lo, (__bf16)hi};
  return __builtin_bit_cast(unsigned, v);
}
__device__ __forceinline__ float bflo(unsigned u) { return __uint_as_float(u << 16); }
__device__ __forceinline__ float bfhi(unsigned u) { return __uint_as_float(u & 0xffff0000u); }
__device__ __forceinline__ int otid() { int t = threadIdx.x; asm volatile("" : "+v"(t)); return t; }
__device__ __forceinline__ int vblock() {
  const int G = gridDim.x, b = blockIdx.x;
  return (G % 8 == 0) ? (b % 8) * (G / 8) + b / 8 : b;
}
__device__ __forceinline__ f32x16 mfma32(bf16x8 a, bf16x8 b, f32x16 c) { return __builtin_amdgcn_mfma_f32_32x32x16_bf16(a, b, c, 0, 0, 0); }

__device__ __forceinline__ int w1_src(int n) {
  if (n < 1024) {
    const int kind = n >> 9, rel = n & 511, pn = rel >> 8, P = rel & 255, bj = P >> 7, wc = (P >> 5) & 3, x = P & 31;
    return kind * 512 + (4 * pn + wc) * 64 + 32 * bj + x;
  }
  const int rel = n - 1024, pn = rel >> 8, P = rel & 255, bj = P >> 7, wc = (P >> 5) & 3, x = P & 31;
  return (bj ? 2048 : 1536) + 128 * pn + 32 * wc + x;
}
__device__ __forceinline__ void transpose_items(const float* __restrict__ W, int ldw, int N, bf16_t* __restrict__ Wt, const float* __restrict__ g, int glimit,
                                                int mode, long gtid, long nthr) {
  const long nitems = (long)N * 128;
  for (long it = gtid; it < nitems; it += nthr) {
    const int n = (int)(it % N), kc = (int)(it / N);
    const int src = mode == 1 ? w1_src(n) : (mode == 2 ? 1024 + n : n);
    float v[8];
#pragma unroll
    for (int i = 0; i < 8; ++i) {
      const int k = kc * 8 + i;
      float w = W[(size_t)k * ldw + src];
      if (k < glimit) w *= g[k];
      v[i] = w;
    }
    u32x4 o = {pk2(v[0], v[1]), pk2(v[2], v[3]), pk2(v[4], v[5]), pk2(v[6], v[7])};
    *(u32x4*)(Wt + (size_t)n * 1024 + kc * 8) = o;
  }
}
__device__ __forceinline__ void convert_items(const float* __restrict__ src, bf16_t* __restrict__ dst, long n8, long gtid, long nthr) {
  for (long it = gtid; it < n8; it += nthr) {
    const f32x4 a = *(const f32x4*)(src + it * 8), b = *(const f32x4*)(src + it * 8 + 4);
    u32x4 o = {pk2(a.x, a.y), pk2(a.z, a.w), pk2(b.x, b.y), pk2(b.z, b.w)};
    *(u32x4*)(dst + it * 8) = o;
  }
}
__device__ void phase_prep(const Params& p) {
  const int tid0 = otid();
  const long gtid = (long)vblock() * NTHREADS + tid0, nthr = (long)gridDim.x * NTHREADS;
  unsigned char* ws = p.ws;
  transpose_items(p.w_in, NIN, 2048, (bf16_t*)(ws + WS_W1), p.norm_mix_g, 1024, 1, gtid, nthr);
  transpose_items(p.w_in, NIN, 512, (bf16_t*)(ws + WS_WV), p.norm_mix_g, 1024, 2, gtid, nthr);
  transpose_items(p.w_out, D, D, (bf16_t*)(ws + WS_WOUT), p.attn_out_g, 512, 0, gtid, nthr);
  transpose_items(p.peer_wq, D, D, (bf16_t*)(ws + WS_WQ), p.norm_ffn_g, 1024, 0, gtid, nthr);
  convert_items(p.peer_k1, (bf16_t*)(ws + WS_K1), 65536 / 8, gtid, nthr);
  convert_items(p.peer_k2, (bf16_t*)(ws + WS_K2), 65536 / 8, gtid, nthr);
  const int lane = tid0 & 63, gw = vblock() * NWAVES + (tid0 >> 6), nw = gridDim.x * NWAVES;
  {
    bf16_t* XB = (bf16_t*)(ws + WS_XB);
    float* RS1 = (float*)(ws + WS_RS1);
    float* SSQ2 = (float*)(ws + WS_SSQ2);
    for (int tb = gw; tb < T; tb += 2 * nw) {
      f32x4 v[2][4];
      float ss[2] = {0.f, 0.f};
#pragma unroll
      for (int u = 0; u < 2; ++u) {
        const int t = (tb + u * nw < T) ? tb + u * nw : tb;
        const float* src = p.x + (size_t)t * 1024 + lane * 4;
#pragma unroll
        for (int i = 0; i < 4; ++i) v[u][i] = *(const f32x4*)(src + 256 * i);
      }
#pragma unroll
      for (int u = 0; u < 2; ++u) {
#pragma unroll
        for (int i = 0; i < 4; ++i) ss[u] += v[u][i].x * v[u][i].x + v[u][i].y * v[u][i].y + v[u][i].z * v[u][i].z + v[u][i].w * v[u][i].w;
      }
#pragma unroll
      for (int o = 1; o < 64; o <<= 1) { ss[0] += __shfl_xor(ss[0], o); ss[1] += __shfl_xor(ss[1], o); }
#pragma unroll
      for (int u = 0; u < 2; ++u) {
        const int t = tb + u * nw;
        if (t < T) {
#pragma unroll
          for (int i = 0; i < 4; ++i) *(u32x2*)(XB + (size_t)t * 1024 + lane * 4 + 256 * i) = (u32x2){pk2(v[u][i].x, v[u][i].y), pk2(v[u][i].z, v[u][i].w)};
          if (lane == 0) { RS1[t] = rsqrtf(ss[u] * (1.f / 1024.f) + EPS); SSQ2[t] = 0.f; }
        }
      }
    }
  }
}

__device__ void prep_tables(const Params& p) {
  unsigned char* ws = p.ws;
  const int tid0 = otid();
  const int lane = tid0 & 63, gw = vblock() * NWAVES + (tid0 >> 6), nw = gridDim.x * NWAVES;
  {
    for (int rb = gw; rb < 32768; rb += 2 * nw) {
      f32x4 v[2][4];
#pragma unroll
      for (int u = 0; u < 2; ++u) {
        const int r = (rb + u * nw < 32768) ? rb + u * nw : rb;
        const float* src = ((r >> 14) ? p.peer_v : p.peer_u) + (size_t)(r & 16383) * 1024 + lane * 16;
#pragma unroll
        for (int i = 0; i < 4; ++i) v[u][i] = *(const f32x4*)(src + 4 * i);
      }
      float am[2] = {0.f, 0.f};
#pragma unroll
      for (int u = 0; u < 2; ++u)
#pragma unroll
        for (int i = 0; i < 4; ++i)
          am[u] = fmaxf(am[u], fmaxf(fmaxf(fabsf(v[u][i].x), fabsf(v[u][i].y)), fmaxf(fabsf(v[u][i].z), fabsf(v[u][i].w))));
#pragma unroll
      for (int o = 1; o < 64; o <<= 1) { am[0] = fmaxf(am[0], __shfl_xor(am[0], o)); am[1] = fmaxf(am[1], __shfl_xor(am[1], o)); }
#pragma unroll
      for (int u = 0; u < 2; ++u) {
        const int r = rb + u * nw;
        if (r < 32768) {
          const int isv = r >> 14, e = r & 16383;
          const float scale = am[u] > 0.f ? am[u] * (1.f / 6.f) : 1.f, inv = am[u] > 0.f ? 6.f / am[u] : 0.f;
          unsigned q[2] = {0u, 0u};
#pragma unroll
          for (int i = 0; i < 4; ++i)
#pragma unroll
            for (int j = 0; j < 4; ++j) {
              const float xv = v[u][i][j], m = fabsf(xv) * inv;
              const unsigned code = (unsigned)(m > 0.25f) + (unsigned)(m > 0.75f) + (unsigned)(m > 1.25f) + (unsigned)(m > 1.75f) +
                                    (unsigned)(m > 2.5f) + (unsigned)(m > 3.5f) + (unsigned)(m > 5.0f);
              const unsigned nib = code | (xv < 0.f ? 8u : 0u);
              const int el = 4 * i + j;
              q[el >> 3] |= nib << (4 * (el & 7));
            }
          if (isv) {
            *(u32x2*)(ws + WS_V8 + (size_t)e * 512 + lane * 8) = (u32x2){q[0], q[1]};
            if (lane == 0) ((float*)(ws + WS_USV))[2 * e + 1] = scale;
          } else {
            *(u32x2*)(ws + WS_U8 + (size_t)e * 512 + lane * 8) = (u32x2){q[0], q[1]};
            if (lane == 0) ((float*)(ws + WS_USV))[2 * e] = scale;
          }
        }
      }
    }
  }
}

namespace pg8 {
typedef short sbf16x8 __attribute__((ext_vector_type(8)));
constexpr int BM = 256, BK = 64, HALF = 128, HTB = HALF * BK * 2  , NXCD = 8, WGM = 8;
__device__ __forceinline__ int lds_byte(int r, int c) { const int st = (r >> 4) * 2 + (c >> 5), rr = r & 15, cc = c & 31, ob = rr * 64 + cc * 2; return st * 1024 + (ob ^ (((ob >> 9) & 1) << 5)); }
__device__ __forceinline__ void stage_rc(int b, int& R, int& C) { const int st = b / 1024, sb = b % 1024, swz = sb ^ (((sb >> 9) & 1) << 5); R = (st >> 1) * 16 + swz / 64; C = (st & 1) * 32 + (swz % 64) / 2; }
__device__ __forceinline__ int perm32(int rho) { const int n = rho >> 4, i = rho & 15; return 8 * (i >> 2) + 4 * n + (i & 3); }
struct Unit { int pm, pn; };
struct Gemm { const bf16_t* A; const bf16_t* Bt; int M, N, K; };
struct StaticOrder {
    int nM, nN, nwg, G, c;
    __device__ void init(int M, int N, int G_, int c_) { nM = M / BM; nN = N / BM; nwg = nM * nN; G = G_; c = c_; }
    __device__ bool next(int i, Unit& u) const {
        const long L = (long)i * G + c; if (L >= nwg) return false;
        int wgid = (int)L; { const int q = nwg / NXCD, r = nwg % NXCD, xcd = wgid % NXCD, off = wgid / NXCD; wgid = (xcd < r ? xcd * (q + 1) : r * (q + 1) + (xcd - r) * q) + off; }
        const int nig = WGM * nN, gid = wgid / nig, fm = gid * WGM, gsz = (nM - fm) < WGM ? (nM - fm) : WGM;
        u.pm = fm + ((wgid % nig) % gsz); u.pn = (wgid % nig) / gsz; return true;
    }
};
template <class Epi>
__device__ __forceinline__ void gemm_phase(LAS unsigned char* lds, const Gemm g, const StaticOrder& S, const Epi& E) {
    const int tid = otid(), wid = __builtin_amdgcn_readfirstlane(tid >> 6), lane = tid & 63, wr = wid >> 2, wc = wid & 3, fr = lane & 15, fq = lane >> 4;
    const int K = g.K, nt = K / BK;
    unsigned voffA[2], voffB[2];
#pragma unroll
    for (int i = 0; i < 2; ++i) { int R, C; stage_rc(tid * 16 + i * 8192, R, C); const int Rb = Epi::PERM ? ((R & ~31) + perm32(R & 31)) : R;
        voffA[i] = (unsigned)(R * K + C) * 2u; voffB[i] = (unsigned)(Rb * K + C) * 2u; }
    const size_t kstep = (size_t)(BK * 2);
    const size_t hstep = (size_t)HALF * K * 2;
    const size_t tstep = 2 * hstep;
    const unsigned ldsw = (unsigned)wid * 1024u;
    const int aoff = lds_byte(wr * 64 + fr, fq * 8), boff = lds_byte(wc * 32 + fr, fq * 8);
#define PG8_SA(b, h) (((b) * 2 + (h)) * HTB)
#define PG8_SB(b, h) ((4 + (b) * 2 + (h)) * HTB)
#define PG8_STAGE(bufoff, gbase, voff) do { _Pragma("unroll") for (int _i = 0; _i < 2; ++_i) \
        __builtin_amdgcn_global_load_lds((const unsigned*)((const char*)(gbase) + (voff)[_i]), (LAS unsigned*)(lds + (bufoff) + ldsw + _i * 8192), 16, 0, 0); } while (0)
#define PG8_LDA(dst, b, h) do { _Pragma("unroll") for (int m = 0; m < 4; ++m) _Pragma("unroll") for (int k = 0; k < 2; ++k) dst[m][k] = *(const LAS sbf16x8*)(lds + PG8_SA(b, h) + aoff + m * 2048 + k * 1024); } while (0)
#define PG8_LDB(dst, b, h) do { _Pragma("unroll") for (int n = 0; n < 2; ++n) _Pragma("unroll") for (int k = 0; k < 2; ++k) dst[n][k] = *(const LAS sbf16x8*)(lds + PG8_SB(b, h) + boff + n * 2048 + k * 1024); } while (0)
#define PG8_MMA(ai, bj, At, Bt) do { __builtin_amdgcn_s_setprio(1); _Pragma("unroll") for (int m = 0; m < 4; ++m) _Pragma("unroll") for (int n = 0; n < 2; ++n) _Pragma("unroll") for (int k = 0; k < 2; ++k) \
        acc[ai][bj][m][n] = __builtin_amdgcn_mfma_f32_16x16x32_bf16(__builtin_bit_cast(bf16x8, Bt[n][k]), __builtin_bit_cast(bf16x8, At[m][k]), acc[ai][bj][m][n], 0, 0, 0); __builtin_amdgcn_s_setprio(0); } while (0)
#define PG8_WAIT_V(n) asm volatile("s_waitcnt vmcnt(" #n ")" ::: "memory")
#define PG8_WAIT_L(n) asm volatile("s_waitcnt lgkmcnt(" #n ")" ::: "memory")
#define PG8_BAR __builtin_amdgcn_s_barrier()
#define PG8_SCHED __builtin_amdgcn_sched_barrier(0)
    Unit cur, nxt; int ui = 0;
    if (!S.next(0, cur)) return;
    f32x4 acc[2][2][4][2];
#pragma unroll
    for (int a = 0; a < 2; ++a)
#pragma unroll
        for (int b = 0; b < 2; ++b)
#pragma unroll
            for (int m = 0; m < 4; ++m)
#pragma unroll
                for (int n = 0; n < 2; ++n) acc[a][b][m][n] = (f32x4){0.f, 0.f, 0.f, 0.f};
    sbf16x8 At[4][2], B0[2][2], B1[2][2];
    const char* cA = (const char*)g.A + (size_t)cur.pm * tstep; const char* cB = (const char*)g.Bt + (size_t)cur.pn * tstep;
    PG8_STAGE(PG8_SB(0, 0), cB, voffB); PG8_STAGE(PG8_SA(0, 0), cA, voffA); PG8_STAGE(PG8_SB(0, 1), cB + hstep, voffB); PG8_STAGE(PG8_SA(0, 1), cA + hstep, voffA);
    if (wr == 1) PG8_BAR;
    PG8_WAIT_V(4); PG8_BAR;
    PG8_STAGE(PG8_SB(1, 0), cB + kstep, voffB); PG8_STAGE(PG8_SA(1, 0), cA + kstep, voffA); PG8_STAGE(PG8_SB(1, 1), cB + hstep + kstep, voffB);
    PG8_WAIT_V(6); PG8_BAR;
    for (;;) {
        const bool has_next = S.next(ui + 1, nxt);
        const char* nA = has_next ? (const char*)g.A + (size_t)nxt.pm * tstep : cA; const char* nB = has_next ? (const char*)g.Bt + (size_t)nxt.pn * tstep : cB;
        for (int t = 0; t < nt; t += 2) {
            const bool last = (t == nt - 2);
            const char* a1 = cA + (size_t)(t + 1) * kstep;
            const char* a2 = last ? nA : cA + (size_t)(t + 2) * kstep; const char* b2 = last ? nB : cB + (size_t)(t + 2) * kstep;
            const char* a3 = a2 + kstep; const char* b3 = b2 + kstep;
            PG8_LDB(B0, 0, 0); PG8_SCHED; PG8_LDA(At, 0, 0); PG8_STAGE(PG8_SA(1, 1), a1 + hstep, voffA);
            PG8_WAIT_L(8); PG8_BAR; PG8_WAIT_L(0); PG8_MMA(0, 0, At, B0); PG8_BAR; PG8_SCHED;
            PG8_LDB(B1, 0, 1); PG8_STAGE(PG8_SB(0, 0), b2, voffB);
            PG8_BAR; PG8_WAIT_L(0); PG8_MMA(0, 1, At, B1); PG8_BAR;
            PG8_LDA(At, 0, 1); PG8_STAGE(PG8_SA(0, 0), a2, voffA);
            PG8_BAR; PG8_WAIT_L(0); PG8_MMA(1, 0, At, B0); PG8_BAR; PG8_SCHED;
            PG8_STAGE(PG8_SB(0, 1), b2 + hstep, voffB);
            PG8_WAIT_V(6); PG8_BAR; PG8_MMA(1, 1, At, B1); PG8_BAR;
            PG8_LDB(B0, 1, 0); PG8_SCHED; PG8_LDA(At, 1, 0); PG8_STAGE(PG8_SA(0, 1), a2 + hstep, voffA);
            PG8_WAIT_L(8); PG8_BAR; PG8_WAIT_L(0); PG8_MMA(0, 0, At, B0); PG8_BAR; PG8_SCHED;
            PG8_LDB(B1, 1, 1); PG8_STAGE(PG8_SB(1, 0), b3, voffB);
            PG8_BAR; PG8_WAIT_L(0); PG8_MMA(0, 1, At, B1); PG8_BAR;
            PG8_LDA(At, 1, 1); PG8_STAGE(PG8_SA(1, 0), a3, voffA);
            PG8_BAR; PG8_WAIT_L(0); PG8_MMA(1, 0, At, B0); PG8_BAR; PG8_SCHED;
            PG8_STAGE(PG8_SB(1, 1), b3 + hstep, voffB);
            PG8_WAIT_V(6); PG8_BAR; PG8_MMA(1, 1, At, B1); PG8_BAR;
        }
        E(acc, cur, wr, wc, fr, fq);
        if (!has_next) break;
#pragma unroll
        for (int a = 0; a < 2; ++a)
#pragma unroll
            for (int b = 0; b < 2; ++b)
#pragma unroll
                for (int m = 0; m < 4; ++m)
#pragma unroll
                    for (int n = 0; n < 2; ++n) acc[a][b][m][n] = (f32x4){0.f, 0.f, 0.f, 0.f};
        cur = nxt; cA = nA; cB = nB; ++ui;
    }
    PG8_WAIT_V(0);
    if (wr == 0) PG8_BAR;
    PG8_BAR;
#undef PG8_SA
#undef PG8_SB
#undef PG8_STAGE
#undef PG8_LDA
#undef PG8_LDB
#undef PG8_MMA
#undef PG8_WAIT_V
#undef PG8_WAIT_L
#undef PG8_BAR
#undef PG8_SCHED
}
}

struct EpiQKC {
  static constexpr bool PERM = true;
  const float* rs1; const float* qg; const float* kg; bf16_t* Q; bf16_t* Kk; bf16_t* HG;
  __device__ __forceinline__ void operator()(const f32x4 (&acc)[2][2][4][2], const pg8::Unit& u, int wr, int wc, int fr, int fq) const {
    const int row0 = u.pm * 256 + wr * 64 + fr;
    if (u.pn < 4) {
      const bool isq = u.pn < 2;
      const int head = 4 * (u.pn & 1) + wc;
      const float* g = isq ? qg : kg;
      f32x4 gv[2][2];
#pragma unroll
      for (int bj = 0; bj < 2; ++bj)
#pragma unroll
        for (int n = 0; n < 2; ++n) gv[bj][n] = *(const f32x4*)(g + 32 * bj + 8 * fq + 4 * n);
      bf16_t* base = isq ? Q : Kk;
#pragma unroll
      for (int ai = 0; ai < 2; ++ai)
#pragma unroll
        for (int m = 0; m < 4; ++m) {
          const int t = row0 + ai * 128 + m * 16;
          float ss = 0.f;
#pragma unroll
          for (int bj = 0; bj < 2; ++bj)
#pragma unroll
            for (int n = 0; n < 2; ++n) { const f32x4 v = acc[ai][bj][m][n]; ss += v.x * v.x + v.y * v.y + v.z * v.z + v.w * v.w; }
          ss += __shfl_xor(ss, 16);
          ss += __shfl_xor(ss, 32);
          const float r = rs1[t];
          float sc = r * rsqrtf(r * r * ss * (1.f / 64.f) + EPS);
          if (isq) sc *= 0.125f * LOG2E;
          bf16_t* dst = base + ((size_t)((t >> 12) * 8 + head) * 4096 + (t & 4095)) * 64 + 8 * fq;
#pragma unroll
          for (int bj = 0; bj < 2; ++bj) {
            const f32x4 a = acc[ai][bj][m][0] * gv[bj][0] * sc, b = acc[ai][bj][m][1] * gv[bj][1] * sc;
            *(u32x4*)(dst + 32 * bj) = (u32x4){pk2(a.x, a.y), pk2(a.z, a.w), pk2(b.x, b.y), pk2(b.z, b.w)};
          }
        }
    } else {
      const int ch0 = 128 * (u.pn - 4) + 32 * wc + 8 * fq;
#pragma unroll
      for (int ai = 0; ai < 2; ++ai)
#pragma unroll
        for (int m = 0; m < 4; ++m) {
          const int t = row0 + ai * 128 + m * 16;
          const float r = rs1[t];
          float h[8];
#pragma unroll
          for (int n = 0; n < 2; ++n)
#pragma unroll
            for (int j = 0; j < 4; ++j) h[4 * n + j] = acc[ai][0][m][n][j] * r / (1.f + __expf(-acc[ai][1][m][n][j] * r));
          *(u32x4*)(HG + (size_t)t * 512 + ch0) = (u32x4){pk2(h[0], h[1]), pk2(h[2], h[3]), pk2(h[4], h[5]), pk2(h[6], h[7])};
        }
    }
  }
};
struct EpiVt {
  static constexpr bool PERM = false;
  const float* rs1; bf16_t* Vt;
  __device__ __forceinline__ void operator()(const f32x4 (&acc)[2][2][4][2], const pg8::Unit& u, int wr, int wc, int fr, int fq) const {
    const int pos0 = 8 * (fq & 1) + 4 * (fq >> 1);
#pragma unroll
    for (int bj = 0; bj < 2; ++bj)
#pragma unroll
      for (int n = 0; n < 2; ++n) {
        const int t = u.pn * 256 + bj * 128 + wc * 32 + n * 16 + 4 * fq;
        const f32x4 r = *(const f32x4*)(rs1 + t);
        const size_t tb = ((size_t)(t >> 12) * 8) * 128 + ((t & 4095) >> 5);
#pragma unroll
        for (int ai = 0; ai < 2; ++ai)
#pragma unroll
          for (int m = 0; m < 4; ++m) {
            const int dg = u.pm * 256 + ai * 128 + wr * 64 + m * 16 + fr, head = dg >> 6, d = dg & 63;
            const f32x4 v = acc[ai][bj][m][n] * r;
            *(u32x2*)(Vt + ((tb + (size_t)head * 128) * 64 + d) * 32 + 16 * n + pos0) = (u32x2){pk2(v.x, v.y), pk2(v.z, v.w)};
          }
      }
  }
};
struct EpiOut {
  static constexpr bool PERM = false;
  const bf16_t* xb; bf16_t* HB; float* ssq2;
  __device__ __forceinline__ void operator()(const f32x4 (&acc)[2][2][4][2], const pg8::Unit& u, int wr, int wc, int fr, int fq) const {
    const int row0 = u.pm * 256 + wr * 64 + fr, col0 = u.pn * 256 + wc * 32 + 4 * fq;
#pragma unroll
    for (int ai = 0; ai < 2; ++ai)
#pragma unroll
      for (int m = 0; m < 4; ++m) {
        const int t = row0 + ai * 128 + m * 16;
        const size_t ro = (size_t)t * 1024 + col0;
        float ss = 0.f;
#pragma unroll
        for (int bj = 0; bj < 2; ++bj)
#pragma unroll
          for (int n = 0; n < 2; ++n) {
            const size_t o = ro + bj * 128 + n * 16;
            const u32x2 xv = *(const u32x2*)(xb + o);
            const f32x4 h = (f32x4){bflo(xv.x), bfhi(xv.x), bflo(xv.y), bfhi(xv.y)} + acc[ai][bj][m][n];
            *(u32x2*)(HB + o) = (u32x2){pk2(h.x, h.y), pk2(h.z, h.w)};
            ss += h.x * h.x + h.y * h.y + h.z * h.z + h.w * h.w;
          }
        ss += __shfl_xor(ss, 16);
        ss += __shfl_xor(ss, 32);
        if (fq == 0) atomicAdd(ssq2 + t, ss);
      }
  }
};
struct EpiQh {
  static constexpr bool PERM = true;
  const float* ssq2; bf16_t* QH;
  __device__ __forceinline__ void operator()(const f32x4 (&acc)[2][2][4][2], const pg8::Unit& u, int wr, int wc, int fr, int fq) const {
    const int row0 = u.pm * 256 + wr * 64 + fr, col0 = u.pn * 256 + wc * 32 + 8 * fq;
#pragma unroll
    for (int ai = 0; ai < 2; ++ai)
#pragma unroll
      for (int m = 0; m < 4; ++m) {
        const int t = row0 + ai * 128 + m * 16;
        const float r = rsqrtf(ssq2[t] * (1.f / 1024.f) + EPS);
#pragma unroll
        for (int bj = 0; bj < 2; ++bj) {
          const f32x4 a = acc[ai][bj][m][0] * r, b = acc[ai][bj][m][1] * r;
          *(u32x4*)(QH + (size_t)t * 1024 + col0 + bj * 128) = (u32x4){pk2(a.x, a.y), pk2(a.z, a.w), pk2(b.x, b.y), pk2(b.z, b.w)};
        }
      }
  }
};

__device__ void phase_inproj(const Params& p, char* smem) {
  unsigned char* ws = p.ws;
  LAS unsigned char* lds = (LAS unsigned char*)smem;
  const bf16_t* XB = (const bf16_t*)(ws + WS_XB);
  const float* RS1 = (const float*)(ws + WS_RS1);
  pg8::StaticOrder S;
  {
    pg8::Gemm g{XB, (const bf16_t*)(ws + WS_W1), T, 2048, 1024};
    S.init(T, 2048, gridDim.x, blockIdx.x);
    EpiQKC E{RS1, p.q_norm_g, p.k_norm_g, (bf16_t*)(ws + WS_Q), (bf16_t*)(ws + WS_K), (bf16_t*)(ws + WS_HG)};
    pg8::gemm_phase<EpiQKC>(lds, g, S, E);
  }
  {
    pg8::Gemm g{(const bf16_t*)(ws + WS_WV), XB, 512, T, 1024};
    S.init(512, T, gridDim.x, blockIdx.x);
    EpiVt E{RS1, (bf16_t*)(ws + WS_VT)};
    pg8::gemm_phase<EpiVt>(lds, g, S, E);
  }
}
__device__ void phase_outproj(const Params& p, char* smem) {
  unsigned char* ws = p.ws;
  pg8::Gemm g{(const bf16_t*)(ws + WS_MIX), (const bf16_t*)(ws + WS_WOUT), T, 1024, 1024};
  pg8::StaticOrder S;
  S.init(T, 1024, gridDim.x, blockIdx.x);
  EpiOut E{(const bf16_t*)(ws + WS_XB), (bf16_t*)(ws + WS_HB), (float*)(ws + WS_SSQ2)};
  pg8::gemm_phase<EpiOut>((LAS unsigned char*)smem, g, S, E);
}
__device__ void phase_qproj(const Params& p, char* smem) {
  unsigned char* ws = p.ws;
  pg8::Gemm g{(const bf16_t*)(ws + WS_HB), (const bf16_t*)(ws + WS_WQ), T, 1024, 1024};
  pg8::StaticOrder S;
  S.init(T, 1024, gridDim.x, blockIdx.x);
  EpiQh E{(const float*)(ws + WS_SSQ2), (bf16_t*)(ws + WS_QH)};
  pg8::gemm_phase<EpiQh>((LAS unsigned char*)smem, g, S, E);
}

__device__ __forceinline__ void conv_stage(const bf16_t* HG, int item, LAS unsigned char* buf, int wave, int lane) {
  const int t0 = item * 32, s0 = t0 & 4095;
#pragma unroll
  for (int j = 0; j < 8; ++j) {
    const int r = wave + 8 * j;
    if (r < 62) {
      if (s0 - 30 + r >= 0)
        __builtin_amdgcn_global_load_lds((const unsigned*)(HG + (size_t)(t0 - 30 + r) * 512 + lane * 8), (LAS unsigned*)(buf + r * 1024), 16, 0, 0);
      else
        *(LAS u32x4*)(buf + r * 1024 + lane * 16) = (u32x4){0u, 0u, 0u, 0u};
    }
  }
}
struct ConvW { f32x2 wv[31]; float2 cb, lg, lb; };
__device__ __forceinline__ void conv_compute(const Params& p, int item, const char* smem, const ConvW& W, int tid512) {
  bf16_t* MIX = (bf16_t*)(p.ws + WS_MIX);
  const int half = tid512 >> 8, tid = tid512 & 255, lane = tid & 63, wave = tid >> 6;
  const int t0 = item * 32;
  float* red = (float*)(smem + 62 * 1024) + half * 128;
  const bool b5 = lane & 32, b4 = lane & 16, b3 = lane & 8, b2 = lane & 4;
#pragma unroll 1
  for (int rd = 0; rd < 2; ++rd) {
    const int tb = 16 * half + 8 * rd;
    f32x2 xv[38];
#pragma unroll
    for (int r = 0; r < 38; ++r) {
      const unsigned v = *(const unsigned*)(smem + (tb + r) * 1024 + tid * 4);
      xv[r] = (f32x2){bflo(v), bfhi(v)};
    }
    float a0[8], a1[8], st[16];
#pragma unroll
    for (int k = 0; k < 8; ++k) {
      f32x2 u = {W.cb.x, W.cb.y};
#pragma unroll
      for (int j = 0; j < 31; ++j) u = __builtin_elementwise_fma(W.wv[j], xv[k + j], u);
      a0[k] = u.x; a1[k] = u.y;
      st[k] = u.x + u.y;
      st[8 + k] = u.x * u.x + u.y * u.y;
    }
    float r8[8], r4[4], r2[2], r1;
#pragma unroll
    for (int i = 0; i < 8; ++i) { const float keep = b5 ? st[8 + i] : st[i], send = b5 ? st[i] : st[8 + i]; r8[i] = keep + __shfl_xor(send, 32); }
#pragma unroll
    for (int i = 0; i < 4; ++i) { const float keep = b4 ? r8[4 + i] : r8[i], send = b4 ? r8[i] : r8[4 + i]; r4[i] = keep + __shfl_xor(send, 16); }
#pragma unroll
    for (int i = 0; i < 2; ++i) { const float keep = b3 ? r4[2 + i] : r4[i], send = b3 ? r4[i] : r4[2 + i]; r2[i] = keep + __shfl_xor(send, 8); }
    { const float keep = b2 ? r2[1] : r2[0], send = b2 ? r2[0] : r2[1]; r1 = keep + __shfl_xor(send, 4); }
    r1 += __shfl_xor(r1, 2);
    r1 += __shfl_xor(r1, 1);
    float* rr = red + rd * 64;
    if ((lane & 3) == 0) rr[wave * 16 + (lane >> 2)] = r1;
    __syncthreads();
#pragma unroll
    for (int k = 0; k < 8; ++k) {
      const float S1 = (rr[k] + rr[16 + k]) + (rr[32 + k] + rr[48 + k]);
      const float S2 = (rr[8 + k] + rr[24 + k]) + (rr[40 + k] + rr[56 + k]);
      const float mu = S1 * (1.f / 512.f);
      const float var = fmaxf(S2 * (1.f / 512.f) - mu * mu, 0.f);
      const float rstd = rsqrtf(var + EPS);
      const float y0 = (a0[k] - mu) * rstd * W.lg.x + W.lb.x, y1 = (a1[k] - mu) * rstd * W.lg.y + W.lb.y;
      const float z0 = y0 / (1.f + __expf(-y0)), z1 = y1 / (1.f + __expf(-y1));
      *(unsigned*)(MIX + (size_t)(t0 + tb + k) * 1024 + 512 + 2 * tid) = pk2(z0, z1);
    }
  }
}
__device__ void conv_items(const Params& p, char* smem) {
  const bf16_t* HG = (const bf16_t*)(p.ws + WS_HG);
  const int tid512 = otid(), tid = tid512 & 255, lane = tid512 & 63;
  const int wave = __builtin_amdgcn_readfirstlane(tid512 >> 6);
  const int vb = vblock(), G = gridDim.x;
  ConvW W;
#pragma unroll
  for (int j = 0; j < 31; ++j) {
    const float2 w = *(const float2*)(p.conv_w + j * 512 + 2 * tid);
    W.wv[j] = (f32x2){w.x, w.y};
  }
  W.cb = *(const float2*)(p.conv_b + 2 * tid);
  W.lg = *(const float2*)(p.conv_ln_g + 2 * tid);
  W.lb = *(const float2*)(p.conv_ln_b + 2 * tid);
  int b = 0;
  if (vb < 1024) conv_stage(HG, vb, (LAS unsigned char*)smem, wave, lane);
  for (int item = vb; item < 1024; item += G, b ^= 1) {
    asm volatile("s_waitcnt vmcnt(0) lgkmcnt(0)" ::: "memory");
    __syncthreads();
    if (item + G < 1024) conv_stage(HG, item + G, (LAS unsigned char*)smem + (b ^ 1) * 65536, wave, lane);
    conv_compute(p, item, smem + b * 65536, W, tid512);
  }
  __syncthreads();
}

struct AttnKV { bf16x8 k[4]; bf16x8 v[2][2]; };
__device__ __forceinline__ void attn_load(const bf16_t* Km, const bf16_t* Vt, int bh, int kb, int tok, int hf, AttnKV& f) {
  const int kc = kb < 0 ? 0 : kb;
  const bf16_t* kp = Km + ((size_t)bh * 4096 + kc * 32 + tok) * 64 + 8 * hf;
#pragma unroll
  for (int ks = 0; ks < 4; ++ks) f.k[ks] = *(const bf16x8*)(kp + ks * 16);
  const bf16_t* vp = Vt + (((size_t)bh * 128 + kc) * 64 + tok) * 32 + hf * 8;
#pragma unroll
  for (int m = 0; m < 2; ++m)
#pragma unroll
    for (int s = 0; s < 2; ++s) f.v[m][s] = *(const bf16x8*)(vp + m * 1024 + s * 16);
}
__device__ __forceinline__ bool attn_block(const AttnKV& f, const bf16x8 (&qf)[4], bool diag, int tok, int hf, float& c, f32x16& o0, f32x16& o1) {
  f32x16 sc;
#pragma unroll
  for (int i = 0; i < 16; ++i) sc[i] = 0.f;
#pragma unroll
  for (int ks = 0; ks < 4; ++ks) sc = mfma32(f.k[ks], qf[ks], sc);
  float lk[16], zs[16];
#pragma unroll
  for (int i = 0; i < 16; ++i) {
    const float zl = sc[i];
    const float e = __builtin_amdgcn_exp2f(zl);
    const float sp = __builtin_amdgcn_logf(1.f + e);
    const bool valid = !diag || ((i & 3) + 8 * (i >> 2) + 4 * hf < tok);
    lk[i] = valid ? -sp : 0.f;
    zs[i] = valid ? zl - sp : -1e30f;
  }
  float Tg[4], Pg[4];
#pragma unroll
  for (int g = 0; g < 4; ++g) {
    Tg[g] = (lk[4 * g] + lk[4 * g + 1]) + (lk[4 * g + 2] + lk[4 * g + 3]);
    Pg[g] = __shfl_xor(Tg[g], 32);
  }
  float base[4];
  float run = 0.f;
#pragma unroll
  for (int g = 3; g >= 0; --g) {
    base[g] = c + run + (hf == 0 ? Pg[g] : 0.f);
    run += Tg[g] + Pg[g];
  }
  float pr[16];
#pragma unroll
  for (int g = 0; g < 4; ++g) {
    float l = base[g];
#pragma unroll
    for (int r = 3; r >= 0; --r) {
      pr[4 * g + r] = __builtin_amdgcn_exp2f(zs[4 * g + r] + l);
      l += lk[4 * g + r];
    }
  }
  c += run;
  bf16x8 pf[2];
#pragma unroll
  for (int s = 0; s < 2; ++s)
#pragma unroll
    for (int j = 0; j < 8; ++j) pf[s][j] = (__bf16)pr[8 * s + j];
#pragma unroll
  for (int s = 0; s < 2; ++s) {
    o0 = mfma32(f.v[0][s], pf[s], o0);
    o1 = mfma32(f.v[1][s], pf[s], o1);
  }
  return __all(c < -150.f);
}
__device__ void attn_tile(const Params& p, int item, int it, int lane, int wave, char* smem) {
  unsigned char* ws = p.ws;
  const bf16_t* Qm = (const bf16_t*)(ws + WS_Q);
  const bf16_t* Km = (const bf16_t*)(ws + WS_K);
  const bf16_t* Vt = (const bf16_t*)(ws + WS_VT);
  bf16_t* MIX = (bf16_t*)(ws + WS_MIX);
  const int qt = item & 127, bh = (item >> 7) * 8 + wave;
  const int tok = lane & 31, hf = lane >> 5;
  bf16x8 qf[4];
  {
    const bf16_t* qp = Qm + ((size_t)bh * 4096 + qt * 32 + tok) * 64 + 8 * hf;
#pragma unroll
    for (int ks = 0; ks < 4; ++ks) qf[ks] = *(const bf16x8*)(qp + ks * 16);
  }
  f32x16 o0, o1;
#pragma unroll
  for (int i = 0; i < 16; ++i) { o0[i] = 0.f; o1[i] = 0.f; }
  float c = 0.f;
  AttnKV fa, fb;
  attn_load(Km, Vt, bh, qt, tok, hf, fa);
  {
    unsigned z = __builtin_bit_cast(u32x4, fa.v[1][1]).w | __builtin_bit_cast(u32x4, fa.k[3]).w | __builtin_bit_cast(u32x4, qf[3]).w;
    asm volatile("" ::"v"(z));
  }
  for (int kb = qt;; kb -= 2) {
    attn_load(Km, Vt, bh, kb - 1, tok, hf, fb);
    __builtin_amdgcn_sched_barrier(0);
    if (attn_block(fa, qf, kb == qt, tok, hf, c, o0, o1) || kb == 0) break;
    attn_load(Km, Vt, bh, kb - 2, tok, hf, fa);
    __builtin_amdgcn_sched_barrier(0);
    if (attn_block(fb, qf, false, tok, hf, c, o0, o1) || kb == 1) break;
  }
  float ssq = 0.f;
#pragma unroll
  for (int i = 0; i < 16; ++i) ssq += o0[i] * o0[i] + o1[i] * o1[i];
  ssq += __shfl_xor(ssq, 32);
  float* xch = (float*)(smem + 100 * 1024) + (it & 1) * 256;
  if (hf == 0) xch[wave * 32 + tok] = ssq;
  __syncthreads();
  float tot = 0.f;
#pragma unroll
  for (int w = 0; w < NWAVES; ++w) tot += xch[w * 32 + tok];
  const float rs = rsqrtf(tot * (1.f / 512.f) + EPS);
  const int t = (bh >> 3) * 4096 + qt * 32 + tok, hh = bh & 7;
  bf16_t* dst = MIX + (size_t)t * 1024 + hh * 64 + 4 * hf;
#pragma unroll
  for (int g = 0; g < 4; ++g) {
    *(u32x2*)(dst + 8 * g) = (u32x2){pk2(o0[4 * g] * rs, o0[4 * g + 1] * rs), pk2(o0[4 * g + 2] * rs, o0[4 * g + 3] * rs)};
    *(u32x2*)(dst + 32 + 8 * g) = (u32x2){pk2(o1[4 * g] * rs, o1[4 * g + 1] * rs), pk2(o1[4 * g + 2] * rs, o1[4 * g + 3] * rs)};
  }
}

__device__ void phase_mix(const Params& p, char* smem) {
  static_assert(NWAVES == 8, "one wave per attention head");
  const int vb = vblock(), G = gridDim.x;
  if (blockIdx.x & 1) prep_tables(p);
  conv_items(p, smem);
  const int tidm = otid();
  const int lane = tidm & 63, wave = tidm >> 6;
  int it = 0;
  for (int item = vb; item < 1024; item += G, ++it) attn_tile(p, item, it, lane, wave, smem);
  if (!(blockIdx.x & 1)) prep_tables(p);
}
__device__ __forceinline__ unsigned f2key(float f, unsigned n) {
  const unsigned u = (__float_as_uint(f) & ~0x7Fu) | n;
  return u ^ ((unsigned)((int)u >> 31) | 0x80000000u);
}
__device__ __forceinline__ unsigned f2key_raw(float f) {
  const unsigned u = __float_as_uint(f);
  return u ^ ((unsigned)((int)u >> 31) | 0x80000000u);
}
__device__ __forceinline__ unsigned key2u(unsigned k) { return k ^ ((k >> 31) ? 0x80000000u : 0xFFFFFFFFu); }

template <int N>
__device__ __forceinline__ void bitonic_sort_desc(unsigned (&v)[N]) {
#pragma unroll
  for (int k = 2; k <= N; k <<= 1) {
#pragma unroll
    for (int j = k >> 1; j > 0; j >>= 1) {
#pragma unroll
      for (int i = 0; i < N; ++i) {
        const int l = i ^ j;
        if (l > i) {
          const bool desc = ((i & k) == 0);
          const unsigned mx = max(v[i], v[l]), mn = min(v[i], v[l]);
          v[i] = desc ? mx : mn;
          v[l] = desc ? mn : mx;
        }
      }
    }
  }
}
template <int N>
__device__ __forceinline__ void bitonic_merge_desc(unsigned (&v)[N]) {
#pragma unroll
  for (int j = N >> 1; j > 0; j >>= 1) {
#pragma unroll
    for (int i = 0; i < N; ++i) {
      const int l = i ^ j;
      if (l > i) {
        const unsigned mx = max(v[i], v[l]), mn = min(v[i], v[l]);
        v[i] = mx;
        v[l] = mn;
      }
    }
  }
}
__device__ __forceinline__ void merge_top16(unsigned (&a)[16], const unsigned (&b)[16]) {
#pragma unroll
  for (int i = 0; i < 16; ++i) a[i] = max(a[i], b[15 - i]);
  bitonic_merge_desc<16>(a);
}
#define CEP(ka, pa, kb, pb, desc)                                  \
  {                                                                \
    const bool sw_ = (desc) ? ((kb) > (ka)) : ((kb) < (ka));       \
    const unsigned tk_ = sw_ ? (kb) : (ka), tl_ = sw_ ? (ka) : (kb); \
    const unsigned tp_ = sw_ ? (pb) : (pa), tq_ = sw_ ? (pa) : (pb); \
    ka = tk_; kb = tl_; pa = tp_; pb = tq_;                        \
  }
template <int N>
__device__ __forceinline__ void bitonic_sort_desc_p(unsigned (&v)[N], unsigned (&pl)[N]) {
#pragma unroll
  for (int k = 2; k <= N; k <<= 1) {
#pragma unroll
    for (int j = k >> 1; j > 0; j >>= 1) {
#pragma unroll
      for (int i = 0; i < N; ++i) {
        const int l = i ^ j;
        if (l > i) {
          const bool desc = ((i & k) == 0);
          CEP(v[i], pl[i], v[l], pl[l], desc);
        }
      }
    }
  }
}
template <int N>
__device__ __forceinline__ void bitonic_merge_desc_p(unsigned (&v)[N], unsigned (&pl)[N]) {
#pragma unroll
  for (int j = N >> 1; j > 0; j >>= 1) {
#pragma unroll
    for (int i = 0; i < N; ++i) {
      const int l = i ^ j;
      if (l > i) { CEP(v[i], pl[i], v[l], pl[l], true); }
    }
  }
}
__device__ __forceinline__ void merge_top16_p(unsigned (&a)[16], unsigned (&pa)[16], const unsigned (&b)[16], const unsigned (&pb)[16]) {
#pragma unroll
  for (int i = 0; i < 16; ++i) {
    const bool s = b[15 - i] > a[i];
    a[i] = s ? b[15 - i] : a[i];
    pa[i] = s ? pb[15 - i] : pa[i];
  }
  bitonic_merge_desc_p<16>(a, pa);
}

constexpr int KROW = 144;
__device__ __forceinline__ void subkey_top16(const LAS unsigned char* Kl, const bf16_t* __restrict__ qrow, int lane, unsigned (&top)[16]) {
  const int tok = lane & 31, hf = lane >> 5;
  f32x16 acc[4];
#pragma unroll
  for (int m = 0; m < 4; ++m)
#pragma unroll
    for (int i = 0; i < 16; ++i) acc[m][i] = 0.f;
  bf16x8 bq[4];
#pragma unroll
  for (int ks = 0; ks < 4; ++ks) bq[ks] = *(const bf16x8*)(qrow + ks * 16 + 8 * hf);
#pragma unroll 1
  for (int ks = 0; ks < 4; ++ks) {
#pragma unroll
    for (int m = 0; m < 4; ++m) {
      const bf16x8 ak = *(const LAS bf16x8*)(Kl + (m * 32 + tok) * KROW + ks * 32 + hf * 16);
      acc[m] = mfma32(ak, ks == 0 ? bq[0] : ks == 1 ? bq[1] : ks == 2 ? bq[2] : bq[3], acc[m]);
    }
  }
  unsigned g[4][16];
#pragma unroll
  for (int m = 0; m < 4; ++m) {
#pragma unroll
    for (int i = 0; i < 16; ++i) g[m][i] = f2key(acc[m][i], (unsigned)(m * 32 + (i & 3) + 8 * (i >> 2) + 4 * hf));
    bitonic_sort_desc<16>(g[m]);
  }
  merge_top16(g[0], g[1]);
  merge_top16(g[2], g[3]);
  merge_top16(g[0], g[2]);
  unsigned o[16];
#pragma unroll
  for (int i = 0; i < 16; ++i) o[i] = __shfl_xor(g[0][i], 32);
  merge_top16(g[0], o);
#pragma unroll
  for (int i = 0; i < 16; ++i) top[i] = g[0][i];
}

__device__ void phase_route(const Params& p, char* smem) {
  unsigned char* ws = p.ws;
  const bf16_t* K1 = (const bf16_t*)(ws + WS_K1);
  const bf16_t* K2 = (const bf16_t*)(ws + WS_K2);
  const bf16_t* QH = (const bf16_t*)(ws + WS_QH);
  const bf16_t* HB = (const bf16_t*)(ws + WS_HB);
  unsigned char* XN8 = ws + WS_XN8;
  const float* SSQ2 = (const float*)(ws + WS_SSQ2);
  unsigned* PIDX = (unsigned*)(ws + WS_PIDX);
  float* PG = (float*)(ws + WS_PG);
  const int tidr = otid();
  const int lane = tidr & 63, wave = tidr >> 6, gw = vblock() * NWAVES + wave, nw = gridDim.x * NWAVES;
  for (int t = gw; t < T; t += nw) {
    const bf16_t* src = HB + (size_t)t * 1024 + lane * 16;
    const float r = rsqrtf(SSQ2[t] * (1.f / 1024.f) + EPS) * 16.f;
    const u32x4 h0 = *(const u32x4*)src, h1 = *(const u32x4*)(src + 8);
    u32x4 q;
#pragma unroll
    for (int i = 0; i < 4; ++i) {
      const f32x4 g4 = *(const f32x4*)(p.norm_ffn_g + lane * 16 + 4 * i);
      const unsigned lo = (i < 2) ? h0[2 * i] : h1[2 * i - 4], hi = (i < 2) ? h0[2 * i + 1] : h1[2 * i - 3];
      int w = 0;
      w = __builtin_amdgcn_cvt_pk_fp8_f32(bflo(lo) * r * g4.x, bfhi(lo) * r * g4.y, w, false);
      w = __builtin_amdgcn_cvt_pk_fp8_f32(bflo(hi) * r * g4.z, bfhi(hi) * r * g4.w, w, true);
      q[i] = (unsigned)w;
    }
    *(u32x4*)(XN8 + (size_t)t * 1024 + lane * 16) = q;
  }
  const int G = gridDim.x, nh = (G % 8 == 0) ? 8 : 1;
  LAS unsigned char* K1l = (LAS unsigned char*)smem;
  LAS unsigned char* K2l = K1l + 128 * KROW;
  for (int hd = blockIdx.x % nh; hd < 8; hd += nh) {
    for (int idx = tidr; idx < 2048; idx += NTHREADS) {
      const int tb = idx >> 10, row = (idx >> 3) & 127, ch = idx & 7;
      const u32x4 v = *(const u32x4*)((tb ? K2 : K1) + hd * 8192 + row * 64 + ch * 8);
      *(LAS u32x4*)((tb ? K2l : K1l) + row * KROW + ch * 16) = v;
    }
    __syncthreads();
    for (int tile = (blockIdx.x / nh) * NWAVES + wave; tile < T / 32; tile += (G / nh) * NWAVES) {
      const int t0 = tile * 32;
      const int tok = lane & 31, hf = lane >> 5;
      const bf16_t* qrow = QH + (size_t)(t0 + tok) * 1024 + hd * 128;
      unsigned top1[16], top2[16];
      subkey_top16(K1l, qrow, lane, top1);
      subkey_top16(K2l, qrow + 64, lane, top2);
      float fa[16], fb[16];
      unsigned ia[16], ib[16];
#pragma unroll
      for (int i = 0; i < 16; ++i) {
        const unsigned ua = key2u(hf ? top2[i] : top1[i]), ub = key2u(hf ? top1[i] : top2[i]);
        fa[i] = __uint_as_float(ua); ia[i] = ua & 0x7Fu;
        fb[i] = __uint_as_float(ub); ib[i] = ub & 0x7Fu;
      }
      unsigned ck[32];
      {
        int n = 0;
#pragma unroll
        for (int i = 0; i < 4; ++i) {
#pragma unroll
          for (int j = i; j < 16; ++j) {
            if ((i + 1) * (j + 1) <= 16) {
              unsigned key = (f2key_raw(fa[i] + fb[j]) & ~0x3FFFu) | (hf ? ((ib[j] << 7) | ia[i]) : ((ia[i] << 7) | ib[j]));
              if (i == j && hf) key = 0u;
              ck[n] = key;
              ++n;
            }
          }
        }
#pragma unroll
        for (; n < 32; ++n) ck[n] = 0u;
      }
      unsigned k0[16], k1[16];
#pragma unroll
      for (int i = 0; i < 16; ++i) { k0[i] = ck[i]; k1[i] = ck[16 + i]; }
      bitonic_sort_desc<16>(k0);
      bitonic_sort_desc<16>(k1);
      merge_top16(k0, k1);
#pragma unroll
      for (int i = 0; i < 16; ++i) k1[i] = __shfl_xor(k0[i], 32);
      merge_top16(k0, k1);
      float sv[16], sum = 0.f;
      const float mx = __uint_as_float(key2u(k0[0] & ~0x3FFFu));
#pragma unroll
      for (int i = 0; i < 16; ++i) {
        sv[i] = __builtin_amdgcn_exp2f((__uint_as_float(key2u(k0[i] & ~0x3FFFu)) - mx) * LOG2E);
        sum += sv[i];
      }
      const float inv = 1.f / sum;
      const size_t po = ((size_t)(t0 + tok) * 8 + hd) * 16;
      if (hf == 0) {
#pragma unroll
        for (int q = 0; q < 4; ++q) *(u32x4*)(PIDX + po + 4 * q) = (u32x4){k0[4 * q] & 0x3FFFu, k0[4 * q + 1] & 0x3FFFu, k0[4 * q + 2] & 0x3FFFu, k0[4 * q + 3] & 0x3FFFu};
      } else {
#pragma unroll
        for (int q = 0; q < 4; ++q) *(f32x4*)(PG + po + 4 * q) = (f32x4){sv[4 * q] * inv, sv[4 * q + 1] * inv, sv[4 * q + 2] * inv, sv[4 * q + 3] * inv};
      }
    }
    __syncthreads();
  }
}

typedef int i32x8 __attribute__((ext_vector_type(8)));
__device__ __forceinline__ f32x4 mfma_fp4_fp8(u32x4 a, u32x4 b0, u32x4 b1, f32x4 c) {
  const i32x8 A = {(int)a.x, (int)a.y, (int)a.z, (int)a.w, 0, 0, 0, 0};
  const i32x8 B = {(int)b0.x, (int)b0.y, (int)b0.z, (int)b0.w, (int)b1.x, (int)b1.y, (int)b1.z, (int)b1.w};
  return __builtin_amdgcn_mfma_scale_f32_16x16x128_f8f6f4(A, B, c, 4, 0, 0, 0x7F7F7F7F, 0, 0x7F7F7F7F);
}
struct PeCtx {
  const unsigned char* U8; const float2* USV; LAS float* glist;
  LAS unsigned* list; int lane, r, g, s, n, t0;
};
__device__ __forceinline__ void pe_rows(const PeCtx& c, int ci, u32x4 (&a)[8]) {
  const int idx = ci * 16 + (c.lane >> 2);
  const unsigned ent = c.list[idx & 2047];
  const unsigned e = (idx < c.n) ? ((ent >> 7) & 16383u) : (unsigned)(c.s << 11);
  const unsigned char* rp = c.U8 + (size_t)e * 512 + (c.lane & 3) * 16;
#pragma unroll
  for (int ks = 0; ks < 8; ++ks) a[ks] = *(const u32x4*)(rp + ks * 64);
}
__device__ __forceinline__ void pe_fix(const PeCtx& c, u32x4 (&a)[8]) {
  const int src = 4 * c.r + c.g;
#pragma unroll
  for (int ks = 0; ks < 8; ++ks) {
    a[ks].x = (unsigned)__shfl((int)a[ks].x, src); a[ks].y = (unsigned)__shfl((int)a[ks].y, src);
    a[ks].z = (unsigned)__shfl((int)a[ks].z, src); a[ks].w = (unsigned)__shfl((int)a[ks].w, src);
  }
}
__device__ __forceinline__ void pe_chunk(const PeCtx& c, int ci, u32x4 (&a)[8], u32x4 (&anext)[8], const u32x4 (&bq)[16]) {
  const int idx = ci * 16 + c.r;
  const unsigned ent = c.list[idx & 2047];
  const bool fin = (c.lane < 16) && (idx < c.n);
  const unsigned e = (ent >> 7) & 16383u, col = (ent >> 21) & 15u;
  const float2 usv = c.USV[fin ? e : 0u];
  const float gt = c.glist[idx & 2047], us = usv.x, vs = usv.y;
  __builtin_amdgcn_sched_barrier(0);
  pe_rows(c, ci + 1, anext);
  __builtin_amdgcn_sched_barrier(0);
  pe_fix(c, a);
  f32x4 acc = {0.f, 0.f, 0.f, 0.f};
#pragma unroll
  for (int ks = 0; ks < 8; ++ks) acc = mfma_fp4_fp8(a[ks], bq[2 * ks], bq[2 * ks + 1], acc);
  const int src = ((c.r >> 2) << 4) | (int)col;
  const float v0 = __shfl(acc[0], src), v1 = __shfl(acc[1], src), v2 = __shfl(acc[2], src), v3 = __shfl(acc[3], src);
  float d = ((c.r & 3) == 0) ? v0 : ((c.r & 3) == 1) ? v1 : ((c.r & 3) == 2) ? v2 : v3;
  float gt_ = gt, us_ = us, vs_ = vs;
  asm volatile("" : "+v"(d), "+v"(gt_), "+v"(us_), "+v"(vs_));
  {
    const float act = d * us_ * (1.f / 16.f);
    const float w = gt_ * 0.5f * act * (1.f + erff(act * 0.70710678118654752f)) * vs_;
    if (fin) c.glist[idx & 2047] = w;
  }
}
#define PFV_LOAD(R, ev, k0)                                                                               \
  {                                                                                                       \
    _Pragma("unroll") for (int i_ = 0; i_ < 8; ++i_) {                                                    \
      const unsigned e_ = (unsigned)__builtin_amdgcn_ds_bpermute(bsel + 4 * ((k0) + 2 * i_), (int)(ev)); \
      R[i_] = *(const u32x4*)(V4 + (e_ << 9));                                                            \
    }                                                                                                     \
  }
#define PFV_FMA(dw, b, a) acc[a] = __builtin_elementwise_fma(__builtin_amdgcn_cvt_scalef32_pk_f32_fp4(dw, 1.0f, b), w2_, acc[a]);
#define PFV_ACC(R, wv, k0)                                                                                \
  {                                                                                                       \
    _Pragma("unroll") for (int i_ = 0; i_ < 8; ++i_) {                                                    \
      const float ws_ = __builtin_bit_cast(float, __builtin_amdgcn_ds_bpermute(bsel + 4 * ((k0) + 2 * i_), __builtin_bit_cast(int, (wv)))); \
      const f32x2 w2_ = {ws_, ws_};                                                                       \
      PFV_FMA(R[i_].x, 0, 0)  PFV_FMA(R[i_].x, 1, 1)  PFV_FMA(R[i_].x, 2, 2)  PFV_FMA(R[i_].x, 3, 3)      \
      PFV_FMA(R[i_].y, 0, 4)  PFV_FMA(R[i_].y, 1, 5)  PFV_FMA(R[i_].y, 2, 6)  PFV_FMA(R[i_].y, 3, 7)      \
      PFV_FMA(R[i_].z, 0, 8)  PFV_FMA(R[i_].z, 1, 9)  PFV_FMA(R[i_].z, 2, 10) PFV_FMA(R[i_].z, 3, 11)     \
      PFV_FMA(R[i_].w, 0, 12) PFV_FMA(R[i_].w, 1, 13) PFV_FMA(R[i_].w, 2, 14) PFV_FMA(R[i_].w, 3, 15)     \
    }                                                                                                     \
  }
__device__ void phase_peer_u(const Params& p, char* smem) {
  unsigned char* ws = p.ws;
  PeCtx c;
  c.U8 = ws + WS_U8; c.USV = (const float2*)(ws + WS_USV);
  const float* PG = (const float*)(ws + WS_PG);
  const bf16_t* HB = (const bf16_t*)(ws + WS_HB);
  const unsigned char* XN8 = ws + WS_XN8;
  const unsigned* PIDX = (const unsigned*)(ws + WS_PIDX);
  const int tidu = otid();
  const int lane = tidu & 63, wave = tidu >> 6;
  c.lane = lane; c.r = lane & 15; c.g = lane >> 4;
  c.list = (LAS unsigned*)(smem + wave * 8192);
  c.glist = (LAS float*)(smem + 65536 + wave * 8192);
  const bool hi = lane >= 32;
  const int bsel = hi ? 4 : 0;
  const unsigned char* V4 = ws + WS_V8 + (lane & 31) * 16;
  c.s = 0;
  {
    for (int grp = vblock() * NWAVES + wave; grp < T / 16; grp += gridDim.x * NWAVES) {
      const int t0 = grp * 16;
      c.t0 = t0;
      u32x4 bq[16];
      {
        const unsigned char* xp = XN8 + (size_t)(t0 + c.r) * 1024 + c.g * 16;
#pragma unroll
        for (int ks = 0; ks < 8; ++ks) { bq[2 * ks] = *(const u32x4*)(xp + ks * 128); bq[2 * ks + 1] = *(const u32x4*)(xp + ks * 128 + 64); }
      }
      const int n = 2048;
#pragma unroll
      for (int q = 0; q < 8; ++q) {
        const u32x4 idv = *(const u32x4*)(PIDX + (size_t)t0 * 128 + q * 256 + lane * 4);
        const f32x4 gv = *(const f32x4*)(PG + (size_t)t0 * 128 + q * 256 + lane * 4);
        const unsigned hi = (unsigned)(2 * q + (lane >> 5)) << 21, sl = (unsigned)((lane & 31) * 4);
        *(LAS u32x4*)(c.list + q * 256 + lane * 4) = (u32x4){hi | (idv.x << 7) | sl, hi | (idv.y << 7) | (sl + 1), hi | (idv.z << 7) | (sl + 2), hi | (idv.w << 7) | (sl + 3)};
        *(LAS f32x4*)(c.glist + q * 256 + lane * 4) = gv;
      }
      asm volatile("s_waitcnt lgkmcnt(0)" ::: "memory");
      c.n = n;
      const int nch = (n + 15) >> 4;
      u32x4 a0[8], a1[8];
      pe_rows(c, 0, a0);
      {
        unsigned z = 0u;
#pragma unroll
        for (int ks = 0; ks < 8; ++ks) z |= a0[ks].w;
        asm volatile("" ::"v"(z));
      }
      if (nch > 0) {
        for (int ci = 0;; ci += 2) {
          pe_chunk(c, ci, a0, a1, bq);
          if (ci + 1 >= nch) break;
          pe_chunk(c, ci + 1, a1, a0, bq);
          if (ci + 2 >= nch) break;
        }
      }
      asm volatile("s_waitcnt lgkmcnt(0)" ::: "memory");
      {
        unsigned e0 = (c.list[lane] >> 7) & 16383u, e1 = (c.list[64 + lane] >> 7) & 16383u;
        float w0 = c.glist[lane], w1 = c.glist[64 + lane];
        u32x4 RA[8], RB[8];
        PFV_LOAD(RA, e0, 0)
        {
          unsigned z = 0u;
#pragma unroll
          for (int i = 0; i < 8; ++i) z |= RA[i].w;
          asm volatile("" ::"v"(z));
        }
        for (int tk = 0; tk < 16; ++tk) {
          const int tn = tk < 15 ? tk + 1 : tk;
          const unsigned e0n = (c.list[tn * 128 + lane] >> 7) & 16383u, e1n = (c.list[tn * 128 + 64 + lane] >> 7) & 16383u;
          const float w0n = c.glist[tn * 128 + lane], w1n = c.glist[tn * 128 + 64 + lane];
          const size_t oo = (size_t)(t0 + tk) * 1024 + (lane & 31) * 32 + (hi ? 16 : 0);
          const u32x4 hb0 = *(const u32x4*)(HB + oo), hb1 = *(const u32x4*)(HB + oo + 8);
          f32x2 acc[16];
#pragma unroll
          for (int k = 0; k < 16; ++k) acc[k] = (f32x2){0.f, 0.f};
          __builtin_amdgcn_sched_barrier(0);
          PFV_LOAD(RB, e0, 16)  __builtin_amdgcn_sched_barrier(0);  PFV_ACC(RA, w0, 0)
          PFV_LOAD(RA, e0, 32)  __builtin_amdgcn_sched_barrier(0);  PFV_ACC(RB, w0, 16)
          PFV_LOAD(RB, e0, 48)  __builtin_amdgcn_sched_barrier(0);  PFV_ACC(RA, w0, 32)
          PFV_LOAD(RA, e1, 0)   __builtin_amdgcn_sched_barrier(0);  PFV_ACC(RB, w0, 48)
          PFV_LOAD(RB, e1, 16)  __builtin_amdgcn_sched_barrier(0);  PFV_ACC(RA, w1, 0)
          PFV_LOAD(RA, e1, 32)  __builtin_amdgcn_sched_barrier(0);  PFV_ACC(RB, w1, 16)
          PFV_LOAD(RB, e1, 48)  __builtin_amdgcn_sched_barrier(0);  PFV_ACC(RA, w1, 32)
          PFV_LOAD(RA, e0n, 0)  __builtin_amdgcn_sched_barrier(0);  PFV_ACC(RB, w1, 48)
          f32x2 r[8];
#pragma unroll
          for (int k = 0; k < 8; ++k) {
            const f32x2 keep = hi ? acc[8 + k] : acc[k], send = hi ? acc[k] : acc[8 + k];
            r[k] = keep + (f32x2){__shfl_xor(send.x, 32), __shfl_xor(send.y, 32)};
          }
          float* o = p.out + oo;
          *(f32x4*)(o)      = (f32x4){bflo(hb0.x) + r[0].x, bfhi(hb0.x) + r[0].y, bflo(hb0.y) + r[1].x, bfhi(hb0.y) + r[1].y};
          *(f32x4*)(o + 4)  = (f32x4){bflo(hb0.z) + r[2].x, bfhi(hb0.z) + r[2].y, bflo(hb0.w) + r[3].x, bfhi(hb0.w) + r[3].y};
          *(f32x4*)(o + 8)  = (f32x4){bflo(hb1.x) + r[4].x, bfhi(hb1.x) + r[4].y, bflo(hb1.y) + r[5].x, bfhi(hb1.y) + r[5].y};
          *(f32x4*)(o + 12) = (f32x4){bflo(hb1.z) + r[6].x, bfhi(hb1.z) + r[6].y, bflo(hb1.w) + r[7].x, bfhi(hb1.w) + r[7].y};
          e0 = e0n; e1 = e1n; w0 = w0n; w1 = w1n;
        }
      }
      asm volatile("" ::: "memory");
    }
  }
}
#undef PFV_LOAD
#undef PFV_FMA
#undef PFV_ACC


#define XB_TMO      128
#define XB_XCNT(j)  (256  + 64 * (j))
#define XB_XSUB(j)  (1280 + 64 * (j))
#define XB_XGEN(j)  (2304 + 64 * (j))
#define XB_TOP      3328
#define XB_TOPGEN   3392
#define XCD_BAR_WORDS 3456
#define XB_SPIN_CAP (1u << 22)
__device__ __forceinline__ unsigned xb_ld(unsigned* p)              { return __hip_atomic_load(p, __ATOMIC_RELAXED, __HIP_MEMORY_SCOPE_AGENT); }
__device__ __forceinline__ unsigned xb_add(unsigned* p, unsigned v) { return __hip_atomic_fetch_add(p, v, __ATOMIC_RELAXED, __HIP_MEMORY_SCOPE_AGENT); }
__device__ __forceinline__ unsigned xb_xcc_id() { return (unsigned)__builtin_amdgcn_s_getreg((3 << 11) | 20) & 0xFu; }
#define XB_SPIN(cond, bar) do { unsigned _sp = 0; while (cond) { __builtin_amdgcn_s_sleep(1); \
    if ((++_sp & 255u) == 0u) { if (xb_ld(&(bar)[XB_TMO])) break; if (_sp > XB_SPIN_CAP) { atomicAdd(&(bar)[XB_TMO], 1u); break; } } } } while (0)
struct XcdBarrier { unsigned* bar; unsigned x; volatile LAS unsigned* st; };
__device__ __forceinline__ XcdBarrier xcd_barrier_post(unsigned* bar, volatile LAS unsigned* st) {
    XcdBarrier b; b.bar = bar; b.x = xb_xcc_id(); b.st = st;
    if (threadIdx.x == 0) (void)xb_add(&bar[XB_XCNT(b.x)], 1u);
    return b;
}
__device__ __forceinline__ void xcd_barrier_complete(unsigned* bar, unsigned x, unsigned& nloc, unsigned& nx) {
    const unsigned G = gridDim.x * gridDim.y * gridDim.z;
    unsigned sum, cnt, mine, sp = 0u;
    for (;;) {
        sum = 0u; cnt = 0u; mine = 0u;
#pragma unroll
        for (unsigned j = 0; j < 16; ++j) { const unsigned c = xb_ld(&bar[XB_XCNT(j)]); sum += c; cnt += (c > 0u) ? 1u : 0u; mine = (j == x) ? c : mine; }
        if (sum == G) break;
        __builtin_amdgcn_s_sleep(1);
        if ((++sp & 255u) == 0u) { if (xb_ld(&bar[XB_TMO])) break; if (sp > XB_SPIN_CAP) { atomicAdd(&bar[XB_TMO], 1u); break; } }
    }
    nloc = mine > 0u ? mine : 1u; nx = cnt > 0u ? cnt : 1u;
}
__device__ __forceinline__ void xcd_barrier(const XcdBarrier& b) {
    asm volatile("s_waitcnt vmcnt(0)" ::: "memory");
    __syncthreads();
    if (threadIdx.x == 0) {
        unsigned* bar = b.bar;
        __builtin_amdgcn_s_waitcnt(0);
        unsigned nloc = b.st[0], nx = b.st[1];
        if (nloc == 0u) { xcd_barrier_complete(bar, b.x, nloc, nx); b.st[0] = nloc; b.st[1] = nx; }
        const unsigned old = xb_add(&bar[XB_XSUB(b.x)], 1u);
        const unsigned gen = old / nloc;
        if (old + 1u == (gen + 1u) * nloc) {
            __builtin_amdgcn_fence(__ATOMIC_RELEASE, "agent");
            asm volatile("s_waitcnt vmcnt(0)" ::: "memory");
            const unsigned og = xb_add(&bar[XB_TOP], 1u);
            const unsigned tg = og / nx;
            if (og + 1u == (tg + 1u) * nx) xb_add(&bar[XB_TOPGEN], 1u);
            else XB_SPIN(xb_ld(&bar[XB_TOPGEN]) == tg, bar);
            __builtin_amdgcn_fence(__ATOMIC_ACQUIRE, "agent");
            xb_add(&bar[XB_XGEN(b.x)], 1u);
            asm volatile("s_waitcnt vmcnt(0)" ::: "memory");
        } else {
            XB_SPIN(xb_ld(&bar[XB_XGEN(b.x)]) == gen, bar);
            __builtin_amdgcn_fence(__ATOMIC_ACQUIRE, "agent");
            asm volatile("s_waitcnt vmcnt(0)" ::: "memory");
        }
    }
    __syncthreads();
}

__global__ void __launch_bounds__(NTHREADS, 2) k_fused(Params p) {
  __shared__ __attribute__((aligned(16))) char smem[LDS_BYTES];
  if (threadIdx.x == 0) *(u32x4*)(smem + LDS_BAR) = (u32x4){0u, 0u, 0u, 0u};
  __syncthreads();
  const XcdBarrier bar = xcd_barrier_post((unsigned*)(p.ws + WS_CTL), (volatile LAS unsigned*)(smem + LDS_BAR));
#ifdef PROBE_PHASE
  unsigned long long ts[12];
#define STAMP(k) ts[k] = __builtin_amdgcn_s_memrealtime();
#else
#define STAMP(k)
#endif
  STAMP(0)
  phase_prep(p);
  xcd_barrier(bar);
  STAMP(1)
  phase_inproj(p, smem);
  xcd_barrier(bar);
  STAMP(2)
  phase_mix(p, smem);
  xcd_barrier(bar);
  STAMP(3)
  phase_outproj(p, smem);
  xcd_barrier(bar);
  STAMP(4)
  phase_qproj(p, smem);
  xcd_barrier(bar);
  STAMP(5)
  phase_route(p, smem);
  xcd_barrier(bar);
  STAMP(6)
  phase_peer_u(p, smem);
#ifdef PROBE_PHASE
  xcd_barrier(bar);
  STAMP(7)
  if (blockIdx.x == 0 && threadIdx.x == 0) {
    const float us = (float)(ts[PROBE_PHASE + 1] - ts[PROBE_PHASE]) * 0.01f;
    p.out[12345] += us * (1.f / PROBE_DIV);
  }
#endif
}

extern "C" void kernel_launch(void* const* d_in, const int* in_sizes, int n_in, void* d_out, int out_size, void* d_ws, size_t ws_size,
                              hipStream_t stream) {
  if (n_in != 17 || ws_size < WS_END) {
    fprintf(stderr, "kernel_launch: unexpected n_in %d / ws_size %zu\n", n_in, ws_size);
    return;
  }
  Params p{};
  p.x = (const float*)d_in[0]; p.norm_mix_g = (const float*)d_in[1]; p.w_in = (const float*)d_in[2]; p.q_norm_g = (const float*)d_in[3];
  p.k_norm_g = (const float*)d_in[4]; p.attn_out_g = (const float*)d_in[5]; p.conv_w = (const float*)d_in[6]; p.conv_b = (const float*)d_in[7];
  p.conv_ln_g = (const float*)d_in[8]; p.conv_ln_b = (const float*)d_in[9]; p.w_out = (const float*)d_in[10]; p.norm_ffn_g = (const float*)d_in[11];
  p.peer_wq = (const float*)d_in[12]; p.peer_k1 = (const float*)d_in[13]; p.peer_k2 = (const float*)d_in[14]; p.peer_u = (const float*)d_in[15];
  p.peer_v = (const float*)d_in[16];
  p.out = (float*)d_out;
  p.ws = (unsigned char*)d_ws;
  static int grid_blocks = 0;
  if (!grid_blocks) {
    int dev = 0, cus = 0, per_cu = 0;
    (void)hipGetDevice(&dev);
    (void)hipDeviceGetAttribute(&cus, hipDeviceAttributeMultiprocessorCount, dev);
    (void)hipOccupancyMaxActiveBlocksPerMultiprocessor(&per_cu, k_fused, NTHREADS, 0);
    if (per_cu > 1) per_cu = 1;
    if (per_cu < 1) per_cu = 1;
    grid_blocks = cus * per_cu;
  }
  (void)hipMemsetAsync((char*)d_ws + WS_CTL, 0, XCD_BAR_WORDS * 4, stream);
  hipLaunchKernelGGL(k_fused, dim3(grid_blocks), dim3(NTHREADS), 0, stream, p);
}
```

```cpp
#include <hip/hip_runtime.h>
#include <cstdio>

#define LAS __attribute__((address_space(3)))
typedef unsigned short bf16_t;
typedef __bf16 bf16x8 __attribute__((ext_vector_type(8)));
typedef __bf16 bf16x2 __attribute__((ext_vector_type(2)));
typedef float f32x4 __attribute__((ext_vector_type(4)));
typedef float f32x16 __attribute__((ext_vector_type(16)));
typedef unsigned u32x4 __attribute__((ext_vector_type(4)));
typedef unsigned u32x2 __attribute__((ext_vector_type(2)));
typedef float f32x2 __attribute__((ext_vector_type(2)));

constexpr int SEQ = 4096, T = 8 * SEQ, D = 1024, NIN = 2560;
constexpr float EPS = 1e-6f;
constexpr float LOG2E = 1.4426950408889634f;

constexpr size_t MiB = 1u << 20;
constexpr size_t WS_W1 = 0, WS_WV = 4 * MiB, WS_WOUT = 5 * MiB, WS_WQ = 7 * MiB, WS_K1 = 9 * MiB, WS_K2 = 9 * MiB + 131072, WS_SSQ = 10 * MiB;
constexpr size_t WS_CTL = 11 * MiB;
constexpr size_t WS_USV = 11 * MiB + 65536;
constexpr size_t WS_RS1 = 11 * MiB + 196608, WS_SSQ2 = 11 * MiB + 327680;
constexpr size_t WS_U8 = 12 * MiB, WS_V8 = 28 * MiB;
constexpr size_t WS_XB = 44 * MiB;
constexpr size_t WS_Q = 108 * MiB, WS_K = 140 * MiB, WS_VT = 172 * MiB, WS_HG = 204 * MiB, WS_MIX = 236 * MiB;
constexpr size_t WS_HB = 300 * MiB, WS_QH = 364 * MiB;
constexpr size_t WS_XN8 = 108 * MiB, WS_PIDX = 140 * MiB, WS_PG = 156 * MiB, WS_PW = 172 * MiB;
constexpr size_t WS_END = 428 * MiB;

struct Params {
  const float *x, *norm_mix_g, *w_in, *q_norm_g, *k_norm_g, *attn_out_g, *conv_w, *conv_b, *conv_ln_g, *conv_ln_b,
      *w_out, *norm_ffn_g, *peer_wq, *peer_k1, *peer_k2, *peer_u, *peer_v;
  float* out;
  unsigned char* ws;
};

constexpr int NTHREADS = 512, NWAVES = 8;
constexpr int LDS_STAGE = 131072, LDS_BAR = LDS_STAGE, LDS_BYTES = LDS_STAGE + 16;

__device__ __forceinline__ unsigned pk2(float lo, float hi) {
  bf16x2 v = {(__bf16)lo, (__bf16)hi};
  return __builtin_bit_cast(unsigned, v);
}
__device__ __forceinline__ float bflo(unsigned u) { return __uint_as_float(u << 16); }
__device__ __forceinline__ float bfhi(unsigned u) { return __uint_as_float(u & 0xffff0000u); }
__device__ __forceinline__ int otid() { int t = threadIdx.x; asm volatile("" : "+v"(t)); return t; }
__device__ __forceinline__ int vblock() {
  const int G = gridDim.x, b = blockIdx.x;
  return (G % 8 == 0) ? (b % 8) * (G / 8) + b / 8 : b;
}
__device__ __forceinline__ f32x16 mfma32(bf16x8 a, bf16x8 b, f32x16 c) { return __builtin_amdgcn_mfma_f32_32x32x16_bf16(a, b, c, 0, 0, 0); }

__device__ __forceinline__ int w1_src(int n) {
  if (n < 1024) {
    const int kind = n >> 9, rel = n & 511, pn = rel >> 8, P = rel & 255, bj = P >> 7, wc = (P >> 5) & 3, x = P & 31;
    return kind * 512 + (4 * pn + wc) * 64 + 32 * bj + x;
  }
  const int rel = n - 1024, pn = rel >> 8, P = rel & 255, bj = P >> 7, wc = (P >> 5) & 3, x = P & 31;
  return (bj ? 2048 : 1536) + 128 * pn + 32 * wc + x;
}
__device__ __forceinline__ void transpose_items(const float* __restrict__ W, int ldw, int N, bf16_t* __restrict__ Wt, const float* __restrict__ g, int glimit,
                                                int mode, long gtid, long nthr) {
  const long nitems = (long)N * 128;
  for (long it = gtid; it < nitems; it += nthr) {
    const int n = (int)(it % N), kc = (int)(it / N);
    const int src = mode == 1 ? w1_src(n) : (mode == 2 ? 1024 + n : n);
    float v[8];
#pragma unroll
    for (int i = 0; i < 8; ++i) {
      const int k = kc * 8 + i;
      float w = W[(size_t)k * ldw + src];
      if (k < glimit) w *= g[k];
      v[i] = w;
    }
    u32x4 o = {pk2(v[0], v[1]), pk2(v[2], v[3]), pk2(v[4], v[5]), pk2(v[6], v[7])};
    *(u32x4*)(Wt + (size_t)n * 1024 + kc * 8) = o;
  }
}
__device__ __forceinline__ void convert_items(const float* __restrict__ src, bf16_t* __restrict__ dst, long n8, long gtid, long nthr) {
  for (long it = gtid; it < n8; it += nthr) {
    const f32x4 a = *(const f32x4*)(src + it * 8), b = *(const f32x4*)(src + it * 8 + 4);
    u32x4 o = {pk2(a.x, a.y), pk2(a.z, a.w), pk2(b.x, b.y), pk2(b.z, b.w)};
    *(u32x4*)(dst + it * 8) = o;
  }
}
__device__ void phase_prep(const Params& p) {
  const int tid0 = otid();
  const long gtid = (long)vblock() * NTHREADS + tid0, nthr = (long)gridDim.x * NTHREADS;
  unsigned char* ws = p.ws;
  transpose_items(p.w_in, NIN, 2048, (bf16_t*)(ws + WS_W1), p.norm_mix_g, 1024, 1, gtid, nthr);
  transpose_items(p.w_in, NIN, 512, (bf16_t*)(ws + WS_WV), p.norm_mix_g, 1024, 2, gtid, nthr);
  transpose_items(p.w_out, D, D, (bf16_t*)(ws + WS_WOUT), p.attn_out_g, 512, 0, gtid, nthr);
  transpose_items(p.peer_wq, D, D, (bf16_t*)(ws + WS_WQ), p.norm_ffn_g, 1024, 0, gtid, nthr);
  convert_items(p.peer_k1, (bf16_t*)(ws + WS_K1), 65536 / 8, gtid, nthr);
  convert_items(p.peer_k2, (bf16_t*)(ws + WS_K2), 65536 / 8, gtid, nthr);
  const int lane = tid0 & 63, gw = vblock() * NWAVES + (tid0 >> 6), nw = gridDim.x * NWAVES;
  {
    bf16_t* XB = (bf16_t*)(ws + WS_XB);
    float* RS1 = (float*)(ws + WS_RS1);
    float* SSQ2 = (float*)(ws + WS_SSQ2);
    for (int tb = gw; tb < T; tb += 2 * nw) {
      f32x4 v[2][4];
      float ss[2] = {0.f, 0.f};
#pragma unroll
      for (int u = 0; u < 2; ++u) {
        const int t = (tb + u * nw < T) ? tb + u * nw : tb;
        const float* src = p.x + (size_t)t * 1024 + lane * 4;
#pragma unroll
        for (int i = 0; i < 4; ++i) v[u][i] = *(const f32x4*)(src + 256 * i);
      }
#pragma unroll
      for (int u = 0; u < 2; ++u) {
#pragma unroll
        for (int i = 0; i < 4; ++i) ss[u] += v[u][i].x * v[u][i].x + v[u][i].y * v[u][i].y + v[u][i].z * v[u][i].z + v[u][i].w * v[u][i].w;
      }
#pragma unroll
      for (int o = 1; o < 64; o <<= 1) { ss[0] += __shfl_xor(ss[0], o); ss[1] += __shfl_xor(ss[1], o); }
#pragma unroll
      for (int u = 0; u < 2; ++u) {
        const int t = tb + u * nw;
        if (t < T) {
#pragma unroll
          for (int i = 0; i < 4; ++i) *(u32x2*)(XB + (size_t)t * 1024 + lane * 4 + 256 * i) = (u32x2){pk2(v[u][i].x, v[u][i].y), pk2(v[u][i].z, v[u][i].w)};
          if (lane == 0) { RS1[t] = rsqrtf(ss[u] * (1.f / 1024.f) + EPS); SSQ2[t] = 0.f; }
        }
      }
    }
  }
}

__device__ void prep_tables(const Params& p) {
  unsigned char* ws = p.ws;
  const int tid0 = otid();
  const int lane = tid0 & 63, gw = vblock() * NWAVES + (tid0 >> 6), nw = gridDim.x * NWAVES;
  {
    f32x4 gn[4];
#pragma unroll
    for (int i = 0; i < 4; ++i) gn[i] = *(const f32x4*)(p.norm_ffn_g + lane * 16 + 4 * i);
    for (int rb = gw; rb < 32768; rb += 2 * nw) {
      f32x4 v[2][4];
#pragma unroll
      for (int u = 0; u < 2; ++u) {
        const int r = (rb + u * nw < 32768) ? rb + u * nw : rb;
        const float* src = ((r >> 14) ? p.peer_v : p.peer_u) + (size_t)(r & 16383) * 1024 + lane * 16;
#pragma unroll
        for (int i = 0; i < 4; ++i) v[u][i] = *(const f32x4*)(src + 4 * i);
        if (!(r >> 14)) {
#pragma unroll
          for (int i = 0; i < 4; ++i) v[u][i] *= gn[i];
        }
      }
      float am[2] = {0.f, 0.f};
#pragma unroll
      for (int u = 0; u < 2; ++u)
#pragma unroll
        for (int i = 0; i < 4; ++i)
          am[u] = fmaxf(am[u], fmaxf(fmaxf(fabsf(v[u][i].x), fabsf(v[u][i].y)), fmaxf(fabsf(v[u][i].z), fabsf(v[u][i].w))));
#pragma unroll
      for (int o = 1; o < 64; o <<= 1) { am[0] = fmaxf(am[0], __shfl_xor(am[0], o)); am[1] = fmaxf(am[1], __shfl_xor(am[1], o)); }
#pragma unroll
      for (int u = 0; u < 2; ++u) {
        const int r = rb + u * nw;
        if (r < 32768) {
          const int isv = r >> 14, e = r & 16383;
          const float scale = am[u] > 0.f ? am[u] * (1.f / 6.f) : 1.f, inv = am[u] > 0.f ? 6.f / am[u] : 0.f;
          unsigned q[2] = {0u, 0u};
#pragma unroll
          for (int i = 0; i < 4; ++i)
#pragma unroll
            for (int j = 0; j < 4; ++j) {
              const float xv = v[u][i][j], m = fabsf(xv) * inv;
              const unsigned code = (unsigned)(m > 0.25f) + (unsigned)(m > 0.75f) + (unsigned)(m > 1.25f) + (unsigned)(m > 1.75f) +
                                    (unsigned)(m > 2.5f) + (unsigned)(m > 3.5f) + (unsigned)(m > 5.0f);
              const unsigned nib = code | (xv < 0.f ? 8u : 0u);
              const int el = 4 * i + j;
              q[el >> 3] |= nib << (4 * (el & 7));
            }
          if (isv) {
            *(u32x2*)(ws + WS_V8 + (size_t)e * 512 + lane * 8) = (u32x2){q[0], q[1]};
            if (lane == 0) ((float*)(ws + WS_USV))[2 * e + 1] = scale;
          } else {
            *(u32x2*)(ws + WS_U8 + (size_t)e * 512 + lane * 8) = (u32x2){q[0], q[1]};
            if (lane == 0) ((float*)(ws + WS_USV))[2 * e] = scale;
          }
        }
      }
    }
  }
}

namespace pg8 {
typedef short sbf16x8 __attribute__((ext_vector_type(8)));
constexpr int BM = 256, BK = 64, HALF = 128, HTB = HALF * BK * 2  , NXCD = 8, WGM = 8;
__device__ __forceinline__ int lds_byte(int r, int c) { const int st = (r >> 4) * 2 + (c >> 5), rr = r & 15, cc = c & 31, ob = rr * 64 + cc * 2; return st * 1024 + (ob ^ (((ob >> 9) & 1) << 5)); }
__device__ __forceinline__ void stage_rc(int b, int& R, int& C) { const int st = b / 1024, sb = b % 1024, swz = sb ^ (((sb >> 9) & 1) << 5); R = (st >> 1) * 16 + swz / 64; C = (st & 1) * 32 + (swz % 64) / 2; }
__device__ __forceinline__ int perm32(int rho) { const int n = rho >> 4, i = rho & 15; return 8 * (i >> 2) + 4 * n + (i & 3); }
struct Unit { int pm, pn; };
struct Gemm { const bf16_t* A; const bf16_t* Bt; int M, N, K; };
struct StaticOrder {
    int nM, nN, nwg, G, c;
    __device__ void init(int M, int N, int G_, int c_) { nM = M / BM; nN = N / BM; nwg = nM * nN; G = G_; c = c_; }
    __device__ bool next(int i, Unit& u) const {
        const long L = (long)i * G + c; if (L >= nwg) return false;
        int wgid = (int)L; { const int q = nwg / NXCD, r = nwg % NXCD, xcd = wgid % NXCD, off = wgid / NXCD; wgid = (xcd < r ? xcd * (q + 1) : r * (q + 1) + (xcd - r) * q) + off; }
        const int nig = WGM * nN, gid = wgid / nig, fm = gid * WGM, gsz = (nM - fm) < WGM ? (nM - fm) : WGM;
        u.pm = fm + ((wgid % nig) % gsz); u.pn = (wgid % nig) / gsz; return true;
    }
};
template <class Epi>
__device__ __forceinline__ void gemm_phase(LAS unsigned char* lds, const Gemm g, const StaticOrder& S, const Epi& E) {
    const int tid = otid(), wid = __builtin_amdgcn_readfirstlane(tid >> 6), lane = tid & 63, wr = wid >> 2, wc = wid & 3, fr = lane & 15, fq = lane >> 4;
    const int K = g.K, nt = K / BK;
    unsigned voffA[2], voffB[2];
#pragma unroll
    for (int i = 0; i < 2; ++i) { int R, C; stage_rc(tid * 16 + i * 8192, R, C); const int Rb = Epi::PERM ? ((R & ~31) + perm32(R & 31)) : R;
        voffA[i] = (unsigned)(R * K + C) * 2u; voffB[i] = (unsigned)(Rb * K + C) * 2u; }
    const size_t kstep = (size_t)(BK * 2);
    const size_t hstep = (size_t)HALF * K * 2;
    const size_t tstep = 2 * hstep;
    const unsigned ldsw = (unsigned)wid * 1024u;
    const int aoff = lds_byte(wr * 64 + fr, fq * 8), boff = lds_byte(wc * 32 + fr, fq * 8);
#define PG8_SA(b, h) (((b) * 2 + (h)) * HTB)
#define PG8_SB(b, h) ((4 + (b) * 2 + (h)) * HTB)
#define PG8_STAGE(bufoff, gbase, voff) do { _Pragma("unroll") for (int _i = 0; _i < 2; ++_i) \
        __builtin_amdgcn_global_load_lds((const unsigned*)((const char*)(gbase) + (voff)[_i]), (LAS unsigned*)(lds + (bufoff) + ldsw + _i * 8192), 16, 0, 0); } while (0)
#define PG8_LDA(dst, b, h) do { _Pragma("unroll") for (int m = 0; m < 4; ++m) _Pragma("unroll") for (int k = 0; k < 2; ++k) dst[m][k] = *(const LAS sbf16x8*)(lds + PG8_SA(b, h) + aoff + m * 2048 + k * 1024); } while (0)
#define PG8_LDB(dst, b, h) do { _Pragma("unroll") for (int n = 0; n < 2; ++n) _Pragma("unroll") for (int k = 0; k < 2; ++k) dst[n][k] = *(const LAS sbf16x8*)(lds + PG8_SB(b, h) + boff + n * 2048 + k * 1024); } while (0)
#define PG8_MMA(ai, bj, At, Bt) do { __builtin_amdgcn_s_setprio(1); _Pragma("unroll") for (int m = 0; m < 4; ++m) _Pragma("unroll") for (int n = 0; n < 2; ++n) _Pragma("unroll") for (int k = 0; k < 2; ++k) \
        acc[ai][bj][m][n] = __builtin_amdgcn_mfma_f32_16x16x32_bf16(__builtin_bit_cast(bf16x8, Bt[n][k]), __builtin_bit_cast(bf16x8, At[m][k]), acc[ai][bj][m][n], 0, 0, 0); __builtin_amdgcn_s_setprio(0); } while (0)
#define PG8_WAIT_V(n) asm volatile("s_waitcnt vmcnt(" #n ")" ::: "memory")
#define PG8_WAIT_L(n) asm volatile("s_waitcnt lgkmcnt(" #n ")" ::: "memory")
#define PG8_BAR __builtin_amdgcn_s_barrier()
#define PG8_SCHED __builtin_amdgcn_sched_barrier(0)
    Unit cur, nxt; int ui = 0;
    if (!S.next(0, cur)) return;
    f32x4 acc[2][2][4][2];
#pragma unroll
    for (int a = 0; a < 2; ++a)
#pragma unroll
        for (int b = 0; b < 2; ++b)
#pragma unroll
            for (int m = 0; m < 4; ++m)
#pragma unroll
                for (int n = 0; n < 2; ++n) acc[a][b][m][n] = (f32x4){0.f, 0.f, 0.f, 0.f};
    sbf16x8 At[4][2], B0[2][2], B1[2][2];
    const char* cA = (const char*)g.A + (size_t)cur.pm * tstep; const char* cB = (const char*)g.Bt + (size_t)cur.pn * tstep;
    PG8_STAGE(PG8_SB(0, 0), cB, voffB); PG8_STAGE(PG8_SA(0, 0), cA, voffA); PG8_STAGE(PG8_SB(0, 1), cB + hstep, voffB); PG8_STAGE(PG8_SA(0, 1), cA + hstep, voffA);
    if (wr == 1) PG8_BAR;
    PG8_WAIT_V(4); PG8_BAR;
    PG8_STAGE(PG8_SB(1, 0), cB + kstep, voffB); PG8_STAGE(PG8_SA(1, 0), cA + kstep, voffA); PG8_STAGE(PG8_SB(1, 1), cB + hstep + kstep, voffB);
    PG8_WAIT_V(6); PG8_BAR;
    for (;;) {
        const bool has_next = S.next(ui + 1, nxt);
        const char* nA = has_next ? (const char*)g.A + (size_t)nxt.pm * tstep : cA; const char* nB = has_next ? (const char*)g.Bt + (size_t)nxt.pn * tstep : cB;
        for (int t = 0; t < nt; t += 2) {
            const bool last = (t == nt - 2);
            const char* a1 = cA + (size_t)(t + 1) * kstep;
            const char* a2 = last ? nA : cA + (size_t)(t + 2) * kstep; const char* b2 = last ? nB : cB + (size_t)(t + 2) * kstep;
            const char* a3 = a2 + kstep; const char* b3 = b2 + kstep;
            PG8_LDB(B0, 0, 0); PG8_SCHED; PG8_LDA(At, 0, 0); PG8_STAGE(PG8_SA(1, 1), a1 + hstep, voffA);
            PG8_WAIT_L(8); PG8_BAR; PG8_WAIT_L(0); PG8_MMA(0, 0, At, B0); PG8_BAR; PG8_SCHED;
            PG8_LDB(B1, 0, 1); PG8_STAGE(PG8_SB(0, 0), b2, voffB);
            PG8_BAR; PG8_WAIT_L(0); PG8_MMA(0, 1, At, B1); PG8_BAR;
            PG8_LDA(At, 0, 1); PG8_STAGE(PG8_SA(0, 0), a2, voffA);
            PG8_BAR; PG8_WAIT_L(0); PG8_MMA(1, 0, At, B0); PG8_BAR; PG8_SCHED;
            PG8_STAGE(PG8_SB(0, 1), b2 + hstep, voffB);
            PG8_WAIT_V(6); PG8_BAR; PG8_MMA(1, 1, At, B1); PG8_BAR;
            PG8_LDB(B0, 1, 0); PG8_SCHED; PG8_LDA(At, 1, 0); PG8_STAGE(PG8_SA(0, 1), a2 + hstep, voffA);
            PG8_WAIT_L(8); PG8_BAR; PG8_WAIT_L(0); PG8_MMA(0, 0, At, B0); PG8_BAR; PG8_SCHED;
            PG8_LDB(B1, 1, 1); PG8_STAGE(PG8_SB(1, 0), b3, voffB);
            PG8_BAR; PG8_WAIT_L(0); PG8_MMA(0, 1, At, B1); PG8_BAR;
            PG8_LDA(At, 1, 1); PG8_STAGE(PG8_SA(1, 0), a3, voffA);
            PG8_BAR; PG8_WAIT_L(0); PG8_MMA(1, 0, At, B0); PG8_BAR; PG8_SCHED;
            PG8_STAGE(PG8_SB(1, 1), b3 + hstep, voffB);
            PG8_WAIT_V(6); PG8_BAR; PG8_MMA(1, 1, At, B1); PG8_BAR;
        }
        E(acc, cur, wr, wc, fr, fq);
        if (!has_next) break;
#pragma unroll
        for (int a = 0; a < 2; ++a)
#pragma unroll
            for (int b = 0; b < 2; ++b)
#pragma unroll
                for (int m = 0; m < 4; ++m)
#pragma unroll
                    for (int n = 0; n < 2; ++n) acc[a][b][m][n] = (f32x4){0.f, 0.f, 0.f, 0.f};
        cur = nxt; cA = nA; cB = nB; ++ui;
    }
    PG8_WAIT_V(0);
    if (wr == 0) PG8_BAR;
    PG8_BAR;
#undef PG8_SA
#undef PG8_SB
#undef PG8_STAGE
#undef PG8_LDA
#undef PG8_LDB
#undef PG8_MMA
#undef PG8_WAIT_V
#undef PG8_WAIT_L
#undef PG8_BAR
#undef PG8_SCHED
}
}

struct EpiQKC {
  static constexpr bool PERM = true;
  const float* rs1; const float* qg; const float* kg; bf16_t* Q; bf16_t* Kk; bf16_t* HG;
  __device__ __forceinline__ void operator()(const f32x4 (&acc)[2][2][4][2], const pg8::Unit& u, int wr, int wc, int fr, int fq) const {
    const int row0 = u.pm * 256 + wr * 64 + fr;
    if (u.pn < 4) {
      const bool isq = u.pn < 2;
      const int head = 4 * (u.pn & 1) + wc;
      const float* g = isq ? qg : kg;
      f32x4 gv[2][2];
#pragma unroll
      for (int bj = 0; bj < 2; ++bj)
#pragma unroll
        for (int n = 0; n < 2; ++n) gv[bj][n] = *(const f32x4*)(g + 32 * bj + 8 * fq + 4 * n);
      bf16_t* base = isq ? Q : Kk;
#pragma unroll
      for (int ai = 0; ai < 2; ++ai)
#pragma unroll
        for (int m = 0; m < 4; ++m) {
          const int t = row0 + ai * 128 + m * 16;
          float ss = 0.f;
#pragma unroll
          for (int bj = 0; bj < 2; ++bj)
#pragma unroll
            for (int n = 0; n < 2; ++n) { const f32x4 v = acc[ai][bj][m][n]; ss += v.x * v.x + v.y * v.y + v.z * v.z + v.w * v.w; }
          ss += __shfl_xor(ss, 16);
          ss += __shfl_xor(ss, 32);
          const float r = rs1[t];
          float sc = r * rsqrtf(r * r * ss * (1.f / 64.f) + EPS);
          if (isq) sc *= 0.125f * LOG2E;
          bf16_t* dst = base + ((size_t)((t >> 12) * 8 + head) * 4096 + (t & 4095)) * 64 + 8 * fq;
#pragma unroll
          for (int bj = 0; bj < 2; ++bj) {
            const f32x4 a = acc[ai][bj][m][0] * gv[bj][0] * sc, b = acc[ai][bj][m][1] * gv[bj][1] * sc;
            *(u32x4*)(dst + 32 * bj) = (u32x4){pk2(a.x, a.y), pk2(a.z, a.w), pk2(b.x, b.y), pk2(b.z, b.w)};
          }
        }
    } else {
      const int ch0 = 128 * (u.pn - 4) + 32 * wc + 8 * fq;
#pragma unroll
      for (int ai = 0; ai < 2; ++ai)
#pragma unroll
        for (int m = 0; m < 4; ++m) {
          const int t = row0 + ai * 128 + m * 16;
          const float r = rs1[t];
          float h[8];
#pragma unroll
          for (int n = 0; n < 2; ++n)
#pragma unroll
            for (int j = 0; j < 4; ++j) h[4 * n + j] = acc[ai][0][m][n][j] * r / (1.f + __expf(-acc[ai][1][m][n][j] * r));
          *(u32x4*)(HG + (size_t)t * 512 + ch0) = (u32x4){pk2(h[0], h[1]), pk2(h[2], h[3]), pk2(h[4], h[5]), pk2(h[6], h[7])};
        }
    }
  }
};
struct EpiVt {
  static constexpr bool PERM = false;
  const float* rs1; bf16_t* Vt;
  __device__ __forceinline__ void operator()(const f32x4 (&acc)[2][2][4][2], const pg8::Unit& u, int wr, int wc, int fr, int fq) const {
    const int pos0 = 8 * (fq & 1) + 4 * (fq >> 1);
#pragma unroll
    for (int bj = 0; bj < 2; ++bj)
#pragma unroll
      for (int n = 0; n < 2; ++n) {
        const int t = u.pn * 256 + bj * 128 + wc * 32 + n * 16 + 4 * fq;
        const f32x4 r = *(const f32x4*)(rs1 + t);
        const size_t tb = ((size_t)(t >> 12) * 8) * 128 + ((t & 4095) >> 5);
#pragma unroll
        for (int ai = 0; ai < 2; ++ai)
#pragma unroll
          for (int m = 0; m < 4; ++m) {
            const int dg = u.pm * 256 + ai * 128 + wr * 64 + m * 16 + fr, head = dg >> 6, d = dg & 63;
            const f32x4 v = acc[ai][bj][m][n] * r;
            *(u32x2*)(Vt + ((tb + (size_t)head * 128) * 64 + d) * 32 + 16 * n + pos0) = (u32x2){pk2(v.x, v.y), pk2(v.z, v.w)};
          }
      }
  }
};
struct EpiOut {
  static constexpr bool PERM = false;
  const bf16_t* xb; bf16_t* HB; float* ssq2;
  __device__ __forceinline__ void operator()(const f32x4 (&acc)[2][2][4][2], const pg8::Unit& u, int wr, int wc, int fr, int fq) const {
    const int row0 = u.pm * 256 + wr * 64 + fr, col0 = u.pn * 256 + wc * 32 + 4 * fq;
#pragma unroll
    for (int ai = 0; ai < 2; ++ai)
#pragma unroll
      for (int m = 0; m < 4; ++m) {
        const int t = row0 + ai * 128 + m * 16;
        const size_t ro = (size_t)t * 1024 + col0;
        float ss = 0.f;
#pragma unroll
        for (int bj = 0; bj < 2; ++bj)
#pragma unroll
          for (int n = 0; n < 2; ++n) {
            const size_t o = ro + bj * 128 + n * 16;
            const u32x2 xv = *(const u32x2*)(xb + o);
            const f32x4 h = (f32x4){bflo(xv.x), bfhi(xv.x), bflo(xv.y), bfhi(xv.y)} + acc[ai][bj][m][n];
            *(u32x2*)(HB + o) = (u32x2){pk2(h.x, h.y), pk2(h.z, h.w)};
            ss += h.x * h.x + h.y * h.y + h.z * h.z + h.w * h.w;
          }
        ss += __shfl_xor(ss, 16);
        ss += __shfl_xor(ss, 32);
        if (fq == 0) atomicAdd(ssq2 + t, ss);
      }
  }
};
struct EpiQh {
  static constexpr bool PERM = true;
  const float* ssq2; bf16_t* QH;
  __device__ __forceinline__ void operator()(const f32x4 (&acc)[2][2][4][2], const pg8::Unit& u, int wr, int wc, int fr, int fq) const {
    const int row0 = u.pm * 256 + wr * 64 + fr, col0 = u.pn * 256 + wc * 32 + 8 * fq;
#pragma unroll
    for (int ai = 0; ai < 2; ++ai)
#pragma unroll
      for (int m = 0; m < 4; ++m) {
        const int t = row0 + ai * 128 + m * 16;
        const float r = rsqrtf(ssq2[t] * (1.f / 1024.f) + EPS);
#pragma unroll
        for (int bj = 0; bj < 2; ++bj) {
          const f32x4 a = acc[ai][bj][m][0] * r, b = acc[ai][bj][m][1] * r;
          *(u32x4*)(QH + (size_t)t * 1024 + col0 + bj * 128) = (u32x4){pk2(a.x, a.y), pk2(a.z, a.w), pk2(b.x, b.y), pk2(b.z, b.w)};
        }
      }
  }
};

__device__ void phase_inproj(const Params& p, char* smem) {
  unsigned char* ws = p.ws;
  LAS unsigned char* lds = (LAS unsigned char*)smem;
  const bf16_t* XB = (const bf16_t*)(ws + WS_XB);
  const float* RS1 = (const float*)(ws + WS_RS1);
  pg8::StaticOrder S;
  {
    pg8::Gemm g{XB, (const bf16_t*)(ws + WS_W1), T, 2048, 1024};
    S.init(T, 2048, gridDim.x, blockIdx.x);
    EpiQKC E{RS1, p.q_norm_g, p.k_norm_g, (bf16_t*)(ws + WS_Q), (bf16_t*)(ws + WS_K), (bf16_t*)(ws + WS_HG)};
    pg8::gemm_phase<EpiQKC>(lds, g, S, E);
  }
  {
    pg8::Gemm g{(const bf16_t*)(ws + WS_WV), XB, 512, T, 1024};
    S.init(512, T, gridDim.x, blockIdx.x);
    EpiVt E{RS1, (bf16_t*)(ws + WS_VT)};
    pg8::gemm_phase<EpiVt>(lds, g, S, E);
  }
}
__device__ void phase_outproj(const Params& p, char* smem) {
  unsigned char* ws = p.ws;
  pg8::Gemm g{(const bf16_t*)(ws + WS_MIX), (const bf16_t*)(ws + WS_WOUT), T, 1024, 1024};
  pg8::StaticOrder S;
  S.init(T, 1024, gridDim.x, blockIdx.x);
  EpiOut E{(const bf16_t*)(ws + WS_XB), (bf16_t*)(ws + WS_HB), (float*)(ws + WS_SSQ2)};
  pg8::gemm_phase<EpiOut>((LAS unsigned char*)smem, g, S, E);
}
__device__ void phase_qproj(const Params& p, char* smem) {
  unsigned char* ws = p.ws;
  pg8::Gemm g{(const bf16_t*)(ws + WS_HB), (const bf16_t*)(ws + WS_WQ), T, 1024, 1024};
  pg8::StaticOrder S;
  S.init(T, 1024, gridDim.x, blockIdx.x);
  EpiQh E{(const float*)(ws + WS_SSQ2), (bf16_t*)(ws + WS_QH)};
  pg8::gemm_phase<EpiQh>((LAS unsigned char*)smem, g, S, E);
}

__device__ __forceinline__ void conv_stage(const bf16_t* HG, int item, LAS unsigned char* buf, int wave, int lane) {
  const int t0 = item * 32, s0 = t0 & 4095;
#pragma unroll
  for (int j = 0; j < 8; ++j) {
    const int r = wave + 8 * j;
    if (r < 62) {
      if (s0 - 30 + r >= 0)
        __builtin_amdgcn_global_load_lds((const unsigned*)(HG + (size_t)(t0 - 30 + r) * 512 + lane * 8), (LAS unsigned*)(buf + r * 1024), 16, 0, 0);
      else
        *(LAS u32x4*)(buf + r * 1024 + lane * 16) = (u32x4){0u, 0u, 0u, 0u};
    }
  }
}
struct ConvW { f32x2 wv[31]; float2 cb, lg, lb; };
__device__ __forceinline__ void conv_compute(const Params& p, int item, const char* smem, const ConvW& W, int tid512) {
  bf16_t* MIX = (bf16_t*)(p.ws + WS_MIX);
  const int half = tid512 >> 8, tid = tid512 & 255, lane = tid & 63, wave = tid >> 6;
  const int t0 = item * 32;
  float* red = (float*)(smem + 62 * 1024) + half * 128;
  const bool b5 = lane & 32, b4 = lane & 16, b3 = lane & 8, b2 = lane & 4;
#pragma unroll 1
  for (int rd = 0; rd < 2; ++rd) {
    const int tb = 16 * half + 8 * rd;
    f32x2 xv[38];
#pragma unroll
    for (int r = 0; r < 38; ++r) {
      const unsigned v = *(const unsigned*)(smem + (tb + r) * 1024 + tid * 4);
      xv[r] = (f32x2){bflo(v), bfhi(v)};
    }
    float a0[8], a1[8], st[16];
#pragma unroll
    for (int k = 0; k < 8; ++k) {
      f32x2 u = {W.cb.x, W.cb.y};
#pragma unroll
      for (int j = 0; j < 31; ++j) u = __builtin_elementwise_fma(W.wv[j], xv[k + j], u);
      a0[k] = u.x; a1[k] = u.y;
      st[k] = u.x + u.y;
      st[8 + k] = u.x * u.x + u.y * u.y;
    }
    float r8[8], r4[4], r2[2], r1;
#pragma unroll
    for (int i = 0; i < 8; ++i) { const float keep = b5 ? st[8 + i] : st[i], send = b5 ? st[i] : st[8 + i]; r8[i] = keep + __shfl_xor(send, 32); }
#pragma unroll
    for (int i = 0; i < 4; ++i) { const float keep = b4 ? r8[4 + i] : r8[i], send = b4 ? r8[i] : r8[4 + i]; r4[i] = keep + __shfl_xor(send, 16); }
#pragma unroll
    for (int i = 0; i < 2; ++i) { const float keep = b3 ? r4[2 + i] : r4[i], send = b3 ? r4[i] : r4[2 + i]; r2[i] = keep + __shfl_xor(send, 8); }
    { const float keep = b2 ? r2[1] : r2[0], send = b2 ? r2[0] : r2[1]; r1 = keep + __shfl_xor(send, 4); }
    r1 += __shfl_xor(r1, 2);
    r1 += __shfl_xor(r1, 1);
    float* rr = red + rd * 64;
    if ((lane & 3) == 0) rr[wave * 16 + (lane >> 2)] = r1;
    __syncthreads();
#pragma unroll
    for (int k = 0; k < 8; ++k) {
      const float S1 = (rr[k] + rr[16 + k]) + (rr[32 + k] + rr[48 + k]);
      const float S2 = (rr[8 + k] + rr[24 + k]) + (rr[40 + k] + rr[56 + k]);
      const float mu = S1 * (1.f / 512.f);
      const float var = fmaxf(S2 * (1.f / 512.f) - mu * mu, 0.f);
      const float rstd = rsqrtf(var + EPS);
      const float y0 = (a0[k] - mu) * rstd * W.lg.x + W.lb.x, y1 = (a1[k] - mu) * rstd * W.lg.y + W.lb.y;
      const float z0 = y0 / (1.f + __expf(-y0)), z1 = y1 / (1.f + __expf(-y1));
      *(unsigned*)(MIX + (size_t)(t0 + tb + k) * 1024 + 512 + 2 * tid) = pk2(z0, z1);
    }
  }
}
__device__ void conv_items(const Params& p, char* smem) {
  const bf16_t* HG = (const bf16_t*)(p.ws + WS_HG);
  const int tid512 = otid(), tid = tid512 & 255, lane = tid512 & 63;
  const int wave = __builtin_amdgcn_readfirstlane(tid512 >> 6);
  const int vb = vblock(), G = gridDim.x;
  ConvW W;
#pragma unroll
  for (int j = 0; j < 31; ++j) {
    const float2 w = *(const float2*)(p.conv_w + j * 512 + 2 * tid);
    W.wv[j] = (f32x2){w.x, w.y};
  }
  W.cb = *(const float2*)(p.conv_b + 2 * tid);
  W.lg = *(const float2*)(p.conv_ln_g + 2 * tid);
  W.lb = *(const float2*)(p.conv_ln_b + 2 * tid);
  int b = 0;
  if (vb < 1024) conv_stage(HG, vb, (LAS unsigned char*)smem, wave, lane);
  for (int item = vb; item < 1024; item += G, b ^= 1) {
    asm volatile("s_waitcnt vmcnt(0) lgkmcnt(0)" ::: "memory");
    __syncthreads();
    if (item + G < 1024) conv_stage(HG, item + G, (LAS unsigned char*)smem + (b ^ 1) * 65536, wave, lane);
    conv_compute(p, item, smem + b * 65536, W, tid512);
  }
  __syncthreads();
}

struct AttnKV { bf16x8 k[4]; bf16x8 v[2][2]; };
__device__ __forceinline__ void attn_load(const bf16_t* Km, const bf16_t* Vt, int bh, int kb, int tok, int hf, AttnKV& f) {
  const int kc = kb < 0 ? 0 : kb;
  const bf16_t* kp = Km + ((size_t)bh * 4096 + kc * 32 + tok) * 64 + 8 * hf;
#pragma unroll
  for (int ks = 0; ks < 4; ++ks) f.k[ks] = *(const bf16x8*)(kp + ks * 16);
  const bf16_t* vp = Vt + (((size_t)bh * 128 + kc) * 64 + tok) * 32 + hf * 8;
#pragma unroll
  for (int m = 0; m < 2; ++m)
#pragma unroll
    for (int s = 0; s < 2; ++s) f.v[m][s] = *(const bf16x8*)(vp + m * 1024 + s * 16);
}
__device__ __forceinline__ bool attn_block(const AttnKV& f, const bf16x8 (&qf)[4], bool diag, int tok, int hf, float& c, f32x16& o0, f32x16& o1) {
  f32x16 sc;
#pragma unroll
  for (int i = 0; i < 16; ++i) sc[i] = 0.f;
#pragma unroll
  for (int ks = 0; ks < 4; ++ks) sc = mfma32(f.k[ks], qf[ks], sc);
  float lk[16], zs[16];
#pragma unroll
  for (int i = 0; i < 16; ++i) {
    const float zl = sc[i];
    const float e = __builtin_amdgcn_exp2f(zl);
    const float sp = __builtin_amdgcn_logf(1.f + e);
    const bool valid = !diag || ((i & 3) + 8 * (i >> 2) + 4 * hf < tok);
    lk[i] = valid ? -sp : 0.f;
    zs[i] = valid ? zl - sp : -1e30f;
  }
  float Tg[4], Pg[4];
#pragma unroll
  for (int g = 0; g < 4; ++g) {
    Tg[g] = (lk[4 * g] + lk[4 * g + 1]) + (lk[4 * g + 2] + lk[4 * g + 3]);
    Pg[g] = __shfl_xor(Tg[g], 32);
  }
  float base[4];
  float run = 0.f;
#pragma unroll
  for (int g = 3; g >= 0; --g) {
    base[g] = c + run + (hf == 0 ? Pg[g] : 0.f);
    run += Tg[g] + Pg[g];
  }
  float pr[16];
#pragma unroll
  for (int g = 0; g < 4; ++g) {
    float l = base[g];
#pragma unroll
    for (int r = 3; r >= 0; --r) {
      pr[4 * g + r] = __builtin_amdgcn_exp2f(zs[4 * g + r] + l);
      l += lk[4 * g + r];
    }
  }
  c += run;
  bf16x8 pf[2];
#pragma unroll
  for (int s = 0; s < 2; ++s)
#pragma unroll
    for (int j = 0; j < 8; ++j) pf[s][j] = (__bf16)pr[8 * s + j];
#pragma unroll
  for (int s = 0; s < 2; ++s) {
    o0 = mfma32(f.v[0][s], pf[s], o0);
    o1 = mfma32(f.v[1][s], pf[s], o1);
  }
  return __all(c < -150.f);
}
__device__ void attn_tile(const Params& p, int item, int it, int lane, int wave, char* smem) {
  unsigned char* ws = p.ws;
  const bf16_t* Qm = (const bf16_t*)(ws + WS_Q);
  const bf16_t* Km = (const bf16_t*)(ws + WS_K);
  const bf16_t* Vt = (const bf16_t*)(ws + WS_VT);
  bf16_t* MIX = (bf16_t*)(ws + WS_MIX);
  const int qt = item & 127, bh = (item >> 7) * 8 + wave;
  const int tok = lane & 31, hf = lane >> 5;
  bf16x8 qf[4];
  {
    const bf16_t* qp = Qm + ((size_t)bh * 4096 + qt * 32 + tok) * 64 + 8 * hf;
#pragma unroll
    for (int ks = 0; ks < 4; ++ks) qf[ks] = *(const bf16x8*)(qp + ks * 16);
  }
  f32x16 o0, o1;
#pragma unroll
  for (int i = 0; i < 16; ++i) { o0[i] = 0.f; o1[i] = 0.f; }
  float c = 0.f;
  AttnKV fa, fb;
  attn_load(Km, Vt, bh, qt, tok, hf, fa);
  {
    unsigned z = __builtin_bit_cast(u32x4, fa.v[1][1]).w | __builtin_bit_cast(u32x4, fa.k[3]).w | __builtin_bit_cast(u32x4, qf[3]).w;
    asm volatile("" ::"v"(z));
  }
  for (int kb = qt;; kb -= 2) {
    attn_load(Km, Vt, bh, kb - 1, tok, hf, fb);
    __builtin_amdgcn_sched_barrier(0);
    if (attn_block(fa, qf, kb == qt, tok, hf, c, o0, o1) || kb == 0) break;
    attn_load(Km, Vt, bh, kb - 2, tok, hf, fa);
    __builtin_amdgcn_sched_barrier(0);
    if (attn_block(fb, qf, false, tok, hf, c, o0, o1) || kb == 1) break;
  }
  float ssq = 0.f;
#pragma unroll
  for (int i = 0; i < 16; ++i) ssq += o0[i] * o0[i] + o1[i] * o1[i];
  ssq += __shfl_xor(ssq, 32);
  float* xch = (float*)(smem + 100 * 1024) + (it & 1) * 256;
  if (hf == 0) xch[wave * 32 + tok] = ssq;
  __syncthreads();
  float tot = 0.f;
#pragma unroll
  for (int w = 0; w < NWAVES; ++w) tot += xch[w * 32 + tok];
  const float rs = rsqrtf(tot * (1.f / 512.f) + EPS);
  const int t = (bh >> 3) * 4096 + qt * 32 + tok, hh = bh & 7;
  bf16_t* dst = MIX + (size_t)t * 1024 + hh * 64 + 4 * hf;
#pragma unroll
  for (int g = 0; g < 4; ++g) {
    *(u32x2*)(dst + 8 * g) = (u32x2){pk2(o0[4 * g] * rs, o0[4 * g + 1] * rs), pk2(o0[4 * g + 2] * rs, o0[4 * g + 3] * rs)};
    *(u32x2*)(dst + 32 + 8 * g) = (u32x2){pk2(o1[4 * g] * rs, o1[4 * g + 1] * rs), pk2(o1[4 * g + 2] * rs, o1[4 * g + 3] * rs)};
  }
}

__device__ void phase_mix(const Params& p, char* smem) {
  static_assert(NWAVES == 8, "one wave per attention head");
  const int vb = vblock(), G = gridDim.x;
  if (blockIdx.x & 1) prep_tables(p);
  conv_items(p, smem);
  const int tidm = otid();
  const int lane = tidm & 63, wave = tidm >> 6;
  int it = 0;
  for (int item = vb; item < 1024; item += G, ++it) attn_tile(p, item, it, lane, wave, smem);
  if (!(blockIdx.x & 1)) prep_tables(p);
}
__device__ __forceinline__ unsigned f2key(float f, unsigned n) {
  const unsigned u = (__float_as_uint(f) & ~0x7Fu) | n;
  return u ^ ((unsigned)((int)u >> 31) | 0x80000000u);
}
__device__ __forceinline__ unsigned f2key_raw(float f) {
  const unsigned u = __float_as_uint(f);
  return u ^ ((unsigned)((int)u >> 31) | 0x80000000u);
}
__device__ __forceinline__ unsigned key2u(unsigned k) { return k ^ ((k >> 31) ? 0x80000000u : 0xFFFFFFFFu); }

template <int N>
__device__ __forceinline__ void bitonic_sort_desc(unsigned (&v)[N]) {
#pragma unroll
  for (int k = 2; k <= N; k <<= 1) {
#pragma unroll
    for (int j = k >> 1; j > 0; j >>= 1) {
#pragma unroll
      for (int i = 0; i < N; ++i) {
        const int l = i ^ j;
        if (l > i) {
          const bool desc = ((i & k) == 0);
          const unsigned mx = max(v[i], v[l]), mn = min(v[i], v[l]);
          v[i] = desc ? mx : mn;
          v[l] = desc ? mn : mx;
        }
      }
    }
  }
}
template <int N>
__device__ __forceinline__ void bitonic_merge_desc(unsigned (&v)[N]) {
#pragma unroll
  for (int j = N >> 1; j > 0; j >>= 1) {
#pragma unroll
    for (int i = 0; i < N; ++i) {
      const int l = i ^ j;
      if (l > i) {
        const unsigned mx = max(v[i], v[l]), mn = min(v[i], v[l]);
        v[i] = mx;
        v[l] = mn;
      }
    }
  }
}
__device__ __forceinline__ void merge_top16(unsigned (&a)[16], const unsigned (&b)[16]) {
#pragma unroll
  for (int i = 0; i < 16; ++i) a[i] = max(a[i], b[15 - i]);
  bitonic_merge_desc<16>(a);
}
#define CEP(ka, pa, kb, pb, desc)                                  \
  {                                                                \
    const bool sw_ = (desc) ? ((kb) > (ka)) : ((kb) < (ka));       \
    const unsigned tk_ = sw_ ? (kb) : (ka), tl_ = sw_ ? (ka) : (kb); \
    const unsigned tp_ = sw_ ? (pb) : (pa), tq_ = sw_ ? (pa) : (pb); \
    ka = tk_; kb = tl_; pa = tp_; pb = tq_;                        \
  }
template <int N>
__device__ __forceinline__ void bitonic_sort_desc_p(unsigned (&v)[N], unsigned (&pl)[N]) {
#pragma unroll
  for (int k = 2; k <= N; k <<= 1) {
#pragma unroll
    for (int j = k >> 1; j > 0; j >>= 1) {
#pragma unroll
      for (int i = 0; i < N; ++i) {
        const int l = i ^ j;
        if (l > i) {
          const bool desc = ((i & k) == 0);
          CEP(v[i], pl[i], v[l], pl[l], desc);
        }
      }
    }
  }
}
template <int N>
__device__ __forceinline__ void bitonic_merge_desc_p(unsigned (&v)[N], unsigned (&pl)[N]) {
#pragma unroll
  for (int j = N >> 1; j > 0; j >>= 1) {
#pragma unroll
    for (int i = 0; i < N; ++i) {
      const int l = i ^ j;
      if (l > i) { CEP(v[i], pl[i], v[l], pl[l], true); }
    }
  }
}
__device__ __forceinline__ void merge_top16_p(unsigned (&a)[16], unsigned (&pa)[16], const unsigned (&b)[16], const unsigned (&pb)[16]) {
#pragma unroll
  for (int i = 0; i < 16; ++i) {
    const bool s = b[15 - i] > a[i];
    a[i] = s ? b[15 - i] : a[i];
    pa[i] = s ? pb[15 - i] : pa[i];
  }
  bitonic_merge_desc_p<16>(a, pa);
}

constexpr int KROW = 144;
__device__ __forceinline__ void subkey_top16(const LAS unsigned char* Kl, const bf16_t* __restrict__ qrow, int lane, unsigned (&top)[16]) {
  const int tok = lane & 31, hf = lane >> 5;
  f32x16 acc[4];
#pragma unroll
  for (int m = 0; m < 4; ++m)
#pragma unroll
    for (int i = 0; i < 16; ++i) acc[m][i] = 0.f;
  bf16x8 bq[4];
#pragma unroll
  for (int ks = 0; ks < 4; ++ks) bq[ks] = *(const bf16x8*)(qrow + ks * 16 + 8 * hf);
#pragma unroll 1
  for (int ks = 0; ks < 4; ++ks) {
#pragma unroll
    for (int m = 0; m < 4; ++m) {
      const bf16x8 ak = *(const LAS bf16x8*)(Kl + (m * 32 + tok) * KROW + ks * 32 + hf * 16);
      acc[m] = mfma32(ak, ks == 0 ? bq[0] : ks == 1 ? bq[1] : ks == 2 ? bq[2] : bq[3], acc[m]);
    }
  }
  unsigned g[4][16];
#pragma unroll
  for (int m = 0; m < 4; ++m) {
#pragma unroll
    for (int i = 0; i < 16; ++i) g[m][i] = f2key(acc[m][i], (unsigned)(m * 32 + (i & 3) + 8 * (i >> 2) + 4 * hf));
    bitonic_sort_desc<16>(g[m]);
  }
  merge_top16(g[0], g[1]);
  merge_top16(g[2], g[3]);
  merge_top16(g[0], g[2]);
  unsigned o[16];
#pragma unroll
  for (int i = 0; i < 16; ++i) o[i] = __shfl_xor(g[0][i], 32);
  merge_top16(g[0], o);
#pragma unroll
  for (int i = 0; i < 16; ++i) top[i] = g[0][i];
}

__device__ void phase_route(const Params& p, char* smem) {
  unsigned char* ws = p.ws;
  const bf16_t* K1 = (const bf16_t*)(ws + WS_K1);
  const bf16_t* K2 = (const bf16_t*)(ws + WS_K2);
  const bf16_t* QH = (const bf16_t*)(ws + WS_QH);
  const bf16_t* HB = (const bf16_t*)(ws + WS_HB);
  unsigned char* XN8 = ws + WS_XN8;
  const float* SSQ2 = (const float*)(ws + WS_SSQ2);
  unsigned* PIDX = (unsigned*)(ws + WS_PIDX);
  float* PG = (float*)(ws + WS_PG);
  const int tidr = otid();
  const int lane = tidr & 63, wave = tidr >> 6, gw = vblock() * NWAVES + wave, nw = gridDim.x * NWAVES;
  const int G = gridDim.x, nh = (G % 8 == 0) ? 8 : 1;
  LAS unsigned char* K1l = (LAS unsigned char*)smem;
  LAS unsigned char* K2l = K1l + 128 * KROW;
  for (int hd = blockIdx.x % nh; hd < 8; hd += nh) {
    for (int idx = tidr; idx < 2048; idx += NTHREADS) {
      const int tb = idx >> 10, row = (idx >> 3) & 127, ch = idx & 7;
      const u32x4 v = *(const u32x4*)((tb ? K2 : K1) + hd * 8192 + row * 64 + ch * 8);
      *(LAS u32x4*)((tb ? K2l : K1l) + row * KROW + ch * 16) = v;
    }
    __syncthreads();
    for (int tile = (blockIdx.x / nh) * NWAVES + wave; tile < T / 32; tile += (G / nh) * NWAVES) {
      const int t0 = tile * 32;
      const int tok = lane & 31, hf = lane >> 5;
      const bf16_t* qrow = QH + (size_t)(t0 + tok) * 1024 + hd * 128;
      unsigned top1[16], top2[16];
      subkey_top16(K1l, qrow, lane, top1);
      subkey_top16(K2l, qrow + 64, lane, top2);
      float fa[16], fb[16];
      unsigned ia[16], ib[16];
#pragma unroll
      for (int i = 0; i < 16; ++i) {
        const unsigned ua = key2u(hf ? top2[i] : top1[i]), ub = key2u(hf ? top1[i] : top2[i]);
        fa[i] = __uint_as_float(ua); ia[i] = ua & 0x7Fu;
        fb[i] = __uint_as_float(ub); ib[i] = ub & 0x7Fu;
      }
      unsigned ck[32];
      {
        int n = 0;
#pragma unroll
        for (int i = 0; i < 4; ++i) {
#pragma unroll
          for (int j = i; j < 16; ++j) {
            if ((i + 1) * (j + 1) <= 16) {
              unsigned key = (f2key_raw(fa[i] + fb[j]) & ~0x3FFFu) | (hf ? ((ib[j] << 7) | ia[i]) : ((ia[i] << 7) | ib[j]));
              if (i == j && hf) key = 0u;
              ck[n] = key;
              ++n;
            }
          }
        }
#pragma unroll
        for (; n < 32; ++n) ck[n] = 0u;
      }
      unsigned k0[16], k1[16];
#pragma unroll
      for (int i = 0; i < 16; ++i) { k0[i] = ck[i]; k1[i] = ck[16 + i]; }
      bitonic_sort_desc<16>(k0);
      bitonic_sort_desc<16>(k1);
      merge_top16(k0, k1);
#pragma unroll
      for (int i = 0; i < 16; ++i) k1[i] = __shfl_xor(k0[i], 32);
      merge_top16(k0, k1);
      float sv[16], sum = 0.f;
      const float mx = __uint_as_float(key2u(k0[0] & ~0x3FFFu));
#pragma unroll
      for (int i = 0; i < 16; ++i) {
        sv[i] = __builtin_amdgcn_exp2f((__uint_as_float(key2u(k0[i] & ~0x3FFFu)) - mx) * LOG2E);
        sum += sv[i];
      }
      const float inv = 1.f / sum;
      const size_t po = ((size_t)(t0 + tok) * 8 + hd) * 16;
      if (hf == 0) {
#pragma unroll
        for (int q = 0; q < 4; ++q) *(u32x4*)(PIDX + po + 4 * q) = (u32x4){k0[4 * q] & 0x3FFFu, k0[4 * q + 1] & 0x3FFFu, k0[4 * q + 2] & 0x3FFFu, k0[4 * q + 3] & 0x3FFFu};
      } else {
#pragma unroll
        for (int q = 0; q < 4; ++q) *(f32x4*)(PG + po + 4 * q) = (f32x4){sv[4 * q] * inv, sv[4 * q + 1] * inv, sv[4 * q + 2] * inv, sv[4 * q + 3] * inv};
      }
    }
    __syncthreads();
  }
}

typedef int i32x8 __attribute__((ext_vector_type(8)));
__device__ __forceinline__ f32x4 mfma_fp4_fp8(u32x4 a, u32x4 b0, u32x4 b1, f32x4 c) {
  const i32x8 A = {(int)a.x, (int)a.y, (int)a.z, (int)a.w, 0, 0, 0, 0};
  const i32x8 B = {(int)b0.x, (int)b0.y, (int)b0.z, (int)b0.w, (int)b1.x, (int)b1.y, (int)b1.z, (int)b1.w};
  return __builtin_amdgcn_mfma_scale_f32_16x16x128_f8f6f4(A, B, c, 4, 0, 0, 0x7F7F7F7F, 0, 0x7F7F7F7F);
}
struct PeCtx {
  const unsigned char* U8; const float2* USV; LAS float* glist;
  LAS unsigned* list; int lane, r, g, s, n, t0;
};
__device__ __forceinline__ void pe_rows(const PeCtx& c, int ci, u32x4 (&a)[8]) {
  const int idx = ci * 16 + (c.lane >> 2);
  const unsigned ent = c.list[idx & 2047];
  const unsigned e = (idx < c.n) ? ((ent >> 7) & 16383u) : (unsigned)(c.s << 11);
  const unsigned char* rp = c.U8 + (size_t)e * 512 + (c.lane & 3) * 16;
#pragma unroll
  for (int ks = 0; ks < 8; ++ks) a[ks] = *(const u32x4*)(rp + ks * 64);
}
__device__ __forceinline__ void pe_fix(const PeCtx& c, u32x4 (&a)[8]) {
  const int src = 4 * c.r + c.g;
#pragma unroll
  for (int ks = 0; ks < 8; ++ks) {
    a[ks].x = (unsigned)__shfl((int)a[ks].x, src); a[ks].y = (unsigned)__shfl((int)a[ks].y, src);
    a[ks].z = (unsigned)__shfl((int)a[ks].z, src); a[ks].w = (unsigned)__shfl((int)a[ks].w, src);
  }
}
__device__ __forceinline__ void pe_chunk(const PeCtx& c, int ci, u32x4 (&a)[8], u32x4 (&anext)[8], const u32x4 (&bq)[16]) {
  const int idx = ci * 16 + c.r;
  const unsigned ent = c.list[idx & 2047];
  const bool fin = (c.lane < 16) && (idx < c.n);
  const unsigned e = (ent >> 7) & 16383u, col = (ent >> 21) & 15u;
  const float2 usv = c.USV[fin ? e : 0u];
  const float gt = c.glist[idx & 2047], us = usv.x, vs = usv.y;
  __builtin_amdgcn_sched_barrier(0);
  pe_rows(c, ci + 1, anext);
  __builtin_amdgcn_sched_barrier(0);
  pe_fix(c, a);
  f32x4 acc = {0.f, 0.f, 0.f, 0.f};
#pragma unroll
  for (int ks = 0; ks < 8; ++ks) acc = mfma_fp4_fp8(a[ks], bq[2 * ks], bq[2 * ks + 1], acc);
  const int src = ((c.r >> 2) << 4) | (int)col;
  const float v0 = __shfl(acc[0], src), v1 = __shfl(acc[1], src), v2 = __shfl(acc[2], src), v3 = __shfl(acc[3], src);
  float d = ((c.r & 3) == 0) ? v0 : ((c.r & 3) == 1) ? v1 : ((c.r & 3) == 2) ? v2 : v3;
  float gt_ = gt, us_ = us, vs_ = vs;
  asm volatile("" : "+v"(d), "+v"(gt_), "+v"(us_), "+v"(vs_));
  {
    const float act = d * us_ * (1.f / 16.f);
    const float w = gt_ * 0.5f * act * (1.f + erff(act * 0.70710678118654752f)) * vs_;
    if (fin) c.glist[idx & 2047] = w;
  }
}
#define PFV_LOAD(R, ev, k0)                                                                               \
  {                                                                                                       \
    _Pragma("unroll") for (int i_ = 0; i_ < 8; ++i_) {                                                    \
      const unsigned e_ = (unsigned)__builtin_amdgcn_ds_bpermute(bsel + 4 * ((k0) + 2 * i_), (int)(ev)); \
      R[i_] = *(const u32x4*)(V4 + (e_ << 9));                                                            \
    }                                                                                                     \
  }
#define PFV_FMA(dw, b, a) acc[a] = __builtin_elementwise_fma(__builtin_amdgcn_cvt_scalef32_pk_f32_fp4(dw, 1.0f, b), w2_, acc[a]);
#define PFV_ACC(R, wv, k0)                                                                                \
  {                                                                                                       \
    _Pragma("unroll") for (int i_ = 0; i_ < 8; ++i_) {                                                    \
      const float ws_ = __builtin_bit_cast(float, __builtin_amdgcn_ds_bpermute(bsel + 4 * ((k0) + 2 * i_), __builtin_bit_cast(int, (wv)))); \
      const f32x2 w2_ = {ws_, ws_};                                                                       \
      PFV_FMA(R[i_].x, 0, 0)  PFV_FMA(R[i_].x, 1, 1)  PFV_FMA(R[i_].x, 2, 2)  PFV_FMA(R[i_].x, 3, 3)      \
      PFV_FMA(R[i_].y, 0, 4)  PFV_FMA(R[i_].y, 1, 5)  PFV_FMA(R[i_].y, 2, 6)  PFV_FMA(R[i_].y, 3, 7)      \
      PFV_FMA(R[i_].z, 0, 8)  PFV_FMA(R[i_].z, 1, 9)  PFV_FMA(R[i_].z, 2, 10) PFV_FMA(R[i_].z, 3, 11)     \
      PFV_FMA(R[i_].w, 0, 12) PFV_FMA(R[i_].w, 1, 13) PFV_FMA(R[i_].w, 2, 14) PFV_FMA(R[i_].w, 3, 15)     \
    }                                                                                                     \
  }
__device__ void phase_peer_u(const Params& p, char* smem) {
  unsigned char* ws = p.ws;
  PeCtx c;
  c.U8 = ws + WS_U8; c.USV = (const float2*)(ws + WS_USV);
  const float* PG = (const float*)(ws + WS_PG);
  const bf16_t* HB = (const bf16_t*)(ws + WS_HB);
  const float* SSQ2 = (const float*)(ws + WS_SSQ2);
  const unsigned* PIDX = (const unsigned*)(ws + WS_PIDX);
  const int tidu = otid();
  const int lane = tidu & 63, wave = tidu >> 6;
  c.lane = lane; c.r = lane & 15; c.g = lane >> 4;
  c.list = (LAS unsigned*)(smem + wave * 8192);
  c.glist = (LAS float*)(smem + 65536 + wave * 8192);
  const bool hi = lane >= 32;
  const int bsel = hi ? 4 : 0;
  const unsigned char* V4 = ws + WS_V8 + (lane & 31) * 16;
  c.s = 0;
  {
    for (int grp = vblock() * NWAVES + wave; grp < T / 16; grp += gridDim.x * NWAVES) {
      const int t0 = grp * 16;
      c.t0 = t0;
      u32x4 bq[16];
      {
        const bf16_t* hp = HB + (size_t)(t0 + c.r) * 1024 + c.g * 16;
        const float rq = rsqrtf(SSQ2[t0 + c.r] * (1.f / 1024.f) + EPS) * 16.f;
#pragma unroll
        for (int kh = 0; kh < 16; ++kh) {
          const u32x4 h0 = *(const u32x4*)(hp + (kh >> 1) * 128 + (kh & 1) * 64), h1 = *(const u32x4*)(hp + (kh >> 1) * 128 + (kh & 1) * 64 + 8);
          u32x4 q;
#pragma unroll
          for (int i = 0; i < 4; ++i) {
            const unsigned lo = (i < 2) ? h0[2 * i] : h1[2 * i - 4], hi2 = (i < 2) ? h0[2 * i + 1] : h1[2 * i - 3];
            int w = 0;
            w = __builtin_amdgcn_cvt_pk_fp8_f32(bflo(lo) * rq, bfhi(lo) * rq, w, false);
            w = __builtin_amdgcn_cvt_pk_fp8_f32(bflo(hi2) * rq, bfhi(hi2) * rq, w, true);
            q[i] = (unsigned)w;
          }
          bq[kh] = q;
        }
      }
      const int n = 2048;
#pragma unroll
      for (int q = 0; q < 8; ++q) {
        const u32x4 idv = *(const u32x4*)(PIDX + (size_t)t0 * 128 + q * 256 + lane * 4);
        const f32x4 gv = *(const f32x4*)(PG + (size_t)t0 * 128 + q * 256 + lane * 4);
        const unsigned hi = (unsigned)(2 * q + (lane >> 5)) << 21, sl = (unsigned)((lane & 31) * 4);
        *(LAS u32x4*)(c.list + q * 256 + lane * 4) = (u32x4){hi | (idv.x << 7) | sl, hi | (idv.y << 7) | (sl + 1), hi | (idv.z << 7) | (sl + 2), hi | (idv.w << 7) | (sl + 3)};
        *(LAS f32x4*)(c.glist + q * 256 + lane * 4) = gv;
      }
      asm volatile("s_waitcnt lgkmcnt(0)" ::: "memory");
      c.n = n;
      const int nch = (n + 15) >> 4;
      u32x4 a0[8], a1[8];
      pe_rows(c, 0, a0);
      {
        unsigned z = 0u;
#pragma unroll
        for (int ks = 0; ks < 8; ++ks) z |= a0[ks].w;
        asm volatile("" ::"v"(z));
      }
      if (nch > 0) {
        for (int ci = 0;; ci += 2) {
          pe_chunk(c, ci, a0, a1, bq);
          if (ci + 1 >= nch) break;
          pe_chunk(c, ci + 1, a1, a0, bq);
          if (ci + 2 >= nch) break;
        }
      }
      asm volatile("s_waitcnt lgkmcnt(0)" ::: "memory");
      {
        unsigned e0 = (c.list[lane] >> 7) & 16383u, e1 = (c.list[64 + lane] >> 7) & 16383u;
        float w0 = c.glist[lane], w1 = c.glist[64 + lane];
        u32x4 RA[8], RB[8];
        PFV_LOAD(RA, e0, 0)
        {
          unsigned z = 0u;
#pragma unroll
          for (int i = 0; i < 8; ++i) z |= RA[i].w;
          asm volatile("" ::"v"(z));
        }
        for (int tk = 0; tk < 16; ++tk) {
          const int tn = tk < 15 ? tk + 1 : tk;
          const unsigned e0n = (c.list[tn * 128 + lane] >> 7) & 16383u, e1n = (c.list[tn * 128 + 64 + lane] >> 7) & 16383u;
          const float w0n = c.glist[tn * 128 + lane], w1n = c.glist[tn * 128 + 64 + lane];
          const size_t oo = (size_t)(t0 + tk) * 1024 + (lane & 31) * 32 + (hi ? 16 : 0);
          const u32x4 hb0 = *(const u32x4*)(HB + oo), hb1 = *(const u32x4*)(HB + oo + 8);
          f32x2 acc[16];
#pragma unroll
          for (int k = 0; k < 16; ++k) acc[k] = (f32x2){0.f, 0.f};
          __builtin_amdgcn_sched_barrier(0);
          PFV_LOAD(RB, e0, 16)  __builtin_amdgcn_sched_barrier(0);  PFV_ACC(RA, w0, 0)
          PFV_LOAD(RA, e0, 32)  __builtin_amdgcn_sched_barrier(0);  PFV_ACC(RB, w0, 16)
          PFV_LOAD(RB, e0, 48)  __builtin_amdgcn_sched_barrier(0);  PFV_ACC(RA, w0, 32)
          PFV_LOAD(RA, e1, 0)   __builtin_amdgcn_sched_barrier(0);  PFV_ACC(RB, w0, 48)
          PFV_LOAD(RB, e1, 16)  __builtin_amdgcn_sched_barrier(0);  PFV_ACC(RA, w1, 0)
          PFV_LOAD(RA, e1, 32)  __builtin_amdgcn_sched_barrier(0);  PFV_ACC(RB, w1, 16)
          PFV_LOAD(RB, e1, 48)  __builtin_amdgcn_sched_barrier(0);  PFV_ACC(RA, w1, 32)
          PFV_LOAD(RA, e0n, 0)  __builtin_amdgcn_sched_barrier(0);  PFV_ACC(RB, w1, 48)
          f32x2 r[8];
#pragma unroll
          for (int k = 0; k < 8; ++k) {
            const f32x2 keep = hi ? acc[8 + k] : acc[k], send = hi ? acc[k] : acc[8 + k];
            r[k] = keep + (f32x2){__shfl_xor(send.x, 32), __shfl_xor(send.y, 32)};
          }
          float* o = p.out + oo;
          *(f32x4*)(o)      = (f32x4){bflo(hb0.x) + r[0].x, bfhi(hb0.x) + r[0].y, bflo(hb0.y) + r[1].x, bfhi(hb0.y) + r[1].y};
          *(f32x4*)(o + 4)  = (f32x4){bflo(hb0.z) + r[2].x, bfhi(hb0.z) + r[2].y, bflo(hb0.w) + r[3].x, bfhi(hb0.w) + r[3].y};
          *(f32x4*)(o + 8)  = (f32x4){bflo(hb1.x) + r[4].x, bfhi(hb1.x) + r[4].y, bflo(hb1.y) + r[5].x, bfhi(hb1.y) + r[5].y};
          *(f32x4*)(o + 12) = (f32x4){bflo(hb1.z) + r[6].x, bfhi(hb1.z) + r[6].y, bflo(hb1.w) + r[7].x, bfhi(hb1.w) + r[7].y};
          e0 = e0n; e1 = e1n; w0 = w0n; w1 = w1n;
        }
      }
      asm volatile("" ::: "memory");
    }
  }
}
#undef PFV_LOAD
#undef PFV_FMA
#undef PFV_ACC


#define XB_TMO      128
#define XB_XCNT(j)  (256  + 64 * (j))
#define XB_XSUB(j)  (1280 + 64 * (j))
#define XB_XGEN(j)  (2304 + 64 * (j))
#define XB_TOP      3328
#define XB_TOPGEN   3392
#define XCD_BAR_WORDS 3456
#define XB_SPIN_CAP (1u << 22)
__device__ __forceinline__ unsigned xb_ld(unsigned* p)              { return __hip_atomic_load(p, __ATOMIC_RELAXED, __HIP_MEMORY_SCOPE_AGENT); }
__device__ __forceinline__ unsigned xb_add(unsigned* p, unsigned v) { return __hip_atomic_fetch_add(p, v, __ATOMIC_RELAXED, __HIP_MEMORY_SCOPE_AGENT); }
__device__ __forceinline__ unsigned xb_xcc_id() { return (unsigned)__builtin_amdgcn_s_getreg((3 << 11) | 20) & 0xFu; }
#define XB_SPIN(cond, bar) do { unsigned _sp = 0; while (cond) { __builtin_amdgcn_s_sleep(1); \
    if ((++_sp & 255u) == 0u) { if (xb_ld(&(bar)[XB_TMO])) break; if (_sp > XB_SPIN_CAP) { atomicAdd(&(bar)[XB_TMO], 1u); break; } } } } while (0)
struct XcdBarrier { unsigned* bar; unsigned x; volatile LAS unsigned* st; };
__device__ __forceinline__ XcdBarrier xcd_barrier_post(unsigned* bar, volatile LAS unsigned* st) {
    XcdBarrier b; b.bar = bar; b.x = xb_xcc_id(); b.st = st;
    if (threadIdx.x == 0) (void)xb_add(&bar[XB_XCNT(b.x)], 1u);
    return b;
}
__device__ __forceinline__ void xcd_barrier_complete(unsigned* bar, unsigned x, unsigned& nloc, unsigned& nx) {
    const unsigned G = gridDim.x * gridDim.y * gridDim.z;
    unsigned sum, cnt, mine, sp = 0u;
    for (;;) {
        sum = 0u; cnt = 0u; mine = 0u;
#pragma unroll
        for (unsigned j = 0; j < 16; ++j) { const unsigned c = xb_ld(&bar[XB_XCNT(j)]); sum += c; cnt += (c > 0u) ? 1u : 0u; mine = (j == x) ? c : mine; }
        if (sum == G) break;
        __builtin_amdgcn_s_sleep(1);
        if ((++sp & 255u) == 0u) { if (xb_ld(&bar[XB_TMO])) break; if (sp > XB_SPIN_CAP) { atomicAdd(&bar[XB_TMO], 1u); break; } }
    }
    nloc = mine > 0u ? mine : 1u; nx = cnt > 0u ? cnt : 1u;
}
__device__ __forceinline__ void xcd_barrier(const XcdBarrier& b) {
    asm volatile("s_waitcnt vmcnt(0)" ::: "memory");
    __syncthreads();
    if (threadIdx.x == 0) {
        unsigned* bar = b.bar;
        __builtin_amdgcn_s_waitcnt(0);
        unsigned nloc = b.st[0], nx = b.st[1];
        if (nloc == 0u) { xcd_barrier_complete(bar, b.x, nloc, nx); b.st[0] = nloc; b.st[1] = nx; }
        const unsigned old = xb_add(&bar[XB_XSUB(b.x)], 1u);
        const unsigned gen = old / nloc;
        if (old + 1u == (gen + 1u) * nloc) {
            __builtin_amdgcn_fence(__ATOMIC_RELEASE, "agent");
            asm volatile("s_waitcnt vmcnt(0)" ::: "memory");
            const unsigned og = xb_add(&bar[XB_TOP], 1u);
            const unsigned tg = og / nx;
            if (og + 1u == (tg + 1u) * nx) xb_add(&bar[XB_TOPGEN], 1u);
            else XB_SPIN(xb_ld(&bar[XB_TOPGEN]) == tg, bar);
            __builtin_amdgcn_fence(__ATOMIC_ACQUIRE, "agent");
            xb_add(&bar[XB_XGEN(b.x)], 1u);
            asm volatile("s_waitcnt vmcnt(0)" ::: "memory");
        } else {
            XB_SPIN(xb_ld(&bar[XB_XGEN(b.x)]) == gen, bar);
            __builtin_amdgcn_fence(__ATOMIC_ACQUIRE, "agent");
            asm volatile("s_waitcnt vmcnt(0)" ::: "memory");
        }
    }
    __syncthreads();
}

__global__ void __launch_bounds__(NTHREADS, 2) k_fused(Params p) {
  __shared__ __attribute__((aligned(16))) char smem[LDS_BYTES];
  if (threadIdx.x == 0) *(u32x4*)(smem + LDS_BAR) = (u32x4){0u, 0u, 0u, 0u};
  __syncthreads();
  const XcdBarrier bar = xcd_barrier_post((unsigned*)(p.ws + WS_CTL), (volatile LAS unsigned*)(smem + LDS_BAR));
#ifdef PROBE_PHASE
  unsigned long long ts[12];
#define STAMP(k) ts[k] = __builtin_amdgcn_s_memrealtime();
#else
#define STAMP(k)
#endif
  STAMP(0)
  phase_prep(p);
  xcd_barrier(bar);
  STAMP(1)
  phase_inproj(p, smem);
  xcd_barrier(bar);
  STAMP(2)
  phase_mix(p, smem);
  xcd_barrier(bar);
  STAMP(3)
  phase_outproj(p, smem);
  xcd_barrier(bar);
  STAMP(4)
  phase_qproj(p, smem);
  xcd_barrier(bar);
  STAMP(5)
  phase_route(p, smem);
  xcd_barrier(bar);
  STAMP(6)
  phase_peer_u(p, smem);
#ifdef PROBE_PHASE
  xcd_barrier(bar);
  STAMP(7)
  if (blockIdx.x == 0 && threadIdx.x == 0) {
    const float us = (float)(ts[PROBE_PHASE + 1] - ts[PROBE_PHASE]) * 0.01f;
    p.out[12345] += us * (1.f / PROBE_DIV);
  }
#endif
}

extern "C" void kernel_launch(void* const* d_in, const int* in_sizes, int n_in, void* d_out, int out_size, void* d_ws, size_t ws_size,
                              hipStream_t stream) {
  if (n_in != 17 || ws_size < WS_END) {
    fprintf(stderr, "kernel_launch: unexpected n_in %d / ws_size %zu\n", n_in, ws_size);
    return;
  }
  Params p{};
  p.x = (const float*)d_in[0]; p.norm_mix_g = (const float*)d_in[1]; p.w_in = (const float*)d_in[2]; p.q_norm_g = (const float*)d_in[3];
  p.k_norm_g = (const float*)d_in[4]; p.attn_out_g = (const float*)d_in[5]; p.conv_w = (const float*)d_in[6]; p.conv_b = (const float*)d_in[7];
  p.conv_ln_g = (const float*)d_in[8]; p.conv_ln_b = (const float*)d_in[9]; p.w_out = (const float*)d_in[10]; p.norm_ffn_g = (const float*)d_in[11];
  p.peer_wq = (const float*)d_in[12]; p.peer_k1 = (const float*)d_in[13]; p.peer_k2 = (const float*)d_in[14]; p.peer_u = (const float*)d_in[15];
  p.peer_v = (const float*)d_in[16];
  p.out = (float*)d_out;
  p.ws = (unsigned char*)d_ws;
  static int grid_blocks = 0;
  if (!grid_blocks) {
    int dev = 0, cus = 0, per_cu = 0;
    (void)hipGetDevice(&dev);
    (void)hipDeviceGetAttribute(&cus, hipDeviceAttributeMultiprocessorCount, dev);
    (void)hipOccupancyMaxActiveBlocksPerMultiprocessor(&per_cu, k_fused, NTHREADS, 0);
    if (per_cu > 1) per_cu = 1;
    if (per_cu < 1) per_cu = 1;
    grid_blocks = cus * per_cu;
  }
  (void)hipMemsetAsync((char*)d_ws + WS_CTL, 0, XCD_BAR_WORDS * 4, stream);
  hipLaunchKernelGGL(k_fused, dim3(grid_blocks), dim3(NTHREADS), 0, stream, p);
}
```

```cpp
#include <hip/hip_runtime.h>
#include <cstdio>

#define LAS __attribute__((address_space(3)))
typedef unsigned short bf16_t;
typedef __bf16 bf16x8 __attribute__((ext_vector_type(8)));
typedef __bf16 bf16x2 __attribute__((ext_vector_type(2)));
typedef float f32x4 __attribute__((ext_vector_type(4)));
typedef float f32x16 __attribute__((ext_vector_type(16)));
typedef unsigned u32x4 __attribute__((ext_vector_type(4)));
typedef unsigned u32x2 __attribute__((ext_vector_type(2)));
typedef float f32x2 __attribute__((ext_vector_type(2)));

constexpr int SEQ = 4096, T = 8 * SEQ, D = 1024, NIN = 2560;
constexpr float EPS = 1e-6f;
constexpr float LOG2E = 1.4426950408889634f;

constexpr size_t MiB = 1u << 20;
constexpr size_t WS_W1 = 0, WS_WV = 4 * MiB, WS_WOUT = 5 * MiB, WS_WQ = 7 * MiB, WS_K1 = 9 * MiB, WS_K2 = 9 * MiB + 131072, WS_SSQ = 10 * MiB;
constexpr size_t WS_CTL = 11 * MiB;
constexpr size_t WS_USV = 11 * MiB + 65536;
constexpr size_t WS_RS1 = 11 * MiB + 196608, WS_SSQ2 = 11 * MiB + 327680;
constexpr size_t WS_U8 = 12 * MiB, WS_V8 = 28 * MiB;
constexpr size_t WS_XB = 44 * MiB;
constexpr size_t WS_Q = 108 * MiB, WS_K = 140 * MiB, WS_VT = 172 * MiB, WS_HG = 204 * MiB, WS_MIX = 236 * MiB;
constexpr size_t WS_HB = 300 * MiB, WS_QH = 364 * MiB;
constexpr size_t WS_XN8 = 108 * MiB, WS_PIDX = 140 * MiB, WS_PG = 156 * MiB, WS_PW = 172 * MiB;
constexpr size_t WS_END = 428 * MiB;

struct Params {
  const float *x, *norm_mix_g, *w_in, *q_norm_g, *k_norm_g, *attn_out_g, *conv_w, *conv_b, *conv_ln_g, *conv_ln_b,
      *w_out, *norm_ffn_g, *peer_wq, *peer_k1, *peer_k2, *peer_u, *peer_v;
  float* out;
  unsigned char* ws;
};

constexpr int NTHREADS = 512, NWAVES = 8;
constexpr int LDS_STAGE = 131072, LDS_BAR = LDS_STAGE, LDS_BYTES = LDS_STAGE + 16;

__device__ __forceinline__ unsigned pk2(float lo, float hi) {
  bf16x2 v = {(__bf16)lo, (__bf16)hi};
  return __builtin_bit_cast(unsigned, v);
}
__device__ __forceinline__ float bflo(unsigned u) { return __uint_as_float(u << 16); }
__device__ __forceinline__ float bfhi(unsigned u) { return __uint_as_float(u & 0xffff0000u); }
__device__ __forceinline__ int otid() { int t = threadIdx.x; asm volatile("" : "+v"(t)); return t; }
__device__ __forceinline__ int vblock() {
  const int G = gridDim.x, b = blockIdx.x;
  return (G % 8 == 0) ? (b % 8) * (G / 8) + b / 8 : b;
}
__device__ __forceinline__ f32x16 mfma32(bf16x8 a, bf16x8 b, f32x16 c) { return __builtin_amdgcn_mfma_f32_32x32x16_bf16(a, b, c, 0, 0, 0); }

__device__ __forceinline__ int w1_src(int n) {
  if (n < 1024) {
    const int kind = n >> 9, rel = n & 511, pn = rel >> 8, P = rel & 255, bj = P >> 7, wc = (P >> 5) & 3, x = P & 31;
    return kind * 512 + (4 * pn + wc) * 64 + 32 * bj + x;
  }
  const int rel = n - 1024, pn = rel >> 8, P = rel & 255, bj = P >> 7, wc = (P >> 5) & 3, x = P & 31;
  return (bj ? 2048 : 1536) + 128 * pn + 32 * wc + x;
}
__device__ __forceinline__ void transpose_items(const float* __restrict__ W, int ldw, int N, bf16_t* __restrict__ Wt, const float* __restrict__ g, int glimit,
                                                int mode, long gtid, long nthr) {
  const long nitems = (long)N * 128;
  for (long it = gtid; it < nitems; it += nthr) {
    const int n = (int)(it % N), kc = (int)(it / N);
    const int src = mode == 1 ? w1_src(n) : (mode == 2 ? 1024 + n : n);
    float v[8];
#pragma unroll
    for (int i = 0; i < 8; ++i) {
      const int k = kc * 8 + i;
      float w = W[(size_t)k * ldw + src];
      if (k < glimit) w *= g[k];
      v[i] = w;
    }
    u32x4 o = {pk2(v[0], v[1]), pk2(v[2], v[3]), pk2(v[4], v[5]), pk2(v[6], v[7])};
    *(u32x4*)(Wt + (size_t)n * 1024 + kc * 8) = o;
  }
}
__device__ __forceinline__ void convert_items(const float* __restrict__ src, bf16_t* __restrict__ dst, long n8, long gtid, long nthr) {
  for (long it = gtid; it < n8; it += nthr) {
    const f32x4 a = *(const f32x4*)(src + it * 8), b = *(const f32x4*)(src + it * 8 + 4);
    u32x4 o = {pk2(a.x, a.y), pk2(a.z, a.w), pk2(b.x, b.y), pk2(b.z, b.w)};
    *(u32x4*)(dst + it * 8) = o;
  }
}
__device__ void phase_prep(const Params& p) {
  const int tid0 = otid();
  const long gtid = (long)vblock() * NTHREADS + tid0, nthr = (long)gridDim.x * NTHREADS;
  unsigned char* ws = p.ws;
  transpose_items(p.w_in, NIN, 2048, (bf16_t*)(ws + WS_W1), p.norm_mix_g, 1024, 1, gtid, nthr);
  transpose_items(p.w_in, NIN, 512, (bf16_t*)(ws + WS_WV), p.norm_mix_g, 1024, 2, gtid, nthr);
  transpose_items(p.w_out, D, D, (bf16_t*)(ws + WS_WOUT), p.attn_out_g, 512, 0, gtid, nthr);
  transpose_items(p.peer_wq, D, D, (bf16_t*)(ws + WS_WQ), p.norm_ffn_g, 1024, 0, gtid, nthr);
  convert_items(p.peer_k1, (bf16_t*)(ws + WS_K1), 65536 / 8, gtid, nthr);
  convert_items(p.peer_k2, (bf16_t*)(ws + WS_K2), 65536 / 8, gtid, nthr);
  const int lane = tid0 & 63, gw = vblock() * NWAVES + (tid0 >> 6), nw = gridDim.x * NWAVES;
  {
    bf16_t* XB = (bf16_t*)(ws + WS_XB);
    float* RS1 = (float*)(ws + WS_RS1);
    float* SSQ2 = (float*)(ws + WS_SSQ2);
    for (int tb = gw; tb < T; tb += 2 * nw) {
      f32x4 v[2][4];
      float ss[2] = {0.f, 0.f};
#pragma unroll
      for (int u = 0; u < 2; ++u) {
        const int t = (tb + u * nw < T) ? tb + u * nw : tb;
        const float* src = p.x + (size_t)t * 1024 + lane * 4;
#pragma unroll
        for (int i = 0; i < 4; ++i) v[u][i] = *(const f32x4*)(src + 256 * i);
      }
#pragma unroll
      for (int u = 0; u < 2; ++u) {
#pragma unroll
        for (int i = 0; i < 4; ++i) ss[u] += v[u][i].x * v[u][i].x + v[u][i].y * v[u][i].y + v[u][i].z * v[u][i].z + v[u][i].w * v[u][i].w;
      }
#pragma unroll
      for (int o = 1; o < 64; o <<= 1) { ss[0] += __shfl_xor(ss[0], o); ss[1] += __shfl_xor(ss[1], o); }
#pragma unroll
      for (int u = 0; u < 2; ++u) {
        const int t = tb + u * nw;
        if (t < T) {
#pragma unroll
          for (int i = 0; i < 4; ++i) *(u32x2*)(XB + (size_t)t * 1024 + lane * 4 + 256 * i) = (u32x2){pk2(v[u][i].x, v[u][i].y), pk2(v[u][i].z, v[u][i].w)};
          if (lane == 0) { RS1[t] = rsqrtf(ss[u] * (1.f / 1024.f) + EPS); SSQ2[t] = 0.f; }
        }
      }
    }
  }
}

__device__ void prep_tables(const Params& p) {
  unsigned char* ws = p.ws;
  const int tid0 = otid();
  const int lane = tid0 & 63, gw = vblock() * NWAVES + (tid0 >> 6), nw = gridDim.x * NWAVES;
  {
    f32x4 gn[4];
#pragma unroll
    for (int i = 0; i < 4; ++i) gn[i] = *(const f32x4*)(p.norm_ffn_g + lane * 16 + 4 * i);
    for (int rb = gw; rb < 32768; rb += 2 * nw) {
      f32x4 v[2][4];
#pragma unroll
      for (int u = 0; u < 2; ++u) {
        const int r = (rb + u * nw < 32768) ? rb + u * nw : rb;
        const float* src = ((r >> 14) ? p.peer_v : p.peer_u) + (size_t)(r & 16383) * 1024 + lane * 16;
#pragma unroll
        for (int i = 0; i < 4; ++i) v[u][i] = *(const f32x4*)(src + 4 * i);
        if (!(r >> 14)) {
#pragma unroll
          for (int i = 0; i < 4; ++i) v[u][i] *= gn[i];
        }
      }
      float am[2] = {0.f, 0.f};
#pragma unroll
      for (int u = 0; u < 2; ++u)
#pragma unroll
        for (int i = 0; i < 4; ++i)
          am[u] = fmaxf(am[u], fmaxf(fmaxf(fabsf(v[u][i].x), fabsf(v[u][i].y)), fmaxf(fabsf(v[u][i].z), fabsf(v[u][i].w))));
#pragma unroll
      for (int o = 1; o < 64; o <<= 1) { am[0] = fmaxf(am[0], __shfl_xor(am[0], o)); am[1] = fmaxf(am[1], __shfl_xor(am[1], o)); }
#pragma unroll
      for (int u = 0; u < 2; ++u) {
        const int r = rb + u * nw;
        if (r < 32768) {
          const int isv = r >> 14, e = r & 16383;
          const float scale = am[u] > 0.f ? am[u] * (1.f / 6.f) : 1.f, inv = am[u] > 0.f ? 6.f / am[u] : 0.f;
          unsigned q[2] = {0u, 0u};
#pragma unroll
          for (int i = 0; i < 4; ++i)
#pragma unroll
            for (int j = 0; j < 4; ++j) {
              const float xv = v[u][i][j], m = fabsf(xv) * inv;
              const unsigned code = (unsigned)(m > 0.25f) + (unsigned)(m > 0.75f) + (unsigned)(m > 1.25f) + (unsigned)(m > 1.75f) +
                                    (unsigned)(m > 2.5f) + (unsigned)(m > 3.5f) + (unsigned)(m > 5.0f);
              const unsigned nib = code | (xv < 0.f ? 8u : 0u);
              const int el = 4 * i + j;
              q[el >> 3] |= nib << (4 * (el & 7));
            }
          if (isv) {
            *(u32x2*)(ws + WS_V8 + (size_t)e * 512 + lane * 8) = (u32x2){q[0], q[1]};
            if (lane == 0) ((float*)(ws + WS_USV))[2 * e + 1] = scale;
          } else {
            *(u32x2*)(ws + WS_U8 + (size_t)e * 512 + lane * 8) = (u32x2){q[0], q[1]};
            if (lane == 0) ((float*)(ws + WS_USV))[2 * e] = scale;
          }
        }
      }
    }
  }
}

namespace pg8 {
typedef short sbf16x8 __attribute__((ext_vector_type(8)));
constexpr int BM = 256, BK = 64, HALF = 128, HTB = HALF * BK * 2  , NXCD = 8, WGM = 8;
__device__ __forceinline__ int lds_byte(int r, int c) { const int st = (r >> 4) * 2 + (c >> 5), rr = r & 15, cc = c & 31, ob = rr * 64 + cc * 2; return st * 1024 + (ob ^ (((ob >> 9) & 1) << 5)); }
__device__ __forceinline__ void stage_rc(int b, int& R, int& C) { const int st = b / 1024, sb = b % 1024, swz = sb ^ (((sb >> 9) & 1) << 5); R = (st >> 1) * 16 + swz / 64; C = (st & 1) * 32 + (swz % 64) / 2; }
__device__ __forceinline__ int perm32(int rho) { const int n = rho >> 4, i = rho & 15; return 8 * (i >> 2) + 4 * n + (i & 3); }
struct Unit { int pm, pn; };
struct Gemm { const bf16_t* A; const bf16_t* Bt; int M, N, K; };
struct StaticOrder {
    int nM, nN, nwg, G, c;
    __device__ void init(int M, int N, int G_, int c_) { nM = M / BM; nN = N / BM; nwg = nM * nN; G = G_; c = c_; }
    __device__ bool next(int i, Unit& u) const {
        const long L = (long)i * G + c; if (L >= nwg) return false;
        int wgid = (int)L; { const int q = nwg / NXCD, r = nwg % NXCD, xcd = wgid % NXCD, off = wgid / NXCD; wgid = (xcd < r ? xcd * (q + 1) : r * (q + 1) + (xcd - r) * q) + off; }
        const int nig = WGM * nN, gid = wgid / nig, fm = gid * WGM, gsz = (nM - fm) < WGM ? (nM - fm) : WGM;
        u.pm = fm + ((wgid % nig) % gsz); u.pn = (wgid % nig) / gsz; return true;
    }
};
template <class Epi>
__device__ __forceinline__ void gemm_phase(LAS unsigned char* lds, const Gemm g, const StaticOrder& S, const Epi& E) {
    const int tid = otid(), wid = __builtin_amdgcn_readfirstlane(tid >> 6), lane = tid & 63, wr = wid >> 2, wc = wid & 3, fr = lane & 15, fq = lane >> 4;
    const int K = g.K, nt = K / BK;
    unsigned voffA[2], voffB[2];
#pragma unroll
    for (int i = 0; i < 2; ++i) { int R, C; stage_rc(tid * 16 + i * 8192, R, C); const int Rb = Epi::PERM ? ((R & ~31) + perm32(R & 31)) : R;
        voffA[i] = (unsigned)(R * K + C) * 2u; voffB[i] = (unsigned)(Rb * K + C) * 2u; }
    const size_t kstep = (size_t)(BK * 2);
    const size_t hstep = (size_t)HALF * K * 2;
    const size_t tstep = 2 * hstep;
    const unsigned ldsw = (unsigned)wid * 1024u;
    const int aoff = lds_byte(wr * 64 + fr, fq * 8), boff = lds_byte(wc * 32 + fr, fq * 8);
#define PG8_SA(b, h) (((b) * 2 + (h)) * HTB)
#define PG8_SB(b, h) ((4 + (b) * 2 + (h)) * HTB)
#define PG8_STAGE(bufoff, gbase, voff) do { _Pragma("unroll") for (int _i = 0; _i < 2; ++_i) \
        __builtin_amdgcn_global_load_lds((const unsigned*)((const char*)(gbase) + (voff)[_i]), (LAS unsigned*)(lds + (bufoff) + ldsw + _i * 8192), 16, 0, 0); } while (0)
#define PG8_LDA(dst, b, h) do { _Pragma("unroll") for (int m = 0; m < 4; ++m) _Pragma("unroll") for (int k = 0; k < 2; ++k) dst[m][k] = *(const LAS sbf16x8*)(lds + PG8_SA(b, h) + aoff + m * 2048 + k * 1024); } while (0)
#define PG8_LDB(dst, b, h) do { _Pragma("unroll") for (int n = 0; n < 2; ++n) _Pragma("unroll") for (int k = 0; k < 2; ++k) dst[n][k] = *(const LAS sbf16x8*)(lds + PG8_SB(b, h) + boff + n * 2048 + k * 1024); } while (0)
#define PG8_MMA(ai, bj, At, Bt) do { __builtin_amdgcn_s_setprio(1); _Pragma("unroll") for (int m = 0; m < 4; ++m) _Pragma("unroll") for (int n = 0; n < 2; ++n) _Pragma("unroll") for (int k = 0; k < 2; ++k) \
        acc[ai][bj][m][n] = __builtin_amdgcn_mfma_f32_16x16x32_bf16(__builtin_bit_cast(bf16x8, Bt[n][k]), __builtin_bit_cast(bf16x8, At[m][k]), acc[ai][bj][m][n], 0, 0, 0); __builtin_amdgcn_s_setprio(0); } while (0)
#define PG8_WAIT_V(n) asm volatile("s_waitcnt vmcnt(" #n ")" ::: "memory")
#define PG8_WAIT_L(n) asm volatile("s_waitcnt lgkmcnt(" #n ")" ::: "memory")
#define PG8_BAR __builtin_amdgcn_s_barrier()
#define PG8_SCHED __builtin_amdgcn_sched_barrier(0)
    Unit cur, nxt; int ui = 0;
    if (!S.next(0, cur)) return;
    f32x4 acc[2][2][4][2];
#pragma unroll
    for (int a = 0; a < 2; ++a)
#pragma unroll
        for (int b = 0; b < 2; ++b)
#pragma unroll
            for (int m = 0; m < 4; ++m)
#pragma unroll
                for (int n = 0; n < 2; ++n) acc[a][b][m][n] = (f32x4){0.f, 0.f, 0.f, 0.f};
    sbf16x8 At[4][2], B0[2][2], B1[2][2];
    const char* cA = (const char*)g.A + (size_t)cur.pm * tstep; const char* cB = (const char*)g.Bt + (size_t)cur.pn * tstep;
    PG8_STAGE(PG8_SB(0, 0), cB, voffB); PG8_STAGE(PG8_SA(0, 0), cA, voffA); PG8_STAGE(PG8_SB(0, 1), cB + hstep, voffB); PG8_STAGE(PG8_SA(0, 1), cA + hstep, voffA);
    if (wr == 1) PG8_BAR;
    PG8_WAIT_V(4); PG8_BAR;
    PG8_STAGE(PG8_SB(1, 0), cB + kstep, voffB); PG8_STAGE(PG8_SA(1, 0), cA + kstep, voffA); PG8_STAGE(PG8_SB(1, 1), cB + hstep + kstep, voffB);
    PG8_WAIT_V(6); PG8_BAR;
    for (;;) {
        const bool has_next = S.next(ui + 1, nxt);
        const char* nA = has_next ? (const char*)g.A + (size_t)nxt.pm * tstep : cA; const char* nB = has_next ? (const char*)g.Bt + (size_t)nxt.pn * tstep : cB;
        for (int t = 0; t < nt; t += 2) {
            const bool last = (t == nt - 2);
            const char* a1 = cA + (size_t)(t + 1) * kstep;
            const char* a2 = last ? nA : cA + (size_t)(t + 2) * kstep; const char* b2 = last ? nB : cB + (size_t)(t + 2) * kstep;
            const char* a3 = a2 + kstep; const char* b3 = b2 + kstep;
            PG8_LDB(B0, 0, 0); PG8_SCHED; PG8_LDA(At, 0, 0); PG8_STAGE(PG8_SA(1, 1), a1 + hstep, voffA);
            PG8_WAIT_L(8); PG8_BAR; PG8_WAIT_L(0); PG8_MMA(0, 0, At, B0); PG8_BAR; PG8_SCHED;
            PG8_LDB(B1, 0, 1); PG8_STAGE(PG8_SB(0, 0), b2, voffB);
            PG8_BAR; PG8_WAIT_L(0); PG8_MMA(0, 1, At, B1); PG8_BAR;
            PG8_LDA(At, 0, 1); PG8_STAGE(PG8_SA(0, 0), a2, voffA);
            PG8_BAR; PG8_WAIT_L(0); PG8_MMA(1, 0, At, B0); PG8_BAR; PG8_SCHED;
            PG8_STAGE(PG8_SB(0, 1), b2 + hstep, voffB);
            PG8_WAIT_V(6); PG8_BAR; PG8_MMA(1, 1, At, B1); PG8_BAR;
            PG8_LDB(B0, 1, 0); PG8_SCHED; PG8_LDA(At, 1, 0); PG8_STAGE(PG8_SA(0, 1), a2 + hstep, voffA);
            PG8_WAIT_L(8); PG8_BAR; PG8_WAIT_L(0); PG8_MMA(0, 0, At, B0); PG8_BAR; PG8_SCHED;
            PG8_LDB(B1, 1, 1); PG8_STAGE(PG8_SB(1, 0), b3, voffB);
            PG8_BAR; PG8_WAIT_L(0); PG8_MMA(0, 1, At, B1); PG8_BAR;
            PG8_LDA(At, 1, 1); PG8_STAGE(PG8_SA(1, 0), a3, voffA);
            PG8_BAR; PG8_WAIT_L(0); PG8_MMA(1, 0, At, B0); PG8_BAR; PG8_SCHED;
            PG8_STAGE(PG8_SB(1, 1), b3 + hstep, voffB);
            PG8_WAIT_V(6); PG8_BAR; PG8_MMA(1, 1, At, B1); PG8_BAR;
        }
        E(acc, cur, wr, wc, fr, fq);
        if (!has_next) break;
#pragma unroll
        for (int a = 0; a < 2; ++a)
#pragma unroll
            for (int b = 0; b < 2; ++b)
#pragma unroll
                for (int m = 0; m < 4; ++m)
#pragma unroll
                    for (int n = 0; n < 2; ++n) acc[a][b][m][n] = (f32x4){0.f, 0.f, 0.f, 0.f};
        cur = nxt; cA = nA; cB = nB; ++ui;
    }
    PG8_WAIT_V(0);
    if (wr == 0) PG8_BAR;
    PG8_BAR;
#undef PG8_SA
#undef PG8_SB
#undef PG8_STAGE
#undef PG8_LDA
#undef PG8_LDB
#undef PG8_MMA
#undef PG8_WAIT_V
#undef PG8_WAIT_L
#undef PG8_BAR
#undef PG8_SCHED
}
}

struct EpiQKC {
  static constexpr bool PERM = true;
  const float* rs1; const float* qg; const float* kg; bf16_t* Q; bf16_t* Kk; bf16_t* HG;
  __device__ __forceinline__ void operator()(const f32x4 (&acc)[2][2][4][2], const pg8::Unit& u, int wr, int wc, int fr, int fq) const {
    const int row0 = u.pm * 256 + wr * 64 + fr;
    if (u.pn < 4) {
      const bool isq = u.pn < 2;
      const int head = 4 * (u.pn & 1) + wc;
      const float* g = isq ? qg : kg;
      f32x4 gv[2][2];
#pragma unroll
      for (int bj = 0; bj < 2; ++bj)
#pragma unroll
        for (int n = 0; n < 2; ++n) gv[bj][n] = *(const f32x4*)(g + 32 * bj + 8 * fq + 4 * n);
      bf16_t* base = isq ? Q : Kk;
#pragma unroll
      for (int ai = 0; ai < 2; ++ai)
#pragma unroll
        for (int m = 0; m < 4; ++m) {
          const int t = row0 + ai * 128 + m * 16;
          float ss = 0.f;
#pragma unroll
          for (int bj = 0; bj < 2; ++bj)
#pragma unroll
            for (int n = 0; n < 2; ++n) { const f32x4 v = acc[ai][bj][m][n]; ss += v.x * v.x + v.y * v.y + v.z * v.z + v.w * v.w; }
          ss += __shfl_xor(ss, 16);
          ss += __shfl_xor(ss, 32);
          const float r = rs1[t];
          float sc = r * rsqrtf(r * r * ss * (1.f / 64.f) + EPS);
          if (isq) sc *= 0.125f * LOG2E;
          bf16_t* dst = base + ((size_t)((t >> 12) * 8 + head) * 4096 + (t & 4095)) * 64 + 8 * fq;
#pragma unroll
          for (int bj = 0; bj < 2; ++bj) {
            const f32x4 a = acc[ai][bj][m][0] * gv[bj][0] * sc, b = acc[ai][bj][m][1] * gv[bj][1] * sc;
            *(u32x4*)(dst + 32 * bj) = (u32x4){pk2(a.x, a.y), pk2(a.z, a.w), pk2(b.x, b.y), pk2(b.z, b.w)};
          }
        }
    } else {
      const int ch0 = 128 * (u.pn - 4) + 32 * wc + 8 * fq;
#pragma unroll
      for (int ai = 0; ai < 2; ++ai)
#pragma unroll
        for (int m = 0; m < 4; ++m) {
          const int t = row0 + ai * 128 + m * 16;
          const float r = rs1[t];
          float h[8];
#pragma unroll
          for (int n = 0; n < 2; ++n)
#pragma unroll
            for (int j = 0; j < 4; ++j) h[4 * n + j] = acc[ai][0][m][n][j] * r / (1.f + __expf(-acc[ai][1][m][n][j] * r));
          *(u32x4*)(HG + (size_t)t * 512 + ch0) = (u32x4){pk2(h[0], h[1]), pk2(h[2], h[3]), pk2(h[4], h[5]), pk2(h[6], h[7])};
        }
    }
  }
};
struct EpiVt {
  static constexpr bool PERM = false;
  const float* rs1; bf16_t* Vt;
  __device__ __forceinline__ void operator()(const f32x4 (&acc)[2][2][4][2], const pg8::Unit& u, int wr, int wc, int fr, int fq) const {
    const int pos0 = 8 * (fq & 1) + 4 * (fq >> 1);
#pragma unroll
    for (int bj = 0; bj < 2; ++bj)
#pragma unroll
      for (int n = 0; n < 2; ++n) {
        const int t = u.pn * 256 + bj * 128 + wc * 32 + n * 16 + 4 * fq;
        const f32x4 r = *(const f32x4*)(rs1 + t);
        const size_t tb = ((size_t)(t >> 12) * 8) * 128 + ((t & 4095) >> 5);
#pragma unroll
        for (int ai = 0; ai < 2; ++ai)
#pragma unroll
          for (int m = 0; m < 4; ++m) {
            const int dg = u.pm * 256 + ai * 128 + wr * 64 + m * 16 + fr, head = dg >> 6, d = dg & 63;
            const f32x4 v = acc[ai][bj][m][n] * r;
            *(u32x2*)(Vt + ((tb + (size_t)head * 128) * 64 + d) * 32 + 16 * n + pos0) = (u32x2){pk2(v.x, v.y), pk2(v.z, v.w)};
          }
      }
  }
};
struct EpiOut {
  static constexpr bool PERM = false;
  const bf16_t* xb; bf16_t* HB; float* ssq2;
  __device__ __forceinline__ void operator()(const f32x4 (&acc)[2][2][4][2], const pg8::Unit& u, int wr, int wc, int fr, int fq) const {
    const int row0 = u.pm * 256 + wr * 64 + fr, col0 = u.pn * 256 + wc * 32 + 4 * fq;
#pragma unroll
    for (int ai = 0; ai < 2; ++ai)
#pragma unroll
      for (int m = 0; m < 4; ++m) {
        const int t = row0 + ai * 128 + m * 16;
        const size_t ro = (size_t)t * 1024 + col0;
        float ss = 0.f;
#pragma unroll
        for (int bj = 0; bj < 2; ++bj)
#pragma unroll
          for (int n = 0; n < 2; ++n) {
            const size_t o = ro + bj * 128 + n * 16;
            const u32x2 xv = *(const u32x2*)(xb + o);
            const f32x4 h = (f32x4){bflo(xv.x), bfhi(xv.x), bflo(xv.y), bfhi(xv.y)} + acc[ai][bj][m][n];
            *(u32x2*)(HB + o) = (u32x2){pk2(h.x, h.y), pk2(h.z, h.w)};
            ss += h.x * h.x + h.y * h.y + h.z * h.z + h.w * h.w;
          }
        ss += __shfl_xor(ss, 16);
        ss += __shfl_xor(ss, 32);
        if (fq == 0) atomicAdd(ssq2 + t, ss);
      }
  }
};
struct EpiQh {
  static constexpr bool PERM = true;
  const float* ssq2; bf16_t* QH;
  __device__ __forceinline__ void operator()(const f32x4 (&acc)[2][2][4][2], const pg8::Unit& u, int wr, int wc, int fr, int fq) const {
    const int row0 = u.pm * 256 + wr * 64 + fr, col0 = u.pn * 256 + wc * 32 + 8 * fq;
#pragma unroll
    for (int ai = 0; ai < 2; ++ai)
#pragma unroll
      for (int m = 0; m < 4; ++m) {
        const int t = row0 + ai * 128 + m * 16;
        const float r = rsqrtf(ssq2[t] * (1.f / 1024.f) + EPS);
#pragma unroll
        for (int bj = 0; bj < 2; ++bj) {
          const f32x4 a = acc[ai][bj][m][0] * r, b = acc[ai][bj][m][1] * r;
          *(u32x4*)(QH + (size_t)t * 1024 + col0 + bj * 128) = (u32x4){pk2(a.x, a.y), pk2(a.z, a.w), pk2(b.x, b.y), pk2(b.z, b.w)};
        }
      }
  }
};

__device__ void phase_inproj(const Params& p, char* smem) {
  unsigned char* ws = p.ws;
  LAS unsigned char* lds = (LAS unsigned char*)smem;
  const bf16_t* XB = (const bf16_t*)(ws + WS_XB);
  const float* RS1 = (const float*)(ws + WS_RS1);
  pg8::StaticOrder S;
  {
    pg8::Gemm g{XB, (const bf16_t*)(ws + WS_W1), T, 2048, 1024};
    S.init(T, 2048, gridDim.x, blockIdx.x);
    EpiQKC E{RS1, p.q_norm_g, p.k_norm_g, (bf16_t*)(ws + WS_Q), (bf16_t*)(ws + WS_K), (bf16_t*)(ws + WS_HG)};
    pg8::gemm_phase<EpiQKC>(lds, g, S, E);
  }
  {
    pg8::Gemm g{(const bf16_t*)(ws + WS_WV), XB, 512, T, 1024};
    S.init(512, T, gridDim.x, blockIdx.x);
    EpiVt E{RS1, (bf16_t*)(ws + WS_VT)};
    pg8::gemm_phase<EpiVt>(lds, g, S, E);
  }
}
__device__ void phase_outproj(const Params& p, char* smem) {
  unsigned char* ws = p.ws;
  pg8::Gemm g{(const bf16_t*)(ws + WS_MIX), (const bf16_t*)(ws + WS_WOUT), T, 1024, 1024};
  pg8::StaticOrder S;
  S.init(T, 1024, gridDim.x, blockIdx.x);
  EpiOut E{(const bf16_t*)(ws + WS_XB), (bf16_t*)(ws + WS_HB), (float*)(ws + WS_SSQ2)};
  pg8::gemm_phase<EpiOut>((LAS unsigned char*)smem, g, S, E);
}
__device__ void phase_qproj(const Params& p, char* smem) {
  unsigned char* ws = p.ws;
  pg8::Gemm g{(const bf16_t*)(ws + WS_HB), (const bf16_t*)(ws + WS_WQ), T, 1024, 1024};
  pg8::StaticOrder S;
  S.init(T, 1024, gridDim.x, blockIdx.x);
  EpiQh E{(const float*)(ws + WS_SSQ2), (bf16_t*)(ws + WS_QH)};
  pg8::gemm_phase<EpiQh>((LAS unsigned char*)smem, g, S, E);
}

__device__ __forceinline__ void conv_stage(const bf16_t* HG, int item, LAS unsigned char* buf, int wave, int lane) {
  const int t0 = item * 32, s0 = t0 & 4095;
#pragma unroll
  for (int j = 0; j < 8; ++j) {
    const int r = wave + 8 * j;
    if (r < 62) {
      if (s0 - 30 + r >= 0)
        __builtin_amdgcn_global_load_lds((const unsigned*)(HG + (size_t)(t0 - 30 + r) * 512 + lane * 8), (LAS unsigned*)(buf + r * 1024), 16, 0, 0);
      else
        *(LAS u32x4*)(buf + r * 1024 + lane * 16) = (u32x4){0u, 0u, 0u, 0u};
    }
  }
}
struct ConvW { f32x2 wv[31]; float2 cb, lg, lb; };
__device__ __forceinline__ void conv_compute(const Params& p, int item, const char* smem, const ConvW& W, int tid512) {
  bf16_t* MIX = (bf16_t*)(p.ws + WS_MIX);
  const int half = tid512 >> 8, tid = tid512 & 255, lane = tid & 63, wave = tid >> 6;
  const int t0 = item * 32;
  float* red = (float*)(smem + 62 * 1024) + half * 128;
  const bool b5 = lane & 32, b4 = lane & 16, b3 = lane & 8, b2 = lane & 4;
#pragma unroll 1
  for (int rd = 0; rd < 2; ++rd) {
    const int tb = 16 * half + 8 * rd;
    f32x2 xv[38];
#pragma unroll
    for (int r = 0; r < 38; ++r) {
      const unsigned v = *(const unsigned*)(smem + (tb + r) * 1024 + tid * 4);
      xv[r] = (f32x2){bflo(v), bfhi(v)};
    }
    float a0[8], a1[8], st[16];
#pragma unroll
    for (int k = 0; k < 8; ++k) {
      f32x2 u = {W.cb.x, W.cb.y};
#pragma unroll
      for (int j = 0; j < 31; ++j) u = __builtin_elementwise_fma(W.wv[j], xv[k + j], u);
      a0[k] = u.x; a1[k] = u.y;
      st[k] = u.x + u.y;
      st[8 + k] = u.x * u.x + u.y * u.y;
    }
    float r8[8], r4[4], r2[2], r1;
#pragma unroll
    for (int i = 0; i < 8; ++i) { const float keep = b5 ? st[8 + i] : st[i], send = b5 ? st[i] : st[8 + i]; r8[i] = keep + __shfl_xor(send, 32); }
#pragma unroll
    for (int i = 0; i < 4; ++i) { const float keep = b4 ? r8[4 + i] : r8[i], send = b4 ? r8[i] : r8[4 + i]; r4[i] = keep + __shfl_xor(send, 16); }
#pragma unroll
    for (int i = 0; i < 2; ++i) { const float keep = b3 ? r4[2 + i] : r4[i], send = b3 ? r4[i] : r4[2 + i]; r2[i] = keep + __shfl_xor(send, 8); }
    { const float keep = b2 ? r2[1] : r2[0], send = b2 ? r2[0] : r2[1]; r1 = keep + __shfl_xor(send, 4); }
    r1 += __shfl_xor(r1, 2);
    r1 += __shfl_xor(r1, 1);
    float* rr = red + rd * 64;
    if ((lane & 3) == 0) rr[wave * 16 + (lane >> 2)] = r1;
    __syncthreads();
#pragma unroll
    for (int k = 0; k < 8; ++k) {
      const float S1 = (rr[k] + rr[16 + k]) + (rr[32 + k] + rr[48 + k]);
      const float S2 = (rr[8 + k] + rr[24 + k]) + (rr[40 + k] + rr[56 + k]);
      const float mu = S1 * (1.f / 512.f);
      const float var = fmaxf(S2 * (1.f / 512.f) - mu * mu, 0.f);
      const float rstd = rsqrtf(var + EPS);
      const float y0 = (a0[k] - mu) * rstd * W.lg.x + W.lb.x, y1 = (a1[k] - mu) * rstd * W.lg.y + W.lb.y;
      const float z0 = y0 / (1.f + __expf(-y0)), z1 = y1 / (1.f + __expf(-y1));
      *(unsigned*)(MIX + (size_t)(t0 + tb + k) * 1024 + 512 + 2 * tid) = pk2(z0, z1);
    }
  }
}
__device__ void conv_items(const Params& p, char* smem) {
  const bf16_t* HG = (const bf16_t*)(p.ws + WS_HG);
  const int tid512 = otid(), tid = tid512 & 255, lane = tid512 & 63;
  const int wave = __builtin_amdgcn_readfirstlane(tid512 >> 6);
  const int vb = vblock(), G = gridDim.x;
  ConvW W;
#pragma unroll
  for (int j = 0; j < 31; ++j) {
    const float2 w = *(const float2*)(p.conv_w + j * 512 + 2 * tid);
    W.wv[j] = (f32x2){w.x, w.y};
  }
  W.cb = *(const float2*)(p.conv_b + 2 * tid);
  W.lg = *(const float2*)(p.conv_ln_g + 2 * tid);
  W.lb = *(const float2*)(p.conv_ln_b + 2 * tid);
  int b = 0;
  if (vb < 1024) conv_stage(HG, vb, (LAS unsigned char*)smem, wave, lane);
  for (int item = vb; item < 1024; item += G, b ^= 1) {
    asm volatile("s_waitcnt vmcnt(0) lgkmcnt(0)" ::: "memory");
    __syncthreads();
    if (item + G < 1024) conv_stage(HG, item + G, (LAS unsigned char*)smem + (b ^ 1) * 65536, wave, lane);
    conv_compute(p, item, smem + b * 65536, W, tid512);
  }
  __syncthreads();
}

struct AttnKV { bf16x8 k[4]; bf16x8 v[2][2]; };
__device__ __forceinline__ void attn_load(const bf16_t* Km, const bf16_t* Vt, int bh, int kb, int tok, int hf, AttnKV& f) {
  const int kc = kb < 0 ? 0 : kb;
  const bf16_t* kp = Km + ((size_t)bh * 4096 + kc * 32 + tok) * 64 + 8 * hf;
#pragma unroll
  for (int ks = 0; ks < 4; ++ks) f.k[ks] = *(const bf16x8*)(kp + ks * 16);
  const bf16_t* vp = Vt + (((size_t)bh * 128 + kc) * 64 + tok) * 32 + hf * 8;
#pragma unroll
  for (int m = 0; m < 2; ++m)
#pragma unroll
    for (int s = 0; s < 2; ++s) f.v[m][s] = *(const bf16x8*)(vp + m * 1024 + s * 16);
}
__device__ __forceinline__ bool attn_block(const AttnKV& f, const bf16x8 (&qf)[4], bool diag, int tok, int hf, float& c, f32x16& o0, f32x16& o1) {
  f32x16 sc;
#pragma unroll
  for (int i = 0; i < 16; ++i) sc[i] = 0.f;
#pragma unroll
  for (int ks = 0; ks < 4; ++ks) sc = mfma32(f.k[ks], qf[ks], sc);
  float kp[16], sg[16];
#pragma unroll
  for (int i = 0; i < 16; ++i) {
    const float e = __builtin_amdgcn_exp2f(fminf(sc[i], 80.f));
    const float r = __builtin_amdgcn_rcpf(1.f + e);
    kp[i] = r;
    sg[i] = e * r;
  }
  if (diag) {
#pragma unroll
    for (int i = 0; i < 16; ++i) {
      const bool valid = ((i & 3) + 8 * (i >> 2) + 4 * hf < tok);
      kp[i] = valid ? kp[i] : 1.f;
      sg[i] = valid ? sg[i] : 0.f;
    }
  }
  float Tg[4], Pg[4];
#pragma unroll
  for (int g = 0; g < 4; ++g) {
    Tg[g] = (kp[4 * g] * kp[4 * g + 1]) * (kp[4 * g + 2] * kp[4 * g + 3]);
    Pg[g] = __shfl_xor(Tg[g], 32);
  }
  float base[4];
  float run = __builtin_amdgcn_exp2f(c);
#pragma unroll
  for (int g = 3; g >= 0; --g) {
    base[g] = run * (hf == 0 ? Pg[g] : 1.f);
    run *= Tg[g] * Pg[g];
  }
  float pr[16];
#pragma unroll
  for (int g = 0; g < 4; ++g) {
    float l = base[g];
#pragma unroll
    for (int r = 3; r >= 0; --r) {
      pr[4 * g + r] = sg[4 * g + r] * l;
      l *= kp[4 * g + r];
    }
  }
  c = __builtin_amdgcn_logf(run);
  bf16x8 pf[2];
#pragma unroll
  for (int s = 0; s < 2; ++s)
#pragma unroll
    for (int j = 0; j < 8; ++j) pf[s][j] = (__bf16)pr[8 * s + j];
#pragma unroll
  for (int s = 0; s < 2; ++s) {
    o0 = mfma32(f.v[0][s], pf[s], o0);
    o1 = mfma32(f.v[1][s], pf[s], o1);
  }
  return __all(c < -150.f);
}
__device__ void attn_tile(const Params& p, int item, int it, int lane, int wave, char* smem) {
  unsigned char* ws = p.ws;
  const bf16_t* Qm = (const bf16_t*)(ws + WS_Q);
  const bf16_t* Km = (const bf16_t*)(ws + WS_K);
  const bf16_t* Vt = (const bf16_t*)(ws + WS_VT);
  bf16_t* MIX = (bf16_t*)(ws + WS_MIX);
  const int qt = item & 127, bh = (item >> 7) * 8 + wave;
  const int tok = lane & 31, hf = lane >> 5;
  bf16x8 qf[4];
  {
    const bf16_t* qp = Qm + ((size_t)bh * 4096 + qt * 32 + tok) * 64 + 8 * hf;
#pragma unroll
    for (int ks = 0; ks < 4; ++ks) qf[ks] = *(const bf16x8*)(qp + ks * 16);
  }
  f32x16 o0, o1;
#pragma unroll
  for (int i = 0; i < 16; ++i) { o0[i] = 0.f; o1[i] = 0.f; }
  float c = 0.f;
  AttnKV fa, fb;
  attn_load(Km, Vt, bh, qt, tok, hf, fa);
  {
    unsigned z = __builtin_bit_cast(u32x4, fa.v[1][1]).w | __builtin_bit_cast(u32x4, fa.k[3]).w | __builtin_bit_cast(u32x4, qf[3]).w;
    asm volatile("" ::"v"(z));
  }
  for (int kb = qt;; kb -= 2) {
    attn_load(Km, Vt, bh, kb - 1, tok, hf, fb);
    __builtin_amdgcn_sched_barrier(0);
    if (attn_block(fa, qf, kb == qt, tok, hf, c, o0, o1) || kb == 0) break;
    attn_load(Km, Vt, bh, kb - 2, tok, hf, fa);
    __builtin_amdgcn_sched_barrier(0);
    if (attn_block(fb, qf, false, tok, hf, c, o0, o1) || kb == 1) break;
  }
  float ssq = 0.f;
#pragma unroll
  for (int i = 0; i < 16; ++i) ssq += o0[i] * o0[i] + o1[i] * o1[i];
  ssq += __shfl_xor(ssq, 32);
  float* xch = (float*)(smem + 100 * 1024) + (it & 1) * 256;
  if (hf == 0) xch[wave * 32 + tok] = ssq;
  __syncthreads();
  float tot = 0.f;
#pragma unroll
  for (int w = 0; w < NWAVES; ++w) tot += xch[w * 32 + tok];
  const float rs = rsqrtf(tot * (1.f / 512.f) + EPS);
  const int t = (bh >> 3) * 4096 + qt * 32 + tok, hh = bh & 7;
  bf16_t* dst = MIX + (size_t)t * 1024 + hh * 64 + 4 * hf;
#pragma unroll
  for (int g = 0; g < 4; ++g) {
    *(u32x2*)(dst + 8 * g) = (u32x2){pk2(o0[4 * g] * rs, o0[4 * g + 1] * rs), pk2(o0[4 * g + 2] * rs, o0[4 * g + 3] * rs)};
    *(u32x2*)(dst + 32 + 8 * g) = (u32x2){pk2(o1[4 * g] * rs, o1[4 * g + 1] * rs), pk2(o1[4 * g + 2] * rs, o1[4 * g + 3] * rs)};
  }
}

__device__ void phase_mix(const Params& p, char* smem) {
  static_assert(NWAVES == 8, "one wave per attention head");
  const int vb = vblock(), G = gridDim.x;
  if (blockIdx.x & 1) prep_tables(p);
  conv_items(p, smem);
  const int tidm = otid();
  const int lane = tidm & 63, wave = tidm >> 6;
  int it = 0;
  for (int item = vb; item < 1024; item += G, ++it) attn_tile(p, item, it, lane, wave, smem);
  if (!(blockIdx.x & 1)) prep_tables(p);
}
__device__ __forceinline__ unsigned f2key(float f, unsigned n) {
  const unsigned u = (__float_as_uint(f) & ~0x7Fu) | n;
  return u ^ ((unsigned)((int)u >> 31) | 0x80000000u);
}
__device__ __forceinline__ unsigned f2key_raw(float f) {
  const unsigned u = __float_as_uint(f);
  return u ^ ((unsigned)((int)u >> 31) | 0x80000000u);
}
__device__ __forceinline__ unsigned key2u(unsigned k) { return k ^ ((k >> 31) ? 0x80000000u : 0xFFFFFFFFu); }

template <int N>
__device__ __forceinline__ void bitonic_sort_desc(unsigned (&v)[N]) {
#pragma unroll
  for (int k = 2; k <= N; k <<= 1) {
#pragma unroll
    for (int j = k >> 1; j > 0; j >>= 1) {
#pragma unroll
      for (int i = 0; i < N; ++i) {
        const int l = i ^ j;
        if (l > i) {
          const bool desc = ((i & k) == 0);
          const unsigned mx = max(v[i], v[l]), mn = min(v[i], v[l]);
          v[i] = desc ? mx : mn;
          v[l] = desc ? mn : mx;
        }
      }
    }
  }
}
template <int N>
__device__ __forceinline__ void bitonic_merge_desc(unsigned (&v)[N]) {
#pragma unroll
  for (int j = N >> 1; j > 0; j >>= 1) {
#pragma unroll
    for (int i = 0; i < N; ++i) {
      const int l = i ^ j;
      if (l > i) {
        const unsigned mx = max(v[i], v[l]), mn = min(v[i], v[l]);
        v[i] = mx;
        v[l] = mn;
      }
    }
  }
}
__device__ __forceinline__ void merge_top16(unsigned (&a)[16], const unsigned (&b)[16]) {
#pragma unroll
  for (int i = 0; i < 16; ++i) a[i] = max(a[i], b[15 - i]);
  bitonic_merge_desc<16>(a);
}
#define CEP(ka, pa, kb, pb, desc)                                  \
  {                                                                \
    const bool sw_ = (desc) ? ((kb) > (ka)) : ((kb) < (ka));       \
    const unsigned tk_ = sw_ ? (kb) : (ka), tl_ = sw_ ? (ka) : (kb); \
    const unsigned tp_ = sw_ ? (pb) : (pa), tq_ = sw_ ? (pa) : (pb); \
    ka = tk_; kb = tl_; pa = tp_; pb = tq_;                        \
  }
template <int N>
__device__ __forceinline__ void bitonic_sort_desc_p(unsigned (&v)[N], unsigned (&pl)[N]) {
#pragma unroll
  for (int k = 2; k <= N; k <<= 1) {
#pragma unroll
    for (int j = k >> 1; j > 0; j >>= 1) {
#pragma unroll
      for (int i = 0; i < N; ++i) {
        const int l = i ^ j;
        if (l > i) {
          const bool desc = ((i & k) == 0);
          CEP(v[i], pl[i], v[l], pl[l], desc);
        }
      }
    }
  }
}
template <int N>
__device__ __forceinline__ void bitonic_merge_desc_p(unsigned (&v)[N], unsigned (&pl)[N]) {
#pragma unroll
  for (int j = N >> 1; j > 0; j >>= 1) {
#pragma unroll
    for (int i = 0; i < N; ++i) {
      const int l = i ^ j;
      if (l > i) { CEP(v[i], pl[i], v[l], pl[l], true); }
    }
  }
}
__device__ __forceinline__ void merge_top16_p(unsigned (&a)[16], unsigned (&pa)[16], const unsigned (&b)[16], const unsigned (&pb)[16]) {
#pragma unroll
  for (int i = 0; i < 16; ++i) {
    const bool s = b[15 - i] > a[i];
    a[i] = s ? b[15 - i] : a[i];
    pa[i] = s ? pb[15 - i] : pa[i];
  }
  bitonic_merge_desc_p<16>(a, pa);
}

constexpr int KROW = 144;
__device__ __forceinline__ void subkey_top16(const LAS unsigned char* Kl, const bf16_t* __restrict__ qrow, int lane, unsigned (&top)[16]) {
  const int tok = lane & 31, hf = lane >> 5;
  f32x16 acc[4];
#pragma unroll
  for (int m = 0; m < 4; ++m)
#pragma unroll
    for (int i = 0; i < 16; ++i) acc[m][i] = 0.f;
  bf16x8 bq[4];
#pragma unroll
  for (int ks = 0; ks < 4; ++ks) bq[ks] = *(const bf16x8*)(qrow + ks * 16 + 8 * hf);
#pragma unroll 1
  for (int ks = 0; ks < 4; ++ks) {
#pragma unroll
    for (int m = 0; m < 4; ++m) {
      const bf16x8 ak = *(const LAS bf16x8*)(Kl + (m * 32 + tok) * KROW + ks * 32 + hf * 16);
      acc[m] = mfma32(ak, ks == 0 ? bq[0] : ks == 1 ? bq[1] : ks == 2 ? bq[2] : bq[3], acc[m]);
    }
  }
  unsigned g[4][16];
#pragma unroll
  for (int m = 0; m < 4; ++m) {
#pragma unroll
    for (int i = 0; i < 16; ++i) g[m][i] = f2key(acc[m][i], (unsigned)(m * 32 + (i & 3) + 8 * (i >> 2) + 4 * hf));
    bitonic_sort_desc<16>(g[m]);
  }
  merge_top16(g[0], g[1]);
  merge_top16(g[2], g[3]);
  merge_top16(g[0], g[2]);
  unsigned o[16];
#pragma unroll
  for (int i = 0; i < 16; ++i) o[i] = __shfl_xor(g[0][i], 32);
  merge_top16(g[0], o);
#pragma unroll
  for (int i = 0; i < 16; ++i) top[i] = g[0][i];
}

__device__ void phase_route(const Params& p, char* smem) {
  unsigned char* ws = p.ws;
  const bf16_t* K1 = (const bf16_t*)(ws + WS_K1);
  const bf16_t* K2 = (const bf16_t*)(ws + WS_K2);
  const bf16_t* QH = (const bf16_t*)(ws + WS_QH);
  const bf16_t* HB = (const bf16_t*)(ws + WS_HB);
  unsigned char* XN8 = ws + WS_XN8;
  const float* SSQ2 = (const float*)(ws + WS_SSQ2);
  unsigned* PIDX = (unsigned*)(ws + WS_PIDX);
  float* PG = (float*)(ws + WS_PG);
  const int tidr = otid();
  const int lane = tidr & 63, wave = tidr >> 6, gw = vblock() * NWAVES + wave, nw = gridDim.x * NWAVES;
  const int G = gridDim.x, nh = (G % 8 == 0) ? 8 : 1;
  LAS unsigned char* K1l = (LAS unsigned char*)smem;
  LAS unsigned char* K2l = K1l + 128 * KROW;
  for (int hd = blockIdx.x % nh; hd < 8; hd += nh) {
    for (int idx = tidr; idx < 2048; idx += NTHREADS) {
      const int tb = idx >> 10, row = (idx >> 3) & 127, ch = idx & 7;
      const u32x4 v = *(const u32x4*)((tb ? K2 : K1) + hd * 8192 + row * 64 + ch * 8);
      *(LAS u32x4*)((tb ? K2l : K1l) + row * KROW + ch * 16) = v;
    }
    __syncthreads();
    for (int tile = (blockIdx.x / nh) * NWAVES + wave; tile < T / 32; tile += (G / nh) * NWAVES) {
      const int t0 = tile * 32;
      const int tok = lane & 31, hf = lane >> 5;
      const bf16_t* qrow = QH + (size_t)(t0 + tok) * 1024 + hd * 128;
      unsigned top1[16], top2[16];
      subkey_top16(K1l, qrow, lane, top1);
      subkey_top16(K2l, qrow + 64, lane, top2);
      float fa[16], fb[16];
      unsigned ia[16], ib[16];
#pragma unroll
      for (int i = 0; i < 16; ++i) {
        const unsigned ua = key2u(hf ? top2[i] : top1[i]), ub = key2u(hf ? top1[i] : top2[i]);
        fa[i] = __uint_as_float(ua); ia[i] = ua & 0x7Fu;
        fb[i] = __uint_as_float(ub); ib[i] = ub & 0x7Fu;
      }
      unsigned ck[32];
      {
        int n = 0;
#pragma unroll
        for (int i = 0; i < 4; ++i) {
#pragma unroll
          for (int j = i; j < 16; ++j) {
            if ((i + 1) * (j + 1) <= 16) {
              unsigned key = (f2key_raw(fa[i] + fb[j]) & ~0x3FFFu) | (hf ? ((ib[j] << 7) | ia[i]) : ((ia[i] << 7) | ib[j]));
              if (i == j && hf) key = 0u;
              ck[n] = key;
              ++n;
            }
          }
        }
#pragma unroll
        for (; n < 32; ++n) ck[n] = 0u;
      }
      unsigned k0[16], k1[16];
#pragma unroll
      for (int i = 0; i < 16; ++i) { k0[i] = ck[i]; k1[i] = ck[16 + i]; }
      bitonic_sort_desc<16>(k0);
      bitonic_sort_desc<16>(k1);
      merge_top16(k0, k1);
#pragma unroll
      for (int i = 0; i < 16; ++i) k1[i] = __shfl_xor(k0[i], 32);
      merge_top16(k0, k1);
      float sv[16], sum = 0.f;
      const float mx = __uint_as_float(key2u(k0[0] & ~0x3FFFu));
#pragma unroll
      for (int i = 0; i < 16; ++i) {
        sv[i] = __builtin_amdgcn_exp2f((__uint_as_float(key2u(k0[i] & ~0x3FFFu)) - mx) * LOG2E);
        sum += sv[i];
      }
      const float inv = 1.f / sum;
      const size_t po = ((size_t)(t0 + tok) * 8 + hd) * 16;
      if (hf == 0) {
#pragma unroll
        for (int q = 0; q < 4; ++q) *(u32x4*)(PIDX + po + 4 * q) = (u32x4){k0[4 * q] & 0x3FFFu, k0[4 * q + 1] & 0x3FFFu, k0[4 * q + 2] & 0x3FFFu, k0[4 * q + 3] & 0x3FFFu};
      } else {
#pragma unroll
        for (int q = 0; q < 4; ++q) *(f32x4*)(PG + po + 4 * q) = (f32x4){sv[4 * q] * inv, sv[4 * q + 1] * inv, sv[4 * q + 2] * inv, sv[4 * q + 3] * inv};
      }
    }
    __syncthreads();
  }
}

typedef int i32x8 __attribute__((ext_vector_type(8)));
__device__ __forceinline__ f32x4 mfma_fp4_fp8(u32x4 a, u32x4 b0, u32x4 b1, f32x4 c) {
  const i32x8 A = {(int)a.x, (int)a.y, (int)a.z, (int)a.w, 0, 0, 0, 0};
  const i32x8 B = {(int)b0.x, (int)b0.y, (int)b0.z, (int)b0.w, (int)b1.x, (int)b1.y, (int)b1.z, (int)b1.w};
  return __builtin_amdgcn_mfma_scale_f32_16x16x128_f8f6f4(A, B, c, 4, 0, 0, 0x7F7F7F7F, 0, 0x7F7F7F7F);
}
struct PeCtx {
  const unsigned char* U8; const float2* USV; LAS float* glist;
  LAS unsigned* list; int lane, r, g, s, n, t0;
};
__device__ __forceinline__ void pe_rows(const PeCtx& c, int ci, u32x4 (&a)[8]) {
  const int idx = ci * 16 + (c.lane >> 2);
  const unsigned ent = c.list[idx & 2047];
  const unsigned e = (idx < c.n) ? ((ent >> 7) & 16383u) : (unsigned)(c.s << 11);
  const unsigned char* rp = c.U8 + (size_t)e * 512 + (c.lane & 3) * 16;
#pragma unroll
  for (int ks = 0; ks < 8; ++ks) a[ks] = *(const u32x4*)(rp + ks * 64);
}
__device__ __forceinline__ void pe_fix(const PeCtx& c, u32x4 (&a)[8]) {
  const int src = 4 * c.r + c.g;
#pragma unroll
  for (int ks = 0; ks < 8; ++ks) {
    a[ks].x = (unsigned)__shfl((int)a[ks].x, src); a[ks].y = (unsigned)__shfl((int)a[ks].y, src);
    a[ks].z = (unsigned)__shfl((int)a[ks].z, src); a[ks].w = (unsigned)__shfl((int)a[ks].w, src);
  }
}
__device__ __forceinline__ void pe_chunk(const PeCtx& c, int ci, u32x4 (&a)[8], u32x4 (&anext)[8], const u32x4 (&bq)[16]) {
  const int idx = ci * 16 + c.r;
  const unsigned ent = c.list[idx & 2047];
  const bool fin = (c.lane < 16) && (idx < c.n);
  const unsigned e = (ent >> 7) & 16383u, col = (ent >> 21) & 15u;
  const float2 usv = c.USV[fin ? e : 0u];
  const float gt = c.glist[idx & 2047], us = usv.x, vs = usv.y;
  __builtin_amdgcn_sched_barrier(0);
  pe_rows(c, ci + 1, anext);
  __builtin_amdgcn_sched_barrier(0);
  pe_fix(c, a);
  f32x4 acc = {0.f, 0.f, 0.f, 0.f};
#pragma unroll
  for (int ks = 0; ks < 8; ++ks) acc = mfma_fp4_fp8(a[ks], bq[2 * ks], bq[2 * ks + 1], acc);
  const int src = ((c.r >> 2) << 4) | (int)col;
  const float v0 = __shfl(acc[0], src), v1 = __shfl(acc[1], src), v2 = __shfl(acc[2], src), v3 = __shfl(acc[3], src);
  float d = ((c.r & 3) == 0) ? v0 : ((c.r & 3) == 1) ? v1 : ((c.r & 3) == 2) ? v2 : v3;
  float gt_ = gt, us_ = us, vs_ = vs;
  asm volatile("" : "+v"(d), "+v"(gt_), "+v"(us_), "+v"(vs_));
  {
    const float act = d * us_ * (1.f / 16.f);
    const float w = gt_ * 0.5f * act * (1.f + erff(act * 0.70710678118654752f)) * vs_;
    if (fin) c.glist[idx & 2047] = w;
  }
}
#define PFV_LOAD(R, ev, k0)                                                                               \
  {                                                                                                       \
    _Pragma("unroll") for (int i_ = 0; i_ < 8; ++i_) {                                                    \
      const unsigned e_ = (unsigned)__builtin_amdgcn_ds_bpermute(bsel + 4 * ((k0) + 2 * i_), (int)(ev)); \
      R[i_] = *(const u32x4*)(V4 + (e_ << 9));                                                            \
    }                                                                                                     \
  }
#define PFV_FMA(dw, b, a) acc[a] = __builtin_elementwise_fma(__builtin_amdgcn_cvt_scalef32_pk_f32_fp4(dw, 1.0f, b), w2_, acc[a]);
#define PFV_ACC(R, wv, k0)                                                                                \
  {                                                                                                       \
    _Pragma("unroll") for (int i_ = 0; i_ < 8; ++i_) {                                                    \
      const float ws_ = __builtin_bit_cast(float, __builtin_amdgcn_ds_bpermute(bsel + 4 * ((k0) + 2 * i_), __builtin_bit_cast(int, (wv)))); \
      const f32x2 w2_ = {ws_, ws_};                                                                       \
      PFV_FMA(R[i_].x, 0, 0)  PFV_FMA(R[i_].x, 1, 1)  PFV_FMA(R[i_].x, 2, 2)  PFV_FMA(R[i_].x, 3, 3)      \
      PFV_FMA(R[i_].y, 0, 4)  PFV_FMA(R[i_].y, 1, 5)  PFV_FMA(R[i_].y, 2, 6)  PFV_FMA(R[i_].y, 3, 7)      \
      PFV_FMA(R[i_].z, 0, 8)  PFV_FMA(R[i_].z, 1, 9)  PFV_FMA(R[i_].z, 2, 10) PFV_FMA(R[i_].z, 3, 11)     \
      PFV_FMA(R[i_].w, 0, 12) PFV_FMA(R[i_].w, 1, 13) PFV_FMA(R[i_].w, 2, 14) PFV_FMA(R[i_].w, 3, 15)     \
    }                                                                                                     \
  }
__device__ void phase_peer_u(const Params& p, char* smem) {
  unsigned char* ws = p.ws;
  PeCtx c;
  c.U8 = ws + WS_U8; c.USV = (const float2*)(ws + WS_USV);
  const float* PG = (const float*)(ws + WS_PG);
  const bf16_t* HB = (const bf16_t*)(ws + WS_HB);
  const float* SSQ2 = (const float*)(ws + WS_SSQ2);
  const unsigned* PIDX = (const unsigned*)(ws + WS_PIDX);
  const int tidu = otid();
  const int lane = tidu & 63, wave = tidu >> 6;
  c.lane = lane; c.r = lane & 15; c.g = lane >> 4;
  c.list = (LAS unsigned*)(smem + wave * 8192);
  c.glist = (LAS float*)(smem + 65536 + wave * 8192);
  const bool hi = lane >= 32;
  const int bsel = hi ? 4 : 0;
  const unsigned char* V4 = ws + WS_V8 + (lane & 31) * 16;
  c.s = 0;
  {
    for (int grp = vblock() * NWAVES + wave; grp < T / 16; grp += gridDim.x * NWAVES) {
      const int t0 = grp * 16;
      c.t0 = t0;
      u32x4 bq[16];
      {
        const bf16_t* hp = HB + (size_t)(t0 + c.r) * 1024 + c.g * 16;
        const float rq = rsqrtf(SSQ2[t0 + c.r] * (1.f / 1024.f) + EPS) * 16.f;
#pragma unroll
        for (int kh = 0; kh < 16; ++kh) {
          const u32x4 h0 = *(const u32x4*)(hp + (kh >> 1) * 128 + (kh & 1) * 64), h1 = *(const u32x4*)(hp + (kh >> 1) * 128 + (kh & 1) * 64 + 8);
          u32x4 q;
#pragma unroll
          for (int i = 0; i < 4; ++i) {
            const unsigned lo = (i < 2) ? h0[2 * i] : h1[2 * i - 4], hi2 = (i < 2) ? h0[2 * i + 1] : h1[2 * i - 3];
            int w = 0;
            w = __builtin_amdgcn_cvt_pk_fp8_f32(bflo(lo) * rq, bfhi(lo) * rq, w, false);
            w = __builtin_amdgcn_cvt_pk_fp8_f32(bflo(hi2) * rq, bfhi(hi2) * rq, w, true);
            q[i] = (unsigned)w;
          }
          bq[kh] = q;
        }
      }
      const int n = 2048;
#pragma unroll
      for (int q = 0; q < 8; ++q) {
        const u32x4 idv = *(const u32x4*)(PIDX + (size_t)t0 * 128 + q * 256 + lane * 4);
        const f32x4 gv = *(const f32x4*)(PG + (size_t)t0 * 128 + q * 256 + lane * 4);
        const unsigned hi = (unsigned)(2 * q + (lane >> 5)) << 21, sl = (unsigned)((lane & 31) * 4);
        *(LAS u32x4*)(c.list + q * 256 + lane * 4) = (u32x4){hi | (idv.x << 7) | sl, hi | (idv.y << 7) | (sl + 1), hi | (idv.z << 7) | (sl + 2), hi | (idv.w << 7) | (sl + 3)};
        *(LAS f32x4*)(c.glist + q * 256 + lane * 4) = gv;
      }
      asm volatile("s_waitcnt lgkmcnt(0)" ::: "memory");
      c.n = n;
      const int nch = (n + 15) >> 4;
      u32x4 a0[8], a1[8];
      pe_rows(c, 0, a0);
      {
        unsigned z = 0u;
#pragma unroll
        for (int ks = 0; ks < 8; ++ks) z |= a0[ks].w;
        asm volatile("" ::"v"(z));
      }
      if (nch > 0) {
        for (int ci = 0;; ci += 2) {
          pe_chunk(c, ci, a0, a1, bq);
          if (ci + 1 >= nch) break;
          pe_chunk(c, ci + 1, a1, a0, bq);
          if (ci + 2 >= nch) break;
        }
      }
      asm volatile("s_waitcnt lgkmcnt(0)" ::: "memory");
      {
        unsigned e0 = (c.list[lane] >> 7) & 16383u, e1 = (c.list[64 + lane] >> 7) & 16383u;
        float w0 = c.glist[lane], w1 = c.glist[64 + lane];
        u32x4 RA[8], RB[8];
        PFV_LOAD(RA, e0, 0)
        {
          unsigned z = 0u;
#pragma unroll
          for (int i = 0; i < 8; ++i) z |= RA[i].w;
          asm volatile("" ::"v"(z));
        }
        for (int tk = 0; tk < 16; ++tk) {
          const int tn = tk < 15 ? tk + 1 : tk;
          const unsigned e0n = (c.list[tn * 128 + lane] >> 7) & 16383u, e1n = (c.list[tn * 128 + 64 + lane] >> 7) & 16383u;
          const float w0n = c.glist[tn * 128 + lane], w1n = c.glist[tn * 128 + 64 + lane];
          const size_t oo = (size_t)(t0 + tk) * 1024 + (lane & 31) * 32 + (hi ? 16 : 0);
          const u32x4 hb0 = *(const u32x4*)(HB + oo), hb1 = *(const u32x4*)(HB + oo + 8);
          f32x2 acc[16];
#pragma unroll
          for (int k = 0; k < 16; ++k) acc[k] = (f32x2){0.f, 0.f};
          __builtin_amdgcn_sched_barrier(0);
          PFV_LOAD(RB, e0, 16)  __builtin_amdgcn_sched_barrier(0);  PFV_ACC(RA, w0, 0)
          PFV_LOAD(RA, e0, 32)  __builtin_amdgcn_sched_barrier(0);  PFV_ACC(RB, w0, 16)
          PFV_LOAD(RB, e0, 48)  __builtin_amdgcn_sched_barrier(0);  PFV_ACC(RA, w0, 32)
          PFV_LOAD(RA, e1, 0)   __builtin_amdgcn_sched_barrier(0);  PFV_ACC(RB, w0, 48)
          PFV_LOAD(RB, e1, 16)  __builtin_amdgcn_sched_barrier(0);  PFV_ACC(RA, w1, 0)
          PFV_LOAD(RA, e1, 32)  __builtin_amdgcn_sched_barrier(0);  PFV_ACC(RB, w1, 16)
          PFV_LOAD(RB, e1, 48)  __builtin_amdgcn_sched_barrier(0);  PFV_ACC(RA, w1, 32)
          PFV_LOAD(RA, e0n, 0)  __builtin_amdgcn_sched_barrier(0);  PFV_ACC(RB, w1, 48)
          f32x2 r[8];
#pragma unroll
          for (int k = 0; k < 8; ++k) {
            const f32x2 keep = hi ? acc[8 + k] : acc[k], send = hi ? acc[k] : acc[8 + k];
            r[k] = keep + (f32x2){__shfl_xor(send.x, 32), __shfl_xor(send.y, 32)};
          }
          float* o = p.out + oo;
          *(f32x4*)(o)      = (f32x4){bflo(hb0.x) + r[0].x, bfhi(hb0.x) + r[0].y, bflo(hb0.y) + r[1].x, bfhi(hb0.y) + r[1].y};
          *(f32x4*)(o + 4)  = (f32x4){bflo(hb0.z) + r[2].x, bfhi(hb0.z) + r[2].y, bflo(hb0.w) + r[3].x, bfhi(hb0.w) + r[3].y};
          *(f32x4*)(o + 8)  = (f32x4){bflo(hb1.x) + r[4].x, bfhi(hb1.x) + r[4].y, bflo(hb1.y) + r[5].x, bfhi(hb1.y) + r[5].y};
          *(f32x4*)(o + 12) = (f32x4){bflo(hb1.z) + r[6].x, bfhi(hb1.z) + r[6].y, bflo(hb1.w) + r[7].x, bfhi(hb1.w) + r[7].y};
          e0 = e0n; e1 = e1n; w0 = w0n; w1 = w1n;
        }
      }
      asm volatile("" ::: "memory");
    }
  }
}
#undef PFV_LOAD
#undef PFV_FMA
#undef PFV_ACC


#define XB_TMO      128
#define XB_XCNT(j)  (256  + 64 * (j))
#define XB_XSUB(j)  (1280 + 64 * (j))
#define XB_XGEN(j)  (2304 + 64 * (j))
#define XB_TOP      3328
#define XB_TOPGEN   3392
#define XCD_BAR_WORDS 3456
#define XB_SPIN_CAP (1u << 22)
__device__ __forceinline__ unsigned xb_ld(unsigned* p)              { return __hip_atomic_load(p, __ATOMIC_RELAXED, __HIP_MEMORY_SCOPE_AGENT); }
__device__ __forceinline__ unsigned xb_add(unsigned* p, unsigned v) { return __hip_atomic_fetch_add(p, v, __ATOMIC_RELAXED, __HIP_MEMORY_SCOPE_AGENT); }
__device__ __forceinline__ unsigned xb_xcc_id() { return (unsigned)__builtin_amdgcn_s_getreg((3 << 11) | 20) & 0xFu; }
#define XB_SPIN(cond, bar) do { unsigned _sp = 0; while (cond) { __builtin_amdgcn_s_sleep(1); \
    if ((++_sp & 255u) == 0u) { if (xb_ld(&(bar)[XB_TMO])) break; if (_sp > XB_SPIN_CAP) { atomicAdd(&(bar)[XB_TMO], 1u); break; } } } } while (0)
struct XcdBarrier { unsigned* bar; unsigned x; volatile LAS unsigned* st; };
__device__ __forceinline__ XcdBarrier xcd_barrier_post(unsigned* bar, volatile LAS unsigned* st) {
    XcdBarrier b; b.bar = bar; b.x = xb_xcc_id(); b.st = st;
    if (threadIdx.x == 0) (void)xb_add(&bar[XB_XCNT(b.x)], 1u);
    return b;
}
__device__ __forceinline__ void xcd_barrier_complete(unsigned* bar, unsigned x, unsigned& nloc, unsigned& nx) {
    const unsigned G = gridDim.x * gridDim.y * gridDim.z;
    unsigned sum, cnt, mine, sp = 0u;
    for (;;) {
        sum = 0u; cnt = 0u; mine = 0u;
#pragma unroll
        for (unsigned j = 0; j < 16; ++j) { const unsigned c = xb_ld(&bar[XB_XCNT(j)]); sum += c; cnt += (c > 0u) ? 1u : 0u; mine = (j == x) ? c : mine; }
        if (sum == G) break;
        __builtin_amdgcn_s_sleep(1);
        if ((++sp & 255u) == 0u) { if (xb_ld(&bar[XB_TMO])) break; if (sp > XB_SPIN_CAP) { atomicAdd(&bar[XB_TMO], 1u); break; } }
    }
    nloc = mine > 0u ? mine : 1u; nx = cnt > 0u ? cnt : 1u;
}
__device__ __forceinline__ void xcd_barrier(const XcdBarrier& b) {
    asm volatile("s_waitcnt vmcnt(0)" ::: "memory");
    __syncthreads();
    if (threadIdx.x == 0) {
        unsigned* bar = b.bar;
        __builtin_amdgcn_s_waitcnt(0);
        unsigned nloc = b.st[0], nx = b.st[1];
        if (nloc == 0u) { xcd_barrier_complete(bar, b.x, nloc, nx); b.st[0] = nloc; b.st[1] = nx; }
        const unsigned old = xb_add(&bar[XB_XSUB(b.x)], 1u);
        const unsigned gen = old / nloc;
        if (old + 1u == (gen + 1u) * nloc) {
            __builtin_amdgcn_fence(__ATOMIC_RELEASE, "agent");
            asm volatile("s_waitcnt vmcnt(0)" ::: "memory");
            const unsigned og = xb_add(&bar[XB_TOP], 1u);
            const unsigned tg = og / nx;
            if (og + 1u == (tg + 1u) * nx) xb_add(&bar[XB_TOPGEN], 1u);
            else XB_SPIN(xb_ld(&bar[XB_TOPGEN]) == tg, bar);
            __builtin_amdgcn_fence(__ATOMIC_ACQUIRE, "agent");
            xb_add(&bar[XB_XGEN(b.x)], 1u);
            asm volatile("s_waitcnt vmcnt(0)" ::: "memory");
        } else {
            XB_SPIN(xb_ld(&bar[XB_XGEN(b.x)]) == gen, bar);
            __builtin_amdgcn_fence(__ATOMIC_ACQUIRE, "agent");
            asm volatile("s_waitcnt vmcnt(0)" ::: "memory");
        }
    }
    __syncthreads();
}

__global__ void __launch_bounds__(NTHREADS, 2) k_fused(Params p) {
  __shared__ __attribute__((aligned(16))) char smem[LDS_BYTES];
  if (threadIdx.x == 0) *(u32x4*)(smem + LDS_BAR) = (u32x4){0u, 0u, 0u, 0u};
  __syncthreads();
  const XcdBarrier bar = xcd_barrier_post((unsigned*)(p.ws + WS_CTL), (volatile LAS unsigned*)(smem + LDS_BAR));
#ifdef PROBE_PHASE
  unsigned long long ts[12];
#define STAMP(k) ts[k] = __builtin_amdgcn_s_memrealtime();
#else
#define STAMP(k)
#endif
  STAMP(0)
  phase_prep(p);
  xcd_barrier(bar);
  STAMP(1)
  phase_inproj(p, smem);
  xcd_barrier(bar);
  STAMP(2)
  phase_mix(p, smem);
  xcd_barrier(bar);
  STAMP(3)
  phase_outproj(p, smem);
  xcd_barrier(bar);
  STAMP(4)
  phase_qproj(p, smem);
  xcd_barrier(bar);
  STAMP(5)
  phase_route(p, smem);
  xcd_barrier(bar);
  STAMP(6)
  phase_peer_u(p, smem);
#ifdef PROBE_PHASE
  xcd_barrier(bar);
  STAMP(7)
  if (blockIdx.x == 0 && threadIdx.x == 0) {
    const float us = (float)(ts[PROBE_PHASE + 1] - ts[PROBE_PHASE]) * 0.01f;
    p.out[12345] += us * (1.f / PROBE_DIV);
  }
#endif
}

extern "C" void kernel_launch(void* const* d_in, const int* in_sizes, int n_in, void* d_out, int out_size, void* d_ws, size_t ws_size,
                              hipStream_t stream) {
  if (n_in != 17 || ws_size < WS_END) {
    fprintf(stderr, "kernel_launch: unexpected n_in %d / ws_size %zu\n", n_in, ws_size);
    return;
  }
  Params p{};
  p.x = (const float*)d_in[0]; p.norm_mix_g = (const float*)d_in[1]; p.w_in = (const float*)d_in[2]; p.q_norm_g = (const float*)d_in[3];
  p.k_norm_g = (const float*)d_in[4]; p.attn_out_g = (const float*)d_in[5]; p.conv_w = (const float*)d_in[6]; p.conv_b = (const float*)d_in[7];
  p.conv_ln_g = (const float*)d_in[8]; p.conv_ln_b = (const float*)d_in[9]; p.w_out = (const float*)d_in[10]; p.norm_ffn_g = (const float*)d_in[11];
  p.peer_wq = (const float*)d_in[12]; p.peer_k1 = (const float*)d_in[13]; p.peer_k2 = (const float*)d_in[14]; p.peer_u = (const float*)d_in[15];
  p.peer_v = (const float*)d_in[16];
  p.out = (float*)d_out;
  p.ws = (unsigned char*)d_ws;
  static int grid_blocks = 0;
  if (!grid_blocks) {
    int dev = 0, cus = 0, per_cu = 0;
    (void)hipGetDevice(&dev);
    (void)hipDeviceGetAttribute(&cus, hipDeviceAttributeMultiprocessorCount, dev);
    (void)hipOccupancyMaxActiveBlocksPerMultiprocessor(&per_cu, k_fused, NTHREADS, 0);
    if (per_cu > 1) per_cu = 1;
    if (per_cu < 1) per_cu = 1;
    grid_blocks = cus * per_cu;
  }
  (void)hipMemsetAsync((char*)d_ws + WS_CTL, 0, XCD_BAR_WORDS * 4, stream);
  hipLaunchKernelGGL(k_fused, dim3(grid_blocks), dim3(NTHREADS), 0, stream, p);
}
```

```cpp
#include <hip/hip_runtime.h>
#include <cstdio>

#define LAS __attribute__((address_space(3)))
typedef unsigned short bf16_t;
typedef __bf16 bf16x8 __attribute__((ext_vector_type(8)));
typedef __bf16 bf16x2 __attribute__((ext_vector_type(2)));
typedef float f32x4 __attribute__((ext_vector_type(4)));
typedef float f32x16 __attribute__((ext_vector_type(16)));
typedef unsigned u32x4 __attribute__((ext_vector_type(4)));
typedef unsigned u32x2 __attribute__((ext_vector_type(2)));
typedef float f32x2 __attribute__((ext_vector_type(2)));

constexpr int SEQ = 4096, T = 8 * SEQ, D = 1024, NIN = 2560;
constexpr float EPS = 1e-6f;
constexpr float LOG2E = 1.4426950408889634f;

constexpr size_t MiB = 1u << 20;
constexpr size_t WS_W1 = 0, WS_WV = 4 * MiB, WS_WOUT = 5 * MiB, WS_WQ = 7 * MiB, WS_K1 = 9 * MiB, WS_K2 = 9 * MiB + 131072, WS_SSQ = 10 * MiB;
constexpr size_t WS_CTL = 11 * MiB;
constexpr size_t WS_USV = 11 * MiB + 65536;
constexpr size_t WS_RS1 = 11 * MiB + 196608, WS_SSQ2 = 11 * MiB + 327680;
constexpr size_t WS_U8 = 12 * MiB, WS_V8 = 28 * MiB;
constexpr size_t WS_XB = 44 * MiB;
constexpr size_t WS_Q = 108 * MiB, WS_K = 140 * MiB, WS_VT = 172 * MiB, WS_HG = 204 * MiB, WS_MIX = 236 * MiB;
constexpr size_t WS_HB = 300 * MiB, WS_QH = 364 * MiB;
constexpr size_t WS_XN8 = 108 * MiB, WS_PIDX = 140 * MiB, WS_PG = 156 * MiB, WS_PW = 172 * MiB;
constexpr size_t WS_END = 428 * MiB;

struct Params {
  const float *x, *norm_mix_g, *w_in, *q_norm_g, *k_norm_g, *attn_out_g, *conv_w, *conv_b, *conv_ln_g, *conv_ln_b,
      *w_out, *norm_ffn_g, *peer_wq, *peer_k1, *peer_k2, *peer_u, *peer_v;
  float* out;
  unsigned char* ws;
};

constexpr int NTHREADS = 512, NWAVES = 8;
constexpr int LDS_STAGE = 131072, LDS_BAR = LDS_STAGE, LDS_BYTES = LDS_STAGE + 16;

__device__ __forceinline__ unsigned pk2(float lo, float hi) {
  bf16x2 v = {(__bf16)lo, (__bf16)hi};
  return __builtin_bit_cast(unsigned, v);
}
__device__ __forceinline__ float bflo(unsigned u) { return __uint_as_float(u << 16); }
__device__ __forceinline__ float bfhi(unsigned u) { return __uint_as_float(u & 0xffff0000u); }
__device__ __forceinline__ int otid() { int t = threadIdx.x; asm volatile("" : "+v"(t)); return t; }
__device__ __forceinline__ int vblock() {
  const int G = gridDim.x, b = blockIdx.x;
  return (G % 8 == 0) ? (b % 8) * (G / 8) + b / 8 : b;
}
__device__ __forceinline__ f32x16 mfma32(bf16x8 a, bf16x8 b, f32x16 c) { return __builtin_amdgcn_mfma_f32_32x32x16_bf16(a, b, c, 0, 0, 0); }

__device__ __forceinline__ int w1_src(int n) {
  if (n < 1024) {
    const int kind = n >> 9, rel = n & 511, pn = rel >> 8, P = rel & 255, bj = P >> 7, wc = (P >> 5) & 3, x = P & 31;
    return kind * 512 + (4 * pn + wc) * 64 + 32 * bj + x;
  }
  const int rel = n - 1024, pn = rel >> 8, P = rel & 255, bj = P >> 7, wc = (P >> 5) & 3, x = P & 31;
  return (bj ? 2048 : 1536) + 128 * pn + 32 * wc + x;
}
__device__ __forceinline__ void transpose_items(const float* __restrict__ W, int ldw, int N, bf16_t* __restrict__ Wt, const float* __restrict__ g, int glimit,
                                                int mode, long gtid, long nthr) {
  const long nitems = (long)N * 128;
  for (long it = gtid; it < nitems; it += nthr) {
    const int n = (int)(it % N), kc = (int)(it / N);
    const int src = mode == 1 ? w1_src(n) : (mode == 2 ? 1024 + n : n);
    float v[8];
#pragma unroll
    for (int i = 0; i < 8; ++i) {
      const int k = kc * 8 + i;
      float w = W[(size_t)k * ldw + src];
      if (k < glimit) w *= g[k];
      v[i] = w;
    }
    u32x4 o = {pk2(v[0], v[1]), pk2(v[2], v[3]), pk2(v[4], v[5]), pk2(v[6], v[7])};
    *(u32x4*)(Wt + (size_t)n * 1024 + kc * 8) = o;
  }
}
__device__ __forceinline__ void convert_items(const float* __restrict__ src, bf16_t* __restrict__ dst, long n8, long gtid, long nthr) {
  for (long it = gtid; it < n8; it += nthr) {
    const f32x4 a = *(const f32x4*)(src + it * 8), b = *(const f32x4*)(src + it * 8 + 4);
    u32x4 o = {pk2(a.x, a.y), pk2(a.z, a.w), pk2(b.x, b.y), pk2(b.z, b.w)};
    *(u32x4*)(dst + it * 8) = o;
  }
}
__device__ void phase_prep(const Params& p) {
  const int tid0 = otid();
  const long gtid = (long)vblock() * NTHREADS + tid0, nthr = (long)gridDim.x * NTHREADS;
  unsigned char* ws = p.ws;
  transpose_items(p.w_in, NIN, 2048, (bf16_t*)(ws + WS_W1), p.norm_mix_g, 1024, 1, gtid, nthr);
  transpose_items(p.w_in, NIN, 512, (bf16_t*)(ws + WS_WV), p.norm_mix_g, 1024, 2, gtid, nthr);
  transpose_items(p.w_out, D, D, (bf16_t*)(ws + WS_WOUT), p.attn_out_g, 512, 0, gtid, nthr);
  transpose_items(p.peer_wq, D, D, (bf16_t*)(ws + WS_WQ), p.norm_ffn_g, 1024, 0, gtid, nthr);
  convert_items(p.peer_k1, (bf16_t*)(ws + WS_K1), 65536 / 8, gtid, nthr);
  convert_items(p.peer_k2, (bf16_t*)(ws + WS_K2), 65536 / 8, gtid, nthr);
  const int lane = tid0 & 63, gw = vblock() * NWAVES + (tid0 >> 6), nw = gridDim.x * NWAVES;
  {
    bf16_t* XB = (bf16_t*)(ws + WS_XB);
    float* RS1 = (float*)(ws + WS_RS1);
    float* SSQ2 = (float*)(ws + WS_SSQ2);
    for (int tb = gw; tb < T; tb += 2 * nw) {
      f32x4 v[2][4];
      float ss[2] = {0.f, 0.f};
#pragma unroll
      for (int u = 0; u < 2; ++u) {
        const int t = (tb + u * nw < T) ? tb + u * nw : tb;
        const float* src = p.x + (size_t)t * 1024 + lane * 4;
#pragma unroll
        for (int i = 0; i < 4; ++i) v[u][i] = *(const f32x4*)(src + 256 * i);
      }
#pragma unroll
      for (int u = 0; u < 2; ++u) {
#pragma unroll
        for (int i = 0; i < 4; ++i) ss[u] += v[u][i].x * v[u][i].x + v[u][i].y * v[u][i].y + v[u][i].z * v[u][i].z + v[u][i].w * v[u][i].w;
      }
#pragma unroll
      for (int o = 1; o < 64; o <<= 1) { ss[0] += __shfl_xor(ss[0], o); ss[1] += __shfl_xor(ss[1], o); }
#pragma unroll
      for (int u = 0; u < 2; ++u) {
        const int t = tb + u * nw;
        if (t < T) {
#pragma unroll
          for (int i = 0; i < 4; ++i) *(u32x2*)(XB + (size_t)t * 1024 + lane * 4 + 256 * i) = (u32x2){pk2(v[u][i].x, v[u][i].y), pk2(v[u][i].z, v[u][i].w)};
          if (lane == 0) { RS1[t] = rsqrtf(ss[u] * (1.f / 1024.f) + EPS); SSQ2[t] = 0.f; }
        }
      }
    }
  }
}

__device__ void prep_tables(const Params& p) {
  unsigned char* ws = p.ws;
  const int tid0 = otid();
  const int lane = tid0 & 63, gw = vblock() * NWAVES + (tid0 >> 6), nw = gridDim.x * NWAVES;
  {
    f32x4 gn[4];
#pragma unroll
    for (int i = 0; i < 4; ++i) gn[i] = *(const f32x4*)(p.norm_ffn_g + lane * 16 + 4 * i);
    for (int rb = gw; rb < 32768; rb += 2 * nw) {
      f32x4 v[2][4];
#pragma unroll
      for (int u = 0; u < 2; ++u) {
        const int r = (rb + u * nw < 32768) ? rb + u * nw : rb;
        const float* src = ((r >> 14) ? p.peer_v : p.peer_u) + (size_t)(r & 16383) * 1024 + lane * 16;
#pragma unroll
        for (int i = 0; i < 4; ++i) v[u][i] = *(const f32x4*)(src + 4 * i);
        if (!(r >> 14)) {
#pragma unroll
          for (int i = 0; i < 4; ++i) v[u][i] *= gn[i];
        }
      }
      float am[2] = {0.f, 0.f};
#pragma unroll
      for (int u = 0; u < 2; ++u)
#pragma unroll
        for (int i = 0; i < 4; ++i)
          am[u] = fmaxf(am[u], fmaxf(fmaxf(fabsf(v[u][i].x), fabsf(v[u][i].y)), fmaxf(fabsf(v[u][i].z), fabsf(v[u][i].w))));
#pragma unroll
      for (int o = 1; o < 64; o <<= 1) { am[0] = fmaxf(am[0], __shfl_xor(am[0], o)); am[1] = fmaxf(am[1], __shfl_xor(am[1], o)); }
#pragma unroll
      for (int u = 0; u < 2; ++u) {
        const int r = rb + u * nw;
        if (r < 32768) {
          const int isv = r >> 14, e = r & 16383;
          const float scale = am[u] > 0.f ? am[u] * (1.f / 6.f) : 1.f, inv = am[u] > 0.f ? 6.f / am[u] : 0.f;
          unsigned q[2] = {0u, 0u};
#pragma unroll
          for (int i = 0; i < 4; ++i)
#pragma unroll
            for (int j = 0; j < 4; ++j) {
              const float xv = v[u][i][j], m = fabsf(xv) * inv;
              const unsigned code = (unsigned)(m > 0.25f) + (unsigned)(m > 0.75f) + (unsigned)(m > 1.25f) + (unsigned)(m > 1.75f) +
                                    (unsigned)(m > 2.5f) + (unsigned)(m > 3.5f) + (unsigned)(m > 5.0f);
              const unsigned nib = code | (xv < 0.f ? 8u : 0u);
              const int el = 4 * i + j;
              q[el >> 3] |= nib << (4 * (el & 7));
            }
          if (isv) {
            *(u32x2*)(ws + WS_V8 + (size_t)e * 512 + lane * 8) = (u32x2){q[0], q[1]};
            if (lane == 0) ((float*)(ws + WS_USV))[2 * e + 1] = scale;
          } else {
            *(u32x2*)(ws + WS_U8 + (size_t)e * 512 + lane * 8) = (u32x2){q[0], q[1]};
            if (lane == 0) ((float*)(ws + WS_USV))[2 * e] = scale;
          }
        }
      }
    }
  }
}

namespace pg8 {
typedef short sbf16x8 __attribute__((ext_vector_type(8)));
constexpr int BM = 256, BK = 64, HALF = 128, HTB = HALF * BK * 2  , NXCD = 8, WGM = 8;
__device__ __forceinline__ int lds_byte(int r, int c) { const int st = (r >> 4) * 2 + (c >> 5), rr = r & 15, cc = c & 31, ob = rr * 64 + cc * 2; return st * 1024 + (ob ^ (((ob >> 9) & 1) << 5)); }
__device__ __forceinline__ void stage_rc(int b, int& R, int& C) { const int st = b / 1024, sb = b % 1024, swz = sb ^ (((sb >> 9) & 1) << 5); R = (st >> 1) * 16 + swz / 64; C = (st & 1) * 32 + (swz % 64) / 2; }
__device__ __forceinline__ int perm32(int rho) { const int n = rho >> 4, i = rho & 15; return 8 * (i >> 2) + 4 * n + (i & 3); }
struct Unit { int pm, pn; };
struct Gemm { const bf16_t* A; const bf16_t* Bt; int M, N, K; };
struct StaticOrder {
    int nM, nN, nwg, G, c;
    __device__ void init(int M, int N, int G_, int c_) { nM = M / BM; nN = N / BM; nwg = nM * nN; G = G_; c = c_; }
    __device__ bool next(int i, Unit& u) const {
        const long L = (long)i * G + c; if (L >= nwg) return false;
        int wgid = (int)L; { const int q = nwg / NXCD, r = nwg % NXCD, xcd = wgid % NXCD, off = wgid / NXCD; wgid = (xcd < r ? xcd * (q + 1) : r * (q + 1) + (xcd - r) * q) + off; }
        const int nig = WGM * nN, gid = wgid / nig, fm = gid * WGM, gsz = (nM - fm) < WGM ? (nM - fm) : WGM;
        u.pm = fm + ((wgid % nig) % gsz); u.pn = (wgid % nig) / gsz; return true;
    }
};
template <class Epi>
__device__ __forceinline__ void gemm_phase(LAS unsigned char* lds, const Gemm g, const StaticOrder& S, const Epi& E) {
    const int tid = otid(), wid = __builtin_amdgcn_readfirstlane(tid >> 6), lane = tid & 63, wr = wid >> 2, wc = wid & 3, fr = lane & 15, fq = lane >> 4;
    const int K = g.K, nt = K / BK;
    unsigned voffA[2], voffB[2];
#pragma unroll
    for (int i = 0; i < 2; ++i) { int R, C; stage_rc(tid * 16 + i * 8192, R, C); const int Rb = Epi::PERM ? ((R & ~31) + perm32(R & 31)) : R;
        voffA[i] = (unsigned)(R * K + C) * 2u; voffB[i] = (unsigned)(Rb * K + C) * 2u; }
    const size_t kstep = (size_t)(BK * 2);
    const size_t hstep = (size_t)HALF * K * 2;
    const size_t tstep = 2 * hstep;
    const unsigned ldsw = (unsigned)wid * 1024u;
    const int aoff = lds_byte(wr * 64 + fr, fq * 8), boff = lds_byte(wc * 32 + fr, fq * 8);
#define PG8_SA(b, h) (((b) * 2 + (h)) * HTB)
#define PG8_SB(b, h) ((4 + (b) * 2 + (h)) * HTB)
#define PG8_STAGE(bufoff, gbase, voff) do { _Pragma("unroll") for (int _i = 0; _i < 2; ++_i) \
        __builtin_amdgcn_global_load_lds((const unsigned*)((const char*)(gbase) + (voff)[_i]), (LAS unsigned*)(lds + (bufoff) + ldsw + _i * 8192), 16, 0, 0); } while (0)
#define PG8_LDA(dst, b, h) do { _Pragma("unroll") for (int m = 0; m < 4; ++m) _Pragma("unroll") for (int k = 0; k < 2; ++k) dst[m][k] = *(const LAS sbf16x8*)(lds + PG8_SA(b, h) + aoff + m * 2048 + k * 1024); } while (0)
#define PG8_LDB(dst, b, h) do { _Pragma("unroll") for (int n = 0; n < 2; ++n) _Pragma("unroll") for (int k = 0; k < 2; ++k) dst[n][k] = *(const LAS sbf16x8*)(lds + PG8_SB(b, h) + boff + n * 2048 + k * 1024); } while (0)
#define PG8_MMA(ai, bj, At, Bt) do { __builtin_amdgcn_s_setprio(1); _Pragma("unroll") for (int m = 0; m < 4; ++m) _Pragma("unroll") for (int n = 0; n < 2; ++n) _Pragma("unroll") for (int k = 0; k < 2; ++k) \
        acc[ai][bj][m][n] = __builtin_amdgcn_mfma_f32_16x16x32_bf16(__builtin_bit_cast(bf16x8, Bt[n][k]), __builtin_bit_cast(bf16x8, At[m][k]), acc[ai][bj][m][n], 0, 0, 0); __builtin_amdgcn_s_setprio(0); } while (0)
#define PG8_WAIT_V(n) asm volatile("s_waitcnt vmcnt(" #n ")" ::: "memory")
#define PG8_WAIT_L(n) asm volatile("s_waitcnt lgkmcnt(" #n ")" ::: "memory")
#define PG8_BAR __builtin_amdgcn_s_barrier()
#define PG8_SCHED __builtin_amdgcn_sched_barrier(0)
    Unit cur, nxt; int ui = 0;
    if (!S.next(0, cur)) return;
    f32x4 acc[2][2][4][2];
#pragma unroll
    for (int a = 0; a < 2; ++a)
#pragma unroll
        for (int b = 0; b < 2; ++b)
#pragma unroll
            for (int m = 0; m < 4; ++m)
#pragma unroll
                for (int n = 0; n < 2; ++n) acc[a][b][m][n] = (f32x4){0.f, 0.f, 0.f, 0.f};
    sbf16x8 At[4][2], B0[2][2], B1[2][2];
    const char* cA = (const char*)g.A + (size_t)cur.pm * tstep; const char* cB = (const char*)g.Bt + (size_t)cur.pn * tstep;
    PG8_STAGE(PG8_SB(0, 0), cB, voffB); PG8_STAGE(PG8_SA(0, 0), cA, voffA); PG8_STAGE(PG8_SB(0, 1), cB + hstep, voffB); PG8_STAGE(PG8_SA(0, 1), cA + hstep, voffA);
    if (wr == 1) PG8_BAR;
    PG8_WAIT_V(4); PG8_BAR;
    PG8_STAGE(PG8_SB(1, 0), cB + kstep, voffB); PG8_STAGE(PG8_SA(1, 0), cA + kstep, voffA); PG8_STAGE(PG8_SB(1, 1), cB + hstep + kstep, voffB);
    PG8_WAIT_V(6); PG8_BAR;
    for (;;) {
        const bool has_next = S.next(ui + 1, nxt);
        const char* nA = has_next ? (const char*)g.A + (size_t)nxt.pm * tstep : cA; const char* nB = has_next ? (const char*)g.Bt + (size_t)nxt.pn * tstep : cB;
        for (int t = 0; t < nt; t += 2) {
            const bool last = (t == nt - 2);
            const char* a1 = cA + (size_t)(t + 1) * kstep;
            const char* a2 = last ? nA : cA + (size_t)(t + 2) * kstep; const char* b2 = last ? nB : cB + (size_t)(t + 2) * kstep;
            const char* a3 = a2 + kstep; const char* b3 = b2 + kstep;
            PG8_LDB(B0, 0, 0); PG8_SCHED; PG8_LDA(At, 0, 0); PG8_STAGE(PG8_SA(1, 1), a1 + hstep, voffA);
            PG8_WAIT_L(8); PG8_BAR; PG8_WAIT_L(0); PG8_MMA(0, 0, At, B0); PG8_BAR; PG8_SCHED;
            PG8_LDB(B1, 0, 1); PG8_STAGE(PG8_SB(0, 0), b2, voffB);
            PG8_BAR; PG8_WAIT_L(0); PG8_MMA(0, 1, At, B1); PG8_BAR;
            PG8_LDA(At, 0, 1); PG8_STAGE(PG8_SA(0, 0), a2, voffA);
            PG8_BAR; PG8_WAIT_L(0); PG8_MMA(1, 0, At, B0); PG8_BAR; PG8_SCHED;
            PG8_STAGE(PG8_SB(0, 1), b2 + hstep, voffB);
            PG8_WAIT_V(6); PG8_BAR; PG8_MMA(1, 1, At, B1); PG8_BAR;
            PG8_LDB(B0, 1, 0); PG8_SCHED; PG8_LDA(At, 1, 0); PG8_STAGE(PG8_SA(0, 1), a2 + hstep, voffA);
            PG8_WAIT_L(8); PG8_BAR; PG8_WAIT_L(0); PG8_MMA(0, 0, At, B0); PG8_BAR; PG8_SCHED;
            PG8_LDB(B1, 1, 1); PG8_STAGE(PG8_SB(1, 0), b3, voffB);
            PG8_BAR; PG8_WAIT_L(0); PG8_MMA(0, 1, At, B1); PG8_BAR;
            PG8_LDA(At, 1, 1); PG8_STAGE(PG8_SA(1, 0), a3, voffA);
            PG8_BAR; PG8_WAIT_L(0); PG8_MMA(1, 0, At, B0); PG8_BAR; PG8_SCHED;
            PG8_STAGE(PG8_SB(1, 1), b3 + hstep, voffB);
            PG8_WAIT_V(6); PG8_BAR; PG8_MMA(1, 1, At, B1); PG8_BAR;
        }
        E(acc, cur, wr, wc, fr, fq);
        if (!has_next) break;
#pragma unroll
        for (int a = 0; a < 2; ++a)
#pragma unroll
            for (int b = 0; b < 2; ++b)
#pragma unroll
                for (int m = 0; m < 4; ++m)
#pragma unroll
                    for (int n = 0; n < 2; ++n) acc[a][b][m][n] = (f32x4){0.f, 0.f, 0.f, 0.f};
        cur = nxt; cA = nA; cB = nB; ++ui;
    }
    PG8_WAIT_V(0);
    if (wr == 0) PG8_BAR;
    PG8_BAR;
#undef PG8_SA
#undef PG8_SB
#undef PG8_STAGE
#undef PG8_LDA
#undef PG8_LDB
#undef PG8_MMA
#undef PG8_WAIT_V
#undef PG8_WAIT_L
#undef PG8_BAR
#undef PG8_SCHED
}
}

struct EpiQKC {
  static constexpr bool PERM = true;
  const float* rs1; const float* qg; const float* kg; bf16_t* Q; bf16_t* Kk; bf16_t* HG;
  __device__ __forceinline__ void operator()(const f32x4 (&acc)[2][2][4][2], const pg8::Unit& u, int wr, int wc, int fr, int fq) const {
    const int row0 = u.pm * 256 + wr * 64 + fr;
    if (u.pn < 4) {
      const bool isq = u.pn < 2;
      const int head = 4 * (u.pn & 1) + wc;
      const float* g = isq ? qg : kg;
      f32x4 gv[2][2];
#pragma unroll
      for (int bj = 0; bj < 2; ++bj)
#pragma unroll
        for (int n = 0; n < 2; ++n) gv[bj][n] = *(const f32x4*)(g + 32 * bj + 8 * fq + 4 * n);
      bf16_t* base = isq ? Q : Kk;
#pragma unroll
      for (int ai = 0; ai < 2; ++ai)
#pragma unroll
        for (int m = 0; m < 4; ++m) {
          const int t = row0 + ai * 128 + m * 16;
          float ss = 0.f;
#pragma unroll
          for (int bj = 0; bj < 2; ++bj)
#pragma unroll
            for (int n = 0; n < 2; ++n) { const f32x4 v = acc[ai][bj][m][n]; ss += v.x * v.x + v.y * v.y + v.z * v.z + v.w * v.w; }
          ss += __shfl_xor(ss, 16);
          ss += __shfl_xor(ss, 32);
          const float r = rs1[t];
          float sc = r * rsqrtf(r * r * ss * (1.f / 64.f) + EPS);
          if (isq) sc *= 0.125f * LOG2E;
          const size_t bh = (size_t)((t >> 12) * 8 + head);
          const int pos = t & 4095;
          bf16_t* dst = isq ? base + (bh * 4096 + pos) * 64 + 8 * fq
                            : base + (bh * 4096 + (pos & ~31)) * 64 + ((((fq >> 1) * 2 + (fq & 1)) * 32) + (pos & 31)) * 8;
#pragma unroll
          for (int bj = 0; bj < 2; ++bj) {
            const f32x4 a = acc[ai][bj][m][0] * gv[bj][0] * sc, b = acc[ai][bj][m][1] * gv[bj][1] * sc;
            *(u32x4*)(dst + (isq ? 32 * bj : 1024 * bj)) = (u32x4){pk2(a.x, a.y), pk2(a.z, a.w), pk2(b.x, b.y), pk2(b.z, b.w)};
          }
        }
    } else {
      const int ch0 = 128 * (u.pn - 4) + 32 * wc + 8 * fq;
#pragma unroll
      for (int ai = 0; ai < 2; ++ai)
#pragma unroll
        for (int m = 0; m < 4; ++m) {
          const int t = row0 + ai * 128 + m * 16;
          const float r = rs1[t];
          float h[8];
#pragma unroll
          for (int n = 0; n < 2; ++n)
#pragma unroll
            for (int j = 0; j < 4; ++j) h[4 * n + j] = acc[ai][0][m][n][j] * r / (1.f + __expf(-acc[ai][1][m][n][j] * r));
          *(u32x4*)(HG + (size_t)t * 512 + ch0) = (u32x4){pk2(h[0], h[1]), pk2(h[2], h[3]), pk2(h[4], h[5]), pk2(h[6], h[7])};
        }
    }
  }
};
struct EpiVt {
  static constexpr bool PERM = false;
  const float* rs1; bf16_t* Vt;
  __device__ __forceinline__ void operator()(const f32x4 (&acc)[2][2][4][2], const pg8::Unit& u, int wr, int wc, int fr, int fq) const {
    const int pos0 = 8 * (fq & 1) + 4 * (fq >> 1);
#pragma unroll
    for (int bj = 0; bj < 2; ++bj)
#pragma unroll
      for (int n = 0; n < 2; ++n) {
        const int t = u.pn * 256 + bj * 128 + wc * 32 + n * 16 + 4 * fq;
        const f32x4 r = *(const f32x4*)(rs1 + t);
        const size_t tb = ((size_t)(t >> 12) * 8) * 128 + ((t & 4095) >> 5);
#pragma unroll
        for (int ai = 0; ai < 2; ++ai)
#pragma unroll
          for (int m = 0; m < 4; ++m) {
            const int dg = u.pm * 256 + ai * 128 + wr * 64 + m * 16 + fr, head = dg >> 6, d = dg & 63;
            const f32x4 v = acc[ai][bj][m][n] * r;
            *(u32x2*)(Vt + (tb + (size_t)head * 128) * 2048 + (((((d >> 5) * 2 + n) * 2 + (fq & 1)) * 32) + (d & 31)) * 8 + 4 * (fq >> 1)) = (u32x2){pk2(v.x, v.y), pk2(v.z, v.w)};
          }
      }
  }
};
struct EpiOut {
  static constexpr bool PERM = false;
  const bf16_t* xb; bf16_t* HB; float* ssq2;
  __device__ __forceinline__ void operator()(const f32x4 (&acc)[2][2][4][2], const pg8::Unit& u, int wr, int wc, int fr, int fq) const {
    const int row0 = u.pm * 256 + wr * 64 + fr, col0 = u.pn * 256 + wc * 32 + 4 * fq;
#pragma unroll
    for (int ai = 0; ai < 2; ++ai)
#pragma unroll
      for (int m = 0; m < 4; ++m) {
        const int t = row0 + ai * 128 + m * 16;
        const size_t ro = (size_t)t * 1024 + col0;
        float ss = 0.f;
#pragma unroll
        for (int bj = 0; bj < 2; ++bj)
#pragma unroll
          for (int n = 0; n < 2; ++n) {
            const size_t o = ro + bj * 128 + n * 16;
            const u32x2 xv = *(const u32x2*)(xb + o);
            const f32x4 h = (f32x4){bflo(xv.x), bfhi(xv.x), bflo(xv.y), bfhi(xv.y)} + acc[ai][bj][m][n];
            *(u32x2*)(HB + o) = (u32x2){pk2(h.x, h.y), pk2(h.z, h.w)};
            ss += h.x * h.x + h.y * h.y + h.z * h.z + h.w * h.w;
          }
        ss += __shfl_xor(ss, 16);
        ss += __shfl_xor(ss, 32);
        if (fq == 0) atomicAdd(ssq2 + t, ss);
      }
  }
};
struct EpiQh {
  static constexpr bool PERM = true;
  const float* ssq2; bf16_t* QH;
  __device__ __forceinline__ void operator()(const f32x4 (&acc)[2][2][4][2], const pg8::Unit& u, int wr, int wc, int fr, int fq) const {
    const int row0 = u.pm * 256 + wr * 64 + fr, col0 = u.pn * 256 + wc * 32 + 8 * fq;
#pragma unroll
    for (int ai = 0; ai < 2; ++ai)
#pragma unroll
      for (int m = 0; m < 4; ++m) {
        const int t = row0 + ai * 128 + m * 16;
        const float r = rsqrtf(ssq2[t] * (1.f / 1024.f) + EPS);
#pragma unroll
        for (int bj = 0; bj < 2; ++bj) {
          const f32x4 a = acc[ai][bj][m][0] * r, b = acc[ai][bj][m][1] * r;
          *(u32x4*)(QH + (size_t)t * 1024 + col0 + bj * 128) = (u32x4){pk2(a.x, a.y), pk2(a.z, a.w), pk2(b.x, b.y), pk2(b.z, b.w)};
        }
      }
  }
};

__device__ void phase_inproj(const Params& p, char* smem) {
  unsigned char* ws = p.ws;
  LAS unsigned char* lds = (LAS unsigned char*)smem;
  const bf16_t* XB = (const bf16_t*)(ws + WS_XB);
  const float* RS1 = (const float*)(ws + WS_RS1);
  pg8::StaticOrder S;
  {
    pg8::Gemm g{XB, (const bf16_t*)(ws + WS_W1), T, 2048, 1024};
    S.init(T, 2048, gridDim.x, blockIdx.x);
    EpiQKC E{RS1, p.q_norm_g, p.k_norm_g, (bf16_t*)(ws + WS_Q), (bf16_t*)(ws + WS_K), (bf16_t*)(ws + WS_HG)};
    pg8::gemm_phase<EpiQKC>(lds, g, S, E);
  }
  {
    pg8::Gemm g{(const bf16_t*)(ws + WS_WV), XB, 512, T, 1024};
    S.init(512, T, gridDim.x, blockIdx.x);
    EpiVt E{RS1, (bf16_t*)(ws + WS_VT)};
    pg8::gemm_phase<EpiVt>(lds, g, S, E);
  }
}
__device__ void phase_outproj(const Params& p, char* smem) {
  unsigned char* ws = p.ws;
  pg8::Gemm g{(const bf16_t*)(ws + WS_MIX), (const bf16_t*)(ws + WS_WOUT), T, 1024, 1024};
  pg8::StaticOrder S;
  S.init(T, 1024, gridDim.x, blockIdx.x);
  EpiOut E{(const bf16_t*)(ws + WS_XB), (bf16_t*)(ws + WS_HB), (float*)(ws + WS_SSQ2)};
  pg8::gemm_phase<EpiOut>((LAS unsigned char*)smem, g, S, E);
}
__device__ void phase_qproj(const Params& p, char* smem) {
  unsigned char* ws = p.ws;
  pg8::Gemm g{(const bf16_t*)(ws + WS_HB), (const bf16_t*)(ws + WS_WQ), T, 1024, 1024};
  pg8::StaticOrder S;
  S.init(T, 1024, gridDim.x, blockIdx.x);
  EpiQh E{(const float*)(ws + WS_SSQ2), (bf16_t*)(ws + WS_QH)};
  pg8::gemm_phase<EpiQh>((LAS unsigned char*)smem, g, S, E);
}

__device__ __forceinline__ void conv_stage(const bf16_t* HG, int item, LAS unsigned char* buf, int wave, int lane) {
  const int t0 = item * 32, s0 = t0 & 4095;
#pragma unroll
  for (int j = 0; j < 8; ++j) {
    const int r = wave + 8 * j;
    if (r < 62) {
      if (s0 - 30 + r >= 0)
        __builtin_amdgcn_global_load_lds((const unsigned*)(HG + (size_t)(t0 - 30 + r) * 512 + lane * 8), (LAS unsigned*)(buf + r * 1024), 16, 0, 0);
      else
        *(LAS u32x4*)(buf + r * 1024 + lane * 16) = (u32x4){0u, 0u, 0u, 0u};
    }
  }
}
struct ConvW { f32x2 wv[31]; float2 cb, lg, lb; };
__device__ __forceinline__ void conv_compute(const Params& p, int item, const char* smem, const ConvW& W, int tid512) {
  bf16_t* MIX = (bf16_t*)(p.ws + WS_MIX);
  const int half = tid512 >> 8, tid = tid512 & 255, lane = tid & 63, wave = tid >> 6;
  const int t0 = item * 32;
  float* red = (float*)(smem + 62 * 1024) + half * 128;
  const bool b5 = lane & 32, b4 = lane & 16, b3 = lane & 8, b2 = lane & 4;
#pragma unroll 1
  for (int rd = 0; rd < 2; ++rd) {
    const int tb = 16 * half + 8 * rd;
    f32x2 xv[38];
#pragma unroll
    for (int r = 0; r < 38; ++r) {
      const unsigned v = *(const unsigned*)(smem + (tb + r) * 1024 + tid * 4);
      xv[r] = (f32x2){bflo(v), bfhi(v)};
    }
    float a0[8], a1[8], st[16];
#pragma unroll
    for (int k = 0; k < 8; ++k) {
      f32x2 u = {W.cb.x, W.cb.y};
#pragma unroll
      for (int j = 0; j < 31; ++j) u = __builtin_elementwise_fma(W.wv[j], xv[k + j], u);
      a0[k] = u.x; a1[k] = u.y;
      st[k] = u.x + u.y;
      st[8 + k] = u.x * u.x + u.y * u.y;
    }
    float r8[8], r4[4], r2[2], r1;
#pragma unroll
    for (int i = 0; i < 8; ++i) { const float keep = b5 ? st[8 + i] : st[i], send = b5 ? st[i] : st[8 + i]; r8[i] = keep + __shfl_xor(send, 32); }
#pragma unroll
    for (int i = 0; i < 4; ++i) { const float keep = b4 ? r8[4 + i] : r8[i], send = b4 ? r8[i] : r8[4 + i]; r4[i] = keep + __shfl_xor(send, 16); }
#pragma unroll
    for (int i = 0; i < 2; ++i) { const float keep = b3 ? r4[2 + i] : r4[i], send = b3 ? r4[i] : r4[2 + i]; r2[i] = keep + __shfl_xor(send, 8); }
    { const float keep = b2 ? r2[1] : r2[0], send = b2 ? r2[0] : r2[1]; r1 = keep + __shfl_xor(send, 4); }
    r1 += __shfl_xor(r1, 2);
    r1 += __shfl_xor(r1, 1);
    float* rr = red + rd * 64;
    if ((lane & 3) == 0) rr[wave * 16 + (lane >> 2)] = r1;
    __syncthreads();
#pragma unroll
    for (int k = 0; k < 8; ++k) {
      const float S1 = (rr[k] + rr[16 + k]) + (rr[32 + k] + rr[48 + k]);
      const float S2 = (rr[8 + k] + rr[24 + k]) + (rr[40 + k] + rr[56 + k]);
      const float mu = S1 * (1.f / 512.f);
      const float var = fmaxf(S2 * (1.f / 512.f) - mu * mu, 0.f);
      const float rstd = rsqrtf(var + EPS);
      const float y0 = (a0[k] - mu) * rstd * W.lg.x + W.lb.x, y1 = (a1[k] - mu) * rstd * W.lg.y + W.lb.y;
      const float z0 = y0 / (1.f + __expf(-y0)), z1 = y1 / (1.f + __expf(-y1));
      *(unsigned*)(MIX + (size_t)(t0 + tb + k) * 1024 + 512 + 2 * tid) = pk2(z0, z1);
    }
  }
}
__device__ void conv_items(const Params& p, char* smem) {
  const bf16_t* HG = (const bf16_t*)(p.ws + WS_HG);
  const int tid512 = otid(), tid = tid512 & 255, lane = tid512 & 63;
  const int wave = __builtin_amdgcn_readfirstlane(tid512 >> 6);
  const int vb = vblock(), G = gridDim.x;
  ConvW W;
#pragma unroll
  for (int j = 0; j < 31; ++j) {
    const float2 w = *(const float2*)(p.conv_w + j * 512 + 2 * tid);
    W.wv[j] = (f32x2){w.x, w.y};
  }
  W.cb = *(const float2*)(p.conv_b + 2 * tid);
  W.lg = *(const float2*)(p.conv_ln_g + 2 * tid);
  W.lb = *(const float2*)(p.conv_ln_b + 2 * tid);
  int b = 0;
  if (vb < 1024) conv_stage(HG, vb, (LAS unsigned char*)smem, wave, lane);
  for (int item = vb; item < 1024; item += G, b ^= 1) {
    asm volatile("s_waitcnt vmcnt(0) lgkmcnt(0)" ::: "memory");
    __syncthreads();
    if (item + G < 1024) conv_stage(HG, item + G, (LAS unsigned char*)smem + (b ^ 1) * 65536, wave, lane);
    conv_compute(p, item, smem + b * 65536, W, tid512);
  }
  __syncthreads();
}

struct AttnKV { bf16x8 k[4]; bf16x8 v[2][2]; };
__device__ __forceinline__ void attn_load(const bf16_t* Km, const bf16_t* Vt, int bh, int kb, int tok, int hf, AttnKV& f) {
  const int kc = kb < 0 ? 0 : kb;
  const bf16_t* kp = Km + ((size_t)bh * 128 + kc) * 2048 + (hf * 32 + tok) * 8;
#pragma unroll
  for (int ks = 0; ks < 4; ++ks) f.k[ks] = *(const bf16x8*)(kp + ks * 512);
  const bf16_t* vp = Vt + ((size_t)bh * 128 + kc) * 2048 + (hf * 32 + tok) * 8;
#pragma unroll
  for (int m = 0; m < 2; ++m)
#pragma unroll
    for (int s = 0; s < 2; ++s) f.v[m][s] = *(const bf16x8*)(vp + (m * 2 + s) * 512);
}
__device__ __forceinline__ bool attn_block(const AttnKV& f, const bf16x8 (&qf)[4], bool diag, int tok, int hf, float& c, f32x16& o0, f32x16& o1) {
  f32x16 sc;
#pragma unroll
  for (int i = 0; i < 16; ++i) sc[i] = 0.f;
#pragma unroll
  for (int ks = 0; ks < 4; ++ks) sc = mfma32(f.k[ks], qf[ks], sc);
  float kp[16], sg[16];
#pragma unroll
  for (int i = 0; i < 16; ++i) {
    const float e = __builtin_amdgcn_exp2f(fminf(sc[i], 80.f));
    const float r = __builtin_amdgcn_rcpf(1.f + e);
    kp[i] = r;
    sg[i] = e * r;
  }
  if (diag) {
#pragma unroll
    for (int i = 0; i < 16; ++i) {
      const bool valid = ((i & 3) + 8 * (i >> 2) + 4 * hf < tok);
      kp[i] = valid ? kp[i] : 1.f;
      sg[i] = valid ? sg[i] : 0.f;
    }
  }
  float Tg[4], Pg[4];
#pragma unroll
  for (int g = 0; g < 4; ++g) {
    Tg[g] = (kp[4 * g] * kp[4 * g + 1]) * (kp[4 * g + 2] * kp[4 * g + 3]);
    Pg[g] = __shfl_xor(Tg[g], 32);
  }
  float base[4];
  float run = __builtin_amdgcn_exp2f(c);
#pragma unroll
  for (int g = 3; g >= 0; --g) {
    base[g] = run * (hf == 0 ? Pg[g] : 1.f);
    run *= Tg[g] * Pg[g];
  }
  float pr[16];
#pragma unroll
  for (int g = 0; g < 4; ++g) {
    float l = base[g];
#pragma unroll
    for (int r = 3; r >= 0; --r) {
      pr[4 * g + r] = sg[4 * g + r] * l;
      l *= kp[4 * g + r];
    }
  }
  c = __builtin_amdgcn_logf(run);
  bf16x8 pf[2];
#pragma unroll
  for (int s = 0; s < 2; ++s)
#pragma unroll
    for (int j = 0; j < 8; ++j) pf[s][j] = (__bf16)pr[8 * s + j];
#pragma unroll
  for (int s = 0; s < 2; ++s) {
    o0 = mfma32(f.v[0][s], pf[s], o0);
    o1 = mfma32(f.v[1][s], pf[s], o1);
  }
  return __all(c < -150.f);
}
__device__ void attn_tile(const Params& p, int item, int it, int lane, int wave, char* smem) {
  unsigned char* ws = p.ws;
  const bf16_t* Qm = (const bf16_t*)(ws + WS_Q);
  const bf16_t* Km = (const bf16_t*)(ws + WS_K);
  const bf16_t* Vt = (const bf16_t*)(ws + WS_VT);
  bf16_t* MIX = (bf16_t*)(ws + WS_MIX);
  const int qt = item & 127, bh = (item >> 7) * 8 + wave;
  const int tok = lane & 31, hf = lane >> 5;
  bf16x8 qf[4];
  {
    const bf16_t* qp = Qm + ((size_t)bh * 4096 + qt * 32 + tok) * 64 + 8 * hf;
#pragma unroll
    for (int ks = 0; ks < 4; ++ks) qf[ks] = *(const bf16x8*)(qp + ks * 16);
  }
  f32x16 o0, o1;
#pragma unroll
  for (int i = 0; i < 16; ++i) { o0[i] = 0.f; o1[i] = 0.f; }
  float c = 0.f;
  AttnKV fa, fb;
  attn_load(Km, Vt, bh, qt, tok, hf, fa);
  {
    unsigned z = __builtin_bit_cast(u32x4, fa.v[1][1]).w | __builtin_bit_cast(u32x4, fa.k[3]).w | __builtin_bit_cast(u32x4, qf[3]).w;
    asm volatile("" ::"v"(z));
  }
  for (int kb = qt;; kb -= 2) {
    attn_load(Km, Vt, bh, kb - 1, tok, hf, fb);
    __builtin_amdgcn_sched_barrier(0);
    if (attn_block(fa, qf, kb == qt, tok, hf, c, o0, o1) || kb == 0) break;
    attn_load(Km, Vt, bh, kb - 2, tok, hf, fa);
    __builtin_amdgcn_sched_barrier(0);
    if (attn_block(fb, qf, false, tok, hf, c, o0, o1) || kb == 1) break;
  }
  float ssq = 0.f;
#pragma unroll
  for (int i = 0; i < 16; ++i) ssq += o0[i] * o0[i] + o1[i] * o1[i];
  ssq += __shfl_xor(ssq, 32);
  float* xch = (float*)(smem + 100 * 1024) + (it & 1) * 256;
  if (hf == 0) xch[wave * 32 + tok] = ssq;
  __syncthreads();
  float tot = 0.f;
#pragma unroll
  for (int w = 0; w < NWAVES; ++w) tot += xch[w * 32 + tok];
  const float rs = rsqrtf(tot * (1.f / 512.f) + EPS);
  const int t = (bh >> 3) * 4096 + qt * 32 + tok, hh = bh & 7;
  bf16_t* dst = MIX + (size_t)t * 1024 + hh * 64 + 4 * hf;
#pragma unroll
  for (int g = 0; g < 4; ++g) {
    *(u32x2*)(dst + 8 * g) = (u32x2){pk2(o0[4 * g] * rs, o0[4 * g + 1] * rs), pk2(o0[4 * g + 2] * rs, o0[4 * g + 3] * rs)};
    *(u32x2*)(dst + 32 + 8 * g) = (u32x2){pk2(o1[4 * g] * rs, o1[4 * g + 1] * rs), pk2(o1[4 * g + 2] * rs, o1[4 * g + 3] * rs)};
  }
}

__device__ void phase_mix(const Params& p, char* smem) {
  static_assert(NWAVES == 8, "one wave per attention head");
  const int vb = vblock(), G = gridDim.x;
  if (blockIdx.x & 1) prep_tables(p);
  conv_items(p, smem);
  const int tidm = otid();
  const int lane = tidm & 63, wave = tidm >> 6;
  int it = 0;
  for (int item = vb; item < 1024; item += G, ++it) attn_tile(p, item, it, lane, wave, smem);
  if (!(blockIdx.x & 1)) prep_tables(p);
}
__device__ __forceinline__ unsigned f2key(float f, unsigned n) {
  const unsigned u = (__float_as_uint(f) & ~0x7Fu) | n;
  return u ^ ((unsigned)((int)u >> 31) | 0x80000000u);
}
__device__ __forceinline__ unsigned f2key_raw(float f) {
  const unsigned u = __float_as_uint(f);
  return u ^ ((unsigned)((int)u >> 31) | 0x80000000u);
}
__device__ __forceinline__ unsigned key2u(unsigned k) { return k ^ ((k >> 31) ? 0x80000000u : 0xFFFFFFFFu); }

template <int N>
__device__ __forceinline__ void bitonic_sort_desc(unsigned (&v)[N]) {
#pragma unroll
  for (int k = 2; k <= N; k <<= 1) {
#pragma unroll
    for (int j = k >> 1; j > 0; j >>= 1) {
#pragma unroll
      for (int i = 0; i < N; ++i) {
        const int l = i ^ j;
        if (l > i) {
          const bool desc = ((i & k) == 0);
          const unsigned mx = max(v[i], v[l]), mn = min(v[i], v[l]);
          v[i] = desc ? mx : mn;
          v[l] = desc ? mn : mx;
        }
      }
    }
  }
}
template <int N>
__device__ __forceinline__ void bitonic_merge_desc(unsigned (&v)[N]) {
#pragma unroll
  for (int j = N >> 1; j > 0; j >>= 1) {
#pragma unroll
    for (int i = 0; i < N; ++i) {
      const int l = i ^ j;
      if (l > i) {
        const unsigned mx = max(v[i], v[l]), mn = min(v[i], v[l]);
        v[i] = mx;
        v[l] = mn;
      }
    }
  }
}
__device__ __forceinline__ void merge_top16(unsigned (&a)[16], const unsigned (&b)[16]) {
#pragma unroll
  for (int i = 0; i < 16; ++i) a[i] = max(a[i], b[15 - i]);
  bitonic_merge_desc<16>(a);
}
#define CEP(ka, pa, kb, pb, desc)                                  \
  {                                                                \
    const bool sw_ = (desc) ? ((kb) > (ka)) : ((kb) < (ka));       \
    const unsigned tk_ = sw_ ? (kb) : (ka), tl_ = sw_ ? (ka) : (kb); \
    const unsigned tp_ = sw_ ? (pb) : (pa), tq_ = sw_ ? (pa) : (pb); \
    ka = tk_; kb = tl_; pa = tp_; pb = tq_;                        \
  }
template <int N>
__device__ __forceinline__ void bitonic_sort_desc_p(unsigned (&v)[N], unsigned (&pl)[N]) {
#pragma unroll
  for (int k = 2; k <= N; k <<= 1) {
#pragma unroll
    for (int j = k >> 1; j > 0; j >>= 1) {
#pragma unroll
      for (int i = 0; i < N; ++i) {
        const int l = i ^ j;
        if (l > i) {
          const bool desc = ((i & k) == 0);
          CEP(v[i], pl[i], v[l], pl[l], desc);
        }
      }
    }
  }
}
template <int N>
__device__ __forceinline__ void bitonic_merge_desc_p(unsigned (&v)[N], unsigned (&pl)[N]) {
#pragma unroll
  for (int j = N >> 1; j > 0; j >>= 1) {
#pragma unroll
    for (int i = 0; i < N; ++i) {
      const int l = i ^ j;
      if (l > i) { CEP(v[i], pl[i], v[l], pl[l], true); }
    }
  }
}
__device__ __forceinline__ void merge_top16_p(unsigned (&a)[16], unsigned (&pa)[16], const unsigned (&b)[16], const unsigned (&pb)[16]) {
#pragma unroll
  for (int i = 0; i < 16; ++i) {
    const bool s = b[15 - i] > a[i];
    a[i] = s ? b[15 - i] : a[i];
    pa[i] = s ? pb[15 - i] : pa[i];
  }
  bitonic_merge_desc_p<16>(a, pa);
}

constexpr int KROW = 144;
__device__ __forceinline__ void subkey_top16(const LAS unsigned char* Kl, const bf16_t* __restrict__ qrow, int lane, unsigned (&top)[16]) {
  const int tok = lane & 31, hf = lane >> 5;
  f32x16 acc[4];
#pragma unroll
  for (int m = 0; m < 4; ++m)
#pragma unroll
    for (int i = 0; i < 16; ++i) acc[m][i] = 0.f;
  bf16x8 bq[4];
#pragma unroll
  for (int ks = 0; ks < 4; ++ks) bq[ks] = *(const bf16x8*)(qrow + ks * 16 + 8 * hf);
#pragma unroll 1
  for (int ks = 0; ks < 4; ++ks) {
#pragma unroll
    for (int m = 0; m < 4; ++m) {
      const bf16x8 ak = *(const LAS bf16x8*)(Kl + (m * 32 + tok) * KROW + ks * 32 + hf * 16);
      acc[m] = mfma32(ak, ks == 0 ? bq[0] : ks == 1 ? bq[1] : ks == 2 ? bq[2] : bq[3], acc[m]);
    }
  }
  unsigned g[4][16];
#pragma unroll
  for (int m = 0; m < 4; ++m) {
#pragma unroll
    for (int i = 0; i < 16; ++i) g[m][i] = f2key(acc[m][i], (unsigned)(m * 32 + (i & 3) + 8 * (i >> 2) + 4 * hf));
    bitonic_sort_desc<16>(g[m]);
  }
  merge_top16(g[0], g[1]);
  merge_top16(g[2], g[3]);
  merge_top16(g[0], g[2]);
  unsigned o[16];
#pragma unroll
  for (int i = 0; i < 16; ++i) o[i] = __shfl_xor(g[0][i], 32);
  merge_top16(g[0], o);
#pragma unroll
  for (int i = 0; i < 16; ++i) top[i] = g[0][i];
}

__device__ void phase_route(const Params& p, char* smem) {
  unsigned char* ws = p.ws;
  const bf16_t* K1 = (const bf16_t*)(ws + WS_K1);
  const bf16_t* K2 = (const bf16_t*)(ws + WS_K2);
  const bf16_t* QH = (const bf16_t*)(ws + WS_QH);
  const bf16_t* HB = (const bf16_t*)(ws + WS_HB);
  unsigned char* XN8 = ws + WS_XN8;
  const float* SSQ2 = (const float*)(ws + WS_SSQ2);
  unsigned* PIDX = (unsigned*)(ws + WS_PIDX);
  float* PG = (float*)(ws + WS_PG);
  const int tidr = otid();
  const int lane = tidr & 63, wave = tidr >> 6, gw = vblock() * NWAVES + wave, nw = gridDim.x * NWAVES;
  const int G = gridDim.x, nh = (G % 8 == 0) ? 8 : 1;
  LAS unsigned char* K1l = (LAS unsigned char*)smem;
  LAS unsigned char* K2l = K1l + 128 * KROW;
  for (int hd = blockIdx.x % nh; hd < 8; hd += nh) {
    for (int idx = tidr; idx < 2048; idx += NTHREADS) {
      const int tb = idx >> 10, row = (idx >> 3) & 127, ch = idx & 7;
      const u32x4 v = *(const u32x4*)((tb ? K2 : K1) + hd * 8192 + row * 64 + ch * 8);
      *(LAS u32x4*)((tb ? K2l : K1l) + row * KROW + ch * 16) = v;
    }
    __syncthreads();
    for (int tile = (blockIdx.x / nh) * NWAVES + wave; tile < T / 32; tile += (G / nh) * NWAVES) {
      const int t0 = tile * 32;
      const int tok = lane & 31, hf = lane >> 5;
      const bf16_t* qrow = QH + (size_t)(t0 + tok) * 1024 + hd * 128;
      unsigned top1[16], top2[16];
      subkey_top16(K1l, qrow, lane, top1);
      subkey_top16(K2l, qrow + 64, lane, top2);
      float fa[16], fb[16];
      unsigned ia[16], ib[16];
#pragma unroll
      for (int i = 0; i < 16; ++i) {
        const unsigned ua = key2u(hf ? top2[i] : top1[i]), ub = key2u(hf ? top1[i] : top2[i]);
        fa[i] = __uint_as_float(ua); ia[i] = ua & 0x7Fu;
        fb[i] = __uint_as_float(ub); ib[i] = ub & 0x7Fu;
      }
      unsigned ck[32];
      {
        int n = 0;
#pragma unroll
        for (int i = 0; i < 4; ++i) {
#pragma unroll
          for (int j = i; j < 16; ++j) {
            if ((i + 1) * (j + 1) <= 16) {
              unsigned key = (f2key_raw(fa[i] + fb[j]) & ~0x3FFFu) | (hf ? ((ib[j] << 7) | ia[i]) : ((ia[i] << 7) | ib[j]));
              if (i == j && hf) key = 0u;
              ck[n] = key;
              ++n;
            }
          }
        }
#pragma unroll
        for (; n < 32; ++n) ck[n] = 0u;
      }
      unsigned k0[16], k1[16];
#pragma unroll
      for (int i = 0; i < 16; ++i) { k0[i] = ck[i]; k1[i] = ck[16 + i]; }
      bitonic_sort_desc<16>(k0);
      bitonic_sort_desc<16>(k1);
      merge_top16(k0, k1);
#pragma unroll
      for (int i = 0; i < 16; ++i) k1[i] = __shfl_xor(k0[i], 32);
      merge_top16(k0, k1);
      float sv[16], sum = 0.f;
      const float mx = __uint_as_float(key2u(k0[0] & ~0x3FFFu));
#pragma unroll
      for (int i = 0; i < 16; ++i) {
        sv[i] = __builtin_amdgcn_exp2f((__uint_as_float(key2u(k0[i] & ~0x3FFFu)) - mx) * LOG2E);
        sum += sv[i];
      }
      const float inv = 1.f / sum;
      const size_t po = ((size_t)(t0 + tok) * 8 + hd) * 16;
      if (hf == 0) {
#pragma unroll
        for (int q = 0; q < 4; ++q) *(u32x4*)(PIDX + po + 4 * q) = (u32x4){k0[4 * q] & 0x3FFFu, k0[4 * q + 1] & 0x3FFFu, k0[4 * q + 2] & 0x3FFFu, k0[4 * q + 3] & 0x3FFFu};
      } else {
#pragma unroll
        for (int q = 0; q < 4; ++q) *(f32x4*)(PG + po + 4 * q) = (f32x4){sv[4 * q] * inv, sv[4 * q + 1] * inv, sv[4 * q + 2] * inv, sv[4 * q + 3] * inv};
      }
    }
    __syncthreads();
  }
}

typedef int i32x8 __attribute__((ext_vector_type(8)));
__device__ __forceinline__ f32x4 mfma_fp4_fp8(u32x4 a, u32x4 b0, u32x4 b1, f32x4 c) {
  const i32x8 A = {(int)a.x, (int)a.y, (int)a.z, (int)a.w, 0, 0, 0, 0};
  const i32x8 B = {(int)b0.x, (int)b0.y, (int)b0.z, (int)b0.w, (int)b1.x, (int)b1.y, (int)b1.z, (int)b1.w};
  return __builtin_amdgcn_mfma_scale_f32_16x16x128_f8f6f4(A, B, c, 4, 0, 0, 0x7F7F7F7F, 0, 0x7F7F7F7F);
}
struct PeCtx {
  const unsigned char* U8; const float2* USV; LAS float* glist;
  LAS unsigned* list; int lane, r, g, s, n, t0;
};
__device__ __forceinline__ void pe_rows(const PeCtx& c, int ci, u32x4 (&a)[8]) {
  const int idx = ci * 16 + (c.lane >> 2);
  const unsigned ent = c.list[idx & 2047];
  const unsigned e = (idx < c.n) ? ((ent >> 7) & 16383u) : (unsigned)(c.s << 11);
  const unsigned char* rp = c.U8 + (size_t)e * 512 + (c.lane & 3) * 16;
#pragma unroll
  for (int ks = 0; ks < 8; ++ks) a[ks] = *(const u32x4*)(rp + ks * 64);
}
__device__ __forceinline__ void pe_fix(const PeCtx& c, u32x4 (&a)[8]) {
  const int src = 4 * c.r + c.g;
#pragma unroll
  for (int ks = 0; ks < 8; ++ks) {
    a[ks].x = (unsigned)__shfl((int)a[ks].x, src); a[ks].y = (unsigned)__shfl((int)a[ks].y, src);
    a[ks].z = (unsigned)__shfl((int)a[ks].z, src); a[ks].w = (unsigned)__shfl((int)a[ks].w, src);
  }
}
__device__ __forceinline__ void pe_chunk(const PeCtx& c, int ci, u32x4 (&a)[8], u32x4 (&anext)[8], const u32x4 (&bq)[16]) {
  const int idx = ci * 16 + c.r;
  const unsigned ent = c.list[idx & 2047];
  const bool fin = (c.lane < 16) && (idx < c.n);
  const unsigned e = (ent >> 7) & 16383u, col = (ent >> 21) & 15u;
  const float2 usv = c.USV[fin ? e : 0u];
  const float gt = c.glist[idx & 2047], us = usv.x, vs = usv.y;
  __builtin_amdgcn_sched_barrier(0);
  pe_rows(c, ci + 1, anext);
  __builtin_amdgcn_sched_barrier(0);
  pe_fix(c, a);
  f32x4 acc = {0.f, 0.f, 0.f, 0.f};
#pragma unroll
  for (int ks = 0; ks < 8; ++ks) acc = mfma_fp4_fp8(a[ks], bq[2 * ks], bq[2 * ks + 1], acc);
  const int src = ((c.r >> 2) << 4) | (int)col;
  const float v0 = __shfl(acc[0], src), v1 = __shfl(acc[1], src), v2 = __shfl(acc[2], src), v3 = __shfl(acc[3], src);
  float d = ((c.r & 3) == 0) ? v0 : ((c.r & 3) == 1) ? v1 : ((c.r & 3) == 2) ? v2 : v3;
  float gt_ = gt, us_ = us, vs_ = vs;
  asm volatile("" : "+v"(d), "+v"(gt_), "+v"(us_), "+v"(vs_));
  {
    const float act = d * us_ * (1.f / 16.f);
    const float w = gt_ * 0.5f * act * (1.f + erff(act * 0.70710678118654752f)) * vs_;
    if (fin) c.glist[idx & 2047] = w;
  }
}
#define PFV_LOAD(R, ev, k0)                                                                               \
  {                                                                                                       \
    _Pragma("unroll") for (int i_ = 0; i_ < 8; ++i_) {                                                    \
      const unsigned e_ = (unsigned)__builtin_amdgcn_ds_bpermute(bsel + 4 * ((k0) + 2 * i_), (int)(ev)); \
      R[i_] = *(const u32x4*)(V4 + (e_ << 9));                                                            \
    }                                                                                                     \
  }
#define PFV_FMA(dw, b, a) acc[a] = __builtin_elementwise_fma(__builtin_amdgcn_cvt_scalef32_pk_f32_fp4(dw, 1.0f, b), w2_, acc[a]);
#define PFV_ACC(R, wv, k0)                                                                                \
  {                                                                                                       \
    _Pragma("unroll") for (int i_ = 0; i_ < 8; ++i_) {                                                    \
      const float ws_ = __builtin_bit_cast(float, __builtin_amdgcn_ds_bpermute(bsel + 4 * ((k0) + 2 * i_), __builtin_bit_cast(int, (wv)))); \
      const f32x2 w2_ = {ws_, ws_};                                                                       \
      PFV_FMA(R[i_].x, 0, 0)  PFV_FMA(R[i_].x, 1, 1)  PFV_FMA(R[i_].x, 2, 2)  PFV_FMA(R[i_].x, 3, 3)      \
      PFV_FMA(R[i_].y, 0, 4)  PFV_FMA(R[i_].y, 1, 5)  PFV_FMA(R[i_].y, 2, 6)  PFV_FMA(R[i_].y, 3, 7)      \
      PFV_FMA(R[i_].z, 0, 8)  PFV_FMA(R[i_].z, 1, 9)  PFV_FMA(R[i_].z, 2, 10) PFV_FMA(R[i_].z, 3, 11)     \
      PFV_FMA(R[i_].w, 0, 12) PFV_FMA(R[i_].w, 1, 13) PFV_FMA(R[i_].w, 2, 14) PFV_FMA(R[i_].w, 3, 15)     \
    }                                                                                                     \
  }
__device__ void phase_peer_u(const Params& p, char* smem) {
  unsigned char* ws = p.ws;
  PeCtx c;
  c.U8 = ws + WS_U8; c.USV = (const float2*)(ws + WS_USV);
  const float* PG = (const float*)(ws + WS_PG);
  const bf16_t* HB = (const bf16_t*)(ws + WS_HB);
  const float* SSQ2 = (const float*)(ws + WS_SSQ2);
  const unsigned* PIDX = (const unsigned*)(ws + WS_PIDX);
  const int tidu = otid();
  const int lane = tidu & 63, wave = tidu >> 6;
  c.lane = lane; c.r = lane & 15; c.g = lane >> 4;
  c.list = (LAS unsigned*)(smem + wave * 8192);
  c.glist = (LAS float*)(smem + 65536 + wave * 8192);
  const bool hi = lane >= 32;
  const int bsel = hi ? 4 : 0;
  const unsigned char* V4 = ws + WS_V8 + (lane & 31) * 16;
  c.s = 0;
  {
    for (int grp = vblock() * NWAVES + wave; grp < T / 16; grp += gridDim.x * NWAVES) {
      const int t0 = grp * 16;
      c.t0 = t0;
      u32x4 bq[16];
      {
        const bf16_t* hp = HB + (size_t)(t0 + c.r) * 1024 + c.g * 16;
        const float rq = rsqrtf(SSQ2[t0 + c.r] * (1.f / 1024.f) + EPS) * 16.f;
#pragma unroll
        for (int kh = 0; kh < 16; ++kh) {
          const u32x4 h0 = *(const u32x4*)(hp + (kh >> 1) * 128 + (kh & 1) * 64), h1 = *(const u32x4*)(hp + (kh >> 1) * 128 + (kh & 1) * 64 + 8);
          u32x4 q;
#pragma unroll
          for (int i = 0; i < 4; ++i) {
            const unsigned lo = (i < 2) ? h0[2 * i] : h1[2 * i - 4], hi2 = (i < 2) ? h0[2 * i + 1] : h1[2 * i - 3];
            int w = 0;
            w = __builtin_amdgcn_cvt_pk_fp8_f32(bflo(lo) * rq, bfhi(lo) * rq, w, false);
            w = __builtin_amdgcn_cvt_pk_fp8_f32(bflo(hi2) * rq, bfhi(hi2) * rq, w, true);
            q[i] = (unsigned)w;
          }
          bq[kh] = q;
        }
      }
      const int n = 2048;
#pragma unroll
      for (int q = 0; q < 8; ++q) {
        const u32x4 idv = *(const u32x4*)(PIDX + (size_t)t0 * 128 + q * 256 + lane * 4);
        const f32x4 gv = *(const f32x4*)(PG + (size_t)t0 * 128 + q * 256 + lane * 4);
        const unsigned hi = (unsigned)(2 * q + (lane >> 5)) << 21, sl = (unsigned)((lane & 31) * 4);
        *(LAS u32x4*)(c.list + q * 256 + lane * 4) = (u32x4){hi | (idv.x << 7) | sl, hi | (idv.y << 7) | (sl + 1), hi | (idv.z << 7) | (sl + 2), hi | (idv.w << 7) | (sl + 3)};
        *(LAS f32x4*)(c.glist + q * 256 + lane * 4) = gv;
      }
      asm volatile("s_waitcnt lgkmcnt(0)" ::: "memory");
      c.n = n;
      const int nch = (n + 15) >> 4;
      u32x4 a0[8], a1[8];
      pe_rows(c, 0, a0);
      {
        unsigned z = 0u;
#pragma unroll
        for (int ks = 0; ks < 8; ++ks) z |= a0[ks].w;
        asm volatile("" ::"v"(z));
      }
      if (nch > 0) {
        for (int ci = 0;; ci += 2) {
          pe_chunk(c, ci, a0, a1, bq);
          if (ci + 1 >= nch) break;
          pe_chunk(c, ci + 1, a1, a0, bq);
          if (ci + 2 >= nch) break;
        }
      }
      asm volatile("s_waitcnt lgkmcnt(0)" ::: "memory");
      {
        unsigned e0 = (c.list[lane] >> 7) & 16383u, e1 = (c.list[64 + lane] >> 7) & 16383u;
        float w0 = c.glist[lane], w1 = c.glist[64 + lane];
        u32x4 RA[8], RB[8];
        PFV_LOAD(RA, e0, 0)
        {
          unsigned z = 0u;
#pragma unroll
          for (int i = 0; i < 8; ++i) z |= RA[i].w;
          asm volatile("" ::"v"(z));
        }
        for (int tk = 0; tk < 16; ++tk) {
          const int tn = tk < 15 ? tk + 1 : tk;
          const unsigned e0n = (c.list[tn * 128 + lane] >> 7) & 16383u, e1n = (c.list[tn * 128 + 64 + lane] >> 7) & 16383u;
          const float w0n = c.glist[tn * 128 + lane], w1n = c.glist[tn * 128 + 64 + lane];
          const size_t oo = (size_t)(t0 + tk) * 1024 + (lane & 31) * 32 + (hi ? 16 : 0);
          const u32x4 hb0 = *(const u32x4*)(HB + oo), hb1 = *(const u32x4*)(HB + oo + 8);
          f32x2 acc[16];
#pragma unroll
          for (int k = 0; k < 16; ++k) acc[k] = (f32x2){0.f, 0.f};
          __builtin_amdgcn_sched_barrier(0);
          PFV_LOAD(RB, e0, 16)  __builtin_amdgcn_sched_barrier(0);  PFV_ACC(RA, w0, 0)
          PFV_LOAD(RA, e0, 32)  __builtin_amdgcn_sched_barrier(0);  PFV_ACC(RB, w0, 16)
          PFV_LOAD(RB, e0, 48)  __builtin_amdgcn_sched_barrier(0);  PFV_ACC(RA, w0, 32)
          PFV_LOAD(RA, e1, 0)   __builtin_amdgcn_sched_barrier(0);  PFV_ACC(RB, w0, 48)
          PFV_LOAD(RB, e1, 16)  __builtin_amdgcn_sched_barrier(0);  PFV_ACC(RA, w1, 0)
          PFV_LOAD(RA, e1, 32)  __builtin_amdgcn_sched_barrier(0);  PFV_ACC(RB, w1, 16)
          PFV_LOAD(RB, e1, 48)  __builtin_amdgcn_sched_barrier(0);  PFV_ACC(RA, w1, 32)
          PFV_LOAD(RA, e0n, 0)  __builtin_amdgcn_sched_barrier(0);  PFV_ACC(RB, w1, 48)
          f32x2 r[8];
#pragma unroll
          for (int k = 0; k < 8; ++k) {
            const f32x2 keep = hi ? acc[8 + k] : acc[k], send = hi ? acc[k] : acc[8 + k];
            r[k] = keep + (f32x2){__shfl_xor(send.x, 32), __shfl_xor(send.y, 32)};
          }
          float* o = p.out + oo;
          *(f32x4*)(o)      = (f32x4){bflo(hb0.x) + r[0].x, bfhi(hb0.x) + r[0].y, bflo(hb0.y) + r[1].x, bfhi(hb0.y) + r[1].y};
          *(f32x4*)(o + 4)  = (f32x4){bflo(hb0.z) + r[2].x, bfhi(hb0.z) + r[2].y, bflo(hb0.w) + r[3].x, bfhi(hb0.w) + r[3].y};
          *(f32x4*)(o + 8)  = (f32x4){bflo(hb1.x) + r[4].x, bfhi(hb1.x) + r[4].y, bflo(hb1.y) + r[5].x, bfhi(hb1.y) + r[5].y};
          *(f32x4*)(o + 12) = (f32x4){bflo(hb1.z) + r[6].x, bfhi(hb1.z) + r[6].y, bflo(hb1.w) + r[7].x, bfhi(hb1.w) + r[7].y};
          e0 = e0n; e1 = e1n; w0 = w0n; w1 = w1n;
        }
      }
      asm volatile("" ::: "memory");
    }
  }
}
#undef PFV_LOAD
#undef PFV_FMA
#undef PFV_ACC


#define XB_TMO      128
#define XB_XCNT(j)  (256  + 64 * (j))
#define XB_XSUB(j)  (1280 + 64 * (j))
#define XB_XGEN(j)  (2304 + 64 * (j))
#define XB_TOP      3328
#define XB_TOPGEN   3392
#define XCD_BAR_WORDS 3456
#define XB_SPIN_CAP (1u << 22)
__device__ __forceinline__ unsigned xb_ld(unsigned* p)              { return __hip_atomic_load(p, __ATOMIC_RELAXED, __HIP_MEMORY_SCOPE_AGENT); }
__device__ __forceinline__ unsigned xb_add(unsigned* p, unsigned v) { return __hip_atomic_fetch_add(p, v, __ATOMIC_RELAXED, __HIP_MEMORY_SCOPE_AGENT); }
__device__ __forceinline__ unsigned xb_xcc_id() { return (unsigned)__builtin_amdgcn_s_getreg((3 << 11) | 20) & 0xFu; }
#define XB_SPIN(cond, bar) do { unsigned _sp = 0; while (cond) { __builtin_amdgcn_s_sleep(1); \
    if ((++_sp & 255u) == 0u) { if (xb_ld(&(bar)[XB_TMO])) break; if (_sp > XB_SPIN_CAP) { atomicAdd(&(bar)[XB_TMO], 1u); break; } } } } while (0)
struct XcdBarrier { unsigned* bar; unsigned x; volatile LAS unsigned* st; };
__device__ __forceinline__ XcdBarrier xcd_barrier_post(unsigned* bar, volatile LAS unsigned* st) {
    XcdBarrier b; b.bar = bar; b.x = xb_xcc_id(); b.st = st;
    if (threadIdx.x == 0) (void)xb_add(&bar[XB_XCNT(b.x)], 1u);
    return b;
}
__device__ __forceinline__ void xcd_barrier_complete(unsigned* bar, unsigned x, unsigned& nloc, unsigned& nx) {
    const unsigned G = gridDim.x * gridDim.y * gridDim.z;
    unsigned sum, cnt, mine, sp = 0u;
    for (;;) {
        sum = 0u; cnt = 0u; mine = 0u;
#pragma unroll
        for (unsigned j = 0; j < 16; ++j) { const unsigned c = xb_ld(&bar[XB_XCNT(j)]); sum += c; cnt += (c > 0u) ? 1u : 0u; mine = (j == x) ? c : mine; }
        if (sum == G) break;
        __builtin_amdgcn_s_sleep(1);
        if ((++sp & 255u) == 0u) { if (xb_ld(&bar[XB_TMO])) break; if (sp > XB_SPIN_CAP) { atomicAdd(&bar[XB_TMO], 1u); break; } }
    }
    nloc = mine > 0u ? mine : 1u; nx = cnt > 0u ? cnt : 1u;
}
__device__ __forceinline__ void xcd_barrier(const XcdBarrier& b) {
    asm volatile("s_waitcnt vmcnt(0)" ::: "memory");
    __syncthreads();
    if (threadIdx.x == 0) {
        unsigned* bar = b.bar;
        __builtin_amdgcn_s_waitcnt(0);
        unsigned nloc = b.st[0], nx = b.st[1];
        if (nloc == 0u) { xcd_barrier_complete(bar, b.x, nloc, nx); b.st[0] = nloc; b.st[1] = nx; }
        const unsigned old = xb_add(&bar[XB_XSUB(b.x)], 1u);
        const unsigned gen = old / nloc;
        if (old + 1u == (gen + 1u) * nloc) {
            __builtin_amdgcn_fence(__ATOMIC_RELEASE, "agent");
            asm volatile("s_waitcnt vmcnt(0)" ::: "memory");
            const unsigned og = xb_add(&bar[XB_TOP], 1u);
            const unsigned tg = og / nx;
            if (og + 1u == (tg + 1u) * nx) xb_add(&bar[XB_TOPGEN], 1u);
            else XB_SPIN(xb_ld(&bar[XB_TOPGEN]) == tg, bar);
            __builtin_amdgcn_fence(__ATOMIC_ACQUIRE, "agent");
            xb_add(&bar[XB_XGEN(b.x)], 1u);
            asm volatile("s_waitcnt vmcnt(0)" ::: "memory");
        } else {
            XB_SPIN(xb_ld(&bar[XB_XGEN(b.x)]) == gen, bar);
            __builtin_amdgcn_fence(__ATOMIC_ACQUIRE, "agent");
            asm volatile("s_waitcnt vmcnt(0)" ::: "memory");
        }
    }
    __syncthreads();
}

__global__ void __launch_bounds__(NTHREADS, 2) k_fused(Params p) {
  __shared__ __attribute__((aligned(16))) char smem[LDS_BYTES];
  if (threadIdx.x == 0) *(u32x4*)(smem + LDS_BAR) = (u32x4){0u, 0u, 0u, 0u};
  __syncthreads();
  const XcdBarrier bar = xcd_barrier_post((unsigned*)(p.ws + WS_CTL), (volatile LAS unsigned*)(smem + LDS_BAR));
#ifdef PROBE_PHASE
  unsigned long long ts[12];
#define STAMP(k) ts[k] = __builtin_amdgcn_s_memrealtime();
#else
#define STAMP(k)
#endif
  STAMP(0)
  phase_prep(p);
  xcd_barrier(bar);
  STAMP(1)
  phase_inproj(p, smem);
  xcd_barrier(bar);
  STAMP(2)
  phase_mix(p, smem);
  xcd_barrier(bar);
  STAMP(3)
  phase_outproj(p, smem);
  xcd_barrier(bar);
  STAMP(4)
  phase_qproj(p, smem);
  xcd_barrier(bar);
  STAMP(5)
  phase_route(p, smem);
  xcd_barrier(bar);
  STAMP(6)
  phase_peer_u(p, smem);
#ifdef PROBE_PHASE
  xcd_barrier(bar);
  STAMP(7)
  if (blockIdx.x == 0 && threadIdx.x == 0) {
    const float us = (float)(ts[PROBE_PHASE + 1] - ts[PROBE_PHASE]) * 0.01f;
    p.out[12345] += us * (1.f / PROBE_DIV);
  }
#endif
}

extern "C" void kernel_launch(void* const* d_in, const int* in_sizes, int n_in, void* d_out, int out_size, void* d_ws, size_t ws_size,
                              hipStream_t stream) {
  if (n_in != 17 || ws_size < WS_END) {
    fprintf(stderr, "kernel_launch: unexpected n_in %d / ws_size %zu\n", n_in, ws_size);
    return;
  }
  Params p{};
  p.x = (const float*)d_in[0]; p.norm_mix_g = (const float*)d_in[1]; p.w_in = (const float*)d_in[2]; p.q_norm_g = (const float*)d_in[3];
  p.k_norm_g = (const float*)d_in[4]; p.attn_out_g = (const float*)d_in[5]; p.conv_w = (const float*)d_in[6]; p.conv_b = (const float*)d_in[7];
  p.conv_ln_g = (const float*)d_in[8]; p.conv_ln_b = (const float*)d_in[9]; p.w_out = (const float*)d_in[10]; p.norm_ffn_g = (const float*)d_in[11];
  p.peer_wq = (const float*)d_in[12]; p.peer_k1 = (const float*)d_in[13]; p.peer_k2 = (const float*)d_in[14]; p.peer_u = (const float*)d_in[15];
  p.peer_v = (const float*)d_in[16];
  p.out = (float*)d_out;
  p.ws = (unsigned char*)d_ws;
  static int grid_blocks = 0;
  if (!grid_blocks) {
    int dev = 0, cus = 0, per_cu = 0;
    (void)hipGetDevice(&dev);
    (void)hipDeviceGetAttribute(&cus, hipDeviceAttributeMultiprocessorCount, dev);
    (void)hipOccupancyMaxActiveBlocksPerMultiprocessor(&per_cu, k_fused, NTHREADS, 0);
    if (per_cu > 1) per_cu = 1;
    if (per_cu < 1) per_cu = 1;
    grid_blocks = cus * per_cu;
  }
  (void)hipMemsetAsync((char*)d_ws + WS_CTL, 0, XCD_BAR_WORDS * 4, stream);
  hipLaunchKernelGGL(k_fused, dim3(grid_blocks), dim3(NTHREADS), 0, stream, p);
}
```

```cpp
#include <hip/hip_runtime.h>
#include <cstdio>

#define LAS __attribute__((address_space(3)))
typedef unsigned short bf16_t;
typedef __bf16 bf16x8 __attribute__((ext_vector_type(8)));
typedef __bf16 bf16x2 __attribute__((ext_vector_type(2)));
typedef float f32x4 __attribute__((ext_vector_type(4)));
typedef float f32x16 __attribute__((ext_vector_type(16)));
typedef unsigned u32x4 __attribute__((ext_vector_type(4)));
typedef unsigned u32x2 __attribute__((ext_vector_type(2)));
typedef float f32x2 __attribute__((ext_vector_type(2)));

constexpr int SEQ = 4096, T = 8 * SEQ, D = 1024, NIN = 2560;
constexpr float EPS = 1e-6f;
constexpr float LOG2E = 1.4426950408889634f;

constexpr size_t MiB = 1u << 20;
constexpr size_t WS_W1 = 0, WS_WV = 4 * MiB, WS_WOUT = 5 * MiB, WS_WQ = 7 * MiB, WS_K1 = 9 * MiB, WS_K2 = 9 * MiB + 131072, WS_SSQ = 10 * MiB;
constexpr size_t WS_CTL = 11 * MiB;
constexpr size_t WS_USV = 11 * MiB + 65536;
constexpr size_t WS_RS1 = 11 * MiB + 196608, WS_SSQ2 = 11 * MiB + 327680;
constexpr size_t WS_U8 = 12 * MiB, WS_V8 = 28 * MiB;
constexpr size_t WS_XB = 44 * MiB;
constexpr size_t WS_Q = 108 * MiB, WS_K = 140 * MiB, WS_VT = 172 * MiB, WS_HG = 204 * MiB, WS_MIX = 236 * MiB;
constexpr size_t WS_HB = 300 * MiB, WS_QH = 364 * MiB;
constexpr size_t WS_XN8 = 108 * MiB, WS_PIDX = 140 * MiB, WS_PG = 156 * MiB, WS_PW = 172 * MiB;
constexpr size_t WS_END = 428 * MiB;

struct Params {
  const float *x, *norm_mix_g, *w_in, *q_norm_g, *k_norm_g, *attn_out_g, *conv_w, *conv_b, *conv_ln_g, *conv_ln_b,
      *w_out, *norm_ffn_g, *peer_wq, *peer_k1, *peer_k2, *peer_u, *peer_v;
  float* out;
  unsigned char* ws;
};

constexpr int NTHREADS = 512, NWAVES = 8;
constexpr int LDS_STAGE = 131072, LDS_BAR = LDS_STAGE, LDS_BYTES = LDS_STAGE + 16;

__device__ __forceinline__ unsigned pk2(float lo, float hi) {
  bf16x2 v = {(__bf16)lo, (__bf16)hi};
  return __builtin_bit_cast(unsigned, v);
}
__device__ __forceinline__ float bflo(unsigned u) { return __uint_as_float(u << 16); }
__device__ __forceinline__ float bfhi(unsigned u) { return __uint_as_float(u & 0xffff0000u); }
__device__ __forceinline__ int otid() { int t = threadIdx.x; asm volatile("" : "+v"(t)); return t; }
__device__ __forceinline__ int vblock() {
  const int G = gridDim.x, b = blockIdx.x;
  return (G % 8 == 0) ? (b % 8) * (G / 8) + b / 8 : b;
}
__device__ __forceinline__ f32x16 mfma32(bf16x8 a, bf16x8 b, f32x16 c) { return __builtin_amdgcn_mfma_f32_32x32x16_bf16(a, b, c, 0, 0, 0); }

__device__ __forceinline__ int w1_src(int n) {
  if (n < 1024) {
    const int kind = n >> 9, rel = n & 511, pn = rel >> 8, P = rel & 255, bj = P >> 7, wc = (P >> 5) & 3, x = P & 31;
    return kind * 512 + (4 * pn + wc) * 64 + 32 * bj + x;
  }
  const int rel = n - 1024, pn = rel >> 8, P = rel & 255, bj = P >> 7, wc = (P >> 5) & 3, x = P & 31;
  return (bj ? 2048 : 1536) + 128 * pn + 32 * wc + x;
}
__device__ __forceinline__ void transpose_items(const float* __restrict__ W, int ldw, int N, bf16_t* __restrict__ Wt, const float* __restrict__ g, int glimit,
                                                int mode, long gtid, long nthr) {
  const long nitems = (long)N * 128;
  for (long it = gtid; it < nitems; it += nthr) {
    const int n = (int)(it % N), kc = (int)(it / N);
    const int src = mode == 1 ? w1_src(n) : (mode == 2 ? 1024 + n : n);
    float v[8];
#pragma unroll
    for (int i = 0; i < 8; ++i) {
      const int k = kc * 8 + i;
      float w = W[(size_t)k * ldw + src];
      if (k < glimit) w *= g[k];
      v[i] = w;
    }
    u32x4 o = {pk2(v[0], v[1]), pk2(v[2], v[3]), pk2(v[4], v[5]), pk2(v[6], v[7])};
    *(u32x4*)(Wt + (size_t)n * 1024 + kc * 8) = o;
  }
}
__device__ __forceinline__ void convert_items(const float* __restrict__ src, bf16_t* __restrict__ dst, long n8, long gtid, long nthr) {
  for (long it = gtid; it < n8; it += nthr) {
    const f32x4 a = *(const f32x4*)(src + it * 8), b = *(const f32x4*)(src + it * 8 + 4);
    u32x4 o = {pk2(a.x, a.y), pk2(a.z, a.w), pk2(b.x, b.y), pk2(b.z, b.w)};
    *(u32x4*)(dst + it * 8) = o;
  }
}
__device__ void phase_prep(const Params& p) {
  const int tid0 = otid();
  const long gtid = (long)vblock() * NTHREADS + tid0, nthr = (long)gridDim.x * NTHREADS;
  unsigned char* ws = p.ws;
  transpose_items(p.w_in, NIN, 2048, (bf16_t*)(ws + WS_W1), p.norm_mix_g, 1024, 1, gtid, nthr);
  transpose_items(p.w_in, NIN, 512, (bf16_t*)(ws + WS_WV), p.norm_mix_g, 1024, 2, gtid, nthr);
  transpose_items(p.w_out, D, D, (bf16_t*)(ws + WS_WOUT), p.attn_out_g, 512, 0, gtid, nthr);
  transpose_items(p.peer_wq, D, D, (bf16_t*)(ws + WS_WQ), p.norm_ffn_g, 1024, 0, gtid, nthr);
  convert_items(p.peer_k1, (bf16_t*)(ws + WS_K1), 65536 / 8, gtid, nthr);
  convert_items(p.peer_k2, (bf16_t*)(ws + WS_K2), 65536 / 8, gtid, nthr);
  const int lane = tid0 & 63, gw = vblock() * NWAVES + (tid0 >> 6), nw = gridDim.x * NWAVES;
  {
    bf16_t* XB = (bf16_t*)(ws + WS_XB);
    float* RS1 = (float*)(ws + WS_RS1);
    float* SSQ2 = (float*)(ws + WS_SSQ2);
    for (int tb = gw; tb < T; tb += 2 * nw) {
      f32x4 v[2][4];
      float ss[2] = {0.f, 0.f};
#pragma unroll
      for (int u = 0; u < 2; ++u) {
        const int t = (tb + u * nw < T) ? tb + u * nw : tb;
        const float* src = p.x + (size_t)t * 1024 + lane * 4;
#pragma unroll
        for (int i = 0; i < 4; ++i) v[u][i] = *(const f32x4*)(src + 256 * i);
      }
#pragma unroll
      for (int u = 0; u < 2; ++u) {
#pragma unroll
        for (int i = 0; i < 4; ++i) ss[u] += v[u][i].x * v[u][i].x + v[u][i].y * v[u][i].y + v[u][i].z * v[u][i].z + v[u][i].w * v[u][i].w;
      }
#pragma unroll
      for (int o = 1; o < 64; o <<= 1) { ss[0] += __shfl_xor(ss[0], o); ss[1] += __shfl_xor(ss[1], o); }
#pragma unroll
      for (int u = 0; u < 2; ++u) {
        const int t = tb + u * nw;
        if (t < T) {
#pragma unroll
          for (int i = 0; i < 4; ++i) *(u32x2*)(XB + (size_t)t * 1024 + lane * 4 + 256 * i) = (u32x2){pk2(v[u][i].x, v[u][i].y), pk2(v[u][i].z, v[u][i].w)};
          if (lane == 0) { RS1[t] = rsqrtf(ss[u] * (1.f / 1024.f) + EPS); SSQ2[t] = 0.f; }
        }
      }
    }
  }
}

__device__ void prep_tables(const Params& p) {
  unsigned char* ws = p.ws;
  const int tid0 = otid();
  const int lane = tid0 & 63, gw = vblock() * NWAVES + (tid0 >> 6), nw = gridDim.x * NWAVES;
  {
    f32x4 gn[4];
#pragma unroll
    for (int i = 0; i < 4; ++i) gn[i] = *(const f32x4*)(p.norm_ffn_g + lane * 16 + 4 * i);
    for (int rb = gw; rb < 32768; rb += 2 * nw) {
      f32x4 v[2][4];
#pragma unroll
      for (int u = 0; u < 2; ++u) {
        const int r = (rb + u * nw < 32768) ? rb + u * nw : rb;
        const float* src = ((r >> 14) ? p.peer_v : p.peer_u) + (size_t)(r & 16383) * 1024 + lane * 16;
#pragma unroll
        for (int i = 0; i < 4; ++i) v[u][i] = *(const f32x4*)(src + 4 * i);
        if (!(r >> 14)) {
#pragma unroll
          for (int i = 0; i < 4; ++i) v[u][i] *= gn[i];
        }
      }
      float am[2] = {0.f, 0.f};
#pragma unroll
      for (int u = 0; u < 2; ++u)
#pragma unroll
        for (int i = 0; i < 4; ++i)
          am[u] = fmaxf(am[u], fmaxf(fmaxf(fabsf(v[u][i].x), fabsf(v[u][i].y)), fmaxf(fabsf(v[u][i].z), fabsf(v[u][i].w))));
#pragma unroll
      for (int o = 1; o < 64; o <<= 1) { am[0] = fmaxf(am[0], __shfl_xor(am[0], o)); am[1] = fmaxf(am[1], __shfl_xor(am[1], o)); }
#pragma unroll
      for (int u = 0; u < 2; ++u) {
        const int r = rb + u * nw;
        if (r < 32768) {
          const int isv = r >> 14, e = r & 16383;
          const float scale = am[u] > 0.f ? am[u] * (1.f / 6.f) : 1.f, inv = am[u] > 0.f ? 6.f / am[u] : 0.f;
          unsigned q[2] = {0u, 0u};
#pragma unroll
          for (int i = 0; i < 4; ++i)
#pragma unroll
            for (int j = 0; j < 4; ++j) {
              const float xv = v[u][i][j], m = fabsf(xv) * inv;
              const unsigned code = (unsigned)(m > 0.25f) + (unsigned)(m > 0.75f) + (unsigned)(m > 1.25f) + (unsigned)(m > 1.75f) +
                                    (unsigned)(m > 2.5f) + (unsigned)(m > 3.5f) + (unsigned)(m > 5.0f);
              const unsigned nib = code | (xv < 0.f ? 8u : 0u);
              const int el = 4 * i + j;
              q[el >> 3] |= nib << (4 * (el & 7));
            }
          if (isv) {
            *(u32x2*)(ws + WS_V8 + (size_t)e * 512 + lane * 8) = (u32x2){q[0], q[1]};
            if (lane == 0) ((float*)(ws + WS_USV))[2 * e + 1] = scale;
          } else {
            *(u32x2*)(ws + WS_U8 + (size_t)e * 512 + lane * 8) = (u32x2){q[0], q[1]};
            if (lane == 0) ((float*)(ws + WS_USV))[2 * e] = scale;
          }
        }
      }
    }
  }
}

namespace pg8 {
typedef short sbf16x8 __attribute__((ext_vector_type(8)));
constexpr int BM = 256, BK = 64, HALF = 128, HTB = HALF * BK * 2  , NXCD = 8, WGM = 8;
__device__ __forceinline__ int lds_byte(int r, int c) { const int st = (r >> 4) * 2 + (c >> 5), rr = r & 15, cc = c & 31, ob = rr * 64 + cc * 2; return st * 1024 + (ob ^ (((ob >> 9) & 1) << 5)); }
__device__ __forceinline__ void stage_rc(int b, int& R, int& C) { const int st = b / 1024, sb = b % 1024, swz = sb ^ (((sb >> 9) & 1) << 5); R = (st >> 1) * 16 + swz / 64; C = (st & 1) * 32 + (swz % 64) / 2; }
__device__ __forceinline__ int perm32(int rho) { const int n = rho >> 4, i = rho & 15; return 8 * (i >> 2) + 4 * n + (i & 3); }
struct Unit { int pm, pn; };
struct Gemm { const bf16_t* A; const bf16_t* Bt; int M, N, K; };
struct StaticOrder {
    int nM, nN, nwg, G, c;
    __device__ void init(int M, int N, int G_, int c_) { nM = M / BM; nN = N / BM; nwg = nM * nN; G = G_; c = c_; }
    __device__ bool next(int i, Unit& u) const {
        const long L = (long)i * G + c; if (L >= nwg) return false;
        int wgid = (int)L; { const int q = nwg / NXCD, r = nwg % NXCD, xcd = wgid % NXCD, off = wgid / NXCD; wgid = (xcd < r ? xcd * (q + 1) : r * (q + 1) + (xcd - r) * q) + off; }
        const int nig = WGM * nN, gid = wgid / nig, fm = gid * WGM, gsz = (nM - fm) < WGM ? (nM - fm) : WGM;
        u.pm = fm + ((wgid % nig) % gsz); u.pn = (wgid % nig) / gsz; return true;
    }
};
template <class Epi>
__device__ __forceinline__ void gemm_phase(LAS unsigned char* lds, const Gemm g, const StaticOrder& S, const Epi& E) {
    const int tid = otid(), wid = __builtin_amdgcn_readfirstlane(tid >> 6), lane = tid & 63, wr = wid >> 2, wc = wid & 3, fr = lane & 15, fq = lane >> 4;
    const int K = g.K, nt = K / BK;
    unsigned voffA[2], voffB[2];
#pragma unroll
    for (int i = 0; i < 2; ++i) { int R, C; stage_rc(tid * 16 + i * 8192, R, C); const int Rb = Epi::PERM ? ((R & ~31) + perm32(R & 31)) : R;
        voffA[i] = (unsigned)(R * K + C) * 2u; voffB[i] = (unsigned)(Rb * K + C) * 2u; }
    const size_t kstep = (size_t)(BK * 2);
    const size_t hstep = (size_t)HALF * K * 2;
    const size_t tstep = 2 * hstep;
    const unsigned ldsw = (unsigned)wid * 1024u;
    const int aoff = lds_byte(wr * 64 + fr, fq * 8), boff = lds_byte(wc * 32 + fr, fq * 8);
#define PG8_SA(b, h) (((b) * 2 + (h)) * HTB)
#define PG8_SB(b, h) ((4 + (b) * 2 + (h)) * HTB)
#define PG8_STAGE(bufoff, gbase, voff) do { _Pragma("unroll") for (int _i = 0; _i < 2; ++_i) \
        __builtin_amdgcn_global_load_lds((const unsigned*)((const char*)(gbase) + (voff)[_i]), (LAS unsigned*)(lds + (bufoff) + ldsw + _i * 8192), 16, 0, 0); } while (0)
#define PG8_LDA(dst, b, h) do { _Pragma("unroll") for (int m = 0; m < 4; ++m) _Pragma("unroll") for (int k = 0; k < 2; ++k) dst[m][k] = *(const LAS sbf16x8*)(lds + PG8_SA(b, h) + aoff + m * 2048 + k * 1024); } while (0)
#define PG8_LDB(dst, b, h) do { _Pragma("unroll") for (int n = 0; n < 2; ++n) _Pragma("unroll") for (int k = 0; k < 2; ++k) dst[n][k] = *(const LAS sbf16x8*)(lds + PG8_SB(b, h) + boff + n * 2048 + k * 1024); } while (0)
#define PG8_MMA(ai, bj, At, Bt) do { __builtin_amdgcn_s_setprio(1); _Pragma("unroll") for (int m = 0; m < 4; ++m) _Pragma("unroll") for (int n = 0; n < 2; ++n) _Pragma("unroll") for (int k = 0; k < 2; ++k) \
        acc[ai][bj][m][n] = __builtin_amdgcn_mfma_f32_16x16x32_bf16(__builtin_bit_cast(bf16x8, Bt[n][k]), __builtin_bit_cast(bf16x8, At[m][k]), acc[ai][bj][m][n], 0, 0, 0); __builtin_amdgcn_s_setprio(0); } while (0)
#define PG8_WAIT_V(n) asm volatile("s_waitcnt vmcnt(" #n ")" ::: "memory")
#define PG8_WAIT_L(n) asm volatile("s_waitcnt lgkmcnt(" #n ")" ::: "memory")
#define PG8_BAR __builtin_amdgcn_s_barrier()
#define PG8_SCHED __builtin_amdgcn_sched_barrier(0)
    Unit cur, nxt; int ui = 0;
    if (!S.next(0, cur)) return;
    f32x4 acc[2][2][4][2];
#pragma unroll
    for (int a = 0; a < 2; ++a)
#pragma unroll
        for (int b = 0; b < 2; ++b)
#pragma unroll
            for (int m = 0; m < 4; ++m)
#pragma unroll
                for (int n = 0; n < 2; ++n) acc[a][b][m][n] = (f32x4){0.f, 0.f, 0.f, 0.f};
    sbf16x8 At[4][2], B0[2][2], B1[2][2];
    const char* cA = (const char*)g.A + (size_t)cur.pm * tstep; const char* cB = (const char*)g.Bt + (size_t)cur.pn * tstep;
    PG8_STAGE(PG8_SB(0, 0), cB, voffB); PG8_STAGE(PG8_SA(0, 0), cA, voffA); PG8_STAGE(PG8_SB(0, 1), cB + hstep, voffB); PG8_STAGE(PG8_SA(0, 1), cA + hstep, voffA);
    if (wr == 1) PG8_BAR;
    PG8_WAIT_V(4); PG8_BAR;
    PG8_STAGE(PG8_SB(1, 0), cB + kstep, voffB); PG8_STAGE(PG8_SA(1, 0), cA + kstep, voffA); PG8_STAGE(PG8_SB(1, 1), cB + hstep + kstep, voffB);
    PG8_WAIT_V(6); PG8_BAR;
    for (;;) {
        const bool has_next = S.next(ui + 1, nxt);
        const char* nA = has_next ? (const char*)g.A + (size_t)nxt.pm * tstep : cA; const char* nB = has_next ? (const char*)g.Bt + (size_t)nxt.pn * tstep : cB;
        for (int t = 0; t < nt; t += 2) {
            const bool last = (t == nt - 2);
            const char* a1 = cA + (size_t)(t + 1) * kstep;
            const char* a2 = last ? nA : cA + (size_t)(t + 2) * kstep; const char* b2 = last ? nB : cB + (size_t)(t + 2) * kstep;
            const char* a3 = a2 + kstep; const char* b3 = b2 + kstep;
            PG8_LDB(B0, 0, 0); PG8_SCHED; PG8_LDA(At, 0, 0); PG8_STAGE(PG8_SA(1, 1), a1 + hstep, voffA);
            PG8_WAIT_L(8); PG8_BAR; PG8_WAIT_L(0); PG8_MMA(0, 0, At, B0); PG8_BAR; PG8_SCHED;
            PG8_LDB(B1, 0, 1); PG8_STAGE(PG8_SB(0, 0), b2, voffB);
            PG8_BAR; PG8_WAIT_L(0); PG8_MMA(0, 1, At, B1); PG8_BAR;
            PG8_LDA(At, 0, 1); PG8_STAGE(PG8_SA(0, 0), a2, voffA);
            PG8_BAR; PG8_WAIT_L(0); PG8_MMA(1, 0, At, B0); PG8_BAR; PG8_SCHED;
            PG8_STAGE(PG8_SB(0, 1), b2 + hstep, voffB);
            PG8_WAIT_V(6); PG8_BAR; PG8_MMA(1, 1, At, B1); PG8_BAR;
            PG8_LDB(B0, 1, 0); PG8_SCHED; PG8_LDA(At, 1, 0); PG8_STAGE(PG8_SA(0, 1), a2 + hstep, voffA);
            PG8_WAIT_L(8); PG8_BAR; PG8_WAIT_L(0); PG8_MMA(0, 0, At, B0); PG8_BAR; PG8_SCHED;
            PG8_LDB(B1, 1, 1); PG8_STAGE(PG8_SB(1, 0), b3, voffB);
            PG8_BAR; PG8_WAIT_L(0); PG8_MMA(0, 1, At, B1); PG8_BAR;
            PG8_LDA(At, 1, 1); PG8_STAGE(PG8_SA(1, 0), a3, voffA);
            PG8_BAR; PG8_WAIT_L(0); PG8_MMA(1, 0, At, B0); PG8_BAR; PG8_SCHED;
            PG8_STAGE(PG8_SB(1, 1), b3 + hstep, voffB);
            PG8_WAIT_V(6); PG8_BAR; PG8_MMA(1, 1, At, B1); PG8_BAR;
        }
        E(acc, cur, wr, wc, fr, fq);
        if (!has_next) break;
#pragma unroll
        for (int a = 0; a < 2; ++a)
#pragma unroll
            for (int b = 0; b < 2; ++b)
#pragma unroll
                for (int m = 0; m < 4; ++m)
#pragma unroll
                    for (int n = 0; n < 2; ++n) acc[a][b][m][n] = (f32x4){0.f, 0.f, 0.f, 0.f};
        cur = nxt; cA = nA; cB = nB; ++ui;
    }
    PG8_WAIT_V(0);
    if (wr == 0) PG8_BAR;
    PG8_BAR;
#undef PG8_SA
#undef PG8_SB
#undef PG8_STAGE
#undef PG8_LDA
#undef PG8_LDB
#undef PG8_MMA
#undef PG8_WAIT_V
#undef PG8_WAIT_L
#undef PG8_BAR
#undef PG8_SCHED
}
}

struct EpiQKC {
  static constexpr bool PERM = true;
  const float* rs1; const float* qg; const float* kg; bf16_t* Q; bf16_t* Kk; bf16_t* HG;
  __device__ __forceinline__ void operator()(const f32x4 (&acc)[2][2][4][2], const pg8::Unit& u, int wr, int wc, int fr, int fq) const {
    const int row0 = u.pm * 256 + wr * 64 + fr;
    if (u.pn < 4) {
      const bool isq = u.pn < 2;
      const int head = 4 * (u.pn & 1) + wc;
      const float* g = isq ? qg : kg;
      f32x4 gv[2][2];
#pragma unroll
      for (int bj = 0; bj < 2; ++bj)
#pragma unroll
        for (int n = 0; n < 2; ++n) gv[bj][n] = *(const f32x4*)(g + 32 * bj + 8 * fq + 4 * n);
      bf16_t* base = isq ? Q : Kk;
#pragma unroll
      for (int ai = 0; ai < 2; ++ai)
#pragma unroll
        for (int m = 0; m < 4; ++m) {
          const int t = row0 + ai * 128 + m * 16;
          float ss = 0.f;
#pragma unroll
          for (int bj = 0; bj < 2; ++bj)
#pragma unroll
            for (int n = 0; n < 2; ++n) { const f32x4 v = acc[ai][bj][m][n]; ss += v.x * v.x + v.y * v.y + v.z * v.z + v.w * v.w; }
          ss += __shfl_xor(ss, 16);
          ss += __shfl_xor(ss, 32);
          const float r = rs1[t];
          float sc = r * rsqrtf(r * r * ss * (1.f / 64.f) + EPS);
          if (isq) sc *= 0.125f * LOG2E;
          const size_t bh = (size_t)((t >> 12) * 8 + head);
          const int pos = t & 4095;
          bf16_t* dst = isq ? base + (bh * 4096 + pos) * 64 + 8 * fq
                            : base + (bh * 4096 + (pos & ~31)) * 64 + ((((fq >> 1) * 2 + (fq & 1)) * 32) + (pos & 31)) * 8;
#pragma unroll
          for (int bj = 0; bj < 2; ++bj) {
            const f32x4 a = acc[ai][bj][m][0] * gv[bj][0] * sc, b = acc[ai][bj][m][1] * gv[bj][1] * sc;
            *(u32x4*)(dst + (isq ? 32 * bj : 1024 * bj)) = (u32x4){pk2(a.x, a.y), pk2(a.z, a.w), pk2(b.x, b.y), pk2(b.z, b.w)};
          }
        }
    } else {
      const int ch0 = 128 * (u.pn - 4) + 32 * wc + 8 * fq;
#pragma unroll
      for (int ai = 0; ai < 2; ++ai)
#pragma unroll
        for (int m = 0; m < 4; ++m) {
          const int t = row0 + ai * 128 + m * 16;
          const float r = rs1[t];
          float h[8];
#pragma unroll
          for (int n = 0; n < 2; ++n)
#pragma unroll
            for (int j = 0; j < 4; ++j) h[4 * n + j] = acc[ai][0][m][n][j] * r / (1.f + __expf(-acc[ai][1][m][n][j] * r));
          *(u32x4*)(HG + (size_t)t * 512 + ch0) = (u32x4){pk2(h[0], h[1]), pk2(h[2], h[3]), pk2(h[4], h[5]), pk2(h[6], h[7])};
        }
    }
  }
};
struct EpiVt {
  static constexpr bool PERM = false;
  const float* rs1; bf16_t* Vt;
  __device__ __forceinline__ void operator()(const f32x4 (&acc)[2][2][4][2], const pg8::Unit& u, int wr, int wc, int fr, int fq) const {
    const int pos0 = 8 * (fq & 1) + 4 * (fq >> 1);
#pragma unroll
    for (int bj = 0; bj < 2; ++bj)
#pragma unroll
      for (int n = 0; n < 2; ++n) {
        const int t = u.pn * 256 + bj * 128 + wc * 32 + n * 16 + 4 * fq;
        const f32x4 r = *(const f32x4*)(rs1 + t);
        const size_t tb = ((size_t)(t >> 12) * 8) * 128 + ((t & 4095) >> 5);
#pragma unroll
        for (int ai = 0; ai < 2; ++ai)
#pragma unroll
          for (int m = 0; m < 4; ++m) {
            const int dg = u.pm * 256 + ai * 128 + wr * 64 + m * 16 + fr, head = dg >> 6, d = dg & 63;
            const f32x4 v = acc[ai][bj][m][n] * r;
            *(u32x2*)(Vt + (tb + (size_t)head * 128) * 2048 + (((((d >> 5) * 2 + n) * 2 + (fq & 1)) * 32) + (d & 31)) * 8 + 4 * (fq >> 1)) = (u32x2){pk2(v.x, v.y), pk2(v.z, v.w)};
          }
      }
  }
};
struct EpiOut {
  static constexpr bool PERM = true;
  const bf16_t* xb; bf16_t* HB; float* ssq2;
  __device__ __forceinline__ void operator()(const f32x4 (&acc)[2][2][4][2], const pg8::Unit& u, int wr, int wc, int fr, int fq) const {
    const int row0 = u.pm * 256 + wr * 64 + fr, col0 = u.pn * 256 + wc * 32 + 8 * fq;
#pragma unroll
    for (int ai = 0; ai < 2; ++ai)
#pragma unroll
      for (int m = 0; m < 4; ++m) {
        const int t = row0 + ai * 128 + m * 16;
        const size_t ro = (size_t)t * 1024 + col0;
        float ss = 0.f;
#pragma unroll
        for (int bj = 0; bj < 2; ++bj) {
          const size_t o = ro + bj * 128;
          const u32x4 xv = *(const u32x4*)(xb + o);
          const f32x4 h0 = (f32x4){bflo(xv.x), bfhi(xv.x), bflo(xv.y), bfhi(xv.y)} + acc[ai][bj][m][0];
          const f32x4 h1 = (f32x4){bflo(xv.z), bfhi(xv.z), bflo(xv.w), bfhi(xv.w)} + acc[ai][bj][m][1];
          *(u32x4*)(HB + o) = (u32x4){pk2(h0.x, h0.y), pk2(h0.z, h0.w), pk2(h1.x, h1.y), pk2(h1.z, h1.w)};
          ss += (h0.x * h0.x + h0.y * h0.y + h0.z * h0.z + h0.w * h0.w) + (h1.x * h1.x + h1.y * h1.y + h1.z * h1.z + h1.w * h1.w);
        }
        ss += __shfl_xor(ss, 16);
        ss += __shfl_xor(ss, 32);
        if (fq == 0) atomicAdd(ssq2 + t, ss);
      }
  }
};
struct EpiQh {
  static constexpr bool PERM = true;
  const float* ssq2; bf16_t* QH;
  __device__ __forceinline__ void operator()(const f32x4 (&acc)[2][2][4][2], const pg8::Unit& u, int wr, int wc, int fr, int fq) const {
    const int row0 = u.pm * 256 + wr * 64 + fr, col0 = u.pn * 256 + wc * 32 + 8 * fq;
#pragma unroll
    for (int ai = 0; ai < 2; ++ai)
#pragma unroll
      for (int m = 0; m < 4; ++m) {
        const int t = row0 + ai * 128 + m * 16;
        const float r = rsqrtf(ssq2[t] * (1.f / 1024.f) + EPS);
#pragma unroll
        for (int bj = 0; bj < 2; ++bj) {
          const f32x4 a = acc[ai][bj][m][0] * r, b = acc[ai][bj][m][1] * r;
          *(u32x4*)(QH + (size_t)t * 1024 + col0 + bj * 128) = (u32x4){pk2(a.x, a.y), pk2(a.z, a.w), pk2(b.x, b.y), pk2(b.z, b.w)};
        }
      }
  }
};

__device__ void phase_inproj(const Params& p, char* smem) {
  unsigned char* ws = p.ws;
  LAS unsigned char* lds = (LAS unsigned char*)smem;
  const bf16_t* XB = (const bf16_t*)(ws + WS_XB);
  const float* RS1 = (const float*)(ws + WS_RS1);
  pg8::StaticOrder S;
  {
    pg8::Gemm g{XB, (const bf16_t*)(ws + WS_W1), T, 2048, 1024};
    S.init(T, 2048, gridDim.x, blockIdx.x);
    EpiQKC E{RS1, p.q_norm_g, p.k_norm_g, (bf16_t*)(ws + WS_Q), (bf16_t*)(ws + WS_K), (bf16_t*)(ws + WS_HG)};
    pg8::gemm_phase<EpiQKC>(lds, g, S, E);
  }
  {
    pg8::Gemm g{(const bf16_t*)(ws + WS_WV), XB, 512, T, 1024};
    S.init(512, T, gridDim.x, blockIdx.x);
    EpiVt E{RS1, (bf16_t*)(ws + WS_VT)};
    pg8::gemm_phase<EpiVt>(lds, g, S, E);
  }
}
__device__ void phase_outproj(const Params& p, char* smem) {
  unsigned char* ws = p.ws;
  pg8::Gemm g{(const bf16_t*)(ws + WS_MIX), (const bf16_t*)(ws + WS_WOUT), T, 1024, 1024};
  pg8::StaticOrder S;
  S.init(T, 1024, gridDim.x, blockIdx.x);
  EpiOut E{(const bf16_t*)(ws + WS_XB), (bf16_t*)(ws + WS_HB), (float*)(ws + WS_SSQ2)};
  pg8::gemm_phase<EpiOut>((LAS unsigned char*)smem, g, S, E);
}
__device__ void phase_qproj(const Params& p, char* smem) {
  unsigned char* ws = p.ws;
  pg8::Gemm g{(const bf16_t*)(ws + WS_HB), (const bf16_t*)(ws + WS_WQ), T, 1024, 1024};
  pg8::StaticOrder S;
  S.init(T, 1024, gridDim.x, blockIdx.x);
  EpiQh E{(const float*)(ws + WS_SSQ2), (bf16_t*)(ws + WS_QH)};
  pg8::gemm_phase<EpiQh>((LAS unsigned char*)smem, g, S, E);
}

__device__ __forceinline__ void conv_stage(const bf16_t* HG, int item, LAS unsigned char* buf, int wave, int lane) {
  const int t0 = item * 32, s0 = t0 & 4095;
#pragma unroll
  for (int j = 0; j < 8; ++j) {
    const int r = wave + 8 * j;
    if (r < 62) {
      if (s0 - 30 + r >= 0)
        __builtin_amdgcn_global_load_lds((const unsigned*)(HG + (size_t)(t0 - 30 + r) * 512 + lane * 8), (LAS unsigned*)(buf + r * 1024), 16, 0, 0);
      else
        *(LAS u32x4*)(buf + r * 1024 + lane * 16) = (u32x4){0u, 0u, 0u, 0u};
    }
  }
}
struct ConvW { f32x2 wv[31]; float2 cb, lg, lb; };
__device__ __forceinline__ void conv_compute(const Params& p, int item, const char* smem, const ConvW& W, int tid512) {
  bf16_t* MIX = (bf16_t*)(p.ws + WS_MIX);
  const int half = tid512 >> 8, tid = tid512 & 255, lane = tid & 63, wave = tid >> 6;
  const int t0 = item * 32;
  float* red = (float*)(smem + 62 * 1024) + half * 128;
  const bool b5 = lane & 32, b4 = lane & 16, b3 = lane & 8, b2 = lane & 4;
#pragma unroll 1
  for (int rd = 0; rd < 2; ++rd) {
    const int tb = 16 * half + 8 * rd;
    f32x2 xv[38];
#pragma unroll
    for (int r = 0; r < 38; ++r) {
      const unsigned v = *(const unsigned*)(smem + (tb + r) * 1024 + tid * 4);
      xv[r] = (f32x2){bflo(v), bfhi(v)};
    }
    float a0[8], a1[8], st[16];
#pragma unroll
    for (int k = 0; k < 8; ++k) {
      f32x2 u = {W.cb.x, W.cb.y};
#pragma unroll
      for (int j = 0; j < 31; ++j) u = __builtin_elementwise_fma(W.wv[j], xv[k + j], u);
      a0[k] = u.x; a1[k] = u.y;
      st[k] = u.x + u.y;
      st[8 + k] = u.x * u.x + u.y * u.y;
    }
    float r8[8], r4[4], r2[2], r1;
#pragma unroll
    for (int i = 0; i < 8; ++i) { const float keep = b5 ? st[8 + i] : st[i], send = b5 ? st[i] : st[8 + i]; r8[i] = keep + __shfl_xor(send, 32); }
#pragma unroll
    for (int i = 0; i < 4; ++i) { const float keep = b4 ? r8[4 + i] : r8[i], send = b4 ? r8[i] : r8[4 + i]; r4[i] = keep + __shfl_xor(send, 16); }
#pragma unroll
    for (int i = 0; i < 2; ++i) { const float keep = b3 ? r4[2 + i] : r4[i], send = b3 ? r4[i] : r4[2 + i]; r2[i] = keep + __shfl_xor(send, 8); }
    { const float keep = b2 ? r2[1] : r2[0], send = b2 ? r2[0] : r2[1]; r1 = keep + __shfl_xor(send, 4); }
    r1 += __shfl_xor(r1, 2);
    r1 += __shfl_xor(r1, 1);
    float* rr = red + rd * 64;
    if ((lane & 3) == 0) rr[wave * 16 + (lane >> 2)] = r1;
    __syncthreads();
#pragma unroll
    for (int k = 0; k < 8; ++k) {
      const float S1 = (rr[k] + rr[16 + k]) + (rr[32 + k] + rr[48 + k]);
      const float S2 = (rr[8 + k] + rr[24 + k]) + (rr[40 + k] + rr[56 + k]);
      const float mu = S1 * (1.f / 512.f);
      const float var = fmaxf(S2 * (1.f / 512.f) - mu * mu, 0.f);
      const float rstd = rsqrtf(var + EPS);
      const float y0 = (a0[k] - mu) * rstd * W.lg.x + W.lb.x, y1 = (a1[k] - mu) * rstd * W.lg.y + W.lb.y;
      const float z0 = y0 / (1.f + __expf(-y0)), z1 = y1 / (1.f + __expf(-y1));
      *(unsigned*)(MIX + (size_t)(t0 + tb + k) * 1024 + 512 + 2 * tid) = pk2(z0, z1);
    }
  }
}
__device__ void conv_items(const Params& p, char* smem) {
  const bf16_t* HG = (const bf16_t*)(p.ws + WS_HG);
  const int tid512 = otid(), tid = tid512 & 255, lane = tid512 & 63;
  const int wave = __builtin_amdgcn_readfirstlane(tid512 >> 6);
  const int vb = vblock(), G = gridDim.x;
  ConvW W;
#pragma unroll
  for (int j = 0; j < 31; ++j) {
    const float2 w = *(const float2*)(p.conv_w + j * 512 + 2 * tid);
    W.wv[j] = (f32x2){w.x, w.y};
  }
  W.cb = *(const float2*)(p.conv_b + 2 * tid);
  W.lg = *(const float2*)(p.conv_ln_g + 2 * tid);
  W.lb = *(const float2*)(p.conv_ln_b + 2 * tid);
  int b = 0;
  if (vb < 1024) conv_stage(HG, vb, (LAS unsigned char*)smem, wave, lane);
  for (int item = vb; item < 1024; item += G, b ^= 1) {
    asm volatile("s_waitcnt vmcnt(0) lgkmcnt(0)" ::: "memory");
    __syncthreads();
    if (item + G < 1024) conv_stage(HG, item + G, (LAS unsigned char*)smem + (b ^ 1) * 65536, wave, lane);
    conv_compute(p, item, smem + b * 65536, W, tid512);
  }
  __syncthreads();
}

struct AttnKV { bf16x8 k[4]; bf16x8 v[2][2]; };
__device__ __forceinline__ void attn_load(const bf16_t* Km, const bf16_t* Vt, int bh, int kb, int tok, int hf, AttnKV& f) {
  const int kc = kb < 0 ? 0 : kb;
  const bf16_t* kp = Km + ((size_t)bh * 128 + kc) * 2048 + (hf * 32 + tok) * 8;
#pragma unroll
  for (int ks = 0; ks < 4; ++ks) f.k[ks] = *(const bf16x8*)(kp + ks * 512);
  const bf16_t* vp = Vt + ((size_t)bh * 128 + kc) * 2048 + (hf * 32 + tok) * 8;
#pragma unroll
  for (int m = 0; m < 2; ++m)
#pragma unroll
    for (int s = 0; s < 2; ++s) f.v[m][s] = *(const bf16x8*)(vp + (m * 2 + s) * 512);
}
__device__ __forceinline__ bool attn_block(const AttnKV& f, const bf16x8 (&qf)[4], bool diag, int tok, int hf, float& c, f32x16& o0, f32x16& o1) {
  f32x16 sc;
#pragma unroll
  for (int i = 0; i < 16; ++i) sc[i] = 0.f;
#pragma unroll
  for (int ks = 0; ks < 4; ++ks) sc = mfma32(f.k[ks], qf[ks], sc);
  float kp[16], sg[16];
#pragma unroll
  for (int i = 0; i < 16; ++i) {
    const float e = __builtin_amdgcn_exp2f(fminf(sc[i], 80.f));
    const float r = __builtin_amdgcn_rcpf(1.f + e);
    kp[i] = r;
    sg[i] = e * r;
  }
  if (diag) {
#pragma unroll
    for (int i = 0; i < 16; ++i) {
      const bool valid = ((i & 3) + 8 * (i >> 2) + 4 * hf < tok);
      kp[i] = valid ? kp[i] : 1.f;
      sg[i] = valid ? sg[i] : 0.f;
    }
  }
  float Tg[4], Pg[4];
#pragma unroll
  for (int g = 0; g < 4; ++g) {
    Tg[g] = (kp[4 * g] * kp[4 * g + 1]) * (kp[4 * g + 2] * kp[4 * g + 3]);
    Pg[g] = __shfl_xor(Tg[g], 32);
  }
  float base[4];
  float run = __builtin_amdgcn_exp2f(c);
#pragma unroll
  for (int g = 3; g >= 0; --g) {
    base[g] = run * (hf == 0 ? Pg[g] : 1.f);
    run *= Tg[g] * Pg[g];
  }
  float pr[16];
#pragma unroll
  for (int g = 0; g < 4; ++g) {
    float l = base[g];
#pragma unroll
    for (int r = 3; r >= 0; --r) {
      pr[4 * g + r] = sg[4 * g + r] * l;
      l *= kp[4 * g + r];
    }
  }
  c = __builtin_amdgcn_logf(run);
  bf16x8 pf[2];
#pragma unroll
  for (int s = 0; s < 2; ++s)
#pragma unroll
    for (int j = 0; j < 8; ++j) pf[s][j] = (__bf16)pr[8 * s + j];
#pragma unroll
  for (int s = 0; s < 2; ++s) {
    o0 = mfma32(f.v[0][s], pf[s], o0);
    o1 = mfma32(f.v[1][s], pf[s], o1);
  }
  return __all(c < -150.f);
}
__device__ void attn_tile(const Params& p, int item, int it, int lane, int wave, char* smem) {
  unsigned char* ws = p.ws;
  const bf16_t* Qm = (const bf16_t*)(ws + WS_Q);
  const bf16_t* Km = (const bf16_t*)(ws + WS_K);
  const bf16_t* Vt = (const bf16_t*)(ws + WS_VT);
  bf16_t* MIX = (bf16_t*)(ws + WS_MIX);
  const int qt = item & 127, bh = (item >> 7) * 8 + wave;
  const int tok = lane & 31, hf = lane >> 5;
  bf16x8 qf[4];
  {
    const bf16_t* qp = Qm + ((size_t)bh * 4096 + qt * 32 + tok) * 64 + 8 * hf;
#pragma unroll
    for (int ks = 0; ks < 4; ++ks) qf[ks] = *(const bf16x8*)(qp + ks * 16);
  }
  f32x16 o0, o1;
#pragma unroll
  for (int i = 0; i < 16; ++i) { o0[i] = 0.f; o1[i] = 0.f; }
  float c = 0.f;
  AttnKV fa, fb;
  attn_load(Km, Vt, bh, qt, tok, hf, fa);
  {
    unsigned z = __builtin_bit_cast(u32x4, fa.v[1][1]).w | __builtin_bit_cast(u32x4, fa.k[3]).w | __builtin_bit_cast(u32x4, qf[3]).w;
    asm volatile("" ::"v"(z));
  }
  for (int kb = qt;; kb -= 2) {
    attn_load(Km, Vt, bh, kb - 1, tok, hf, fb);
    __builtin_amdgcn_sched_barrier(0);
    if (attn_block(fa, qf, kb == qt, tok, hf, c, o0, o1) || kb == 0) break;
    attn_load(Km, Vt, bh, kb - 2, tok, hf, fa);
    __builtin_amdgcn_sched_barrier(0);
    if (attn_block(fb, qf, false, tok, hf, c, o0, o1) || kb == 1) break;
  }
  float ssq = 0.f;
#pragma unroll
  for (int i = 0; i < 16; ++i) ssq += o0[i] * o0[i] + o1[i] * o1[i];
  ssq += __shfl_xor(ssq, 32);
  float* xch = (float*)(smem + 100 * 1024) + (it & 1) * 256;
  if (hf == 0) xch[wave * 32 + tok] = ssq;
  __syncthreads();
  float tot = 0.f;
#pragma unroll
  for (int w = 0; w < NWAVES; ++w) tot += xch[w * 32 + tok];
  const float rs = rsqrtf(tot * (1.f / 512.f) + EPS);
  const int t = (bh >> 3) * 4096 + qt * 32 + tok, hh = bh & 7;
  bf16_t* dst = MIX + (size_t)t * 1024 + hh * 64 + 4 * hf;
#pragma unroll
  for (int g = 0; g < 4; ++g) {
    *(u32x2*)(dst + 8 * g) = (u32x2){pk2(o0[4 * g] * rs, o0[4 * g + 1] * rs), pk2(o0[4 * g + 2] * rs, o0[4 * g + 3] * rs)};
    *(u32x2*)(dst + 32 + 8 * g) = (u32x2){pk2(o1[4 * g] * rs, o1[4 * g + 1] * rs), pk2(o1[4 * g + 2] * rs, o1[4 * g + 3] * rs)};
  }
}

__device__ void phase_mix(const Params& p, char* smem) {
  static_assert(NWAVES == 8, "one wave per attention head");
  const int vb = vblock(), G = gridDim.x;
  if (blockIdx.x & 1) prep_tables(p);
  conv_items(p, smem);
  const int tidm = otid();
  const int lane = tidm & 63, wave = tidm >> 6;
  int it = 0;
  for (int item = vb; item < 1024; item += G, ++it) attn_tile(p, item, it, lane, wave, smem);
  if (!(blockIdx.x & 1)) prep_tables(p);
}
__device__ __forceinline__ unsigned f2key(float f, unsigned n) {
  const unsigned u = (__float_as_uint(f) & ~0x7Fu) | n;
  return u ^ ((unsigned)((int)u >> 31) | 0x80000000u);
}
__device__ __forceinline__ unsigned f2key_raw(float f) {
  const unsigned u = __float_as_uint(f);
  return u ^ ((unsigned)((int)u >> 31) | 0x80000000u);
}
__device__ __forceinline__ unsigned key2u(unsigned k) { return k ^ ((k >> 31) ? 0x80000000u : 0xFFFFFFFFu); }

template <int N>
__device__ __forceinline__ void bitonic_sort_desc(unsigned (&v)[N]) {
#pragma unroll
  for (int k = 2; k <= N; k <<= 1) {
#pragma unroll
    for (int j = k >> 1; j > 0; j >>= 1) {
#pragma unroll
      for (int i = 0; i < N; ++i) {
        const int l = i ^ j;
        if (l > i) {
          const bool desc = ((i & k) == 0);
          const unsigned mx = max(v[i], v[l]), mn = min(v[i], v[l]);
          v[i] = desc ? mx : mn;
          v[l] = desc ? mn : mx;
        }
      }
    }
  }
}
template <int N>
__device__ __forceinline__ void bitonic_merge_desc(unsigned (&v)[N]) {
#pragma unroll
  for (int j = N >> 1; j > 0; j >>= 1) {
#pragma unroll
    for (int i = 0; i < N; ++i) {
      const int l = i ^ j;
      if (l > i) {
        const unsigned mx = max(v[i], v[l]), mn = min(v[i], v[l]);
        v[i] = mx;
        v[l] = mn;
      }
    }
  }
}
__device__ __forceinline__ void merge_top16(unsigned (&a)[16], const unsigned (&b)[16]) {
#pragma unroll
  for (int i = 0; i < 16; ++i) a[i] = max(a[i], b[15 - i]);
  bitonic_merge_desc<16>(a);
}
#define CEP(ka, pa, kb, pb, desc)                                  \
  {                                                                \
    const bool sw_ = (desc) ? ((kb) > (ka)) : ((kb) < (ka));       \
    const unsigned tk_ = sw_ ? (kb) : (ka), tl_ = sw_ ? (ka) : (kb); \
    const unsigned tp_ = sw_ ? (pb) : (pa), tq_ = sw_ ? (pa) : (pb); \
    ka = tk_; kb = tl_; pa = tp_; pb = tq_;                        \
  }
template <int N>
__device__ __forceinline__ void bitonic_sort_desc_p(unsigned (&v)[N], unsigned (&pl)[N]) {
#pragma unroll
  for (int k = 2; k <= N; k <<= 1) {
#pragma unroll
    for (int j = k >> 1; j > 0; j >>= 1) {
#pragma unroll
      for (int i = 0; i < N; ++i) {
        const int l = i ^ j;
        if (l > i) {
          const bool desc = ((i & k) == 0);
          CEP(v[i], pl[i], v[l], pl[l], desc);
        }
      }
    }
  }
}
template <int N>
__device__ __forceinline__ void bitonic_merge_desc_p(unsigned (&v)[N], unsigned (&pl)[N]) {
#pragma unroll
  for (int j = N >> 1; j > 0; j >>= 1) {
#pragma unroll
    for (int i = 0; i < N; ++i) {
      const int l = i ^ j;
      if (l > i) { CEP(v[i], pl[i], v[l], pl[l], true); }
    }
  }
}
__device__ __forceinline__ void merge_top16_p(unsigned (&a)[16], unsigned (&pa)[16], const unsigned (&b)[16], const unsigned (&pb)[16]) {
#pragma unroll
  for (int i = 0; i < 16; ++i) {
    const bool s = b[15 - i] > a[i];
    a[i] = s ? b[15 - i] : a[i];
    pa[i] = s ? pb[15 - i] : pa[i];
  }
  bitonic_merge_desc_p<16>(a, pa);
}

constexpr int KROW = 144;
__device__ __forceinline__ void subkey_top16(const LAS unsigned char* Kl, const bf16_t* __restrict__ qrow, int lane, unsigned (&top)[16]) {
  const int tok = lane & 31, hf = lane >> 5;
  f32x16 acc[4];
#pragma unroll
  for (int m = 0; m < 4; ++m)
#pragma unroll
    for (int i = 0; i < 16; ++i) acc[m][i] = 0.f;
  bf16x8 bq[4];
#pragma unroll
  for (int ks = 0; ks < 4; ++ks) bq[ks] = *(const bf16x8*)(qrow + ks * 16 + 8 * hf);
#pragma unroll 1
  for (int ks = 0; ks < 4; ++ks) {
#pragma unroll
    for (int m = 0; m < 4; ++m) {
      const bf16x8 ak = *(const LAS bf16x8*)(Kl + (m * 32 + tok) * KROW + ks * 32 + hf * 16);
      acc[m] = mfma32(ak, ks == 0 ? bq[0] : ks == 1 ? bq[1] : ks == 2 ? bq[2] : bq[3], acc[m]);
    }
  }
  unsigned g[4][16];
#pragma unroll
  for (int m = 0; m < 4; ++m) {
#pragma unroll
    for (int i = 0; i < 16; ++i) g[m][i] = f2key(acc[m][i], (unsigned)(m * 32 + (i & 3) + 8 * (i >> 2) + 4 * hf));
    bitonic_sort_desc<16>(g[m]);
  }
  merge_top16(g[0], g[1]);
  merge_top16(g[2], g[3]);
  merge_top16(g[0], g[2]);
  unsigned o[16];
#pragma unroll
  for (int i = 0; i < 16; ++i) o[i] = __shfl_xor(g[0][i], 32);
  merge_top16(g[0], o);
#pragma unroll
  for (int i = 0; i < 16; ++i) top[i] = g[0][i];
}

__device__ void phase_route(const Params& p, char* smem) {
  unsigned char* ws = p.ws;
  const bf16_t* K1 = (const bf16_t*)(ws + WS_K1);
  const bf16_t* K2 = (const bf16_t*)(ws + WS_K2);
  const bf16_t* QH = (const bf16_t*)(ws + WS_QH);
  const bf16_t* HB = (const bf16_t*)(ws + WS_HB);
  unsigned char* XN8 = ws + WS_XN8;
  const float* SSQ2 = (const float*)(ws + WS_SSQ2);
  unsigned* PIDX = (unsigned*)(ws + WS_PIDX);
  float* PG = (float*)(ws + WS_PG);
  const int tidr = otid();
  const int lane = tidr & 63, wave = tidr >> 6, gw = vblock() * NWAVES + wave, nw = gridDim.x * NWAVES;
  const int G = gridDim.x, nh = (G % 8 == 0) ? 8 : 1;
  LAS unsigned char* K1l = (LAS unsigned char*)smem;
  LAS unsigned char* K2l = K1l + 128 * KROW;
  for (int hd = blockIdx.x % nh; hd < 8; hd += nh) {
    for (int idx = tidr; idx < 2048; idx += NTHREADS) {
      const int tb = idx >> 10, row = (idx >> 3) & 127, ch = idx & 7;
      const u32x4 v = *(const u32x4*)((tb ? K2 : K1) + hd * 8192 + row * 64 + ch * 8);
      *(LAS u32x4*)((tb ? K2l : K1l) + row * KROW + ch * 16) = v;
    }
    __syncthreads();
    for (int tile = (blockIdx.x / nh) * NWAVES + wave; tile < T / 32; tile += (G / nh) * NWAVES) {
      const int t0 = tile * 32;
      const int tok = lane & 31, hf = lane >> 5;
      const bf16_t* qrow = QH + (size_t)(t0 + tok) * 1024 + hd * 128;
      unsigned top1[16], top2[16];
      subkey_top16(K1l, qrow, lane, top1);
      subkey_top16(K2l, qrow + 64, lane, top2);
      float fa[16], fb[16];
      unsigned ia[16], ib[16];
#pragma unroll
      for (int i = 0; i < 16; ++i) {
        const unsigned ua = key2u(hf ? top2[i] : top1[i]), ub = key2u(hf ? top1[i] : top2[i]);
        fa[i] = __uint_as_float(ua); ia[i] = ua & 0x7Fu;
        fb[i] = __uint_as_float(ub); ib[i] = ub & 0x7Fu;
      }
      unsigned ck[32];
      {
        int n = 0;
#pragma unroll
        for (int i = 0; i < 4; ++i) {
#pragma unroll
          for (int j = i; j < 16; ++j) {
            if ((i + 1) * (j + 1) <= 16) {
              unsigned key = (f2key_raw(fa[i] + fb[j]) & ~0x3FFFu) | (hf ? ((ib[j] << 7) | ia[i]) : ((ia[i] << 7) | ib[j]));
              if (i == j && hf) key = 0u;
              ck[n] = key;
              ++n;
            }
          }
        }
#pragma unroll
        for (; n < 32; ++n) ck[n] = 0u;
      }
      unsigned k0[16], k1[16];
#pragma unroll
      for (int i = 0; i < 16; ++i) { k0[i] = ck[i]; k1[i] = ck[16 + i]; }
      bitonic_sort_desc<16>(k0);
      bitonic_sort_desc<16>(k1);
      merge_top16(k0, k1);
#pragma unroll
      for (int i = 0; i < 16; ++i) k1[i] = __shfl_xor(k0[i], 32);
      merge_top16(k0, k1);
      float sv[16], sum = 0.f;
      const float mx = __uint_as_float(key2u(k0[0] & ~0x3FFFu));
#pragma unroll
      for (int i = 0; i < 16; ++i) {
        sv[i] = __builtin_amdgcn_exp2f((__uint_as_float(key2u(k0[i] & ~0x3FFFu)) - mx) * LOG2E);
        sum += sv[i];
      }
      const float inv = 1.f / sum;
      const size_t po = ((size_t)(t0 + tok) * 8 + hd) * 16;
      if (hf == 0) {
#pragma unroll
        for (int q = 0; q < 4; ++q) *(u32x4*)(PIDX + po + 4 * q) = (u32x4){k0[4 * q] & 0x3FFFu, k0[4 * q + 1] & 0x3FFFu, k0[4 * q + 2] & 0x3FFFu, k0[4 * q + 3] & 0x3FFFu};
      } else {
#pragma unroll
        for (int q = 0; q < 4; ++q) *(f32x4*)(PG + po + 4 * q) = (f32x4){sv[4 * q] * inv, sv[4 * q + 1] * inv, sv[4 * q + 2] * inv, sv[4 * q + 3] * inv};
      }
    }
    __syncthreads();
  }
}

typedef int i32x8 __attribute__((ext_vector_type(8)));
__device__ __forceinline__ f32x4 mfma_fp4_fp8(u32x4 a, u32x4 b0, u32x4 b1, f32x4 c) {
  const i32x8 A = {(int)a.x, (int)a.y, (int)a.z, (int)a.w, 0, 0, 0, 0};
  const i32x8 B = {(int)b0.x, (int)b0.y, (int)b0.z, (int)b0.w, (int)b1.x, (int)b1.y, (int)b1.z, (int)b1.w};
  return __builtin_amdgcn_mfma_scale_f32_16x16x128_f8f6f4(A, B, c, 4, 0, 0, 0x7F7F7F7F, 0, 0x7F7F7F7F);
}
struct PeCtx {
  const unsigned char* U8; const float2* USV; LAS float* glist;
  LAS unsigned* list; int lane, r, g, s, n, t0;
};
__device__ __forceinline__ void pe_rows(const PeCtx& c, int ci, u32x4 (&a)[8]) {
  const int idx = ci * 16 + (c.lane >> 2);
  const unsigned ent = c.list[idx & 2047];
  const unsigned e = (idx < c.n) ? ((ent >> 7) & 16383u) : (unsigned)(c.s << 11);
  const unsigned char* rp = c.U8 + (size_t)e * 512 + (c.lane & 3) * 16;
#pragma unroll
  for (int ks = 0; ks < 8; ++ks) a[ks] = *(const u32x4*)(rp + ks * 64);
}
__device__ __forceinline__ void pe_fix(const PeCtx& c, u32x4 (&a)[8]) {
  const int src = 4 * c.r + c.g;
#pragma unroll
  for (int ks = 0; ks < 8; ++ks) {
    a[ks].x = (unsigned)__shfl((int)a[ks].x, src); a[ks].y = (unsigned)__shfl((int)a[ks].y, src);
    a[ks].z = (unsigned)__shfl((int)a[ks].z, src); a[ks].w = (unsigned)__shfl((int)a[ks].w, src);
  }
}
__device__ __forceinline__ void pe_chunk(const PeCtx& c, int ci, u32x4 (&a)[8], u32x4 (&anext)[8], const u32x4 (&bq)[16]) {
  const int idx = ci * 16 + c.r;
  const unsigned ent = c.list[idx & 2047];
  const bool fin = (c.lane < 16) && (idx < c.n);
  const unsigned e = (ent >> 7) & 16383u, col = (ent >> 21) & 15u;
  const float2 usv = c.USV[fin ? e : 0u];
  const float gt = c.glist[idx & 2047], us = usv.x, vs = usv.y;
  __builtin_amdgcn_sched_barrier(0);
  pe_rows(c, ci + 1, anext);
  __builtin_amdgcn_sched_barrier(0);
  pe_fix(c, a);
  f32x4 acc = {0.f, 0.f, 0.f, 0.f};
#pragma unroll
  for (int ks = 0; ks < 8; ++ks) acc = mfma_fp4_fp8(a[ks], bq[2 * ks], bq[2 * ks + 1], acc);
  const int src = ((c.r >> 2) << 4) | (int)col;
  const float v0 = __shfl(acc[0], src), v1 = __shfl(acc[1], src), v2 = __shfl(acc[2], src), v3 = __shfl(acc[3], src);
  float d = ((c.r & 3) == 0) ? v0 : ((c.r & 3) == 1) ? v1 : ((c.r & 3) == 2) ? v2 : v3;
  float gt_ = gt, us_ = us, vs_ = vs;
  asm volatile("" : "+v"(d), "+v"(gt_), "+v"(us_), "+v"(vs_));
  {
    const float act = d * us_ * (1.f / 16.f);
    const float w = gt_ * 0.5f * act * (1.f + erff(act * 0.70710678118654752f)) * vs_;
    if (fin) c.glist[idx & 2047] = w;
  }
}
#define PFV_LOAD(R, ev, k0)                                                                               \
  {                                                                                                       \
    _Pragma("unroll") for (int i_ = 0; i_ < 8; ++i_) {                                                    \
      const unsigned e_ = (unsigned)__builtin_amdgcn_ds_bpermute(bsel + 4 * ((k0) + 2 * i_), (int)(ev)); \
      R[i_] = *(const u32x4*)(V4 + (e_ << 9));                                                            \
    }                                                                                                     \
  }
#define PFV_FMA(dw, b, a) acc[a] = __builtin_elementwise_fma(__builtin_amdgcn_cvt_scalef32_pk_f32_fp4(dw, 1.0f, b), w2_, acc[a]);
#define PFV_ACC(R, wv, k0)                                                                                \
  {                                                                                                       \
    _Pragma("unroll") for (int i_ = 0; i_ < 8; ++i_) {                                                    \
      const float ws_ = __builtin_bit_cast(float, __builtin_amdgcn_ds_bpermute(bsel + 4 * ((k0) + 2 * i_), __builtin_bit_cast(int, (wv)))); \
      const f32x2 w2_ = {ws_, ws_};                                                                       \
      PFV_FMA(R[i_].x, 0, 0)  PFV_FMA(R[i_].x, 1, 1)  PFV_FMA(R[i_].x, 2, 2)  PFV_FMA(R[i_].x, 3, 3)      \
      PFV_FMA(R[i_].y, 0, 4)  PFV_FMA(R[i_].y, 1, 5)  PFV_FMA(R[i_].y, 2, 6)  PFV_FMA(R[i_].y, 3, 7)      \
      PFV_FMA(R[i_].z, 0, 8)  PFV_FMA(R[i_].z, 1, 9)  PFV_FMA(R[i_].z, 2, 10) PFV_FMA(R[i_].z, 3, 11)     \
      PFV_FMA(R[i_].w, 0, 12) PFV_FMA(R[i_].w, 1, 13) PFV_FMA(R[i_].w, 2, 14) PFV_FMA(R[i_].w, 3, 15)     \
    }                                                                                                     \
  }
__device__ void phase_peer_u(const Params& p, char* smem) {
  unsigned char* ws = p.ws;
  PeCtx c;
  c.U8 = ws + WS_U8; c.USV = (const float2*)(ws + WS_USV);
  const float* PG = (const float*)(ws + WS_PG);
  const bf16_t* HB = (const bf16_t*)(ws + WS_HB);
  const float* SSQ2 = (const float*)(ws + WS_SSQ2);
  const unsigned* PIDX = (const unsigned*)(ws + WS_PIDX);
  const int tidu = otid();
  const int lane = tidu & 63, wave = tidu >> 6;
  c.lane = lane; c.r = lane & 15; c.g = lane >> 4;
  c.list = (LAS unsigned*)(smem + wave * 8192);
  c.glist = (LAS float*)(smem + 65536 + wave * 8192);
  const bool hi = lane >= 32;
  const int bsel = hi ? 4 : 0;
  const unsigned char* V4 = ws + WS_V8 + (lane & 31) * 16;
  c.s = 0;
  {
    for (int grp = vblock() * NWAVES + wave; grp < T / 16; grp += gridDim.x * NWAVES) {
      const int t0 = grp * 16;
      c.t0 = t0;
      u32x4 bq[16];
      {
        const bf16_t* hp = HB + (size_t)(t0 + c.r) * 1024 + c.g * 16;
        const float rq = rsqrtf(SSQ2[t0 + c.r] * (1.f / 1024.f) + EPS) * 16.f;
#pragma unroll
        for (int kh = 0; kh < 16; ++kh) {
          const u32x4 h0 = *(const u32x4*)(hp + (kh >> 1) * 128 + (kh & 1) * 64), h1 = *(const u32x4*)(hp + (kh >> 1) * 128 + (kh & 1) * 64 + 8);
          u32x4 q;
#pragma unroll
          for (int i = 0; i < 4; ++i) {
            const unsigned lo = (i < 2) ? h0[2 * i] : h1[2 * i - 4], hi2 = (i < 2) ? h0[2 * i + 1] : h1[2 * i - 3];
            int w = 0;
            w = __builtin_amdgcn_cvt_pk_fp8_f32(bflo(lo) * rq, bfhi(lo) * rq, w, false);
            w = __builtin_amdgcn_cvt_pk_fp8_f32(bflo(hi2) * rq, bfhi(hi2) * rq, w, true);
            q[i] = (unsigned)w;
          }
          bq[kh] = q;
        }
      }
      const int n = 2048;
#pragma unroll
      for (int q = 0; q < 8; ++q) {
        const u32x4 idv = *(const u32x4*)(PIDX + (size_t)t0 * 128 + q * 256 + lane * 4);
        const f32x4 gv = *(const f32x4*)(PG + (size_t)t0 * 128 + q * 256 + lane * 4);
        const unsigned hi = (unsigned)(2 * q + (lane >> 5)) << 21, sl = (unsigned)((lane & 31) * 4);
        *(LAS u32x4*)(c.list + q * 256 + lane * 4) = (u32x4){hi | (idv.x << 7) | sl, hi | (idv.y << 7) | (sl + 1), hi | (idv.z << 7) | (sl + 2), hi | (idv.w << 7) | (sl + 3)};
        *(LAS f32x4*)(c.glist + q * 256 + lane * 4) = gv;
      }
      asm volatile("s_waitcnt lgkmcnt(0)" ::: "memory");
      c.n = n;
      const int nch = (n + 15) >> 4;
      u32x4 a0[8], a1[8];
      pe_rows(c, 0, a0);
      {
        unsigned z = 0u;
#pragma unroll
        for (int ks = 0; ks < 8; ++ks) z |= a0[ks].w;
        asm volatile("" ::"v"(z));
      }
      if (nch > 0) {
        for (int ci = 0;; ci += 2) {
          pe_chunk(c, ci, a0, a1, bq);
          if (ci + 1 >= nch) break;
          pe_chunk(c, ci + 1, a1, a0, bq);
          if (ci + 2 >= nch) break;
        }
      }
      asm volatile("s_waitcnt lgkmcnt(0)" ::: "memory");
      {
        unsigned e0 = (c.list[lane] >> 7) & 16383u, e1 = (c.list[64 + lane] >> 7) & 16383u;
        float w0 = c.glist[lane], w1 = c.glist[64 + lane];
        u32x4 RA[8], RB[8];
        PFV_LOAD(RA, e0, 0)
        {
          unsigned z = 0u;
#pragma unroll
          for (int i = 0; i < 8; ++i) z |= RA[i].w;
          asm volatile("" ::"v"(z));
        }
        for (int tk = 0; tk < 16; ++tk) {
          const int tn = tk < 15 ? tk + 1 : tk;
          const unsigned e0n = (c.list[tn * 128 + lane] >> 7) & 16383u, e1n = (c.list[tn * 128 + 64 + lane] >> 7) & 16383u;
          const float w0n = c.glist[tn * 128 + lane], w1n = c.glist[tn * 128 + 64 + lane];
          const size_t oo = (size_t)(t0 + tk) * 1024 + (lane & 31) * 32 + (hi ? 16 : 0);
          const u32x4 hb0 = *(const u32x4*)(HB + oo), hb1 = *(const u32x4*)(HB + oo + 8);
          f32x2 acc[16];
#pragma unroll
          for (int k = 0; k < 16; ++k) acc[k] = (f32x2){0.f, 0.f};
          __builtin_amdgcn_sched_barrier(0);
          PFV_LOAD(RB, e0, 16)  __builtin_amdgcn_sched_barrier(0);  PFV_ACC(RA, w0, 0)
          PFV_LOAD(RA, e0, 32)  __builtin_amdgcn_sched_barrier(0);  PFV_ACC(RB, w0, 16)
          PFV_LOAD(RB, e0, 48)  __builtin_amdgcn_sched_barrier(0);  PFV_ACC(RA, w0, 32)
          PFV_LOAD(RA, e1, 0)   __builtin_amdgcn_sched_barrier(0);  PFV_ACC(RB, w0, 48)
          PFV_LOAD(RB, e1, 16)  __builtin_amdgcn_sched_barrier(0);  PFV_ACC(RA, w1, 0)
          PFV_LOAD(RA, e1, 32)  __builtin_amdgcn_sched_barrier(0);  PFV_ACC(RB, w1, 16)
          PFV_LOAD(RB, e1, 48)  __builtin_amdgcn_sched_barrier(0);  PFV_ACC(RA, w1, 32)
          PFV_LOAD(RA, e0n, 0)  __builtin_amdgcn_sched_barrier(0);  PFV_ACC(RB, w1, 48)
          f32x2 r[8];
#pragma unroll
          for (int k = 0; k < 8; ++k) {
            const f32x2 keep = hi ? acc[8 + k] : acc[k], send = hi ? acc[k] : acc[8 + k];
            r[k] = keep + (f32x2){__shfl_xor(send.x, 32), __shfl_xor(send.y, 32)};
          }
          float* o = p.out + oo;
          *(f32x4*)(o)      = (f32x4){bflo(hb0.x) + r[0].x, bfhi(hb0.x) + r[0].y, bflo(hb0.y) + r[1].x, bfhi(hb0.y) + r[1].y};
          *(f32x4*)(o + 4)  = (f32x4){bflo(hb0.z) + r[2].x, bfhi(hb0.z) + r[2].y, bflo(hb0.w) + r[3].x, bfhi(hb0.w) + r[3].y};
          *(f32x4*)(o + 8)  = (f32x4){bflo(hb1.x) + r[4].x, bfhi(hb1.x) + r[4].y, bflo(hb1.y) + r[5].x, bfhi(hb1.y) + r[5].y};
          *(f32x4*)(o + 12) = (f32x4){bflo(hb1.z) + r[6].x, bfhi(hb1.z) + r[6].y, bflo(hb1.w) + r[7].x, bfhi(hb1.w) + r[7].y};
          e0 = e0n; e1 = e1n; w0 = w0n; w1 = w1n;
        }
      }
      asm volatile("" ::: "memory");
    }
  }
}
#undef PFV_LOAD
#undef PFV_FMA
#undef PFV_ACC


#define XB_TMO      128
#define XB_XCNT(j)  (256  + 64 * (j))
#define XB_XSUB(j)  (1280 + 64 * (j))
#define XB_XGEN(j)  (2304 + 64 * (j))
#define XB_TOP      3328
#define XB_TOPGEN   3392
#define XCD_BAR_WORDS 3456
#define XB_SPIN_CAP (1u << 22)
__device__ __forceinline__ unsigned xb_ld(unsigned* p)              { return __hip_atomic_load(p, __ATOMIC_RELAXED, __HIP_MEMORY_SCOPE_AGENT); }
__device__ __forceinline__ unsigned xb_add(unsigned* p, unsigned v) { return __hip_atomic_fetch_add(p, v, __ATOMIC_RELAXED, __HIP_MEMORY_SCOPE_AGENT); }
__device__ __forceinline__ unsigned xb_xcc_id() { return (unsigned)__builtin_amdgcn_s_getreg((3 << 11) | 20) & 0xFu; }
#define XB_SPIN(cond, bar) do { unsigned _sp = 0; while (cond) { __builtin_amdgcn_s_sleep(1); \
    if ((++_sp & 255u) == 0u) { if (xb_ld(&(bar)[XB_TMO])) break; if (_sp > XB_SPIN_CAP) { atomicAdd(&(bar)[XB_TMO], 1u); break; } } } } while (0)
struct XcdBarrier { unsigned* bar; unsigned x; volatile LAS unsigned* st; };
__device__ __forceinline__ XcdBarrier xcd_barrier_post(unsigned* bar, volatile LAS unsigned* st) {
    XcdBarrier b; b.bar = bar; b.x = xb_xcc_id(); b.st = st;
    if (threadIdx.x == 0) (void)xb_add(&bar[XB_XCNT(b.x)], 1u);
    return b;
}
__device__ __forceinline__ void xcd_barrier_complete(unsigned* bar, unsigned x, unsigned& nloc, unsigned& nx) {
    const unsigned G = gridDim.x * gridDim.y * gridDim.z;
    unsigned sum, cnt, mine, sp = 0u;
    for (;;) {
        sum = 0u; cnt = 0u; mine = 0u;
#pragma unroll
        for (unsigned j = 0; j < 16; ++j) { const unsigned c = xb_ld(&bar[XB_XCNT(j)]); sum += c; cnt += (c > 0u) ? 1u : 0u; mine = (j == x) ? c : mine; }
        if (sum == G) break;
        __builtin_amdgcn_s_sleep(1);
        if ((++sp & 255u) == 0u) { if (xb_ld(&bar[XB_TMO])) break; if (sp > XB_SPIN_CAP) { atomicAdd(&bar[XB_TMO], 1u); break; } }
    }
    nloc = mine > 0u ? mine : 1u; nx = cnt > 0u ? cnt : 1u;
}
__device__ __forceinline__ void xcd_barrier(const XcdBarrier& b) {
    asm volatile("s_waitcnt vmcnt(0)" ::: "memory");
    __syncthreads();
    if (threadIdx.x == 0) {
        unsigned* bar = b.bar;
        __builtin_amdgcn_s_waitcnt(0);
        unsigned nloc = b.st[0], nx = b.st[1];
        if (nloc == 0u) { xcd_barrier_complete(bar, b.x, nloc, nx); b.st[0] = nloc; b.st[1] = nx; }
        const unsigned old = xb_add(&bar[XB_XSUB(b.x)], 1u);
        const unsigned gen = old / nloc;
        if (old + 1u == (gen + 1u) * nloc) {
            __builtin_amdgcn_fence(__ATOMIC_RELEASE, "agent");
            asm volatile("s_waitcnt vmcnt(0)" ::: "memory");
            const unsigned og = xb_add(&bar[XB_TOP], 1u);
            const unsigned tg = og / nx;
            if (og + 1u == (tg + 1u) * nx) xb_add(&bar[XB_TOPGEN], 1u);
            else XB_SPIN(xb_ld(&bar[XB_TOPGEN]) == tg, bar);
            __builtin_amdgcn_fence(__ATOMIC_ACQUIRE, "agent");
            xb_add(&bar[XB_XGEN(b.x)], 1u);
            asm volatile("s_waitcnt vmcnt(0)" ::: "memory");
        } else {
            XB_SPIN(xb_ld(&bar[XB_XGEN(b.x)]) == gen, bar);
            __builtin_amdgcn_fence(__ATOMIC_ACQUIRE, "agent");
            asm volatile("s_waitcnt vmcnt(0)" ::: "memory");
        }
    }
    __syncthreads();
}

__global__ void __launch_bounds__(NTHREADS, 2) k_fused(Params p) {
  __shared__ __attribute__((aligned(16))) char smem[LDS_BYTES];
  if (threadIdx.x == 0) *(u32x4*)(smem + LDS_BAR) = (u32x4){0u, 0u, 0u, 0u};
  __syncthreads();
  const XcdBarrier bar = xcd_barrier_post((unsigned*)(p.ws + WS_CTL), (volatile LAS unsigned*)(smem + LDS_BAR));
#ifdef PROBE_PHASE
  unsigned long long ts[12];
#define STAMP(k) ts[k] = __builtin_amdgcn_s_memrealtime();
#else
#define STAMP(k)
#endif
  STAMP(0)
  phase_prep(p);
  xcd_barrier(bar);
  STAMP(1)
  phase_inproj(p, smem);
  xcd_barrier(bar);
  STAMP(2)
  phase_mix(p, smem);
  xcd_barrier(bar);
  STAMP(3)
  phase_outproj(p, smem);
  xcd_barrier(bar);
  STAMP(4)
  phase_qproj(p, smem);
  xcd_barrier(bar);
  STAMP(5)
  phase_route(p, smem);
  xcd_barrier(bar);
  STAMP(6)
  phase_peer_u(p, smem);
#ifdef PROBE_PHASE
  xcd_barrier(bar);
  STAMP(7)
  if (blockIdx.x == 0 && threadIdx.x == 0) {
    const float us = (float)(ts[PROBE_PHASE + 1] - ts[PROBE_PHASE]) * 0.01f;
    p.out[12345] += us * (1.f / PROBE_DIV);
  }
#endif
}

extern "C" void kernel_launch(void* const* d_in, const int* in_sizes, int n_in, void* d_out, int out_size, void* d_ws, size_t ws_size,
                              hipStream_t stream) {
  if (n_in != 17 || ws_size < WS_END) {
    fprintf(stderr, "kernel_launch: unexpected n_in %d / ws_size %zu\n", n_in, ws_size);
    return;
  }
  Params p{};
  p.x = (const float*)d_in[0]; p.norm_mix_g = (const float*)d_in[1]; p.w_in = (const float*)d_in[2]; p.q_norm_g = (const float*)d_in[3];
  p.k_norm_g = (const float*)d_in[4]; p.attn_out_g = (const float*)d_in[5]; p.conv_w = (const float*)d_in[6]; p.conv_b = (const float*)d_in[7];
  p.conv_ln_g = (const float*)d_in[8]; p.conv_ln_b = (const float*)d_in[9]; p.w_out = (const float*)d_in[10]; p.norm_ffn_g = (const float*)d_in[11];
  p.peer_wq = (const float*)d_in[12]; p.peer_k1 = (const float*)d_in[13]; p.peer_k2 = (const float*)d_in[14]; p.peer_u = (const float*)d_in[15];
  p.peer_v = (const float*)d_in[16];
  p.out = (float*)d_out;
  p.ws = (unsigned char*)d_ws;
  static int grid_blocks = 0;
  if (!grid_blocks) {
    int dev = 0, cus = 0, per_cu = 0;
    (void)hipGetDevice(&dev);
    (void)hipDeviceGetAttribute(&cus, hipDeviceAttributeMultiprocessorCount, dev);
    (void)hipOccupancyMaxActiveBlocksPerMultiprocessor(&per_cu, k_fused, NTHREADS, 0);
    if (per_cu > 1) per_cu = 1;
    if (per_cu < 1) per_cu = 1;
    grid_blocks = cus * per_cu;
  }
  (void)hipMemsetAsync((char*)d_ws + WS_CTL, 0, XCD_BAR_WORDS * 4, stream);
  hipLaunchKernelGGL(k_fused, dim3(grid_blocks), dim3(NTHREADS), 0, stream, p);
}
```

```cpp
#include <hip/hip_runtime.h>
#include <cstdio>

#define LAS __attribute__((address_space(3)))
typedef unsigned short bf16_t;
typedef __bf16 bf16x8 __attribute__((ext_vector_type(8)));
typedef __bf16 bf16x2 __attribute__((ext_vector_type(2)));
typedef float f32x4 __attribute__((ext_vector_type(4)));
typedef float f32x16 __attribute__((ext_vector_type(16)));
typedef unsigned u32x4 __attribute__((ext_vector_type(4)));
typedef unsigned u32x2 __attribute__((ext_vector_type(2)));
typedef float f32x2 __attribute__((ext_vector_type(2)));

constexpr int SEQ = 4096, T = 8 * SEQ, D = 1024, NIN = 2560;
constexpr float EPS = 1e-6f;
constexpr float LOG2E = 1.4426950408889634f;

constexpr size_t MiB = 1u << 20;
constexpr size_t WS_W1 = 0, WS_WV = 4 * MiB, WS_WOUT = 5 * MiB, WS_WQ = 7 * MiB, WS_K1 = 9 * MiB, WS_K2 = 9 * MiB + 131072, WS_SSQ = 10 * MiB;
constexpr size_t WS_CTL = 11 * MiB;
constexpr size_t WS_USV = 11 * MiB + 65536;
constexpr size_t WS_RS1 = 11 * MiB + 196608, WS_SSQ2 = 11 * MiB + 327680;
constexpr size_t WS_U8 = 12 * MiB, WS_V8 = 28 * MiB;
constexpr size_t WS_XB = 44 * MiB;
constexpr size_t WS_Q = 108 * MiB, WS_K = 140 * MiB, WS_VT = 172 * MiB, WS_HG = 204 * MiB, WS_MIX = 236 * MiB;
constexpr size_t WS_HB = 300 * MiB, WS_QH = 364 * MiB;
constexpr size_t WS_XN8 = 108 * MiB, WS_PIDX = 140 * MiB, WS_PG = 156 * MiB, WS_PW = 172 * MiB;
constexpr size_t WS_END = 428 * MiB;

struct Params {
  const float *x, *norm_mix_g, *w_in, *q_norm_g, *k_norm_g, *attn_out_g, *conv_w, *conv_b, *conv_ln_g, *conv_ln_b,
      *w_out, *norm_ffn_g, *peer_wq, *peer_k1, *peer_k2, *peer_u, *peer_v;
  float* out;
  unsigned char* ws;
};

constexpr int NTHREADS = 512, NWAVES = 8;
constexpr int LDS_STAGE = 131072, LDS_BAR = LDS_STAGE, LDS_BYTES = LDS_STAGE + 16;

__device__ __forceinline__ unsigned pk2(float lo, float hi) {
  bf16x2 v = {(__bf16)lo, (__bf16)hi};
  return __builtin_bit_cast(unsigned, v);
}
__device__ __forceinline__ float bflo(unsigned u) { return __uint_as_float(u << 16); }
__device__ __forceinline__ float bfhi(unsigned u) { return __uint_as_float(u & 0xffff0000u); }
__device__ __forceinline__ int otid() { int t = threadIdx.x; asm volatile("" : "+v"(t)); return t; }
__device__ __forceinline__ int vblock() {
  const int G = gridDim.x, b = blockIdx.x;
  return (G % 8 == 0) ? (b % 8) * (G / 8) + b / 8 : b;
}
__device__ __forceinline__ f32x16 mfma32(bf16x8 a, bf16x8 b, f32x16 c) { return __builtin_amdgcn_mfma_f32_32x32x16_bf16(a, b, c, 0, 0, 0); }

__device__ __forceinline__ int w1_src(int n) {
  if (n < 1024) {
    const int kind = n >> 9, rel = n & 511, pn = rel >> 8, P = rel & 255, bj = P >> 7, wc = (P >> 5) & 3, x = P & 31;
    return kind * 512 + (4 * pn + wc) * 64 + 32 * bj + x;
  }
  const int rel = n - 1024, pn = rel >> 8, P = rel & 255, bj = P >> 7, wc = (P >> 5) & 3, x = P & 31;
  return (bj ? 2048 : 1536) + 128 * pn + 32 * wc + x;
}
__device__ __forceinline__ void transpose_items(const float* __restrict__ W, int ldw, int N, bf16_t* __restrict__ Wt, const float* __restrict__ g, int glimit,
                                                int mode, long gtid, long nthr) {
  const long nitems = (long)N * 128;
  for (long it = gtid; it < nitems; it += nthr) {
    const int n = (int)(it % N), kc = (int)(it / N);
    const int src = mode == 1 ? w1_src(n) : (mode == 2 ? 1024 + n : n);
    float v[8];
#pragma unroll
    for (int i = 0; i < 8; ++i) {
      const int k = kc * 8 + i;
      float w = W[(size_t)k * ldw + src];
      if (k < glimit) w *= g[k];
      v[i] = w;
    }
    u32x4 o = {pk2(v[0], v[1]), pk2(v[2], v[3]), pk2(v[4], v[5]), pk2(v[6], v[7])};
    *(u32x4*)(Wt + (size_t)n * 1024 + kc * 8) = o;
  }
}
__device__ __forceinline__ void convert_items(const float* __restrict__ src, bf16_t* __restrict__ dst, long n8, long gtid, long nthr) {
  for (long it = gtid; it < n8; it += nthr) {
    const f32x4 a = *(const f32x4*)(src + it * 8), b = *(const f32x4*)(src + it * 8 + 4);
    u32x4 o = {pk2(a.x, a.y), pk2(a.z, a.w), pk2(b.x, b.y), pk2(b.z, b.w)};
    *(u32x4*)(dst + it * 8) = o;
  }
}
__device__ void phase_prep(const Params& p) {
  const int tid0 = otid();
  const long gtid = (long)vblock() * NTHREADS + tid0, nthr = (long)gridDim.x * NTHREADS;
  unsigned char* ws = p.ws;
  transpose_items(p.w_in, NIN, 2048, (bf16_t*)(ws + WS_W1), p.norm_mix_g, 1024, 1, gtid, nthr);
  transpose_items(p.w_in, NIN, 512, (bf16_t*)(ws + WS_WV), p.norm_mix_g, 1024, 2, gtid, nthr);
  transpose_items(p.w_out, D, D, (bf16_t*)(ws + WS_WOUT), p.attn_out_g, 512, 0, gtid, nthr);
  transpose_items(p.peer_wq, D, D, (bf16_t*)(ws + WS_WQ), p.norm_ffn_g, 1024, 0, gtid, nthr);
  convert_items(p.peer_k1, (bf16_t*)(ws + WS_K1), 65536 / 8, gtid, nthr);
  convert_items(p.peer_k2, (bf16_t*)(ws + WS_K2), 65536 / 8, gtid, nthr);
  const int lane = tid0 & 63, gw = vblock() * NWAVES + (tid0 >> 6), nw = gridDim.x * NWAVES;
  {
    bf16_t* XB = (bf16_t*)(ws + WS_XB);
    float* RS1 = (float*)(ws + WS_RS1);
    float* SSQ2 = (float*)(ws + WS_SSQ2);
    for (int tb = gw; tb < T; tb += 2 * nw) {
      f32x4 v[2][4];
      float ss[2] = {0.f, 0.f};
#pragma unroll
      for (int u = 0; u < 2; ++u) {
        const int t = (tb + u * nw < T) ? tb + u * nw : tb;
        const float* src = p.x + (size_t)t * 1024 + lane * 4;
#pragma unroll
        for (int i = 0; i < 4; ++i) v[u][i] = *(const f32x4*)(src + 256 * i);
      }
#pragma unroll
      for (int u = 0; u < 2; ++u) {
#pragma unroll
        for (int i = 0; i < 4; ++i) ss[u] += v[u][i].x * v[u][i].x + v[u][i].y * v[u][i].y + v[u][i].z * v[u][i].z + v[u][i].w * v[u][i].w;
      }
#pragma unroll
      for (int o = 1; o < 64; o <<= 1) { ss[0] += __shfl_xor(ss[0], o); ss[1] += __shfl_xor(ss[1], o); }
#pragma unroll
      for (int u = 0; u < 2; ++u) {
        const int t = tb + u * nw;
        if (t < T) {
#pragma unroll
          for (int i = 0; i < 4; ++i) *(u32x2*)(XB + (size_t)t * 1024 + lane * 4 + 256 * i) = (u32x2){pk2(v[u][i].x, v[u][i].y), pk2(v[u][i].z, v[u][i].w)};
          if (lane == 0) { RS1[t] = rsqrtf(ss[u] * (1.f / 1024.f) + EPS); SSQ2[t] = 0.f; }
        }
      }
    }
  }
}

__device__ void prep_tables(const Params& p) {
  unsigned char* ws = p.ws;
  const int tid0 = otid();
  const int lane = tid0 & 63, gw = vblock() * NWAVES + (tid0 >> 6), nw = gridDim.x * NWAVES;
  {
    f32x4 gn[4];
#pragma unroll
    for (int i = 0; i < 4; ++i) gn[i] = *(const f32x4*)(p.norm_ffn_g + lane * 16 + 4 * i);
    for (int rb = gw; rb < 32768; rb += 2 * nw) {
      f32x4 v[2][4];
#pragma unroll
      for (int u = 0; u < 2; ++u) {
        const int r = (rb + u * nw < 32768) ? rb + u * nw : rb;
        const float* src = ((r >> 14) ? p.peer_v : p.peer_u) + (size_t)(r & 16383) * 1024 + lane * 16;
#pragma unroll
        for (int i = 0; i < 4; ++i) v[u][i] = *(const f32x4*)(src + 4 * i);
        if (!(r >> 14)) {
#pragma unroll
          for (int i = 0; i < 4; ++i) v[u][i] *= gn[i];
        }
      }
      float am[2] = {0.f, 0.f};
#pragma unroll
      for (int u = 0; u < 2; ++u)
#pragma unroll
        for (int i = 0; i < 4; ++i)
          am[u] = fmaxf(am[u], fmaxf(fmaxf(fabsf(v[u][i].x), fabsf(v[u][i].y)), fmaxf(fabsf(v[u][i].z), fabsf(v[u][i].w))));
#pragma unroll
      for (int o = 1; o < 64; o <<= 1) { am[0] = fmaxf(am[0], __shfl_xor(am[0], o)); am[1] = fmaxf(am[1], __shfl_xor(am[1], o)); }
#pragma unroll
      for (int u = 0; u < 2; ++u) {
        const int r = rb + u * nw;
        if (r < 32768) {
          const int isv = r >> 14, e = r & 16383;
          const float scale = am[u] > 0.f ? am[u] * (1.f / 6.f) : 1.f, inv = am[u] > 0.f ? 6.f / am[u] : 0.f;
          unsigned q[2] = {0u, 0u};
#define TQ(i, j0, w, sel) q[w] = __builtin_amdgcn_cvt_scalef32_pk_fp4_f32(q[w], v[u][i][j0] * inv, v[u][i][j0 + 1] * inv, 1.0f, sel);
          TQ(0, 0, 0, 0) TQ(0, 2, 0, 1) TQ(1, 0, 0, 2) TQ(1, 2, 0, 3)
          TQ(2, 0, 1, 0) TQ(2, 2, 1, 1) TQ(3, 0, 1, 2) TQ(3, 2, 1, 3)
#undef TQ
          if (isv) {
            *(u32x2*)(ws + WS_V8 + (size_t)e * 512 + lane * 8) = (u32x2){q[0], q[1]};
            if (lane == 0) ((float*)(ws + WS_USV))[2 * e + 1] = scale;
          } else {
            *(u32x2*)(ws + WS_U8 + (size_t)e * 512 + lane * 8) = (u32x2){q[0], q[1]};
            if (lane == 0) ((float*)(ws + WS_USV))[2 * e] = scale;
          }
        }
      }
    }
  }
}

namespace pg8 {
typedef short sbf16x8 __attribute__((ext_vector_type(8)));
constexpr int BM = 256, BK = 64, HALF = 128, HTB = HALF * BK * 2  , NXCD = 8, WGM = 8;
__device__ __forceinline__ int lds_byte(int r, int c) { const int st = (r >> 4) * 2 + (c >> 5), rr = r & 15, cc = c & 31, ob = rr * 64 + cc * 2; return st * 1024 + (ob ^ (((ob >> 9) & 1) << 5)); }
__device__ __forceinline__ void stage_rc(int b, int& R, int& C) { const int st = b / 1024, sb = b % 1024, swz = sb ^ (((sb >> 9) & 1) << 5); R = (st >> 1) * 16 + swz / 64; C = (st & 1) * 32 + (swz % 64) / 2; }
__device__ __forceinline__ int perm32(int rho) { const int n = rho >> 4, i = rho & 15; return 8 * (i >> 2) + 4 * n + (i & 3); }
struct Unit { int pm, pn; };
struct Gemm { const bf16_t* A; const bf16_t* Bt; int M, N, K; };
struct StaticOrder {
    int nM, nN, nwg, G, c;
    __device__ void init(int M, int N, int G_, int c_) { nM = M / BM; nN = N / BM; nwg = nM * nN; G = G_; c = c_; }
    __device__ bool next(int i, Unit& u) const {
        const long L = (long)i * G + c; if (L >= nwg) return false;
        int wgid = (int)L; { const int q = nwg / NXCD, r = nwg % NXCD, xcd = wgid % NXCD, off = wgid / NXCD; wgid = (xcd < r ? xcd * (q + 1) : r * (q + 1) + (xcd - r) * q) + off; }
        const int nig = WGM * nN, gid = wgid / nig, fm = gid * WGM, gsz = (nM - fm) < WGM ? (nM - fm) : WGM;
        u.pm = fm + ((wgid % nig) % gsz); u.pn = (wgid % nig) / gsz; return true;
    }
};
template <class Epi>
__device__ __forceinline__ void gemm_phase(LAS unsigned char* lds, const Gemm g, const StaticOrder& S, const Epi& E) {
    const int tid = otid(), wid = __builtin_amdgcn_readfirstlane(tid >> 6), lane = tid & 63, wr = wid >> 2, wc = wid & 3, fr = lane & 15, fq = lane >> 4;
    const int K = g.K, nt = K / BK;
    unsigned voffA[2], voffB[2];
#pragma unroll
    for (int i = 0; i < 2; ++i) { int R, C; stage_rc(tid * 16 + i * 8192, R, C); const int Rb = Epi::PERM ? ((R & ~31) + perm32(R & 31)) : R;
        voffA[i] = (unsigned)(R * K + C) * 2u; voffB[i] = (unsigned)(Rb * K + C) * 2u; }
    const size_t kstep = (size_t)(BK * 2);
    const size_t hstep = (size_t)HALF * K * 2;
    const size_t tstep = 2 * hstep;
    const unsigned ldsw = (unsigned)wid * 1024u;
    const int aoff = lds_byte(wr * 64 + fr, fq * 8), boff = lds_byte(wc * 32 + fr, fq * 8);
#define PG8_SA(b, h) (((b) * 2 + (h)) * HTB)
#define PG8_SB(b, h) ((4 + (b) * 2 + (h)) * HTB)
#define PG8_STAGE(bufoff, gbase, voff) do { _Pragma("unroll") for (int _i = 0; _i < 2; ++_i) \
        __builtin_amdgcn_global_load_lds((const unsigned*)((const char*)(gbase) + (voff)[_i]), (LAS unsigned*)(lds + (bufoff) + ldsw + _i * 8192), 16, 0, 0); } while (0)
#define PG8_LDA(dst, b, h) do { _Pragma("unroll") for (int m = 0; m < 4; ++m) _Pragma("unroll") for (int k = 0; k < 2; ++k) dst[m][k] = *(const LAS sbf16x8*)(lds + PG8_SA(b, h) + aoff + m * 2048 + k * 1024); } while (0)
#define PG8_LDB(dst, b, h) do { _Pragma("unroll") for (int n = 0; n < 2; ++n) _Pragma("unroll") for (int k = 0; k < 2; ++k) dst[n][k] = *(const LAS sbf16x8*)(lds + PG8_SB(b, h) + boff + n * 2048 + k * 1024); } while (0)
#define PG8_MMA(ai, bj, At, Bt) do { __builtin_amdgcn_s_setprio(1); _Pragma("unroll") for (int m = 0; m < 4; ++m) _Pragma("unroll") for (int n = 0; n < 2; ++n) _Pragma("unroll") for (int k = 0; k < 2; ++k) \
        acc[ai][bj][m][n] = __builtin_amdgcn_mfma_f32_16x16x32_bf16(__builtin_bit_cast(bf16x8, Bt[n][k]), __builtin_bit_cast(bf16x8, At[m][k]), acc[ai][bj][m][n], 0, 0, 0); __builtin_amdgcn_s_setprio(0); } while (0)
#define PG8_WAIT_V(n) asm volatile("s_waitcnt vmcnt(" #n ")" ::: "memory")
#define PG8_WAIT_L(n) asm volatile("s_waitcnt lgkmcnt(" #n ")" ::: "memory")
#define PG8_BAR __builtin_amdgcn_s_barrier()
#define PG8_SCHED __builtin_amdgcn_sched_barrier(0)
    Unit cur, nxt; int ui = 0;
    if (!S.next(0, cur)) return;
    f32x4 acc[2][2][4][2];
#pragma unroll
    for (int a = 0; a < 2; ++a)
#pragma unroll
        for (int b = 0; b < 2; ++b)
#pragma unroll
            for (int m = 0; m < 4; ++m)
#pragma unroll
                for (int n = 0; n < 2; ++n) acc[a][b][m][n] = (f32x4){0.f, 0.f, 0.f, 0.f};
    sbf16x8 At[4][2], B0[2][2], B1[2][2];
    const char* cA = (const char*)g.A + (size_t)cur.pm * tstep; const char* cB = (const char*)g.Bt + (size_t)cur.pn * tstep;
    PG8_STAGE(PG8_SB(0, 0), cB, voffB); PG8_STAGE(PG8_SA(0, 0), cA, voffA); PG8_STAGE(PG8_SB(0, 1), cB + hstep, voffB); PG8_STAGE(PG8_SA(0, 1), cA + hstep, voffA);
    if (wr == 1) PG8_BAR;
    PG8_WAIT_V(4); PG8_BAR;
    PG8_STAGE(PG8_SB(1, 0), cB + kstep, voffB); PG8_STAGE(PG8_SA(1, 0), cA + kstep, voffA); PG8_STAGE(PG8_SB(1, 1), cB + hstep + kstep, voffB);
    PG8_WAIT_V(6); PG8_BAR;
    for (;;) {
        const bool has_next = S.next(ui + 1, nxt);
        const char* nA = has_next ? (const char*)g.A + (size_t)nxt.pm * tstep : cA; const char* nB = has_next ? (const char*)g.Bt + (size_t)nxt.pn * tstep : cB;
        for (int t = 0; t < nt; t += 2) {
            const bool last = (t == nt - 2);
            const char* a1 = cA + (size_t)(t + 1) * kstep;
            const char* a2 = last ? nA : cA + (size_t)(t + 2) * kstep; const char* b2 = last ? nB : cB + (size_t)(t + 2) * kstep;
            const char* a3 = a2 + kstep; const char* b3 = b2 + kstep;
            PG8_LDB(B0, 0, 0); PG8_SCHED; PG8_LDA(At, 0, 0); PG8_STAGE(PG8_SA(1, 1), a1 + hstep, voffA);
            PG8_WAIT_L(8); PG8_BAR; PG8_WAIT_L(0); PG8_MMA(0, 0, At, B0); PG8_BAR; PG8_SCHED;
            PG8_LDB(B1, 0, 1); PG8_STAGE(PG8_SB(0, 0), b2, voffB);
            PG8_BAR; PG8_WAIT_L(0); PG8_MMA(0, 1, At, B1); PG8_BAR;
            PG8_LDA(At, 0, 1); PG8_STAGE(PG8_SA(0, 0), a2, voffA);
            PG8_BAR; PG8_WAIT_L(0); PG8_MMA(1, 0, At, B0); PG8_BAR; PG8_SCHED;
            PG8_STAGE(PG8_SB(0, 1), b2 + hstep, voffB);
            PG8_WAIT_V(6); PG8_BAR; PG8_MMA(1, 1, At, B1); PG8_BAR;
            PG8_LDB(B0, 1, 0); PG8_SCHED; PG8_LDA(At, 1, 0); PG8_STAGE(PG8_SA(0, 1), a2 + hstep, voffA);
            PG8_WAIT_L(8); PG8_BAR; PG8_WAIT_L(0); PG8_MMA(0, 0, At, B0); PG8_BAR; PG8_SCHED;
            PG8_LDB(B1, 1, 1); PG8_STAGE(PG8_SB(1, 0), b3, voffB);
            PG8_BAR; PG8_WAIT_L(0); PG8_MMA(0, 1, At, B1); PG8_BAR;
            PG8_LDA(At, 1, 1); PG8_STAGE(PG8_SA(1, 0), a3, voffA);
            PG8_BAR; PG8_WAIT_L(0); PG8_MMA(1, 0, At, B0); PG8_BAR; PG8_SCHED;
            PG8_STAGE(PG8_SB(1, 1), b3 + hstep, voffB);
            PG8_WAIT_V(6); PG8_BAR; PG8_MMA(1, 1, At, B1); PG8_BAR;
        }
        E(acc, cur, wr, wc, fr, fq);
        if (!has_next) break;
#pragma unroll
        for (int a = 0; a < 2; ++a)
#pragma unroll
            for (int b = 0; b < 2; ++b)
#pragma unroll
                for (int m = 0; m < 4; ++m)
#pragma unroll
                    for (int n = 0; n < 2; ++n) acc[a][b][m][n] = (f32x4){0.f, 0.f, 0.f, 0.f};
        cur = nxt; cA = nA; cB = nB; ++ui;
    }
    PG8_WAIT_V(0);
    if (wr == 0) PG8_BAR;
    PG8_BAR;
#undef PG8_SA
#undef PG8_SB
#undef PG8_STAGE
#undef PG8_LDA
#undef PG8_LDB
#undef PG8_MMA
#undef PG8_WAIT_V
#undef PG8_WAIT_L
#undef PG8_BAR
#undef PG8_SCHED
}
}

struct EpiQKC {
  static constexpr bool PERM = true;
  const float* rs1; const float* qg; const float* kg; bf16_t* Q; bf16_t* Kk; bf16_t* HG;
  __device__ __forceinline__ void operator()(const f32x4 (&acc)[2][2][4][2], const pg8::Unit& u, int wr, int wc, int fr, int fq) const {
    const int row0 = u.pm * 256 + wr * 64 + fr;
    if (u.pn < 4) {
      const bool isq = u.pn < 2;
      const int head = 4 * (u.pn & 1) + wc;
      const float* g = isq ? qg : kg;
      f32x4 gv[2][2];
#pragma unroll
      for (int bj = 0; bj < 2; ++bj)
#pragma unroll
        for (int n = 0; n < 2; ++n) gv[bj][n] = *(const f32x4*)(g + 32 * bj + 8 * fq + 4 * n);
      bf16_t* base = isq ? Q : Kk;
#pragma unroll
      for (int ai = 0; ai < 2; ++ai)
#pragma unroll
        for (int m = 0; m < 4; ++m) {
          const int t = row0 + ai * 128 + m * 16;
          float ss = 0.f;
#pragma unroll
          for (int bj = 0; bj < 2; ++bj)
#pragma unroll
            for (int n = 0; n < 2; ++n) { const f32x4 v = acc[ai][bj][m][n]; ss += v.x * v.x + v.y * v.y + v.z * v.z + v.w * v.w; }
          ss += __shfl_xor(ss, 16);
          ss += __shfl_xor(ss, 32);
          const float r = rs1[t];
          float sc = r * rsqrtf(r * r * ss * (1.f / 64.f) + EPS);
          if (isq) sc *= 0.125f * LOG2E;
          const size_t bh = (size_t)((t >> 12) * 8 + head);
          const int pos = t & 4095;
          bf16_t* dst = isq ? base + (bh * 4096 + pos) * 64 + 8 * fq
                            : base + (bh * 4096 + (pos & ~31)) * 64 + ((((fq >> 1) * 2 + (fq & 1)) * 32) + (pos & 31)) * 8;
#pragma unroll
          for (int bj = 0; bj < 2; ++bj) {
            const f32x4 a = acc[ai][bj][m][0] * gv[bj][0] * sc, b = acc[ai][bj][m][1] * gv[bj][1] * sc;
            *(u32x4*)(dst + (isq ? 32 * bj : 1024 * bj)) = (u32x4){pk2(a.x, a.y), pk2(a.z, a.w), pk2(b.x, b.y), pk2(b.z, b.w)};
          }
        }
    } else {
      const int ch0 = 128 * (u.pn - 4) + 32 * wc + 8 * fq;
#pragma unroll
      for (int ai = 0; ai < 2; ++ai)
#pragma unroll
        for (int m = 0; m < 4; ++m) {
          const int t = row0 + ai * 128 + m * 16;
          const float r = rs1[t];
          float h[8];
#pragma unroll
          for (int n = 0; n < 2; ++n)
#pragma unroll
            for (int j = 0; j < 4; ++j) h[4 * n + j] = acc[ai][0][m][n][j] * r / (1.f + __expf(-acc[ai][1][m][n][j] * r));
          *(u32x4*)(HG + (size_t)t * 512 + ch0) = (u32x4){pk2(h[0], h[1]), pk2(h[2], h[3]), pk2(h[4], h[5]), pk2(h[6], h[7])};
        }
    }
  }
};
struct EpiVt {
  static constexpr bool PERM = false;
  const float* rs1; bf16_t* Vt;
  __device__ __forceinline__ void operator()(const f32x4 (&acc)[2][2][4][2], const pg8::Unit& u, int wr, int wc, int fr, int fq) const {
    const int pos0 = 8 * (fq & 1) + 4 * (fq >> 1);
#pragma unroll
    for (int bj = 0; bj < 2; ++bj)
#pragma unroll
      for (int n = 0; n < 2; ++n) {
        const int t = u.pn * 256 + bj * 128 + wc * 32 + n * 16 + 4 * fq;
        const f32x4 r = *(const f32x4*)(rs1 + t);
        const size_t tb = ((size_t)(t >> 12) * 8) * 128 + ((t & 4095) >> 5);
#pragma unroll
        for (int ai = 0; ai < 2; ++ai)
#pragma unroll
          for (int m = 0; m < 4; ++m) {
            const int dg = u.pm * 256 + ai * 128 + wr * 64 + m * 16 + fr, head = dg >> 6, d = dg & 63;
            const f32x4 v = acc[ai][bj][m][n] * r;
            *(u32x2*)(Vt + (tb + (size_t)head * 128) * 2048 + (((((d >> 5) * 2 + n) * 2 + (fq & 1)) * 32) + (d & 31)) * 8 + 4 * (fq >> 1)) = (u32x2){pk2(v.x, v.y), pk2(v.z, v.w)};
          }
      }
  }
};
struct EpiOut {
  static constexpr bool PERM = true;
  const bf16_t* xb; bf16_t* HB; float* ssq2;
  __device__ __forceinline__ void operator()(const f32x4 (&acc)[2][2][4][2], const pg8::Unit& u, int wr, int wc, int fr, int fq) const {
    const int row0 = u.pm * 256 + wr * 64 + fr, col0 = u.pn * 256 + wc * 32 + 8 * fq;
#pragma unroll
    for (int ai = 0; ai < 2; ++ai)
#pragma unroll
      for (int m = 0; m < 4; ++m) {
        const int t = row0 + ai * 128 + m * 16;
        const size_t ro = (size_t)t * 1024 + col0;
        float ss = 0.f;
#pragma unroll
        for (int bj = 0; bj < 2; ++bj) {
          const size_t o = ro + bj * 128;
          const u32x4 xv = *(const u32x4*)(xb + o);
          const f32x4 h0 = (f32x4){bflo(xv.x), bfhi(xv.x), bflo(xv.y), bfhi(xv.y)} + acc[ai][bj][m][0];
          const f32x4 h1 = (f32x4){bflo(xv.z), bfhi(xv.z), bflo(xv.w), bfhi(xv.w)} + acc[ai][bj][m][1];
          *(u32x4*)(HB + o) = (u32x4){pk2(h0.x, h0.y), pk2(h0.z, h0.w), pk2(h1.x, h1.y), pk2(h1.z, h1.w)};
          ss += (h0.x * h0.x + h0.y * h0.y + h0.z * h0.z + h0.w * h0.w) + (h1.x * h1.x + h1.y * h1.y + h1.z * h1.z + h1.w * h1.w);
        }
        ss += __shfl_xor(ss, 16);
        ss += __shfl_xor(ss, 32);
        if (fq == 0) atomicAdd(ssq2 + t, ss);
      }
  }
};
struct EpiQh {
  static constexpr bool PERM = true;
  const float* ssq2; bf16_t* QH;
  __device__ __forceinline__ void operator()(const f32x4 (&acc)[2][2][4][2], const pg8::Unit& u, int wr, int wc, int fr, int fq) const {
    const int row0 = u.pm * 256 + wr * 64 + fr, col0 = u.pn * 256 + wc * 32 + 8 * fq;
#pragma unroll
    for (int ai = 0; ai < 2; ++ai)
#pragma unroll
      for (int m = 0; m < 4; ++m) {
        const int t = row0 + ai * 128 + m * 16;
        const float r = rsqrtf(ssq2[t] * (1.f / 1024.f) + EPS);
#pragma unroll
        for (int bj = 0; bj < 2; ++bj) {
          const f32x4 a = acc[ai][bj][m][0] * r, b = acc[ai][bj][m][1] * r;
          *(u32x4*)(QH + (size_t)t * 1024 + col0 + bj * 128) = (u32x4){pk2(a.x, a.y), pk2(a.z, a.w), pk2(b.x, b.y), pk2(b.z, b.w)};
        }
      }
  }
};

__device__ void phase_inproj(const Params& p, char* smem) {
  unsigned char* ws = p.ws;
  LAS unsigned char* lds = (LAS unsigned char*)smem;
  const bf16_t* XB = (const bf16_t*)(ws + WS_XB);
  const float* RS1 = (const float*)(ws + WS_RS1);
  pg8::StaticOrder S;
  {
    pg8::Gemm g{XB, (const bf16_t*)(ws + WS_W1), T, 2048, 1024};
    S.init(T, 2048, gridDim.x, blockIdx.x);
    EpiQKC E{RS1, p.q_norm_g, p.k_norm_g, (bf16_t*)(ws + WS_Q), (bf16_t*)(ws + WS_K), (bf16_t*)(ws + WS_HG)};
    pg8::gemm_phase<EpiQKC>(lds, g, S, E);
  }
  {
    pg8::Gemm g{(const bf16_t*)(ws + WS_WV), XB, 512, T, 1024};
    S.init(512, T, gridDim.x, blockIdx.x);
    EpiVt E{RS1, (bf16_t*)(ws + WS_VT)};
    pg8::gemm_phase<EpiVt>(lds, g, S, E);
  }
}
__device__ void phase_outproj(const Params& p, char* smem) {
  unsigned char* ws = p.ws;
  pg8::Gemm g{(const bf16_t*)(ws + WS_MIX), (const bf16_t*)(ws + WS_WOUT), T, 1024, 1024};
  pg8::StaticOrder S;
  S.init(T, 1024, gridDim.x, blockIdx.x);
  EpiOut E{(const bf16_t*)(ws + WS_XB), (bf16_t*)(ws + WS_HB), (float*)(ws + WS_SSQ2)};
  pg8::gemm_phase<EpiOut>((LAS unsigned char*)smem, g, S, E);
}
__device__ void phase_qproj(const Params& p, char* smem) {
  unsigned char* ws = p.ws;
  pg8::Gemm g{(const bf16_t*)(ws + WS_HB), (const bf16_t*)(ws + WS_WQ), T, 1024, 1024};
  pg8::StaticOrder S;
  S.init(T, 1024, gridDim.x, blockIdx.x);
  EpiQh E{(const float*)(ws + WS_SSQ2), (bf16_t*)(ws + WS_QH)};
  pg8::gemm_phase<EpiQh>((LAS unsigned char*)smem, g, S, E);
}

__device__ __forceinline__ void conv_stage(const bf16_t* HG, int item, LAS unsigned char* buf, int wave, int lane) {
  const int t0 = item * 32, s0 = t0 & 4095;
#pragma unroll
  for (int j = 0; j < 8; ++j) {
    const int r = wave + 8 * j;
    if (r < 62) {
      if (s0 - 30 + r >= 0)
        __builtin_amdgcn_global_load_lds((const unsigned*)(HG + (size_t)(t0 - 30 + r) * 512 + lane * 8), (LAS unsigned*)(buf + r * 1024), 16, 0, 0);
      else
        *(LAS u32x4*)(buf + r * 1024 + lane * 16) = (u32x4){0u, 0u, 0u, 0u};
    }
  }
}
struct ConvW { f32x2 wv[31]; float2 cb, lg, lb; };
__device__ __forceinline__ void conv_compute(const Params& p, int item, const char* smem, const ConvW& W, int tid512) {
  bf16_t* MIX = (bf16_t*)(p.ws + WS_MIX);
  const int half = tid512 >> 8, tid = tid512 & 255, lane = tid & 63, wave = tid >> 6;
  const int t0 = item * 32;
  float* red = (float*)(smem + 62 * 1024) + half * 128;
  const bool b5 = lane & 32, b4 = lane & 16, b3 = lane & 8, b2 = lane & 4;
#pragma unroll 1
  for (int rd = 0; rd < 2; ++rd) {
    const int tb = 16 * half + 8 * rd;
    f32x2 xv[38];
#pragma unroll
    for (int r = 0; r < 38; ++r) {
      const unsigned v = *(const unsigned*)(smem + (tb + r) * 1024 + tid * 4);
      xv[r] = (f32x2){bflo(v), bfhi(v)};
    }
    float a0[8], a1[8], st[16];
#pragma unroll
    for (int k = 0; k < 8; ++k) {
      f32x2 u = {W.cb.x, W.cb.y};
#pragma unroll
      for (int j = 0; j < 31; ++j) u = __builtin_elementwise_fma(W.wv[j], xv[k + j], u);
      a0[k] = u.x; a1[k] = u.y;
      st[k] = u.x + u.y;
      st[8 + k] = u.x * u.x + u.y * u.y;
    }
    float r8[8], r4[4], r2[2], r1;
#pragma unroll
    for (int i = 0; i < 8; ++i) { const float keep = b5 ? st[8 + i] : st[i], send = b5 ? st[i] : st[8 + i]; r8[i] = keep + __shfl_xor(send, 32); }
#pragma unroll
    for (int i = 0; i < 4; ++i) { const float keep = b4 ? r8[4 + i] : r8[i], send = b4 ? r8[i] : r8[4 + i]; r4[i] = keep + __shfl_xor(send, 16); }
#pragma unroll
    for (int i = 0; i < 2; ++i) { const float keep = b3 ? r4[2 + i] : r4[i], send = b3 ? r4[i] : r4[2 + i]; r2[i] = keep + __shfl_xor(send, 8); }
    { const float keep = b2 ? r2[1] : r2[0], send = b2 ? r2[0] : r2[1]; r1 = keep + __shfl_xor(send, 4); }
    r1 += __shfl_xor(r1, 2);
    r1 += __shfl_xor(r1, 1);
    float* rr = red + rd * 64;
    if ((lane & 3) == 0) rr[wave * 16 + (lane >> 2)] = r1;
    __syncthreads();
#pragma unroll
    for (int k = 0; k < 8; ++k) {
      const float S1 = (rr[k] + rr[16 + k]) + (rr[32 + k] + rr[48 + k]);
      const float S2 = (rr[8 + k] + rr[24 + k]) + (rr[40 + k] + rr[56 + k]);
      const float mu = S1 * (1.f / 512.f);
      const float var = fmaxf(S2 * (1.f / 512.f) - mu * mu, 0.f);
      const float rstd = rsqrtf(var + EPS);
      const float y0 = (a0[k] - mu) * rstd * W.lg.x + W.lb.x, y1 = (a1[k] - mu) * rstd * W.lg.y + W.lb.y;
      const float z0 = y0 / (1.f + __expf(-y0)), z1 = y1 / (1.f + __expf(-y1));
      *(unsigned*)(MIX + (size_t)(t0 + tb + k) * 1024 + 512 + 2 * tid) = pk2(z0, z1);
    }
  }
}
__device__ void conv_items(const Params& p, char* smem) {
  const bf16_t* HG = (const bf16_t*)(p.ws + WS_HG);
  const int tid512 = otid(), tid = tid512 & 255, lane = tid512 & 63;
  const int wave = __builtin_amdgcn_readfirstlane(tid512 >> 6);
  const int vb = vblock(), G = gridDim.x;
  ConvW W;
#pragma unroll
  for (int j = 0; j < 31; ++j) {
    const float2 w = *(const float2*)(p.conv_w + j * 512 + 2 * tid);
    W.wv[j] = (f32x2){w.x, w.y};
  }
  W.cb = *(const float2*)(p.conv_b + 2 * tid);
  W.lg = *(const float2*)(p.conv_ln_g + 2 * tid);
  W.lb = *(const float2*)(p.conv_ln_b + 2 * tid);
  int b = 0;
  if (vb < 1024) conv_stage(HG, vb, (LAS unsigned char*)smem, wave, lane);
  for (int item = vb; item < 1024; item += G, b ^= 1) {
    asm volatile("s_waitcnt vmcnt(0) lgkmcnt(0)" ::: "memory");
    __syncthreads();
    if (item + G < 1024) conv_stage(HG, item + G, (LAS unsigned char*)smem + (b ^ 1) * 65536, wave, lane);
    conv_compute(p, item, smem + b * 65536, W, tid512);
  }
  __syncthreads();
}

struct AttnKV { bf16x8 k[4]; bf16x8 v[2][2]; };
__device__ __forceinline__ void attn_load(const bf16_t* Km, const bf16_t* Vt, int bh, int kb, int tok, int hf, AttnKV& f) {
  const int kc = kb < 0 ? 0 : kb;
  const bf16_t* kp = Km + ((size_t)bh * 128 + kc) * 2048 + (hf * 32 + tok) * 8;
#pragma unroll
  for (int ks = 0; ks < 4; ++ks) f.k[ks] = *(const bf16x8*)(kp + ks * 512);
  const bf16_t* vp = Vt + ((size_t)bh * 128 + kc) * 2048 + (hf * 32 + tok) * 8;
#pragma unroll
  for (int m = 0; m < 2; ++m)
#pragma unroll
    for (int s = 0; s < 2; ++s) f.v[m][s] = *(const bf16x8*)(vp + (m * 2 + s) * 512);
}
__device__ __forceinline__ bool attn_block(const AttnKV& f, const bf16x8 (&qf)[4], bool diag, int tok, int hf, float& c, f32x16& o0, f32x16& o1) {
  f32x16 sc;
#pragma unroll
  for (int i = 0; i < 16; ++i) sc[i] = 0.f;
#pragma unroll
  for (int ks = 0; ks < 4; ++ks) sc = mfma32(f.k[ks], qf[ks], sc);
  float kp[16], sg[16];
#pragma unroll
  for (int i = 0; i < 16; ++i) {
    const float e = __builtin_amdgcn_exp2f(fminf(sc[i], 80.f));
    const float r = __builtin_amdgcn_rcpf(1.f + e);
    kp[i] = r;
    sg[i] = e * r;
  }
  if (diag) {
#pragma unroll
    for (int i = 0; i < 16; ++i) {
      const bool valid = ((i & 3) + 8 * (i >> 2) + 4 * hf < tok);
      kp[i] = valid ? kp[i] : 1.f;
      sg[i] = valid ? sg[i] : 0.f;
    }
  }
  float Tg[4], Pg[4];
#pragma unroll
  for (int g = 0; g < 4; ++g) {
    Tg[g] = (kp[4 * g] * kp[4 * g + 1]) * (kp[4 * g + 2] * kp[4 * g + 3]);
    Pg[g] = __shfl_xor(Tg[g], 32);
  }
  float base[4];
  float run = __builtin_amdgcn_exp2f(c);
#pragma unroll
  for (int g = 3; g >= 0; --g) {
    base[g] = run * (hf == 0 ? Pg[g] : 1.f);
    run *= Tg[g] * Pg[g];
  }
  float pr[16];
#pragma unroll
  for (int g = 0; g < 4; ++g) {
    float l = base[g];
#pragma unroll
    for (int r = 3; r >= 0; --r) {
      pr[4 * g + r] = sg[4 * g + r] * l;
      l *= kp[4 * g + r];
    }
  }
  c = __builtin_amdgcn_logf(run);
  bf16x8 pf[2];
#pragma unroll
  for (int s = 0; s < 2; ++s)
#pragma unroll
    for (int j = 0; j < 8; ++j) pf[s][j] = (__bf16)pr[8 * s + j];
#pragma unroll
  for (int s = 0; s < 2; ++s) {
    o0 = mfma32(f.v[0][s], pf[s], o0);
    o1 = mfma32(f.v[1][s], pf[s], o1);
  }
  return __all(c < -150.f);
}
__device__ void attn_tile(const Params& p, int item, int it, int lane, int wave, char* smem) {
  unsigned char* ws = p.ws;
  const bf16_t* Qm = (const bf16_t*)(ws + WS_Q);
  const bf16_t* Km = (const bf16_t*)(ws + WS_K);
  const bf16_t* Vt = (const bf16_t*)(ws + WS_VT);
  bf16_t* MIX = (bf16_t*)(ws + WS_MIX);
  const int qt = item & 127, bh = (item >> 7) * 8 + wave;
  const int tok = lane & 31, hf = lane >> 5;
  bf16x8 qf[4];
  {
    const bf16_t* qp = Qm + ((size_t)bh * 4096 + qt * 32 + tok) * 64 + 8 * hf;
#pragma unroll
    for (int ks = 0; ks < 4; ++ks) qf[ks] = *(const bf16x8*)(qp + ks * 16);
  }
  f32x16 o0, o1;
#pragma unroll
  for (int i = 0; i < 16; ++i) { o0[i] = 0.f; o1[i] = 0.f; }
  float c = 0.f;
  AttnKV fa, fb;
  attn_load(Km, Vt, bh, qt, tok, hf, fa);
  {
    unsigned z = __builtin_bit_cast(u32x4, fa.v[1][1]).w | __builtin_bit_cast(u32x4, fa.k[3]).w | __builtin_bit_cast(u32x4, qf[3]).w;
    asm volatile("" ::"v"(z));
  }
  for (int kb = qt;; kb -= 2) {
    attn_load(Km, Vt, bh, kb - 1, tok, hf, fb);
    __builtin_amdgcn_sched_barrier(0);
    if (attn_block(fa, qf, kb == qt, tok, hf, c, o0, o1) || kb == 0) break;
    attn_load(Km, Vt, bh, kb - 2, tok, hf, fa);
    __builtin_amdgcn_sched_barrier(0);
    if (attn_block(fb, qf, false, tok, hf, c, o0, o1) || kb == 1) break;
  }
  float ssq = 0.f;
#pragma unroll
  for (int i = 0; i < 16; ++i) ssq += o0[i] * o0[i] + o1[i] * o1[i];
  ssq += __shfl_xor(ssq, 32);
  float* xch = (float*)(smem + 100 * 1024) + (it & 1) * 256;
  if (hf == 0) xch[wave * 32 + tok] = ssq;
  __syncthreads();
  float tot = 0.f;
#pragma unroll
  for (int w = 0; w < NWAVES; ++w) tot += xch[w * 32 + tok];
  const float rs = rsqrtf(tot * (1.f / 512.f) + EPS);
  const int t = (bh >> 3) * 4096 + qt * 32 + tok, hh = bh & 7;
  bf16_t* dst = MIX + (size_t)t * 1024 + hh * 64 + 4 * hf;
#pragma unroll
  for (int g = 0; g < 4; ++g) {
    *(u32x2*)(dst + 8 * g) = (u32x2){pk2(o0[4 * g] * rs, o0[4 * g + 1] * rs), pk2(o0[4 * g + 2] * rs, o0[4 * g + 3] * rs)};
    *(u32x2*)(dst + 32 + 8 * g) = (u32x2){pk2(o1[4 * g] * rs, o1[4 * g + 1] * rs), pk2(o1[4 * g + 2] * rs, o1[4 * g + 3] * rs)};
  }
}

__device__ void phase_mix(const Params& p, char* smem) {
  static_assert(NWAVES == 8, "one wave per attention head");
  const int vb = vblock(), G = gridDim.x;
  if (blockIdx.x & 1) prep_tables(p);
  conv_items(p, smem);
  const int tidm = otid();
  const int lane = tidm & 63, wave = tidm >> 6;
  int it = 0;
  for (int item = vb; item < 1024; item += G, ++it) attn_tile(p, item, it, lane, wave, smem);
  if (!(blockIdx.x & 1)) prep_tables(p);
}
__device__ __forceinline__ unsigned f2key(float f, unsigned n) {
  const unsigned u = (__float_as_uint(f) & ~0x7Fu) | n;
  return u ^ ((unsigned)((int)u >> 31) | 0x80000000u);
}
__device__ __forceinline__ unsigned f2key_raw(float f) {
  const unsigned u = __float_as_uint(f);
  return u ^ ((unsigned)((int)u >> 31) | 0x80000000u);
}
__device__ __forceinline__ unsigned key2u(unsigned k) { return k ^ ((k >> 31) ? 0x80000000u : 0xFFFFFFFFu); }

template <int N>
__device__ __forceinline__ void bitonic_sort_desc(unsigned (&v)[N]) {
#pragma unroll
  for (int k = 2; k <= N; k <<= 1) {
#pragma unroll
    for (int j = k >> 1; j > 0; j >>= 1) {
#pragma unroll
      for (int i = 0; i < N; ++i) {
        const int l = i ^ j;
        if (l > i) {
          const bool desc = ((i & k) == 0);
          const unsigned mx = max(v[i], v[l]), mn = min(v[i], v[l]);
          v[i] = desc ? mx : mn;
          v[l] = desc ? mn : mx;
        }
      }
    }
  }
}
template <int N>
__device__ __forceinline__ void bitonic_merge_desc(unsigned (&v)[N]) {
#pragma unroll
  for (int j = N >> 1; j > 0; j >>= 1) {
#pragma unroll
    for (int i = 0; i < N; ++i) {
      const int l = i ^ j;
      if (l > i) {
        const unsigned mx = max(v[i], v[l]), mn = min(v[i], v[l]);
        v[i] = mx;
        v[l] = mn;
      }
    }
  }
}
__device__ __forceinline__ void merge_top16(unsigned (&a)[16], const unsigned (&b)[16]) {
#pragma unroll
  for (int i = 0; i < 16; ++i) a[i] = max(a[i], b[15 - i]);
  bitonic_merge_desc<16>(a);
}
#define CEP(ka, pa, kb, pb, desc)                                  \
  {                                                                \
    const bool sw_ = (desc) ? ((kb) > (ka)) : ((kb) < (ka));       \
    const unsigned tk_ = sw_ ? (kb) : (ka), tl_ = sw_ ? (ka) : (kb); \
    const unsigned tp_ = sw_ ? (pb) : (pa), tq_ = sw_ ? (pa) : (pb); \
    ka = tk_; kb = tl_; pa = tp_; pb = tq_;                        \
  }
template <int N>
__device__ __forceinline__ void bitonic_sort_desc_p(unsigned (&v)[N], unsigned (&pl)[N]) {
#pragma unroll
  for (int k = 2; k <= N; k <<= 1) {
#pragma unroll
    for (int j = k >> 1; j > 0; j >>= 1) {
#pragma unroll
      for (int i = 0; i < N; ++i) {
        const int l = i ^ j;
        if (l > i) {
          const bool desc = ((i & k) == 0);
          CEP(v[i], pl[i], v[l], pl[l], desc);
        }
      }
    }
  }
}
template <int N>
__device__ __forceinline__ void bitonic_merge_desc_p(unsigned (&v)[N], unsigned (&pl)[N]) {
#pragma unroll
  for (int j = N >> 1; j > 0; j >>= 1) {
#pragma unroll
    for (int i = 0; i < N; ++i) {
      const int l = i ^ j;
      if (l > i) { CEP(v[i], pl[i], v[l], pl[l], true); }
    }
  }
}
__device__ __forceinline__ void merge_top16_p(unsigned (&a)[16], unsigned (&pa)[16], const unsigned (&b)[16], const unsigned (&pb)[16]) {
#pragma unroll
  for (int i = 0; i < 16; ++i) {
    const bool s = b[15 - i] > a[i];
    a[i] = s ? b[15 - i] : a[i];
    pa[i] = s ? pb[15 - i] : pa[i];
  }
  bitonic_merge_desc_p<16>(a, pa);
}

constexpr int KROW = 144;
__device__ __forceinline__ void subkey_top16(const LAS unsigned char* Kl, const bf16_t* __restrict__ qrow, int lane, unsigned (&top)[16]) {
  const int tok = lane & 31, hf = lane >> 5;
  f32x16 acc[4];
#pragma unroll
  for (int m = 0; m < 4; ++m)
#pragma unroll
    for (int i = 0; i < 16; ++i) acc[m][i] = 0.f;
  bf16x8 bq[4];
#pragma unroll
  for (int ks = 0; ks < 4; ++ks) bq[ks] = *(const bf16x8*)(qrow + ks * 16 + 8 * hf);
#pragma unroll 1
  for (int ks = 0; ks < 4; ++ks) {
#pragma unroll
    for (int m = 0; m < 4; ++m) {
      const bf16x8 ak = *(const LAS bf16x8*)(Kl + (m * 32 + tok) * KROW + ks * 32 + hf * 16);
      acc[m] = mfma32(ak, ks == 0 ? bq[0] : ks == 1 ? bq[1] : ks == 2 ? bq[2] : bq[3], acc[m]);
    }
  }
  unsigned g[4][16];
#pragma unroll
  for (int m = 0; m < 4; ++m) {
#pragma unroll
    for (int i = 0; i < 16; ++i) g[m][i] = f2key(acc[m][i], (unsigned)(m * 32 + (i & 3) + 8 * (i >> 2) + 4 * hf));
    bitonic_sort_desc<16>(g[m]);
  }
  merge_top16(g[0], g[1]);
  merge_top16(g[2], g[3]);
  merge_top16(g[0], g[2]);
  unsigned o[16];
#pragma unroll
  for (int i = 0; i < 16; ++i) o[i] = __shfl_xor(g[0][i], 32);
  merge_top16(g[0], o);
#pragma unroll
  for (int i = 0; i < 16; ++i) top[i] = g[0][i];
}

__device__ void phase_route(const Params& p, char* smem) {
  unsigned char* ws = p.ws;
  const bf16_t* K1 = (const bf16_t*)(ws + WS_K1);
  const bf16_t* K2 = (const bf16_t*)(ws + WS_K2);
  const bf16_t* QH = (const bf16_t*)(ws + WS_QH);
  const bf16_t* HB = (const bf16_t*)(ws + WS_HB);
  unsigned char* XN8 = ws + WS_XN8;
  const float* SSQ2 = (const float*)(ws + WS_SSQ2);
  unsigned* PIDX = (unsigned*)(ws + WS_PIDX);
  float* PG = (float*)(ws + WS_PG);
  const int tidr = otid();
  const int lane = tidr & 63, wave = tidr >> 6, gw = vblock() * NWAVES + wave, nw = gridDim.x * NWAVES;
  const int G = gridDim.x, nh = (G % 8 == 0) ? 8 : 1;
  LAS unsigned char* K1l = (LAS unsigned char*)smem;
  LAS unsigned char* K2l = K1l + 128 * KROW;
  for (int hd = blockIdx.x % nh; hd < 8; hd += nh) {
    for (int idx = tidr; idx < 2048; idx += NTHREADS) {
      const int tb = idx >> 10, row = (idx >> 3) & 127, ch = idx & 7;
      const u32x4 v = *(const u32x4*)((tb ? K2 : K1) + hd * 8192 + row * 64 + ch * 8);
      *(LAS u32x4*)((tb ? K2l : K1l) + row * KROW + ch * 16) = v;
    }
    __syncthreads();
    for (int tile = (blockIdx.x / nh) * NWAVES + wave; tile < T / 32; tile += (G / nh) * NWAVES) {
      const int t0 = tile * 32;
      const int tok = lane & 31, hf = lane >> 5;
      const bf16_t* qrow = QH + (size_t)(t0 + tok) * 1024 + hd * 128;
      unsigned top1[16], top2[16];
      subkey_top16(K1l, qrow, lane, top1);
      subkey_top16(K2l, qrow + 64, lane, top2);
      float fa[16], fb[16];
      unsigned ia[16], ib[16];
#pragma unroll
      for (int i = 0; i < 16; ++i) {
        const unsigned ua = key2u(hf ? top2[i] : top1[i]), ub = key2u(hf ? top1[i] : top2[i]);
        fa[i] = __uint_as_float(ua); ia[i] = ua & 0x7Fu;
        fb[i] = __uint_as_float(ub); ib[i] = ub & 0x7Fu;
      }
      unsigned ck[32];
      {
        int n = 0;
#pragma unroll
        for (int i = 0; i < 4; ++i) {
#pragma unroll
          for (int j = i; j < 16; ++j) {
            if ((i + 1) * (j + 1) <= 16) {
              unsigned key = (f2key_raw(fa[i] + fb[j]) & ~0x3FFFu) | (hf ? ((ib[j] << 7) | ia[i]) : ((ia[i] << 7) | ib[j]));
              if (i == j && hf) key = 0u;
              ck[n] = key;
              ++n;
            }
          }
        }
#pragma unroll
        for (; n < 32; ++n) ck[n] = 0u;
      }
      unsigned k0[16], k1[16];
#pragma unroll
      for (int i = 0; i < 16; ++i) { k0[i] = ck[i]; k1[i] = ck[16 + i]; }
      bitonic_sort_desc<16>(k0);
      bitonic_sort_desc<16>(k1);
      merge_top16(k0, k1);
#pragma unroll
      for (int i = 0; i < 16; ++i) k1[i] = __shfl_xor(k0[i], 32);
      merge_top16(k0, k1);
      float sv[16], sum = 0.f;
      const float mx = __uint_as_float(key2u(k0[0] & ~0x3FFFu));
#pragma unroll
      for (int i = 0; i < 16; ++i) {
        sv[i] = __builtin_amdgcn_exp2f((__uint_as_float(key2u(k0[i] & ~0x3FFFu)) - mx) * LOG2E);
        sum += sv[i];
      }
      const float inv = 1.f / sum;
      const size_t po = ((size_t)(t0 + tok) * 8 + hd) * 16;
      if (hf == 0) {
#pragma unroll
        for (int q = 0; q < 4; ++q) *(u32x4*)(PIDX + po + 4 * q) = (u32x4){k0[4 * q] & 0x3FFFu, k0[4 * q + 1] & 0x3FFFu, k0[4 * q + 2] & 0x3FFFu, k0[4 * q + 3] & 0x3FFFu};
      } else {
#pragma unroll
        for (int q = 0; q < 4; ++q) *(f32x4*)(PG + po + 4 * q) = (f32x4){sv[4 * q] * inv, sv[4 * q + 1] * inv, sv[4 * q + 2] * inv, sv[4 * q + 3] * inv};
      }
    }
    __syncthreads();
  }
}

typedef int i32x8 __attribute__((ext_vector_type(8)));
__device__ __forceinline__ f32x4 mfma_fp4_fp8(u32x4 a, u32x4 b0, u32x4 b1, f32x4 c) {
  const i32x8 A = {(int)a.x, (int)a.y, (int)a.z, (int)a.w, 0, 0, 0, 0};
  const i32x8 B = {(int)b0.x, (int)b0.y, (int)b0.z, (int)b0.w, (int)b1.x, (int)b1.y, (int)b1.z, (int)b1.w};
  return __builtin_amdgcn_mfma_scale_f32_16x16x128_f8f6f4(A, B, c, 4, 0, 0, 0x7F7F7F7F, 0, 0x7F7F7F7F);
}
struct PeCtx {
  const unsigned char* U8; const float2* USV; LAS float* glist;
  LAS unsigned* list; int lane, r, g, s, n, t0;
};
__device__ __forceinline__ void pe_rows(const PeCtx& c, int ci, u32x4 (&a)[8]) {
  const int idx = ci * 16 + (c.lane >> 2);
  const unsigned ent = c.list[idx & 2047];
  const unsigned e = (idx < c.n) ? ((ent >> 7) & 16383u) : (unsigned)(c.s << 11);
  const unsigned char* rp = c.U8 + (size_t)e * 512 + (c.lane & 3) * 16;
#pragma unroll
  for (int ks = 0; ks < 8; ++ks) a[ks] = *(const u32x4*)(rp + ks * 64);
}
__device__ __forceinline__ void pe_fix(const PeCtx& c, u32x4 (&a)[8]) {
  const int src = 4 * c.r + c.g;
#pragma unroll
  for (int ks = 0; ks < 8; ++ks) {
    a[ks].x = (unsigned)__shfl((int)a[ks].x, src); a[ks].y = (unsigned)__shfl((int)a[ks].y, src);
    a[ks].z = (unsigned)__shfl((int)a[ks].z, src); a[ks].w = (unsigned)__shfl((int)a[ks].w, src);
  }
}
__device__ __forceinline__ void pe_chunk(const PeCtx& c, int ci, u32x4 (&a)[8], u32x4 (&anext)[8], const u32x4 (&bq)[16]) {
  const int idx = ci * 16 + c.r;
  const unsigned ent = c.list[idx & 2047];
  const bool fin = (c.lane < 16) && (idx < c.n);
  const unsigned e = (ent >> 7) & 16383u, col = (ent >> 21) & 15u;
  const float2 usv = c.USV[fin ? e : 0u];
  const float gt = c.glist[idx & 2047], us = usv.x, vs = usv.y;
  __builtin_amdgcn_sched_barrier(0);
  pe_rows(c, ci + 1, anext);
  __builtin_amdgcn_sched_barrier(0);
  pe_fix(c, a);
  f32x4 acc = {0.f, 0.f, 0.f, 0.f};
#pragma unroll
  for (int ks = 0; ks < 8; ++ks) acc = mfma_fp4_fp8(a[ks], bq[2 * ks], bq[2 * ks + 1], acc);
  const int src = ((c.r >> 2) << 4) | (int)col;
  const float v0 = __shfl(acc[0], src), v1 = __shfl(acc[1], src), v2 = __shfl(acc[2], src), v3 = __shfl(acc[3], src);
  float d = ((c.r & 3) == 0) ? v0 : ((c.r & 3) == 1) ? v1 : ((c.r & 3) == 2) ? v2 : v3;
  float gt_ = gt, us_ = us, vs_ = vs;
  asm volatile("" : "+v"(d), "+v"(gt_), "+v"(us_), "+v"(vs_));
  {
    const float act = d * us_ * (1.f / 16.f);
    const float w = gt_ * 0.5f * act * (1.f + erff(act * 0.70710678118654752f)) * vs_;
    if (fin) c.glist[idx & 2047] = w;
  }
}
#define PFV_LOAD(R, ev, k0)                                                                               \
  {                                                                                                       \
    _Pragma("unroll") for (int i_ = 0; i_ < 8; ++i_) {                                                    \
      const unsigned e_ = (unsigned)__builtin_amdgcn_ds_bpermute(bsel + 4 * ((k0) + 2 * i_), (int)(ev)); \
      R[i_] = *(const u32x4*)(V4 + (e_ << 9));                                                            \
    }                                                                                                     \
  }
#define PFV_FMA(dw, b, a) acc[a] = __builtin_elementwise_fma(__builtin_amdgcn_cvt_scalef32_pk_f32_fp4(dw, 1.0f, b), w2_, acc[a]);
#define PFV_ACC(R, wv, k0)                                                                                \
  {                                                                                                       \
    _Pragma("unroll") for (int i_ = 0; i_ < 8; ++i_) {                                                    \
      const float ws_ = __builtin_bit_cast(float, __builtin_amdgcn_ds_bpermute(bsel + 4 * ((k0) + 2 * i_), __builtin_bit_cast(int, (wv)))); \
      const f32x2 w2_ = {ws_, ws_};                                                                       \
      PFV_FMA(R[i_].x, 0, 0)  PFV_FMA(R[i_].x, 1, 1)  PFV_FMA(R[i_].x, 2, 2)  PFV_FMA(R[i_].x, 3, 3)      \
      PFV_FMA(R[i_].y, 0, 4)  PFV_FMA(R[i_].y, 1, 5)  PFV_FMA(R[i_].y, 2, 6)  PFV_FMA(R[i_].y, 3, 7)      \
      PFV_FMA(R[i_].z, 0, 8)  PFV_FMA(R[i_].z, 1, 9)  PFV_FMA(R[i_].z, 2, 10) PFV_FMA(R[i_].z, 3, 11)     \
      PFV_FMA(R[i_].w, 0, 12) PFV_FMA(R[i_].w, 1, 13) PFV_FMA(R[i_].w, 2, 14) PFV_FMA(R[i_].w, 3, 15)     \
    }                                                                                                     \
  }
__device__ void phase_peer_u(const Params& p, char* smem) {
  unsigned char* ws = p.ws;
  PeCtx c;
  c.U8 = ws + WS_U8; c.USV = (const float2*)(ws + WS_USV);
  const float* PG = (const float*)(ws + WS_PG);
  const bf16_t* HB = (const bf16_t*)(ws + WS_HB);
  const float* SSQ2 = (const float*)(ws + WS_SSQ2);
  const unsigned* PIDX = (const unsigned*)(ws + WS_PIDX);
  const int tidu = otid();
  const int lane = tidu & 63, wave = tidu >> 6;
  c.lane = lane; c.r = lane & 15; c.g = lane >> 4;
  c.list = (LAS unsigned*)(smem + wave * 8192);
  c.glist = (LAS float*)(smem + 65536 + wave * 8192);
  const bool hi = lane >= 32;
  const int bsel = hi ? 4 : 0;
  const unsigned char* V4 = ws + WS_V8 + (lane & 31) * 16;
  c.s = 0;
  {
    for (int grp = vblock() * NWAVES + wave; grp < T / 16; grp += gridDim.x * NWAVES) {
      const int t0 = grp * 16;
      c.t0 = t0;
      u32x4 bq[16];
      {
        const bf16_t* hp = HB + (size_t)(t0 + c.r) * 1024 + c.g * 16;
        const float rq = rsqrtf(SSQ2[t0 + c.r] * (1.f / 1024.f) + EPS) * 16.f;
#pragma unroll
        for (int kh = 0; kh < 16; ++kh) {
          const u32x4 h0 = *(const u32x4*)(hp + (kh >> 1) * 128 + (kh & 1) * 64), h1 = *(const u32x4*)(hp + (kh >> 1) * 128 + (kh & 1) * 64 + 8);
          u32x4 q;
#pragma unroll
          for (int i = 0; i < 4; ++i) {
            const unsigned lo = (i < 2) ? h0[2 * i] : h1[2 * i - 4], hi2 = (i < 2) ? h0[2 * i + 1] : h1[2 * i - 3];
            int w = 0;
            w = __builtin_amdgcn_cvt_pk_fp8_f32(bflo(lo) * rq, bfhi(lo) * rq, w, false);
            w = __builtin_amdgcn_cvt_pk_fp8_f32(bflo(hi2) * rq, bfhi(hi2) * rq, w, true);
            q[i] = (unsigned)w;
          }
          bq[kh] = q;
        }
      }
      const int n = 2048;
#pragma unroll
      for (int q = 0; q < 8; ++q) {
        const u32x4 idv = *(const u32x4*)(PIDX + (size_t)t0 * 128 + q * 256 + lane * 4);
        const f32x4 gv = *(const f32x4*)(PG + (size_t)t0 * 128 + q * 256 + lane * 4);
        const unsigned hi = (unsigned)(2 * q + (lane >> 5)) << 21, sl = (unsigned)((lane & 31) * 4);
        *(LAS u32x4*)(c.list + q * 256 + lane * 4) = (u32x4){hi | (idv.x << 7) | sl, hi | (idv.y << 7) | (sl + 1), hi | (idv.z << 7) | (sl + 2), hi | (idv.w << 7) | (sl + 3)};
        *(LAS f32x4*)(c.glist + q * 256 + lane * 4) = gv;
      }
      asm volatile("s_waitcnt lgkmcnt(0)" ::: "memory");
      c.n = n;
      const int nch = (n + 15) >> 4;
      u32x4 a0[8], a1[8];
      pe_rows(c, 0, a0);
      {
        unsigned z = 0u;
#pragma unroll
        for (int ks = 0; ks < 8; ++ks) z |= a0[ks].w;
        asm volatile("" ::"v"(z));
      }
      if (nch > 0) {
        for (int ci = 0;; ci += 2) {
          pe_chunk(c, ci, a0, a1, bq);
          if (ci + 1 >= nch) break;
          pe_chunk(c, ci + 1, a1, a0, bq);
          if (ci + 2 >= nch) break;
        }
      }
      asm volatile("s_waitcnt lgkmcnt(0)" ::: "memory");
      {
        unsigned e0 = (c.list[lane] >> 7) & 16383u, e1 = (c.list[64 + lane] >> 7) & 16383u;
        float w0 = c.glist[lane], w1 = c.glist[64 + lane];
        u32x4 RA[8], RB[8];
        PFV_LOAD(RA, e0, 0)
        {
          unsigned z = 0u;
#pragma unroll
          for (int i = 0; i < 8; ++i) z |= RA[i].w;
          asm volatile("" ::"v"(z));
        }
        for (int tk = 0; tk < 16; ++tk) {
          const int tn = tk < 15 ? tk + 1 : tk;
          const unsigned e0n = (c.list[tn * 128 + lane] >> 7) & 16383u, e1n = (c.list[tn * 128 + 64 + lane] >> 7) & 16383u;
          const float w0n = c.glist[tn * 128 + lane], w1n = c.glist[tn * 128 + 64 + lane];
          const size_t oo = (size_t)(t0 + tk) * 1024 + (lane & 31) * 32 + (hi ? 16 : 0);
          const u32x4 hb0 = *(const u32x4*)(HB + oo), hb1 = *(const u32x4*)(HB + oo + 8);
          f32x2 acc[16];
#pragma unroll
          for (int k = 0; k < 16; ++k) acc[k] = (f32x2){0.f, 0.f};
          __builtin_amdgcn_sched_barrier(0);
          PFV_LOAD(RB, e0, 16)  __builtin_amdgcn_sched_barrier(0);  PFV_ACC(RA, w0, 0)
          PFV_LOAD(RA, e0, 32)  __builtin_amdgcn_sched_barrier(0);  PFV_ACC(RB, w0, 16)
          PFV_LOAD(RB, e0, 48)  __builtin_amdgcn_sched_barrier(0);  PFV_ACC(RA, w0, 32)
          PFV_LOAD(RA, e1, 0)   __builtin_amdgcn_sched_barrier(0);  PFV_ACC(RB, w0, 48)
          PFV_LOAD(RB, e1, 16)  __builtin_amdgcn_sched_barrier(0);  PFV_ACC(RA, w1, 0)
          PFV_LOAD(RA, e1, 32)  __builtin_amdgcn_sched_barrier(0);  PFV_ACC(RB, w1, 16)
          PFV_LOAD(RB, e1, 48)  __builtin_amdgcn_sched_barrier(0);  PFV_ACC(RA, w1, 32)
          PFV_LOAD(RA, e0n, 0)  __builtin_amdgcn_sched_barrier(0);  PFV_ACC(RB, w1, 48)
          f32x2 r[8];
#pragma unroll
          for (int k = 0; k < 8; ++k) {
            const f32x2 keep = hi ? acc[8 + k] : acc[k], send = hi ? acc[k] : acc[8 + k];
            r[k] = keep + (f32x2){__shfl_xor(send.x, 32), __shfl_xor(send.y, 32)};
          }
          float* o = p.out + oo;
          *(f32x4*)(o)      = (f32x4){bflo(hb0.x) + r[0].x, bfhi(hb0.x) + r[0].y, bflo(hb0.y) + r[1].x, bfhi(hb0.y) + r[1].y};
          *(f32x4*)(o + 4)  = (f32x4){bflo(hb0.z) + r[2].x, bfhi(hb0.z) + r[2].y, bflo(hb0.w) + r[3].x, bfhi(hb0.w) + r[3].y};
          *(f32x4*)(o + 8)  = (f32x4){bflo(hb1.x) + r[4].x, bfhi(hb1.x) + r[4].y, bflo(hb1.y) + r[5].x, bfhi(hb1.y) + r[5].y};
          *(f32x4*)(o + 12) = (f32x4){bflo(hb1.z) + r[6].x, bfhi(hb1.z) + r[6].y, bflo(hb1.w) + r[7].x, bfhi(hb1.w) + r[7].y};
          e0 = e0n; e1 = e1n; w0 = w0n; w1 = w1n;
        }
      }
      asm volatile("" ::: "memory");
    }
  }
}
#undef PFV_LOAD
#undef PFV_FMA
#undef PFV_ACC


#define XB_TMO      128
#define XB_XCNT(j)  (256  + 64 * (j))
#define XB_XSUB(j)  (1280 + 64 * (j))
#define XB_XGEN(j)  (2304 + 64 * (j))
#define XB_TOP      3328
#define XB_TOPGEN   3392
#define XCD_BAR_WORDS 3456
#define XB_SPIN_CAP (1u << 22)
__device__ __forceinline__ unsigned xb_ld(unsigned* p)              { return __hip_atomic_load(p, __ATOMIC_RELAXED, __HIP_MEMORY_SCOPE_AGENT); }
__device__ __forceinline__ unsigned xb_add(unsigned* p, unsigned v) { return __hip_atomic_fetch_add(p, v, __ATOMIC_RELAXED, __HIP_MEMORY_SCOPE_AGENT); }
__device__ __forceinline__ unsigned xb_xcc_id() { return (unsigned)__builtin_amdgcn_s_getreg((3 << 11) | 20) & 0xFu; }
#define XB_SPIN(cond, bar) do { unsigned _sp = 0; while (cond) { __builtin_amdgcn_s_sleep(1); \
    if ((++_sp & 255u) == 0u) { if (xb_ld(&(bar)[XB_TMO])) break; if (_sp > XB_SPIN_CAP) { atomicAdd(&(bar)[XB_TMO], 1u); break; } } } } while (0)
struct XcdBarrier { unsigned* bar; unsigned x; volatile LAS unsigned* st; };
__device__ __forceinline__ XcdBarrier xcd_barrier_post(unsigned* bar, volatile LAS unsigned* st) {
    XcdBarrier b; b.bar = bar; b.x = xb_xcc_id(); b.st = st;
    if (threadIdx.x == 0) (void)xb_add(&bar[XB_XCNT(b.x)], 1u);
    return b;
}
__device__ __forceinline__ void xcd_barrier_complete(unsigned* bar, unsigned x, unsigned& nloc, unsigned& nx) {
    const unsigned G = gridDim.x * gridDim.y * gridDim.z;
    unsigned sum, cnt, mine, sp = 0u;
    for (;;) {
        sum = 0u; cnt = 0u; mine = 0u;
#pragma unroll
        for (unsigned j = 0; j < 16; ++j) { const unsigned c = xb_ld(&bar[XB_XCNT(j)]); sum += c; cnt += (c > 0u) ? 1u : 0u; mine = (j == x) ? c : mine; }
        if (sum == G) break;
        __builtin_amdgcn_s_sleep(1);
        if ((++sp & 255u) == 0u) { if (xb_ld(&bar[XB_TMO])) break; if (sp > XB_SPIN_CAP) { atomicAdd(&bar[XB_TMO], 1u); break; } }
    }
    nloc = mine > 0u ? mine : 1u; nx = cnt > 0u ? cnt : 1u;
}
__device__ __forceinline__ void xcd_barrier(const XcdBarrier& b) {
    asm volatile("s_waitcnt vmcnt(0)" ::: "memory");
    __syncthreads();
    if (threadIdx.x == 0) {
        unsigned* bar = b.bar;
        __builtin_amdgcn_s_waitcnt(0);
        unsigned nloc = b.st[0], nx = b.st[1];
        if (nloc == 0u) { xcd_barrier_complete(bar, b.x, nloc, nx); b.st[0] = nloc; b.st[1] = nx; }
        const unsigned old = xb_add(&bar[XB_XSUB(b.x)], 1u);
        const unsigned gen = old / nloc;
        if (old + 1u == (gen + 1u) * nloc) {
            __builtin_amdgcn_fence(__ATOMIC_RELEASE, "agent");
            asm volatile("s_waitcnt vmcnt(0)" ::: "memory");
            const unsigned og = xb_add(&bar[XB_TOP], 1u);
            const unsigned tg = og / nx;
            if (og + 1u == (tg + 1u) * nx) xb_add(&bar[XB_TOPGEN], 1u);
            else XB_SPIN(xb_ld(&bar[XB_TOPGEN]) == tg, bar);
            __builtin_amdgcn_fence(__ATOMIC_ACQUIRE, "agent");
            xb_add(&bar[XB_XGEN(b.x)], 1u);
            asm volatile("s_waitcnt vmcnt(0)" ::: "memory");
        } else {
            XB_SPIN(xb_ld(&bar[XB_XGEN(b.x)]) == gen, bar);
            __builtin_amdgcn_fence(__ATOMIC_ACQUIRE, "agent");
            asm volatile("s_waitcnt vmcnt(0)" ::: "memory");
        }
    }
    __syncthreads();
}

__global__ void __launch_bounds__(NTHREADS, 2) k_fused(Params p) {
  __shared__ __attribute__((aligned(16))) char smem[LDS_BYTES];
  if (threadIdx.x == 0) *(u32x4*)(smem + LDS_BAR) = (u32x4){0u, 0u, 0u, 0u};
  __syncthreads();
  const XcdBarrier bar = xcd_barrier_post((unsigned*)(p.ws + WS_CTL), (volatile LAS unsigned*)(smem + LDS_BAR));
#ifdef PROBE_PHASE
  unsigned long long ts[12];
#define STAMP(k) ts[k] = __builtin_amdgcn_s_memrealtime();
#else
#define STAMP(k)
#endif
  STAMP(0)
  phase_prep(p);
  xcd_barrier(bar);
  STAMP(1)
  phase_inproj(p, smem);
  xcd_barrier(bar);
  STAMP(2)
  phase_mix(p, smem);
  xcd_barrier(bar);
  STAMP(3)
  phase_outproj(p, smem);
  xcd_barrier(bar);
  STAMP(4)
  phase_qproj(p, smem);
  xcd_barrier(bar);
  STAMP(5)
  phase_route(p, smem);
  xcd_barrier(bar);
  STAMP(6)
  phase_peer_u(p, smem);
#ifdef PROBE_PHASE
  xcd_barrier(bar);
  STAMP(7)
  if (blockIdx.x == 0 && threadIdx.x == 0) {
    const float us = (float)(ts[PROBE_PHASE + 1] - ts[PROBE_PHASE]) * 0.01f;
    p.out[12345] += us * (1.f / PROBE_DIV);
  }
#endif
}

extern "C" void kernel_launch(void* const* d_in, const int* in_sizes, int n_in, void* d_out, int out_size, void* d_ws, size_t ws_size,
                              hipStream_t stream) {
  if (n_in != 17 || ws_size < WS_END) {
    fprintf(stderr, "kernel_launch: unexpected n_in %d / ws_size %zu\n", n_in, ws_size);
    return;
  }
  Params p{};
  p.x = (const float*)d_in[0]; p.norm_mix_g = (const float*)d_in[1]; p.w_in = (const float*)d_in[2]; p.q_norm_g = (const float*)d_in[3];
  p.k_norm_g = (const float*)d_in[4]; p.attn_out_g = (const float*)d_in[5]; p.conv_w = (const float*)d_in[6]; p.conv_b = (const float*)d_in[7];
  p.conv_ln_g = (const float*)d_in[8]; p.conv_ln_b = (const float*)d_in[9]; p.w_out = (const float*)d_in[10]; p.norm_ffn_g = (const float*)d_in[11];
  p.peer_wq = (const float*)d_in[12]; p.peer_k1 = (const float*)d_in[13]; p.peer_k2 = (const float*)d_in[14]; p.peer_u = (const float*)d_in[15];
  p.peer_v = (const float*)d_in[16];
  p.out = (float*)d_out;
  p.ws = (unsigned char*)d_ws;
  static int grid_blocks = 0;
  if (!grid_blocks) {
    int dev = 0, cus = 0, per_cu = 0;
    (void)hipGetDevice(&dev);
    (void)hipDeviceGetAttribute(&cus, hipDeviceAttributeMultiprocessorCount, dev);
    (void)hipOccupancyMaxActiveBlocksPerMultiprocessor(&per_cu, k_fused, NTHREADS, 0);
    if (per_cu > 1) per_cu = 1;
    if (per_cu < 1) per_cu = 1;
    grid_blocks = cus * per_cu;
  }
  (void)hipMemsetAsync((char*)d_ws + WS_CTL, 0, XCD_BAR_WORDS * 4, stream);
  hipLaunchKernelGGL(k_fused, dim3(grid_blocks), dim3(NTHREADS), 0, stream, p);
}
```

```cpp
#include <hip/hip_runtime.h>
#include <cstdio>

#define LAS __attribute__((address_space(3)))
typedef unsigned short bf16_t;
typedef __bf16 bf16x8 __attribute__((ext_vector_type(8)));
typedef __bf16 bf16x2 __attribute__((ext_vector_type(2)));
typedef float f32x4 __attribute__((ext_vector_type(4)));
typedef float f32x16 __attribute__((ext_vector_type(16)));
typedef unsigned u32x4 __attribute__((ext_vector_type(4)));
typedef unsigned u32x2 __attribute__((ext_vector_type(2)));
typedef float f32x2 __attribute__((ext_vector_type(2)));

constexpr int SEQ = 4096, T = 8 * SEQ, D = 1024, NIN = 2560;
constexpr float EPS = 1e-6f;
constexpr float LOG2E = 1.4426950408889634f;

constexpr size_t MiB = 1u << 20;
constexpr size_t WS_W1 = 0, WS_WV = 4 * MiB, WS_WOUT = 5 * MiB, WS_WQ = 7 * MiB, WS_K1 = 9 * MiB, WS_K2 = 9 * MiB + 131072, WS_SSQ = 10 * MiB;
constexpr size_t WS_CTL = 11 * MiB;
constexpr size_t WS_USV = 11 * MiB + 65536;
constexpr size_t WS_RS1 = 11 * MiB + 196608, WS_SSQ2 = 11 * MiB + 327680;
constexpr size_t WS_U8 = 12 * MiB, WS_V8 = 28 * MiB;
constexpr size_t WS_XB = 44 * MiB;
constexpr size_t WS_Q = 108 * MiB, WS_K = 140 * MiB, WS_VT = 172 * MiB, WS_HG = 204 * MiB, WS_MIX = 236 * MiB;
constexpr size_t WS_HB = 300 * MiB, WS_QH = 364 * MiB;
constexpr size_t WS_XN8 = 108 * MiB, WS_PIDX = 140 * MiB, WS_PG = 156 * MiB, WS_PW = 172 * MiB;
constexpr size_t WS_END = 428 * MiB;

struct Params {
  const float *x, *norm_mix_g, *w_in, *q_norm_g, *k_norm_g, *attn_out_g, *conv_w, *conv_b, *conv_ln_g, *conv_ln_b,
      *w_out, *norm_ffn_g, *peer_wq, *peer_k1, *peer_k2, *peer_u, *peer_v;
  float* out;
  unsigned char* ws;
};

constexpr int NTHREADS = 512, NWAVES = 8;
constexpr int LDS_STAGE = 131072, LDS_BAR = LDS_STAGE, LDS_BYTES = LDS_STAGE + 16;

__device__ __forceinline__ unsigned pk2(float lo, float hi) {
  bf16x2 v = {(__bf16)lo, (__bf16)hi};
  return __builtin_bit_cast(unsigned, v);
}
__device__ __forceinline__ float bflo(unsigned u) { return __uint_as_float(u << 16); }
__device__ __forceinline__ float bfhi(unsigned u) { return __uint_as_float(u & 0xffff0000u); }
__device__ __forceinline__ int otid() { int t = threadIdx.x; asm volatile("" : "+v"(t)); return t; }
__device__ __forceinline__ int vblock() {
  const int G = gridDim.x, b = blockIdx.x;
  return (G % 8 == 0) ? (b % 8) * (G / 8) + b / 8 : b;
}
__device__ __forceinline__ f32x16 mfma32(bf16x8 a, bf16x8 b, f32x16 c) { return __builtin_amdgcn_mfma_f32_32x32x16_bf16(a, b, c, 0, 0, 0); }

__device__ __forceinline__ int w1_src(int n) {
  if (n < 1024) {
    const int kind = n >> 9, rel = n & 511, pn = rel >> 8, P = rel & 255, bj = P >> 7, wc = (P >> 5) & 3, x = P & 31;
    return kind * 512 + (4 * pn + wc) * 64 + 32 * bj + x;
  }
  const int rel = n - 1024, pn = rel >> 8, P = rel & 255, bj = P >> 7, wc = (P >> 5) & 3, x = P & 31;
  return (bj ? 2048 : 1536) + 128 * pn + 32 * wc + x;
}
__device__ __forceinline__ void transpose_items(const float* __restrict__ W, int ldw, int N, bf16_t* __restrict__ Wt, const float* __restrict__ g, int glimit,
                                                int mode, long gtid, long nthr) {
  const long nitems = (long)N * 128;
  for (long it = gtid; it < nitems; it += nthr) {
    const int n = (int)(it % N), kc = (int)(it / N);
    const int src = mode == 1 ? w1_src(n) : (mode == 2 ? 1024 + n : n);
    float v[8];
#pragma unroll
    for (int i = 0; i < 8; ++i) {
      const int k = kc * 8 + i;
      float w = W[(size_t)k * ldw + src];
      if (k < glimit) w *= g[k];
      v[i] = w;
    }
    u32x4 o = {pk2(v[0], v[1]), pk2(v[2], v[3]), pk2(v[4], v[5]), pk2(v[6], v[7])};
    *(u32x4*)(Wt + (size_t)n * 1024 + kc * 8) = o;
  }
}
__device__ __forceinline__ void convert_items(const float* __restrict__ src, bf16_t* __restrict__ dst, long n8, long gtid, long nthr) {
  for (long it = gtid; it < n8; it += nthr) {
    const f32x4 a = *(const f32x4*)(src + it * 8), b = *(const f32x4*)(src + it * 8 + 4);
    u32x4 o = {pk2(a.x, a.y), pk2(a.z, a.w), pk2(b.x, b.y), pk2(b.z, b.w)};
    *(u32x4*)(dst + it * 8) = o;
  }
}
__device__ void phase_prep(const Params& p) {
  const int tid0 = otid();
  const long gtid = (long)vblock() * NTHREADS + tid0, nthr = (long)gridDim.x * NTHREADS;
  unsigned char* ws = p.ws;
  transpose_items(p.w_in, NIN, 2048, (bf16_t*)(ws + WS_W1), p.norm_mix_g, 1024, 1, gtid, nthr);
  transpose_items(p.w_in, NIN, 512, (bf16_t*)(ws + WS_WV), p.norm_mix_g, 1024, 2, gtid, nthr);
  transpose_items(p.w_out, D, D, (bf16_t*)(ws + WS_WOUT), p.attn_out_g, 512, 0, gtid, nthr);
  transpose_items(p.peer_wq, D, D, (bf16_t*)(ws + WS_WQ), p.norm_ffn_g, 1024, 0, gtid, nthr);
  convert_items(p.peer_k1, (bf16_t*)(ws + WS_K1), 65536 / 8, gtid, nthr);
  convert_items(p.peer_k2, (bf16_t*)(ws + WS_K2), 65536 / 8, gtid, nthr);
  const int lane = tid0 & 63, gw = vblock() * NWAVES + (tid0 >> 6), nw = gridDim.x * NWAVES;
  {
    bf16_t* XB = (bf16_t*)(ws + WS_XB);
    float* RS1 = (float*)(ws + WS_RS1);
    float* SSQ2 = (float*)(ws + WS_SSQ2);
    for (int tb = gw; tb < T; tb += 2 * nw) {
      f32x4 v[2][4];
      float ss[2] = {0.f, 0.f};
#pragma unroll
      for (int u = 0; u < 2; ++u) {
        const int t = (tb + u * nw < T) ? tb + u * nw : tb;
        const float* src = p.x + (size_t)t * 1024 + lane * 4;
#pragma unroll
        for (int i = 0; i < 4; ++i) v[u][i] = *(const f32x4*)(src + 256 * i);
      }
#pragma unroll
      for (int u = 0; u < 2; ++u) {
#pragma unroll
        for (int i = 0; i < 4; ++i) ss[u] += v[u][i].x * v[u][i].x + v[u][i].y * v[u][i].y + v[u][i].z * v[u][i].z + v[u][i].w * v[u][i].w;
      }
#pragma unroll
      for (int o = 1; o < 64; o <<= 1) { ss[0] += __shfl_xor(ss[0], o); ss[1] += __shfl_xor(ss[1], o); }
#pragma unroll
      for (int u = 0; u < 2; ++u) {
        const int t = tb + u * nw;
        if (t < T) {
#pragma unroll
          for (int i = 0; i < 4; ++i) *(u32x2*)(XB + (size_t)t * 1024 + lane * 4 + 256 * i) = (u32x2){pk2(v[u][i].x, v[u][i].y), pk2(v[u][i].z, v[u][i].w)};
          if (lane == 0) { RS1[t] = rsqrtf(ss[u] * (1.f / 1024.f) + EPS); SSQ2[t] = 0.f; }
        }
      }
    }
  }
}

__device__ void prep_tables(const Params& p) {
  unsigned char* ws = p.ws;
  const int tid0 = otid();
  const int lane = tid0 & 63, gw = vblock() * NWAVES + (tid0 >> 6), nw = gridDim.x * NWAVES;
  {
    f32x4 gn[4];
#pragma unroll
    for (int i = 0; i < 4; ++i) gn[i] = *(const f32x4*)(p.norm_ffn_g + lane * 16 + 4 * i);
    for (int rb = gw; rb < 32768; rb += 2 * nw) {
      f32x4 v[2][4];
#pragma unroll
      for (int u = 0; u < 2; ++u) {
        const int r = (rb + u * nw < 32768) ? rb + u * nw : rb;
        const float* src = ((r >> 14) ? p.peer_v : p.peer_u) + (size_t)(r & 16383) * 1024 + lane * 16;
#pragma unroll
        for (int i = 0; i < 4; ++i) v[u][i] = *(const f32x4*)(src + 4 * i);
        if (!(r >> 14)) {
#pragma unroll
          for (int i = 0; i < 4; ++i) v[u][i] *= gn[i];
        }
      }
      float am[2] = {0.f, 0.f};
#pragma unroll
      for (int u = 0; u < 2; ++u)
#pragma unroll
        for (int i = 0; i < 4; ++i)
          am[u] = fmaxf(am[u], fmaxf(fmaxf(fabsf(v[u][i].x), fabsf(v[u][i].y)), fmaxf(fabsf(v[u][i].z), fabsf(v[u][i].w))));
#pragma unroll
      for (int o = 1; o < 64; o <<= 1) { am[0] = fmaxf(am[0], __shfl_xor(am[0], o)); am[1] = fmaxf(am[1], __shfl_xor(am[1], o)); }
#pragma unroll
      for (int u = 0; u < 2; ++u) {
        const int r = rb + u * nw;
        if (r < 32768) {
          const int isv = r >> 14, e = r & 16383;
          const float scale = am[u] > 0.f ? am[u] * (1.f / 6.f) : 1.f, inv = am[u] > 0.f ? 6.f / am[u] : 0.f;
          unsigned q[2] = {0u, 0u};
#define TQ(i, j0, w, sel) q[w] = __builtin_amdgcn_cvt_scalef32_pk_fp4_f32(q[w], v[u][i][j0] * inv, v[u][i][j0 + 1] * inv, 1.0f, sel);
          TQ(0, 0, 0, 0) TQ(0, 2, 0, 1) TQ(1, 0, 0, 2) TQ(1, 2, 0, 3)
          TQ(2, 0, 1, 0) TQ(2, 2, 1, 1) TQ(3, 0, 1, 2) TQ(3, 2, 1, 3)
#undef TQ
          if (isv) {
            *(u32x2*)(ws + WS_V8 + (size_t)e * 512 + lane * 8) = (u32x2){q[0], q[1]};
            if (lane == 0) ((float*)(ws + WS_USV))[2 * e + 1] = scale;
          } else {
            *(u32x2*)(ws + WS_U8 + (size_t)e * 512 + lane * 8) = (u32x2){q[0], q[1]};
            if (lane == 0) ((float*)(ws + WS_USV))[2 * e] = scale;
          }
        }
      }
    }
  }
}

namespace pg8 {
typedef short sbf16x8 __attribute__((ext_vector_type(8)));
constexpr int BM = 256, BK = 64, HALF = 128, HTB = HALF * BK * 2  , NXCD = 8, WGM = 8;
__device__ __forceinline__ int lds_byte(int r, int c) { const int st = (r >> 4) * 2 + (c >> 5), rr = r & 15, cc = c & 31, ob = rr * 64 + cc * 2; return st * 1024 + (ob ^ (((ob >> 9) & 1) << 5)); }
__device__ __forceinline__ void stage_rc(int b, int& R, int& C) { const int st = b / 1024, sb = b % 1024, swz = sb ^ (((sb >> 9) & 1) << 5); R = (st >> 1) * 16 + swz / 64; C = (st & 1) * 32 + (swz % 64) / 2; }
__device__ __forceinline__ int perm32(int rho) { const int n = rho >> 4, i = rho & 15; return 8 * (i >> 2) + 4 * n + (i & 3); }
struct Unit { int pm, pn; };
struct Gemm { const bf16_t* A; const bf16_t* Bt; int M, N, K; };
struct StaticOrder {
    int nM, nN, nwg, G, c;
    __device__ void init(int M, int N, int G_, int c_) { nM = M / BM; nN = N / BM; nwg = nM * nN; G = G_; c = c_; }
    __device__ bool next(int i, Unit& u) const {
        const long L = (long)i * G + c; if (L >= nwg) return false;
        int wgid = (int)L; { const int q = nwg / NXCD, r = nwg % NXCD, xcd = wgid % NXCD, off = wgid / NXCD; wgid = (xcd < r ? xcd * (q + 1) : r * (q + 1) + (xcd - r) * q) + off; }
        const int nig = WGM * nN, gid = wgid / nig, fm = gid * WGM, gsz = (nM - fm) < WGM ? (nM - fm) : WGM;
        u.pm = fm + ((wgid % nig) % gsz); u.pn = (wgid % nig) / gsz; return true;
    }
};
template <class Epi>
__device__ __forceinline__ void gemm_phase(LAS unsigned char* lds, const Gemm g, const StaticOrder& S, const Epi& E) {
    const int tid = otid(), wid = __builtin_amdgcn_readfirstlane(tid >> 6), lane = tid & 63, wr = wid >> 2, wc = wid & 3, fr = lane & 15, fq = lane >> 4;
    const int K = g.K, nt = K / BK;
    unsigned voffA[2], voffB[2];
#pragma unroll
    for (int i = 0; i < 2; ++i) { int R, C; stage_rc(tid * 16 + i * 8192, R, C); const int Rb = Epi::PERM ? ((R & ~31) + perm32(R & 31)) : R;
        voffA[i] = (unsigned)(R * K + C) * 2u; voffB[i] = (unsigned)(Rb * K + C) * 2u; }
    const size_t kstep = (size_t)(BK * 2);
    const size_t hstep = (size_t)HALF * K * 2;
    const size_t tstep = 2 * hstep;
    const unsigned ldsw = (unsigned)wid * 1024u;
    const int aoff = lds_byte(wr * 64 + fr, fq * 8), boff = lds_byte(wc * 32 + fr, fq * 8);
#define PG8_SA(b, h) (((b) * 2 + (h)) * HTB)
#define PG8_SB(b, h) ((4 + (b) * 2 + (h)) * HTB)
#define PG8_STAGE(bufoff, gbase, voff) do { _Pragma("unroll") for (int _i = 0; _i < 2; ++_i) \
        __builtin_amdgcn_global_load_lds((const unsigned*)((const char*)(gbase) + (voff)[_i]), (LAS unsigned*)(lds + (bufoff) + ldsw + _i * 8192), 16, 0, 0); } while (0)
#define PG8_LDA(dst, b, h) do { _Pragma("unroll") for (int m = 0; m < 4; ++m) _Pragma("unroll") for (int k = 0; k < 2; ++k) dst[m][k] = *(const LAS sbf16x8*)(lds + PG8_SA(b, h) + aoff + m * 2048 + k * 1024); } while (0)
#define PG8_LDB(dst, b, h) do { _Pragma("unroll") for (int n = 0; n < 2; ++n) _Pragma("unroll") for (int k = 0; k < 2; ++k) dst[n][k] = *(const LAS sbf16x8*)(lds + PG8_SB(b, h) + boff + n * 2048 + k * 1024); } while (0)
#define PG8_MMA(ai, bj, At, Bt) do { __builtin_amdgcn_s_setprio(1); _Pragma("unroll") for (int m = 0; m < 4; ++m) _Pragma("unroll") for (int n = 0; n < 2; ++n) _Pragma("unroll") for (int k = 0; k < 2; ++k) \
        acc[ai][bj][m][n] = __builtin_amdgcn_mfma_f32_16x16x32_bf16(__builtin_bit_cast(bf16x8, Bt[n][k]), __builtin_bit_cast(bf16x8, At[m][k]), acc[ai][bj][m][n], 0, 0, 0); __builtin_amdgcn_s_setprio(0); } while (0)
#define PG8_WAIT_V(n) asm volatile("s_waitcnt vmcnt(" #n ")" ::: "memory")
#define PG8_WAIT_L(n) asm volatile("s_waitcnt lgkmcnt(" #n ")" ::: "memory")
#define PG8_BAR __builtin_amdgcn_s_barrier()
#define PG8_SCHED __builtin_amdgcn_sched_barrier(0)
    Unit cur, nxt; int ui = 0;
    if (!S.next(0, cur)) return;
    f32x4 acc[2][2][4][2];
#pragma unroll
    for (int a = 0; a < 2; ++a)
#pragma unroll
        for (int b = 0; b < 2; ++b)
#pragma unroll
            for (int m = 0; m < 4; ++m)
#pragma unroll
                for (int n = 0; n < 2; ++n) acc[a][b][m][n] = (f32x4){0.f, 0.f, 0.f, 0.f};
    sbf16x8 At[4][2], B0[2][2], B1[2][2];
    const char* cA = (const char*)g.A + (size_t)cur.pm * tstep; const char* cB = (const char*)g.Bt + (size_t)cur.pn * tstep;
    PG8_STAGE(PG8_SB(0, 0), cB, voffB); PG8_STAGE(PG8_SA(0, 0), cA, voffA); PG8_STAGE(PG8_SB(0, 1), cB + hstep, voffB); PG8_STAGE(PG8_SA(0, 1), cA + hstep, voffA);
    if (wr == 1) PG8_BAR;
    PG8_WAIT_V(4); PG8_BAR;
    PG8_STAGE(PG8_SB(1, 0), cB + kstep, voffB); PG8_STAGE(PG8_SA(1, 0), cA + kstep, voffA); PG8_STAGE(PG8_SB(1, 1), cB + hstep + kstep, voffB);
    PG8_WAIT_V(6); PG8_BAR;
    for (;;) {
        const bool has_next = S.next(ui + 1, nxt);
        const char* nA = has_next ? (const char*)g.A + (size_t)nxt.pm * tstep : cA; const char* nB = has_next ? (const char*)g.Bt + (size_t)nxt.pn * tstep : cB;
        for (int t = 0; t < nt; t += 2) {
            const bool last = (t == nt - 2);
            const char* a1 = cA + (size_t)(t + 1) * kstep;
            const char* a2 = last ? nA : cA + (size_t)(t + 2) * kstep; const char* b2 = last ? nB : cB + (size_t)(t + 2) * kstep;
            const char* a3 = a2 + kstep; const char* b3 = b2 + kstep;
            PG8_LDB(B0, 0, 0); PG8_SCHED; PG8_LDA(At, 0, 0); PG8_STAGE(PG8_SA(1, 1), a1 + hstep, voffA);
            PG8_WAIT_L(8); PG8_BAR; PG8_WAIT_L(0); PG8_MMA(0, 0, At, B0); PG8_BAR; PG8_SCHED;
            PG8_LDB(B1, 0, 1); PG8_STAGE(PG8_SB(0, 0), b2, voffB);
            PG8_BAR; PG8_WAIT_L(0); PG8_MMA(0, 1, At, B1); PG8_BAR;
            PG8_LDA(At, 0, 1); PG8_STAGE(PG8_SA(0, 0), a2, voffA);
            PG8_BAR; PG8_WAIT_L(0); PG8_MMA(1, 0, At, B0); PG8_BAR; PG8_SCHED;
            PG8_STAGE(PG8_SB(0, 1), b2 + hstep, voffB);
            PG8_WAIT_V(6); PG8_BAR; PG8_MMA(1, 1, At, B1); PG8_BAR;
            PG8_LDB(B0, 1, 0); PG8_SCHED; PG8_LDA(At, 1, 0); PG8_STAGE(PG8_SA(0, 1), a2 + hstep, voffA);
            PG8_WAIT_L(8); PG8_BAR; PG8_WAIT_L(0); PG8_MMA(0, 0, At, B0); PG8_BAR; PG8_SCHED;
            PG8_LDB(B1, 1, 1); PG8_STAGE(PG8_SB(1, 0), b3, voffB);
            PG8_BAR; PG8_WAIT_L(0); PG8_MMA(0, 1, At, B1); PG8_BAR;
            PG8_LDA(At, 1, 1); PG8_STAGE(PG8_SA(1, 0), a3, voffA);
            PG8_BAR; PG8_WAIT_L(0); PG8_MMA(1, 0, At, B0); PG8_BAR; PG8_SCHED;
            PG8_STAGE(PG8_SB(1, 1), b3 + hstep, voffB);
            PG8_WAIT_V(6); PG8_BAR; PG8_MMA(1, 1, At, B1); PG8_BAR;
        }
        E(acc, cur, wr, wc, fr, fq);
        if (!has_next) break;
#pragma unroll
        for (int a = 0; a < 2; ++a)
#pragma unroll
            for (int b = 0; b < 2; ++b)
#pragma unroll
                for (int m = 0; m < 4; ++m)
#pragma unroll
                    for (int n = 0; n < 2; ++n) acc[a][b][m][n] = (f32x4){0.f, 0.f, 0.f, 0.f};
        cur = nxt; cA = nA; cB = nB; ++ui;
    }
    PG8_WAIT_V(0);
    if (wr == 0) PG8_BAR;
    PG8_BAR;
#undef PG8_SA
#undef PG8_SB
#undef PG8_STAGE
#undef PG8_LDA
#undef PG8_LDB
#undef PG8_MMA
#undef PG8_WAIT_V
#undef PG8_WAIT_L
#undef PG8_BAR
#undef PG8_SCHED
}
}

struct EpiQKC {
  static constexpr bool PERM = true;
  const float* rs1; const float* qg; const float* kg; bf16_t* Q; bf16_t* Kk; bf16_t* HG;
  __device__ __forceinline__ void operator()(const f32x4 (&acc)[2][2][4][2], const pg8::Unit& u, int wr, int wc, int fr, int fq) const {
    const int row0 = u.pm * 256 + wr * 64 + fr;
    if (u.pn < 4) {
      const bool isq = u.pn < 2;
      const int head = 4 * (u.pn & 1) + wc;
      const float* g = isq ? qg : kg;
      f32x4 gv[2][2];
#pragma unroll
      for (int bj = 0; bj < 2; ++bj)
#pragma unroll
        for (int n = 0; n < 2; ++n) gv[bj][n] = *(const f32x4*)(g + 32 * bj + 8 * fq + 4 * n);
      bf16_t* base = isq ? Q : Kk;
#pragma unroll
      for (int ai = 0; ai < 2; ++ai)
#pragma unroll
        for (int m = 0; m < 4; ++m) {
          const int t = row0 + ai * 128 + m * 16;
          float ss = 0.f;
#pragma unroll
          for (int bj = 0; bj < 2; ++bj)
#pragma unroll
            for (int n = 0; n < 2; ++n) { const f32x4 v = acc[ai][bj][m][n]; ss += v.x * v.x + v.y * v.y + v.z * v.z + v.w * v.w; }
          ss += __shfl_xor(ss, 16);
          ss += __shfl_xor(ss, 32);
          const float r = rs1[t];
          float sc = r * rsqrtf(r * r * ss * (1.f / 64.f) + EPS);
          if (isq) sc *= 0.125f * LOG2E;
          const size_t bh = (size_t)((t >> 12) * 8 + head);
          const int pos = t & 4095;
          bf16_t* dst = isq ? base + (bh * 4096 + pos) * 64 + 8 * fq
                            : base + (bh * 4096 + (pos & ~31)) * 64 + ((((fq >> 1) * 2 + (fq & 1)) * 32) + (pos & 31)) * 8;
#pragma unroll
          for (int bj = 0; bj < 2; ++bj) {
            const f32x4 a = acc[ai][bj][m][0] * gv[bj][0] * sc, b = acc[ai][bj][m][1] * gv[bj][1] * sc;
            *(u32x4*)(dst + (isq ? 32 * bj : 1024 * bj)) = (u32x4){pk2(a.x, a.y), pk2(a.z, a.w), pk2(b.x, b.y), pk2(b.z, b.w)};
          }
        }
    } else {
      const int ch0 = 128 * (u.pn - 4) + 32 * wc + 8 * fq;
#pragma unroll
      for (int ai = 0; ai < 2; ++ai)
#pragma unroll
        for (int m = 0; m < 4; ++m) {
          const int t = row0 + ai * 128 + m * 16;
          const float r = rs1[t];
          float h[8];
#pragma unroll
          for (int n = 0; n < 2; ++n)
#pragma unroll
            for (int j = 0; j < 4; ++j) h[4 * n + j] = acc[ai][0][m][n][j] * r * __builtin_amdgcn_rcpf(1.f + __expf(-acc[ai][1][m][n][j] * r));
          *(u32x4*)(HG + (size_t)t * 512 + ch0) = (u32x4){pk2(h[0], h[1]), pk2(h[2], h[3]), pk2(h[4], h[5]), pk2(h[6], h[7])};
        }
    }
  }
};
struct EpiVt {
  static constexpr bool PERM = false;
  const float* rs1; bf16_t* Vt;
  __device__ __forceinline__ void operator()(const f32x4 (&acc)[2][2][4][2], const pg8::Unit& u, int wr, int wc, int fr, int fq) const {
    const int pos0 = 8 * (fq & 1) + 4 * (fq >> 1);
#pragma unroll
    for (int bj = 0; bj < 2; ++bj)
#pragma unroll
      for (int n = 0; n < 2; ++n) {
        const int t = u.pn * 256 + bj * 128 + wc * 32 + n * 16 + 4 * fq;
        const f32x4 r = *(const f32x4*)(rs1 + t);
        const size_t tb = ((size_t)(t >> 12) * 8) * 128 + ((t & 4095) >> 5);
#pragma unroll
        for (int ai = 0; ai < 2; ++ai)
#pragma unroll
          for (int m = 0; m < 4; ++m) {
            const int dg = u.pm * 256 + ai * 128 + wr * 64 + m * 16 + fr, head = dg >> 6, d = dg & 63;
            const f32x4 v = acc[ai][bj][m][n] * r;
            *(u32x2*)(Vt + (tb + (size_t)head * 128) * 2048 + (((((d >> 5) * 2 + n) * 2 + (fq & 1)) * 32) + (d & 31)) * 8 + 4 * (fq >> 1)) = (u32x2){pk2(v.x, v.y), pk2(v.z, v.w)};
          }
      }
  }
};
struct EpiOut {
  static constexpr bool PERM = true;
  const bf16_t* xb; bf16_t* HB; float* ssq2;
  __device__ __forceinline__ void operator()(const f32x4 (&acc)[2][2][4][2], const pg8::Unit& u, int wr, int wc, int fr, int fq) const {
    const int row0 = u.pm * 256 + wr * 64 + fr, col0 = u.pn * 256 + wc * 32 + 8 * fq;
#pragma unroll
    for (int ai = 0; ai < 2; ++ai)
#pragma unroll
      for (int m = 0; m < 4; ++m) {
        const int t = row0 + ai * 128 + m * 16;
        const size_t ro = (size_t)t * 1024 + col0;
        float ss = 0.f;
#pragma unroll
        for (int bj = 0; bj < 2; ++bj) {
          const size_t o = ro + bj * 128;
          const u32x4 xv = *(const u32x4*)(xb + o);
          const f32x4 h0 = (f32x4){bflo(xv.x), bfhi(xv.x), bflo(xv.y), bfhi(xv.y)} + acc[ai][bj][m][0];
          const f32x4 h1 = (f32x4){bflo(xv.z), bfhi(xv.z), bflo(xv.w), bfhi(xv.w)} + acc[ai][bj][m][1];
          *(u32x4*)(HB + o) = (u32x4){pk2(h0.x, h0.y), pk2(h0.z, h0.w), pk2(h1.x, h1.y), pk2(h1.z, h1.w)};
          ss += (h0.x * h0.x + h0.y * h0.y + h0.z * h0.z + h0.w * h0.w) + (h1.x * h1.x + h1.y * h1.y + h1.z * h1.z + h1.w * h1.w);
        }
        ss += __shfl_xor(ss, 16);
        ss += __shfl_xor(ss, 32);
        if (fq == 0) atomicAdd(ssq2 + t, ss);
      }
  }
};
struct EpiQh {
  static constexpr bool PERM = true;
  const float* ssq2; bf16_t* QH;
  __device__ __forceinline__ void operator()(const f32x4 (&acc)[2][2][4][2], const pg8::Unit& u, int wr, int wc, int fr, int fq) const {
    const int row0 = u.pm * 256 + wr * 64 + fr, col0 = u.pn * 256 + wc * 32 + 8 * fq;
#pragma unroll
    for (int ai = 0; ai < 2; ++ai)
#pragma unroll
      for (int m = 0; m < 4; ++m) {
        const int t = row0 + ai * 128 + m * 16;
        const float r = rsqrtf(ssq2[t] * (1.f / 1024.f) + EPS);
#pragma unroll
        for (int bj = 0; bj < 2; ++bj) {
          const f32x4 a = acc[ai][bj][m][0] * r, b = acc[ai][bj][m][1] * r;
          *(u32x4*)(QH + (size_t)t * 1024 + col0 + bj * 128) = (u32x4){pk2(a.x, a.y), pk2(a.z, a.w), pk2(b.x, b.y), pk2(b.z, b.w)};
        }
      }
  }
};

__device__ void phase_inproj(const Params& p, char* smem) {
  unsigned char* ws = p.ws;
  LAS unsigned char* lds = (LAS unsigned char*)smem;
  const bf16_t* XB = (const bf16_t*)(ws + WS_XB);
  const float* RS1 = (const float*)(ws + WS_RS1);
  pg8::StaticOrder S;
  {
    pg8::Gemm g{XB, (const bf16_t*)(ws + WS_W1), T, 2048, 1024};
    S.init(T, 2048, gridDim.x, blockIdx.x);
    EpiQKC E{RS1, p.q_norm_g, p.k_norm_g, (bf16_t*)(ws + WS_Q), (bf16_t*)(ws + WS_K), (bf16_t*)(ws + WS_HG)};
    pg8::gemm_phase<EpiQKC>(lds, g, S, E);
  }
  {
    pg8::Gemm g{(const bf16_t*)(ws + WS_WV), XB, 512, T, 1024};
    S.init(512, T, gridDim.x, blockIdx.x);
    EpiVt E{RS1, (bf16_t*)(ws + WS_VT)};
    pg8::gemm_phase<EpiVt>(lds, g, S, E);
  }
}
__device__ void phase_outproj(const Params& p, char* smem) {
  unsigned char* ws = p.ws;
  pg8::Gemm g{(const bf16_t*)(ws + WS_MIX), (const bf16_t*)(ws + WS_WOUT), T, 1024, 1024};
  pg8::StaticOrder S;
  S.init(T, 1024, gridDim.x, blockIdx.x);
  EpiOut E{(const bf16_t*)(ws + WS_XB), (bf16_t*)(ws + WS_HB), (float*)(ws + WS_SSQ2)};
  pg8::gemm_phase<EpiOut>((LAS unsigned char*)smem, g, S, E);
}
__device__ void phase_qproj(const Params& p, char* smem) {
  unsigned char* ws = p.ws;
  pg8::Gemm g{(const bf16_t*)(ws + WS_HB), (const bf16_t*)(ws + WS_WQ), T, 1024, 1024};
  pg8::StaticOrder S;
  S.init(T, 1024, gridDim.x, blockIdx.x);
  EpiQh E{(const float*)(ws + WS_SSQ2), (bf16_t*)(ws + WS_QH)};
  pg8::gemm_phase<EpiQh>((LAS unsigned char*)smem, g, S, E);
}

__device__ __forceinline__ void conv_stage(const bf16_t* HG, int item, LAS unsigned char* buf, int wave, int lane) {
  const int t0 = item * 32, s0 = t0 & 4095;
#pragma unroll
  for (int j = 0; j < 8; ++j) {
    const int r = wave + 8 * j;
    if (r < 62) {
      if (s0 - 30 + r >= 0)
        __builtin_amdgcn_global_load_lds((const unsigned*)(HG + (size_t)(t0 - 30 + r) * 512 + lane * 8), (LAS unsigned*)(buf + r * 1024), 16, 0, 0);
      else
        *(LAS u32x4*)(buf + r * 1024 + lane * 16) = (u32x4){0u, 0u, 0u, 0u};
    }
  }
}
struct ConvW { f32x2 wv[31]; float2 cb, lg, lb; };
__device__ __forceinline__ void conv_compute(const Params& p, int item, const char* smem, const ConvW& W, int tid512) {
  bf16_t* MIX = (bf16_t*)(p.ws + WS_MIX);
  const int half = tid512 >> 8, tid = tid512 & 255, lane = tid & 63, wave = tid >> 6;
  const int t0 = item * 32;
  float* red = (float*)(smem + 62 * 1024) + half * 128;
  const bool b5 = lane & 32, b4 = lane & 16, b3 = lane & 8, b2 = lane & 4;
#pragma unroll 1
  for (int rd = 0; rd < 2; ++rd) {
    const int tb = 16 * half + 8 * rd;
    f32x2 xv[38];
#pragma unroll
    for (int r = 0; r < 38; ++r) {
      const unsigned v = *(const unsigned*)(smem + (tb + r) * 1024 + tid * 4);
      xv[r] = (f32x2){bflo(v), bfhi(v)};
    }
    float a0[8], a1[8], st[16];
#pragma unroll
    for (int k = 0; k < 8; ++k) {
      f32x2 u = {W.cb.x, W.cb.y};
#pragma unroll
      for (int j = 0; j < 31; ++j) u = __builtin_elementwise_fma(W.wv[j], xv[k + j], u);
      a0[k] = u.x; a1[k] = u.y;
      st[k] = u.x + u.y;
      st[8 + k] = u.x * u.x + u.y * u.y;
    }
    float r8[8], r4[4], r2[2], r1;
#pragma unroll
    for (int i = 0; i < 8; ++i) { const float keep = b5 ? st[8 + i] : st[i], send = b5 ? st[i] : st[8 + i]; r8[i] = keep + __shfl_xor(send, 32); }
#pragma unroll
    for (int i = 0; i < 4; ++i) { const float keep = b4 ? r8[4 + i] : r8[i], send = b4 ? r8[i] : r8[4 + i]; r4[i] = keep + __shfl_xor(send, 16); }
#pragma unroll
    for (int i = 0; i < 2; ++i) { const float keep = b3 ? r4[2 + i] : r4[i], send = b3 ? r4[i] : r4[2 + i]; r2[i] = keep + __shfl_xor(send, 8); }
    { const float keep = b2 ? r2[1] : r2[0], send = b2 ? r2[0] : r2[1]; r1 = keep + __shfl_xor(send, 4); }
    r1 += __shfl_xor(r1, 2);
    r1 += __shfl_xor(r1, 1);
    float* rr = red + rd * 64;
    if ((lane & 3) == 0) rr[wave * 16 + (lane >> 2)] = r1;
    __syncthreads();
#pragma unroll
    for (int k = 0; k < 8; ++k) {
      const float S1 = (rr[k] + rr[16 + k]) + (rr[32 + k] + rr[48 + k]);
      const float S2 = (rr[8 + k] + rr[24 + k]) + (rr[40 + k] + rr[56 + k]);
      const float mu = S1 * (1.f / 512.f);
      const float var = fmaxf(S2 * (1.f / 512.f) - mu * mu, 0.f);
      const float rstd = rsqrtf(var + EPS);
      const float y0 = (a0[k] - mu) * rstd * W.lg.x + W.lb.x, y1 = (a1[k] - mu) * rstd * W.lg.y + W.lb.y;
      const float z0 = y0 * __builtin_amdgcn_rcpf(1.f + __expf(-y0)), z1 = y1 * __builtin_amdgcn_rcpf(1.f + __expf(-y1));
      *(unsigned*)(MIX + (size_t)(t0 + tb + k) * 1024 + 512 + 2 * tid) = pk2(z0, z1);
    }
  }
}
__device__ void conv_items(const Params& p, char* smem) {
  const bf16_t* HG = (const bf16_t*)(p.ws + WS_HG);
  const int tid512 = otid(), tid = tid512 & 255, lane = tid512 & 63;
  const int wave = __builtin_amdgcn_readfirstlane(tid512 >> 6);
  const int vb = vblock(), G = gridDim.x;
  ConvW W;
#pragma unroll
  for (int j = 0; j < 31; ++j) {
    const float2 w = *(const float2*)(p.conv_w + j * 512 + 2 * tid);
    W.wv[j] = (f32x2){w.x, w.y};
  }
  W.cb = *(const float2*)(p.conv_b + 2 * tid);
  W.lg = *(const float2*)(p.conv_ln_g + 2 * tid);
  W.lb = *(const float2*)(p.conv_ln_b + 2 * tid);
  int b = 0;
  if (vb < 1024) conv_stage(HG, vb, (LAS unsigned char*)smem, wave, lane);
  for (int item = vb; item < 1024; item += G, b ^= 1) {
    asm volatile("s_waitcnt vmcnt(0) lgkmcnt(0)" ::: "memory");
    __syncthreads();
    if (item + G < 1024) conv_stage(HG, item + G, (LAS unsigned char*)smem + (b ^ 1) * 65536, wave, lane);
    conv_compute(p, item, smem + b * 65536, W, tid512);
  }
  __syncthreads();
}

struct AttnKV { bf16x8 k[4]; bf16x8 v[2][2]; };
__device__ __forceinline__ void attn_load(const bf16_t* Km, const bf16_t* Vt, int bh, int kb, int tok, int hf, AttnKV& f) {
  const int kc = kb < 0 ? 0 : kb;
  const bf16_t* kp = Km + ((size_t)bh * 128 + kc) * 2048 + (hf * 32 + tok) * 8;
#pragma unroll
  for (int ks = 0; ks < 4; ++ks) f.k[ks] = *(const bf16x8*)(kp + ks * 512);
  const bf16_t* vp = Vt + ((size_t)bh * 128 + kc) * 2048 + (hf * 32 + tok) * 8;
#pragma unroll
  for (int m = 0; m < 2; ++m)
#pragma unroll
    for (int s = 0; s < 2; ++s) f.v[m][s] = *(const bf16x8*)(vp + (m * 2 + s) * 512);
}
__device__ __forceinline__ bool attn_block(const AttnKV& f, const bf16x8 (&qf)[4], bool diag, int tok, int hf, float& c, f32x16& o0, f32x16& o1) {
  f32x16 sc;
#pragma unroll
  for (int i = 0; i < 16; ++i) sc[i] = 0.f;
#pragma unroll
  for (int ks = 0; ks < 4; ++ks) sc = mfma32(f.k[ks], qf[ks], sc);
  float kp[16], sg[16];
#pragma unroll
  for (int i = 0; i < 16; ++i) {
    const float e = __builtin_amdgcn_exp2f(fminf(sc[i], 80.f));
    const float r = __builtin_amdgcn_rcpf(1.f + e);
    kp[i] = r;
    sg[i] = e * r;
  }
  if (diag) {
#pragma unroll
    for (int i = 0; i < 16; ++i) {
      const bool valid = ((i & 3) + 8 * (i >> 2) + 4 * hf < tok);
      kp[i] = valid ? kp[i] : 1.f;
      sg[i] = valid ? sg[i] : 0.f;
    }
  }
  float Tg[4], Pg[4];
#pragma unroll
  for (int g = 0; g < 4; ++g) {
    Tg[g] = (kp[4 * g] * kp[4 * g + 1]) * (kp[4 * g + 2] * kp[4 * g + 3]);
    Pg[g] = __shfl_xor(Tg[g], 32);
  }
  float base[4];
  float run = __builtin_amdgcn_exp2f(c);
#pragma unroll
  for (int g = 3; g >= 0; --g) {
    base[g] = run * (hf == 0 ? Pg[g] : 1.f);
    run *= Tg[g] * Pg[g];
  }
  float pr[16];
#pragma unroll
  for (int g = 0; g < 4; ++g) {
    float l = base[g];
#pragma unroll
    for (int r = 3; r >= 0; --r) {
      pr[4 * g + r] = sg[4 * g + r] * l;
      l *= kp[4 * g + r];
    }
  }
  c = __builtin_amdgcn_logf(run);
  bf16x8 pf[2];
#pragma unroll
  for (int s = 0; s < 2; ++s)
#pragma unroll
    for (int j = 0; j < 8; ++j) pf[s][j] = (__bf16)pr[8 * s + j];
#pragma unroll
  for (int s = 0; s < 2; ++s) {
    o0 = mfma32(f.v[0][s], pf[s], o0);
    o1 = mfma32(f.v[1][s], pf[s], o1);
  }
  return __all(c < -150.f);
}
__device__ void attn_tile(const Params& p, int item, int it, int lane, int wave, char* smem) {
  unsigned char* ws = p.ws;
  const bf16_t* Qm = (const bf16_t*)(ws + WS_Q);
  const bf16_t* Km = (const bf16_t*)(ws + WS_K);
  const bf16_t* Vt = (const bf16_t*)(ws + WS_VT);
  bf16_t* MIX = (bf16_t*)(ws + WS_MIX);
  const int qt = item & 127, bh = (item >> 7) * 8 + wave;
  const int tok = lane & 31, hf = lane >> 5;
  bf16x8 qf[4];
  {
    const bf16_t* qp = Qm + ((size_t)bh * 4096 + qt * 32 + tok) * 64 + 8 * hf;
#pragma unroll
    for (int ks = 0; ks < 4; ++ks) qf[ks] = *(const bf16x8*)(qp + ks * 16);
  }
  f32x16 o0, o1;
#pragma unroll
  for (int i = 0; i < 16; ++i) { o0[i] = 0.f; o1[i] = 0.f; }
  float c = 0.f;
  AttnKV fa, fb;
  attn_load(Km, Vt, bh, qt, tok, hf, fa);
  {
    unsigned z = __builtin_bit_cast(u32x4, fa.v[1][1]).w | __builtin_bit_cast(u32x4, fa.k[3]).w | __builtin_bit_cast(u32x4, qf[3]).w;
    asm volatile("" ::"v"(z));
  }
  for (int kb = qt;; kb -= 2) {
    attn_load(Km, Vt, bh, kb - 1, tok, hf, fb);
    __builtin_amdgcn_sched_barrier(0);
    if (attn_block(fa, qf, kb == qt, tok, hf, c, o0, o1) || kb == 0) break;
    attn_load(Km, Vt, bh, kb - 2, tok, hf, fa);
    __builtin_amdgcn_sched_barrier(0);
    if (attn_block(fb, qf, false, tok, hf, c, o0, o1) || kb == 1) break;
  }
  float ssq = 0.f;
#pragma unroll
  for (int i = 0; i < 16; ++i) ssq += o0[i] * o0[i] + o1[i] * o1[i];
  ssq += __shfl_xor(ssq, 32);
  float* xch = (float*)(smem + 100 * 1024) + (it & 1) * 256;
  if (hf == 0) xch[wave * 32 + tok] = ssq;
  __syncthreads();
  float tot = 0.f;
#pragma unroll
  for (int w = 0; w < NWAVES; ++w) tot += xch[w * 32 + tok];
  const float rs = rsqrtf(tot * (1.f / 512.f) + EPS);
  const int t = (bh >> 3) * 4096 + qt * 32 + tok, hh = bh & 7;
  bf16_t* dst = MIX + (size_t)t * 1024 + hh * 64 + 4 * hf;
#pragma unroll
  for (int g = 0; g < 4; ++g) {
    *(u32x2*)(dst + 8 * g) = (u32x2){pk2(o0[4 * g] * rs, o0[4 * g + 1] * rs), pk2(o0[4 * g + 2] * rs, o0[4 * g + 3] * rs)};
    *(u32x2*)(dst + 32 + 8 * g) = (u32x2){pk2(o1[4 * g] * rs, o1[4 * g + 1] * rs), pk2(o1[4 * g + 2] * rs, o1[4 * g + 3] * rs)};
  }
}

__device__ void phase_mix(const Params& p, char* smem) {
  static_assert(NWAVES == 8, "one wave per attention head");
  const int vb = vblock(), G = gridDim.x;
  if (blockIdx.x & 1) prep_tables(p);
  conv_items(p, smem);
  const int tidm = otid();
  const int lane = tidm & 63, wave = tidm >> 6;
  int it = 0;
  for (int item = vb; item < 1024; item += G, ++it) attn_tile(p, item, it, lane, wave, smem);
  if (!(blockIdx.x & 1)) prep_tables(p);
}
__device__ __forceinline__ unsigned f2key(float f, unsigned n) {
  const unsigned u = (__float_as_uint(f) & ~0x7Fu) | n;
  return u ^ ((unsigned)((int)u >> 31) | 0x80000000u);
}
__device__ __forceinline__ unsigned f2key_raw(float f) {
  const unsigned u = __float_as_uint(f);
  return u ^ ((unsigned)((int)u >> 31) | 0x80000000u);
}
__device__ __forceinline__ unsigned key2u(unsigned k) { return k ^ ((k >> 31) ? 0x80000000u : 0xFFFFFFFFu); }

template <int N>
__device__ __forceinline__ void bitonic_sort_desc(unsigned (&v)[N]) {
#pragma unroll
  for (int k = 2; k <= N; k <<= 1) {
#pragma unroll
    for (int j = k >> 1; j > 0; j >>= 1) {
#pragma unroll
      for (int i = 0; i < N; ++i) {
        const int l = i ^ j;
        if (l > i) {
          const bool desc = ((i & k) == 0);
          const unsigned mx = max(v[i], v[l]), mn = min(v[i], v[l]);
          v[i] = desc ? mx : mn;
          v[l] = desc ? mn : mx;
        }
      }
    }
  }
}
template <int N>
__device__ __forceinline__ void bitonic_merge_desc(unsigned (&v)[N]) {
#pragma unroll
  for (int j = N >> 1; j > 0; j >>= 1) {
#pragma unroll
    for (int i = 0; i < N; ++i) {
      const int l = i ^ j;
      if (l > i) {
        const unsigned mx = max(v[i], v[l]), mn = min(v[i], v[l]);
        v[i] = mx;
        v[l] = mn;
      }
    }
  }
}
__device__ __forceinline__ void merge_top16(unsigned (&a)[16], const unsigned (&b)[16]) {
#pragma unroll
  for (int i = 0; i < 16; ++i) a[i] = max(a[i], b[15 - i]);
  bitonic_merge_desc<16>(a);
}
#define CEP(ka, pa, kb, pb, desc)                                  \
  {                                                                \
    const bool sw_ = (desc) ? ((kb) > (ka)) : ((kb) < (ka));       \
    const unsigned tk_ = sw_ ? (kb) : (ka), tl_ = sw_ ? (ka) : (kb); \
    const unsigned tp_ = sw_ ? (pb) : (pa), tq_ = sw_ ? (pa) : (pb); \
    ka = tk_; kb = tl_; pa = tp_; pb = tq_;                        \
  }
template <int N>
__device__ __forceinline__ void bitonic_sort_desc_p(unsigned (&v)[N], unsigned (&pl)[N]) {
#pragma unroll
  for (int k = 2; k <= N; k <<= 1) {
#pragma unroll
    for (int j = k >> 1; j > 0; j >>= 1) {
#pragma unroll
      for (int i = 0; i < N; ++i) {
        const int l = i ^ j;
        if (l > i) {
          const bool desc = ((i & k) == 0);
          CEP(v[i], pl[i], v[l], pl[l], desc);
        }
      }
    }
  }
}
template <int N>
__device__ __forceinline__ void bitonic_merge_desc_p(unsigned (&v)[N], unsigned (&pl)[N]) {
#pragma unroll
  for (int j = N >> 1; j > 0; j >>= 1) {
#pragma unroll
    for (int i = 0; i < N; ++i) {
      const int l = i ^ j;
      if (l > i) { CEP(v[i], pl[i], v[l], pl[l], true); }
    }
  }
}
__device__ __forceinline__ void merge_top16_p(unsigned (&a)[16], unsigned (&pa)[16], const unsigned (&b)[16], const unsigned (&pb)[16]) {
#pragma unroll
  for (int i = 0; i < 16; ++i) {
    const bool s = b[15 - i] > a[i];
    a[i] = s ? b[15 - i] : a[i];
    pa[i] = s ? pb[15 - i] : pa[i];
  }
  bitonic_merge_desc_p<16>(a, pa);
}

constexpr int KROW = 144;
__device__ __forceinline__ void subkey_top16(const LAS unsigned char* Kl, const bf16_t* __restrict__ qrow, int lane, unsigned (&top)[16]) {
  const int tok = lane & 31, hf = lane >> 5;
  f32x16 acc[4];
#pragma unroll
  for (int m = 0; m < 4; ++m)
#pragma unroll
    for (int i = 0; i < 16; ++i) acc[m][i] = 0.f;
  bf16x8 bq[4];
#pragma unroll
  for (int ks = 0; ks < 4; ++ks) bq[ks] = *(const bf16x8*)(qrow + ks * 16 + 8 * hf);
#pragma unroll 1
  for (int ks = 0; ks < 4; ++ks) {
#pragma unroll
    for (int m = 0; m < 4; ++m) {
      const bf16x8 ak = *(const LAS bf16x8*)(Kl + (m * 32 + tok) * KROW + ks * 32 + hf * 16);
      acc[m] = mfma32(ak, ks == 0 ? bq[0] : ks == 1 ? bq[1] : ks == 2 ? bq[2] : bq[3], acc[m]);
    }
  }
  unsigned g[4][16];
#pragma unroll
  for (int m = 0; m < 4; ++m) {
#pragma unroll
    for (int i = 0; i < 16; ++i) g[m][i] = f2key(acc[m][i], (unsigned)(m * 32 + (i & 3) + 8 * (i >> 2) + 4 * hf));
    bitonic_sort_desc<16>(g[m]);
  }
  merge_top16(g[0], g[1]);
  merge_top16(g[2], g[3]);
  merge_top16(g[0], g[2]);
  unsigned o[16];
#pragma unroll
  for (int i = 0; i < 16; ++i) o[i] = __shfl_xor(g[0][i], 32);
  merge_top16(g[0], o);
#pragma unroll
  for (int i = 0; i < 16; ++i) top[i] = g[0][i];
}

__device__ void phase_route(const Params& p, char* smem) {
  unsigned char* ws = p.ws;
  const bf16_t* K1 = (const bf16_t*)(ws + WS_K1);
  const bf16_t* K2 = (const bf16_t*)(ws + WS_K2);
  const bf16_t* QH = (const bf16_t*)(ws + WS_QH);
  const bf16_t* HB = (const bf16_t*)(ws + WS_HB);
  unsigned char* XN8 = ws + WS_XN8;
  const float* SSQ2 = (const float*)(ws + WS_SSQ2);
  unsigned* PIDX = (unsigned*)(ws + WS_PIDX);
  float* PG = (float*)(ws + WS_PG);
  const int tidr = otid();
  const int lane = tidr & 63, wave = tidr >> 6, gw = vblock() * NWAVES + wave, nw = gridDim.x * NWAVES;
  const int G = gridDim.x, nh = (G % 8 == 0) ? 8 : 1;
  LAS unsigned char* K1l = (LAS unsigned char*)smem;
  LAS unsigned char* K2l = K1l + 128 * KROW;
  for (int hd = blockIdx.x % nh; hd < 8; hd += nh) {
    for (int idx = tidr; idx < 2048; idx += NTHREADS) {
      const int tb = idx >> 10, row = (idx >> 3) & 127, ch = idx & 7;
      const u32x4 v = *(const u32x4*)((tb ? K2 : K1) + hd * 8192 + row * 64 + ch * 8);
      *(LAS u32x4*)((tb ? K2l : K1l) + row * KROW + ch * 16) = v;
    }
    __syncthreads();
    for (int tile = (blockIdx.x / nh) * NWAVES + wave; tile < T / 32; tile += (G / nh) * NWAVES) {
      const int t0 = tile * 32;
      const int tok = lane & 31, hf = lane >> 5;
      const bf16_t* qrow = QH + (size_t)(t0 + tok) * 1024 + hd * 128;
      unsigned top1[16], top2[16];
      subkey_top16(K1l, qrow, lane, top1);
      subkey_top16(K2l, qrow + 64, lane, top2);
      float fa[16], fb[16];
      unsigned ia[16], ib[16];
#pragma unroll
      for (int i = 0; i < 16; ++i) {
        const unsigned ua = key2u(hf ? top2[i] : top1[i]), ub = key2u(hf ? top1[i] : top2[i]);
        fa[i] = __uint_as_float(ua); ia[i] = ua & 0x7Fu;
        fb[i] = __uint_as_float(ub); ib[i] = ub & 0x7Fu;
      }
      unsigned ck[32];
      {
        int n = 0;
#pragma unroll
        for (int i = 0; i < 4; ++i) {
#pragma unroll
          for (int j = i; j < 16; ++j) {
            if ((i + 1) * (j + 1) <= 16) {
              unsigned key = (f2key_raw(fa[i] + fb[j]) & ~0x3FFFu) | (hf ? ((ib[j] << 7) | ia[i]) : ((ia[i] << 7) | ib[j]));
              if (i == j && hf) key = 0u;
              ck[n] = key;
              ++n;
            }
          }
        }
#pragma unroll
        for (; n < 32; ++n) ck[n] = 0u;
      }
      unsigned k0[16], k1[16];
#pragma unroll
      for (int i = 0; i < 16; ++i) { k0[i] = ck[i]; k1[i] = ck[16 + i]; }
      bitonic_sort_desc<16>(k0);
      bitonic_sort_desc<16>(k1);
      merge_top16(k0, k1);
#pragma unroll
      for (int i = 0; i < 16; ++i) k1[i] = __shfl_xor(k0[i], 32);
      merge_top16(k0, k1);
      float sv[16], sum = 0.f;
      const float mx = __uint_as_float(key2u(k0[0] & ~0x3FFFu));
#pragma unroll
      for (int i = 0; i < 16; ++i) {
        sv[i] = __builtin_amdgcn_exp2f((__uint_as_float(key2u(k0[i] & ~0x3FFFu)) - mx) * LOG2E);
        sum += sv[i];
      }
      const float inv = 1.f / sum;
      const size_t po = ((size_t)(t0 + tok) * 8 + hd) * 16;
      if (hf == 0) {
#pragma unroll
        for (int q = 0; q < 4; ++q) *(u32x4*)(PIDX + po + 4 * q) = (u32x4){k0[4 * q] & 0x3FFFu, k0[4 * q + 1] & 0x3FFFu, k0[4 * q + 2] & 0x3FFFu, k0[4 * q + 3] & 0x3FFFu};
      } else {
#pragma unroll
        for (int q = 0; q < 4; ++q) *(f32x4*)(PG + po + 4 * q) = (f32x4){sv[4 * q] * inv, sv[4 * q + 1] * inv, sv[4 * q + 2] * inv, sv[4 * q + 3] * inv};
      }
    }
    __syncthreads();
  }
}

typedef int i32x8 __attribute__((ext_vector_type(8)));
__device__ __forceinline__ f32x4 mfma_fp4_fp8(u32x4 a, u32x4 b0, u32x4 b1, f32x4 c) {
  const i32x8 A = {(int)a.x, (int)a.y, (int)a.z, (int)a.w, 0, 0, 0, 0};
  const i32x8 B = {(int)b0.x, (int)b0.y, (int)b0.z, (int)b0.w, (int)b1.x, (int)b1.y, (int)b1.z, (int)b1.w};
  return __builtin_amdgcn_mfma_scale_f32_16x16x128_f8f6f4(A, B, c, 4, 0, 0, 0x7F7F7F7F, 0, 0x7F7F7F7F);
}
struct PeCtx {
  const unsigned char* U8; const float2* USV; LAS float* glist;
  LAS unsigned* list; int lane, r, g, s, n, t0;
};
__device__ __forceinline__ void pe_rows(const PeCtx& c, int ci, u32x4 (&a)[8]) {
  const int idx = ci * 16 + (c.lane >> 2);
  const unsigned ent = c.list[idx & 2047];
  const unsigned e = (idx < c.n) ? ((ent >> 7) & 16383u) : (unsigned)(c.s << 11);
  const unsigned char* rp = c.U8 + (size_t)e * 512 + (c.lane & 3) * 16;
#pragma unroll
  for (int ks = 0; ks < 8; ++ks) a[ks] = *(const u32x4*)(rp + ks * 64);
}
__device__ __forceinline__ void pe_fix(const PeCtx& c, u32x4 (&a)[8]) {
  const int src = 4 * c.r + c.g;
#pragma unroll
  for (int ks = 0; ks < 8; ++ks) {
    a[ks].x = (unsigned)__shfl((int)a[ks].x, src); a[ks].y = (unsigned)__shfl((int)a[ks].y, src);
    a[ks].z = (unsigned)__shfl((int)a[ks].z, src); a[ks].w = (unsigned)__shfl((int)a[ks].w, src);
  }
}
__device__ __forceinline__ void pe_chunk(const PeCtx& c, int ci, u32x4 (&a)[8], u32x4 (&anext)[8], const u32x4 (&bq)[16]) {
  const int idx = ci * 16 + c.r;
  const unsigned ent = c.list[idx & 2047];
  const bool fin = (c.lane < 16) && (idx < c.n);
  const unsigned e = (ent >> 7) & 16383u, col = (ent >> 21) & 15u;
  const float2 usv = c.USV[fin ? e : 0u];
  const float gt = c.glist[idx & 2047], us = usv.x, vs = usv.y;
  __builtin_amdgcn_sched_barrier(0);
  pe_rows(c, ci + 1, anext);
  __builtin_amdgcn_sched_barrier(0);
  pe_fix(c, a);
  f32x4 acc = {0.f, 0.f, 0.f, 0.f};
#pragma unroll
  for (int ks = 0; ks < 8; ++ks) acc = mfma_fp4_fp8(a[ks], bq[2 * ks], bq[2 * ks + 1], acc);
  const int src = ((c.r >> 2) << 4) | (int)col;
  const float v0 = __shfl(acc[0], src), v1 = __shfl(acc[1], src), v2 = __shfl(acc[2], src), v3 = __shfl(acc[3], src);
  float d = ((c.r & 3) == 0) ? v0 : ((c.r & 3) == 1) ? v1 : ((c.r & 3) == 2) ? v2 : v3;
  float gt_ = gt, us_ = us, vs_ = vs;
  asm volatile("" : "+v"(d), "+v"(gt_), "+v"(us_), "+v"(vs_));
  {
    const float act = d * us_ * (1.f / 16.f);
    const float w = gt_ * 0.5f * act * (1.f + erff(act * 0.70710678118654752f)) * vs_;
    if (fin) c.glist[idx & 2047] = w;
  }
}
#define PFV_LOAD(R, ev, k0)                                                                               \
  {                                                                                                       \
    _Pragma("unroll") for (int i_ = 0; i_ < 8; ++i_) {                                                    \
      const unsigned e_ = (unsigned)__builtin_amdgcn_ds_bpermute(bsel + 4 * ((k0) + 2 * i_), (int)(ev)); \
      R[i_] = *(const u32x4*)(V4 + (e_ << 9));                                                            \
    }                                                                                                     \
  }
#define PFV_FMA(dw, b, a) acc[a] = __builtin_elementwise_fma(__builtin_amdgcn_cvt_scalef32_pk_f32_fp4(dw, 1.0f, b), w2_, acc[a]);
#define PFV_ACC(R, wv, k0)                                                                                \
  {                                                                                                       \
    _Pragma("unroll") for (int i_ = 0; i_ < 8; ++i_) {                                                    \
      const float ws_ = __builtin_bit_cast(float, __builtin_amdgcn_ds_bpermute(bsel + 4 * ((k0) + 2 * i_), __builtin_bit_cast(int, (wv)))); \
      const f32x2 w2_ = {ws_, ws_};                                                                       \
      PFV_FMA(R[i_].x, 0, 0)  PFV_FMA(R[i_].x, 1, 1)  PFV_FMA(R[i_].x, 2, 2)  PFV_FMA(R[i_].x, 3, 3)      \
      PFV_FMA(R[i_].y, 0, 4)  PFV_FMA(R[i_].y, 1, 5)  PFV_FMA(R[i_].y, 2, 6)  PFV_FMA(R[i_].y, 3, 7)      \
      PFV_FMA(R[i_].z, 0, 8)  PFV_FMA(R[i_].z, 1, 9)  PFV_FMA(R[i_].z, 2, 10) PFV_FMA(R[i_].z, 3, 11)     \
      PFV_FMA(R[i_].w, 0, 12) PFV_FMA(R[i_].w, 1, 13) PFV_FMA(R[i_].w, 2, 14) PFV_FMA(R[i_].w, 3, 15)     \
    }                                                                                                     \
  }
__device__ void phase_peer_u(const Params& p, char* smem) {
  unsigned char* ws = p.ws;
  PeCtx c;
  c.U8 = ws + WS_U8; c.USV = (const float2*)(ws + WS_USV);
  const float* PG = (const float*)(ws + WS_PG);
  const bf16_t* HB = (const bf16_t*)(ws + WS_HB);
  const float* SSQ2 = (const float*)(ws + WS_SSQ2);
  const unsigned* PIDX = (const unsigned*)(ws + WS_PIDX);
  const int tidu = otid();
  const int lane = tidu & 63, wave = tidu >> 6;
  c.lane = lane; c.r = lane & 15; c.g = lane >> 4;
  c.list = (LAS unsigned*)(smem + wave * 8192);
  c.glist = (LAS float*)(smem + 65536 + wave * 8192);
  const bool hi = lane >= 32;
  const int bsel = hi ? 4 : 0;
  const unsigned char* V4 = ws + WS_V8 + (lane & 31) * 16;
  c.s = 0;
  {
    for (int grp = vblock() * NWAVES + wave; grp < T / 16; grp += gridDim.x * NWAVES) {
      const int t0 = grp * 16;
      c.t0 = t0;
      u32x4 bq[16];
      {
        const bf16_t* hp = HB + (size_t)(t0 + c.r) * 1024 + c.g * 16;
        const float rq = rsqrtf(SSQ2[t0 + c.r] * (1.f / 1024.f) + EPS) * 16.f;
#pragma unroll
        for (int kh = 0; kh < 16; ++kh) {
          const u32x4 h0 = *(const u32x4*)(hp + (kh >> 1) * 128 + (kh & 1) * 64), h1 = *(const u32x4*)(hp + (kh >> 1) * 128 + (kh & 1) * 64 + 8);
          u32x4 q;
#pragma unroll
          for (int i = 0; i < 4; ++i) {
            const unsigned lo = (i < 2) ? h0[2 * i] : h1[2 * i - 4], hi2 = (i < 2) ? h0[2 * i + 1] : h1[2 * i - 3];
            int w = 0;
            w = __builtin_amdgcn_cvt_pk_fp8_f32(bflo(lo) * rq, bfhi(lo) * rq, w, false);
            w = __builtin_amdgcn_cvt_pk_fp8_f32(bflo(hi2) * rq, bfhi(hi2) * rq, w, true);
            q[i] = (unsigned)w;
          }
          bq[kh] = q;
        }
      }
      const int n = 2048;
#pragma unroll
      for (int q = 0; q < 8; ++q) {
        const u32x4 idv = *(const u32x4*)(PIDX + (size_t)t0 * 128 + q * 256 + lane * 4);
        const f32x4 gv = *(const f32x4*)(PG + (size_t)t0 * 128 + q * 256 + lane * 4);
        const unsigned hi = (unsigned)(2 * q + (lane >> 5)) << 21, sl = (unsigned)((lane & 31) * 4);
        *(LAS u32x4*)(c.list + q * 256 + lane * 4) = (u32x4){hi | (idv.x << 7) | sl, hi | (idv.y << 7) | (sl + 1), hi | (idv.z << 7) | (sl + 2), hi | (idv.w << 7) | (sl + 3)};
        *(LAS f32x4*)(c.glist + q * 256 + lane * 4) = gv;
      }
      asm volatile("s_waitcnt lgkmcnt(0)" ::: "memory");
      c.n = n;
      const int nch = (n + 15) >> 4;
      u32x4 a0[8], a1[8];
      pe_rows(c, 0, a0);
      {
        unsigned z = 0u;
#pragma unroll
        for (int ks = 0; ks < 8; ++ks) z |= a0[ks].w;
        asm volatile("" ::"v"(z));
      }
      if (nch > 0) {
        for (int ci = 0;; ci += 2) {
          pe_chunk(c, ci, a0, a1, bq);
          if (ci + 1 >= nch) break;
          pe_chunk(c, ci + 1, a1, a0, bq);
          if (ci + 2 >= nch) break;
        }
      }
      asm volatile("s_waitcnt lgkmcnt(0)" ::: "memory");
      {
        unsigned e0 = (c.list[lane] >> 7) & 16383u, e1 = (c.list[64 + lane] >> 7) & 16383u;
        float w0 = c.glist[lane], w1 = c.glist[64 + lane];
        u32x4 RA[8], RB[8];
        PFV_LOAD(RA, e0, 0)
        {
          unsigned z = 0u;
#pragma unroll
          for (int i = 0; i < 8; ++i) z |= RA[i].w;
          asm volatile("" ::"v"(z));
        }
        for (int tk = 0; tk < 16; ++tk) {
          const int tn = tk < 15 ? tk + 1 : tk;
          const unsigned e0n = (c.list[tn * 128 + lane] >> 7) & 16383u, e1n = (c.list[tn * 128 + 64 + lane] >> 7) & 16383u;
          const float w0n = c.glist[tn * 128 + lane], w1n = c.glist[tn * 128 + 64 + lane];
          const size_t oo = (size_t)(t0 + tk) * 1024 + (lane & 31) * 32 + (hi ? 16 : 0);
          const u32x4 hb0 = *(const u32x4*)(HB + oo), hb1 = *(const u32x4*)(HB + oo + 8);
          f32x2 acc[16];
#pragma unroll
          for (int k = 0; k < 16; ++k) acc[k] = (f32x2){0.f, 0.f};
          __builtin_amdgcn_sched_barrier(0);
          PFV_LOAD(RB, e0, 16)  __builtin_amdgcn_sched_barrier(0);  PFV_ACC(RA, w0, 0)
          PFV_LOAD(RA, e0, 32)  __builtin_amdgcn_sched_barrier(0);  PFV_ACC(RB, w0, 16)
          PFV_LOAD(RB, e0, 48)  __builtin_amdgcn_sched_barrier(0);  PFV_ACC(RA, w0, 32)
          PFV_LOAD(RA, e1, 0)   __builtin_amdgcn_sched_barrier(0);  PFV_ACC(RB, w0, 48)
          PFV_LOAD(RB, e1, 16)  __builtin_amdgcn_sched_barrier(0);  PFV_ACC(RA, w1, 0)
          PFV_LOAD(RA, e1, 32)  __builtin_amdgcn_sched_barrier(0);  PFV_ACC(RB, w1, 16)
          PFV_LOAD(RB, e1, 48)  __builtin_amdgcn_sched_barrier(0);  PFV_ACC(RA, w1, 32)
          PFV_LOAD(RA, e0n, 0)  __builtin_amdgcn_sched_barrier(0);  PFV_ACC(RB, w1, 48)
          f32x2 r[8];
#pragma unroll
          for (int k = 0; k < 8; ++k) {
            const f32x2 keep = hi ? acc[8 + k] : acc[k], send = hi ? acc[k] : acc[8 + k];
            r[k] = keep + (f32x2){__shfl_xor(send.x, 32), __shfl_xor(send.y, 32)};
          }
          float* o = p.out + oo;
          *(f32x4*)(o)      = (f32x4){bflo(hb0.x) + r[0].x, bfhi(hb0.x) + r[0].y, bflo(hb0.y) + r[1].x, bfhi(hb0.y) + r[1].y};
          *(f32x4*)(o + 4)  = (f32x4){bflo(hb0.z) + r[2].x, bfhi(hb0.z) + r[2].y, bflo(hb0.w) + r[3].x, bfhi(hb0.w) + r[3].y};
          *(f32x4*)(o + 8)  = (f32x4){bflo(hb1.x) + r[4].x, bfhi(hb1.x) + r[4].y, bflo(hb1.y) + r[5].x, bfhi(hb1.y) + r[5].y};
          *(f32x4*)(o + 12) = (f32x4){bflo(hb1.z) + r[6].x, bfhi(hb1.z) + r[6].y, bflo(hb1.w) + r[7].x, bfhi(hb1.w) + r[7].y};
          e0 = e0n; e1 = e1n; w0 = w0n; w1 = w1n;
        }
      }
      asm volatile("" ::: "memory");
    }
  }
}
#undef PFV_LOAD
#undef PFV_FMA
#undef PFV_ACC


#define XB_TMO      128
#define XB_XCNT(j)  (256  + 64 * (j))
#define XB_XSUB(j)  (1280 + 64 * (j))
#define XB_XGEN(j)  (2304 + 64 * (j))
#define XB_TOP      3328
#define XB_TOPGEN   3392
#define XCD_BAR_WORDS 3456
#define XB_SPIN_CAP (1u << 22)
__device__ __forceinline__ unsigned xb_ld(unsigned* p)              { return __hip_atomic_load(p, __ATOMIC_RELAXED, __HIP_MEMORY_SCOPE_AGENT); }
__device__ __forceinline__ unsigned xb_add(unsigned* p, unsigned v) { return __hip_atomic_fetch_add(p, v, __ATOMIC_RELAXED, __HIP_MEMORY_SCOPE_AGENT); }
__device__ __forceinline__ unsigned xb_xcc_id() { return (unsigned)__builtin_amdgcn_s_getreg((3 << 11) | 20) & 0xFu; }
#define XB_SPIN(cond, bar) do { unsigned _sp = 0; while (cond) { __builtin_amdgcn_s_sleep(1); \
    if ((++_sp & 255u) == 0u) { if (xb_ld(&(bar)[XB_TMO])) break; if (_sp > XB_SPIN_CAP) { atomicAdd(&(bar)[XB_TMO], 1u); break; } } } } while (0)
struct XcdBarrier { unsigned* bar; unsigned x; volatile LAS unsigned* st; };
__device__ __forceinline__ XcdBarrier xcd_barrier_post(unsigned* bar, volatile LAS unsigned* st) {
    XcdBarrier b; b.bar = bar; b.x = xb_xcc_id(); b.st = st;
    if (threadIdx.x == 0) (void)xb_add(&bar[XB_XCNT(b.x)], 1u);
    return b;
}
__device__ __forceinline__ void xcd_barrier_complete(unsigned* bar, unsigned x, unsigned& nloc, unsigned& nx) {
    const unsigned G = gridDim.x * gridDim.y * gridDim.z;
    unsigned sum, cnt, mine, sp = 0u;
    for (;;) {
        sum = 0u; cnt = 0u; mine = 0u;
#pragma unroll
        for (unsigned j = 0; j < 16; ++j) { const unsigned c = xb_ld(&bar[XB_XCNT(j)]); sum += c; cnt += (c > 0u) ? 1u : 0u; mine = (j == x) ? c : mine; }
        if (sum == G) break;
        __builtin_amdgcn_s_sleep(1);
        if ((++sp & 255u) == 0u) { if (xb_ld(&bar[XB_TMO])) break; if (sp > XB_SPIN_CAP) { atomicAdd(&bar[XB_TMO], 1u); break; } }
    }
    nloc = mine > 0u ? mine : 1u; nx = cnt > 0u ? cnt : 1u;
}
__device__ __forceinline__ void xcd_barrier(const XcdBarrier& b) {
    asm volatile("s_waitcnt vmcnt(0)" ::: "memory");
    __syncthreads();
    if (threadIdx.x == 0) {
        unsigned* bar = b.bar;
        __builtin_amdgcn_s_waitcnt(0);
        unsigned nloc = b.st[0], nx = b.st[1];
        if (nloc == 0u) { xcd_barrier_complete(bar, b.x, nloc, nx); b.st[0] = nloc; b.st[1] = nx; }
        const unsigned old = xb_add(&bar[XB_XSUB(b.x)], 1u);
        const unsigned gen = old / nloc;
        if (old + 1u == (gen + 1u) * nloc) {
            __builtin_amdgcn_fence(__ATOMIC_RELEASE, "agent");
            asm volatile("s_waitcnt vmcnt(0)" ::: "memory");
            const unsigned og = xb_add(&bar[XB_TOP], 1u);
            const unsigned tg = og / nx;
            if (og + 1u == (tg + 1u) * nx) xb_add(&bar[XB_TOPGEN], 1u);
            else XB_SPIN(xb_ld(&bar[XB_TOPGEN]) == tg, bar);
            __builtin_amdgcn_fence(__ATOMIC_ACQUIRE, "agent");
            xb_add(&bar[XB_XGEN(b.x)], 1u);
            asm volatile("s_waitcnt vmcnt(0)" ::: "memory");
        } else {
            XB_SPIN(xb_ld(&bar[XB_XGEN(b.x)]) == gen, bar);
            __builtin_amdgcn_fence(__ATOMIC_ACQUIRE, "agent");
            asm volatile("s_waitcnt vmcnt(0)" ::: "memory");
        }
    }
    __syncthreads();
}

__global__ void __launch_bounds__(NTHREADS, 2) k_fused(Params p) {
  __shared__ __attribute__((aligned(16))) char smem[LDS_BYTES];
  if (threadIdx.x == 0) *(u32x4*)(smem + LDS_BAR) = (u32x4){0u, 0u, 0u, 0u};
  __syncthreads();
  const XcdBarrier bar = xcd_barrier_post((unsigned*)(p.ws + WS_CTL), (volatile LAS unsigned*)(smem + LDS_BAR));
#ifdef PROBE_PHASE
  unsigned long long ts[12];
#define STAMP(k) ts[k] = __builtin_amdgcn_s_memrealtime();
#else
#define STAMP(k)
#endif
  STAMP(0)
  phase_prep(p);
  xcd_barrier(bar);
  STAMP(1)
  phase_inproj(p, smem);
  xcd_barrier(bar);
  STAMP(2)
  phase_mix(p, smem);
  xcd_barrier(bar);
  STAMP(3)
  phase_outproj(p, smem);
  xcd_barrier(bar);
  STAMP(4)
  phase_qproj(p, smem);
  xcd_barrier(bar);
  STAMP(5)
  phase_route(p, smem);
  xcd_barrier(bar);
  STAMP(6)
  phase_peer_u(p, smem);
#ifdef PROBE_PHASE
  xcd_barrier(bar);
  STAMP(7)
  if (blockIdx.x == 0 && threadIdx.x == 0) {
    const float us = (float)(ts[PROBE_PHASE + 1] - ts[PROBE_PHASE]) * 0.01f;
    p.out[12345] += us * (1.f / PROBE_DIV);
  }
#endif
}

extern "C" void kernel_launch(void* const* d_in, const int* in_sizes, int n_in, void* d_out, int out_size, void* d_ws, size_t ws_size,
                              hipStream_t stream) {
  if (n_in != 17 || ws_size < WS_END) {
    fprintf(stderr, "kernel_launch: unexpected n_in %d / ws_size %zu\n", n_in, ws_size);
    return;
  }
  Params p{};
  p.x = (const float*)d_in[0]; p.norm_mix_g = (const float*)d_in[1]; p.w_in = (const float*)d_in[2]; p.q_norm_g = (const float*)d_in[3];
  p.k_norm_g = (const float*)d_in[4]; p.attn_out_g = (const float*)d_in[5]; p.conv_w = (const float*)d_in[6]; p.conv_b = (const float*)d_in[7];
  p.conv_ln_g = (const float*)d_in[8]; p.conv_ln_b = (const float*)d_in[9]; p.w_out = (const float*)d_in[10]; p.norm_ffn_g = (const float*)d_in[11];
  p.peer_wq = (const float*)d_in[12]; p.peer_k1 = (const float*)d_in[13]; p.peer_k2 = (const float*)d_in[14]; p.peer_u = (const float*)d_in[15];
  p.peer_v = (const float*)d_in[16];
  p.out = (float*)d_out;
  p.ws = (unsigned char*)d_ws;
  static int grid_blocks = 0;
  if (!grid_blocks) {
    int dev = 0, cus = 0, per_cu = 0;
    (void)hipGetDevice(&dev);
    (void)hipDeviceGetAttribute(&cus, hipDeviceAttributeMultiprocessorCount, dev);
    (void)hipOccupancyMaxActiveBlocksPerMultiprocessor(&per_cu, k_fused, NTHREADS, 0);
    if (per_cu > 1) per_cu = 1;
    if (per_cu < 1) per_cu = 1;
    grid_blocks = cus * per_cu;
  }
  (void)hipMemsetAsync((char*)d_ws + WS_CTL, 0, XCD_BAR_WORDS * 4, stream);
  hipLaunchKernelGGL(k_fused, dim3(grid_blocks), dim3(NTHREADS), 0, stream, p);
}
```

```cpp
#include <hip/hip_runtime.h>
#include <cstdio>

#define LAS __attribute__((address_space(3)))
typedef unsigned short bf16_t;
typedef __bf16 bf16x8 __attribute__((ext_vector_type(8)));
typedef __bf16 bf16x2 __attribute__((ext_vector_type(2)));
typedef float f32x4 __attribute__((ext_vector_type(4)));
typedef float f32x16 __attribute__((ext_vector_type(16)));
typedef unsigned u32x4 __attribute__((ext_vector_type(4)));
typedef unsigned u32x2 __attribute__((ext_vector_type(2)));
typedef float f32x2 __attribute__((ext_vector_type(2)));

constexpr int SEQ = 4096, T = 8 * SEQ, D = 1024, NIN = 2560;
constexpr float EPS = 1e-6f;
constexpr float LOG2E = 1.4426950408889634f;

constexpr size_t MiB = 1u << 20;
constexpr size_t WS_W1 = 0, WS_WV = 4 * MiB, WS_WOUT = 5 * MiB, WS_WQ = 7 * MiB, WS_K1 = 9 * MiB, WS_K2 = 9 * MiB + 131072, WS_SSQ = 10 * MiB;
constexpr size_t WS_CTL = 11 * MiB;
constexpr size_t WS_USV = 11 * MiB + 65536;
constexpr size_t WS_RS1 = 11 * MiB + 196608, WS_SSQ2 = 11 * MiB + 327680;
constexpr size_t WS_U8 = 12 * MiB, WS_V8 = 28 * MiB;
constexpr size_t WS_XB = 44 * MiB;
constexpr size_t WS_Q = 108 * MiB, WS_K = 140 * MiB, WS_VT = 172 * MiB, WS_HG = 204 * MiB, WS_MIX = 236 * MiB;
constexpr size_t WS_HB = 300 * MiB, WS_QH = 364 * MiB;
constexpr size_t WS_XN8 = 108 * MiB, WS_PIDX = 140 * MiB, WS_PG = 156 * MiB, WS_PW = 172 * MiB;
constexpr size_t WS_END = 428 * MiB;

struct Params {
  const float *x, *norm_mix_g, *w_in, *q_norm_g, *k_norm_g, *attn_out_g, *conv_w, *conv_b, *conv_ln_g, *conv_ln_b,
      *w_out, *norm_ffn_g, *peer_wq, *peer_k1, *peer_k2, *peer_u, *peer_v;
  float* out;
  unsigned char* ws;
};

constexpr int NTHREADS = 512, NWAVES = 8;
constexpr int LDS_STAGE = 131072, LDS_BAR = LDS_STAGE, LDS_BYTES = LDS_STAGE + 16;

__device__ __forceinline__ unsigned pk2(float lo, float hi) {
  bf16x2 v = {(__bf16)lo, (__bf16)hi};
  return __builtin_bit_cast(unsigned, v);
}
__device__ __forceinline__ float bflo(unsigned u) { return __uint_as_float(u << 16); }
__device__ __forceinline__ float bfhi(unsigned u) { return __uint_as_float(u & 0xffff0000u); }
__device__ __forceinline__ int otid() { int t = threadIdx.x; asm volatile("" : "+v"(t)); return t; }
__device__ __forceinline__ int vblock() {
  const int G = gridDim.x, b = blockIdx.x;
  return (G % 8 == 0) ? (b % 8) * (G / 8) + b / 8 : b;
}
__device__ __forceinline__ f32x16 mfma32(bf16x8 a, bf16x8 b, f32x16 c) { return __builtin_amdgcn_mfma_f32_32x32x16_bf16(a, b, c, 0, 0, 0); }

__device__ __forceinline__ int w1_src(int n) {
  if (n < 1024) {
    const int kind = n >> 9, rel = n & 511, pn = rel >> 8, P = rel & 255, bj = P >> 7, wc = (P >> 5) & 3, x = P & 31;
    return kind * 512 + (4 * pn + wc) * 64 + 32 * bj + x;
  }
  const int rel = n - 1024, pn = rel >> 8, P = rel & 255, bj = P >> 7, wc = (P >> 5) & 3, x = P & 31;
  return (bj ? 2048 : 1536) + 128 * pn + 32 * wc + x;
}
__device__ __forceinline__ void transpose_items(const float* __restrict__ W, int ldw, int N, bf16_t* __restrict__ Wt, const float* __restrict__ g, int glimit,
                                                int mode, long gtid, long nthr) {
  const long nitems = (long)N * 128;
  for (long it0 = gtid; it0 < nitems; it0 += 4 * nthr) {
    float v[4][8];
#pragma unroll
    for (int u = 0; u < 4; ++u) {
      const long it = (it0 + u * nthr < nitems) ? it0 + u * nthr : it0;
      const int n = (int)(it % N), kc = (int)(it / N);
      const int src = mode == 1 ? w1_src(n) : (mode == 2 ? 1024 + n : n);
#pragma unroll
      for (int i = 0; i < 8; ++i) v[u][i] = W[(size_t)(kc * 8 + i) * ldw + src];
    }
#pragma unroll
    for (int u = 0; u < 4; ++u) {
      const long it = it0 + u * nthr;
      if (it < nitems) {
        const int n = (int)(it % N), kc = (int)(it / N);
#pragma unroll
        for (int i = 0; i < 8; ++i) { const int k = kc * 8 + i; if (k < glimit) v[u][i] *= g[k]; }
        *(u32x4*)(Wt + (size_t)n * 1024 + kc * 8) = (u32x4){pk2(v[u][0], v[u][1]), pk2(v[u][2], v[u][3]), pk2(v[u][4], v[u][5]), pk2(v[u][6], v[u][7])};
      }
    }
  }
}
__device__ __forceinline__ void convert_items(const float* __restrict__ src, bf16_t* __restrict__ dst, long n8, long gtid, long nthr) {
  for (long it = gtid; it < n8; it += nthr) {
    const f32x4 a = *(const f32x4*)(src + it * 8), b = *(const f32x4*)(src + it * 8 + 4);
    u32x4 o = {pk2(a.x, a.y), pk2(a.z, a.w), pk2(b.x, b.y), pk2(b.z, b.w)};
    *(u32x4*)(dst + it * 8) = o;
  }
}
__device__ void phase_prep(const Params& p) {
  const int tid0 = otid();
  unsigned char* ws = p.ws;
  if (tid0 >= 384) {
    const long gtid = (long)vblock() * 128 + (tid0 - 384), nthr = (long)gridDim.x * 128;
    transpose_items(p.w_in, NIN, 2048, (bf16_t*)(ws + WS_W1), p.norm_mix_g, 1024, 1, gtid, nthr);
    transpose_items(p.w_in, NIN, 512, (bf16_t*)(ws + WS_WV), p.norm_mix_g, 1024, 2, gtid, nthr);
    transpose_items(p.w_out, D, D, (bf16_t*)(ws + WS_WOUT), p.attn_out_g, 512, 0, gtid, nthr);
    transpose_items(p.peer_wq, D, D, (bf16_t*)(ws + WS_WQ), p.norm_ffn_g, 1024, 0, gtid, nthr);
    convert_items(p.peer_k1, (bf16_t*)(ws + WS_K1), 65536 / 8, gtid, nthr);
    convert_items(p.peer_k2, (bf16_t*)(ws + WS_K2), 65536 / 8, gtid, nthr);
    return;
  }
  const int lane = tid0 & 63, gw = vblock() * 6 + (tid0 >> 6), nw = gridDim.x * 6;
  {
    bf16_t* XB = (bf16_t*)(ws + WS_XB);
    float* RS1 = (float*)(ws + WS_RS1);
    float* SSQ2 = (float*)(ws + WS_SSQ2);
    for (int tb = gw; tb < T; tb += 2 * nw) {
      f32x4 v[2][4];
      float ss[2] = {0.f, 0.f};
#pragma unroll
      for (int u = 0; u < 2; ++u) {
        const int t = (tb + u * nw < T) ? tb + u * nw : tb;
        const float* src = p.x + (size_t)t * 1024 + lane * 4;
#pragma unroll
        for (int i = 0; i < 4; ++i) v[u][i] = *(const f32x4*)(src + 256 * i);
      }
#pragma unroll
      for (int u = 0; u < 2; ++u) {
#pragma unroll
        for (int i = 0; i < 4; ++i) ss[u] += v[u][i].x * v[u][i].x + v[u][i].y * v[u][i].y + v[u][i].z * v[u][i].z + v[u][i].w * v[u][i].w;
      }
#pragma unroll
      for (int o = 1; o < 64; o <<= 1) { ss[0] += __shfl_xor(ss[0], o); ss[1] += __shfl_xor(ss[1], o); }
#pragma unroll
      for (int u = 0; u < 2; ++u) {
        const int t = tb + u * nw;
        if (t < T) {
#pragma unroll
          for (int i = 0; i < 4; ++i) *(u32x2*)(XB + (size_t)t * 1024 + lane * 4 + 256 * i) = (u32x2){pk2(v[u][i].x, v[u][i].y), pk2(v[u][i].z, v[u][i].w)};
          if (lane == 0) { RS1[t] = rsqrtf(ss[u] * (1.f / 1024.f) + EPS); SSQ2[t] = 0.f; }
        }
      }
    }
  }
}

__device__ void prep_tables(const Params& p) {
  unsigned char* ws = p.ws;
  const int tid0 = otid();
  const int lane = tid0 & 63, gw = vblock() * NWAVES + (tid0 >> 6), nw = gridDim.x * NWAVES;
  {
    f32x4 gn[4];
#pragma unroll
    for (int i = 0; i < 4; ++i) gn[i] = *(const f32x4*)(p.norm_ffn_g + lane * 16 + 4 * i);
    for (int rb = gw; rb < 32768; rb += 2 * nw) {
      f32x4 v[2][4];
#pragma unroll
      for (int u = 0; u < 2; ++u) {
        const int r = (rb + u * nw < 32768) ? rb + u * nw : rb;
        const float* src = ((r >> 14) ? p.peer_v : p.peer_u) + (size_t)(r & 16383) * 1024 + lane * 16;
#pragma unroll
        for (int i = 0; i < 4; ++i) v[u][i] = *(const f32x4*)(src + 4 * i);
        if (!(r >> 14)) {
#pragma unroll
          for (int i = 0; i < 4; ++i) v[u][i] *= gn[i];
        }
      }
      float am[2] = {0.f, 0.f};
#pragma unroll
      for (int u = 0; u < 2; ++u)
#pragma unroll
        for (int i = 0; i < 4; ++i)
          am[u] = fmaxf(am[u], fmaxf(fmaxf(fabsf(v[u][i].x), fabsf(v[u][i].y)), fmaxf(fabsf(v[u][i].z), fabsf(v[u][i].w))));
#pragma unroll
      for (int o = 1; o < 64; o <<= 1) { am[0] = fmaxf(am[0], __shfl_xor(am[0], o)); am[1] = fmaxf(am[1], __shfl_xor(am[1], o)); }
#pragma unroll
      for (int u = 0; u < 2; ++u) {
        const int r = rb + u * nw;
        if (r < 32768) {
          const int isv = r >> 14, e = r & 16383;
          const float scale = am[u] > 0.f ? am[u] * (1.f / 6.f) : 1.f, inv = am[u] > 0.f ? 6.f / am[u] : 0.f;
          unsigned q[2] = {0u, 0u};
#define TQ(i, j0, w, sel) q[w] = __builtin_amdgcn_cvt_scalef32_pk_fp4_f32(q[w], v[u][i][j0] * inv, v[u][i][j0 + 1] * inv, 1.0f, sel);
          TQ(0, 0, 0, 0) TQ(0, 2, 0, 1) TQ(1, 0, 0, 2) TQ(1, 2, 0, 3)
          TQ(2, 0, 1, 0) TQ(2, 2, 1, 1) TQ(3, 0, 1, 2) TQ(3, 2, 1, 3)
#undef TQ
          if (isv) {
            *(u32x2*)(ws + WS_V8 + (size_t)e * 512 + lane * 8) = (u32x2){q[0], q[1]};
            if (lane == 0) ((float*)(ws + WS_USV))[2 * e + 1] = scale;
          } else {
            *(u32x2*)(ws + WS_U8 + (size_t)e * 512 + lane * 8) = (u32x2){q[0], q[1]};
            if (lane == 0) ((float*)(ws + WS_USV))[2 * e] = scale;
          }
        }
      }
    }
  }
}

namespace pg8 {
typedef short sbf16x8 __attribute__((ext_vector_type(8)));
constexpr int BM = 256, BK = 64, HALF = 128, HTB = HALF * BK * 2  , NXCD = 8, WGM = 8;
__device__ __forceinline__ int lds_byte(int r, int c) { const int st = (r >> 4) * 2 + (c >> 5), rr = r & 15, cc = c & 31, ob = rr * 64 + cc * 2; return st * 1024 + (ob ^ (((ob >> 9) & 1) << 5)); }
__device__ __forceinline__ void stage_rc(int b, int& R, int& C) { const int st = b / 1024, sb = b % 1024, swz = sb ^ (((sb >> 9) & 1) << 5); R = (st >> 1) * 16 + swz / 64; C = (st & 1) * 32 + (swz % 64) / 2; }
__device__ __forceinline__ int perm32(int rho) { const int n = rho >> 4, i = rho & 15; return 8 * (i >> 2) + 4 * n + (i & 3); }
struct Unit { int pm, pn; };
struct Gemm { const bf16_t* A; const bf16_t* Bt; int M, N, K; };
struct StaticOrder {
    int nM, nN, nwg, G, c;
    __device__ void init(int M, int N, int G_, int c_) { nM = M / BM; nN = N / BM; nwg = nM * nN; G = G_; c = c_; }
    __device__ bool next(int i, Unit& u) const {
        const long L = (long)i * G + c; if (L >= nwg) return false;
        int wgid = (int)L; { const int q = nwg / NXCD, r = nwg % NXCD, xcd = wgid % NXCD, off = wgid / NXCD; wgid = (xcd < r ? xcd * (q + 1) : r * (q + 1) + (xcd - r) * q) + off; }
        const int nig = WGM * nN, gid = wgid / nig, fm = gid * WGM, gsz = (nM - fm) < WGM ? (nM - fm) : WGM;
        u.pm = fm + ((wgid % nig) % gsz); u.pn = (wgid % nig) / gsz; return true;
    }
};
template <class Epi>
__device__ __forceinline__ void gemm_phase(LAS unsigned char* lds, const Gemm g, const StaticOrder& S, const Epi& E) {
    const int tid = otid(), wid = __builtin_amdgcn_readfirstlane(tid >> 6), lane = tid & 63, wr = wid >> 2, wc = wid & 3, fr = lane & 15, fq = lane >> 4;
    const int K = g.K, nt = K / BK;
    unsigned voffA[2], voffB[2];
#pragma unroll
    for (int i = 0; i < 2; ++i) { int R, C; stage_rc(tid * 16 + i * 8192, R, C); const int Rb = Epi::PERM ? ((R & ~31) + perm32(R & 31)) : R;
        voffA[i] = (unsigned)(R * K + C) * 2u; voffB[i] = (unsigned)(Rb * K + C) * 2u; }
    const size_t kstep = (size_t)(BK * 2);
    const size_t hstep = (size_t)HALF * K * 2;
    const size_t tstep = 2 * hstep;
    const unsigned ldsw = (unsigned)wid * 1024u;
    const int aoff = lds_byte(wr * 64 + fr, fq * 8), boff = lds_byte(wc * 32 + fr, fq * 8);
#define PG8_SA(b, h) (((b) * 2 + (h)) * HTB)
#define PG8_SB(b, h) ((4 + (b) * 2 + (h)) * HTB)
#define PG8_STAGE(bufoff, gbase, voff) do { _Pragma("unroll") for (int _i = 0; _i < 2; ++_i) \
        __builtin_amdgcn_global_load_lds((const unsigned*)((const char*)(gbase) + (voff)[_i]), (LAS unsigned*)(lds + (bufoff) + ldsw + _i * 8192), 16, 0, 0); } while (0)
#define PG8_LDA(dst, b, h) do { _Pragma("unroll") for (int m = 0; m < 4; ++m) _Pragma("unroll") for (int k = 0; k < 2; ++k) dst[m][k] = *(const LAS sbf16x8*)(lds + PG8_SA(b, h) + aoff + m * 2048 + k * 1024); } while (0)
#define PG8_LDB(dst, b, h) do { _Pragma("unroll") for (int n = 0; n < 2; ++n) _Pragma("unroll") for (int k = 0; k < 2; ++k) dst[n][k] = *(const LAS sbf16x8*)(lds + PG8_SB(b, h) + boff + n * 2048 + k * 1024); } while (0)
#define PG8_MMA(ai, bj, At, Bt) do { __builtin_amdgcn_s_setprio(1); _Pragma("unroll") for (int m = 0; m < 4; ++m) _Pragma("unroll") for (int n = 0; n < 2; ++n) _Pragma("unroll") for (int k = 0; k < 2; ++k) \
        acc[ai][bj][m][n] = __builtin_amdgcn_mfma_f32_16x16x32_bf16(__builtin_bit_cast(bf16x8, Bt[n][k]), __builtin_bit_cast(bf16x8, At[m][k]), acc[ai][bj][m][n], 0, 0, 0); __builtin_amdgcn_s_setprio(0); } while (0)
#define PG8_WAIT_V(n) asm volatile("s_waitcnt vmcnt(" #n ")" ::: "memory")
#define PG8_WAIT_L(n) asm volatile("s_waitcnt lgkmcnt(" #n ")" ::: "memory")
#define PG8_BAR __builtin_amdgcn_s_barrier()
#define PG8_SCHED __builtin_amdgcn_sched_barrier(0)
    Unit cur, nxt; int ui = 0;
    if (!S.next(0, cur)) return;
    f32x4 acc[2][2][4][2];
#pragma unroll
    for (int a = 0; a < 2; ++a)
#pragma unroll
        for (int b = 0; b < 2; ++b)
#pragma unroll
            for (int m = 0; m < 4; ++m)
#pragma unroll
                for (int n = 0; n < 2; ++n) acc[a][b][m][n] = (f32x4){0.f, 0.f, 0.f, 0.f};
    sbf16x8 At[4][2], B0[2][2], B1[2][2];
    const char* cA = (const char*)g.A + (size_t)cur.pm * tstep; const char* cB = (const char*)g.Bt + (size_t)cur.pn * tstep;
    PG8_STAGE(PG8_SB(0, 0), cB, voffB); PG8_STAGE(PG8_SA(0, 0), cA, voffA); PG8_STAGE(PG8_SB(0, 1), cB + hstep, voffB); PG8_STAGE(PG8_SA(0, 1), cA + hstep, voffA);
    if (wr == 1) PG8_BAR;
    PG8_WAIT_V(4); PG8_BAR;
    PG8_STAGE(PG8_SB(1, 0), cB + kstep, voffB); PG8_STAGE(PG8_SA(1, 0), cA + kstep, voffA); PG8_STAGE(PG8_SB(1, 1), cB + hstep + kstep, voffB);
    PG8_WAIT_V(6); PG8_BAR;
    for (;;) {
        const bool has_next = S.next(ui + 1, nxt);
        const char* nA = has_next ? (const char*)g.A + (size_t)nxt.pm * tstep : cA; const char* nB = has_next ? (const char*)g.Bt + (size_t)nxt.pn * tstep : cB;
        for (int t = 0; t < nt; t += 2) {
            const bool last = (t == nt - 2);
            const char* a1 = cA + (size_t)(t + 1) * kstep;
            const char* a2 = last ? nA : cA + (size_t)(t + 2) * kstep; const char* b2 = last ? nB : cB + (size_t)(t + 2) * kstep;
            const char* a3 = a2 + kstep; const char* b3 = b2 + kstep;
            PG8_LDB(B0, 0, 0); PG8_SCHED; PG8_LDA(At, 0, 0); PG8_STAGE(PG8_SA(1, 1), a1 + hstep, voffA);
            PG8_WAIT_L(8); PG8_BAR; PG8_WAIT_L(0); PG8_MMA(0, 0, At, B0); PG8_BAR; PG8_SCHED;
            PG8_LDB(B1, 0, 1); PG8_STAGE(PG8_SB(0, 0), b2, voffB);
            PG8_BAR; PG8_WAIT_L(0); PG8_MMA(0, 1, At, B1); PG8_BAR;
            PG8_LDA(At, 0, 1); PG8_STAGE(PG8_SA(0, 0), a2, voffA);
            PG8_BAR; PG8_WAIT_L(0); PG8_MMA(1, 0, At, B0); PG8_BAR; PG8_SCHED;
            PG8_STAGE(PG8_SB(0, 1), b2 + hstep, voffB);
            PG8_WAIT_V(6); PG8_BAR; PG8_MMA(1, 1, At, B1); PG8_BAR;
            PG8_LDB(B0, 1, 0); PG8_SCHED; PG8_LDA(At, 1, 0); PG8_STAGE(PG8_SA(0, 1), a2 + hstep, voffA);
            PG8_WAIT_L(8); PG8_BAR; PG8_WAIT_L(0); PG8_MMA(0, 0, At, B0); PG8_BAR; PG8_SCHED;
            PG8_LDB(B1, 1, 1); PG8_STAGE(PG8_SB(1, 0), b3, voffB);
            PG8_BAR; PG8_WAIT_L(0); PG8_MMA(0, 1, At, B1); PG8_BAR;
            PG8_LDA(At, 1, 1); PG8_STAGE(PG8_SA(1, 0), a3, voffA);
            PG8_BAR; PG8_WAIT_L(0); PG8_MMA(1, 0, At, B0); PG8_BAR; PG8_SCHED;
            PG8_STAGE(PG8_SB(1, 1), b3 + hstep, voffB);
            PG8_WAIT_V(6); PG8_BAR; PG8_MMA(1, 1, At, B1); PG8_BAR;
        }
        E(acc, cur, wr, wc, fr, fq);
        if (!has_next) break;
#pragma unroll
        for (int a = 0; a < 2; ++a)
#pragma unroll
            for (int b = 0; b < 2; ++b)
#pragma unroll
                for (int m = 0; m < 4; ++m)
#pragma unroll
                    for (int n = 0; n < 2; ++n) acc[a][b][m][n] = (f32x4){0.f, 0.f, 0.f, 0.f};
        cur = nxt; cA = nA; cB = nB; ++ui;
    }
    PG8_WAIT_V(0);
    if (wr == 0) PG8_BAR;
    PG8_BAR;
#undef PG8_SA
#undef PG8_SB
#undef PG8_STAGE
#undef PG8_LDA
#undef PG8_LDB
#undef PG8_MMA
#undef PG8_WAIT_V
#undef PG8_WAIT_L
#undef PG8_BAR
#undef PG8_SCHED
}
}

struct EpiQKC {
  static constexpr bool PERM = true;
  const float* rs1; const float* qg; const float* kg; bf16_t* Q; bf16_t* Kk; bf16_t* HG;
  __device__ __forceinline__ void operator()(const f32x4 (&acc)[2][2][4][2], const pg8::Unit& u, int wr, int wc, int fr, int fq) const {
    const int row0 = u.pm * 256 + wr * 64 + fr;
    if (u.pn < 4) {
      const bool isq = u.pn < 2;
      const int head = 4 * (u.pn & 1) + wc;
      const float* g = isq ? qg : kg;
      f32x4 gv[2][2];
#pragma unroll
      for (int bj = 0; bj < 2; ++bj)
#pragma unroll
        for (int n = 0; n < 2; ++n) gv[bj][n] = *(const f32x4*)(g + 32 * bj + 8 * fq + 4 * n);
      bf16_t* base = isq ? Q : Kk;
#pragma unroll
      for (int ai = 0; ai < 2; ++ai)
#pragma unroll
        for (int m = 0; m < 4; ++m) {
          const int t = row0 + ai * 128 + m * 16;
          float ss = 0.f;
#pragma unroll
          for (int bj = 0; bj < 2; ++bj)
#pragma unroll
            for (int n = 0; n < 2; ++n) { const f32x4 v = acc[ai][bj][m][n]; ss += v.x * v.x + v.y * v.y + v.z * v.z + v.w * v.w; }
          ss += __shfl_xor(ss, 16);
          ss += __shfl_xor(ss, 32);
          const float r = rs1[t];
          float sc = r * rsqrtf(r * r * ss * (1.f / 64.f) + EPS);
          if (isq) sc *= 0.125f * LOG2E;
          const size_t bh = (size_t)((t >> 12) * 8 + head);
          const int pos = t & 4095;
          bf16_t* dst = isq ? base + (bh * 4096 + pos) * 64 + 8 * fq
                            : base + (bh * 4096 + (pos & ~31)) * 64 + ((((fq >> 1) * 2 + (fq & 1)) * 32) + (pos & 31)) * 8;
#pragma unroll
          for (int bj = 0; bj < 2; ++bj) {
            const f32x4 a = acc[ai][bj][m][0] * gv[bj][0] * sc, b = acc[ai][bj][m][1] * gv[bj][1] * sc;
            *(u32x4*)(dst + (isq ? 32 * bj : 1024 * bj)) = (u32x4){pk2(a.x, a.y), pk2(a.z, a.w), pk2(b.x, b.y), pk2(b.z, b.w)};
          }
        }
    } else {
      const int ch0 = 128 * (u.pn - 4) + 32 * wc + 8 * fq;
#pragma unroll
      for (int ai = 0; ai < 2; ++ai)
#pragma unroll
        for (int m = 0; m < 4; ++m) {
          const int t = row0 + ai * 128 + m * 16;
          const float r = rs1[t];
          float h[8];
#pragma unroll
          for (int n = 0; n < 2; ++n)
#pragma unroll
            for (int j = 0; j < 4; ++j) h[4 * n + j] = acc[ai][0][m][n][j] * r * __builtin_amdgcn_rcpf(1.f + __expf(-acc[ai][1][m][n][j] * r));
          *(u32x4*)(HG + (size_t)t * 512 + ch0) = (u32x4){pk2(h[0], h[1]), pk2(h[2], h[3]), pk2(h[4], h[5]), pk2(h[6], h[7])};
        }
    }
  }
};
struct EpiVt {
  static constexpr bool PERM = false;
  const float* rs1; bf16_t* Vt;
  __device__ __forceinline__ void operator()(const f32x4 (&acc)[2][2][4][2], const pg8::Unit& u, int wr, int wc, int fr, int fq) const {
    const int pos0 = 8 * (fq & 1) + 4 * (fq >> 1);
#pragma unroll
    for (int bj = 0; bj < 2; ++bj)
#pragma unroll
      for (int n = 0; n < 2; ++n) {
        const int t = u.pn * 256 + bj * 128 + wc * 32 + n * 16 + 4 * fq;
        const f32x4 r = *(const f32x4*)(rs1 + t);
        const size_t tb = ((size_t)(t >> 12) * 8) * 128 + ((t & 4095) >> 5);
#pragma unroll
        for (int ai = 0; ai < 2; ++ai)
#pragma unroll
          for (int m = 0; m < 4; ++m) {
            const int dg = u.pm * 256 + ai * 128 + wr * 64 + m * 16 + fr, head = dg >> 6, d = dg & 63;
            const f32x4 v = acc[ai][bj][m][n] * r;
            *(u32x2*)(Vt + (tb + (size_t)head * 128) * 2048 + (((((d >> 5) * 2 + n) * 2 + (fq & 1)) * 32) + (d & 31)) * 8 + 4 * (fq >> 1)) = (u32x2){pk2(v.x, v.y), pk2(v.z, v.w)};
          }
      }
  }
};
struct EpiOut {
  static constexpr bool PERM = true;
  const bf16_t* xb; bf16_t* HB; float* ssq2;
  __device__ __forceinline__ void operator()(const f32x4 (&acc)[2][2][4][2], const pg8::Unit& u, int wr, int wc, int fr, int fq) const {
    const int row0 = u.pm * 256 + wr * 64 + fr, col0 = u.pn * 256 + wc * 32 + 8 * fq;
#pragma unroll
    for (int ai = 0; ai < 2; ++ai)
#pragma unroll
      for (int m = 0; m < 4; ++m) {
        const int t = row0 + ai * 128 + m * 16;
        const size_t ro = (size_t)t * 1024 + col0;
        float ss = 0.f;
#pragma unroll
        for (int bj = 0; bj < 2; ++bj) {
          const size_t o = ro + bj * 128;
          const u32x4 xv = *(const u32x4*)(xb + o);
          const f32x4 h0 = (f32x4){bflo(xv.x), bfhi(xv.x), bflo(xv.y), bfhi(xv.y)} + acc[ai][bj][m][0];
          const f32x4 h1 = (f32x4){bflo(xv.z), bfhi(xv.z), bflo(xv.w), bfhi(xv.w)} + acc[ai][bj][m][1];
          *(u32x4*)(HB + o) = (u32x4){pk2(h0.x, h0.y), pk2(h0.z, h0.w), pk2(h1.x, h1.y), pk2(h1.z, h1.w)};
          ss += (h0.x * h0.x + h0.y * h0.y + h0.z * h0.z + h0.w * h0.w) + (h1.x * h1.x + h1.y * h1.y + h1.z * h1.z + h1.w * h1.w);
        }
        ss += __shfl_xor(ss, 16);
        ss += __shfl_xor(ss, 32);
        if (fq == 0) atomicAdd(ssq2 + t, ss);
      }
  }
};
struct EpiQh {
  static constexpr bool PERM = true;
  const float* ssq2; bf16_t* QH;
  __device__ __forceinline__ void operator()(const f32x4 (&acc)[2][2][4][2], const pg8::Unit& u, int wr, int wc, int fr, int fq) const {
    const int row0 = u.pm * 256 + wr * 64 + fr, col0 = u.pn * 256 + wc * 32 + 8 * fq;
#pragma unroll
    for (int ai = 0; ai < 2; ++ai)
#pragma unroll
      for (int m = 0; m < 4; ++m) {
        const int t = row0 + ai * 128 + m * 16;
        const float r = rsqrtf(ssq2[t] * (1.f / 1024.f) + EPS);
#pragma unroll
        for (int bj = 0; bj < 2; ++bj) {
          const f32x4 a = acc[ai][bj][m][0] * r, b = acc[ai][bj][m][1] * r;
          *(u32x4*)(QH + (size_t)t * 1024 + col0 + bj * 128) = (u32x4){pk2(a.x, a.y), pk2(a.z, a.w), pk2(b.x, b.y), pk2(b.z, b.w)};
        }
      }
  }
};

__device__ void phase_inproj(const Params& p, char* smem) {
  unsigned char* ws = p.ws;
  LAS unsigned char* lds = (LAS unsigned char*)smem;
  const bf16_t* XB = (const bf16_t*)(ws + WS_XB);
  const float* RS1 = (const float*)(ws + WS_RS1);
  pg8::StaticOrder S;
  {
    pg8::Gemm g{XB, (const bf16_t*)(ws + WS_W1), T, 2048, 1024};
    S.init(T, 2048, gridDim.x, blockIdx.x);
    EpiQKC E{RS1, p.q_norm_g, p.k_norm_g, (bf16_t*)(ws + WS_Q), (bf16_t*)(ws + WS_K), (bf16_t*)(ws + WS_HG)};
    pg8::gemm_phase<EpiQKC>(lds, g, S, E);
  }
  {
    pg8::Gemm g{(const bf16_t*)(ws + WS_WV), XB, 512, T, 1024};
    S.init(512, T, gridDim.x, blockIdx.x);
    EpiVt E{RS1, (bf16_t*)(ws + WS_VT)};
    pg8::gemm_phase<EpiVt>(lds, g, S, E);
  }
}
__device__ void phase_outproj(const Params& p, char* smem) {
  unsigned char* ws = p.ws;
  pg8::Gemm g{(const bf16_t*)(ws + WS_MIX), (const bf16_t*)(ws + WS_WOUT), T, 1024, 1024};
  pg8::StaticOrder S;
  S.init(T, 1024, gridDim.x, blockIdx.x);
  EpiOut E{(const bf16_t*)(ws + WS_XB), (bf16_t*)(ws + WS_HB), (float*)(ws + WS_SSQ2)};
  pg8::gemm_phase<EpiOut>((LAS unsigned char*)smem, g, S, E);
}
__device__ void phase_qproj(const Params& p, char* smem) {
  unsigned char* ws = p.ws;
  pg8::Gemm g{(const bf16_t*)(ws + WS_HB), (const bf16_t*)(ws + WS_WQ), T, 1024, 1024};
  pg8::StaticOrder S;
  S.init(T, 1024, gridDim.x, blockIdx.x);
  EpiQh E{(const float*)(ws + WS_SSQ2), (bf16_t*)(ws + WS_QH)};
  pg8::gemm_phase<EpiQh>((LAS unsigned char*)smem, g, S, E);
}

__device__ __forceinline__ void conv_stage(const bf16_t* HG, int item, LAS unsigned char* buf, int wave, int lane) {
  const int t0 = item * 32, s0 = t0 & 4095;
#pragma unroll
  for (int j = 0; j < 8; ++j) {
    const int r = wave + 8 * j;
    if (r < 62) {
      if (s0 - 30 + r >= 0)
        __builtin_amdgcn_global_load_lds((const unsigned*)(HG + (size_t)(t0 - 30 + r) * 512 + lane * 8), (LAS unsigned*)(buf + r * 1024), 16, 0, 0);
      else
        *(LAS u32x4*)(buf + r * 1024 + lane * 16) = (u32x4){0u, 0u, 0u, 0u};
    }
  }
}
struct ConvW { f32x2 wv[31]; float2 cb, lg, lb; };
__device__ __forceinline__ void conv_compute(const Params& p, int item, const char* smem, const ConvW& W, int tid512) {
  bf16_t* MIX = (bf16_t*)(p.ws + WS_MIX);
  const int half = tid512 >> 8, tid = tid512 & 255, lane = tid & 63, wave = tid >> 6;
  const int t0 = item * 32;
  float* red = (float*)(smem + 62 * 1024) + half * 128;
  const bool b5 = lane & 32, b4 = lane & 16, b3 = lane & 8, b2 = lane & 4;
#pragma unroll 1
  for (int rd = 0; rd < 2; ++rd) {
    const int tb = 16 * half + 8 * rd;
    f32x2 xv[38];
#pragma unroll
    for (int r = 0; r < 38; ++r) {
      const unsigned v = *(const unsigned*)(smem + (tb + r) * 1024 + tid * 4);
      xv[r] = (f32x2){bflo(v), bfhi(v)};
    }
    float a0[8], a1[8], st[16];
#pragma unroll
    for (int k = 0; k < 8; ++k) {
      f32x2 u = {W.cb.x, W.cb.y};
#pragma unroll
      for (int j = 0; j < 31; ++j) u = __builtin_elementwise_fma(W.wv[j], xv[k + j], u);
      a0[k] = u.x; a1[k] = u.y;
      st[k] = u.x + u.y;
      st[8 + k] = u.x * u.x + u.y * u.y;
    }
    float r8[8], r4[4], r2[2], r1;
#pragma unroll
    for (int i = 0; i < 8; ++i) { const float keep = b5 ? st[8 + i] : st[i], send = b5 ? st[i] : st[8 + i]; r8[i] = keep + __shfl_xor(send, 32); }
#pragma unroll
    for (int i = 0; i < 4; ++i) { const float keep = b4 ? r8[4 + i] : r8[i], send = b4 ? r8[i] : r8[4 + i]; r4[i] = keep + __shfl_xor(send, 16); }
#pragma unroll
    for (int i = 0; i < 2; ++i) { const float keep = b3 ? r4[2 + i] : r4[i], send = b3 ? r4[i] : r4[2 + i]; r2[i] = keep + __shfl_xor(send, 8); }
    { const float keep = b2 ? r2[1] : r2[0], send = b2 ? r2[0] : r2[1]; r1 = keep + __shfl_xor(send, 4); }
    r1 += __shfl_xor(r1, 2);
    r1 += __shfl_xor(r1, 1);
    float* rr = red + rd * 64;
    if ((lane & 3) == 0) rr[wave * 16 + (lane >> 2)] = r1;
    __syncthreads();
#pragma unroll
    for (int k = 0; k < 8; ++k) {
      const float S1 = (rr[k] + rr[16 + k]) + (rr[32 + k] + rr[48 + k]);
      const float S2 = (rr[8 + k] + rr[24 + k]) + (rr[40 + k] + rr[56 + k]);
      const float mu = S1 * (1.f / 512.f);
      const float var = fmaxf(S2 * (1.f / 512.f) - mu * mu, 0.f);
      const float rstd = rsqrtf(var + EPS);
      const float y0 = (a0[k] - mu) * rstd * W.lg.x + W.lb.x, y1 = (a1[k] - mu) * rstd * W.lg.y + W.lb.y;
      const float z0 = y0 * __builtin_amdgcn_rcpf(1.f + __expf(-y0)), z1 = y1 * __builtin_amdgcn_rcpf(1.f + __expf(-y1));
      *(unsigned*)(MIX + (size_t)(t0 + tb + k) * 1024 + 512 + 2 * tid) = pk2(z0, z1);
    }
  }
}
__device__ void conv_items(const Params& p, char* smem) {
  const bf16_t* HG = (const bf16_t*)(p.ws + WS_HG);
  const int tid512 = otid(), tid = tid512 & 255, lane = tid512 & 63;
  const int wave = __builtin_amdgcn_readfirstlane(tid512 >> 6);
  const int vb = vblock(), G = gridDim.x;
  ConvW W;
#pragma unroll
  for (int j = 0; j < 31; ++j) {
    const float2 w = *(const float2*)(p.conv_w + j * 512 + 2 * tid);
    W.wv[j] = (f32x2){w.x, w.y};
  }
  W.cb = *(const float2*)(p.conv_b + 2 * tid);
  W.lg = *(const float2*)(p.conv_ln_g + 2 * tid);
  W.lb = *(const float2*)(p.conv_ln_b + 2 * tid);
  int b = 0;
  if (vb < 1024) conv_stage(HG, vb, (LAS unsigned char*)smem, wave, lane);
  for (int item = vb; item < 1024; item += G, b ^= 1) {
    asm volatile("s_waitcnt vmcnt(0) lgkmcnt(0)" ::: "memory");
    __syncthreads();
    if (item + G < 1024) conv_stage(HG, item + G, (LAS unsigned char*)smem + (b ^ 1) * 65536, wave, lane);
    conv_compute(p, item, smem + b * 65536, W, tid512);
  }
  __syncthreads();
}

struct AttnKV { bf16x8 k[4]; bf16x8 v[2][2]; };
__device__ __forceinline__ void attn_load(const bf16_t* Km, const bf16_t* Vt, int bh, int kb, int tok, int hf, AttnKV& f) {
  const int kc = kb < 0 ? 0 : kb;
  const bf16_t* kp = Km + ((size_t)bh * 128 + kc) * 2048 + (hf * 32 + tok) * 8;
#pragma unroll
  for (int ks = 0; ks < 4; ++ks) f.k[ks] = *(const bf16x8*)(kp + ks * 512);
  const bf16_t* vp = Vt + ((size_t)bh * 128 + kc) * 2048 + (hf * 32 + tok) * 8;
#pragma unroll
  for (int m = 0; m < 2; ++m)
#pragma unroll
    for (int s = 0; s < 2; ++s) f.v[m][s] = *(const bf16x8*)(vp + (m * 2 + s) * 512);
}
__device__ __forceinline__ bool attn_block(const AttnKV& f, const bf16x8 (&qf)[4], bool diag, int tok, int hf, float& c, f32x16& o0, f32x16& o1) {
  f32x16 sc;
#pragma unroll
  for (int i = 0; i < 16; ++i) sc[i] = 0.f;
#pragma unroll
  for (int ks = 0; ks < 4; ++ks) sc = mfma32(f.k[ks], qf[ks], sc);
  float kp[16], sg[16];
#pragma unroll
  for (int i = 0; i < 16; ++i) {
    const float e = __builtin_amdgcn_exp2f(fminf(sc[i], 80.f));
    const float r = __builtin_amdgcn_rcpf(1.f + e);
    kp[i] = r;
    sg[i] = e * r;
  }
  if (diag) {
#pragma unroll
    for (int i = 0; i < 16; ++i) {
      const bool valid = ((i & 3) + 8 * (i >> 2) + 4 * hf < tok);
      kp[i] = valid ? kp[i] : 1.f;
      sg[i] = valid ? sg[i] : 0.f;
    }
  }
  float Tg[4], Pg[4];
#pragma unroll
  for (int g = 0; g < 4; ++g) {
    Tg[g] = (kp[4 * g] * kp[4 * g + 1]) * (kp[4 * g + 2] * kp[4 * g + 3]);
    Pg[g] = __shfl_xor(Tg[g], 32);
  }
  float base[4];
  float run = __builtin_amdgcn_exp2f(c);
#pragma unroll
  for (int g = 3; g >= 0; --g) {
    base[g] = run * (hf == 0 ? Pg[g] : 1.f);
    run *= Tg[g] * Pg[g];
  }
  float pr[16];
#pragma unroll
  for (int g = 0; g < 4; ++g) {
    float l = base[g];
#pragma unroll
    for (int r = 3; r >= 0; --r) {
      pr[4 * g + r] = sg[4 * g + r] * l;
      l *= kp[4 * g + r];
    }
  }
  c = __builtin_amdgcn_logf(run);
  bf16x8 pf[2];
#pragma unroll
  for (int s = 0; s < 2; ++s)
#pragma unroll
    for (int j = 0; j < 8; ++j) pf[s][j] = (__bf16)pr[8 * s + j];
#pragma unroll
  for (int s = 0; s < 2; ++s) {
    o0 = mfma32(f.v[0][s], pf[s], o0);
    o1 = mfma32(f.v[1][s], pf[s], o1);
  }
  return __all(c < -150.f);
}
__device__ void attn_tile(const Params& p, int item, int it, int lane, int wave, char* smem) {
  unsigned char* ws = p.ws;
  const bf16_t* Qm = (const bf16_t*)(ws + WS_Q);
  const bf16_t* Km = (const bf16_t*)(ws + WS_K);
  const bf16_t* Vt = (const bf16_t*)(ws + WS_VT);
  bf16_t* MIX = (bf16_t*)(ws + WS_MIX);
  const int qt = item & 127, bh = (item >> 7) * 8 + wave;
  const int tok = lane & 31, hf = lane >> 5;
  bf16x8 qf[4];
  {
    const bf16_t* qp = Qm + ((size_t)bh * 4096 + qt * 32 + tok) * 64 + 8 * hf;
#pragma unroll
    for (int ks = 0; ks < 4; ++ks) qf[ks] = *(const bf16x8*)(qp + ks * 16);
  }
  f32x16 o0, o1;
#pragma unroll
  for (int i = 0; i < 16; ++i) { o0[i] = 0.f; o1[i] = 0.f; }
  float c = 0.f;
  AttnKV fa, fb;
  attn_load(Km, Vt, bh, qt, tok, hf, fa);
  {
    unsigned z = __builtin_bit_cast(u32x4, fa.v[1][1]).w | __builtin_bit_cast(u32x4, fa.k[3]).w | __builtin_bit_cast(u32x4, qf[3]).w;
    asm volatile("" ::"v"(z));
  }
  for (int kb = qt;; kb -= 2) {
    attn_load(Km, Vt, bh, kb - 1, tok, hf, fb);
    __builtin_amdgcn_sched_barrier(0);
    if (attn_block(fa, qf, kb == qt, tok, hf, c, o0, o1) || kb == 0) break;
    attn_load(Km, Vt, bh, kb - 2, tok, hf, fa);
    __builtin_amdgcn_sched_barrier(0);
    if (attn_block(fb, qf, false, tok, hf, c, o0, o1) || kb == 1) break;
  }
  float ssq = 0.f;
#pragma unroll
  for (int i = 0; i < 16; ++i) ssq += o0[i] * o0[i] + o1[i] * o1[i];
  ssq += __shfl_xor(ssq, 32);
  float* xch = (float*)(smem + 100 * 1024) + (it & 1) * 256;
  if (hf == 0) xch[wave * 32 + tok] = ssq;
  __syncthreads();
  float tot = 0.f;
#pragma unroll
  for (int w = 0; w < NWAVES; ++w) tot += xch[w * 32 + tok];
  const float rs = rsqrtf(tot * (1.f / 512.f) + EPS);
  const int t = (bh >> 3) * 4096 + qt * 32 + tok, hh = bh & 7;
  bf16_t* dst = MIX + (size_t)t * 1024 + hh * 64 + 4 * hf;
#pragma unroll
  for (int g = 0; g < 4; ++g) {
    *(u32x2*)(dst + 8 * g) = (u32x2){pk2(o0[4 * g] * rs, o0[4 * g + 1] * rs), pk2(o0[4 * g + 2] * rs, o0[4 * g + 3] * rs)};
    *(u32x2*)(dst + 32 + 8 * g) = (u32x2){pk2(o1[4 * g] * rs, o1[4 * g + 1] * rs), pk2(o1[4 * g + 2] * rs, o1[4 * g + 3] * rs)};
  }
}

__device__ void phase_mix(const Params& p, char* smem) {
  static_assert(NWAVES == 8, "one wave per attention head");
  const int vb = vblock(), G = gridDim.x;
  if (blockIdx.x & 1) prep_tables(p);
  conv_items(p, smem);
  const int tidm = otid();
  const int lane = tidm & 63, wave = tidm >> 6;
  int it = 0;
  for (int item = vb; item < 1024; item += G, ++it) attn_tile(p, item, it, lane, wave, smem);
  if (!(blockIdx.x & 1)) prep_tables(p);
}
__device__ __forceinline__ unsigned f2key(float f, unsigned n) {
  const unsigned u = (__float_as_uint(f) & ~0x7Fu) | n;
  return u ^ ((unsigned)((int)u >> 31) | 0x80000000u);
}
__device__ __forceinline__ unsigned f2key_raw(float f) {
  const unsigned u = __float_as_uint(f);
  return u ^ ((unsigned)((int)u >> 31) | 0x80000000u);
}
__device__ __forceinline__ unsigned key2u(unsigned k) { return k ^ ((k >> 31) ? 0x80000000u : 0xFFFFFFFFu); }

template <int N>
__device__ __forceinline__ void bitonic_sort_desc(unsigned (&v)[N]) {
#pragma unroll
  for (int k = 2; k <= N; k <<= 1) {
#pragma unroll
    for (int j = k >> 1; j > 0; j >>= 1) {
#pragma unroll
      for (int i = 0; i < N; ++i) {
        const int l = i ^ j;
        if (l > i) {
          const bool desc = ((i & k) == 0);
          const unsigned mx = max(v[i], v[l]), mn = min(v[i], v[l]);
          v[i] = desc ? mx : mn;
          v[l] = desc ? mn : mx;
        }
      }
    }
  }
}
template <int N>
__device__ __forceinline__ void bitonic_merge_desc(unsigned (&v)[N]) {
#pragma unroll
  for (int j = N >> 1; j > 0; j >>= 1) {
#pragma unroll
    for (int i = 0; i < N; ++i) {
      const int l = i ^ j;
      if (l > i) {
        const unsigned mx = max(v[i], v[l]), mn = min(v[i], v[l]);
        v[i] = mx;
        v[l] = mn;
      }
    }
  }
}
__device__ __forceinline__ void merge_top16(unsigned (&a)[16], const unsigned (&b)[16]) {
#pragma unroll
  for (int i = 0; i < 16; ++i) a[i] = max(a[i], b[15 - i]);
  bitonic_merge_desc<16>(a);
}
#define CEP(ka, pa, kb, pb, desc)                                  \
  {                                                                \
    const bool sw_ = (desc) ? ((kb) > (ka)) : ((kb) < (ka));       \
    const unsigned tk_ = sw_ ? (kb) : (ka), tl_ = sw_ ? (ka) : (kb); \
    const unsigned tp_ = sw_ ? (pb) : (pa), tq_ = sw_ ? (pa) : (pb); \
    ka = tk_; kb = tl_; pa = tp_; pb = tq_;                        \
  }
template <int N>
__device__ __forceinline__ void bitonic_sort_desc_p(unsigned (&v)[N], unsigned (&pl)[N]) {
#pragma unroll
  for (int k = 2; k <= N; k <<= 1) {
#pragma unroll
    for (int j = k >> 1; j > 0; j >>= 1) {
#pragma unroll
      for (int i = 0; i < N; ++i) {
        const int l = i ^ j;
        if (l > i) {
          const bool desc = ((i & k) == 0);
          CEP(v[i], pl[i], v[l], pl[l], desc);
        }
      }
    }
  }
}
template <int N>
__device__ __forceinline__ void bitonic_merge_desc_p(unsigned (&v)[N], unsigned (&pl)[N]) {
#pragma unroll
  for (int j = N >> 1; j > 0; j >>= 1) {
#pragma unroll
    for (int i = 0; i < N; ++i) {
      const int l = i ^ j;
      if (l > i) { CEP(v[i], pl[i], v[l], pl[l], true); }
    }
  }
}
__device__ __forceinline__ void merge_top16_p(unsigned (&a)[16], unsigned (&pa)[16], const unsigned (&b)[16], const unsigned (&pb)[16]) {
#pragma unroll
  for (int i = 0; i < 16; ++i) {
    const bool s = b[15 - i] > a[i];
    a[i] = s ? b[15 - i] : a[i];
    pa[i] = s ? pb[15 - i] : pa[i];
  }
  bitonic_merge_desc_p<16>(a, pa);
}

constexpr int KROW = 144;
__device__ __forceinline__ void subkey_top16(const LAS unsigned char* Kl, const bf16_t* __restrict__ qrow, int lane, unsigned (&top)[16]) {
  const int tok = lane & 31, hf = lane >> 5;
  f32x16 acc[4];
#pragma unroll
  for (int m = 0; m < 4; ++m)
#pragma unroll
    for (int i = 0; i < 16; ++i) acc[m][i] = 0.f;
  bf16x8 bq[4];
#pragma unroll
  for (int ks = 0; ks < 4; ++ks) bq[ks] = *(const bf16x8*)(qrow + ks * 16 + 8 * hf);
#pragma unroll 1
  for (int ks = 0; ks < 4; ++ks) {
#pragma unroll
    for (int m = 0; m < 4; ++m) {
      const bf16x8 ak = *(const LAS bf16x8*)(Kl + (m * 32 + tok) * KROW + ks * 32 + hf * 16);
      acc[m] = mfma32(ak, ks == 0 ? bq[0] : ks == 1 ? bq[1] : ks == 2 ? bq[2] : bq[3], acc[m]);
    }
  }
  unsigned g[4][16];
#pragma unroll
  for (int m = 0; m < 4; ++m) {
#pragma unroll
    for (int i = 0; i < 16; ++i) g[m][i] = f2key(acc[m][i], (unsigned)(m * 32 + (i & 3) + 8 * (i >> 2) + 4 * hf));
    bitonic_sort_desc<16>(g[m]);
  }
  merge_top16(g[0], g[1]);
  merge_top16(g[2], g[3]);
  merge_top16(g[0], g[2]);
  unsigned o[16];
#pragma unroll
  for (int i = 0; i < 16; ++i) o[i] = __shfl_xor(g[0][i], 32);
  merge_top16(g[0], o);
#pragma unroll
  for (int i = 0; i < 16; ++i) top[i] = g[0][i];
}

__device__ void phase_route(const Params& p, char* smem) {
  unsigned char* ws = p.ws;
  const bf16_t* K1 = (const bf16_t*)(ws + WS_K1);
  const bf16_t* K2 = (const bf16_t*)(ws + WS_K2);
  const bf16_t* QH = (const bf16_t*)(ws + WS_QH);
  const bf16_t* HB = (const bf16_t*)(ws + WS_HB);
  unsigned char* XN8 = ws + WS_XN8;
  const float* SSQ2 = (const float*)(ws + WS_SSQ2);
  unsigned* PIDX = (unsigned*)(ws + WS_PIDX);
  float* PG = (float*)(ws + WS_PG);
  const int tidr = otid();
  const int lane = tidr & 63, wave = tidr >> 6, gw = vblock() * NWAVES + wave, nw = gridDim.x * NWAVES;
  const int G = gridDim.x, nh = (G % 8 == 0) ? 8 : 1;
  LAS unsigned char* K1l = (LAS unsigned char*)smem;
  LAS unsigned char* K2l = K1l + 128 * KROW;
  for (int hd = blockIdx.x % nh; hd < 8; hd += nh) {
    for (int idx = tidr; idx < 2048; idx += NTHREADS) {
      const int tb = idx >> 10, row = (idx >> 3) & 127, ch = idx & 7;
      const u32x4 v = *(const u32x4*)((tb ? K2 : K1) + hd * 8192 + row * 64 + ch * 8);
      *(LAS u32x4*)((tb ? K2l : K1l) + row * KROW + ch * 16) = v;
    }
    __syncthreads();
    for (int tile = (blockIdx.x / nh) * NWAVES + wave; tile < T / 32; tile += (G / nh) * NWAVES) {
      const int t0 = tile * 32;
      const int tok = lane & 31, hf = lane >> 5;
      const bf16_t* qrow = QH + (size_t)(t0 + tok) * 1024 + hd * 128;
      unsigned top1[16], top2[16];
      subkey_top16(K1l, qrow, lane, top1);
      subkey_top16(K2l, qrow + 64, lane, top2);
      float fa[16], fb[16];
      unsigned ia[16], ib[16];
#pragma unroll
      for (int i = 0; i < 16; ++i) {
        const unsigned ua = key2u(hf ? top2[i] : top1[i]), ub = key2u(hf ? top1[i] : top2[i]);
        fa[i] = __uint_as_float(ua); ia[i] = ua & 0x7Fu;
        fb[i] = __uint_as_float(ub); ib[i] = ub & 0x7Fu;
      }
      unsigned ck[32];
      {
        int n = 0;
#pragma unroll
        for (int i = 0; i < 4; ++i) {
#pragma unroll
          for (int j = i; j < 16; ++j) {
            if ((i + 1) * (j + 1) <= 16) {
              unsigned key = (f2key_raw(fa[i] + fb[j]) & ~0x3FFFu) | (hf ? ((ib[j] << 7) | ia[i]) : ((ia[i] << 7) | ib[j]));
              if (i == j && hf) key = 0u;
              ck[n] = key;
              ++n;
            }
          }
        }
#pragma unroll
        for (; n < 32; ++n) ck[n] = 0u;
      }
      unsigned k0[16], k1[16];
#pragma unroll
      for (int i = 0; i < 16; ++i) { k0[i] = ck[i]; k1[i] = ck[16 + i]; }
      bitonic_sort_desc<16>(k0);
      bitonic_sort_desc<16>(k1);
      merge_top16(k0, k1);
#pragma unroll
      for (int i = 0; i < 16; ++i) k1[i] = __shfl_xor(k0[i], 32);
      merge_top16(k0, k1);
      float sv[16], sum = 0.f;
      const float mx = __uint_as_float(key2u(k0[0] & ~0x3FFFu));
#pragma unroll
      for (int i = 0; i < 16; ++i) {
        sv[i] = __builtin_amdgcn_exp2f((__uint_as_float(key2u(k0[i] & ~0x3FFFu)) - mx) * LOG2E);
        sum += sv[i];
      }
      const float inv = 1.f / sum;
      const size_t po = ((size_t)(t0 + tok) * 8 + hd) * 16;
      if (hf == 0) {
#pragma unroll
        for (int q = 0; q < 4; ++q) *(u32x4*)(PIDX + po + 4 * q) = (u32x4){k0[4 * q] & 0x3FFFu, k0[4 * q + 1] & 0x3FFFu, k0[4 * q + 2] & 0x3FFFu, k0[4 * q + 3] & 0x3FFFu};
      } else {
#pragma unroll
        for (int q = 0; q < 4; ++q) *(f32x4*)(PG + po + 4 * q) = (f32x4){sv[4 * q] * inv, sv[4 * q + 1] * inv, sv[4 * q + 2] * inv, sv[4 * q + 3] * inv};
      }
    }
    __syncthreads();
  }
}

typedef int i32x8 __attribute__((ext_vector_type(8)));
__device__ __forceinline__ f32x4 mfma_fp4_fp8(u32x4 a, u32x4 b0, u32x4 b1, f32x4 c) {
  const i32x8 A = {(int)a.x, (int)a.y, (int)a.z, (int)a.w, 0, 0, 0, 0};
  const i32x8 B = {(int)b0.x, (int)b0.y, (int)b0.z, (int)b0.w, (int)b1.x, (int)b1.y, (int)b1.z, (int)b1.w};
  return __builtin_amdgcn_mfma_scale_f32_16x16x128_f8f6f4(A, B, c, 4, 0, 0, 0x7F7F7F7F, 0, 0x7F7F7F7F);
}
struct PeCtx {
  const unsigned char* U8; const float2* USV; LAS float* glist;
  LAS unsigned* list; int lane, r, g, s, n, t0;
};
__device__ __forceinline__ void pe_rows(const PeCtx& c, int ci, u32x4 (&a)[8]) {
  const int idx = ci * 16 + (c.lane >> 2);
  const unsigned ent = c.list[idx & 2047];
  const unsigned e = (idx < c.n) ? ((ent >> 7) & 16383u) : (unsigned)(c.s << 11);
  const unsigned char* rp = c.U8 + (size_t)e * 512 + (c.lane & 3) * 16;
#pragma unroll
  for (int ks = 0; ks < 8; ++ks) a[ks] = *(const u32x4*)(rp + ks * 64);
}
__device__ __forceinline__ void pe_fix(const PeCtx& c, u32x4 (&a)[8]) {
  const int src = 4 * c.r + c.g;
#pragma unroll
  for (int ks = 0; ks < 8; ++ks) {
    a[ks].x = (unsigned)__shfl((int)a[ks].x, src); a[ks].y = (unsigned)__shfl((int)a[ks].y, src);
    a[ks].z = (unsigned)__shfl((int)a[ks].z, src); a[ks].w = (unsigned)__shfl((int)a[ks].w, src);
  }
}
__device__ __forceinline__ void pe_chunk(const PeCtx& c, int ci, u32x4 (&a)[8], u32x4 (&anext)[8], const u32x4 (&bq)[16]) {
  const int idx = ci * 16 + c.r;
  const unsigned ent = c.list[idx & 2047];
  const bool fin = (c.lane < 16) && (idx < c.n);
  const unsigned e = (ent >> 7) & 16383u, col = (ent >> 21) & 15u;
  const float2 usv = c.USV[fin ? e : 0u];
  const float gt = c.glist[idx & 2047], us = usv.x, vs = usv.y;
  __builtin_amdgcn_sched_barrier(0);
  pe_rows(c, ci + 1, anext);
  __builtin_amdgcn_sched_barrier(0);
  pe_fix(c, a);
  f32x4 acc = {0.f, 0.f, 0.f, 0.f};
#pragma unroll
  for (int ks = 0; ks < 8; ++ks) acc = mfma_fp4_fp8(a[ks], bq[2 * ks], bq[2 * ks + 1], acc);
  const int src = ((c.r >> 2) << 4) | (int)col;
  const float v0 = __shfl(acc[0], src), v1 = __shfl(acc[1], src), v2 = __shfl(acc[2], src), v3 = __shfl(acc[3], src);
  float d = ((c.r & 3) == 0) ? v0 : ((c.r & 3) == 1) ? v1 : ((c.r & 3) == 2) ? v2 : v3;
  float gt_ = gt, us_ = us, vs_ = vs;
  asm volatile("" : "+v"(d), "+v"(gt_), "+v"(us_), "+v"(vs_));
  {
    const float act = d * us_ * (1.f / 16.f);
    const float w = gt_ * 0.5f * act * (1.f + erff(act * 0.70710678118654752f)) * vs_;
    if (fin) c.glist[idx & 2047] = w;
  }
}
#define PFV_LOAD(R, ev, k0)                                                                               \
  {                                                                                                       \
    _Pragma("unroll") for (int i_ = 0; i_ < 8; ++i_) {                                                    \
      const unsigned e_ = (unsigned)__builtin_amdgcn_ds_bpermute(bsel + 4 * ((k0) + 2 * i_), (int)(ev)); \
      R[i_] = *(const u32x4*)(V4 + (e_ << 9));                                                            \
    }                                                                                                     \
  }
#define PFV_FMA(dw, b, a) acc[a] = __builtin_elementwise_fma(__builtin_amdgcn_cvt_scalef32_pk_f32_fp4(dw, 1.0f, b), w2_, acc[a]);
#define PFV_ACC(R, wv, k0)                                                                                \
  {                                                                                                       \
    _Pragma("unroll") for (int i_ = 0; i_ < 8; ++i_) {                                                    \
      const float ws_ = __builtin_bit_cast(float, __builtin_amdgcn_ds_bpermute(bsel + 4 * ((k0) + 2 * i_), __builtin_bit_cast(int, (wv)))); \
      const f32x2 w2_ = {ws_, ws_};                                                                       \
      PFV_FMA(R[i_].x, 0, 0)  PFV_FMA(R[i_].x, 1, 1)  PFV_FMA(R[i_].x, 2, 2)  PFV_FMA(R[i_].x, 3, 3)      \
      PFV_FMA(R[i_].y, 0, 4)  PFV_FMA(R[i_].y, 1, 5)  PFV_FMA(R[i_].y, 2, 6)  PFV_FMA(R[i_].y, 3, 7)      \
      PFV_FMA(R[i_].z, 0, 8)  PFV_FMA(R[i_].z, 1, 9)  PFV_FMA(R[i_].z, 2, 10) PFV_FMA(R[i_].z, 3, 11)     \
      PFV_FMA(R[i_].w, 0, 12) PFV_FMA(R[i_].w, 1, 13) PFV_FMA(R[i_].w, 2, 14) PFV_FMA(R[i_].w, 3, 15)     \
    }                                                                                                     \
  }
__device__ void phase_peer_u(const Params& p, char* smem) {
  unsigned char* ws = p.ws;
  PeCtx c;
  c.U8 = ws + WS_U8; c.USV = (const float2*)(ws + WS_USV);
  const float* PG = (const float*)(ws + WS_PG);
  const bf16_t* HB = (const bf16_t*)(ws + WS_HB);
  const float* SSQ2 = (const float*)(ws + WS_SSQ2);
  const unsigned* PIDX = (const unsigned*)(ws + WS_PIDX);
  const int tidu = otid();
  const int lane = tidu & 63, wave = tidu >> 6;
  c.lane = lane; c.r = lane & 15; c.g = lane >> 4;
  c.list = (LAS unsigned*)(smem + wave * 8192);
  c.glist = (LAS float*)(smem + 65536 + wave * 8192);
  const bool hi = lane >= 32;
  const int bsel = hi ? 4 : 0;
  const unsigned char* V4 = ws + WS_V8 + (lane & 31) * 16;
  c.s = 0;
  {
    for (int grp = vblock() * NWAVES + wave; grp < T / 16; grp += gridDim.x * NWAVES) {
      const int t0 = grp * 16;
      c.t0 = t0;
      u32x4 bq[16];
      {
        const bf16_t* hp = HB + (size_t)(t0 + c.r) * 1024 + c.g * 16;
        const float rq = rsqrtf(SSQ2[t0 + c.r] * (1.f / 1024.f) + EPS) * 16.f;
#pragma unroll
        for (int kh = 0; kh < 16; ++kh) {
          const u32x4 h0 = *(const u32x4*)(hp + (kh >> 1) * 128 + (kh & 1) * 64), h1 = *(const u32x4*)(hp + (kh >> 1) * 128 + (kh & 1) * 64 + 8);
          u32x4 q;
#pragma unroll
          for (int i = 0; i < 4; ++i) {
            const unsigned lo = (i < 2) ? h0[2 * i] : h1[2 * i - 4], hi2 = (i < 2) ? h0[2 * i + 1] : h1[2 * i - 3];
            int w = 0;
            w = __builtin_amdgcn_cvt_pk_fp8_f32(bflo(lo) * rq, bfhi(lo) * rq, w, false);
            w = __builtin_amdgcn_cvt_pk_fp8_f32(bflo(hi2) * rq, bfhi(hi2) * rq, w, true);
            q[i] = (unsigned)w;
          }
          bq[kh] = q;
        }
      }
      const int n = 2048;
#pragma unroll
      for (int q = 0; q < 8; ++q) {
        const u32x4 idv = *(const u32x4*)(PIDX + (size_t)t0 * 128 + q * 256 + lane * 4);
        const f32x4 gv = *(const f32x4*)(PG + (size_t)t0 * 128 + q * 256 + lane * 4);
        const unsigned hi = (unsigned)(2 * q + (lane >> 5)) << 21, sl = (unsigned)((lane & 31) * 4);
        *(LAS u32x4*)(c.list + q * 256 + lane * 4) = (u32x4){hi | (idv.x << 7) | sl, hi | (idv.y << 7) | (sl + 1), hi | (idv.z << 7) | (sl + 2), hi | (idv.w << 7) | (sl + 3)};
        *(LAS f32x4*)(c.glist + q * 256 + lane * 4) = gv;
      }
      asm volatile("s_waitcnt lgkmcnt(0)" ::: "memory");
      c.n = n;
      const int nch = (n + 15) >> 4;
      u32x4 a0[8], a1[8];
      pe_rows(c, 0, a0);
      {
        unsigned z = 0u;
#pragma unroll
        for (int ks = 0; ks < 8; ++ks) z |= a0[ks].w;
        asm volatile("" ::"v"(z));
      }
      if (nch > 0) {
        for (int ci = 0;; ci += 2) {
          pe_chunk(c, ci, a0, a1, bq);
          if (ci + 1 >= nch) break;
          pe_chunk(c, ci + 1, a1, a0, bq);
          if (ci + 2 >= nch) break;
        }
      }
      asm volatile("s_waitcnt lgkmcnt(0)" ::: "memory");
      {
        unsigned e0 = (c.list[lane] >> 7) & 16383u, e1 = (c.list[64 + lane] >> 7) & 16383u;
        float w0 = c.glist[lane], w1 = c.glist[64 + lane];
        u32x4 RA[8], RB[8];
        PFV_LOAD(RA, e0, 0)
        {
          unsigned z = 0u;
#pragma unroll
          for (int i = 0; i < 8; ++i) z |= RA[i].w;
          asm volatile("" ::"v"(z));
        }
        for (int tk = 0; tk < 16; ++tk) {
          const int tn = tk < 15 ? tk + 1 : tk;
          const unsigned e0n = (c.list[tn * 128 + lane] >> 7) & 16383u, e1n = (c.list[tn * 128 + 64 + lane] >> 7) & 16383u;
          const float w0n = c.glist[tn * 128 + lane], w1n = c.glist[tn * 128 + 64 + lane];
          const size_t oo = (size_t)(t0 + tk) * 1024 + (lane & 31) * 32 + (hi ? 16 : 0);
          const u32x4 hb0 = *(const u32x4*)(HB + oo), hb1 = *(const u32x4*)(HB + oo + 8);
          f32x2 acc[16];
#pragma unroll
          for (int k = 0; k < 16; ++k) acc[k] = (f32x2){0.f, 0.f};
          __builtin_amdgcn_sched_barrier(0);
          PFV_LOAD(RB, e0, 16)  __builtin_amdgcn_sched_barrier(0);  PFV_ACC(RA, w0, 0)
          PFV_LOAD(RA, e0, 32)  __builtin_amdgcn_sched_barrier(0);  PFV_ACC(RB, w0, 16)
          PFV_LOAD(RB, e0, 48)  __builtin_amdgcn_sched_barrier(0);  PFV_ACC(RA, w0, 32)
          PFV_LOAD(RA, e1, 0)   __builtin_amdgcn_sched_barrier(0);  PFV_ACC(RB, w0, 48)
          PFV_LOAD(RB, e1, 16)  __builtin_amdgcn_sched_barrier(0);  PFV_ACC(RA, w1, 0)
          PFV_LOAD(RA, e1, 32)  __builtin_amdgcn_sched_barrier(0);  PFV_ACC(RB, w1, 16)
          PFV_LOAD(RB, e1, 48)  __builtin_amdgcn_sched_barrier(0);  PFV_ACC(RA, w1, 32)
          PFV_LOAD(RA, e0n, 0)  __builtin_amdgcn_sched_barrier(0);  PFV_ACC(RB, w1, 48)
          f32x2 r[8];
#pragma unroll
          for (int k = 0; k < 8; ++k) {
            const f32x2 keep = hi ? acc[8 + k] : acc[k], send = hi ? acc[k] : acc[8 + k];
            r[k] = keep + (f32x2){__shfl_xor(send.x, 32), __shfl_xor(send.y, 32)};
          }
          float* o = p.out + oo;
          *(f32x4*)(o)      = (f32x4){bflo(hb0.x) + r[0].x, bfhi(hb0.x) + r[0].y, bflo(hb0.y) + r[1].x, bfhi(hb0.y) + r[1].y};
          *(f32x4*)(o + 4)  = (f32x4){bflo(hb0.z) + r[2].x, bfhi(hb0.z) + r[2].y, bflo(hb0.w) + r[3].x, bfhi(hb0.w) + r[3].y};
          *(f32x4*)(o + 8)  = (f32x4){bflo(hb1.x) + r[4].x, bfhi(hb1.x) + r[4].y, bflo(hb1.y) + r[5].x, bfhi(hb1.y) + r[5].y};
          *(f32x4*)(o + 12) = (f32x4){bflo(hb1.z) + r[6].x, bfhi(hb1.z) + r[6].y, bflo(hb1.w) + r[7].x, bfhi(hb1.w) + r[7].y};
          e0 = e0n; e1 = e1n; w0 = w0n; w1 = w1n;
        }
      }
      asm volatile("" ::: "memory");
    }
  }
}
#undef PFV_LOAD
#undef PFV_FMA
#undef PFV_ACC


#define XB_TMO      128
#define XB_XCNT(j)  (256  + 64 * (j))
#define XB_XSUB(j)  (1280 + 64 * (j))
#define XB_XGEN(j)  (2304 + 64 * (j))
#define XB_TOP      3328
#define XB_TOPGEN   3392
#define XCD_BAR_WORDS 3456
#define XB_SPIN_CAP (1u << 22)
__device__ __forceinline__ unsigned xb_ld(unsigned* p)              { return __hip_atomic_load(p, __ATOMIC_RELAXED, __HIP_MEMORY_SCOPE_AGENT); }
__device__ __forceinline__ unsigned xb_add(unsigned* p, unsigned v) { return __hip_atomic_fetch_add(p, v, __ATOMIC_RELAXED, __HIP_MEMORY_SCOPE_AGENT); }
__device__ __forceinline__ unsigned xb_xcc_id() { return (unsigned)__builtin_amdgcn_s_getreg((3 << 11) | 20) & 0xFu; }
#define XB_SPIN(cond, bar) do { unsigned _sp = 0; while (cond) { __builtin_amdgcn_s_sleep(1); \
    if ((++_sp & 255u) == 0u) { if (xb_ld(&(bar)[XB_TMO])) break; if (_sp > XB_SPIN_CAP) { atomicAdd(&(bar)[XB_TMO], 1u); break; } } } } while (0)
struct XcdBarrier { unsigned* bar; unsigned x; volatile LAS unsigned* st; };
__device__ __forceinline__ XcdBarrier xcd_barrier_post(unsigned* bar, volatile LAS unsigned* st) {
    XcdBarrier b; b.bar = bar; b.x = xb_xcc_id(); b.st = st;
    if (threadIdx.x == 0) (void)xb_add(&bar[XB_XCNT(b.x)], 1u);
    return b;
}
__device__ __forceinline__ void xcd_barrier_complete(unsigned* bar, unsigned x, unsigned& nloc, unsigned& nx) {
    const unsigned G = gridDim.x * gridDim.y * gridDim.z;
    unsigned sum, cnt, mine, sp = 0u;
    for (;;) {
        sum = 0u; cnt = 0u; mine = 0u;
#pragma unroll
        for (unsigned j = 0; j < 16; ++j) { const unsigned c = xb_ld(&bar[XB_XCNT(j)]); sum += c; cnt += (c > 0u) ? 1u : 0u; mine = (j == x) ? c : mine; }
        if (sum == G) break;
        __builtin_amdgcn_s_sleep(1);
        if ((++sp & 255u) == 0u) { if (xb_ld(&bar[XB_TMO])) break; if (sp > XB_SPIN_CAP) { atomicAdd(&bar[XB_TMO], 1u); break; } }
    }
    nloc = mine > 0u ? mine : 1u; nx = cnt > 0u ? cnt : 1u;
}
__device__ __forceinline__ void xcd_barrier(const XcdBarrier& b) {
    asm volatile("s_waitcnt vmcnt(0)" ::: "memory");
    __syncthreads();
    if (threadIdx.x == 0) {
        unsigned* bar = b.bar;
        __builtin_amdgcn_s_waitcnt(0);
        unsigned nloc = b.st[0], nx = b.st[1];
        if (nloc == 0u) { xcd_barrier_complete(bar, b.x, nloc, nx); b.st[0] = nloc; b.st[1] = nx; }
        const unsigned old = xb_add(&bar[XB_XSUB(b.x)], 1u);
        const unsigned gen = old / nloc;
        if (old + 1u == (gen + 1u) * nloc) {
            __builtin_amdgcn_fence(__ATOMIC_RELEASE, "agent");
            asm volatile("s_waitcnt vmcnt(0)" ::: "memory");
            const unsigned og = xb_add(&bar[XB_TOP], 1u);
            const unsigned tg = og / nx;
            if (og + 1u == (tg + 1u) * nx) xb_add(&bar[XB_TOPGEN], 1u);
            else XB_SPIN(xb_ld(&bar[XB_TOPGEN]) == tg, bar);
            __builtin_amdgcn_fence(__ATOMIC_ACQUIRE, "agent");
            xb_add(&bar[XB_XGEN(b.x)], 1u);
            asm volatile("s_waitcnt vmcnt(0)" ::: "memory");
        } else {
            XB_SPIN(xb_ld(&bar[XB_XGEN(b.x)]) == gen, bar);
            __builtin_amdgcn_fence(__ATOMIC_ACQUIRE, "agent");
            asm volatile("s_waitcnt vmcnt(0)" ::: "memory");
        }
    }
    __syncthreads();
}

__global__ void __launch_bounds__(NTHREADS, 2) k_fused(Params p) {
  __shared__ __attribute__((aligned(16))) char smem[LDS_BYTES];
  if (threadIdx.x == 0) *(u32x4*)(smem + LDS_BAR) = (u32x4){0u, 0u, 0u, 0u};
  __syncthreads();
  const XcdBarrier bar = xcd_barrier_post((unsigned*)(p.ws + WS_CTL), (volatile LAS unsigned*)(smem + LDS_BAR));
#ifdef PROBE_PHASE
  unsigned long long ts[12];
#define STAMP(k) ts[k] = __builtin_amdgcn_s_memrealtime();
#else
#define STAMP(k)
#endif
  STAMP(0)
  phase_prep(p);
  xcd_barrier(bar);
  STAMP(1)
  phase_inproj(p, smem);
  xcd_barrier(bar);
  STAMP(2)
  phase_mix(p, smem);
  xcd_barrier(bar);
  STAMP(3)
  phase_outproj(p, smem);
  xcd_barrier(bar);
  STAMP(4)
  phase_qproj(p, smem);
  xcd_barrier(bar);
  STAMP(5)
  phase_route(p, smem);
  xcd_barrier(bar);
  STAMP(6)
  phase_peer_u(p, smem);
#ifdef PROBE_PHASE
  xcd_barrier(bar);
  STAMP(7)
  if (blockIdx.x == 0 && threadIdx.x == 0) {
    const float us = (float)(ts[PROBE_PHASE + 1] - ts[PROBE_PHASE]) * 0.01f;
    p.out[12345] += us * (1.f / PROBE_DIV);
  }
#endif
}

extern "C" void kernel_launch(void* const* d_in, const int* in_sizes, int n_in, void* d_out, int out_size, void* d_ws, size_t ws_size,
                              hipStream_t stream) {
  if (n_in != 17 || ws_size < WS_END) {
    fprintf(stderr, "kernel_launch: unexpected n_in %d / ws_size %zu\n", n_in, ws_size);
    return;
  }
  Params p{};
  p.x = (const float*)d_in[0]; p.norm_mix_g = (const float*)d_in[1]; p.w_in = (const float*)d_in[2]; p.q_norm_g = (const float*)d_in[3];
  p.k_norm_g = (const float*)d_in[4]; p.attn_out_g = (const float*)d_in[5]; p.conv_w = (const float*)d_in[6]; p.conv_b = (const float*)d_in[7];
  p.conv_ln_g = (const float*)d_in[8]; p.conv_ln_b = (const float*)d_in[9]; p.w_out = (const float*)d_in[10]; p.norm_ffn_g = (const float*)d_in[11];
  p.peer_wq = (const float*)d_in[12]; p.peer_k1 = (const float*)d_in[13]; p.peer_k2 = (const float*)d_in[14]; p.peer_u = (const float*)d_in[15];
  p.peer_v = (const float*)d_in[16];
  p.out = (float*)d_out;
  p.ws = (unsigned char*)d_ws;
  static int grid_blocks = 0;
  if (!grid_blocks) {
    int dev = 0, cus = 0, per_cu = 0;
    (void)hipGetDevice(&dev);
    (void)hipDeviceGetAttribute(&cus, hipDeviceAttributeMultiprocessorCount, dev);
    (void)hipOccupancyMaxActiveBlocksPerMultiprocessor(&per_cu, k_fused, NTHREADS, 0);
    if (per_cu > 1) per_cu = 1;
    if (per_cu < 1) per_cu = 1;
    grid_blocks = cus * per_cu;
  }
  (void)hipMemsetAsync((char*)d_ws + WS_CTL, 0, XCD_BAR_WORDS * 4, stream);
  hipLaunchKernelGGL(k_fused, dim3(grid_blocks), dim3(NTHREADS), 0, stream, p);
}
```
